# Optimizing an MI355X kernel written in HIP

```python
import math
import jax, jax.numpy as jnp
from jax import lax
import numpy as np

D_MODEL = 1024
BATCH = 8
SEQ = 4096
DEPTH = 1

N_META = 16
BLOCK = 128
PREFIX = BLOCK
N_PAD = PREFIX - N_META
ATT_HEADS = 16
ATT_KV_HEADS = 2
ATT_GROUP = ATT_HEADS // ATT_KV_HEADS
ATT_HEAD_DIM = 64
WINDOW = 128
RET_HEADS = 4
RET_KEY_DIM = 128
RET_VALUE_DIM = 256
ATT_Q_W = ATT_HEADS * ATT_HEAD_DIM
ATT_KV_W = ATT_KV_HEADS * ATT_HEAD_DIM
RET_QK_W = RET_HEADS * RET_KEY_DIM
RET_V_W = RET_HEADS * RET_VALUE_DIM
GATE_W = 2 * D_MODEL
SPLIT_POINTS = (ATT_Q_W,
                ATT_Q_W + ATT_KV_W,
                ATT_Q_W + 2 * ATT_KV_W,
                ATT_Q_W + 2 * ATT_KV_W + RET_QK_W,
                ATT_Q_W + 2 * ATT_KV_W + 2 * RET_QK_W,
                ATT_Q_W + 2 * ATT_KV_W + 2 * RET_QK_W + RET_V_W,
                ATT_Q_W + 2 * ATT_KV_W + 2 * RET_QK_W + 2 * RET_V_W)
IN_WIDTH = ATT_Q_W + 2 * ATT_KV_W + 2 * RET_QK_W + 2 * RET_V_W + GATE_W
N_EXPERTS = 32
TOP_K = 4
D_FF = 1024
SWIGLU_ALPHA = 1.702
SWIGLU_LIMIT = 7.0
MOE_BLOCK = 256
EPS = 1e-5

kernel_name = "hybrid_swa_retention_moe_meta"


def rms_norm(x, gain=None):
    xf = x.astype(jnp.float32)
    y = xf * lax.rsqrt(jnp.mean(xf * xf, axis=-1, keepdims=True) + EPS)
    if gain is not None:
        y = y * gain.astype(jnp.float32)
    return y.astype(x.dtype)


def alibi_slopes(n_heads):
    return 2.0 ** (-8.0 * jnp.arange(1, n_heads + 1, dtype=jnp.float32) / n_heads)


def sliding_window_attention(q, k, v, sinks):
    b, l = q.shape[:2]
    nb = l // BLOCK
    qb = q.reshape(b, nb, BLOCK, ATT_KV_HEADS, ATT_GROUP, ATT_HEAD_DIM)
    kb = k.reshape(b, nb, BLOCK, ATT_KV_HEADS, ATT_HEAD_DIM)
    vb = v.reshape(b, nb, BLOCK, ATT_KV_HEADS, ATT_HEAD_DIM)
    pad_prev = ((0, 0), (1, 0), (0, 0), (0, 0), (0, 0))
    k_band = jnp.concatenate([jnp.pad(kb[:, :-1], pad_prev), kb], axis=2)
    v_band = jnp.concatenate([jnp.pad(vb[:, :-1], pad_prev), vb], axis=2)
    k_meta = k[:, N_PAD:PREFIX]
    v_meta = v[:, N_PAD:PREFIX]
    meta_pos = jnp.arange(N_PAD, PREFIX)
    q_pos = jnp.arange(l).reshape(nb, BLOCK)
    slopes = alibi_slopes(ATT_HEADS).reshape(ATT_KV_HEADS, ATT_GROUP)
    sink = sinks.astype(jnp.float32).reshape(ATT_KV_HEADS, ATT_GROUP)
    scale = ATT_HEAD_DIM ** -0.5

    def one_block(args):
        q_blk, kb_blk, vb_blk, qp = args
        kp = jnp.concatenate([qp - BLOCK, qp])
        d_band = qp[:, None] - kp[None, :]
        ok_band = (d_band >= 0) & (d_band < WINDOW) & (kp[None, :] >= PREFIX)
        d_meta = qp[:, None] - meta_pos[None, :]
        ok_meta = d_meta >= 0
        dist = jnp.abs(jnp.concatenate([d_meta, d_band], axis=1)).astype(jnp.float32)
        ok = jnp.concatenate([ok_meta, ok_band], axis=1)
        keys = jnp.concatenate([k_meta, kb_blk], axis=1)
        vals = jnp.concatenate([v_meta, vb_blk], axis=1)
        s = jnp.einsum('bqhgd,bkhd->bhgqk', q_blk, keys).astype(jnp.float32) * scale
        s = s - slopes[:, :, None, None] * dist
        s = jnp.where(ok, s, -jnp.inf)
        sink_col = jnp.broadcast_to(sink[None, :, :, None, None], s.shape[:-1] + (1,))
        p = jax.nn.softmax(jnp.concatenate([s, sink_col], axis=-1), axis=-1)[..., :-1]
        return jnp.einsum('bhgqk,bkhd->bqhgd', p.astype(vals.dtype), vals)

    out = lax.map(one_block, (jnp.moveaxis(qb, 1, 0), jnp.moveaxis(k_band, 1, 0),
                              jnp.moveaxis(v_band, 1, 0), q_pos))
    return jnp.moveaxis(out, 0, 1).reshape(b, l, ATT_Q_W)


def chunkwise_retention(q, k, v):
    out_dtype = q.dtype
    q, k, v = (a.astype(jnp.float32) for a in (q, k, v))
    b, l = q.shape[:2]
    nc = l // BLOCK
    log_g = jnp.log1p(-(2.0 ** (-5.0 - jnp.arange(RET_HEADS, dtype=jnp.float32))))
    idx = jnp.arange(BLOCK, dtype=jnp.float32)
    diff = idx[:, None] - idx[None, :]
    decay_intra = jnp.where(diff >= 0, jnp.exp(log_g[:, None, None] * jnp.maximum(diff, 0.0)), 0.0)
    decay_in = jnp.exp(log_g[None, :] * (idx[:, None] + 1.0))
    decay_out = jnp.exp(log_g[None, :] * (BLOCK - 1.0 - idx[:, None]))
    decay_chunk = jnp.exp(log_g * BLOCK)
    qc = q.reshape(b, nc, BLOCK, RET_HEADS, RET_KEY_DIM)
    kc = k.reshape(b, nc, BLOCK, RET_HEADS, RET_KEY_DIM)
    vc = v.reshape(b, nc, BLOCK, RET_HEADS, RET_VALUE_DIM)
    s = jnp.einsum('bnqhd,bnkhd->bnhqk', qc, kc) * decay_intra
    intra = jnp.einsum('bnhqk,bnkhe->bnqhe', s, vc)
    kv = jnp.einsum('bnkhd,bnkhe->bnhde', kc * decay_out[None, None, :, :, None], vc)

    def step(state, kv_n):
        return state * decay_chunk[:, None, None] + kv_n, state

    init = jnp.zeros((b, RET_HEADS, RET_KEY_DIM, RET_VALUE_DIM), jnp.float32)
    _, prev = lax.scan(step, init, jnp.moveaxis(kv, 1, 0))
    prev = jnp.moveaxis(prev, 0, 1)
    cross = jnp.einsum('bnqhd,bnhde->bnqhe', qc, prev) * decay_in[None, None, :, :, None]
    return (intra + cross).reshape(b, l, RET_HEADS, RET_VALUE_DIM).astype(out_dtype)


def moe_ffn(u, w_router, b_router, w_gate_up, b_gate_up, w_down, b_down):
    shape = u.shape
    t = u.reshape(-1, D_MODEL)
    n = t.shape[0]
    logits = (t @ w_router + b_router).astype(jnp.float32)
    top_logit, top_idx = lax.top_k(logits, TOP_K)
    top_w = jax.nn.softmax(top_logit, axis=-1)
    e_flat = top_idx.reshape(-1)
    tok_flat = jnp.repeat(jnp.arange(n, dtype=jnp.int32), TOP_K)
    w_flat = top_w.reshape(-1)
    order = jnp.argsort(e_flat)
    e_sorted = e_flat[order]
    counts = jnp.bincount(e_flat, length=N_EXPERTS)
    padded = (counts + MOE_BLOCK - 1) // MOE_BLOCK * MOE_BLOCK
    start = jnp.cumsum(counts) - counts
    pend = jnp.cumsum(padded)
    pstart = pend - padded
    dest = pstart[e_sorted] + jnp.arange(n * TOP_K) - start[e_sorted]
    n_rows = (-(-(n * TOP_K) // MOE_BLOCK) + N_EXPERTS) * MOE_BLOCK
    n_blocks = n_rows // MOE_BLOCK
    row_tok = jnp.full((n_rows,), n, jnp.int32).at[dest].set(tok_flat[order])
    row_w = jnp.zeros((n_rows,), jnp.float32).at[dest].set(w_flat[order])
    block_expert = jnp.minimum(
        jnp.searchsorted(pend, jnp.arange(n_blocks) * MOE_BLOCK, side='right'), N_EXPERTS - 1)
    t_pad = jnp.concatenate([t, jnp.zeros((1, D_MODEL), t.dtype)], axis=0)

    def expert_block(args):
        rows, e = args
        xb = t_pad[rows]
        gu = xb @ w_gate_up[e] + b_gate_up[e]
        gate, up = jnp.split(gu, 2, axis=-1)
        gate = jnp.minimum(gate, SWIGLU_LIMIT)
        up = jnp.clip(up, -SWIGLU_LIMIT, SWIGLU_LIMIT)
        act = (up + 1.0) * gate * jax.nn.sigmoid(SWIGLU_ALPHA * gate)
        return act @ w_down[e] + b_down[e]

    out = lax.map(expert_block, (row_tok.reshape(n_blocks, MOE_BLOCK), block_expert))
    out = out.reshape(n_rows, D_MODEL) * row_w[:, None].astype(out.dtype)
    y = jnp.zeros((n + 1, D_MODEL), out.dtype).at[row_tok].add(out)[:n]
    return y.reshape(shape)


def setup_inputs(seed: int = 0) -> dict:
    key = jax.random.key(seed)
    ks = jax.random.split(key, 20)
    f32 = jnp.float32
    nrm = lambda k, s, sc: jax.random.normal(k, s, f32) * sc
    return {
        "x": nrm(ks[0], (BATCH, SEQ, D_MODEL), 1.0),
        "meta_tokens": nrm(ks[1], (N_META, D_MODEL), 1.0),
        "mix_norm_gain": 1.0 + nrm(ks[2], (DEPTH, D_MODEL), 0.02),
        "w_in": nrm(ks[3], (DEPTH, D_MODEL, IN_WIDTH), D_MODEL ** -0.5),
        "q_norm_gain": 1.0 + nrm(ks[4], (DEPTH, ATT_HEAD_DIM), 0.02),
        "k_norm_gain": 1.0 + nrm(ks[5], (DEPTH, ATT_HEAD_DIM), 0.02),
        "attn_sinks": nrm(ks[6], (DEPTH, ATT_HEADS), 0.5),
        "w_attn_branch": nrm(ks[7], (DEPTH, ATT_Q_W, D_MODEL), ATT_Q_W ** -0.5),
        "w_ret_branch": nrm(ks[8], (DEPTH, RET_V_W, D_MODEL), RET_V_W ** -0.5),
        "w_out": nrm(ks[9], (DEPTH, D_MODEL, D_MODEL), D_MODEL ** -0.5),
        "ffn_norm_gain": 1.0 + nrm(ks[10], (DEPTH, D_MODEL), 0.02),
        "w_router": nrm(ks[11], (DEPTH, D_MODEL, N_EXPERTS), D_MODEL ** -0.5),
        "b_router": nrm(ks[12], (DEPTH, N_EXPERTS), 0.01),
        "w_gate_up": nrm(ks[13], (DEPTH, N_EXPERTS, D_MODEL, 2 * D_FF), D_MODEL ** -0.5),
        "b_gate_up": nrm(ks[14], (DEPTH, N_EXPERTS, 2 * D_FF), 0.01),
        "w_down": nrm(ks[15], (DEPTH, N_EXPERTS, D_FF, D_MODEL), D_FF ** -0.5),
        "b_down": nrm(ks[16], (DEPTH, N_EXPERTS, D_MODEL), 0.01),
    }


def reference(x, meta_tokens, mix_norm_gain, w_in, q_norm_gain, k_norm_gain, attn_sinks,
              w_attn_branch, w_ret_branch, w_out, ffn_norm_gain, w_router, b_router,
              w_gate_up, b_gate_up, w_down, b_down):
    b = x.shape[0]
    h = jnp.concatenate([
        jnp.zeros((b, N_PAD, D_MODEL), x.dtype),
        jnp.broadcast_to(meta_tokens.astype(x.dtype)[None], (b, N_META, D_MODEL)),
        x], axis=1)
    l = h.shape[1]
    occupied = (jnp.arange(l) >= N_PAD)[None, :, None, None]
    for layer in range(DEPTH):
        u = rms_norm(h, mix_norm_gain[layer])
        proj = u @ w_in[layer]
        aq, ak, av, rq, rk, rv, rg, gates = jnp.split(proj, SPLIT_POINTS, axis=-1)
        aq = rms_norm(aq.reshape(b, l, ATT_HEADS, ATT_HEAD_DIM), q_norm_gain[layer])
        ak = rms_norm(ak.reshape(b, l, ATT_KV_HEADS, ATT_HEAD_DIM), k_norm_gain[layer])
        av = av.reshape(b, l, ATT_KV_HEADS, ATT_HEAD_DIM)
        y_att = sliding_window_attention(aq, ak, av, attn_sinks[layer])
        rq = rq.reshape(b, l, RET_HEADS, RET_KEY_DIM)
        rk = jnp.where(occupied, rk.reshape(b, l, RET_HEADS, RET_KEY_DIM), 0.0).astype(rq.dtype) * (RET_KEY_DIM ** -0.5)
        rv = rv.reshape(b, l, RET_HEADS, RET_VALUE_DIM)
        y_ret = rms_norm(chunkwise_retention(rq, rk, rv)).reshape(b, l, RET_V_W) * jax.nn.silu(rg)
        g_att, g_ret = jnp.split(jax.nn.sigmoid(gates), 2, axis=-1)
        merged = g_att * (y_att @ w_attn_branch[layer]) + g_ret * (y_ret @ w_ret_branch[layer])
        h = h + merged @ w_out[layer]
        if layer == DEPTH - 1:
            h = h[:, PREFIX:]
        h = h + moe_ffn(rms_norm(h, ffn_norm_gain[layer]), w_router[layer], b_router[layer],
                        w_gate_up[layer], b_gate_up[layer], w_down[layer], b_down[layer])
    return h
```

```cpp
#include <hip/hip_runtime.h>
#include <cstdio>
#include <cstdint>

typedef unsigned short bf16;
__device__ __forceinline__ float bf2f(bf16 v) { return __uint_as_float(((unsigned)v) << 16); }
__device__ __forceinline__ bf16 f2bf(float f) { unsigned u = __float_as_uint(f); return (bf16)((u + 0x7fffu + ((u >> 16) & 1u)) >> 16); }
__device__ __forceinline__ float sigmoidf_(float x) { return 1.0f / (1.0f + __expf(-x)); }

constexpr int NB = 8, SEQ = 4096, D = 1024, NTOK = NB * SEQ;
constexpr int NMETA = 16;
constexpr int INW = 6400;
constexpr int C_AQ = 0, C_AK = 1024, C_AV = 1152, C_RQ = 1280, C_RK = 1792, C_RV = 2304, C_RG = 3328, C_GA = 4352, C_GR = 5376;
constexpr int NE = 32, TOPK = 4, DFF = 1024;
constexpr int NROWS = (NTOK * TOPK / 256 + NE) * 256;
constexpr int NTILE = NROWS / 256;
constexpr float EPS = 1e-5f;

constexpr size_t MiB = 1u << 20;
constexpr size_t WS_CTL = 0;
constexpr size_t WS_SMALL = 1 * MiB;
constexpr size_t WS_W = 16 * MiB;
constexpr size_t WS_XB = 232 * MiB;
constexpr size_t WS_PROJ = 296 * MiB;
constexpr size_t WS_YATT = 696 * MiB;
constexpr size_t WS_YRET = 760 * MiB;
constexpr size_t WS_MERGED = 824 * MiB;
constexpr size_t WS_END = 1020 * MiB;
constexpr size_t WS_ACT = 296 * MiB;
constexpr size_t WS_ROWS = 568 * MiB;
constexpr size_t SM_UMETA = WS_SMALL;
constexpr size_t SM_PMETA = WS_SMALL + 64 * 1024;
constexpr size_t SM_TKE = WS_SMALL + 512 * 1024;
constexpr size_t SM_TKW = SM_TKE + 512 * 1024;
constexpr size_t SM_TKPOS = SM_TKW + 512 * 1024;
constexpr size_t SM_TKROW = SM_TKPOS + 512 * 1024;
constexpr size_t SM_ROWTOK = SM_TKROW + 512 * 1024;
constexpr size_t SM_ROWW = SM_ROWTOK + 1024 * 1024;
constexpr size_t SM_TILEE = SM_ROWW + 1024 * 1024;
constexpr int CW_CNT = 1024;

__global__ void __launch_bounds__(256) k_prep_naive(const float* __restrict__ x, const float* __restrict__ g, bf16* __restrict__ u, int nrows) {
    const int row = blockIdx.x * 4 + (threadIdx.x >> 6), lane = threadIdx.x & 63;
    if (row >= nrows) return;
    const float4* xr = (const float4*)(x + (size_t)row * D);
    float4 v[4]; float ss = 0.f;
#pragma unroll
    for (int j = 0; j < 4; ++j) { v[j] = xr[j * 64 + lane]; ss += v[j].x * v[j].x + v[j].y * v[j].y + v[j].z * v[j].z + v[j].w * v[j].w; }
#pragma unroll
    for (int o = 1; o < 64; o <<= 1) ss += __shfl_xor(ss, o);
    const float rstd = rsqrtf(ss * (1.0f / D) + EPS);
#pragma unroll
    for (int j = 0; j < 4; ++j) {
        const float4 gg = ((const float4*)g)[j * 64 + lane];
        bf16* o = u + (size_t)row * D + (j * 64 + lane) * 4;
        o[0] = f2bf(v[j].x * rstd * gg.x); o[1] = f2bf(v[j].y * rstd * gg.y); o[2] = f2bf(v[j].z * rstd * gg.z); o[3] = f2bf(v[j].w * rstd * gg.w);
    }
}

enum { EPI_RAW = 0, EPI_BR0, EPI_BR1, EPI_OUT, EPI_GU, EPI_DOWN };
struct NGemm {
    const bf16* A; int lda; const int* arow;
    const float* B; int ldb; long bstride;
    int M, N, K;
    const int* tile_e;
    bf16* Cb; int ldc; float* Cf; const float* X;
    const bf16* G; int ldg;
    const float* bias; long bias_stride; const float* roww;
};
template <int EPI>
__global__ void __launch_bounds__(256) k_gemm_naive(NGemm p) {
    __shared__ float As[16][68];
    __shared__ float Bs[16][64];
    __shared__ float Bs2[(EPI == EPI_GU) ? 16 : 1][64];
    const int tid = threadIdx.x, tx = tid & 15, ty = tid >> 4;
    const int m0 = blockIdx.y * 64, n0 = blockIdx.x * 64;
    int e = 0;
    if (p.tile_e) { e = p.tile_e[m0 >> 8]; if (e < 0) return; }
    const float* B = p.B + (size_t)e * p.bstride;
    float acc[4][4], acc2[4][4];
#pragma unroll
    for (int i = 0; i < 4; ++i)
#pragma unroll
        for (int j = 0; j < 4; ++j) { acc[i][j] = 0.f; acc2[i][j] = 0.f; }
    const int ar = tid >> 2, ak = (tid & 3) * 4;
    int arow = m0 + ar; if (arow >= p.M) arow = p.M - 1;
    if (p.arow) arow = p.arow[arow];
    const bf16* Ap = p.A + (size_t)arow * p.lda + ak;
    const int bk = tid >> 4, bn = (tid & 15) * 4;
    for (int k0 = 0; k0 < p.K; k0 += 16) {
        const uint2 av = *(const uint2*)(Ap + k0);
        As[ak + 0][ar] = __uint_as_float(av.x << 16); As[ak + 1][ar] = __uint_as_float(av.x & 0xffff0000u);
        As[ak + 2][ar] = __uint_as_float(av.y << 16); As[ak + 3][ar] = __uint_as_float(av.y & 0xffff0000u);
        const float4 bv = *(const float4*)(B + (size_t)(k0 + bk) * p.ldb + n0 + bn);
        *(float4*)&Bs[bk][bn] = bv;
        if (EPI == EPI_GU) { const float4 bv2 = *(const float4*)(B + (size_t)(k0 + bk) * p.ldb + DFF + n0 + bn); *(float4*)&Bs2[bk][bn] = bv2; }
        __syncthreads();
#pragma unroll
        for (int k = 0; k < 16; ++k) {
            const float4 a = *(const float4*)&As[k][ty * 4];
            const float4 b = *(const float4*)&Bs[k][tx * 4];
            const float aa[4] = {a.x, a.y, a.z, a.w}, bb[4] = {b.x, b.y, b.z, b.w};
#pragma unroll
            for (int i = 0; i < 4; ++i)
#pragma unroll
                for (int j = 0; j < 4; ++j) acc[i][j] += aa[i] * bb[j];
            if (EPI == EPI_GU) {
                const float4 b2 = *(const float4*)&Bs2[k][tx * 4];
                const float cc[4] = {b2.x, b2.y, b2.z, b2.w};
#pragma unroll
                for (int i = 0; i < 4; ++i)
#pragma unroll
                    for (int j = 0; j < 4; ++j) acc2[i][j] += aa[i] * cc[j];
            }
        }
        __syncthreads();
    }
#pragma unroll
    for (int i = 0; i < 4; ++i) {
        const int r = m0 + ty * 4 + i; if (r >= p.M) continue;
#pragma unroll
        for (int j = 0; j < 4; ++j) {
            const int c = n0 + tx * 4 + j; const float a = acc[i][j];
            if (EPI == EPI_RAW) p.Cb[(size_t)r * p.ldc + c] = f2bf(a);
            else if (EPI == EPI_BR0) p.Cb[(size_t)r * p.ldc + c] = f2bf(bf2f(p.G[(size_t)r * p.ldg + c]) * a);
            else if (EPI == EPI_BR1) p.Cb[(size_t)r * p.ldc + c] = f2bf(bf2f(p.Cb[(size_t)r * p.ldc + c]) + bf2f(p.G[(size_t)r * p.ldg + c]) * a);
            else if (EPI == EPI_OUT) p.Cf[(size_t)r * p.ldc + c] = p.X[(size_t)r * p.ldc + c] + a;
            else if (EPI == EPI_GU) {
                float gate = a + p.bias[(size_t)e * p.bias_stride + c], up = acc2[i][j] + p.bias[(size_t)e * p.bias_stride + DFF + c];
                gate = fminf(gate, 7.0f); up = fminf(fmaxf(up, -7.0f), 7.0f);
                p.Cb[(size_t)r * p.ldc + c] = f2bf((up + 1.0f) * gate * sigmoidf_(1.702f * gate));
            } else if (EPI == EPI_DOWN) p.Cb[(size_t)r * p.ldc + c] = f2bf((a + p.bias[(size_t)e * p.bias_stride + c]) * p.roww[r]);
        }
    }
}

__global__ void __launch_bounds__(256) k_post_naive(bf16* __restrict__ proj, const float* __restrict__ qg, const float* __restrict__ kg) {
    bf16* row = proj + (size_t)blockIdx.x * INW; const int t = threadIdx.x;
    {
        float v[4], ss = 0.f;
#pragma unroll
        for (int j = 0; j < 4; ++j) { v[j] = bf2f(row[C_AQ + 4 * t + j]); ss += v[j] * v[j]; }
        ss += __shfl_xor(ss, 1); ss += __shfl_xor(ss, 2); ss += __shfl_xor(ss, 4); ss += __shfl_xor(ss, 8);
        const float r = rsqrtf(ss * (1.0f / 64.0f) + EPS);
#pragma unroll
        for (int j = 0; j < 4; ++j) row[C_AQ + 4 * t + j] = f2bf(v[j] * r * qg[(4 * t + j) & 63] * 0.125f);
    }
    {
        if (t < 64) {
            const int tt = t & 31; float v[4], ss = 0.f;
#pragma unroll
            for (int j = 0; j < 4; ++j) { v[j] = bf2f(row[C_AK + 4 * tt + j]); ss += v[j] * v[j]; }
            ss += __shfl_xor(ss, 1); ss += __shfl_xor(ss, 2); ss += __shfl_xor(ss, 4); ss += __shfl_xor(ss, 8);
            const float r = rsqrtf(ss * (1.0f / 64.0f) + EPS);
            if (t < 32) {
#pragma unroll
                for (int j = 0; j < 4; ++j) row[C_AK + 4 * tt + j] = f2bf(v[j] * r * kg[(4 * tt + j) & 63]);
            }
        }
    }
    for (int c = t; c < 512; c += 256) row[C_RK + c] = f2bf(bf2f(row[C_RK + c]) * 0.08838834764831845f);
    for (int c = t; c < 1024; c += 256) { const float v = bf2f(row[C_RG + c]); row[C_RG + c] = f2bf(v * sigmoidf_(v)); }
    for (int c = t; c < 2048; c += 256) { const float v = bf2f(row[C_GA + c]); row[C_GA + c] = f2bf(sigmoidf_(v)); }
}

__global__ void __launch_bounds__(256) k_attn_naive(const bf16* __restrict__ proj, const bf16* __restrict__ pmeta, const float* __restrict__ sinks, bf16* __restrict__ yatt) {
    const int tid = threadIdx.x, h = tid & 15, tl = tid >> 4;
    const int row = blockIdx.x * 16 + tl, b = row / SEQ, i = row % SEQ, kvh = h >> 3;
    const float slope = exp2f(-0.5f * (float)(h + 1));
    float q[64], o[64];
    { const bf16* qp = proj + (size_t)row * INW + C_AQ + h * 64;
#pragma unroll
      for (int d = 0; d < 64; ++d) { q[d] = bf2f(qp[d]); o[d] = 0.f; } }
    float m = -1e30f, l = 0.f;
    const int j0 = (i - 127 > 0) ? i - 127 : 0;
    const int nk = NMETA + (i - j0 + 1);
    for (int kk = 0; kk < nk; ++kk) {
        const bf16* kp; float dist;
        if (kk < NMETA) { kp = pmeta + (size_t)kk * INW; dist = (float)(i + 16 - kk); }
        else { const int j = j0 + kk - NMETA; kp = proj + ((size_t)b * SEQ + j) * INW; dist = (float)(i - j); }
        const bf16* kr = kp + C_AK + kvh * 64; const bf16* vr = kp + C_AV + kvh * 64;
        float s = 0.f;
#pragma unroll
        for (int d = 0; d < 64; ++d) s += q[d] * bf2f(kr[d]);
        s -= slope * dist;
        const float mn = fmaxf(m, s), corr = __expf(m - mn), pw = __expf(s - mn);
        l = l * corr + pw;
#pragma unroll
        for (int d = 0; d < 64; ++d) o[d] = o[d] * corr + pw * bf2f(vr[d]);
        m = mn;
    }
    { const float sk = sinks[h]; const float mn = fmaxf(m, sk), corr = __expf(m - mn); l = l * corr + __expf(sk - mn);
      const float inv = corr / l;
      bf16* op = yatt + (size_t)row * D + h * 64;
#pragma unroll
      for (int d = 0; d < 64; ++d) op[d] = f2bf(o[d] * inv); }
}

__global__ void __launch_bounds__(256) k_ret_naive(const bf16* __restrict__ proj, const bf16* __restrict__ pmeta, float* __restrict__ raw) {
    __shared__ float qs[16][128], ks[16][128], vs[16][256];
    const int b = blockIdx.x >> 2, h = blockIdx.x & 3, c = threadIdx.x;
    const float gamma = 1.0f - exp2f(-5.0f - (float)h);
    float st[128];
#pragma unroll
    for (int d = 0; d < 128; ++d) st[d] = 0.f;
    for (int t0 = -16; t0 < SEQ; t0 += 16) {
        __syncthreads();
        for (int idx = threadIdx.x; idx < 16 * 128; idx += 256) {
            const int s = idx >> 7, d = idx & 127;
            const bf16* pr = (t0 < 0) ? pmeta + (size_t)s * INW : proj + ((size_t)b * SEQ + t0 + s) * INW;
            qs[s][d] = bf2f(pr[C_RQ + h * 128 + d]); ks[s][d] = bf2f(pr[C_RK + h * 128 + d]);
        }
        for (int idx = threadIdx.x; idx < 16 * 256; idx += 256) {
            const int s = idx >> 8, d = idx & 255;
            const bf16* pr = (t0 < 0) ? pmeta + (size_t)s * INW : proj + ((size_t)b * SEQ + t0 + s) * INW;
            vs[s][d] = bf2f(pr[C_RV + h * 256 + d]);
        }
        __syncthreads();
        for (int s = 0; s < 16; ++s) {
            const float v = vs[s][c]; float out = 0.f;
#pragma unroll
            for (int d = 0; d < 128; ++d) { st[d] = st[d] * gamma + ks[s][d] * v; out += qs[s][d] * st[d]; }
            if (t0 >= 0) raw[((size_t)b * SEQ + t0 + s) * 1024 + h * 256 + c] = out;
        }
    }
}
__global__ void __launch_bounds__(256) k_retnorm_naive(const float* __restrict__ raw, const bf16* __restrict__ proj, bf16* __restrict__ yret) {
    const int w = blockIdx.x * 4 + (threadIdx.x >> 6), lane = threadIdx.x & 63;
    const int row = w >> 2, h = w & 3;
    const float4 v = *(const float4*)(raw + (size_t)row * 1024 + h * 256 + lane * 4);
    float ss = v.x * v.x + v.y * v.y + v.z * v.z + v.w * v.w;
#pragma unroll
    for (int o = 1; o < 64; o <<= 1) ss += __shfl_xor(ss, o);
    const float r = rsqrtf(ss * (1.0f / 256.0f) + EPS);
    const bf16* g = proj + (size_t)row * INW + C_RG + h * 256 + lane * 4;
    bf16* o = yret + (size_t)row * D + h * 256 + lane * 4;
    o[0] = f2bf(v.x * r * bf2f(g[0])); o[1] = f2bf(v.y * r * bf2f(g[1])); o[2] = f2bf(v.z * r * bf2f(g[2])); o[3] = f2bf(v.w * r * bf2f(g[3]));
}

__global__ void __launch_bounds__(256) k_route_naive(const float* __restrict__ h2, const float* __restrict__ g2, const float* __restrict__ wr, const float* __restrict__ br,
                                                     bf16* __restrict__ xn2, int* __restrict__ tke, float* __restrict__ tkw, int* __restrict__ tkpos, unsigned* __restrict__ cnt) {
    const int row = blockIdx.x * 4 + (threadIdx.x >> 6), lane = threadIdx.x & 63;
    const float4* xr = (const float4*)(h2 + (size_t)row * D);
    float xv[16]; float ss = 0.f;
#pragma unroll
    for (int j = 0; j < 4; ++j) { const float4 v = xr[j * 64 + lane]; xv[4 * j] = v.x; xv[4 * j + 1] = v.y; xv[4 * j + 2] = v.z; xv[4 * j + 3] = v.w; ss += v.x * v.x + v.y * v.y + v.z * v.z + v.w * v.w; }
#pragma unroll
    for (int o = 1; o < 64; o <<= 1) ss += __shfl_xor(ss, o);
    const float rstd = rsqrtf(ss * (1.0f / D) + EPS);
    float lg[32];
#pragma unroll
    for (int e = 0; e < 32; ++e) lg[e] = 0.f;
#pragma unroll
    for (int j = 0; j < 4; ++j) {
        const float4 gg = ((const float4*)g2)[j * 64 + lane];
        const float gv[4] = {gg.x, gg.y, gg.z, gg.w};
        bf16* o = xn2 + (size_t)row * D + (j * 64 + lane) * 4;
#pragma unroll
        for (int q = 0; q < 4; ++q) {
            const float xn = xv[4 * j + q] * rstd * gv[q];
            o[q] = f2bf(xn);
            const float* wrow = wr + (size_t)((j * 64 + lane) * 4 + q) * NE;
#pragma unroll
            for (int e = 0; e < 32; ++e) lg[e] += xn * wrow[e];
        }
    }
#pragma unroll
    for (int e = 0; e < 32; ++e) {
#pragma unroll
        for (int o = 1; o < 64; o <<= 1) lg[e] += __shfl_xor(lg[e], o);
        lg[e] += br[e];
    }
    if (lane == 0) {
        int idx[4]; float val[4];
#pragma unroll
        for (int k = 0; k < 4; ++k) {
            float best = -3.0e38f; int bi = 0;
#pragma unroll
            for (int e = 0; e < 32; ++e) { const bool taken = (k > 0 && idx[0] == e) || (k > 1 && idx[1] == e) || (k > 2 && idx[2] == e); if (!taken && lg[e] > best) { best = lg[e]; bi = e; } }
            idx[k] = bi; val[k] = best;
        }
        const float mx = val[0]; float ex[4], sum = 0.f;
#pragma unroll
        for (int k = 0; k < 4; ++k) { ex[k] = __expf(val[k] - mx); sum += ex[k]; }
#pragma unroll
        for (int k = 0; k < 4; ++k) {
            tke[row * 4 + k] = idx[k]; tkw[row * 4 + k] = ex[k] / sum;
            tkpos[row * 4 + k] = (int)atomicAdd(&cnt[idx[k]], 1u);
        }
    }
}
__global__ void __launch_bounds__(256) k_place_naive(const unsigned* __restrict__ cnt, const int* __restrict__ tke, const float* __restrict__ tkw, const int* __restrict__ tkpos,
                                                     int* __restrict__ tkrow, int* __restrict__ rowtok, float* __restrict__ roww, int* __restrict__ tile_e) {
    __shared__ int pstart[NE + 1];
    if (threadIdx.x == 0) { int s = 0; for (int e = 0; e < NE; ++e) { pstart[e] = s; s += ((int)cnt[e] + 255) / 256 * 256; } pstart[NE] = s; }
    __syncthreads();
    const int gid = blockIdx.x * 256 + threadIdx.x, gsz = gridDim.x * 256;
    for (int p = gid; p < NTOK * TOPK; p += gsz) {
        const int e = tke[p], r = pstart[e] + tkpos[p];
        tkrow[p] = r; rowtok[r] = p >> 2; roww[r] = tkw[p];
    }
    for (int r = gid; r < NROWS; r += gsz) {
        int e = -1;
        for (int q = 0; q < NE; ++q) if (r >= pstart[q] && r < pstart[q + 1]) e = q;
        if (e < 0 || r >= pstart[e] + (int)cnt[e]) { rowtok[r] = 0; roww[r] = 0.f; }
        if ((r & 255) == 0) tile_e[r >> 8] = e;
    }
}
__global__ void __launch_bounds__(256) k_combine_naive(float* __restrict__ out, const bf16* __restrict__ rows, const int* __restrict__ tkrow) {
    const int row = blockIdx.x, c = threadIdx.x * 4;
    float4 v = *(float4*)(out + (size_t)row * D + c);
#pragma unroll
    for (int k = 0; k < 4; ++k) {
        const bf16* r = rows + (size_t)tkrow[row * 4 + k] * D + c;
        v.x += bf2f(r[0]); v.y += bf2f(r[1]); v.z += bf2f(r[2]); v.w += bf2f(r[3]);
    }
    *(float4*)(out + (size_t)row * D + c) = v;
}

extern "C" void kernel_launch(void* const* d_in, const int* in_sizes, int n_in, void* d_out, int out_size, void* d_ws, size_t ws_size, hipStream_t stream) {
    if (n_in != 17 || in_sizes[0] != NTOK * D || out_size != NTOK * D || ws_size < WS_END) {
        fprintf(stderr, "kernel_launch: unexpected shapes (n_in %d in0 %d out %d ws %zu)\n", n_in, n_in > 0 ? in_sizes[0] : -1, out_size, ws_size); return; }
    const float* x = (const float*)d_in[0]; const float* meta = (const float*)d_in[1]; const float* g1 = (const float*)d_in[2]; const float* w_in = (const float*)d_in[3];
    const float* qg = (const float*)d_in[4]; const float* kg = (const float*)d_in[5]; const float* sinks = (const float*)d_in[6];
    const float* w_ab = (const float*)d_in[7]; const float* w_rb = (const float*)d_in[8]; const float* w_out = (const float*)d_in[9];
    const float* g2 = (const float*)d_in[10]; const float* w_r = (const float*)d_in[11]; const float* b_r = (const float*)d_in[12];
    const float* w_gu = (const float*)d_in[13]; const float* b_gu = (const float*)d_in[14]; const float* w_dn = (const float*)d_in[15]; const float* b_dn = (const float*)d_in[16];
    unsigned char* ws = (unsigned char*)d_ws; float* out = (float*)d_out;
    unsigned* ctl = (unsigned*)(ws + WS_CTL);
    bf16* xb = (bf16*)(ws + WS_XB); bf16* proj = (bf16*)(ws + WS_PROJ); bf16* yatt = (bf16*)(ws + WS_YATT); bf16* yret = (bf16*)(ws + WS_YRET); bf16* merged = (bf16*)(ws + WS_MERGED);
    bf16* umeta = (bf16*)(ws + SM_UMETA); bf16* pmeta = (bf16*)(ws + SM_PMETA);
    int* tke = (int*)(ws + SM_TKE); float* tkw = (float*)(ws + SM_TKW); int* tkpos = (int*)(ws + SM_TKPOS); int* tkrow = (int*)(ws + SM_TKROW);
    int* rowtok = (int*)(ws + SM_ROWTOK); float* roww = (float*)(ws + SM_ROWW); int* tile_e = (int*)(ws + SM_TILEE);
    bf16* act = (bf16*)(ws + WS_ACT); bf16* rows = (bf16*)(ws + WS_ROWS);
    float* retraw = (float*)(ws + WS_MERGED);

    hipMemsetAsync(ws + WS_CTL, 0, 1 * MiB, stream);
    k_prep_naive<<<NTOK / 4, 256, 0, stream>>>(x, g1, xb, NTOK);
    k_prep_naive<<<NMETA / 4, 256, 0, stream>>>(meta, g1, umeta, NMETA);
    { NGemm p{}; p.A = xb; p.lda = D; p.B = w_in; p.ldb = INW; p.M = NTOK; p.N = INW; p.K = D; p.Cb = proj; p.ldc = INW;
      k_gemm_naive<EPI_RAW><<<dim3(INW / 64, NTOK / 64), 256, 0, stream>>>(p); }
    { NGemm p{}; p.A = umeta; p.lda = D; p.B = w_in; p.ldb = INW; p.M = NMETA; p.N = INW; p.K = D; p.Cb = pmeta; p.ldc = INW;
      k_gemm_naive<EPI_RAW><<<dim3(INW / 64, 1), 256, 0, stream>>>(p); }
    k_post_naive<<<NTOK, 256, 0, stream>>>(proj, qg, kg);
    k_post_naive<<<NMETA, 256, 0, stream>>>(pmeta, qg, kg);
    k_attn_naive<<<NTOK / 16, 256, 0, stream>>>(proj, pmeta, sinks, yatt);
    k_ret_naive<<<NB * 4, 256, 0, stream>>>(proj, pmeta, retraw);
    k_retnorm_naive<<<NTOK, 256, 0, stream>>>(retraw, proj, yret);
    { NGemm p{}; p.A = yatt; p.lda = D; p.B = w_ab; p.ldb = D; p.M = NTOK; p.N = D; p.K = D; p.Cb = merged; p.ldc = D; p.G = proj + C_GA; p.ldg = INW;
      k_gemm_naive<EPI_BR0><<<dim3(D / 64, NTOK / 64), 256, 0, stream>>>(p); }
    { NGemm p{}; p.A = yret; p.lda = D; p.B = w_rb; p.ldb = D; p.M = NTOK; p.N = D; p.K = D; p.Cb = merged; p.ldc = D; p.G = proj + C_GR; p.ldg = INW;
      k_gemm_naive<EPI_BR1><<<dim3(D / 64, NTOK / 64), 256, 0, stream>>>(p); }
    { NGemm p{}; p.A = merged; p.lda = D; p.B = w_out; p.ldb = D; p.M = NTOK; p.N = D; p.K = D; p.Cf = out; p.ldc = D; p.X = x;
      k_gemm_naive<EPI_OUT><<<dim3(D / 64, NTOK / 64), 256, 0, stream>>>(p); }
    k_route_naive<<<NTOK / 4, 256, 0, stream>>>(out, g2, w_r, b_r, xb, tke, tkw, tkpos, ctl + CW_CNT);
    k_place_naive<<<256, 256, 0, stream>>>(ctl + CW_CNT, tke, tkw, tkpos, tkrow, rowtok, roww, tile_e);
    { NGemm p{}; p.A = xb; p.lda = D; p.arow = rowtok; p.B = w_gu; p.ldb = 2 * DFF; p.bstride = (long)D * 2 * DFF; p.M = NROWS; p.N = DFF; p.K = D; p.tile_e = tile_e;
      p.Cb = act; p.ldc = DFF; p.bias = b_gu; p.bias_stride = 2 * DFF;
      k_gemm_naive<EPI_GU><<<dim3(DFF / 64, NROWS / 64), 256, 0, stream>>>(p); }
    { NGemm p{}; p.A = act; p.lda = DFF; p.B = w_dn; p.ldb = D; p.bstride = (long)DFF * D; p.M = NROWS; p.N = D; p.K = DFF; p.tile_e = tile_e;
      p.Cb = rows; p.ldc = D; p.bias = b_dn; p.bias_stride = D; p.roww = roww;
      k_gemm_naive<EPI_DOWN><<<dim3(D / 64, NROWS / 64), 256, 0, stream>>>(p); }
    k_combine_naive<<<NTOK, 256, 0, stream>>>(out, rows, tkrow);
}
```

```cpp
#include <hip/hip_runtime.h>
#include <cstdio>
#include <cstdint>

typedef unsigned short bf16;
__device__ __forceinline__ float bf2f(bf16 v) { return __uint_as_float(((unsigned)v) << 16); }
__device__ __forceinline__ bf16 f2bf(float f) { unsigned u = __float_as_uint(f); return (bf16)((u + 0x7fffu + ((u >> 16) & 1u)) >> 16); }
__device__ __forceinline__ float sigmoidf_(float x) { return 1.0f / (1.0f + __expf(-x)); }

constexpr int NB = 8, SEQ = 4096, D = 1024, NTOK = NB * SEQ;
constexpr int NMETA = 16;
constexpr int INW = 6400;
constexpr int C_AQ = 0, C_AK = 1024, C_AV = 1152, C_RQ = 1280, C_RK = 1792, C_RV = 2304, C_RG = 3328, C_GA = 4352, C_GR = 5376;
constexpr int NE = 32, TOPK = 4, DFF = 1024;
constexpr int NROWS = (NTOK * TOPK / 256 + NE) * 256;
constexpr int NTILE = NROWS / 256;
constexpr float EPS = 1e-5f;

constexpr size_t MiB = 1u << 20;
constexpr size_t WS_CTL = 0;
constexpr size_t WS_SMALL = 1 * MiB;
constexpr size_t WS_W = 16 * MiB;
constexpr size_t WS_XB = 232 * MiB;
constexpr size_t WS_PROJ = 296 * MiB;
constexpr size_t WS_YATT = 696 * MiB;
constexpr size_t WS_YRET = 760 * MiB;
constexpr size_t WS_MERGED = 824 * MiB;
constexpr size_t WS_END = 1020 * MiB;
constexpr size_t WS_ACT = 296 * MiB;
constexpr size_t WS_ROWS = 568 * MiB;
constexpr size_t SM_UMETA = WS_SMALL;
constexpr size_t SM_PMETA = WS_SMALL + 64 * 1024;
constexpr size_t SM_TKE = WS_SMALL + 512 * 1024;
constexpr size_t SM_TKW = SM_TKE + 512 * 1024;
constexpr size_t SM_TKPOS = SM_TKW + 512 * 1024;
constexpr size_t SM_TKROW = SM_TKPOS + 512 * 1024;
constexpr size_t SM_ROWTOK = SM_TKROW + 512 * 1024;
constexpr size_t SM_ROWW = SM_ROWTOK + 1024 * 1024;
constexpr size_t SM_TILEE = SM_ROWW + 1024 * 1024;
constexpr int CW_CNT = 1024;

__global__ void __launch_bounds__(256) k_prep_naive(const float* __restrict__ x, const float* __restrict__ g, bf16* __restrict__ u, int nrows) {
    const int row = blockIdx.x * 4 + (threadIdx.x >> 6), lane = threadIdx.x & 63;
    if (row >= nrows) return;
    const float4* xr = (const float4*)(x + (size_t)row * D);
    float4 v[4]; float ss = 0.f;
#pragma unroll
    for (int j = 0; j < 4; ++j) { v[j] = xr[j * 64 + lane]; ss += v[j].x * v[j].x + v[j].y * v[j].y + v[j].z * v[j].z + v[j].w * v[j].w; }
#pragma unroll
    for (int o = 1; o < 64; o <<= 1) ss += __shfl_xor(ss, o);
    const float rstd = rsqrtf(ss * (1.0f / D) + EPS);
#pragma unroll
    for (int j = 0; j < 4; ++j) {
        const float4 gg = ((const float4*)g)[j * 64 + lane];
        bf16* o = u + (size_t)row * D + (j * 64 + lane) * 4;
        o[0] = f2bf(v[j].x * rstd * gg.x); o[1] = f2bf(v[j].y * rstd * gg.y); o[2] = f2bf(v[j].z * rstd * gg.z); o[3] = f2bf(v[j].w * rstd * gg.w);
    }
}

enum { EPI_RAW = 0, EPI_BR0, EPI_BR1, EPI_OUT, EPI_GU, EPI_DOWN };
struct NGemm {
    const bf16* A; int lda; const int* arow;
    const float* B; int ldb; long bstride;
    int M, N, K;
    const int* tile_e;
    bf16* Cb; int ldc; float* Cf; const float* X;
    const bf16* G; int ldg;
    const float* bias; long bias_stride; const float* roww;
};
template <int EPI>
__global__ void __launch_bounds__(256) k_gemm_naive(NGemm p) {
    __shared__ float As[16][68];
    __shared__ float Bs[16][64];
    __shared__ float Bs2[(EPI == EPI_GU) ? 16 : 1][64];
    const int tid = threadIdx.x, tx = tid & 15, ty = tid >> 4;
    const int m0 = blockIdx.y * 64, n0 = blockIdx.x * 64;
    int e = 0;
    if (p.tile_e) { e = p.tile_e[m0 >> 8]; if (e < 0) return; }
    const float* B = p.B + (size_t)e * p.bstride;
    float acc[4][4], acc2[4][4];
#pragma unroll
    for (int i = 0; i < 4; ++i)
#pragma unroll
        for (int j = 0; j < 4; ++j) { acc[i][j] = 0.f; acc2[i][j] = 0.f; }
    const int ar = tid >> 2, ak = (tid & 3) * 4;
    int arow = m0 + ar; if (arow >= p.M) arow = p.M - 1;
    if (p.arow) arow = p.arow[arow];
    const bf16* Ap = p.A + (size_t)arow * p.lda + ak;
    const int bk = tid >> 4, bn = (tid & 15) * 4;
    for (int k0 = 0; k0 < p.K; k0 += 16) {
        const uint2 av = *(const uint2*)(Ap + k0);
        As[ak + 0][ar] = __uint_as_float(av.x << 16); As[ak + 1][ar] = __uint_as_float(av.x & 0xffff0000u);
        As[ak + 2][ar] = __uint_as_float(av.y << 16); As[ak + 3][ar] = __uint_as_float(av.y & 0xffff0000u);
        const float4 bv = *(const float4*)(B + (size_t)(k0 + bk) * p.ldb + n0 + bn);
        *(float4*)&Bs[bk][bn] = bv;
        if (EPI == EPI_GU) { const float4 bv2 = *(const float4*)(B + (size_t)(k0 + bk) * p.ldb + DFF + n0 + bn); *(float4*)&Bs2[bk][bn] = bv2; }
        __syncthreads();
#pragma unroll
        for (int k = 0; k < 16; ++k) {
            const float4 a = *(const float4*)&As[k][ty * 4];
            const float4 b = *(const float4*)&Bs[k][tx * 4];
            const float aa[4] = {a.x, a.y, a.z, a.w}, bb[4] = {b.x, b.y, b.z, b.w};
#pragma unroll
            for (int i = 0; i < 4; ++i)
#pragma unroll
                for (int j = 0; j < 4; ++j) acc[i][j] += aa[i] * bb[j];
            if (EPI == EPI_GU) {
                const float4 b2 = *(const float4*)&Bs2[k][tx * 4];
                const float cc[4] = {b2.x, b2.y, b2.z, b2.w};
#pragma unroll
                for (int i = 0; i < 4; ++i)
#pragma unroll
                    for (int j = 0; j < 4; ++j) acc2[i][j] += aa[i] * cc[j];
            }
        }
        __syncthreads();
    }
#pragma unroll
    for (int i = 0; i < 4; ++i) {
        const int r = m0 + ty * 4 + i; if (r >= p.M) continue;
#pragma unroll
        for (int j = 0; j < 4; ++j) {
            const int c = n0 + tx * 4 + j; const float a = acc[i][j];
            if (EPI == EPI_RAW) p.Cb[(size_t)r * p.ldc + c] = f2bf(a);
            else if (EPI == EPI_BR0) p.Cb[(size_t)r * p.ldc + c] = f2bf(bf2f(p.G[(size_t)r * p.ldg + c]) * a);
            else if (EPI == EPI_BR1) p.Cb[(size_t)r * p.ldc + c] = f2bf(bf2f(p.Cb[(size_t)r * p.ldc + c]) + bf2f(p.G[(size_t)r * p.ldg + c]) * a);
            else if (EPI == EPI_OUT) p.Cf[(size_t)r * p.ldc + c] = p.X[(size_t)r * p.ldc + c] + a;
            else if (EPI == EPI_GU) {
                float gate = a + p.bias[(size_t)e * p.bias_stride + c], up = acc2[i][j] + p.bias[(size_t)e * p.bias_stride + DFF + c];
                gate = fminf(gate, 7.0f); up = fminf(fmaxf(up, -7.0f), 7.0f);
                p.Cb[(size_t)r * p.ldc + c] = f2bf((up + 1.0f) * gate * sigmoidf_(1.702f * gate));
            } else if (EPI == EPI_DOWN) p.Cb[(size_t)r * p.ldc + c] = f2bf((a + p.bias[(size_t)e * p.bias_stride + c]) * p.roww[r]);
        }
    }
}

__global__ void __launch_bounds__(256) k_post_naive(bf16* __restrict__ proj, const float* __restrict__ qg, const float* __restrict__ kg) {
    bf16* row = proj + (size_t)blockIdx.x * INW; const int t = threadIdx.x;
    {
        float v[4], ss = 0.f;
#pragma unroll
        for (int j = 0; j < 4; ++j) { v[j] = bf2f(row[C_AQ + 4 * t + j]); ss += v[j] * v[j]; }
        ss += __shfl_xor(ss, 1); ss += __shfl_xor(ss, 2); ss += __shfl_xor(ss, 4); ss += __shfl_xor(ss, 8);
        const float r = rsqrtf(ss * (1.0f / 64.0f) + EPS);
#pragma unroll
        for (int j = 0; j < 4; ++j) row[C_AQ + 4 * t + j] = f2bf(v[j] * r * qg[(4 * t + j) & 63] * 0.125f);
    }
    {
        if (t < 64) {
            const int tt = t & 31; float v[4], ss = 0.f;
#pragma unroll
            for (int j = 0; j < 4; ++j) { v[j] = bf2f(row[C_AK + 4 * tt + j]); ss += v[j] * v[j]; }
            ss += __shfl_xor(ss, 1); ss += __shfl_xor(ss, 2); ss += __shfl_xor(ss, 4); ss += __shfl_xor(ss, 8);
            const float r = rsqrtf(ss * (1.0f / 64.0f) + EPS);
            if (t < 32) {
#pragma unroll
                for (int j = 0; j < 4; ++j) row[C_AK + 4 * tt + j] = f2bf(v[j] * r * kg[(4 * tt + j) & 63]);
            }
        }
    }
    for (int c = t; c < 512; c += 256) row[C_RK + c] = f2bf(bf2f(row[C_RK + c]) * 0.08838834764831845f);
    for (int c = t; c < 1024; c += 256) { const float v = bf2f(row[C_RG + c]); row[C_RG + c] = f2bf(v * sigmoidf_(v)); }
    for (int c = t; c < 2048; c += 256) { const float v = bf2f(row[C_GA + c]); row[C_GA + c] = f2bf(sigmoidf_(v)); }
}

__global__ void __launch_bounds__(256) k_attn_naive(const bf16* __restrict__ proj, const bf16* __restrict__ pmeta, const float* __restrict__ sinks, bf16* __restrict__ yatt) {
    const int tid = threadIdx.x, h = tid & 15, tl = tid >> 4;
    const int row = blockIdx.x * 16 + tl, b = row / SEQ, i = row % SEQ, kvh = h >> 3;
    const float slope = exp2f(-0.5f * (float)(h + 1));
    float q[64], o[64];
    { const bf16* qp = proj + (size_t)row * INW + C_AQ + h * 64;
#pragma unroll
      for (int d = 0; d < 64; ++d) { q[d] = bf2f(qp[d]); o[d] = 0.f; } }
    float m = -1e30f, l = 0.f;
    const int j0 = (i - 127 > 0) ? i - 127 : 0;
    const int nk = NMETA + (i - j0 + 1);
    for (int kk = 0; kk < nk; ++kk) {
        const bf16* kp; float dist;
        if (kk < NMETA) { kp = pmeta + (size_t)kk * INW; dist = (float)(i + 16 - kk); }
        else { const int j = j0 + kk - NMETA; kp = proj + ((size_t)b * SEQ + j) * INW; dist = (float)(i - j); }
        const bf16* kr = kp + C_AK + kvh * 64; const bf16* vr = kp + C_AV + kvh * 64;
        float s = 0.f;
#pragma unroll
        for (int d = 0; d < 64; ++d) s += q[d] * bf2f(kr[d]);
        s -= slope * dist;
        const float mn = fmaxf(m, s), corr = __expf(m - mn), pw = __expf(s - mn);
        l = l * corr + pw;
#pragma unroll
        for (int d = 0; d < 64; ++d) o[d] = o[d] * corr + pw * bf2f(vr[d]);
        m = mn;
    }
    { const float sk = sinks[h]; const float mn = fmaxf(m, sk), corr = __expf(m - mn); l = l * corr + __expf(sk - mn);
      const float inv = corr / l;
      bf16* op = yatt + (size_t)row * D + h * 64;
#pragma unroll
      for (int d = 0; d < 64; ++d) op[d] = f2bf(o[d] * inv); }
}

__global__ void __launch_bounds__(256) k_ret_naive(const bf16* __restrict__ proj, const bf16* __restrict__ pmeta, float* __restrict__ raw) {
    __shared__ float qs[16][128], ks[16][128], vs[16][256];
    const int b = blockIdx.x >> 2, h = blockIdx.x & 3, c = threadIdx.x;
    const float gamma = 1.0f - exp2f(-5.0f - (float)h);
    float st[128];
#pragma unroll
    for (int d = 0; d < 128; ++d) st[d] = 0.f;
    for (int t0 = -16; t0 < SEQ; t0 += 16) {
        __syncthreads();
        for (int idx = threadIdx.x; idx < 16 * 128; idx += 256) {
            const int s = idx >> 7, d = idx & 127;
            const bf16* pr = (t0 < 0) ? pmeta + (size_t)s * INW : proj + ((size_t)b * SEQ + t0 + s) * INW;
            qs[s][d] = bf2f(pr[C_RQ + h * 128 + d]); ks[s][d] = bf2f(pr[C_RK + h * 128 + d]);
        }
        for (int idx = threadIdx.x; idx < 16 * 256; idx += 256) {
            const int s = idx >> 8, d = idx & 255;
            const bf16* pr = (t0 < 0) ? pmeta + (size_t)s * INW : proj + ((size_t)b * SEQ + t0 + s) * INW;
            vs[s][d] = bf2f(pr[C_RV + h * 256 + d]);
        }
        __syncthreads();
        for (int s = 0; s < 16; ++s) {
            const float v = vs[s][c]; float out = 0.f;
#pragma unroll
            for (int d = 0; d < 128; ++d) { st[d] = st[d] * gamma + ks[s][d] * v; out += qs[s][d] * st[d]; }
            if (t0 >= 0) raw[((size_t)b * SEQ + t0 + s) * 1024 + h * 256 + c] = out;
        }
    }
}
__global__ void __launch_bounds__(256) k_retnorm_naive(const float* __restrict__ raw, const bf16* __restrict__ proj, bf16* __restrict__ yret) {
    const int w = blockIdx.x * 4 + (threadIdx.x >> 6), lane = threadIdx.x & 63;
    const int row = w >> 2, h = w & 3;
    const float4 v = *(const float4*)(raw + (size_t)row * 1024 + h * 256 + lane * 4);
    float ss = v.x * v.x + v.y * v.y + v.z * v.z + v.w * v.w;
#pragma unroll
    for (int o = 1; o < 64; o <<= 1) ss += __shfl_xor(ss, o);
    const float r = rsqrtf(ss * (1.0f / 256.0f) + EPS);
    const bf16* g = proj + (size_t)row * INW + C_RG + h * 256 + lane * 4;
    bf16* o = yret + (size_t)row * D + h * 256 + lane * 4;
    o[0] = f2bf(v.x * r * bf2f(g[0])); o[1] = f2bf(v.y * r * bf2f(g[1])); o[2] = f2bf(v.z * r * bf2f(g[2])); o[3] = f2bf(v.w * r * bf2f(g[3]));
}

__global__ void __launch_bounds__(256) k_route_naive(const float* __restrict__ h2, const float* __restrict__ g2, const float* __restrict__ wr, const float* __restrict__ br,
                                                     bf16* __restrict__ xn2, int* __restrict__ tke, float* __restrict__ tkw, int* __restrict__ tkpos, unsigned* __restrict__ cnt) {
    const int row = blockIdx.x * 4 + (threadIdx.x >> 6), lane = threadIdx.x & 63;
    const float4* xr = (const float4*)(h2 + (size_t)row * D);
    float xv[16]; float ss = 0.f;
#pragma unroll
    for (int j = 0; j < 4; ++j) { const float4 v = xr[j * 64 + lane]; xv[4 * j] = v.x; xv[4 * j + 1] = v.y; xv[4 * j + 2] = v.z; xv[4 * j + 3] = v.w; ss += v.x * v.x + v.y * v.y + v.z * v.z + v.w * v.w; }
#pragma unroll
    for (int o = 1; o < 64; o <<= 1) ss += __shfl_xor(ss, o);
    const float rstd = rsqrtf(ss * (1.0f / D) + EPS);
    float lg[32];
#pragma unroll
    for (int e = 0; e < 32; ++e) lg[e] = 0.f;
#pragma unroll
    for (int j = 0; j < 4; ++j) {
        const float4 gg = ((const float4*)g2)[j * 64 + lane];
        const float gv[4] = {gg.x, gg.y, gg.z, gg.w};
        bf16* o = xn2 + (size_t)row * D + (j * 64 + lane) * 4;
#pragma unroll
        for (int q = 0; q < 4; ++q) {
            const float xn = xv[4 * j + q] * rstd * gv[q];
            o[q] = f2bf(xn);
            const float* wrow = wr + (size_t)((j * 64 + lane) * 4 + q) * NE;
#pragma unroll
            for (int e = 0; e < 32; ++e) lg[e] += xn * wrow[e];
        }
    }
#pragma unroll
    for (int e = 0; e < 32; ++e) {
#pragma unroll
        for (int o = 1; o < 64; o <<= 1) lg[e] += __shfl_xor(lg[e], o);
        lg[e] += br[e];
    }
    if (lane == 0) {
        int idx[4]; float val[4];
#pragma unroll
        for (int k = 0; k < 4; ++k) {
            float best = -3.0e38f; int bi = 0;
#pragma unroll
            for (int e = 0; e < 32; ++e) { const bool taken = (k > 0 && idx[0] == e) || (k > 1 && idx[1] == e) || (k > 2 && idx[2] == e); if (!taken && lg[e] > best) { best = lg[e]; bi = e; } }
            idx[k] = bi; val[k] = best;
        }
        const float mx = val[0]; float ex[4], sum = 0.f;
#pragma unroll
        for (int k = 0; k < 4; ++k) { ex[k] = __expf(val[k] - mx); sum += ex[k]; }
#pragma unroll
        for (int k = 0; k < 4; ++k) {
            tke[row * 4 + k] = idx[k]; tkw[row * 4 + k] = ex[k] / sum;
            tkpos[row * 4 + k] = (int)atomicAdd(&cnt[idx[k]], 1u);
        }
    }
}
__global__ void __launch_bounds__(256) k_place_naive(const unsigned* __restrict__ cnt, const int* __restrict__ tke, const float* __restrict__ tkw, const int* __restrict__ tkpos,
                                                     int* __restrict__ tkrow, int* __restrict__ rowtok, float* __restrict__ roww, int* __restrict__ tile_e, int* __restrict__ atile, unsigned* __restrict__ nact) {
    __shared__ int pstart[NE + 1];
    if (threadIdx.x == 0) { int s = 0; for (int e = 0; e < NE; ++e) { pstart[e] = s; s += ((int)cnt[e] + 255) / 256 * 256; } pstart[NE] = s; }
    __syncthreads();
    const int gid = blockIdx.x * 256 + threadIdx.x, gsz = gridDim.x * 256;
    for (int p = gid; p < NTOK * TOPK; p += gsz) {
        const int e = tke[p], r = pstart[e] + tkpos[p];
        tkrow[p] = r; rowtok[r] = p >> 2; roww[r] = tkw[p];
    }
    for (int r = gid; r < NROWS; r += gsz) {
        int e = -1;
        for (int q = 0; q < NE; ++q) if (r >= pstart[q] && r < pstart[q + 1]) e = q;
        if (e < 0 || r >= pstart[e] + (int)cnt[e]) { rowtok[r] = 0; roww[r] = 0.f; }
        if ((r & 255) == 0) tile_e[r >> 8] = e;
    }
    if (blockIdx.x == 0 && threadIdx.x == 0) {
        int k = 0;
        for (int e = 0; e < NE; ++e) { const int nt = ((int)cnt[e] + 255) / 256; for (int t = 0; t < nt; ++t) { atile[2 * k] = pstart[e] / 256 + t; atile[2 * k + 1] = e; ++k; } }
        *nact = (unsigned)k;
    }
}
__global__ void __launch_bounds__(256) k_combine_naive(float* __restrict__ out, const bf16* __restrict__ rows, const int* __restrict__ tkrow) {
    const int row = blockIdx.x, c = threadIdx.x * 4;
    float4 v = *(float4*)(out + (size_t)row * D + c);
#pragma unroll
    for (int k = 0; k < 4; ++k) {
        const bf16* r = rows + (size_t)tkrow[row * 4 + k] * D + c;
        v.x += bf2f(r[0]); v.y += bf2f(r[1]); v.z += bf2f(r[2]); v.w += bf2f(r[3]);
    }
    *(float4*)(out + (size_t)row * D + c) = v;
}

#define LAS __attribute__((address_space(3)))
#define GAS __attribute__((address_space(1)))
typedef short bf16x8 __attribute__((ext_vector_type(8)));
typedef float f32x4 __attribute__((ext_vector_type(4)));
typedef float f32x2 __attribute__((ext_vector_type(2)));
typedef unsigned u32x4 __attribute__((ext_vector_type(4)));
typedef unsigned u32x2 __attribute__((ext_vector_type(2)));
#define LDS_WAIT() asm volatile("s_waitcnt lgkmcnt(0)" ::: "memory")
#define VM_WAIT() asm volatile("s_waitcnt vmcnt(0)" ::: "memory")
__device__ __forceinline__ unsigned pk2(float lo, float hi) { return (unsigned)f2bf(lo) | ((unsigned)f2bf(hi) << 16); }
__device__ __forceinline__ float wave_sum(float v) {
#pragma unroll
    for (int o = 1; o < 64; o <<= 1) v += __shfl_xor(v, o);
    return v;
}

constexpr size_t WS_WIN = WS_W;
constexpr size_t WS_WAB = WS_W + 13 * MiB;
constexpr size_t WS_WRB = WS_W + 15 * MiB;
constexpr size_t WS_WOUT = WS_W + 17 * MiB;
constexpr size_t WS_WGU = WS_W + 19 * MiB;
constexpr size_t WS_WDN = WS_W + 147 * MiB;
static_assert(WS_WDN + 64 * MiB <= WS_XB, "weight map");
constexpr size_t SM_ATILE = SM_TILEE + 4096;
constexpr int CW_NACT = 1088;
constexpr int CW_BAR = 4096;

constexpr int RING_BYTES = 131072;
constexpr int MISC_OFF = RING_BYTES;
constexpr int LDS_BYTES = 147456;
constexpr int NWAVES = 8;

#define XB_TMO      128
#define XB_XCNT(j)  (256  + 64 * (j))
#define XB_XSUB(j)  (1280 + 64 * (j))
#define XB_XGEN(j)  (2304 + 64 * (j))
#define XB_TOP      3328
#define XB_TOPGEN   3392
#define XCD_BAR_WORDS 3456
#define XB_SPIN_CAP (1u << 20)
__device__ __forceinline__ unsigned xb_ld(unsigned* p)              { return __hip_atomic_load(p, __ATOMIC_RELAXED, __HIP_MEMORY_SCOPE_AGENT); }
__device__ __forceinline__ unsigned xb_add(unsigned* p, unsigned v) { return __hip_atomic_fetch_add(p, v, __ATOMIC_RELAXED, __HIP_MEMORY_SCOPE_AGENT); }
__device__ __forceinline__ unsigned xb_xcc_id() { return (unsigned)__builtin_amdgcn_s_getreg((3 << 11) | 20) & 0xFu; }
#define XB_SPIN(cond, bar) do { unsigned _sp = 0; while (cond) { __builtin_amdgcn_s_sleep(1); \
    if ((++_sp & 255u) == 0u) { if (xb_ld(&(bar)[XB_TMO])) break; if (_sp > XB_SPIN_CAP) { atomicAdd(&(bar)[XB_TMO], 1u); break; } } } } while (0)
struct XcdBarrier { unsigned* bar; unsigned x; volatile LAS unsigned* st; };
__device__ __forceinline__ XcdBarrier xcd_barrier_post(unsigned* bar, volatile LAS unsigned* st) {
    XcdBarrier b; b.bar = bar; b.x = xb_xcc_id(); b.st = st;
    if (threadIdx.x == 0) (void)xb_add(&bar[XB_XCNT(b.x)], 1u);
    return b;
}
__device__ __forceinline__ void xcd_barrier_complete(unsigned* bar, unsigned x, unsigned& nloc, unsigned& nx) {
    const unsigned G = gridDim.x * gridDim.y * gridDim.z;
    unsigned sum, cnt, mine, sp = 0u;
    for (;;) {
        sum = 0u; cnt = 0u; mine = 0u;
#pragma unroll
        for (unsigned j = 0; j < 16; ++j) { const unsigned c = xb_ld(&bar[XB_XCNT(j)]); sum += c; cnt += (c > 0u) ? 1u : 0u; mine = (j == x) ? c : mine; }
        if (sum == G) break;
        __builtin_amdgcn_s_sleep(1);
        if ((++sp & 255u) == 0u) { if (xb_ld(&bar[XB_TMO])) break; if (sp > XB_SPIN_CAP) { atomicAdd(&bar[XB_TMO], 1u); break; } }
    }
    nloc = mine > 0u ? mine : 1u; nx = cnt > 0u ? cnt : 1u;
}
__device__ __forceinline__ void xcd_barrier(const XcdBarrier& b) {
    asm volatile("s_waitcnt vmcnt(0)" ::: "memory");
    __syncthreads();
    if (threadIdx.x == 0) {
        unsigned* bar = b.bar;
        __builtin_amdgcn_s_waitcnt(0);
        unsigned nloc = b.st[0], nx = b.st[1];
        if (nloc == 0u) { xcd_barrier_complete(bar, b.x, nloc, nx); b.st[0] = nloc; b.st[1] = nx; }
        const unsigned old = xb_add(&bar[XB_XSUB(b.x)], 1u);
        const unsigned gen = old / nloc;
        if (old + 1u == (gen + 1u) * nloc) {
            __builtin_amdgcn_fence(__ATOMIC_RELEASE, "agent");
            asm volatile("s_waitcnt vmcnt(0)" ::: "memory");
            const unsigned og = xb_add(&bar[XB_TOP], 1u);
            const unsigned tg = og / nx;
            if (og + 1u == (tg + 1u) * nx) xb_add(&bar[XB_TOPGEN], 1u);
            else XB_SPIN(xb_ld(&bar[XB_TOPGEN]) == tg, bar);
            __builtin_amdgcn_fence(__ATOMIC_ACQUIRE, "agent");
            xb_add(&bar[XB_XGEN(b.x)], 1u);
            asm volatile("s_waitcnt vmcnt(0)" ::: "memory");
        } else {
            XB_SPIN(xb_ld(&bar[XB_XGEN(b.x)]) == gen, bar);
            __builtin_amdgcn_fence(__ATOMIC_ACQUIRE, "agent");
            asm volatile("s_waitcnt vmcnt(0)" ::: "memory");
        }
    }
    __syncthreads();
}

namespace pg8 {
constexpr int BM = 256, BK = 64, HALF = 128, HTB = HALF * BK * 2, STAGE_BYTES = 8 * HTB;
__host__ __device__ __forceinline__ int lds_byte(int r, int c) { const int st = (r >> 4) * 2 + (c >> 5), rr = r & 15, cc = c & 31, ob = rr * 64 + cc * 2; return st * 1024 + (ob ^ (((ob >> 9) & 1) << 5)); }
__host__ __device__ __forceinline__ void stage_rc(int b, int& R, int& C) { const int st = b / 1024, sb = b % 1024, swz = sb ^ (((sb >> 9) & 1) << 5); R = (st >> 1) * 16 + swz / 64; C = (st & 1) * 32 + (swz % 64) / 2; }
__host__ __device__ __forceinline__ int perm32(int rho) { const int n = rho >> 4, i = rho & 15; return 8 * (i >> 2) + 4 * n + (i & 3); }
struct Unit { int pm, pn, aux; const char* A; const char* B; };
typedef f32x4 Acc[2][2][4][2];

template <class Epi, class Sched>
__device__ __forceinline__ void gemm_phase(LAS unsigned char* lds, const int K, const Sched& S, const Epi& E) {
    const int tid = threadIdx.x, wid = __builtin_amdgcn_readfirstlane(tid >> 6), lane = tid & 63, wr = wid >> 2, wc = wid & 3, fr = lane & 15, fq = lane >> 4;
    const int nt = K / BK;
    int RA[2], CA[2]; unsigned voffB[2];
#pragma unroll
    for (int i = 0; i < 2; ++i) { int R, C; stage_rc(tid * 16 + i * 8192, R, C); const int Rb = Epi::PERM ? ((R & ~31) + perm32(R & 31)) : R;
        RA[i] = R; CA[i] = C; voffB[i] = (unsigned)(Rb * K + C) * 2u; }
    const size_t kstep = (size_t)(BK * 2);
    const size_t hstep = (size_t)HALF * K * 2;
    const unsigned ldsw = (unsigned)wid * 1024u;
    const int aoff = lds_byte(wr * 64 + fr, fq * 8), boff = lds_byte(wc * 32 + fr, fq * 8);
#define PG8_SA(b, h) (((b) * 2 + (h)) * HTB)
#define PG8_SB(b, h) ((4 + (b) * 2 + (h)) * HTB)
#define PG8_STAGE(bufoff, gbase, voff) do { _Pragma("unroll") for (int _i = 0; _i < 2; ++_i) \
        __builtin_amdgcn_global_load_lds((const unsigned*)((const char*)(gbase) + (voff)[_i]), (LAS unsigned*)(lds + (bufoff) + ldsw + _i * 8192), 16, 0, 0); } while (0)
#define PG8_LDA(dst, b, h) do { _Pragma("unroll") for (int m = 0; m < 4; ++m) _Pragma("unroll") for (int k = 0; k < 2; ++k) dst[m][k] = *(const LAS bf16x8*)(lds + PG8_SA(b, h) + aoff + m * 2048 + k * 1024); } while (0)
#define PG8_LDB(dst, b, h) do { _Pragma("unroll") for (int n = 0; n < 2; ++n) _Pragma("unroll") for (int k = 0; k < 2; ++k) dst[n][k] = *(const LAS bf16x8*)(lds + PG8_SB(b, h) + boff + n * 2048 + k * 1024); } while (0)
#define PG8_MMA(ai, bj, At, Bt) do { __builtin_amdgcn_s_setprio(1); _Pragma("unroll") for (int m = 0; m < 4; ++m) _Pragma("unroll") for (int n = 0; n < 2; ++n) _Pragma("unroll") for (int k = 0; k < 2; ++k) \
        acc[ai][bj][m][n] = __builtin_amdgcn_mfma_f32_16x16x32_bf16(Bt[n][k], At[m][k], acc[ai][bj][m][n], 0, 0, 0); __builtin_amdgcn_s_setprio(0); } while (0)
#define PG8_WAIT_V(n) asm volatile("s_waitcnt vmcnt(" #n ")" ::: "memory")
#define PG8_WAIT_L(n) asm volatile("s_waitcnt lgkmcnt(" #n ")" ::: "memory")
#define PG8_BAR __builtin_amdgcn_s_barrier()
#define PG8_SCHED __builtin_amdgcn_sched_barrier(0)
    Unit cur, nxt; int ui = 0;
    if (!S.next(0, cur)) return;
    unsigned ca[2][2], na[2][2];
    S.aoff(cur, RA, CA, ca);
    f32x4 acc[2][2][4][2];
#pragma unroll
    for (int a = 0; a < 2; ++a)
#pragma unroll
        for (int b = 0; b < 2; ++b)
#pragma unroll
            for (int m = 0; m < 4; ++m)
#pragma unroll
                for (int n = 0; n < 2; ++n) acc[a][b][m][n] = (f32x4){0.f, 0.f, 0.f, 0.f};
    bf16x8 At[4][2], B0[2][2], B1[2][2];
    const char* cA = cur.A; const char* cB = cur.B;
    PG8_STAGE(PG8_SB(0, 0), cB, voffB); PG8_STAGE(PG8_SB(0, 1), cB + hstep, voffB); PG8_STAGE(PG8_SA(0, 0), cA, ca[0]); PG8_STAGE(PG8_SA(0, 1), cA, ca[1]);
    if (wr == 1) PG8_BAR;
    PG8_WAIT_V(2); PG8_BAR;
    PG8_STAGE(PG8_SB(1, 0), cB + kstep, voffB); PG8_STAGE(PG8_SA(1, 0), cA + kstep, ca[0]); PG8_STAGE(PG8_SB(1, 1), cB + hstep + kstep, voffB);
    PG8_WAIT_V(6); PG8_BAR;
    for (;;) {
        const bool has_next = S.next(ui + 1, nxt);
        if (has_next) S.aoff(nxt, RA, CA, na);
        else {
#pragma unroll
            for (int h = 0; h < 2; ++h)
#pragma unroll
                for (int i = 0; i < 2; ++i) na[h][i] = ca[h][i];
        }
        const char* nA = has_next ? nxt.A : cA; const char* nB = has_next ? nxt.B : cB;
        for (int t = 0; t < nt; t += 2) {
            const bool last = (t == nt - 2);
            const char* a1 = cA + (size_t)(t + 1) * kstep;
            const char* a2 = last ? nA : cA + (size_t)(t + 2) * kstep; const char* b2 = last ? nB : cB + (size_t)(t + 2) * kstep;
            const char* a3 = a2 + kstep; const char* b3 = b2 + kstep;
            unsigned o2[2][2];
#pragma unroll
            for (int h = 0; h < 2; ++h)
#pragma unroll
                for (int i = 0; i < 2; ++i) o2[h][i] = last ? na[h][i] : ca[h][i];
            PG8_LDB(B0, 0, 0); PG8_LDB(B1, 0, 1); PG8_SCHED; PG8_LDA(At, 0, 0); PG8_STAGE(PG8_SA(1, 1), a1, ca[1]);
            PG8_WAIT_V(8); PG8_WAIT_L(0); PG8_BAR; PG8_MMA(0, 0, At, B0); PG8_MMA(0, 1, At, B1); PG8_BAR; PG8_SCHED;
            PG8_LDA(At, 0, 1); PG8_STAGE(PG8_SB(0, 0), b2, voffB); PG8_STAGE(PG8_SB(0, 1), b2 + hstep, voffB); PG8_STAGE(PG8_SA(0, 0), a2, o2[0]);
            PG8_WAIT_V(8); PG8_WAIT_L(0); PG8_BAR; PG8_MMA(1, 0, At, B0); PG8_MMA(1, 1, At, B1); PG8_BAR; PG8_SCHED;
            PG8_LDB(B0, 1, 0); PG8_LDB(B1, 1, 1); PG8_SCHED; PG8_LDA(At, 1, 0); PG8_STAGE(PG8_SA(0, 1), a2, o2[1]);
            PG8_WAIT_V(8); PG8_WAIT_L(0); PG8_BAR; PG8_MMA(0, 0, At, B0); PG8_MMA(0, 1, At, B1); PG8_BAR; PG8_SCHED;
            PG8_LDA(At, 1, 1); PG8_STAGE(PG8_SB(1, 0), b3, voffB); PG8_STAGE(PG8_SB(1, 1), b3 + hstep, voffB); PG8_STAGE(PG8_SA(1, 0), a3, o2[0]);
            PG8_WAIT_V(8); PG8_WAIT_L(0); PG8_BAR; PG8_MMA(1, 0, At, B0); PG8_MMA(1, 1, At, B1); PG8_BAR; PG8_SCHED;
        }
        if (wr == 0) PG8_BAR;
        E(acc, cur, wr, wc, fr, fq);
        if (!has_next) break;
#pragma unroll
        for (int a = 0; a < 2; ++a)
#pragma unroll
            for (int b = 0; b < 2; ++b)
#pragma unroll
                for (int m = 0; m < 4; ++m)
#pragma unroll
                    for (int n = 0; n < 2; ++n) acc[a][b][m][n] = (f32x4){0.f, 0.f, 0.f, 0.f};
        cur = nxt; cA = nA; cB = nB; ++ui;
#pragma unroll
        for (int h = 0; h < 2; ++h)
#pragma unroll
            for (int i = 0; i < 2; ++i) ca[h][i] = na[h][i];
        if (wr == 1) PG8_BAR;
    }
    PG8_WAIT_V(0);
    PG8_BAR;
#undef PG8_SA
#undef PG8_SB
#undef PG8_STAGE
#undef PG8_LDA
#undef PG8_LDB
#undef PG8_MMA
#undef PG8_WAIT_V
#undef PG8_WAIT_L
#undef PG8_BAR
#undef PG8_SCHED
}
}
struct SchedDense {
    const char* A; const char* Bt; int K, nM, nN, nwg, G, c;
    __device__ void init(const bf16* A_, const bf16* Bt_, int M, int N, int K_, int G_, int c_) { A = (const char*)A_; Bt = (const char*)Bt_; K = K_; nM = M / 256; nN = N / 256; nwg = nM * nN; G = G_; c = c_; }
    __device__ __forceinline__ bool next(int i, pg8::Unit& u) const {
        const long L = (long)i * G + c; if (L >= nwg) return false;
        int wgid = (int)L; { const int q = nwg / 8, r = nwg % 8, xcd = wgid % 8, off = wgid / 8; wgid = (xcd < r ? xcd * (q + 1) : r * (q + 1) + (xcd - r) * q) + off; }
        const int nig = 8 * nN, gid = wgid / nig, fm = gid * 8, gsz = (nM - fm) < 8 ? (nM - fm) : 8;
        u.pm = fm + ((wgid % nig) % gsz); u.pn = (wgid % nig) / gsz; u.aux = 0;
        u.A = A + (size_t)u.pm * 256 * K * 2; u.B = Bt + (size_t)u.pn * 256 * K * 2; return true;
    }
    __device__ __forceinline__ void aoff(const pg8::Unit&, const int (&R)[2], const int (&C)[2], unsigned (&o)[2][2]) const {
#pragma unroll
        for (int h = 0; h < 2; ++h)
#pragma unroll
            for (int i = 0; i < 2; ++i) o[h][i] = (unsigned)((128 * h + R[i]) * K + C[i]) * 2u;
    }
};
struct SchedBranch {
    const char* A0; const char* A1; const char* B0; const char* B1; int G, c;
    __device__ __forceinline__ bool next(int i, pg8::Unit& u) const {
        const int L = (i >> 1) * G + c; if (L >= 512) return false;
        int wgid = L; { const int off = wgid / 8, xcd = wgid % 8; wgid = xcd * 64 + off; }
        const int nig = 8 * 4, gid = wgid / nig;
        u.pm = gid * 8 + ((wgid % nig) % 8); u.pn = (wgid % nig) / 8; u.aux = i & 1;
        u.A = ((i & 1) ? A1 : A0) + (size_t)u.pm * 256 * D * 2; u.B = ((i & 1) ? B1 : B0) + (size_t)u.pn * 256 * D * 2; return true;
    }
    __device__ __forceinline__ void aoff(const pg8::Unit&, const int (&R)[2], const int (&C)[2], unsigned (&o)[2][2]) const {
#pragma unroll
        for (int h = 0; h < 2; ++h)
#pragma unroll
            for (int i = 0; i < 2; ++i) o[h][i] = (unsigned)((128 * h + R[i]) * D + C[i]) * 2u;
    }
};
template <bool GATHER, int NPN>
struct SchedMoe {
    const char* A; const char* Bt; const int* atile; const int* rowtok; int nact, G, c;
    __device__ __forceinline__ bool next(int i, pg8::Unit& u) const {
        const int L = i * G + c; if (L >= nact * NPN) return false;
        const int k = L / NPN; u.pn = L % NPN; u.pm = atile[2 * k]; u.aux = atile[2 * k + 1];
        u.A = GATHER ? A : A + (size_t)u.pm * 256 * 1024 * 2;
        u.B = Bt + ((size_t)u.aux * NPN + u.pn) * 256 * 1024 * 2; return true;
    }
    __device__ __forceinline__ void aoff(const pg8::Unit& u, const int (&R)[2], const int (&C)[2], unsigned (&o)[2][2]) const {
#pragma unroll
        for (int h = 0; h < 2; ++h)
#pragma unroll
            for (int i = 0; i < 2; ++i) {
                if (GATHER) o[h][i] = (unsigned)rowtok[u.pm * 256 + 128 * h + R[i]] * 2048u + (unsigned)C[i] * 2u;
                else o[h][i] = (unsigned)((128 * h + R[i]) * 1024 + C[i]) * 2u;
            }
    }
};

__device__ __forceinline__ u32x4 pack8(const f32x4& a, const f32x4& b) { u32x4 w; w.x = pk2(a[0], a[1]); w.y = pk2(a[2], a[3]); w.z = pk2(b[0], b[1]); w.w = pk2(b[2], b[3]); return w; }
__device__ __forceinline__ void unpack8(const u32x4& w, float (&f)[8]) {
    f[0] = __uint_as_float(w.x << 16); f[1] = __uint_as_float(w.x & 0xffff0000u); f[2] = __uint_as_float(w.y << 16); f[3] = __uint_as_float(w.y & 0xffff0000u);
    f[4] = __uint_as_float(w.z << 16); f[5] = __uint_as_float(w.z & 0xffff0000u); f[6] = __uint_as_float(w.w << 16); f[7] = __uint_as_float(w.w & 0xffff0000u);
}
struct EpiProj {
    static constexpr bool PERM = true;
    bf16* proj; const float* qg; const float* kg;
    __device__ __forceinline__ void operator()(pg8::Acc& acc, const pg8::Unit& u, int wr, int wc, int fr, int fq) const {
        const int pn = u.pn;
        int mode;
        if (pn < 4) mode = 1; else if (pn == 4) mode = (wc < 2) ? 2 : 0; else if (pn < 7) mode = 0; else if (pn < 9) mode = 3; else if (pn < 13) mode = 0; else if (pn < 17) mode = 4; else mode = 5;
        float gn[2][8];
        if (mode == 1 || mode == 2) { const float* g = (mode == 1) ? qg : kg; const float s = (mode == 1) ? 0.125f : 1.0f;
#pragma unroll
            for (int bj = 0; bj < 2; ++bj)
#pragma unroll
                for (int j = 0; j < 8; ++j) gn[bj][j] = g[32 * bj + 8 * fq + j] * s; }
#pragma unroll
        for (int ai = 0; ai < 2; ++ai)
#pragma unroll
            for (int m = 0; m < 4; ++m) {
                const int r = u.pm * 256 + ai * 128 + wr * 64 + m * 16 + fr;
                bf16* rowp = proj + (size_t)r * INW + pn * 256 + wc * 64 + 8 * fq;
                f32x4 v[2][2];
#pragma unroll
                for (int bj = 0; bj < 2; ++bj) { v[bj][0] = acc[ai][bj][m][0]; v[bj][1] = acc[ai][bj][m][1]; }
                if (mode == 1 || mode == 2) {
                    float ss = 0.f;
#pragma unroll
                    for (int bj = 0; bj < 2; ++bj)
#pragma unroll
                        for (int n = 0; n < 2; ++n) ss += v[bj][n][0] * v[bj][n][0] + v[bj][n][1] * v[bj][n][1] + v[bj][n][2] * v[bj][n][2] + v[bj][n][3] * v[bj][n][3];
                    ss += __shfl_xor(ss, 16); ss += __shfl_xor(ss, 32);
                    const float rs = rsqrtf(ss * (1.0f / 64.0f) + EPS);
#pragma unroll
                    for (int bj = 0; bj < 2; ++bj)
#pragma unroll
                        for (int n = 0; n < 2; ++n)
#pragma unroll
                            for (int i = 0; i < 4; ++i) v[bj][n][i] = v[bj][n][i] * rs * gn[bj][4 * n + i];
                } else if (mode == 3) {
#pragma unroll
                    for (int bj = 0; bj < 2; ++bj)
#pragma unroll
                        for (int n = 0; n < 2; ++n) v[bj][n] = v[bj][n] * 0.08838834764831845f;
                } else if (mode == 4) {
#pragma unroll
                    for (int bj = 0; bj < 2; ++bj)
#pragma unroll
                        for (int n = 0; n < 2; ++n)
#pragma unroll
                            for (int i = 0; i < 4; ++i) { const float x = v[bj][n][i]; v[bj][n][i] = x * sigmoidf_(x); }
                } else if (mode == 5) {
#pragma unroll
                    for (int bj = 0; bj < 2; ++bj)
#pragma unroll
                        for (int n = 0; n < 2; ++n)
#pragma unroll
                            for (int i = 0; i < 4; ++i) v[bj][n][i] = sigmoidf_(v[bj][n][i]);
                }
#pragma unroll
                for (int bj = 0; bj < 2; ++bj) *(u32x4*)(rowp + 32 * bj) = pack8(v[bj][0], v[bj][1]);
            }
    }
};
struct EpiBranch {
    static constexpr bool PERM = true;
    bf16* merged; const bf16* proj;
    __device__ __forceinline__ void operator()(pg8::Acc& acc, const pg8::Unit& u, int wr, int wc, int fr, int fq) const {
        const int gcol = u.aux ? C_GR : C_GA;
#pragma unroll
        for (int ai = 0; ai < 2; ++ai)
#pragma unroll
            for (int m = 0; m < 4; ++m) {
                const int r = u.pm * 256 + ai * 128 + wr * 64 + m * 16 + fr;
#pragma unroll
                for (int bj = 0; bj < 2; ++bj) {
                    const int col = u.pn * 256 + bj * 128 + wc * 32 + 8 * fq;
                    const u32x4 gw = *(const u32x4*)(proj + (size_t)r * INW + gcol + col);
                    float g[8]; unpack8(gw, g);
                    f32x4 a = acc[ai][bj][m][0], b = acc[ai][bj][m][1];
                    a[0] *= g[0]; a[1] *= g[1]; a[2] *= g[2]; a[3] *= g[3]; b[0] *= g[4]; b[1] *= g[5]; b[2] *= g[6]; b[3] *= g[7];
                    bf16* mp = merged + (size_t)r * D + col;
                    if (u.aux) { const u32x4 pw = *(const u32x4*)mp; float p[8]; unpack8(pw, p);
                        a[0] += p[0]; a[1] += p[1]; a[2] += p[2]; a[3] += p[3]; b[0] += p[4]; b[1] += p[5]; b[2] += p[6]; b[3] += p[7]; }
                    *(u32x4*)mp = pack8(a, b);
                }
            }
    }
};
struct EpiOut {
    static constexpr bool PERM = false;
    const float* x; float* out;
    __device__ __forceinline__ void operator()(pg8::Acc& acc, const pg8::Unit& u, int wr, int wc, int fr, int fq) const {
#pragma unroll
        for (int ai = 0; ai < 2; ++ai)
#pragma unroll
            for (int m = 0; m < 4; ++m) {
                const size_t off = (size_t)(u.pm * 256 + ai * 128 + wr * 64 + m * 16 + fr) * D + u.pn * 256 + wc * 32 + 4 * fq;
#pragma unroll
                for (int bj = 0; bj < 2; ++bj)
#pragma unroll
                    for (int n = 0; n < 2; ++n) { const f32x4 xv = *(const f32x4*)(x + off + bj * 128 + n * 16); *(f32x4*)(out + off + bj * 128 + n * 16) = xv + acc[ai][bj][m][n]; }
            }
    }
};
struct EpiGU {
    static constexpr bool PERM = true;
    bf16* act; const float* bgu;
    __device__ __forceinline__ void operator()(pg8::Acc& acc, const pg8::Unit& u, int wr, int wc, int fr, int fq) const {
        const int col = u.pn * 128 + wc * 32 + 8 * fq;
        const float* bg = bgu + (size_t)u.aux * 2048 + col;
        float bgate[8], bup[8];
#pragma unroll
        for (int j = 0; j < 8; ++j) { bgate[j] = bg[j]; bup[j] = bg[1024 + j]; }
#pragma unroll
        for (int ai = 0; ai < 2; ++ai)
#pragma unroll
            for (int m = 0; m < 4; ++m) {
                const int r = u.pm * 256 + ai * 128 + wr * 64 + m * 16 + fr;
                f32x4 o[2];
#pragma unroll
                for (int n = 0; n < 2; ++n)
#pragma unroll
                    for (int i = 0; i < 4; ++i) {
                        float gate = acc[ai][0][m][n][i] + bgate[4 * n + i], up = acc[ai][1][m][n][i] + bup[4 * n + i];
                        gate = fminf(gate, 7.0f); up = fminf(fmaxf(up, -7.0f), 7.0f);
                        o[n][i] = (up + 1.0f) * gate * sigmoidf_(1.702f * gate);
                    }
                *(u32x4*)(act + (size_t)r * DFF + col) = pack8(o[0], o[1]);
            }
    }
};
struct EpiDown {
    static constexpr bool PERM = true;
    bf16* rows; const float* bdn; const float* roww;
    __device__ __forceinline__ void operator()(pg8::Acc& acc, const pg8::Unit& u, int wr, int wc, int fr, int fq) const {
        float bb[2][8];
#pragma unroll
        for (int bj = 0; bj < 2; ++bj)
#pragma unroll
            for (int j = 0; j < 8; ++j) bb[bj][j] = bdn[(size_t)u.aux * D + u.pn * 256 + bj * 128 + wc * 32 + 8 * fq + j];
#pragma unroll
        for (int ai = 0; ai < 2; ++ai)
#pragma unroll
            for (int m = 0; m < 4; ++m) {
                const int r = u.pm * 256 + ai * 128 + wr * 64 + m * 16 + fr;
                const float w = roww[r];
#pragma unroll
                for (int bj = 0; bj < 2; ++bj) {
                    f32x4 a = acc[ai][bj][m][0], b = acc[ai][bj][m][1];
#pragma unroll
                    for (int i = 0; i < 4; ++i) { a[i] = (a[i] + bb[bj][i]) * w; b[i] = (b[i] + bb[bj][4 + i]) * w; }
                    *(u32x4*)(rows + (size_t)r * D + u.pn * 256 + bj * 128 + wc * 32 + 8 * fq) = pack8(a, b);
                }
            }
    }
};
__device__ __forceinline__ void p0_transpose_item(const float* W, int K, int N, bf16* WT, int k0, int n0, int dst_row0, LAS float* scr, int lane) {
#pragma unroll 8
    for (int i = 0; i < 32; ++i) { const int kk = 2 * i + (lane >> 5); scr[kk * 33 + (lane & 31)] = W[(size_t)(k0 + kk) * N + n0 + (lane & 31)]; }
    LDS_WAIT(); asm volatile("" ::: "memory");
    const int c = lane & 7;
#pragma unroll
    for (int j = 0; j < 4; ++j) { const int n = (lane >> 3) + 8 * j; const LAS float* s = scr + (8 * c) * 33 + n;
        u32x4 o; o.x = pk2(s[0 * 33], s[1 * 33]); o.y = pk2(s[2 * 33], s[3 * 33]); o.z = pk2(s[4 * 33], s[5 * 33]); o.w = pk2(s[6 * 33], s[7 * 33]);
        *(u32x4*)(WT + (size_t)(dst_row0 + n) * K + k0 + 8 * c) = o; }
    LDS_WAIT(); asm volatile("" ::: "memory");
}

struct Args { const float* in[17]; float* out; unsigned char* ws; int ph_lo, ph_hi, li, pad; };

__global__ void __launch_bounds__(512, 2) mk_fwd(Args args) {
    extern __shared__ __attribute__((aligned(16))) unsigned char lds_raw[];
    LAS unsigned char* lds = (LAS unsigned char*)lds_raw;
    volatile LAS unsigned* MISC = (volatile LAS unsigned*)(lds + MISC_OFF);
    const int tid = threadIdx.x, lane = tid & 63, wave = __builtin_amdgcn_readfirstlane(tid >> 6);
    const int G = gridDim.x, bx = blockIdx.x;
    const int vcu = (G % 8 == 0) ? (bx % 8) * (G / 8) + bx / 8 : bx;
    unsigned char* ws = args.ws;
    unsigned* ctl = (unsigned*)(ws + WS_CTL);
    const float* x = args.in[0]; const float* meta = args.in[1]; const float* g1 = args.in[2]; const float* w_in = args.in[3];
    const float* qg = args.in[4]; const float* kg = args.in[5];
    const float* w_ab = args.in[7]; const float* w_rb = args.in[8]; const float* w_out = args.in[9];
    const float* w_gu = args.in[13]; const float* b_gu = args.in[14]; const float* w_dn = args.in[15]; const float* b_dn = args.in[16];
    float* out = args.out;
    bf16* Win_t = (bf16*)(ws + WS_WIN); bf16* Wab_t = (bf16*)(ws + WS_WAB); bf16* Wrb_t = (bf16*)(ws + WS_WRB); bf16* Wout_t = (bf16*)(ws + WS_WOUT);
    bf16* Wgu_t = (bf16*)(ws + WS_WGU); bf16* Wdn_t = (bf16*)(ws + WS_WDN);
    bf16* xb = (bf16*)(ws + WS_XB); bf16* proj = (bf16*)(ws + WS_PROJ); bf16* yatt = (bf16*)(ws + WS_YATT); bf16* yret = (bf16*)(ws + WS_YRET); bf16* merged = (bf16*)(ws + WS_MERGED);
    bf16* pmeta = (bf16*)(ws + SM_PMETA);
    const int* rowtok = (const int*)(ws + SM_ROWTOK); const float* roww = (const float*)(ws + SM_ROWW); const int* atile = (const int*)(ws + SM_ATILE);
    bf16* act = (bf16*)(ws + WS_ACT); bf16* rows = (bf16*)(ws + WS_ROWS);

    for (int u = tid; u < (LDS_BYTES - MISC_OFF) / 4; u += 512) ((LAS unsigned*)(lds + MISC_OFF))[u] = 0u;
    __syncthreads();
    XcdBarrier bar = xcd_barrier_post(ctl + CW_BAR + args.li * XCD_BAR_WORDS, MISC + 8);
    const int lo = args.ph_lo, hi = args.ph_hi;
#define IN(k) (lo <= (k) && (k) < hi)
#define BOTH(k) (IN(k) && IN((k) + 1))
#define GRID_BAR() xcd_barrier(bar)

    if (IN(0)) {
        LAS float* scr = (LAS float*)(lds + wave * 16384);
        const int gw = vcu * NWAVES + wave, NGW = G * NWAVES;
        constexpr int I_IN = 16 * 200, I_SQ = 16 * 32, I_GU = 32 * 16 * 64, I_DN = 32 * 16 * 32;
        constexpr int NITEMS = I_IN + 3 * I_SQ + I_GU + I_DN;
        for (int it = gw; it < NITEMS; it += NGW) {
            int r = it;
            if (r < I_IN) { const int kb = r / 200, nb = r % 200, n0 = nb * 32, o = n0 & 255, wcc = o >> 6, bj = (o >> 5) & 1;
                p0_transpose_item(w_in, D, INW, Win_t, kb * 64, n0, (n0 & ~255) + 128 * bj + 32 * wcc, scr, lane); continue; }
            r -= I_IN;
            if (r < I_SQ) { p0_transpose_item(w_ab, D, D, Wab_t, (r / 32) * 64, (r % 32) * 32, (r % 32) * 32, scr, lane); continue; } r -= I_SQ;
            if (r < I_SQ) { p0_transpose_item(w_rb, D, D, Wrb_t, (r / 32) * 64, (r % 32) * 32, (r % 32) * 32, scr, lane); continue; } r -= I_SQ;
            if (r < I_SQ) { p0_transpose_item(w_out, D, D, Wout_t, (r / 32) * 64, (r % 32) * 32, (r % 32) * 32, scr, lane); continue; } r -= I_SQ;
            if (r < I_GU) { const int e = r / 1024, q = r % 1024, kb = q / 64, nb = q % 64, n0 = nb * 32, bj = n0 >> 10, rem = n0 & 1023, pn = rem >> 7, cl = rem & 127;
                p0_transpose_item(w_gu + (size_t)e * D * 2048, D, 2048, Wgu_t + (size_t)e * 2048 * D, kb * 64, n0, 256 * pn + 128 * bj + cl, scr, lane); continue; }
            r -= I_GU;
            { const int e = r / 512, q = r % 512, kb = q / 32, nb = q % 32;
              p0_transpose_item(w_dn + (size_t)e * DFF * D, DFF, D, Wdn_t + (size_t)e * D * DFF, kb * 64, nb * 32, nb * 32, scr, lane); }
        }
        for (int row = gw; row < NTOK; row += NGW) {
            const f32x4* xr = (const f32x4*)(x + (size_t)row * D) + lane;
            f32x4 v[4]; float ss = 0.f;
#pragma unroll
            for (int j = 0; j < 4; ++j) { v[j] = xr[64 * j]; ss += (v[j][0] * v[j][0] + v[j][1] * v[j][1]) + (v[j][2] * v[j][2] + v[j][3] * v[j][3]); }
            const float rstd = rsqrtf(wave_sum(ss) * (1.0f / D) + EPS);
            u32x2* o8 = (u32x2*)(xb + (size_t)row * D) + lane;
#pragma unroll
            for (int j = 0; j < 4; ++j) { const f32x4 gg = ((const f32x4*)g1)[64 * j + lane]; u32x2 w; w.x = pk2(v[j][0] * rstd * gg[0], v[j][1] * rstd * gg[1]); w.y = pk2(v[j][2] * rstd * gg[2], v[j][3] * rstd * gg[3]); o8[64 * j] = w; }
        }
        __syncthreads();
        for (int item = vcu; item < 28; item += G) {
            const int c0 = (item < 4) ? 1024 + 64 * item : 1792 + 64 * (item - 4);
            LAS float* red = (LAS float*)lds;
            LAS float* rst = (LAS float*)(lds + 32768);
            {
#pragma unroll
              for (int q = 0; q < 2; ++q) { const int r = 2 * wave + q; float ss = 0.f;
                for (int j = 0; j < 4; ++j) { const f32x4 v = ((const f32x4*)(meta + (size_t)r * D))[64 * j + lane]; ss += v[0] * v[0] + v[1] * v[1] + v[2] * v[2] + v[3] * v[3]; }
                ss = wave_sum(ss); if (lane == 0) rst[r] = rsqrtf(ss * (1.0f / D) + EPS); } }
            __syncthreads();
            float a[16];
#pragma unroll
            for (int r = 0; r < 16; ++r) a[r] = 0.f;
            for (int k = wave * 128; k < wave * 128 + 128; ++k) {
                const float w = w_in[(size_t)k * INW + c0 + lane]; const float gk = g1[k];
#pragma unroll
                for (int r = 0; r < 16; ++r) a[r] += bf2f(f2bf(meta[(size_t)r * D + k] * rst[r] * gk)) * w;
            }
#pragma unroll
            for (int r = 0; r < 16; ++r) red[(wave * 16 + r) * 64 + lane] = a[r];
            __syncthreads();
#pragma unroll
            for (int q = 0; q < 2; ++q) { const int r = 2 * wave + q; float v = 0.f;
#pragma unroll
                for (int w8 = 0; w8 < 8; ++w8) v += red[(w8 * 16 + r) * 64 + lane];
                if (item < 2) { const float ss = wave_sum(v * v); v = v * rsqrtf(ss * (1.0f / 64.0f) + EPS) * kg[lane]; }
                else if (item >= 4 && item < 12) v *= 0.08838834764831845f;
                pmeta[(size_t)r * INW + c0 + lane] = f2bf(v); }
            __syncthreads();
        }
        if (BOTH(0)) GRID_BAR();
    }
    if (IN(1)) {
        SchedDense S; S.init(xb, Win_t, NTOK, INW, D, G, bx);
        EpiProj E{proj, qg, kg};
        pg8::gemm_phase<EpiProj, SchedDense>(lds, D, S, E);
        if (BOTH(1)) GRID_BAR();
    }
    if (IN(3)) {
        SchedBranch S{(const char*)yatt, (const char*)yret, (const char*)Wab_t, (const char*)Wrb_t, G, bx};
        EpiBranch E{merged, proj};
        pg8::gemm_phase<EpiBranch, SchedBranch>(lds, D, S, E);
        if (BOTH(3)) GRID_BAR();
    }
    if (IN(4)) {
        SchedDense S; S.init(merged, Wout_t, NTOK, D, D, G, bx);
        EpiOut E{x, out};
        pg8::gemm_phase<EpiOut, SchedDense>(lds, D, S, E);
        if (BOTH(4)) GRID_BAR();
    }
    if (IN(7)) {
        const int nact = (int)ctl[CW_NACT];
        SchedMoe<true, 8> S{(const char*)xb, (const char*)Wgu_t, atile, rowtok, nact, G, bx};
        EpiGU E{act, b_gu};
        pg8::gemm_phase<EpiGU, SchedMoe<true, 8>>(lds, D, S, E);
        if (BOTH(7)) GRID_BAR();
    }
    if (IN(8)) {
        const int nact = (int)ctl[CW_NACT];
        SchedMoe<false, 4> S{(const char*)act, (const char*)Wdn_t, atile, rowtok, nact, G, bx};
        EpiDown E{rows, b_dn, roww};
        pg8::gemm_phase<EpiDown, SchedMoe<false, 4>>(lds, DFF, S, E);
        if (BOTH(8)) GRID_BAR();
    }
#undef IN
#undef BOTH
#undef GRID_BAR
}

static void launch_mk(Args a, int lo, int hi, int li, int grid, hipStream_t stream) {
    a.ph_lo = lo; a.ph_hi = hi; a.li = li; a.pad = 0;
    hipLaunchKernelGGL(mk_fwd, dim3(grid), dim3(512), LDS_BYTES, stream, a);
}
extern "C" void kernel_launch(void* const* d_in, const int* in_sizes, int n_in, void* d_out, int out_size, void* d_ws, size_t ws_size, hipStream_t stream) {
    static int grid = 0;
    if (grid == 0) {
        if (n_in != 17 || in_sizes[0] != NTOK * D || out_size != NTOK * D || ws_size < WS_END) {
            fprintf(stderr, "kernel_launch: unexpected shapes (n_in %d in0 %d out %d ws %zu)\n", n_in, n_in > 0 ? in_sizes[0] : -1, out_size, ws_size); grid = -1; return; }
        int dev = 0, cus = 0;
        if (hipGetDevice(&dev) != hipSuccess || hipDeviceGetAttribute(&cus, hipDeviceAttributeMultiprocessorCount, dev) != hipSuccess) { grid = -1; return; }
        if (hipFuncSetAttribute((const void*)mk_fwd, hipFuncAttributeMaxDynamicSharedMemorySize, LDS_BYTES) != hipSuccess) { fprintf(stderr, "kernel_launch: hipFuncSetAttribute failed\n"); grid = -1; return; }
        grid = cus;
    }
    if (grid < 0) return;
    const float* x = (const float*)d_in[0]; const float* sinks = (const float*)d_in[6];
    const float* g2 = (const float*)d_in[10]; const float* w_r = (const float*)d_in[11]; const float* b_r = (const float*)d_in[12];
    unsigned char* ws = (unsigned char*)d_ws; float* out = (float*)d_out;
    unsigned* ctl = (unsigned*)(ws + WS_CTL);
    bf16* xb = (bf16*)(ws + WS_XB); bf16* proj = (bf16*)(ws + WS_PROJ); bf16* yatt = (bf16*)(ws + WS_YATT); bf16* yret = (bf16*)(ws + WS_YRET);
    bf16* pmeta = (bf16*)(ws + SM_PMETA);
    int* tke = (int*)(ws + SM_TKE); float* tkw = (float*)(ws + SM_TKW); int* tkpos = (int*)(ws + SM_TKPOS); int* tkrow = (int*)(ws + SM_TKROW);
    int* rowtok = (int*)(ws + SM_ROWTOK); float* roww = (float*)(ws + SM_ROWW); int* tile_e = (int*)(ws + SM_TILEE); int* atile = (int*)(ws + SM_ATILE);
    bf16* rows = (bf16*)(ws + WS_ROWS);
    float* retraw = (float*)(ws + WS_MERGED);

    (void)hipMemsetAsync(ws + WS_CTL, 0, 1 * MiB, stream);
    Args a{};
    for (int i = 0; i < 17; ++i) a.in[i] = (const float*)d_in[i];
    a.out = out; a.ws = ws;
    launch_mk(a, 0, 2, 0, grid, stream);
    k_attn_naive<<<NTOK / 16, 256, 0, stream>>>(proj, pmeta, sinks, yatt);
    k_ret_naive<<<NB * 4, 256, 0, stream>>>(proj, pmeta, retraw);
    k_retnorm_naive<<<NTOK, 256, 0, stream>>>(retraw, proj, yret);
    launch_mk(a, 3, 5, 1, grid, stream);
    k_route_naive<<<NTOK / 4, 256, 0, stream>>>(out, g2, w_r, b_r, xb, tke, tkw, tkpos, ctl + CW_CNT);
    k_place_naive<<<256, 256, 0, stream>>>(ctl + CW_CNT, tke, tkw, tkpos, tkrow, rowtok, roww, tile_e, atile, ctl + CW_NACT);
    launch_mk(a, 7, 9, 2, grid, stream);
    k_combine_naive<<<NTOK, 256, 0, stream>>>(out, rows, tkrow);
}
```

```cpp
#include <hip/hip_runtime.h>
#include <cstdio>
#include <cstdint>

typedef unsigned short bf16;
__device__ __forceinline__ float bf2f(bf16 v) { return __uint_as_float(((unsigned)v) << 16); }
__device__ __forceinline__ bf16 f2bf(float f) { unsigned u = __float_as_uint(f); return (bf16)((u + 0x7fffu + ((u >> 16) & 1u)) >> 16); }
__device__ __forceinline__ float sigmoidf_(float x) { return 1.0f / (1.0f + __expf(-x)); }

constexpr int NB = 8, SEQ = 4096, D = 1024, NTOK = NB * SEQ;
constexpr int NMETA = 16;
constexpr int INW = 6400;
constexpr int C_AQ = 0, C_AK = 1024, C_AV = 1152, C_RQ = 1280, C_RK = 1792, C_RV = 2304, C_RG = 3328, C_GA = 4352, C_GR = 5376;
constexpr int NE = 32, TOPK = 4, DFF = 1024;
constexpr int NROWS = (NTOK * TOPK / 256 + NE) * 256;
constexpr int NTILE = NROWS / 256;
constexpr float EPS = 1e-5f;

constexpr size_t MiB = 1u << 20;
constexpr size_t WS_CTL = 0;
constexpr size_t WS_SMALL = 1 * MiB;
constexpr size_t WS_W = 16 * MiB;
constexpr size_t WS_XB = 232 * MiB;
constexpr size_t WS_PROJ = 296 * MiB;
constexpr size_t WS_YATT = 696 * MiB;
constexpr size_t WS_YRET = 760 * MiB;
constexpr size_t WS_MERGED = 824 * MiB;
constexpr size_t WS_END = 1020 * MiB;
constexpr size_t WS_ACT = 296 * MiB;
constexpr size_t WS_ROWS = 568 * MiB;
constexpr size_t SM_UMETA = WS_SMALL;
constexpr size_t SM_PMETA = WS_SMALL + 64 * 1024;
constexpr size_t SM_TKE = WS_SMALL + 512 * 1024;
constexpr size_t SM_TKW = SM_TKE + 512 * 1024;
constexpr size_t SM_TKPOS = SM_TKW + 512 * 1024;
constexpr size_t SM_TKROW = SM_TKPOS + 512 * 1024;
constexpr size_t SM_ROWTOK = SM_TKROW + 512 * 1024;
constexpr size_t SM_ROWW = SM_ROWTOK + 1024 * 1024;
constexpr size_t SM_TILEE = SM_ROWW + 1024 * 1024;
constexpr int CW_CNT = 1024;

#define LAS __attribute__((address_space(3)))
#define GAS __attribute__((address_space(1)))
typedef short bf16x8 __attribute__((ext_vector_type(8)));
typedef float f32x4 __attribute__((ext_vector_type(4)));
typedef float f32x2 __attribute__((ext_vector_type(2)));
typedef unsigned u32x4 __attribute__((ext_vector_type(4)));
typedef unsigned u32x2 __attribute__((ext_vector_type(2)));
#define LDS_WAIT() asm volatile("s_waitcnt lgkmcnt(0)" ::: "memory")
#define VM_WAIT() asm volatile("s_waitcnt vmcnt(0)" ::: "memory")
__device__ __forceinline__ unsigned pk2(float lo, float hi) { return (unsigned)f2bf(lo) | ((unsigned)f2bf(hi) << 16); }
__device__ __forceinline__ float wave_sum(float v) {
#pragma unroll
    for (int o = 1; o < 64; o <<= 1) v += __shfl_xor(v, o);
    return v;
}

constexpr size_t WS_WIN = WS_W;
constexpr size_t WS_WAB = WS_W + 13 * MiB;
constexpr size_t WS_WRB = WS_W + 15 * MiB;
constexpr size_t WS_WOUT = WS_W + 17 * MiB;
constexpr size_t WS_WGU = WS_W + 19 * MiB;
constexpr size_t WS_WDN = WS_W + 147 * MiB;
static_assert(WS_WDN + 64 * MiB <= WS_XB, "weight map");
constexpr size_t SM_ATILE = SM_TILEE + 4096;
constexpr int CW_NACT = 1088;
constexpr int CW_BAR = 4096;

constexpr int RING_BYTES = 131072;
constexpr int MISC_OFF = RING_BYTES;
constexpr int LDS_BYTES = 147456;
constexpr int NWAVES = 8;

#define XB_TMO      128
#define XB_XCNT(j)  (256  + 64 * (j))
#define XB_XSUB(j)  (1280 + 64 * (j))
#define XB_XGEN(j)  (2304 + 64 * (j))
#define XB_TOP      3328
#define XB_TOPGEN   3392
#define XCD_BAR_WORDS 3456
#define XB_SPIN_CAP (1u << 20)
__device__ __forceinline__ unsigned xb_ld(unsigned* p)              { return __hip_atomic_load(p, __ATOMIC_RELAXED, __HIP_MEMORY_SCOPE_AGENT); }
__device__ __forceinline__ unsigned xb_add(unsigned* p, unsigned v) { return __hip_atomic_fetch_add(p, v, __ATOMIC_RELAXED, __HIP_MEMORY_SCOPE_AGENT); }
__device__ __forceinline__ unsigned xb_xcc_id() { return (unsigned)__builtin_amdgcn_s_getreg((3 << 11) | 20) & 0xFu; }
#define XB_SPIN(cond, bar) do { unsigned _sp = 0; while (cond) { __builtin_amdgcn_s_sleep(1); \
    if ((++_sp & 255u) == 0u) { if (xb_ld(&(bar)[XB_TMO])) break; if (_sp > XB_SPIN_CAP) { atomicAdd(&(bar)[XB_TMO], 1u); break; } } } } while (0)
struct XcdBarrier { unsigned* bar; unsigned x; volatile LAS unsigned* st; };
__device__ __forceinline__ XcdBarrier xcd_barrier_post(unsigned* bar, volatile LAS unsigned* st) {
    XcdBarrier b; b.bar = bar; b.x = xb_xcc_id(); b.st = st;
    if (threadIdx.x == 0) (void)xb_add(&bar[XB_XCNT(b.x)], 1u);
    return b;
}
__device__ __forceinline__ void xcd_barrier_complete(unsigned* bar, unsigned x, unsigned& nloc, unsigned& nx) {
    const unsigned G = gridDim.x * gridDim.y * gridDim.z;
    unsigned sum, cnt, mine, sp = 0u;
    for (;;) {
        sum = 0u; cnt = 0u; mine = 0u;
#pragma unroll
        for (unsigned j = 0; j < 16; ++j) { const unsigned c = xb_ld(&bar[XB_XCNT(j)]); sum += c; cnt += (c > 0u) ? 1u : 0u; mine = (j == x) ? c : mine; }
        if (sum == G) break;
        __builtin_amdgcn_s_sleep(1);
        if ((++sp & 255u) == 0u) { if (xb_ld(&bar[XB_TMO])) break; if (sp > XB_SPIN_CAP) { atomicAdd(&bar[XB_TMO], 1u); break; } }
    }
    nloc = mine > 0u ? mine : 1u; nx = cnt > 0u ? cnt : 1u;
}
__device__ __forceinline__ void xcd_barrier(const XcdBarrier& b) {
    asm volatile("s_waitcnt vmcnt(0)" ::: "memory");
    __syncthreads();
    if (threadIdx.x == 0) {
        unsigned* bar = b.bar;
        __builtin_amdgcn_s_waitcnt(0);
        unsigned nloc = b.st[0], nx = b.st[1];
        if (nloc == 0u) { xcd_barrier_complete(bar, b.x, nloc, nx); b.st[0] = nloc; b.st[1] = nx; }
        const unsigned old = xb_add(&bar[XB_XSUB(b.x)], 1u);
        const unsigned gen = old / nloc;
        if (old + 1u == (gen + 1u) * nloc) {
            __builtin_amdgcn_fence(__ATOMIC_RELEASE, "agent");
            asm volatile("s_waitcnt vmcnt(0)" ::: "memory");
            const unsigned og = xb_add(&bar[XB_TOP], 1u);
            const unsigned tg = og / nx;
            if (og + 1u == (tg + 1u) * nx) xb_add(&bar[XB_TOPGEN], 1u);
            else XB_SPIN(xb_ld(&bar[XB_TOPGEN]) == tg, bar);
            __builtin_amdgcn_fence(__ATOMIC_ACQUIRE, "agent");
            xb_add(&bar[XB_XGEN(b.x)], 1u);
            asm volatile("s_waitcnt vmcnt(0)" ::: "memory");
        } else {
            XB_SPIN(xb_ld(&bar[XB_XGEN(b.x)]) == gen, bar);
            __builtin_amdgcn_fence(__ATOMIC_ACQUIRE, "agent");
            asm volatile("s_waitcnt vmcnt(0)" ::: "memory");
        }
    }
    __syncthreads();
}

namespace pg8 {
constexpr int BM = 256, BK = 64, HALF = 128, HTB = HALF * BK * 2, STAGE_BYTES = 8 * HTB;
__host__ __device__ __forceinline__ int lds_byte(int r, int c) { const int st = (r >> 4) * 2 + (c >> 5), rr = r & 15, cc = c & 31, ob = rr * 64 + cc * 2; return st * 1024 + (ob ^ (((ob >> 9) & 1) << 5)); }
__host__ __device__ __forceinline__ void stage_rc(int b, int& R, int& C) { const int st = b / 1024, sb = b % 1024, swz = sb ^ (((sb >> 9) & 1) << 5); R = (st >> 1) * 16 + swz / 64; C = (st & 1) * 32 + (swz % 64) / 2; }
__host__ __device__ __forceinline__ int perm32(int rho) { const int n = rho >> 4, i = rho & 15; return 8 * (i >> 2) + 4 * n + (i & 3); }
struct Unit { int pm, pn, aux, tl; const char* A; const char* B; };
typedef f32x4 Acc[2][2][4][2];

template <class Epi, class Sched>
__device__ __forceinline__ void gemm_phase(LAS unsigned char* lds, const int K, const Sched& S, const Epi& E) {
    const int tid = threadIdx.x, wid = __builtin_amdgcn_readfirstlane(tid >> 6), lane = tid & 63, wr = wid >> 2, wc = wid & 3, fr = lane & 15, fq = lane >> 4;
    const int nt = K / BK;
    int RA[2], CA[2]; unsigned voffB[2];
#pragma unroll
    for (int i = 0; i < 2; ++i) { int R, C; stage_rc(tid * 16 + i * 8192, R, C); const int Rb = Epi::PERM ? ((R & ~31) + perm32(R & 31)) : R;
        RA[i] = R; CA[i] = C; voffB[i] = (unsigned)(Rb * K + C) * 2u; }
    const size_t kstep = (size_t)(BK * 2);
    const size_t hstep = (size_t)HALF * K * 2;
    const unsigned ldsw = (unsigned)wid * 1024u;
    const int aoff = lds_byte(wr * 64 + fr, fq * 8), boff = lds_byte(wc * 32 + fr, fq * 8);
#define PG8_SA(b, h) (((b) * 2 + (h)) * HTB)
#define PG8_SB(b, h) ((4 + (b) * 2 + (h)) * HTB)
#define PG8_STAGE(bufoff, gbase, voff) do { _Pragma("unroll") for (int _i = 0; _i < 2; ++_i) \
        __builtin_amdgcn_global_load_lds((const unsigned*)((const char*)(gbase) + (voff)[_i]), (LAS unsigned*)(lds + (bufoff) + ldsw + _i * 8192), 16, 0, 0); } while (0)
#define PG8_LDA(dst, b, h) do { _Pragma("unroll") for (int m = 0; m < 4; ++m) _Pragma("unroll") for (int k = 0; k < 2; ++k) dst[m][k] = *(const LAS bf16x8*)(lds + PG8_SA(b, h) + aoff + m * 2048 + k * 1024); } while (0)
#define PG8_LDB(dst, b, h) do { _Pragma("unroll") for (int n = 0; n < 2; ++n) _Pragma("unroll") for (int k = 0; k < 2; ++k) dst[n][k] = *(const LAS bf16x8*)(lds + PG8_SB(b, h) + boff + n * 2048 + k * 1024); } while (0)
#define PG8_MMA(ai, bj, At, Bt) do { __builtin_amdgcn_s_setprio(1); _Pragma("unroll") for (int m = 0; m < 4; ++m) _Pragma("unroll") for (int n = 0; n < 2; ++n) _Pragma("unroll") for (int k = 0; k < 2; ++k) \
        acc[ai][bj][m][n] = __builtin_amdgcn_mfma_f32_16x16x32_bf16(Bt[n][k], At[m][k], acc[ai][bj][m][n], 0, 0, 0); __builtin_amdgcn_s_setprio(0); } while (0)
#define PG8_WAIT_V(n) asm volatile("s_waitcnt vmcnt(" #n ")" ::: "memory")
#define PG8_WAIT_L(n) asm volatile("s_waitcnt lgkmcnt(" #n ")" ::: "memory")
#define PG8_BAR __builtin_amdgcn_s_barrier()
#define PG8_SCHED __builtin_amdgcn_sched_barrier(0)
    Unit cur, nxt; int ui = 0;
    if (!S.next(0, cur)) return;
    unsigned ca[2][2], na[2][2];
    S.aoff(cur, RA, CA, ca);
    f32x4 acc[2][2][4][2];
#pragma unroll
    for (int a = 0; a < 2; ++a)
#pragma unroll
        for (int b = 0; b < 2; ++b)
#pragma unroll
            for (int m = 0; m < 4; ++m)
#pragma unroll
                for (int n = 0; n < 2; ++n) acc[a][b][m][n] = (f32x4){0.f, 0.f, 0.f, 0.f};
    bf16x8 At[4][2], B0[2][2], B1[2][2];
    const char* cA = cur.A; const char* cB = cur.B;
    PG8_STAGE(PG8_SB(0, 0), cB, voffB); PG8_STAGE(PG8_SB(0, 1), cB + hstep, voffB); PG8_STAGE(PG8_SA(0, 0), cA, ca[0]); PG8_STAGE(PG8_SA(0, 1), cA, ca[1]);
    if (wr == 1) PG8_BAR;
    PG8_WAIT_V(2); PG8_BAR;
    PG8_STAGE(PG8_SB(1, 0), cB + kstep, voffB); PG8_STAGE(PG8_SA(1, 0), cA + kstep, ca[0]); PG8_STAGE(PG8_SB(1, 1), cB + hstep + kstep, voffB);
    PG8_WAIT_V(6); PG8_BAR;
    for (;;) {
        const bool has_next = S.next(ui + 1, nxt);
        if (has_next) S.aoff(nxt, RA, CA, na);
        else {
#pragma unroll
            for (int h = 0; h < 2; ++h)
#pragma unroll
                for (int i = 0; i < 2; ++i) na[h][i] = ca[h][i];
        }
        const char* nA = has_next ? nxt.A : cA; const char* nB = has_next ? nxt.B : cB;
        for (int t = 0; t < nt; t += 2) {
            const bool last = (t == nt - 2);
            const char* a1 = cA + (size_t)(t + 1) * kstep;
            const char* a2 = last ? nA : cA + (size_t)(t + 2) * kstep; const char* b2 = last ? nB : cB + (size_t)(t + 2) * kstep;
            const char* a3 = a2 + kstep; const char* b3 = b2 + kstep;
            unsigned o2[2][2];
#pragma unroll
            for (int h = 0; h < 2; ++h)
#pragma unroll
                for (int i = 0; i < 2; ++i) o2[h][i] = last ? na[h][i] : ca[h][i];
            PG8_LDB(B0, 0, 0); PG8_LDB(B1, 0, 1); PG8_SCHED; PG8_LDA(At, 0, 0); PG8_STAGE(PG8_SA(1, 1), a1, ca[1]);
            PG8_WAIT_V(8); PG8_WAIT_L(0); PG8_BAR; PG8_MMA(0, 0, At, B0); PG8_MMA(0, 1, At, B1); PG8_BAR; PG8_SCHED;
            PG8_LDA(At, 0, 1); PG8_STAGE(PG8_SB(0, 0), b2, voffB); PG8_STAGE(PG8_SB(0, 1), b2 + hstep, voffB); PG8_STAGE(PG8_SA(0, 0), a2, o2[0]);
            PG8_WAIT_V(8); PG8_WAIT_L(0); PG8_BAR; PG8_MMA(1, 0, At, B0); PG8_MMA(1, 1, At, B1); PG8_BAR; PG8_SCHED;
            PG8_LDB(B0, 1, 0); PG8_LDB(B1, 1, 1); PG8_SCHED; PG8_LDA(At, 1, 0); PG8_STAGE(PG8_SA(0, 1), a2, o2[1]);
            PG8_WAIT_V(8); PG8_WAIT_L(0); PG8_BAR; PG8_MMA(0, 0, At, B0); PG8_MMA(0, 1, At, B1); PG8_BAR; PG8_SCHED;
            PG8_LDA(At, 1, 1); PG8_STAGE(PG8_SB(1, 0), b3, voffB); PG8_STAGE(PG8_SB(1, 1), b3 + hstep, voffB); PG8_STAGE(PG8_SA(1, 0), a3, o2[0]);
            PG8_WAIT_V(8); PG8_WAIT_L(0); PG8_BAR; PG8_MMA(1, 0, At, B0); PG8_MMA(1, 1, At, B1); PG8_BAR; PG8_SCHED;
        }
        if (wr == 0) PG8_BAR;
        E(acc, cur, wr, wc, fr, fq);
        if (!has_next) break;
#pragma unroll
        for (int a = 0; a < 2; ++a)
#pragma unroll
            for (int b = 0; b < 2; ++b)
#pragma unroll
                for (int m = 0; m < 4; ++m)
#pragma unroll
                    for (int n = 0; n < 2; ++n) acc[a][b][m][n] = (f32x4){0.f, 0.f, 0.f, 0.f};
        cur = nxt; cA = nA; cB = nB; ++ui;
#pragma unroll
        for (int h = 0; h < 2; ++h)
#pragma unroll
            for (int i = 0; i < 2; ++i) ca[h][i] = na[h][i];
        if (wr == 1) PG8_BAR;
    }
    PG8_WAIT_V(0);
    PG8_BAR;
#undef PG8_SA
#undef PG8_SB
#undef PG8_STAGE
#undef PG8_LDA
#undef PG8_LDB
#undef PG8_MMA
#undef PG8_WAIT_V
#undef PG8_WAIT_L
#undef PG8_BAR
#undef PG8_SCHED
}
}
constexpr size_t SM_LIST = WS_SMALL + 5 * MiB;
constexpr size_t SM_WLIST = WS_SMALL + 9 * MiB;
constexpr int MT_PSTART = 256;
constexpr int MT_CNT = 512;
constexpr int MT_NACT = 768;
constexpr int MT_ATILE = 1024;
constexpr int MT_HIST = 4096;
constexpr int MT_BASE = 4224;
constexpr int MT_REC = 4352;

__device__ __forceinline__ void moe_tables(LAS unsigned char* misc, const unsigned* cnt) {
    LAS int* pstart = (LAS int*)(misc + MT_PSTART); LAS int* cl = (LAS int*)(misc + MT_CNT); LAS int* at = (LAS int*)(misc + MT_ATILE);
    __syncthreads();
    if (threadIdx.x < 64) {
        const int lane = threadIdx.x, e = lane & 31;
        const int c = (int)__hip_atomic_load(cnt + e, __ATOMIC_RELAXED, __HIP_MEMORY_SCOPE_AGENT), nt = (c + 255) >> 8;
        int incl = nt;
#pragma unroll
        for (int o = 1; o < 32; o <<= 1) { const int v = __shfl_up(incl, o); if (e >= o) incl += v; }
        const int t0 = incl - nt;
        if (lane < 32) { cl[e] = c; pstart[e] = t0 << 8; for (int t = 0; t < nt; ++t) at[t0 + t] = (t0 + t) | (e << 12) | (t << 20);
            if (e == 31) { pstart[NE] = incl << 8; *(LAS int*)(misc + MT_NACT) = incl; } }
    }
    __syncthreads();
}

template <int N, int XR>
__device__ __forceinline__ void tr_step(float (&v)[64], int lane) {
    const bool up = (lane & XR) != 0;
#pragma unroll
    for (int i = 0; i < N; ++i) { const float keep = up ? v[i + N] : v[i], send = up ? v[i] : v[i + N]; v[i] = keep + __shfl_xor(send, XR); }
}

__device__ __forceinline__ void route_phase(LAS unsigned char* lds, const float* __restrict__ h2, const float* __restrict__ g2, const float* __restrict__ wr, const float* __restrict__ br,
                                            bf16* __restrict__ xn2, int* __restrict__ tke, int* __restrict__ tkpos, float* __restrict__ tkw, int* __restrict__ list, float* __restrict__ wlist,
                                            unsigned* __restrict__ cnt, int G, int bx) {
    const int tid = threadIdx.x, lane = tid & 63; const int wave = __builtin_amdgcn_readfirstlane(tid >> 6);
    LAS float* wT = (LAS float*)lds;
    LAS unsigned char* misc = lds + MISC_OFF;
    LAS int* hist = (LAS int*)(misc + MT_HIST); LAS int* base = (LAS int*)(misc + MT_BASE); LAS int* rec = (LAS int*)(misc + MT_REC);
    for (int idx = tid; idx < NE * D; idx += 512) { const int e = idx >> 10, k = idx & 1023; wT[idx] = wr[(size_t)k * NE + e]; }
    const float bias = br[lane & 31];
    for (int tb = bx; tb < NTOK / 128; tb += G) {
        if (tid < 32) hist[tid] = 0;
        __syncthreads();
        for (int pp = 0; pp < 8; ++pp) {
            const int tl0 = wave * 16 + pp * 2;
            const int row0 = tb * 128 + tl0;
            float xv[2][16];
#pragma unroll
            for (int t = 0; t < 2; ++t) {
                const f32x4* xr = (const f32x4*)(h2 + (size_t)(row0 + t) * D) + lane;
                float ss = 0.f; f32x4 v[4];
#pragma unroll
                for (int j = 0; j < 4; ++j) { v[j] = xr[64 * j]; ss += (v[j][0] * v[j][0] + v[j][1] * v[j][1]) + (v[j][2] * v[j][2] + v[j][3] * v[j][3]); }
                const float rstd = rsqrtf(wave_sum(ss) * (1.0f / D) + EPS);
                u32x2* o8 = (u32x2*)(xn2 + (size_t)(row0 + t) * D) + lane;
#pragma unroll
                for (int j = 0; j < 4; ++j) { const f32x4 gg = ((const f32x4*)g2)[64 * j + lane];
#pragma unroll
                    for (int q = 0; q < 4; ++q) xv[t][4 * j + q] = v[j][q] * rstd * gg[q];
                    u32x2 w; w.x = pk2(xv[t][4 * j], xv[t][4 * j + 1]); w.y = pk2(xv[t][4 * j + 2], xv[t][4 * j + 3]); o8[64 * j] = w; }
            }
            float acc[64];
#pragma unroll
            for (int i = 0; i < 64; ++i) acc[i] = 0.f;
#pragma unroll
            for (int e = 0; e < 32; ++e)
#pragma unroll
                for (int j = 0; j < 4; ++j) {
                    const f32x4 w = *(const LAS f32x4*)(wT + e * 1024 + (64 * j + lane) * 4);
                    acc[e] += (xv[0][4 * j] * w[0] + xv[0][4 * j + 1] * w[1]) + (xv[0][4 * j + 2] * w[2] + xv[0][4 * j + 3] * w[3]);
                    acc[32 + e] += (xv[1][4 * j] * w[0] + xv[1][4 * j + 1] * w[1]) + (xv[1][4 * j + 2] * w[2] + xv[1][4 * j + 3] * w[3]);
                }
            tr_step<32, 32>(acc, lane); tr_step<16, 16>(acc, lane); tr_step<8, 8>(acc, lane); tr_step<4, 4>(acc, lane); tr_step<2, 2>(acc, lane); tr_step<1, 1>(acc, lane);
            const float logit = acc[0] + bias;
            float cur = logit, m0 = 0.f; int myrank = -1;
#pragma unroll
            for (int k = 0; k < 4; ++k) {
                float m = cur;
#pragma unroll
                for (int o = 1; o < 32; o <<= 1) m = fmaxf(m, __shfl_xor(m, o));
                if (k == 0) m0 = m;
                const unsigned long long mask = __ballot(cur == m);
                const unsigned half = (lane < 32) ? (unsigned)mask : (unsigned)(mask >> 32);
                const int sel = __ffs(half) - 1;
                if ((lane & 31) == sel) { myrank = k; cur = -3.0e38f; }
            }
            float ex = (myrank >= 0) ? __expf(logit - m0) : 0.f, sum = ex;
#pragma unroll
            for (int o = 1; o < 32; o <<= 1) sum += __shfl_xor(sum, o);
            if (myrank >= 0) {
                const int e = lane & 31, tl = tl0 + (lane >> 5);
                const int lp = __hip_atomic_fetch_add(hist + e, 1, __ATOMIC_RELAXED, __HIP_MEMORY_SCOPE_WORKGROUP);
                LAS int* r = rec + (tl * 4 + myrank) * 3; r[0] = e; r[1] = lp; r[2] = __float_as_int(ex / sum);
            }
        }
        __syncthreads();
        if (tid < 32) base[tid] = (int)atomicAdd(&cnt[tid], (unsigned)hist[tid]);
        __syncthreads();
        { const int tl = tid >> 2; const int token = tb * 128 + tl; LAS int* r = rec + tid * 3; const int e = r[0], pos = base[e] + r[1]; const float w = __int_as_float(r[2]);
          tke[token * 4 + (tid & 3)] = e; tkpos[token * 4 + (tid & 3)] = pos; tkw[token * 4 + (tid & 3)] = w;
          list[e * NTOK + pos] = token; wlist[e * NTOK + pos] = w; }
        __syncthreads();
    }
}

__device__ __forceinline__ void combine_phase(LAS unsigned char* misc, float* __restrict__ out, const bf16* __restrict__ rows, const int* __restrict__ tke, const int* __restrict__ tkpos, int gw, int NGW, int lane) {
    LAS const int* pstart = (LAS const int*)(misc + MT_PSTART);
    for (int token = gw; token < NTOK; token += NGW) {
        int rr[4];
#pragma unroll
        for (int k = 0; k < 4; ++k) rr[k] = pstart[tke[token * 4 + k]] + tkpos[token * 4 + k];
        f32x4* o = (f32x4*)(out + (size_t)token * D) + lane;
        f32x4 v[4];
#pragma unroll
        for (int j = 0; j < 4; ++j) v[j] = o[64 * j];
#pragma unroll
        for (int k = 0; k < 4; ++k) {
            const u32x2* rp = (const u32x2*)(rows + (size_t)rr[k] * D) + lane;
#pragma unroll
            for (int j = 0; j < 4; ++j) { const u32x2 w = rp[64 * j];
                v[j][0] += __uint_as_float(w.x << 16); v[j][1] += __uint_as_float(w.x & 0xffff0000u); v[j][2] += __uint_as_float(w.y << 16); v[j][3] += __uint_as_float(w.y & 0xffff0000u); }
        }
#pragma unroll
        for (int j = 0; j < 4; ++j) o[64 * j] = v[j];
    }
}
struct SchedDense {
    const char* A; const char* Bt; int K, nM, nN, nwg, G, c;
    __device__ void init(const bf16* A_, const bf16* Bt_, int M, int N, int K_, int G_, int c_) { A = (const char*)A_; Bt = (const char*)Bt_; K = K_; nM = M / 256; nN = N / 256; nwg = nM * nN; G = G_; c = c_; }
    __device__ __forceinline__ bool next(int i, pg8::Unit& u) const {
        const long L = (long)i * G + c; if (L >= nwg) return false;
        int wgid = (int)L; { const int q = nwg / 8, r = nwg % 8, xcd = wgid % 8, off = wgid / 8; wgid = (xcd < r ? xcd * (q + 1) : r * (q + 1) + (xcd - r) * q) + off; }
        const int nig = 8 * nN, gid = wgid / nig, fm = gid * 8, gsz = (nM - fm) < 8 ? (nM - fm) : 8;
        u.pm = fm + ((wgid % nig) % gsz); u.pn = (wgid % nig) / gsz; u.aux = 0; u.tl = 0;
        u.A = A + (size_t)u.pm * 256 * K * 2; u.B = Bt + (size_t)u.pn * 256 * K * 2; return true;
    }
    __device__ __forceinline__ void aoff(const pg8::Unit&, const int (&R)[2], const int (&C)[2], unsigned (&o)[2][2]) const {
#pragma unroll
        for (int h = 0; h < 2; ++h)
#pragma unroll
            for (int i = 0; i < 2; ++i) o[h][i] = (unsigned)((128 * h + R[i]) * K + C[i]) * 2u;
    }
};
struct SchedBranch {
    const char* A0; const char* A1; const char* B0; const char* B1; int G, c;
    __device__ __forceinline__ bool next(int i, pg8::Unit& u) const {
        const int L = (i >> 1) * G + c; if (L >= 512) return false;
        int wgid = L; { const int off = wgid / 8, xcd = wgid % 8; wgid = xcd * 64 + off; }
        const int nig = 8 * 4, gid = wgid / nig;
        u.pm = gid * 8 + ((wgid % nig) % 8); u.pn = (wgid % nig) / 8; u.aux = i & 1; u.tl = 0;
        u.A = ((i & 1) ? A1 : A0) + (size_t)u.pm * 256 * D * 2; u.B = ((i & 1) ? B1 : B0) + (size_t)u.pn * 256 * D * 2; return true;
    }
    __device__ __forceinline__ void aoff(const pg8::Unit&, const int (&R)[2], const int (&C)[2], unsigned (&o)[2][2]) const {
#pragma unroll
        for (int h = 0; h < 2; ++h)
#pragma unroll
            for (int i = 0; i < 2; ++i) o[h][i] = (unsigned)((128 * h + R[i]) * D + C[i]) * 2u;
    }
};
template <bool GATHER, int NPN>
struct SchedMoe {
    const char* A; const char* Bt; LAS const unsigned char* misc; const int* list; int G, c;
    __device__ __forceinline__ bool next(int i, pg8::Unit& u) const {
        const int nact = *(LAS const int*)(misc + MT_NACT);
        const int L = i * G + c; if (L >= nact * NPN) return false;
        const int k = L / NPN; u.pn = L % NPN; const int w = ((LAS const int*)(misc + MT_ATILE))[k];
        u.pm = w & 0xfff; u.aux = (w >> 12) & 0xff; u.tl = w >> 20;
        u.A = GATHER ? A : A + (size_t)u.pm * 256 * 1024 * 2;
        u.B = Bt + ((size_t)u.aux * NPN + u.pn) * 256 * 1024 * 2; return true;
    }
    __device__ __forceinline__ void aoff(const pg8::Unit& u, const int (&R)[2], const int (&C)[2], unsigned (&o)[2][2]) const {
        const int ce = ((LAS const int*)(misc + MT_CNT))[u.aux];
#pragma unroll
        for (int h = 0; h < 2; ++h)
#pragma unroll
            for (int i = 0; i < 2; ++i) {
                if (GATHER) { const int idx = u.tl * 256 + 128 * h + R[i]; const int tok = (idx < ce) ? list[u.aux * NTOK + idx] : 0; o[h][i] = (unsigned)tok * 2048u + (unsigned)C[i] * 2u; }
                else o[h][i] = (unsigned)((128 * h + R[i]) * 1024 + C[i]) * 2u;
            }
    }
};

__device__ __forceinline__ u32x4 pack8(const f32x4& a, const f32x4& b) { u32x4 w; w.x = pk2(a[0], a[1]); w.y = pk2(a[2], a[3]); w.z = pk2(b[0], b[1]); w.w = pk2(b[2], b[3]); return w; }
__device__ __forceinline__ void unpack8(const u32x4& w, float (&f)[8]) {
    f[0] = __uint_as_float(w.x << 16); f[1] = __uint_as_float(w.x & 0xffff0000u); f[2] = __uint_as_float(w.y << 16); f[3] = __uint_as_float(w.y & 0xffff0000u);
    f[4] = __uint_as_float(w.z << 16); f[5] = __uint_as_float(w.z & 0xffff0000u); f[6] = __uint_as_float(w.w << 16); f[7] = __uint_as_float(w.w & 0xffff0000u);
}
struct EpiProj {
    static constexpr bool PERM = true;
    bf16* proj; const float* qg; const float* kg;
    __device__ __forceinline__ void operator()(pg8::Acc& acc, const pg8::Unit& u, int wr, int wc, int fr, int fq) const {
        const int pn = u.pn;
        int mode;
        if (pn < 4) mode = 1; else if (pn == 4) mode = (wc < 2) ? 2 : 0; else if (pn < 7) mode = 0; else if (pn < 9) mode = 3; else if (pn < 13) mode = 0; else if (pn < 17) mode = 4; else mode = 5;
        float gn[2][8];
        if (mode == 1 || mode == 2) { const float* g = (mode == 1) ? qg : kg; const float s = (mode == 1) ? 0.125f : 1.0f;
#pragma unroll
            for (int bj = 0; bj < 2; ++bj)
#pragma unroll
                for (int j = 0; j < 8; ++j) gn[bj][j] = g[32 * bj + 8 * fq + j] * s; }
#pragma unroll
        for (int ai = 0; ai < 2; ++ai)
#pragma unroll
            for (int m = 0; m < 4; ++m) {
                const int r = u.pm * 256 + ai * 128 + wr * 64 + m * 16 + fr;
                bf16* rowp = proj + (size_t)r * INW + pn * 256 + wc * 64 + 8 * fq;
                f32x4 v[2][2];
#pragma unroll
                for (int bj = 0; bj < 2; ++bj) { v[bj][0] = acc[ai][bj][m][0]; v[bj][1] = acc[ai][bj][m][1]; }
                if (mode == 1 || mode == 2) {
                    float ss = 0.f;
#pragma unroll
                    for (int bj = 0; bj < 2; ++bj)
#pragma unroll
                        for (int n = 0; n < 2; ++n) ss += v[bj][n][0] * v[bj][n][0] + v[bj][n][1] * v[bj][n][1] + v[bj][n][2] * v[bj][n][2] + v[bj][n][3] * v[bj][n][3];
                    ss += __shfl_xor(ss, 16); ss += __shfl_xor(ss, 32);
                    const float rs = rsqrtf(ss * (1.0f / 64.0f) + EPS);
#pragma unroll
                    for (int bj = 0; bj < 2; ++bj)
#pragma unroll
                        for (int n = 0; n < 2; ++n)
#pragma unroll
                            for (int i = 0; i < 4; ++i) v[bj][n][i] = v[bj][n][i] * rs * gn[bj][4 * n + i];
                } else if (mode == 3) {
#pragma unroll
                    for (int bj = 0; bj < 2; ++bj)
#pragma unroll
                        for (int n = 0; n < 2; ++n) v[bj][n] = v[bj][n] * 0.08838834764831845f;
                } else if (mode == 4) {
#pragma unroll
                    for (int bj = 0; bj < 2; ++bj)
#pragma unroll
                        for (int n = 0; n < 2; ++n)
#pragma unroll
                            for (int i = 0; i < 4; ++i) { const float x = v[bj][n][i]; v[bj][n][i] = x * sigmoidf_(x); }
                } else if (mode == 5) {
#pragma unroll
                    for (int bj = 0; bj < 2; ++bj)
#pragma unroll
                        for (int n = 0; n < 2; ++n)
#pragma unroll
                            for (int i = 0; i < 4; ++i) v[bj][n][i] = sigmoidf_(v[bj][n][i]);
                }
#pragma unroll
                for (int bj = 0; bj < 2; ++bj) *(u32x4*)(rowp + 32 * bj) = pack8(v[bj][0], v[bj][1]);
            }
    }
};
struct EpiBranch {
    static constexpr bool PERM = true;
    bf16* merged; const bf16* proj;
    __device__ __forceinline__ void operator()(pg8::Acc& acc, const pg8::Unit& u, int wr, int wc, int fr, int fq) const {
        const int gcol = u.aux ? C_GR : C_GA;
#pragma unroll
        for (int ai = 0; ai < 2; ++ai)
#pragma unroll
            for (int m = 0; m < 4; ++m) {
                const int r = u.pm * 256 + ai * 128 + wr * 64 + m * 16 + fr;
#pragma unroll
                for (int bj = 0; bj < 2; ++bj) {
                    const int col = u.pn * 256 + bj * 128 + wc * 32 + 8 * fq;
                    const u32x4 gw = *(const u32x4*)(proj + (size_t)r * INW + gcol + col);
                    float g[8]; unpack8(gw, g);
                    f32x4 a = acc[ai][bj][m][0], b = acc[ai][bj][m][1];
                    a[0] *= g[0]; a[1] *= g[1]; a[2] *= g[2]; a[3] *= g[3]; b[0] *= g[4]; b[1] *= g[5]; b[2] *= g[6]; b[3] *= g[7];
                    bf16* mp = merged + (size_t)r * D + col;
                    if (u.aux) { const u32x4 pw = *(const u32x4*)mp; float p[8]; unpack8(pw, p);
                        a[0] += p[0]; a[1] += p[1]; a[2] += p[2]; a[3] += p[3]; b[0] += p[4]; b[1] += p[5]; b[2] += p[6]; b[3] += p[7]; }
                    *(u32x4*)mp = pack8(a, b);
                }
            }
    }
};
struct EpiOut {
    static constexpr bool PERM = false;
    const float* x; float* out;
    __device__ __forceinline__ void operator()(pg8::Acc& acc, const pg8::Unit& u, int wr, int wc, int fr, int fq) const {
#pragma unroll
        for (int ai = 0; ai < 2; ++ai)
#pragma unroll
            for (int m = 0; m < 4; ++m) {
                const size_t off = (size_t)(u.pm * 256 + ai * 128 + wr * 64 + m * 16 + fr) * D + u.pn * 256 + wc * 32 + 4 * fq;
#pragma unroll
                for (int bj = 0; bj < 2; ++bj)
#pragma unroll
                    for (int n = 0; n < 2; ++n) { const f32x4 xv = *(const f32x4*)(x + off + bj * 128 + n * 16); *(f32x4*)(out + off + bj * 128 + n * 16) = xv + acc[ai][bj][m][n]; }
            }
    }
};
struct EpiGU {
    static constexpr bool PERM = true;
    bf16* act; const float* bgu;
    __device__ __forceinline__ void operator()(pg8::Acc& acc, const pg8::Unit& u, int wr, int wc, int fr, int fq) const {
        const int col = u.pn * 128 + wc * 32 + 8 * fq;
        const float* bg = bgu + (size_t)u.aux * 2048 + col;
        float bgate[8], bup[8];
#pragma unroll
        for (int j = 0; j < 8; ++j) { bgate[j] = bg[j]; bup[j] = bg[1024 + j]; }
#pragma unroll
        for (int ai = 0; ai < 2; ++ai)
#pragma unroll
            for (int m = 0; m < 4; ++m) {
                const int r = u.pm * 256 + ai * 128 + wr * 64 + m * 16 + fr;
                f32x4 o[2];
#pragma unroll
                for (int n = 0; n < 2; ++n)
#pragma unroll
                    for (int i = 0; i < 4; ++i) {
                        float gate = acc[ai][0][m][n][i] + bgate[4 * n + i], up = acc[ai][1][m][n][i] + bup[4 * n + i];
                        gate = fminf(gate, 7.0f); up = fminf(fmaxf(up, -7.0f), 7.0f);
                        o[n][i] = (up + 1.0f) * gate * sigmoidf_(1.702f * gate);
                    }
                *(u32x4*)(act + (size_t)r * DFF + col) = pack8(o[0], o[1]);
            }
    }
};
struct EpiDown {
    static constexpr bool PERM = true;
    bf16* rows; const float* bdn; const float* wlist; LAS const unsigned char* misc;
    __device__ __forceinline__ void operator()(pg8::Acc& acc, const pg8::Unit& u, int wr, int wc, int fr, int fq) const {
        const int ce = ((LAS const int*)(misc + MT_CNT))[u.aux];
        float bb[2][8];
#pragma unroll
        for (int bj = 0; bj < 2; ++bj)
#pragma unroll
            for (int j = 0; j < 8; ++j) bb[bj][j] = bdn[(size_t)u.aux * D + u.pn * 256 + bj * 128 + wc * 32 + 8 * fq + j];
#pragma unroll
        for (int ai = 0; ai < 2; ++ai)
#pragma unroll
            for (int m = 0; m < 4; ++m) {
                const int lr = ai * 128 + wr * 64 + m * 16 + fr, r = u.pm * 256 + lr, idx = u.tl * 256 + lr;
                const float w = (idx < ce) ? wlist[u.aux * NTOK + idx] : 0.f;
#pragma unroll
                for (int bj = 0; bj < 2; ++bj) {
                    f32x4 a = acc[ai][bj][m][0], b = acc[ai][bj][m][1];
#pragma unroll
                    for (int i = 0; i < 4; ++i) { a[i] = (a[i] + bb[bj][i]) * w; b[i] = (b[i] + bb[bj][4 + i]) * w; }
                    *(u32x4*)(rows + (size_t)r * D + u.pn * 256 + bj * 128 + wc * 32 + 8 * fq) = pack8(a, b);
                }
            }
    }
};
namespace attn {
typedef float f32x16 __attribute__((ext_vector_type(16)));
typedef short s16x4 __attribute__((ext_vector_type(4)));
constexpr int NK = 272, K_OFF = 0, V_OFF = 34816, WS_OFF = 69632, OST_OFF = 71680, LDS_END = OST_OFF + 8 * 4096;
constexpr float LOG2E = 1.4426950408889634f;
__device__ __forceinline__ s16x4 vtr(LAS const unsigned char* p) { return __builtin_bit_cast(s16x4, __builtin_amdgcn_ds_read_tr16_b64_v4i16((LAS s16x4*)p)); }
__device__ __forceinline__ int crowc(int r) { return (r & 3) + 8 * (r >> 2); }

template <int TYPE, bool DIAG>
__device__ __forceinline__ void tile(LAS const unsigned char* lds, int kbase, const bf16x8 (&qr)[4], f32x16 (&o)[2], float& l, float lanebase, float c1, int tt, int lane) {
    const int r32 = lane & 31, hi = lane >> 5;
    f32x16 p = {};
#pragma unroll
    for (int d0 = 0; d0 < 4; ++d0) {
        const bf16x8 kf = *(const LAS bf16x8*)(lds + K_OFF + (2 * d0 + hi) * (NK * 16) + (kbase + r32) * 16);
        p = __builtin_amdgcn_mfma_f32_32x32x16_bf16(kf, qr[d0], p, 0, 0, 0);
    }
    constexpr int NR = (TYPE == 0) ? 8 : 16;
    float e[16];
#pragma unroll
    for (int r = 0; r < NR; ++r) {
        const float add = __builtin_fmaf(c1, (float)crowc(r), lanebase);
        float v = __builtin_amdgcn_exp2f(__builtin_fmaf(p[r], LOG2E, add));
        if (DIAG) { const bool ok = (TYPE == 1) ? (crowc(r) > tt) : (crowc(r) <= tt); v = ok ? v : 0.f; }
        e[r] = v; l += v;
    }
    constexpr int NS = (TYPE == 0) ? 1 : 2;
    u32x4 pw[2];
#pragma unroll
    for (int s = 0; s < NS; ++s) { pw[s].x = pk2(e[8 * s + 0], e[8 * s + 1]); pw[s].y = pk2(e[8 * s + 2], e[8 * s + 3]); pw[s].z = pk2(e[8 * s + 4], e[8 * s + 5]); pw[s].w = pk2(e[8 * s + 6], e[8 * s + 7]); }
    LAS const unsigned char* vb = lds + V_OFF + (kbase + 4 * hi + ((lane & 15) >> 2)) * 64 + ((lane >> 4) & 1) * 32 + (lane & 3) * 8;
#pragma unroll
    for (int d0 = 0; d0 < 2; ++d0)
#pragma unroll
        for (int s = 0; s < NS; ++s) {
            const s16x4 lo = vtr(vb + d0 * (NK * 64) + s * 1024), hh = vtr(vb + d0 * (NK * 64) + s * 1024 + 512);
            const bf16x8 vf = (bf16x8){lo[0], lo[1], lo[2], lo[3], hh[0], hh[1], hh[2], hh[3]};
            o[d0] = __builtin_amdgcn_mfma_f32_32x32x16_bf16(__builtin_bit_cast(bf16x8, pw[s]), vf, o[d0], 0, 0, 0);
        }
}

__device__ __forceinline__ void unit(LAS unsigned char* lds, int b, int qb, int kvh, const bf16* __restrict__ proj, const bf16* __restrict__ pmeta, const float* __restrict__ sinks, float bshift, bf16* __restrict__ yatt) {
    const int tid = threadIdx.x, lane = tid & 63, r32 = lane & 31, hi = lane >> 5; const int wave = __builtin_amdgcn_readfirstlane(tid >> 6);
    for (int idx = tid; idx < NK * 8; idx += 512) {
        const int key = idx >> 3, c = idx & 7;
        const bf16* rowp;
        if (key < 16) rowp = pmeta + (size_t)key * INW;
        else { int j = qb * 128 - 128 + (key - 16); if (j < 0) j = 0; rowp = proj + ((size_t)b * SEQ + j) * INW; }
        const u32x4 kv = *(const u32x4*)(rowp + C_AK + kvh * 64 + c * 8);
        const u32x4 vv = *(const u32x4*)(rowp + C_AV + kvh * 64 + c * 8);
        *(LAS u32x4*)(lds + K_OFF + c * (NK * 16) + key * 16) = kv;
        *(LAS u32x4*)(lds + V_OFF + (c >> 2) * (NK * 64) + key * 64 + (c & 3) * 16) = vv;
    }
    __syncthreads();
    const int h = kvh * 8 + wave;
    const float slope = exp2f(-0.5f * (float)(h + 1)), sink = sinks[h];
    const float M = fmaxf(bshift, sink);
    const float c1 = slope * LOG2E;
    LAS float* wsf = (LAS float*)(lds + WS_OFF) + wave * 64;
    LAS bf16* stg = (LAS bf16*)(lds + OST_OFF) + wave * 2048;
    for (int a = 0; a < 4; ++a) {
        const size_t qrow = (size_t)b * SEQ + qb * 128 + 32 * a + r32;
        bf16x8 qr[4];
#pragma unroll
        for (int d0 = 0; d0 < 4; ++d0) qr[d0] = *(const bf16x8*)(proj + qrow * INW + C_AQ + h * 64 + d0 * 16 + hi * 8);
        f32x16 o[2]; o[0] = f32x16{}; o[1] = f32x16{};
        float l = 0.f;
        const int t = 32 * a + r32;
        const int tt = r32 - 4 * hi;
        const float hi4 = c1 * 4.0f * (float)hi;
        tile<0, false>(lds, 0, qr, o, l, -(slope * (float)(qb * 128 + t + 16) + M) * LOG2E + hi4, c1, tt, lane);
        if (qb > 0) {
            tile<1, true>(lds, 16 + 32 * a, qr, o, l, -(slope * (float)(128 + r32) + M) * LOG2E + hi4, c1, tt, lane);
            for (int bb = a + 1; bb < 4; ++bb) tile<1, false>(lds, 16 + 32 * bb, qr, o, l, -(slope * (float)(128 + t - 32 * bb) + M) * LOG2E + hi4, c1, tt, lane);
        }
        for (int bb = 0; bb < a; ++bb) tile<2, false>(lds, 144 + 32 * bb, qr, o, l, -(slope * (float)(t - 32 * bb) + M) * LOG2E + hi4, c1, tt, lane);
        tile<2, true>(lds, 144 + 32 * a, qr, o, l, -(slope * (float)r32 + M) * LOG2E + hi4, c1, tt, lane);
        l += __shfl_xor(l, 32);
        l += exp2f((sink - M) * LOG2E);
        if (hi == 0) wsf[r32] = l;
        LDS_WAIT();
        float rli[16];
#pragma unroll
        for (int r = 0; r < 16; ++r) rli[r] = __builtin_amdgcn_rcpf(wsf[crowc(r) + 4 * hi]);
#pragma unroll
        for (int r = 0; r < 16; ++r) { const int orow = crowc(r) + 4 * hi;
#pragma unroll
            for (int d0 = 0; d0 < 2; ++d0) stg[orow * 64 + d0 * 32 + r32] = f2bf(o[d0][r] * rli[r]); }
        LDS_WAIT();
        bf16* Ow = yatt + ((size_t)b * SEQ + qb * 128 + 32 * a) * D + h * 64;
#pragma unroll
        for (int i = 0; i < 4; ++i) { const int row = i * 8 + (lane >> 3), ch = lane & 7; const u32x4 v = *(const LAS u32x4*)(stg + row * 64 + ch * 8); *(u32x4*)(Ow + (size_t)row * D + ch * 8) = v; }
        LDS_WAIT();
    }
    __syncthreads();
}
}
namespace ret {
typedef float f32x16 __attribute__((ext_vector_type(16)));
typedef short s16x4 __attribute__((ext_vector_type(4)));
constexpr size_t WS_STATES = 888 * MiB;
__device__ __forceinline__ s16x4 vtr(LAS const unsigned char* p) { return __builtin_bit_cast(s16x4, __builtin_amdgcn_ds_read_tr16_b64_v4i16((LAS s16x4*)p)); }
__device__ __forceinline__ int crowc(int r) { return (r & 3) + 8 * (r >> 2); }
__device__ __forceinline__ float lg2gamma(int h) { return log2f(1.0f - exp2f(-5.0f - (float)h)); }

constexpr int R1_BUF = 40960;
__device__ __forceinline__ void state_chain(LAS unsigned char* lds, int b, int h, int dvs, const bf16* __restrict__ proj, const bf16* __restrict__ pmeta, bf16* __restrict__ states) {
    const int tid = threadIdx.x, lane = tid & 63, hi = lane >> 5; const int wave = __builtin_amdgcn_readfirstlane(tid >> 6);
    const float lg = lg2gamma(h), g128 = exp2f(lg * 128.0f);
    u32x4 kreg[4], vreg;
#define RET_ISSUE(c_) do { const int c__ = (c_); \
        _Pragma("unroll") for (int i = 0; i < 4; ++i) { const int idx = tid + 512 * i, key = idx >> 4, ch = idx & 15; \
            if (c__ == 0) { kreg[i] = (key >= 112) ? *(const u32x4*)(pmeta + (size_t)(key - 112) * INW + C_RK + h * 128 + ch * 8) : (u32x4){0u, 0u, 0u, 0u}; } \
            else kreg[i] = *(const u32x4*)(proj + ((size_t)b * SEQ + (c__ - 1) * 128 + key) * INW + C_RK + h * 128 + ch * 8); } \
        { const int key = tid >> 2, ch = tid & 3; \
          if (c__ == 0) vreg = (key >= 112) ? *(const u32x4*)(pmeta + (size_t)(key - 112) * INW + C_RV + h * 256 + dvs * 32 + ch * 8) : (u32x4){0u, 0u, 0u, 0u}; \
          else vreg = *(const u32x4*)(proj + ((size_t)b * SEQ + (c__ - 1) * 128 + key) * INW + C_RV + h * 256 + dvs * 32 + ch * 8); } } while (0)
    const float vscale = exp2f(lg * (float)(127 - (tid >> 2)));
    f32x16 acc = {};
    RET_ISSUE(0);
    for (int c = 0; c < 32; ++c) {
        LAS unsigned char* buf = lds + (c & 1) * R1_BUF;
#pragma unroll
        for (int i = 0; i < 4; ++i) { const int idx = tid + 512 * i, key = idx >> 4, ch = idx & 15; *(LAS u32x4*)(buf + (ch >> 2) * (128 * 64) + key * 64 + (ch & 3) * 16) = kreg[i]; }
        { const int key = tid >> 2, ch = tid & 3; float f[8]; unpack8(vreg, f); u32x4 w;
          w.x = pk2(f[0] * vscale, f[1] * vscale); w.y = pk2(f[2] * vscale, f[3] * vscale); w.z = pk2(f[4] * vscale, f[5] * vscale); w.w = pk2(f[6] * vscale, f[7] * vscale);
          *(LAS u32x4*)(buf + 32768 + key * 64 + ch * 16) = w; }
        if (c + 1 < 32) RET_ISSUE(c + 1);
        __syncthreads();
        if (wave < 4) {
            const int dt = wave;
            acc = acc * g128;
            LAS const unsigned char* ab = buf + dt * (128 * 64) + (4 * hi + ((lane & 15) >> 2)) * 64 + ((lane >> 4) & 1) * 32 + (lane & 3) * 8;
            LAS const unsigned char* bb = buf + 32768 + (4 * hi + ((lane & 15) >> 2)) * 64 + ((lane >> 4) & 1) * 32 + (lane & 3) * 8;
#pragma unroll
            for (int ks = 0; ks < 8; ++ks) {
                const s16x4 al = vtr(ab + ks * 1024), ah = vtr(ab + ks * 1024 + 512), bl = vtr(bb + ks * 1024), bh = vtr(bb + ks * 1024 + 512);
                const bf16x8 af = (bf16x8){al[0], al[1], al[2], al[3], ah[0], ah[1], ah[2], ah[3]}, bfr = (bf16x8){bl[0], bl[1], bl[2], bl[3], bh[0], bh[1], bh[2], bh[3]};
                acc = __builtin_amdgcn_mfma_f32_32x32x16_bf16(af, bfr, acc, 0, 0, 0);
            }
            bf16* sb = states + ((((size_t)(b * 4 + h) * 32 + c) * 8 + dvs) * 8) * 512;
#pragma unroll
            for (int g = 0; g < 4; ++g) { u32x2 w; w.x = pk2(acc[4 * g], acc[4 * g + 1]); w.y = pk2(acc[4 * g + 2], acc[4 * g + 3]);
                *(u32x2*)(sb + (size_t)(2 * dt + (g >> 1)) * 512 + (32 * (g & 1) + (lane & 31)) * 8 + 4 * hi) = w; }
        }
    }
    __syncthreads();
#undef RET_ISSUE
}

constexpr int R3_K = 0, R3_V = 32768;
__device__ __forceinline__ void out_unit(LAS unsigned char* lds, int b, int h, int tb, const bf16* __restrict__ proj, const bf16* __restrict__ states, bf16* __restrict__ yret) {
    const int tid = threadIdx.x, lane = tid & 63, r32 = lane & 31, hi = lane >> 5; const int wave = __builtin_amdgcn_readfirstlane(tid >> 6);
    const float lg = lg2gamma(h);
    const size_t row0 = (size_t)b * SEQ + tb * 128;
    for (int idx = tid; idx < 128 * 16; idx += 512) { const int key = idx >> 4, ch = idx & 15;
        *(LAS u32x4*)(lds + R3_K + ch * (128 * 16) + key * 16) = *(const u32x4*)(proj + (row0 + key) * INW + C_RK + h * 128 + ch * 8); }
    for (int idx = tid; idx < 128 * 32; idx += 512) { const int key = idx >> 5, ch = idx & 31;
        *(LAS u32x4*)(lds + R3_V + (ch >> 2) * (128 * 64) + key * 64 + (ch & 3) * 16) = *(const u32x4*)(proj + (row0 + key) * INW + C_RV + h * 256 + ch * 8); }
    const int a = wave & 3, dvh = wave >> 2;
    bf16x8 qr[8];
#pragma unroll
    for (int k = 0; k < 8; ++k) qr[k] = *(const bf16x8*)(proj + (row0 + 32 * a + r32) * INW + C_RQ + h * 128 + k * 16 + hi * 8);
    __syncthreads();
    f32x16 o[4];
#pragma unroll
    for (int d = 0; d < 4; ++d) o[d] = f32x16{};
    const float cpos = -lg;
    const int tt = r32 - 4 * hi;
    for (int bb = 0; bb <= a; ++bb) {
        f32x16 p = {};
#pragma unroll
        for (int k = 0; k < 8; ++k) { const bf16x8 kf = *(const LAS bf16x8*)(lds + R3_K + (2 * k + hi) * (128 * 16) + (32 * bb + r32) * 16); p = __builtin_amdgcn_mfma_f32_32x32x16_bf16(kf, qr[k], p, 0, 0, 0); }
        const float lanebase = lg * (float)(32 * (a - bb) + r32 - 4 * hi);
        float e[16];
#pragma unroll
        for (int r = 0; r < 16; ++r) { float v = p[r] * __builtin_amdgcn_exp2f(__builtin_fmaf(cpos, (float)crowc(r), lanebase)); if (bb == a) v = (crowc(r) <= tt) ? v : 0.f; e[r] = v; }
        u32x4 pw[2];
#pragma unroll
        for (int s = 0; s < 2; ++s) { pw[s].x = pk2(e[8 * s + 0], e[8 * s + 1]); pw[s].y = pk2(e[8 * s + 2], e[8 * s + 3]); pw[s].z = pk2(e[8 * s + 4], e[8 * s + 5]); pw[s].w = pk2(e[8 * s + 6], e[8 * s + 7]); }
        LAS const unsigned char* vb = lds + R3_V + (32 * bb + 4 * hi + ((lane & 15) >> 2)) * 64 + ((lane >> 4) & 1) * 32 + (lane & 3) * 8;
#pragma unroll
        for (int d = 0; d < 4; ++d)
#pragma unroll
            for (int s = 0; s < 2; ++s) {
                const s16x4 lo = vtr(vb + (4 * dvh + d) * (128 * 64) + s * 1024), hh = vtr(vb + (4 * dvh + d) * (128 * 64) + s * 1024 + 512);
                const bf16x8 vf = (bf16x8){lo[0], lo[1], lo[2], lo[3], hh[0], hh[1], hh[2], hh[3]};
                o[d] = __builtin_amdgcn_mfma_f32_32x32x16_bf16(__builtin_bit_cast(bf16x8, pw[s]), vf, o[d], 0, 0, 0);
            }
    }
    {
        float din[16];
#pragma unroll
        for (int r = 0; r < 16; ++r) din[r] = __builtin_amdgcn_exp2f(lg * (float)(32 * a + crowc(r) + 4 * hi + 1));
        const bf16* sb = states + (((size_t)(b * 4 + h) * 32 + tb) * 64) * 512 + lane * 8;
#pragma unroll
        for (int d = 0; d < 4; ++d) {
            f32x16 x = {};
#pragma unroll
            for (int k = 0; k < 8; ++k) { const bf16x8 sf = *(const bf16x8*)(sb + (size_t)((4 * dvh + d) * 8 + k) * 512); x = __builtin_amdgcn_mfma_f32_32x32x16_bf16(qr[k], sf, x, 0, 0, 0); }
#pragma unroll
            for (int r = 0; r < 16; ++r) o[d][r] += din[r] * x[r];
        }
    }
    __syncthreads();
    LAS float* stg = (LAS float*)lds;
#pragma unroll
    for (int d = 0; d < 4; ++d)
#pragma unroll
        for (int r = 0; r < 16; ++r) stg[(32 * a + crowc(r) + 4 * hi) * 256 + (4 * dvh + d) * 32 + r32] = o[d][r];
    __syncthreads();
    for (int i = 0; i < 16; ++i) {
        const int q = wave * 16 + i;
        const f32x4 v = *(const LAS f32x4*)(stg + q * 256 + lane * 4);
        const float ss = wave_sum((v[0] * v[0] + v[1] * v[1]) + (v[2] * v[2] + v[3] * v[3]));
        const float rs = rsqrtf(ss * (1.0f / 256.0f) + EPS);
        const u32x2 gw = *(const u32x2*)(proj + (row0 + q) * INW + C_RG + h * 256 + lane * 4);
        u32x2 w; w.x = pk2(v[0] * rs * __uint_as_float(gw.x << 16), v[1] * rs * __uint_as_float(gw.x & 0xffff0000u)); w.y = pk2(v[2] * rs * __uint_as_float(gw.y << 16), v[3] * rs * __uint_as_float(gw.y & 0xffff0000u));
        *(u32x2*)(yret + (row0 + q) * D + h * 256 + lane * 4) = w;
    }
    __syncthreads();
}
}
__device__ __forceinline__ void p0_transpose_item(const float* W, int K, int N, bf16* WT, int k0, int n0, int dst_row0, LAS float* scr, int lane) {
#pragma unroll 8
    for (int i = 0; i < 32; ++i) { const int kk = 2 * i + (lane >> 5); scr[kk * 33 + (lane & 31)] = W[(size_t)(k0 + kk) * N + n0 + (lane & 31)]; }
    LDS_WAIT(); asm volatile("" ::: "memory");
    const int c = lane & 7;
#pragma unroll
    for (int j = 0; j < 4; ++j) { const int n = (lane >> 3) + 8 * j; const LAS float* s = scr + (8 * c) * 33 + n;
        u32x4 o; o.x = pk2(s[0 * 33], s[1 * 33]); o.y = pk2(s[2 * 33], s[3 * 33]); o.z = pk2(s[4 * 33], s[5 * 33]); o.w = pk2(s[6 * 33], s[7 * 33]);
        *(u32x4*)(WT + (size_t)(dst_row0 + n) * K + k0 + 8 * c) = o; }
    LDS_WAIT(); asm volatile("" ::: "memory");
}

struct Args { const float* in[17]; float* out; unsigned char* ws; int ph_lo, ph_hi, li, pad; };

__global__ void __launch_bounds__(512, 2) mk_fwd(Args args) {
    extern __shared__ __attribute__((aligned(16))) unsigned char lds_raw[];
    LAS unsigned char* lds = (LAS unsigned char*)lds_raw;
    volatile LAS unsigned* MISC = (volatile LAS unsigned*)(lds + MISC_OFF);
    const int tid = threadIdx.x, lane = tid & 63, wave = __builtin_amdgcn_readfirstlane(tid >> 6);
    const int G = gridDim.x, bx = blockIdx.x;
    const int vcu = (G % 8 == 0) ? (bx % 8) * (G / 8) + bx / 8 : bx;
    unsigned char* ws = args.ws;
    unsigned* ctl = (unsigned*)(ws + WS_CTL);
    const float* x = args.in[0]; const float* meta = args.in[1]; const float* g1 = args.in[2]; const float* w_in = args.in[3];
    const float* qg = args.in[4]; const float* kg = args.in[5];
    const float* w_ab = args.in[7]; const float* w_rb = args.in[8]; const float* w_out = args.in[9];
    const float* w_gu = args.in[13]; const float* b_gu = args.in[14]; const float* w_dn = args.in[15]; const float* b_dn = args.in[16];
    float* out = args.out;
    bf16* Win_t = (bf16*)(ws + WS_WIN); bf16* Wab_t = (bf16*)(ws + WS_WAB); bf16* Wrb_t = (bf16*)(ws + WS_WRB); bf16* Wout_t = (bf16*)(ws + WS_WOUT);
    bf16* Wgu_t = (bf16*)(ws + WS_WGU); bf16* Wdn_t = (bf16*)(ws + WS_WDN);
    bf16* xb = (bf16*)(ws + WS_XB); bf16* proj = (bf16*)(ws + WS_PROJ); bf16* yatt = (bf16*)(ws + WS_YATT); bf16* yret = (bf16*)(ws + WS_YRET); bf16* merged = (bf16*)(ws + WS_MERGED);
    bf16* pmeta = (bf16*)(ws + SM_PMETA);
    const float* sinks = args.in[6]; const float* g2 = args.in[10]; const float* w_r = args.in[11]; const float* b_r = args.in[12];
    int* tke = (int*)(ws + SM_TKE); float* tkw = (float*)(ws + SM_TKW); int* tkpos = (int*)(ws + SM_TKPOS); int* list = (int*)(ws + SM_LIST); float* wlist = (float*)(ws + SM_WLIST);
    LAS unsigned char* misc = lds + MISC_OFF;
    bf16* states = (bf16*)(ws + ret::WS_STATES);
    bf16* act = (bf16*)(ws + WS_ACT); bf16* rows = (bf16*)(ws + WS_ROWS);

    for (int u = tid; u < (LDS_BYTES - MISC_OFF) / 4; u += 512) ((LAS unsigned*)(lds + MISC_OFF))[u] = 0u;
    __syncthreads();
    XcdBarrier bar = xcd_barrier_post(ctl + CW_BAR + args.li * XCD_BAR_WORDS, MISC + 8);
    const int lo = args.ph_lo, hi = args.ph_hi;
#define IN(k) (lo <= (k) && (k) < hi)
#define BOTH(k) (IN(k) && IN((k) + 1))
#define GRID_BAR() xcd_barrier(bar)

    if (IN(0)) {
        LAS float* scr = (LAS float*)(lds + wave * 16384);
        const int gw = vcu * NWAVES + wave, NGW = G * NWAVES;
        constexpr int I_IN = 16 * 200, I_SQ = 16 * 32, I_GU = 32 * 16 * 64, I_DN = 32 * 16 * 32;
        constexpr int NITEMS = I_IN + 3 * I_SQ + I_GU + I_DN;
        for (int it = gw; it < NITEMS; it += NGW) {
            int r = it;
            if (r < I_IN) { const int kb = r / 200, nb = r % 200, n0 = nb * 32, o = n0 & 255, wcc = o >> 6, bj = (o >> 5) & 1;
                p0_transpose_item(w_in, D, INW, Win_t, kb * 64, n0, (n0 & ~255) + 128 * bj + 32 * wcc, scr, lane); continue; }
            r -= I_IN;
            if (r < I_SQ) { p0_transpose_item(w_ab, D, D, Wab_t, (r / 32) * 64, (r % 32) * 32, (r % 32) * 32, scr, lane); continue; } r -= I_SQ;
            if (r < I_SQ) { p0_transpose_item(w_rb, D, D, Wrb_t, (r / 32) * 64, (r % 32) * 32, (r % 32) * 32, scr, lane); continue; } r -= I_SQ;
            if (r < I_SQ) { p0_transpose_item(w_out, D, D, Wout_t, (r / 32) * 64, (r % 32) * 32, (r % 32) * 32, scr, lane); continue; } r -= I_SQ;
            if (r < I_GU) { const int e = r / 1024, q = r % 1024, kb = q / 64, nb = q % 64, n0 = nb * 32, bj = n0 >> 10, rem = n0 & 1023, pn = rem >> 7, cl = rem & 127;
                p0_transpose_item(w_gu + (size_t)e * D * 2048, D, 2048, Wgu_t + (size_t)e * 2048 * D, kb * 64, n0, 256 * pn + 128 * bj + cl, scr, lane); continue; }
            r -= I_GU;
            { const int e = r / 512, q = r % 512, kb = q / 32, nb = q % 32;
              p0_transpose_item(w_dn + (size_t)e * DFF * D, DFF, D, Wdn_t + (size_t)e * D * DFF, kb * 64, nb * 32, nb * 32, scr, lane); }
        }
        for (int row = gw; row < NTOK; row += NGW) {
            const f32x4* xr = (const f32x4*)(x + (size_t)row * D) + lane;
            f32x4 v[4]; float ss = 0.f;
#pragma unroll
            for (int j = 0; j < 4; ++j) { v[j] = xr[64 * j]; ss += (v[j][0] * v[j][0] + v[j][1] * v[j][1]) + (v[j][2] * v[j][2] + v[j][3] * v[j][3]); }
            const float rstd = rsqrtf(wave_sum(ss) * (1.0f / D) + EPS);
            u32x2* o8 = (u32x2*)(xb + (size_t)row * D) + lane;
#pragma unroll
            for (int j = 0; j < 4; ++j) { const f32x4 gg = ((const f32x4*)g1)[64 * j + lane]; u32x2 w; w.x = pk2(v[j][0] * rstd * gg[0], v[j][1] * rstd * gg[1]); w.y = pk2(v[j][2] * rstd * gg[2], v[j][3] * rstd * gg[3]); o8[64 * j] = w; }
        }
        __syncthreads();
        for (int item = vcu; item < 28; item += G) {
            const int c0 = (item < 4) ? 1024 + 64 * item : 1792 + 64 * (item - 4);
            LAS float* red = (LAS float*)lds;
            LAS float* rst = (LAS float*)(lds + 32768);
            {
#pragma unroll
              for (int q = 0; q < 2; ++q) { const int r = 2 * wave + q; float ss = 0.f;
                for (int j = 0; j < 4; ++j) { const f32x4 v = ((const f32x4*)(meta + (size_t)r * D))[64 * j + lane]; ss += v[0] * v[0] + v[1] * v[1] + v[2] * v[2] + v[3] * v[3]; }
                ss = wave_sum(ss); if (lane == 0) rst[r] = rsqrtf(ss * (1.0f / D) + EPS); } }
            __syncthreads();
            float a[16];
#pragma unroll
            for (int r = 0; r < 16; ++r) a[r] = 0.f;
            for (int k = wave * 128; k < wave * 128 + 128; ++k) {
                const float w = w_in[(size_t)k * INW + c0 + lane]; const float gk = g1[k];
#pragma unroll
                for (int r = 0; r < 16; ++r) a[r] += bf2f(f2bf(meta[(size_t)r * D + k] * rst[r] * gk)) * w;
            }
#pragma unroll
            for (int r = 0; r < 16; ++r) red[(wave * 16 + r) * 64 + lane] = a[r];
            __syncthreads();
#pragma unroll
            for (int q = 0; q < 2; ++q) { const int r = 2 * wave + q; float v = 0.f;
#pragma unroll
                for (int w8 = 0; w8 < 8; ++w8) v += red[(w8 * 16 + r) * 64 + lane];
                if (item < 2) { const float ss = wave_sum(v * v); v = v * rsqrtf(ss * (1.0f / 64.0f) + EPS) * kg[lane]; }
                else if (item >= 4 && item < 12) v *= 0.08838834764831845f;
                pmeta[(size_t)r * INW + c0 + lane] = f2bf(v); }
            __syncthreads();
        }
        if (BOTH(0)) GRID_BAR();
    }
    if (IN(1)) {
        SchedDense S; S.init(xb, Win_t, NTOK, INW, D, G, bx);
        EpiProj E{proj, qg, kg};
        pg8::gemm_phase<EpiProj, SchedDense>(lds, D, S, E);
        if (BOTH(1)) GRID_BAR();
    }
    if (IN(2)) {
        float mq = fabsf(qg[lane]), mk = fabsf(kg[lane]);
#pragma unroll
        for (int o = 1; o < 64; o <<= 1) { mq = fmaxf(mq, __shfl_xor(mq, o)); mk = fmaxf(mk, __shfl_xor(mk, o)); }
        const float bshift = 8.0f * mq * mk;
        for (int u = bx; u < NB * 32 * 2; u += G) attn::unit(lds, u >> 6, (u >> 1) & 31, u & 1, proj, pmeta, sinks, bshift, yatt);
        for (int u = bx; u < NB * 4 * 8; u += G) ret::state_chain(lds, u >> 5, (u >> 3) & 3, u & 7, proj, pmeta, states);
        if (BOTH(2)) GRID_BAR();
    }
    if (IN(3)) {
        for (int u = bx; u < NB * 4 * 32; u += G) ret::out_unit(lds, u >> 7, (u >> 5) & 3, u & 31, proj, states, yret);
        if (BOTH(3)) GRID_BAR();
    }
    if (IN(4)) {
        SchedBranch S{(const char*)yatt, (const char*)yret, (const char*)Wab_t, (const char*)Wrb_t, G, bx};
        EpiBranch E{merged, proj};
        pg8::gemm_phase<EpiBranch, SchedBranch>(lds, D, S, E);
        if (BOTH(4)) GRID_BAR();
    }
    if (IN(5)) {
        SchedDense S; S.init(merged, Wout_t, NTOK, D, D, G, bx);
        EpiOut E{x, out};
        pg8::gemm_phase<EpiOut, SchedDense>(lds, D, S, E);
        if (BOTH(5)) GRID_BAR();
    }
    if (IN(6)) {
        route_phase(lds, out, g2, w_r, b_r, xb, tke, tkpos, tkw, list, wlist, ctl + CW_CNT, G, bx);
        if (BOTH(6)) GRID_BAR();
    }
    if (hi > 7 && lo <= 9) moe_tables(misc, ctl + CW_CNT);
    if (IN(7)) {
        SchedMoe<true, 8> S{(const char*)xb, (const char*)Wgu_t, misc, list, G, bx};
        EpiGU E{act, b_gu};
        pg8::gemm_phase<EpiGU, SchedMoe<true, 8>>(lds, D, S, E);
        if (BOTH(7)) GRID_BAR();
    }
    if (IN(8)) {
        SchedMoe<false, 4> S{(const char*)act, (const char*)Wdn_t, misc, list, G, bx};
        EpiDown E{rows, b_dn, wlist, misc};
        pg8::gemm_phase<EpiDown, SchedMoe<false, 4>>(lds, DFF, S, E);
        if (BOTH(8)) GRID_BAR();
    }
    if (IN(9)) combine_phase(misc, out, rows, tke, tkpos, vcu * NWAVES + wave, G * NWAVES, lane);
#undef IN
#undef BOTH
#undef GRID_BAR
}

extern "C" void kernel_launch(void* const* d_in, const int* in_sizes, int n_in, void* d_out, int out_size, void* d_ws, size_t ws_size, hipStream_t stream) {
    static int grid = 0;
    if (grid == 0) {
        if (n_in != 17 || in_sizes[0] != NTOK * D || out_size != NTOK * D || ws_size < WS_END) {
            fprintf(stderr, "kernel_launch: unexpected shapes (n_in %d in0 %d out %d ws %zu)\n", n_in, n_in > 0 ? in_sizes[0] : -1, out_size, ws_size); grid = -1; return; }
        int dev = 0, cus = 0;
        if (hipGetDevice(&dev) != hipSuccess || hipDeviceGetAttribute(&cus, hipDeviceAttributeMultiprocessorCount, dev) != hipSuccess) { grid = -1; return; }
        if (hipFuncSetAttribute((const void*)mk_fwd, hipFuncAttributeMaxDynamicSharedMemorySize, LDS_BYTES) != hipSuccess) { fprintf(stderr, "kernel_launch: hipFuncSetAttribute failed\n"); grid = -1; return; }
        grid = cus;
    }
    if (grid < 0) return;
    unsigned char* ws = (unsigned char*)d_ws;
    (void)hipMemsetAsync(ws + WS_CTL, 0, 1 * MiB, stream);
    Args a{};
    for (int i = 0; i < 17; ++i) a.in[i] = (const float*)d_in[i];
    a.out = (float*)d_out; a.ws = ws; a.ph_lo = 0; a.ph_hi = 10; a.li = 0; a.pad = 0;
    hipLaunchKernelGGL(mk_fwd, dim3(grid), dim3(512), LDS_BYTES, stream, a);
}
```

```cpp
#include <hip/hip_runtime.h>
#include <cstdio>
#include <cstdint>

typedef unsigned short bf16;
__device__ __forceinline__ float bf2f(bf16 v) { return __uint_as_float(((unsigned)v) << 16); }
__device__ __forceinline__ bf16 f2bf(float f) { unsigned u = __float_as_uint(f); return (bf16)((u + 0x7fffu + ((u >> 16) & 1u)) >> 16); }
__device__ __forceinline__ float sigmoidf_(float x) { return 1.0f / (1.0f + __expf(-x)); }

constexpr int NB = 8, SEQ = 4096, D = 1024, NTOK = NB * SEQ;
constexpr int NMETA = 16;
constexpr int INW = 6400;
constexpr int C_AQ = 0, C_AK = 1024, C_AV = 1152, C_RQ = 1280, C_RK = 1792, C_RV = 2304, C_RG = 3328, C_GA = 4352, C_GR = 5376;
constexpr int NE = 32, TOPK = 4, DFF = 1024;
constexpr int NROWS = (NTOK * TOPK / 256 + NE) * 256;
constexpr int NTILE = NROWS / 256;
constexpr float EPS = 1e-5f;

constexpr size_t MiB = 1u << 20;
constexpr size_t WS_CTL = 0;
constexpr size_t WS_SMALL = 1 * MiB;
constexpr size_t WS_W = 16 * MiB;
constexpr size_t WS_XB = 232 * MiB;
constexpr size_t WS_PROJ = 296 * MiB;
constexpr size_t WS_YATT = 696 * MiB;
constexpr size_t WS_YRET = 760 * MiB;
constexpr size_t WS_MERGED = 824 * MiB;
constexpr size_t WS_END = 1020 * MiB;
constexpr size_t WS_ACT = 296 * MiB;
constexpr size_t WS_ROWS = 568 * MiB;
constexpr size_t SM_UMETA = WS_SMALL;
constexpr size_t SM_PMETA = WS_SMALL + 64 * 1024;
constexpr size_t SM_TKE = WS_SMALL + 512 * 1024;
constexpr size_t SM_TKW = SM_TKE + 512 * 1024;
constexpr size_t SM_TKPOS = SM_TKW + 512 * 1024;
constexpr size_t SM_TKROW = SM_TKPOS + 512 * 1024;
constexpr size_t SM_ROWTOK = SM_TKROW + 512 * 1024;
constexpr size_t SM_ROWW = SM_ROWTOK + 1024 * 1024;
constexpr size_t SM_TILEE = SM_ROWW + 1024 * 1024;
constexpr int CW_CNT = 1024;

#define LAS __attribute__((address_space(3)))
#define GAS __attribute__((address_space(1)))
typedef short bf16x8 __attribute__((ext_vector_type(8)));
typedef float f32x4 __attribute__((ext_vector_type(4)));
typedef float f32x2 __attribute__((ext_vector_type(2)));
typedef unsigned u32x4 __attribute__((ext_vector_type(4)));
typedef unsigned u32x2 __attribute__((ext_vector_type(2)));
#define LDS_WAIT() asm volatile("s_waitcnt lgkmcnt(0)" ::: "memory")
#define VM_WAIT() asm volatile("s_waitcnt vmcnt(0)" ::: "memory")
__device__ __forceinline__ unsigned pk2(float lo, float hi) { return (unsigned)f2bf(lo) | ((unsigned)f2bf(hi) << 16); }
__device__ __forceinline__ unsigned pk4_fp8(float a, float b, float c, float d) { int w = __builtin_amdgcn_cvt_pk_fp8_f32(a, b, 0, false); w = __builtin_amdgcn_cvt_pk_fp8_f32(c, d, w, true); return (unsigned)w; }
constexpr float W8_SCALE = 64.0f, W8_INV = 1.0f / 64.0f;
__device__ __forceinline__ float wave_sum(float v) {
#pragma unroll
    for (int o = 1; o < 64; o <<= 1) v += __shfl_xor(v, o);
    return v;
}

constexpr size_t WS_WIN = WS_W;
constexpr size_t WS_WAB = WS_W + 13 * MiB;
constexpr size_t WS_WRB = WS_W + 15 * MiB;
constexpr size_t WS_WOUT = WS_W + 17 * MiB;
constexpr size_t WS_WGU = WS_W + 19 * MiB;
constexpr size_t WS_WDN = WS_W + 147 * MiB;
static_assert(WS_WDN + 64 * MiB <= WS_XB, "weight map");
constexpr size_t SM_ATILE = SM_TILEE + 4096;
constexpr int CW_NACT = 1088;
constexpr int CW_BAR = 4096;

constexpr int RING_BYTES = 131072;
constexpr int MISC_OFF = RING_BYTES;
constexpr int LDS_BYTES = 147456;
constexpr int NWAVES = 8;

#define XB_TMO      128
#define XB_XCNT(j)  (256  + 64 * (j))
#define XB_XSUB(j)  (1280 + 64 * (j))
#define XB_XGEN(j)  (2304 + 64 * (j))
#define XB_TOP      3328
#define XB_TOPGEN   3392
#define XCD_BAR_WORDS 3456
#define XB_SPIN_CAP (1u << 20)
__device__ __forceinline__ unsigned xb_ld(unsigned* p)              { return __hip_atomic_load(p, __ATOMIC_RELAXED, __HIP_MEMORY_SCOPE_AGENT); }
__device__ __forceinline__ unsigned xb_add(unsigned* p, unsigned v) { return __hip_atomic_fetch_add(p, v, __ATOMIC_RELAXED, __HIP_MEMORY_SCOPE_AGENT); }
__device__ __forceinline__ unsigned xb_xcc_id() { return (unsigned)__builtin_amdgcn_s_getreg((3 << 11) | 20) & 0xFu; }
#define XB_SPIN(cond, bar) do { unsigned _sp = 0; while (cond) { __builtin_amdgcn_s_sleep(1); \
    if ((++_sp & 255u) == 0u) { if (xb_ld(&(bar)[XB_TMO])) break; if (_sp > XB_SPIN_CAP) { atomicAdd(&(bar)[XB_TMO], 1u); break; } } } } while (0)
struct XcdBarrier { unsigned* bar; unsigned x; volatile LAS unsigned* st; };
__device__ __forceinline__ XcdBarrier xcd_barrier_post(unsigned* bar, volatile LAS unsigned* st) {
    XcdBarrier b; b.bar = bar; b.x = xb_xcc_id(); b.st = st;
    if (threadIdx.x == 0) (void)xb_add(&bar[XB_XCNT(b.x)], 1u);
    return b;
}
__device__ __forceinline__ void xcd_barrier_complete(unsigned* bar, unsigned x, unsigned& nloc, unsigned& nx) {
    const unsigned G = gridDim.x * gridDim.y * gridDim.z;
    unsigned sum, cnt, mine, sp = 0u;
    for (;;) {
        sum = 0u; cnt = 0u; mine = 0u;
#pragma unroll
        for (unsigned j = 0; j < 16; ++j) { const unsigned c = xb_ld(&bar[XB_XCNT(j)]); sum += c; cnt += (c > 0u) ? 1u : 0u; mine = (j == x) ? c : mine; }
        if (sum == G) break;
        __builtin_amdgcn_s_sleep(1);
        if ((++sp & 255u) == 0u) { if (xb_ld(&bar[XB_TMO])) break; if (sp > XB_SPIN_CAP) { atomicAdd(&bar[XB_TMO], 1u); break; } }
    }
    nloc = mine > 0u ? mine : 1u; nx = cnt > 0u ? cnt : 1u;
}
__device__ __forceinline__ void xcd_barrier(const XcdBarrier& b) {
    asm volatile("s_waitcnt vmcnt(0)" ::: "memory");
    __syncthreads();
    if (threadIdx.x == 0) {
        unsigned* bar = b.bar;
        __builtin_amdgcn_s_waitcnt(0);
        unsigned nloc = b.st[0], nx = b.st[1];
        if (nloc == 0u) { xcd_barrier_complete(bar, b.x, nloc, nx); b.st[0] = nloc; b.st[1] = nx; }
        const unsigned old = xb_add(&bar[XB_XSUB(b.x)], 1u);
        const unsigned gen = old / nloc;
        if (old + 1u == (gen + 1u) * nloc) {
            __builtin_amdgcn_fence(__ATOMIC_RELEASE, "agent");
            asm volatile("s_waitcnt vmcnt(0)" ::: "memory");
            const unsigned og = xb_add(&bar[XB_TOP], 1u);
            const unsigned tg = og / nx;
            if (og + 1u == (tg + 1u) * nx) xb_add(&bar[XB_TOPGEN], 1u);
            else XB_SPIN(xb_ld(&bar[XB_TOPGEN]) == tg, bar);
            __builtin_amdgcn_fence(__ATOMIC_ACQUIRE, "agent");
            xb_add(&bar[XB_XGEN(b.x)], 1u);
            asm volatile("s_waitcnt vmcnt(0)" ::: "memory");
        } else {
            XB_SPIN(xb_ld(&bar[XB_XGEN(b.x)]) == gen, bar);
            __builtin_amdgcn_fence(__ATOMIC_ACQUIRE, "agent");
            asm volatile("s_waitcnt vmcnt(0)" ::: "memory");
        }
    }
    __syncthreads();
}

namespace pg8 {
constexpr int BM = 256, BK = 64, HALF = 128, HTB = HALF * BK * 2, STAGE_BYTES = 8 * HTB;
__host__ __device__ __forceinline__ int lds_byte(int r, int c) { const int st = (r >> 4) * 2 + (c >> 5), rr = r & 15, cc = c & 31, ob = rr * 64 + cc * 2; return st * 1024 + (ob ^ (((ob >> 9) & 1) << 5)); }
__host__ __device__ __forceinline__ void stage_rc(int b, int& R, int& C) { const int st = b / 1024, sb = b % 1024, swz = sb ^ (((sb >> 9) & 1) << 5); R = (st >> 1) * 16 + swz / 64; C = (st & 1) * 32 + (swz % 64) / 2; }
__host__ __device__ __forceinline__ int perm32(int rho) { const int n = rho >> 4, i = rho & 15; return 8 * (i >> 2) + 4 * n + (i & 3); }
struct Unit { int pm, pn, aux, tl; const char* A; const char* B; };
typedef f32x4 Acc[2][2][4][2];
typedef int u32x4_i __attribute__((ext_vector_type(4)));

typedef int v8i32 __attribute__((ext_vector_type(8)));
template <class Epi, class Sched, bool FP8 = false>
__device__ __forceinline__ void gemm_phase(LAS unsigned char* lds, const int Kb, const Sched& S, const Epi& E) {
    const int tid = threadIdx.x, wid = __builtin_amdgcn_readfirstlane(tid >> 6), lane = tid & 63, wr = wid >> 2, wc = wid & 3, fr = lane & 15, fq = lane >> 4;
    const int nt = Kb / 128;
    int RA[2], CA[2]; unsigned voffB[2];
#pragma unroll
    for (int i = 0; i < 2; ++i) { int R, C; stage_rc(tid * 16 + i * 8192, R, C); const int Rb = Epi::PERM ? ((R & ~31) + perm32(R & 31)) : R;
        RA[i] = R; CA[i] = C; voffB[i] = (unsigned)(Rb * Kb + C * 2); }
    const size_t kstep = (size_t)(BK * 2);
    const size_t hstep = (size_t)HALF * Kb;
    const unsigned ldsw = (unsigned)wid * 1024u;
    const int aoff = lds_byte(wr * 64 + fr, fq * 8), boff = lds_byte(wc * 32 + fr, fq * 8);
#define PG8_SA(b, h) (((b) * 2 + (h)) * HTB)
#define PG8_SB(b, h) ((4 + (b) * 2 + (h)) * HTB)
#define PG8_STAGE(bufoff, gbase, voff) do { _Pragma("unroll") for (int _i = 0; _i < 2; ++_i) \
        __builtin_amdgcn_global_load_lds((const unsigned*)((const char*)(gbase) + (voff)[_i]), (LAS unsigned*)(lds + (bufoff) + ldsw + _i * 8192), 16, 0, 0); } while (0)
#define PG8_LDA(dst, b, h) do { _Pragma("unroll") for (int m = 0; m < 4; ++m) _Pragma("unroll") for (int k = 0; k < 2; ++k) dst[m][k] = *(const LAS bf16x8*)(lds + PG8_SA(b, h) + aoff + m * 2048 + k * 1024); } while (0)
#define PG8_LDB(dst, b, h) do { _Pragma("unroll") for (int n = 0; n < 2; ++n) _Pragma("unroll") for (int k = 0; k < 2; ++k) dst[n][k] = *(const LAS bf16x8*)(lds + PG8_SB(b, h) + boff + n * 2048 + k * 1024); } while (0)
#define PG8_MMA(ai, bj, At, Bt) do { __builtin_amdgcn_s_setprio(1); _Pragma("unroll") for (int m = 0; m < 4; ++m) _Pragma("unroll") for (int n = 0; n < 2; ++n) { \
        if constexpr (FP8) { const v8i32 bq = __builtin_shufflevector(__builtin_bit_cast(u32x4_i, Bt[n][0]), __builtin_bit_cast(u32x4_i, Bt[n][1]), 0, 1, 2, 3, 4, 5, 6, 7), \
                                         aq = __builtin_shufflevector(__builtin_bit_cast(u32x4_i, At[m][0]), __builtin_bit_cast(u32x4_i, At[m][1]), 0, 1, 2, 3, 4, 5, 6, 7); \
            asm volatile("v_mfma_scale_f32_16x16x128_f8f6f4 %0, %1, %2, %0, %3, %3 op_sel_hi:[0,0,0]" : "+v"(acc[ai][bj][m][n]) : "v"(bq), "v"(aq), "v"(scale1)); } \
        else { _Pragma("unroll") for (int k = 0; k < 2; ++k) acc[ai][bj][m][n] = __builtin_amdgcn_mfma_f32_16x16x32_bf16(Bt[n][k], At[m][k], acc[ai][bj][m][n], 0, 0, 0); } } \
        __builtin_amdgcn_s_setprio(0); } while (0)
#define PG8_WAIT_V(n) asm volatile("s_waitcnt vmcnt(" #n ")" ::: "memory")
#define PG8_WAIT_L(n) asm volatile("s_waitcnt lgkmcnt(" #n ")" ::: "memory")
#define PG8_BAR __builtin_amdgcn_s_barrier()
#define PG8_SCHED __builtin_amdgcn_sched_barrier(0)
    int scale1 = 0x7f7f7f7f; asm volatile("" : "+v"(scale1));
    Unit cur, nxt; int ui = 0;
    if (!S.next(0, cur)) return;
    unsigned ca[2][2], na[2][2];
    S.aoff(cur, RA, CA, ca);
    f32x4 acc[2][2][4][2];
#pragma unroll
    for (int a = 0; a < 2; ++a)
#pragma unroll
        for (int b = 0; b < 2; ++b)
#pragma unroll
            for (int m = 0; m < 4; ++m)
#pragma unroll
                for (int n = 0; n < 2; ++n) acc[a][b][m][n] = (f32x4){0.f, 0.f, 0.f, 0.f};
    bf16x8 At[4][2], B0[2][2], B1[2][2];
    const char* cA = cur.A; const char* cB = cur.B;
    PG8_STAGE(PG8_SB(0, 0), cB, voffB); PG8_STAGE(PG8_SB(0, 1), cB + hstep, voffB); PG8_STAGE(PG8_SA(0, 0), cA, ca[0]); PG8_STAGE(PG8_SA(0, 1), cA, ca[1]);
    if (wr == 1) PG8_BAR;
    PG8_WAIT_V(2); PG8_BAR;
    PG8_STAGE(PG8_SB(1, 0), cB + kstep, voffB); PG8_STAGE(PG8_SA(1, 0), cA + kstep, ca[0]); PG8_STAGE(PG8_SB(1, 1), cB + hstep + kstep, voffB);
    PG8_WAIT_V(6); PG8_BAR;
    for (;;) {
        const bool has_next = S.next(ui + 1, nxt);
        if constexpr (Sched::GATHER) {
            if (has_next) S.aoff(nxt, RA, CA, na);
            else {
#pragma unroll
                for (int h = 0; h < 2; ++h)
#pragma unroll
                    for (int i = 0; i < 2; ++i) na[h][i] = ca[h][i];
            }
        }
        const char* nA = has_next ? nxt.A : cA; const char* nB = has_next ? nxt.B : cB;
#pragma nounroll
        for (int t = 0; t < nt; t += 2) {
            const bool last = (t == nt - 2);
            const char* a1 = cA + (size_t)(t + 1) * kstep;
            const char* a2 = last ? nA : cA + (size_t)(t + 2) * kstep; const char* b2 = last ? nB : cB + (size_t)(t + 2) * kstep;
            const char* a3 = a2 + kstep; const char* b3 = b2 + kstep;
            unsigned o2[2][2];
#pragma unroll
            for (int h = 0; h < 2; ++h)
#pragma unroll
                for (int i = 0; i < 2; ++i) { if constexpr (Sched::GATHER) o2[h][i] = last ? na[h][i] : ca[h][i]; else o2[h][i] = ca[h][i]; }
            PG8_LDB(B0, 0, 0); PG8_LDB(B1, 0, 1); PG8_SCHED; PG8_LDA(At, 0, 0); PG8_STAGE(PG8_SA(1, 1), a1, ca[1]);
            PG8_WAIT_V(8); PG8_WAIT_L(0); PG8_BAR; PG8_MMA(0, 0, At, B0); PG8_MMA(0, 1, At, B1); PG8_BAR; PG8_SCHED;
            PG8_LDA(At, 0, 1); PG8_STAGE(PG8_SB(0, 0), b2, voffB); PG8_STAGE(PG8_SB(0, 1), b2 + hstep, voffB); PG8_STAGE(PG8_SA(0, 0), a2, o2[0]);
            PG8_WAIT_V(8); PG8_WAIT_L(0); PG8_BAR; PG8_MMA(1, 0, At, B0); PG8_MMA(1, 1, At, B1); PG8_BAR; PG8_SCHED;
            PG8_LDB(B0, 1, 0); PG8_LDB(B1, 1, 1); PG8_SCHED; PG8_LDA(At, 1, 0); PG8_STAGE(PG8_SA(0, 1), a2, o2[1]);
            PG8_WAIT_V(8); PG8_WAIT_L(0); PG8_BAR; PG8_MMA(0, 0, At, B0); PG8_MMA(0, 1, At, B1); PG8_BAR; PG8_SCHED;
            PG8_LDA(At, 1, 1); PG8_STAGE(PG8_SB(1, 0), b3, voffB); PG8_STAGE(PG8_SB(1, 1), b3 + hstep, voffB); PG8_STAGE(PG8_SA(1, 0), a3, o2[0]);
            PG8_WAIT_V(8); PG8_WAIT_L(0); PG8_BAR; PG8_MMA(1, 0, At, B0); PG8_MMA(1, 1, At, B1); PG8_BAR; PG8_SCHED;
        }
        if constexpr (FP8) { asm volatile("s_nop 15\n\ts_nop 15\n\ts_nop 15" ::: "memory"); PG8_SCHED; }
        if (wr == 0) PG8_BAR;
        E(acc, cur, wr, wc, fr, fq);
        if (!has_next) break;
#pragma unroll
        for (int a = 0; a < 2; ++a)
#pragma unroll
            for (int b = 0; b < 2; ++b)
#pragma unroll
                for (int m = 0; m < 4; ++m)
#pragma unroll
                    for (int n = 0; n < 2; ++n) acc[a][b][m][n] = (f32x4){0.f, 0.f, 0.f, 0.f};
        cur = nxt; cA = nA; cB = nB; ++ui;
        if constexpr (Sched::GATHER) {
#pragma unroll
            for (int h = 0; h < 2; ++h)
#pragma unroll
                for (int i = 0; i < 2; ++i) ca[h][i] = na[h][i];
        }
        if (wr == 1) PG8_BAR;
    }
    PG8_WAIT_V(0);
    PG8_BAR;
#undef PG8_SA
#undef PG8_SB
#undef PG8_STAGE
#undef PG8_LDA
#undef PG8_LDB
#undef PG8_MMA
#undef PG8_WAIT_V
#undef PG8_WAIT_L
#undef PG8_BAR
#undef PG8_SCHED
}
}
constexpr size_t SM_LIST = WS_SMALL + 5 * MiB;
constexpr size_t SM_WLIST = WS_SMALL + 9 * MiB;
constexpr int MT_PSTART = 256;
constexpr int MT_CNT = 512;
constexpr int MT_NACT = 768;
constexpr int MT_ATILE = 1024;
constexpr int MT_HIST = 4096;
constexpr int MT_BASE = 4224;
constexpr int MT_REC = 4352;

__device__ __forceinline__ void moe_tables(LAS unsigned char* misc, const unsigned* cnt) {
    LAS int* pstart = (LAS int*)(misc + MT_PSTART); LAS int* cl = (LAS int*)(misc + MT_CNT); LAS int* at = (LAS int*)(misc + MT_ATILE);
    __syncthreads();
    if (threadIdx.x < 64) {
        const int lane = threadIdx.x, e = lane & 31;
        const int c = (int)__hip_atomic_load(cnt + e, __ATOMIC_RELAXED, __HIP_MEMORY_SCOPE_AGENT), nt = (c + 255) >> 8;
        int incl = nt;
#pragma unroll
        for (int o = 1; o < 32; o <<= 1) { const int v = __shfl_up(incl, o); if (e >= o) incl += v; }
        const int t0 = incl - nt;
        if (lane < 32) { cl[e] = c; pstart[e] = t0 << 8; for (int t = 0; t < nt; ++t) at[t0 + t] = (t0 + t) | (e << 12) | (t << 20);
            if (e == 31) { pstart[NE] = incl << 8; *(LAS int*)(misc + MT_NACT) = incl; } }
    }
    __syncthreads();
}

template <int N, int XR>
__device__ __forceinline__ void tr_step(float (&v)[64], int lane) {
    const bool up = (lane & XR) != 0;
#pragma unroll
    for (int i = 0; i < N; ++i) { const float keep = up ? v[i + N] : v[i], send = up ? v[i] : v[i + N]; v[i] = keep + __shfl_xor(send, XR); }
}

__device__ __forceinline__ void route_phase(LAS unsigned char* lds, const float* __restrict__ h2, const float* __restrict__ g2, const float* __restrict__ wr, const float* __restrict__ br,
                                            unsigned char* __restrict__ xn2, int* __restrict__ tke, int* __restrict__ tkpos, float* __restrict__ tkw, int* __restrict__ list, float* __restrict__ wlist,
                                            unsigned* __restrict__ cnt, int G, int bx) {
    const int tid = threadIdx.x, lane = tid & 63; const int wave = __builtin_amdgcn_readfirstlane(tid >> 6);
    LAS float* wT = (LAS float*)lds;
    LAS unsigned char* misc = lds + MISC_OFF;
    LAS int* hist = (LAS int*)(misc + MT_HIST); LAS int* base = (LAS int*)(misc + MT_BASE); LAS int* rec = (LAS int*)(misc + MT_REC);
    for (int idx = tid; idx < NE * D; idx += 512) { const int e = idx >> 10, k = idx & 1023; wT[idx] = wr[(size_t)k * NE + e]; }
    const float bias = br[lane & 31];
    for (int tb = bx; tb < NTOK / 128; tb += G) {
        if (tid < 32) hist[tid] = 0;
        __syncthreads();
        for (int pp = 0; pp < 8; ++pp) {
            const int tl0 = wave * 16 + pp * 2;
            const int row0 = tb * 128 + tl0;
            float xv[2][16];
#pragma unroll
            for (int t = 0; t < 2; ++t) {
                const f32x4* xr = (const f32x4*)(h2 + (size_t)(row0 + t) * D) + lane;
                float ss = 0.f; f32x4 v[4];
#pragma unroll
                for (int j = 0; j < 4; ++j) { v[j] = xr[64 * j]; ss += (v[j][0] * v[j][0] + v[j][1] * v[j][1]) + (v[j][2] * v[j][2] + v[j][3] * v[j][3]); }
                const float rstd = rsqrtf(wave_sum(ss) * (1.0f / D) + EPS);
                unsigned* o4 = (unsigned*)(xn2 + (size_t)(row0 + t) * D) + lane;
#pragma unroll
                for (int j = 0; j < 4; ++j) { const f32x4 gg = ((const f32x4*)g2)[64 * j + lane];
#pragma unroll
                    for (int q = 0; q < 4; ++q) xv[t][4 * j + q] = v[j][q] * rstd * gg[q];
                    o4[64 * j] = pk4_fp8(xv[t][4 * j], xv[t][4 * j + 1], xv[t][4 * j + 2], xv[t][4 * j + 3]); }
            }
            float acc[64];
#pragma unroll
            for (int i = 0; i < 64; ++i) acc[i] = 0.f;
#pragma unroll
            for (int e = 0; e < 32; ++e)
#pragma unroll
                for (int j = 0; j < 4; ++j) {
                    const f32x4 w = *(const LAS f32x4*)(wT + e * 1024 + (64 * j + lane) * 4);
                    acc[e] += (xv[0][4 * j] * w[0] + xv[0][4 * j + 1] * w[1]) + (xv[0][4 * j + 2] * w[2] + xv[0][4 * j + 3] * w[3]);
                    acc[32 + e] += (xv[1][4 * j] * w[0] + xv[1][4 * j + 1] * w[1]) + (xv[1][4 * j + 2] * w[2] + xv[1][4 * j + 3] * w[3]);
                }
            tr_step<32, 32>(acc, lane); tr_step<16, 16>(acc, lane); tr_step<8, 8>(acc, lane); tr_step<4, 4>(acc, lane); tr_step<2, 2>(acc, lane); tr_step<1, 1>(acc, lane);
            const float logit = acc[0] + bias;
            float cur = logit, m0 = 0.f; int myrank = -1;
#pragma unroll
            for (int k = 0; k < 4; ++k) {
                float m = cur;
#pragma unroll
                for (int o = 1; o < 32; o <<= 1) m = fmaxf(m, __shfl_xor(m, o));
                if (k == 0) m0 = m;
                const unsigned long long mask = __ballot(cur == m);
                const unsigned half = (lane < 32) ? (unsigned)mask : (unsigned)(mask >> 32);
                const int sel = __ffs(half) - 1;
                if ((lane & 31) == sel) { myrank = k; cur = -3.0e38f; }
            }
            float ex = (myrank >= 0) ? __expf(logit - m0) : 0.f, sum = ex;
#pragma unroll
            for (int o = 1; o < 32; o <<= 1) sum += __shfl_xor(sum, o);
            if (myrank >= 0) {
                const int e = lane & 31, tl = tl0 + (lane >> 5);
                const int lp = __hip_atomic_fetch_add(hist + e, 1, __ATOMIC_RELAXED, __HIP_MEMORY_SCOPE_WORKGROUP);
                LAS int* r = rec + (tl * 4 + myrank) * 3; r[0] = e; r[1] = lp; r[2] = __float_as_int(ex / sum);
            }
        }
        __syncthreads();
        if (tid < 32) base[tid] = (int)atomicAdd(&cnt[tid], (unsigned)hist[tid]);
        __syncthreads();
        { const int tl = tid >> 2; const int token = tb * 128 + tl; LAS int* r = rec + tid * 3; const int e = r[0], pos = base[e] + r[1]; const float w = __int_as_float(r[2]);
          tke[token * 4 + (tid & 3)] = e; tkpos[token * 4 + (tid & 3)] = pos; tkw[token * 4 + (tid & 3)] = w;
          list[e * NTOK + pos] = token; wlist[e * NTOK + pos] = w; }
        __syncthreads();
    }
}

__device__ __forceinline__ void combine_phase(LAS unsigned char* misc, float* __restrict__ out, const bf16* __restrict__ rows, const int* __restrict__ tke, const int* __restrict__ tkpos, int gw, int NGW, int lane) {
    LAS const int* pstart = (LAS const int*)(misc + MT_PSTART);
    for (int token = gw; token < NTOK; token += NGW) {
        int rr[4];
#pragma unroll
        for (int k = 0; k < 4; ++k) rr[k] = pstart[tke[token * 4 + k]] + tkpos[token * 4 + k];
        f32x4* o = (f32x4*)(out + (size_t)token * D) + lane;
        f32x4 v[4];
#pragma unroll
        for (int j = 0; j < 4; ++j) v[j] = o[64 * j];
#pragma unroll
        for (int k = 0; k < 4; ++k) {
            const u32x2* rp = (const u32x2*)(rows + (size_t)rr[k] * D) + lane;
#pragma unroll
            for (int j = 0; j < 4; ++j) { const u32x2 w = rp[64 * j];
                v[j][0] += __uint_as_float(w.x << 16); v[j][1] += __uint_as_float(w.x & 0xffff0000u); v[j][2] += __uint_as_float(w.y << 16); v[j][3] += __uint_as_float(w.y & 0xffff0000u); }
        }
#pragma unroll
        for (int j = 0; j < 4; ++j) o[64 * j] = v[j];
    }
}
struct SchedDense {
    static constexpr bool GATHER = false;
    const char* A; const char* Bt; int K, nM, nN, nwg, G, c;
    __device__ void init(const bf16* A_, const bf16* Bt_, int M, int N, int K_, int G_, int c_) { A = (const char*)A_; Bt = (const char*)Bt_; K = K_; nM = M / 256; nN = N / 256; nwg = nM * nN; G = G_; c = c_; }
    __device__ __forceinline__ bool next(int i, pg8::Unit& u) const {
        const long L = (long)i * G + c; if (L >= nwg) return false;
        int wgid = (int)L; { const int q = nwg / 8, r = nwg % 8, xcd = wgid % 8, off = wgid / 8; wgid = (xcd < r ? xcd * (q + 1) : r * (q + 1) + (xcd - r) * q) + off; }
        const int nig = 8 * nN, gid = wgid / nig, fm = gid * 8, gsz = (nM - fm) < 8 ? (nM - fm) : 8;
        u.pm = fm + ((wgid % nig) % gsz); u.pn = (wgid % nig) / gsz; u.aux = 0; u.tl = 0;
        u.A = A + (size_t)u.pm * 256 * K * 2; u.B = Bt + (size_t)u.pn * 256 * K * 2; return true;
    }
    __device__ __forceinline__ void aoff(const pg8::Unit&, const int (&R)[2], const int (&C)[2], unsigned (&o)[2][2]) const {
#pragma unroll
        for (int h = 0; h < 2; ++h)
#pragma unroll
            for (int i = 0; i < 2; ++i) o[h][i] = (unsigned)((128 * h + R[i]) * K + C[i]) * 2u;
    }
};
struct SchedBranch {
    static constexpr bool GATHER = false;
    const char* A0; const char* A1; const char* B0; const char* B1; int G, c;
    __device__ __forceinline__ bool next(int i, pg8::Unit& u) const {
        const int L = (i >> 1) * G + c; if (L >= 512) return false;
        int wgid = L; { const int off = wgid / 8, xcd = wgid % 8; wgid = xcd * 64 + off; }
        const int nig = 8 * 4, gid = wgid / nig;
        u.pm = gid * 8 + ((wgid % nig) % 8); u.pn = (wgid % nig) / 8; u.aux = i & 1; u.tl = 0;
        u.A = ((i & 1) ? A1 : A0) + (size_t)u.pm * 256 * D * 2; u.B = ((i & 1) ? B1 : B0) + (size_t)u.pn * 256 * D * 2; return true;
    }
    __device__ __forceinline__ void aoff(const pg8::Unit&, const int (&R)[2], const int (&C)[2], unsigned (&o)[2][2]) const {
#pragma unroll
        for (int h = 0; h < 2; ++h)
#pragma unroll
            for (int i = 0; i < 2; ++i) o[h][i] = (unsigned)((128 * h + R[i]) * D + C[i]) * 2u;
    }
};
template <bool GATHER_, int NPN>
struct SchedMoe {
    static constexpr bool GATHER = GATHER_;
    const char* A; const char* Bt; LAS const unsigned char* misc; const int* list; int G, c;
    __device__ __forceinline__ bool next(int i, pg8::Unit& u) const {
        const int nact = *(LAS const int*)(misc + MT_NACT);
        const int L = i * G + c; if (L >= nact * NPN) return false;
        const int k = L / NPN; u.pn = L % NPN; const int w = ((LAS const int*)(misc + MT_ATILE))[k];
        u.pm = w & 0xfff; u.aux = (w >> 12) & 0xff; u.tl = w >> 20;
        u.A = GATHER ? A : A + (size_t)u.pm * 256 * 1024;
        u.B = Bt + ((size_t)u.aux * NPN + u.pn) * 256 * 1024; return true;
    }
    __device__ __forceinline__ void aoff(const pg8::Unit& u, const int (&R)[2], const int (&C)[2], unsigned (&o)[2][2]) const {
        const int ce = ((LAS const int*)(misc + MT_CNT))[u.aux];
#pragma unroll
        for (int h = 0; h < 2; ++h)
#pragma unroll
            for (int i = 0; i < 2; ++i) {
                if (GATHER) { const int idx = u.tl * 256 + 128 * h + R[i]; const int tok = (idx < ce) ? list[u.aux * NTOK + idx] : 0; o[h][i] = (unsigned)tok * 1024u + (unsigned)C[i] * 2u; }
                else o[h][i] = (unsigned)((128 * h + R[i]) * 1024 + C[i] * 2);
            }
    }
};

__device__ __forceinline__ u32x4 pack8(const f32x4& a, const f32x4& b) { u32x4 w; w.x = pk2(a[0], a[1]); w.y = pk2(a[2], a[3]); w.z = pk2(b[0], b[1]); w.w = pk2(b[2], b[3]); return w; }
__device__ __forceinline__ void unpack8(const u32x4& w, float (&f)[8]) {
    f[0] = __uint_as_float(w.x << 16); f[1] = __uint_as_float(w.x & 0xffff0000u); f[2] = __uint_as_float(w.y << 16); f[3] = __uint_as_float(w.y & 0xffff0000u);
    f[4] = __uint_as_float(w.z << 16); f[5] = __uint_as_float(w.z & 0xffff0000u); f[6] = __uint_as_float(w.w << 16); f[7] = __uint_as_float(w.w & 0xffff0000u);
}
struct EpiProj {
    static constexpr bool PERM = true;
    bf16* proj; const float* qg; const float* kg;
    __device__ __forceinline__ void operator()(pg8::Acc& acc, const pg8::Unit& u, int wr, int wc, int fr, int fq) const {
        const int pn = u.pn;
        int mode;
        if (pn < 4) mode = 1; else if (pn == 4) mode = (wc < 2) ? 2 : 0; else if (pn < 7) mode = 0; else if (pn < 9) mode = 3; else if (pn < 13) mode = 0; else if (pn < 17) mode = 4; else mode = 5;
        float gn[2][8];
        if (mode == 1 || mode == 2) { const float* g = (mode == 1) ? qg : kg; const float s = (mode == 1) ? 0.125f : 1.0f;
#pragma unroll
            for (int bj = 0; bj < 2; ++bj)
#pragma unroll
                for (int j = 0; j < 8; ++j) gn[bj][j] = g[32 * bj + 8 * fq + j] * s; }
#pragma unroll
        for (int ai = 0; ai < 2; ++ai)
#pragma unroll
            for (int m = 0; m < 4; ++m) {
                const int r = u.pm * 256 + ai * 128 + wr * 64 + m * 16 + fr;
                bf16* rowp = proj + (size_t)r * INW + pn * 256 + wc * 64 + 8 * fq;
                f32x4 v[2][2];
#pragma unroll
                for (int bj = 0; bj < 2; ++bj) { v[bj][0] = acc[ai][bj][m][0]; v[bj][1] = acc[ai][bj][m][1]; }
                if (mode == 1 || mode == 2) {
                    float ss = 0.f;
#pragma unroll
                    for (int bj = 0; bj < 2; ++bj)
#pragma unroll
                        for (int n = 0; n < 2; ++n) ss += v[bj][n][0] * v[bj][n][0] + v[bj][n][1] * v[bj][n][1] + v[bj][n][2] * v[bj][n][2] + v[bj][n][3] * v[bj][n][3];
                    ss += __shfl_xor(ss, 16); ss += __shfl_xor(ss, 32);
                    const float rs = rsqrtf(ss * (1.0f / 64.0f) + EPS);
#pragma unroll
                    for (int bj = 0; bj < 2; ++bj)
#pragma unroll
                        for (int n = 0; n < 2; ++n)
#pragma unroll
                            for (int i = 0; i < 4; ++i) v[bj][n][i] = v[bj][n][i] * rs * gn[bj][4 * n + i];
                } else if (mode == 3) {
#pragma unroll
                    for (int bj = 0; bj < 2; ++bj)
#pragma unroll
                        for (int n = 0; n < 2; ++n) v[bj][n] = v[bj][n] * 0.08838834764831845f;
                } else if (mode == 4) {
#pragma unroll
                    for (int bj = 0; bj < 2; ++bj)
#pragma unroll
                        for (int n = 0; n < 2; ++n)
#pragma unroll
                            for (int i = 0; i < 4; ++i) { const float x = v[bj][n][i]; v[bj][n][i] = x * sigmoidf_(x); }
                } else if (mode == 5) {
#pragma unroll
                    for (int bj = 0; bj < 2; ++bj)
#pragma unroll
                        for (int n = 0; n < 2; ++n)
#pragma unroll
                            for (int i = 0; i < 4; ++i) v[bj][n][i] = sigmoidf_(v[bj][n][i]);
                }
#pragma unroll
                for (int bj = 0; bj < 2; ++bj) *(u32x4*)(rowp + 32 * bj) = pack8(v[bj][0], v[bj][1]);
            }
    }
};
struct EpiBranch {
    static constexpr bool PERM = true;
    bf16* merged; const bf16* proj;
    __device__ __forceinline__ void operator()(pg8::Acc& acc, const pg8::Unit& u, int wr, int wc, int fr, int fq) const {
        const int gcol = u.aux ? C_GR : C_GA;
#pragma unroll
        for (int ai = 0; ai < 2; ++ai)
#pragma unroll
            for (int m = 0; m < 4; ++m) {
                const int r = u.pm * 256 + ai * 128 + wr * 64 + m * 16 + fr;
#pragma unroll
                for (int bj = 0; bj < 2; ++bj) {
                    const int col = u.pn * 256 + bj * 128 + wc * 32 + 8 * fq;
                    const u32x4 gw = *(const u32x4*)(proj + (size_t)r * INW + gcol + col);
                    float g[8]; unpack8(gw, g);
                    f32x4 a = acc[ai][bj][m][0], b = acc[ai][bj][m][1];
                    a[0] *= g[0]; a[1] *= g[1]; a[2] *= g[2]; a[3] *= g[3]; b[0] *= g[4]; b[1] *= g[5]; b[2] *= g[6]; b[3] *= g[7];
                    bf16* mp = merged + (size_t)r * D + col;
                    if (u.aux) { const u32x4 pw = *(const u32x4*)mp; float p[8]; unpack8(pw, p);
                        a[0] += p[0]; a[1] += p[1]; a[2] += p[2]; a[3] += p[3]; b[0] += p[4]; b[1] += p[5]; b[2] += p[6]; b[3] += p[7]; }
                    *(u32x4*)mp = pack8(a, b);
                }
            }
    }
};
struct EpiOut {
    static constexpr bool PERM = false;
    const float* x; float* out;
    __device__ __forceinline__ void operator()(pg8::Acc& acc, const pg8::Unit& u, int wr, int wc, int fr, int fq) const {
#pragma unroll
        for (int ai = 0; ai < 2; ++ai)
#pragma unroll
            for (int m = 0; m < 4; ++m) {
                const size_t off = (size_t)(u.pm * 256 + ai * 128 + wr * 64 + m * 16 + fr) * D + u.pn * 256 + wc * 32 + 4 * fq;
#pragma unroll
                for (int bj = 0; bj < 2; ++bj)
#pragma unroll
                    for (int n = 0; n < 2; ++n) { const f32x4 xv = *(const f32x4*)(x + off + bj * 128 + n * 16); *(f32x4*)(out + off + bj * 128 + n * 16) = xv + acc[ai][bj][m][n]; }
            }
    }
};
struct EpiGU {
    static constexpr bool PERM = true;
    unsigned char* act; const float* bgu;
    __device__ __forceinline__ void operator()(pg8::Acc& acc, const pg8::Unit& u, int wr, int wc, int fr, int fq) const {
        const int col = u.pn * 128 + wc * 32 + 8 * fq;
        const float* bg = bgu + (size_t)u.aux * 2048 + col;
        float bgate[8], bup[8];
#pragma unroll
        for (int j = 0; j < 8; ++j) { bgate[j] = bg[j]; bup[j] = bg[1024 + j]; }
#pragma unroll
        for (int ai = 0; ai < 2; ++ai)
#pragma unroll
            for (int m = 0; m < 4; ++m) {
                const int r = u.pm * 256 + ai * 128 + wr * 64 + m * 16 + fr;
                float o[8];
#pragma unroll
                for (int n = 0; n < 2; ++n)
#pragma unroll
                    for (int i = 0; i < 4; ++i) {
                        float gate = acc[ai][0][m][n][i] * W8_INV + bgate[4 * n + i], up = acc[ai][1][m][n][i] * W8_INV + bup[4 * n + i];
                        gate = fminf(gate, 7.0f); up = fminf(fmaxf(up, -7.0f), 7.0f);
                        o[4 * n + i] = (up + 1.0f) * gate * sigmoidf_(1.702f * gate);
                    }
                u32x2 w; w.x = pk4_fp8(o[0], o[1], o[2], o[3]); w.y = pk4_fp8(o[4], o[5], o[6], o[7]);
                *(u32x2*)(act + (size_t)r * DFF + col) = w;
            }
    }
};
struct EpiDown {
    static constexpr bool PERM = true;
    bf16* rows; const float* bdn; const float* wlist; LAS const unsigned char* misc;
    __device__ __forceinline__ void operator()(pg8::Acc& acc, const pg8::Unit& u, int wr, int wc, int fr, int fq) const {
        const int ce = ((LAS const int*)(misc + MT_CNT))[u.aux];
        float bb[2][8];
#pragma unroll
        for (int bj = 0; bj < 2; ++bj)
#pragma unroll
            for (int j = 0; j < 8; ++j) bb[bj][j] = bdn[(size_t)u.aux * D + u.pn * 256 + bj * 128 + wc * 32 + 8 * fq + j];
#pragma unroll
        for (int ai = 0; ai < 2; ++ai)
#pragma unroll
            for (int m = 0; m < 4; ++m) {
                const int lr = ai * 128 + wr * 64 + m * 16 + fr, r = u.pm * 256 + lr, idx = u.tl * 256 + lr;
                const float w = (idx < ce) ? wlist[u.aux * NTOK + idx] : 0.f;
#pragma unroll
                for (int bj = 0; bj < 2; ++bj) {
                    f32x4 a = acc[ai][bj][m][0], b = acc[ai][bj][m][1];
#pragma unroll
                    for (int i = 0; i < 4; ++i) { a[i] = (a[i] * W8_INV + bb[bj][i]) * w; b[i] = (b[i] * W8_INV + bb[bj][4 + i]) * w; }
                    *(u32x4*)(rows + (size_t)r * D + u.pn * 256 + bj * 128 + wc * 32 + 8 * fq) = pack8(a, b);
                }
            }
    }
};
namespace attn {
typedef float f32x16 __attribute__((ext_vector_type(16)));
typedef short s16x4 __attribute__((ext_vector_type(4)));
constexpr int NK = 272, K_OFF = 0, V_OFF = 34816, WS_OFF = 69632, OST_OFF = 71680, LDS_END = OST_OFF + 8 * 4096;
constexpr float LOG2E = 1.4426950408889634f;
__device__ __forceinline__ s16x4 vtr(LAS const unsigned char* p) { return __builtin_bit_cast(s16x4, __builtin_amdgcn_ds_read_tr16_b64_v4i16((LAS s16x4*)p)); }
__device__ __forceinline__ int crowc(int r) { return (r & 3) + 8 * (r >> 2); }

template <int TYPE, bool DIAG>
__device__ __forceinline__ void tile(LAS const unsigned char* lds, int kbase, const bf16x8 (&qr)[4], f32x16 (&o)[2], float& l, float lanebase, float c1, int tt, int lane) {
    const int r32 = lane & 31, hi = lane >> 5;
    f32x16 p = {};
#pragma unroll
    for (int d0 = 0; d0 < 4; ++d0) {
        const bf16x8 kf = *(const LAS bf16x8*)(lds + K_OFF + (2 * d0 + hi) * (NK * 16) + (kbase + r32) * 16);
        p = __builtin_amdgcn_mfma_f32_32x32x16_bf16(kf, qr[d0], p, 0, 0, 0);
    }
    constexpr int NR = (TYPE == 0) ? 8 : 16;
    float e[16];
#pragma unroll
    for (int r = 0; r < NR; ++r) {
        const float add = __builtin_fmaf(c1, (float)crowc(r), lanebase);
        float v = __builtin_amdgcn_exp2f(__builtin_fmaf(p[r], LOG2E, add));
        if (DIAG) { const bool ok = (TYPE == 1) ? (crowc(r) > tt) : (crowc(r) <= tt); v = ok ? v : 0.f; }
        e[r] = v; l += v;
    }
    constexpr int NS = (TYPE == 0) ? 1 : 2;
    u32x4 pw[2];
#pragma unroll
    for (int s = 0; s < NS; ++s) { pw[s].x = pk2(e[8 * s + 0], e[8 * s + 1]); pw[s].y = pk2(e[8 * s + 2], e[8 * s + 3]); pw[s].z = pk2(e[8 * s + 4], e[8 * s + 5]); pw[s].w = pk2(e[8 * s + 6], e[8 * s + 7]); }
    LAS const unsigned char* vb = lds + V_OFF + (kbase + 4 * hi + ((lane & 15) >> 2)) * 64 + ((lane >> 4) & 1) * 32 + (lane & 3) * 8;
#pragma unroll
    for (int d0 = 0; d0 < 2; ++d0)
#pragma unroll
        for (int s = 0; s < NS; ++s) {
            const s16x4 lo = vtr(vb + d0 * (NK * 64) + s * 1024), hh = vtr(vb + d0 * (NK * 64) + s * 1024 + 512);
            const bf16x8 vf = (bf16x8){lo[0], lo[1], lo[2], lo[3], hh[0], hh[1], hh[2], hh[3]};
            o[d0] = __builtin_amdgcn_mfma_f32_32x32x16_bf16(__builtin_bit_cast(bf16x8, pw[s]), vf, o[d0], 0, 0, 0);
        }
}

__device__ __forceinline__ void unit(LAS unsigned char* lds, int b, int qb, int kvh, const bf16* __restrict__ proj, const bf16* __restrict__ pmeta, const float* __restrict__ sinks, float bshift, bf16* __restrict__ yatt) {
    const int tid = threadIdx.x, lane = tid & 63, r32 = lane & 31, hi = lane >> 5; const int wave = __builtin_amdgcn_readfirstlane(tid >> 6);
    for (int idx = tid; idx < NK * 8; idx += 512) {
        const int key = idx >> 3, c = idx & 7;
        const bf16* rowp;
        if (key < 16) rowp = pmeta + (size_t)key * INW;
        else { int j = qb * 128 - 128 + (key - 16); if (j < 0) j = 0; rowp = proj + ((size_t)b * SEQ + j) * INW; }
        const u32x4 kv = *(const u32x4*)(rowp + C_AK + kvh * 64 + c * 8);
        const u32x4 vv = *(const u32x4*)(rowp + C_AV + kvh * 64 + c * 8);
        *(LAS u32x4*)(lds + K_OFF + c * (NK * 16) + key * 16) = kv;
        *(LAS u32x4*)(lds + V_OFF + (c >> 2) * (NK * 64) + key * 64 + (c & 3) * 16) = vv;
    }
    __syncthreads();
    const int h = kvh * 8 + wave;
    const float slope = exp2f(-0.5f * (float)(h + 1)), sink = sinks[h];
    const float M = fmaxf(bshift, sink);
    const float c1 = slope * LOG2E;
    LAS float* wsf = (LAS float*)(lds + WS_OFF) + wave * 64;
    LAS bf16* stg = (LAS bf16*)(lds + OST_OFF) + wave * 2048;
    for (int a = 0; a < 4; ++a) {
        const size_t qrow = (size_t)b * SEQ + qb * 128 + 32 * a + r32;
        bf16x8 qr[4];
#pragma unroll
        for (int d0 = 0; d0 < 4; ++d0) qr[d0] = *(const bf16x8*)(proj + qrow * INW + C_AQ + h * 64 + d0 * 16 + hi * 8);
        f32x16 o[2]; o[0] = f32x16{}; o[1] = f32x16{};
        float l = 0.f;
        const int t = 32 * a + r32;
        const int tt = r32 - 4 * hi;
        const float hi4 = c1 * 4.0f * (float)hi;
        tile<0, false>(lds, 0, qr, o, l, -(slope * (float)(qb * 128 + t + 16) + M) * LOG2E + hi4, c1, tt, lane);
        if (qb > 0) {
            tile<1, true>(lds, 16 + 32 * a, qr, o, l, -(slope * (float)(128 + r32) + M) * LOG2E + hi4, c1, tt, lane);
            for (int bb = a + 1; bb < 4; ++bb) tile<1, false>(lds, 16 + 32 * bb, qr, o, l, -(slope * (float)(128 + t - 32 * bb) + M) * LOG2E + hi4, c1, tt, lane);
        }
        for (int bb = 0; bb < a; ++bb) tile<2, false>(lds, 144 + 32 * bb, qr, o, l, -(slope * (float)(t - 32 * bb) + M) * LOG2E + hi4, c1, tt, lane);
        tile<2, true>(lds, 144 + 32 * a, qr, o, l, -(slope * (float)r32 + M) * LOG2E + hi4, c1, tt, lane);
        l += __shfl_xor(l, 32);
        l += exp2f((sink - M) * LOG2E);
        if (hi == 0) wsf[r32] = l;
        LDS_WAIT();
        float rli[16];
#pragma unroll
        for (int r = 0; r < 16; ++r) rli[r] = __builtin_amdgcn_rcpf(wsf[crowc(r) + 4 * hi]);
#pragma unroll
        for (int r = 0; r < 16; ++r) { const int orow = crowc(r) + 4 * hi;
#pragma unroll
            for (int d0 = 0; d0 < 2; ++d0) stg[orow * 64 + d0 * 32 + r32] = f2bf(o[d0][r] * rli[r]); }
        LDS_WAIT();
        bf16* Ow = yatt + ((size_t)b * SEQ + qb * 128 + 32 * a) * D + h * 64;
#pragma unroll
        for (int i = 0; i < 4; ++i) { const int row = i * 8 + (lane >> 3), ch = lane & 7; const u32x4 v = *(const LAS u32x4*)(stg + row * 64 + ch * 8); *(u32x4*)(Ow + (size_t)row * D + ch * 8) = v; }
        LDS_WAIT();
    }
    __syncthreads();
}
}
namespace ret {
typedef float f32x16 __attribute__((ext_vector_type(16)));
typedef short s16x4 __attribute__((ext_vector_type(4)));
constexpr size_t WS_STATES = 888 * MiB;
__device__ __forceinline__ s16x4 vtr(LAS const unsigned char* p) { return __builtin_bit_cast(s16x4, __builtin_amdgcn_ds_read_tr16_b64_v4i16((LAS s16x4*)p)); }
__device__ __forceinline__ int crowc(int r) { return (r & 3) + 8 * (r >> 2); }
__device__ __forceinline__ float lg2gamma(int h) { return log2f(1.0f - exp2f(-5.0f - (float)h)); }

constexpr int R1_BUF = 40960;
__device__ __forceinline__ void state_chain(LAS unsigned char* lds, int b, int h, int dvs, const bf16* __restrict__ proj, const bf16* __restrict__ pmeta, bf16* __restrict__ states) {
    const int tid = threadIdx.x, lane = tid & 63, hi = lane >> 5; const int wave = __builtin_amdgcn_readfirstlane(tid >> 6);
    const float lg = lg2gamma(h), g128 = exp2f(lg * 128.0f);
    u32x4 kreg[4], vreg;
#define RET_ISSUE(c_) do { const int c__ = (c_); \
        _Pragma("unroll") for (int i = 0; i < 4; ++i) { const int idx = tid + 512 * i, key = idx >> 4, ch = idx & 15; \
            if (c__ == 0) { kreg[i] = (key >= 112) ? *(const u32x4*)(pmeta + (size_t)(key - 112) * INW + C_RK + h * 128 + ch * 8) : (u32x4){0u, 0u, 0u, 0u}; } \
            else kreg[i] = *(const u32x4*)(proj + ((size_t)b * SEQ + (c__ - 1) * 128 + key) * INW + C_RK + h * 128 + ch * 8); } \
        { const int key = tid >> 2, ch = tid & 3; \
          if (c__ == 0) vreg = (key >= 112) ? *(const u32x4*)(pmeta + (size_t)(key - 112) * INW + C_RV + h * 256 + dvs * 32 + ch * 8) : (u32x4){0u, 0u, 0u, 0u}; \
          else vreg = *(const u32x4*)(proj + ((size_t)b * SEQ + (c__ - 1) * 128 + key) * INW + C_RV + h * 256 + dvs * 32 + ch * 8); } } while (0)
    const float vscale = exp2f(lg * (float)(127 - (tid >> 2)));
    f32x16 acc = {};
    RET_ISSUE(0);
    for (int c = 0; c < 32; ++c) {
        LAS unsigned char* buf = lds + (c & 1) * R1_BUF;
#pragma unroll
        for (int i = 0; i < 4; ++i) { const int idx = tid + 512 * i, key = idx >> 4, ch = idx & 15; *(LAS u32x4*)(buf + (ch >> 2) * (128 * 64) + key * 64 + (ch & 3) * 16) = kreg[i]; }
        { const int key = tid >> 2, ch = tid & 3; float f[8]; unpack8(vreg, f); u32x4 w;
          w.x = pk2(f[0] * vscale, f[1] * vscale); w.y = pk2(f[2] * vscale, f[3] * vscale); w.z = pk2(f[4] * vscale, f[5] * vscale); w.w = pk2(f[6] * vscale, f[7] * vscale);
          *(LAS u32x4*)(buf + 32768 + key * 64 + ch * 16) = w; }
        if (c + 1 < 32) RET_ISSUE(c + 1);
        __syncthreads();
        if (wave < 4) {
            const int dt = wave;
            acc = acc * g128;
            LAS const unsigned char* ab = buf + dt * (128 * 64) + (4 * hi + ((lane & 15) >> 2)) * 64 + ((lane >> 4) & 1) * 32 + (lane & 3) * 8;
            LAS const unsigned char* bb = buf + 32768 + (4 * hi + ((lane & 15) >> 2)) * 64 + ((lane >> 4) & 1) * 32 + (lane & 3) * 8;
#pragma unroll
            for (int ks = 0; ks < 8; ++ks) {
                const s16x4 al = vtr(ab + ks * 1024), ah = vtr(ab + ks * 1024 + 512), bl = vtr(bb + ks * 1024), bh = vtr(bb + ks * 1024 + 512);
                const bf16x8 af = (bf16x8){al[0], al[1], al[2], al[3], ah[0], ah[1], ah[2], ah[3]}, bfr = (bf16x8){bl[0], bl[1], bl[2], bl[3], bh[0], bh[1], bh[2], bh[3]};
                acc = __builtin_amdgcn_mfma_f32_32x32x16_bf16(af, bfr, acc, 0, 0, 0);
            }
            bf16* sb = states + ((((size_t)(b * 4 + h) * 32 + c) * 8 + dvs) * 8) * 512;
#pragma unroll
            for (int g = 0; g < 4; ++g) { u32x2 w; w.x = pk2(acc[4 * g], acc[4 * g + 1]); w.y = pk2(acc[4 * g + 2], acc[4 * g + 3]);
                *(u32x2*)(sb + (size_t)(2 * dt + (g >> 1)) * 512 + (32 * (g & 1) + (lane & 31)) * 8 + 4 * hi) = w; }
        }
    }
    __syncthreads();
#undef RET_ISSUE
}

constexpr int R3_K = 0, R3_V = 32768;
__device__ __forceinline__ void out_unit(LAS unsigned char* lds, int b, int h, int tb, const bf16* __restrict__ proj, const bf16* __restrict__ states, bf16* __restrict__ yret) {
    const int tid = threadIdx.x, lane = tid & 63, r32 = lane & 31, hi = lane >> 5; const int wave = __builtin_amdgcn_readfirstlane(tid >> 6);
    const float lg = lg2gamma(h);
    const size_t row0 = (size_t)b * SEQ + tb * 128;
    for (int idx = tid; idx < 128 * 16; idx += 512) { const int key = idx >> 4, ch = idx & 15;
        *(LAS u32x4*)(lds + R3_K + ch * (128 * 16) + key * 16) = *(const u32x4*)(proj + (row0 + key) * INW + C_RK + h * 128 + ch * 8); }
    for (int idx = tid; idx < 128 * 32; idx += 512) { const int key = idx >> 5, ch = idx & 31;
        *(LAS u32x4*)(lds + R3_V + (ch >> 2) * (128 * 64) + key * 64 + (ch & 3) * 16) = *(const u32x4*)(proj + (row0 + key) * INW + C_RV + h * 256 + ch * 8); }
    const int a = wave & 3, dvh = wave >> 2;
    bf16x8 qr[8];
#pragma unroll
    for (int k = 0; k < 8; ++k) qr[k] = *(const bf16x8*)(proj + (row0 + 32 * a + r32) * INW + C_RQ + h * 128 + k * 16 + hi * 8);
    __syncthreads();
    f32x16 o[4];
#pragma unroll
    for (int d = 0; d < 4; ++d) o[d] = f32x16{};
    const float cpos = -lg;
    const int tt = r32 - 4 * hi;
    for (int bb = 0; bb <= a; ++bb) {
        f32x16 p = {};
#pragma unroll
        for (int k = 0; k < 8; ++k) { const bf16x8 kf = *(const LAS bf16x8*)(lds + R3_K + (2 * k + hi) * (128 * 16) + (32 * bb + r32) * 16); p = __builtin_amdgcn_mfma_f32_32x32x16_bf16(kf, qr[k], p, 0, 0, 0); }
        const float lanebase = lg * (float)(32 * (a - bb) + r32 - 4 * hi);
        float e[16];
#pragma unroll
        for (int r = 0; r < 16; ++r) { float v = p[r] * __builtin_amdgcn_exp2f(__builtin_fmaf(cpos, (float)crowc(r), lanebase)); if (bb == a) v = (crowc(r) <= tt) ? v : 0.f; e[r] = v; }
        u32x4 pw[2];
#pragma unroll
        for (int s = 0; s < 2; ++s) { pw[s].x = pk2(e[8 * s + 0], e[8 * s + 1]); pw[s].y = pk2(e[8 * s + 2], e[8 * s + 3]); pw[s].z = pk2(e[8 * s + 4], e[8 * s + 5]); pw[s].w = pk2(e[8 * s + 6], e[8 * s + 7]); }
        LAS const unsigned char* vb = lds + R3_V + (32 * bb + 4 * hi + ((lane & 15) >> 2)) * 64 + ((lane >> 4) & 1) * 32 + (lane & 3) * 8;
#pragma unroll
        for (int d = 0; d < 4; ++d)
#pragma unroll
            for (int s = 0; s < 2; ++s) {
                const s16x4 lo = vtr(vb + (4 * dvh + d) * (128 * 64) + s * 1024), hh = vtr(vb + (4 * dvh + d) * (128 * 64) + s * 1024 + 512);
                const bf16x8 vf = (bf16x8){lo[0], lo[1], lo[2], lo[3], hh[0], hh[1], hh[2], hh[3]};
                o[d] = __builtin_amdgcn_mfma_f32_32x32x16_bf16(__builtin_bit_cast(bf16x8, pw[s]), vf, o[d], 0, 0, 0);
            }
    }
    {
        float din[16];
#pragma unroll
        for (int r = 0; r < 16; ++r) din[r] = __builtin_amdgcn_exp2f(lg * (float)(32 * a + crowc(r) + 4 * hi + 1));
        const bf16* sb = states + (((size_t)(b * 4 + h) * 32 + tb) * 64) * 512 + lane * 8;
#pragma unroll
        for (int d = 0; d < 4; ++d) {
            f32x16 x = {};
#pragma unroll
            for (int k = 0; k < 8; ++k) { const bf16x8 sf = *(const bf16x8*)(sb + (size_t)((4 * dvh + d) * 8 + k) * 512); x = __builtin_amdgcn_mfma_f32_32x32x16_bf16(qr[k], sf, x, 0, 0, 0); }
#pragma unroll
            for (int r = 0; r < 16; ++r) o[d][r] += din[r] * x[r];
        }
    }
    __syncthreads();
    LAS float* stg = (LAS float*)lds;
#pragma unroll
    for (int d = 0; d < 4; ++d)
#pragma unroll
        for (int r = 0; r < 16; ++r) stg[(32 * a + crowc(r) + 4 * hi) * 256 + (4 * dvh + d) * 32 + r32] = o[d][r];
    __syncthreads();
    for (int i = 0; i < 16; ++i) {
        const int q = wave * 16 + i;
        const f32x4 v = *(const LAS f32x4*)(stg + q * 256 + lane * 4);
        const float ss = wave_sum((v[0] * v[0] + v[1] * v[1]) + (v[2] * v[2] + v[3] * v[3]));
        const float rs = rsqrtf(ss * (1.0f / 256.0f) + EPS);
        const u32x2 gw = *(const u32x2*)(proj + (row0 + q) * INW + C_RG + h * 256 + lane * 4);
        u32x2 w; w.x = pk2(v[0] * rs * __uint_as_float(gw.x << 16), v[1] * rs * __uint_as_float(gw.x & 0xffff0000u)); w.y = pk2(v[2] * rs * __uint_as_float(gw.y << 16), v[3] * rs * __uint_as_float(gw.y & 0xffff0000u));
        *(u32x2*)(yret + (row0 + q) * D + h * 256 + lane * 4) = w;
    }
    __syncthreads();
}
}
__device__ __forceinline__ void p0_transpose_item(const float* W, int K, int N, bf16* WT, int k0, int n0, int dst_row0, LAS float* scr, int lane) {
#pragma unroll 8
    for (int i = 0; i < 32; ++i) { const int kk = 2 * i + (lane >> 5); scr[kk * 33 + (lane & 31)] = W[(size_t)(k0 + kk) * N + n0 + (lane & 31)]; }
    LDS_WAIT(); asm volatile("" ::: "memory");
    const int c = lane & 7;
#pragma unroll
    for (int j = 0; j < 4; ++j) { const int n = (lane >> 3) + 8 * j; const LAS float* s = scr + (8 * c) * 33 + n;
        u32x4 o; o.x = pk2(s[0 * 33], s[1 * 33]); o.y = pk2(s[2 * 33], s[3 * 33]); o.z = pk2(s[4 * 33], s[5 * 33]); o.w = pk2(s[6 * 33], s[7 * 33]);
        *(u32x4*)(WT + (size_t)(dst_row0 + n) * K + k0 + 8 * c) = o; }
    LDS_WAIT(); asm volatile("" ::: "memory");
}

#ifndef PROBE_PHASE
#define PROBE_PHASE (-1)
#endif
__device__ __forceinline__ void p0_transpose_item_fp8(const float* W, int K, int N, unsigned char* WT, int k0, int n0, int dst_row0, LAS float* scr, int lane) {
#pragma unroll 8
    for (int i = 0; i < 32; ++i) { const int kk = 2 * i + (lane >> 5); scr[kk * 33 + (lane & 31)] = W[(size_t)(k0 + kk) * N + n0 + (lane & 31)]; }
    LDS_WAIT(); asm volatile("" ::: "memory");
    const int c = lane & 3;
#pragma unroll
    for (int j = 0; j < 2; ++j) { const int n = (lane >> 2) + 16 * j; const LAS float* s = scr + (16 * c) * 33 + n;
        u32x4 o;
        o.x = pk4_fp8(s[0 * 33] * W8_SCALE, s[1 * 33] * W8_SCALE, s[2 * 33] * W8_SCALE, s[3 * 33] * W8_SCALE); o.y = pk4_fp8(s[4 * 33] * W8_SCALE, s[5 * 33] * W8_SCALE, s[6 * 33] * W8_SCALE, s[7 * 33] * W8_SCALE);
        o.z = pk4_fp8(s[8 * 33] * W8_SCALE, s[9 * 33] * W8_SCALE, s[10 * 33] * W8_SCALE, s[11 * 33] * W8_SCALE); o.w = pk4_fp8(s[12 * 33] * W8_SCALE, s[13 * 33] * W8_SCALE, s[14 * 33] * W8_SCALE, s[15 * 33] * W8_SCALE);
        *(u32x4*)(WT + (size_t)(dst_row0 + n) * K + k0 + 16 * c) = o; }
    LDS_WAIT(); asm volatile("" ::: "memory");
}
struct Args { const float* in[17]; float* out; unsigned char* ws; int ph_lo, ph_hi, li, pad; };

__global__ void __launch_bounds__(512, 2) mk_fwd(Args args) {
    extern __shared__ __attribute__((aligned(16))) unsigned char lds_raw[];
    LAS unsigned char* lds = (LAS unsigned char*)lds_raw;
    volatile LAS unsigned* MISC = (volatile LAS unsigned*)(lds + MISC_OFF);
    const int tid = threadIdx.x, lane = tid & 63, wave = __builtin_amdgcn_readfirstlane(tid >> 6);
    const int G = gridDim.x, bx = blockIdx.x;
    const int vcu = (G % 8 == 0) ? (bx % 8) * (G / 8) + bx / 8 : bx;
    unsigned char* ws = args.ws;
    unsigned* ctl = (unsigned*)(ws + WS_CTL);
    const float* x = args.in[0]; const float* meta = args.in[1]; const float* g1 = args.in[2]; const float* w_in = args.in[3];
    const float* qg = args.in[4]; const float* kg = args.in[5];
    const float* w_ab = args.in[7]; const float* w_rb = args.in[8]; const float* w_out = args.in[9];
    const float* w_gu = args.in[13]; const float* b_gu = args.in[14]; const float* w_dn = args.in[15]; const float* b_dn = args.in[16];
    float* out = args.out;
    bf16* Win_t = (bf16*)(ws + WS_WIN); bf16* Wab_t = (bf16*)(ws + WS_WAB); bf16* Wrb_t = (bf16*)(ws + WS_WRB); bf16* Wout_t = (bf16*)(ws + WS_WOUT);
    unsigned char* Wgu_t = ws + WS_WGU; unsigned char* Wdn_t = ws + WS_WDN;
    bf16* xb = (bf16*)(ws + WS_XB); bf16* proj = (bf16*)(ws + WS_PROJ); bf16* yatt = (bf16*)(ws + WS_YATT); bf16* yret = (bf16*)(ws + WS_YRET); bf16* merged = (bf16*)(ws + WS_MERGED);
    bf16* pmeta = (bf16*)(ws + SM_PMETA);
    const float* sinks = args.in[6]; const float* g2 = args.in[10]; const float* w_r = args.in[11]; const float* b_r = args.in[12];
    int* tke = (int*)(ws + SM_TKE); float* tkw = (float*)(ws + SM_TKW); int* tkpos = (int*)(ws + SM_TKPOS); int* list = (int*)(ws + SM_LIST); float* wlist = (float*)(ws + SM_WLIST);
    LAS unsigned char* misc = lds + MISC_OFF;
    bf16* states = (bf16*)(ws + ret::WS_STATES);
    unsigned char* act = ws + WS_ACT; bf16* rows = (bf16*)(ws + WS_ROWS); unsigned char* xn8 = ws + WS_XB;

    for (int u = tid; u < (LDS_BYTES - MISC_OFF) / 4; u += 512) ((LAS unsigned*)(lds + MISC_OFF))[u] = 0u;
    __syncthreads();
    XcdBarrier bar = xcd_barrier_post(ctl + CW_BAR + args.li * XCD_BAR_WORDS, MISC + 8);
    const int lo = args.ph_lo, hi = args.ph_hi;
#define IN(k) (lo <= (k) && (k) < hi)
#define BOTH(k) (IN(k) && IN((k) + 1))
#define GRID_BAR() xcd_barrier(bar)

    if (IN(0)) { for (int rep_ = 0; rep_ < ((PROBE_PHASE == 0) ? 2 : 1); ++rep_) {
        LAS float* scr = (LAS float*)(lds + wave * 16384);
        const int gw = vcu * NWAVES + wave, NGW = G * NWAVES;
        constexpr int I_IN = 16 * 200, I_SQ = 16 * 32, I_GU = 32 * 16 * 64, I_DN = 32 * 16 * 32;
        constexpr int NITEMS = I_IN + 3 * I_SQ + I_GU + I_DN;
        for (int it = gw; it < NITEMS; it += NGW) {
            int r = it;
            if (r < I_IN) { const int kb = r / 200, nb = r % 200, n0 = nb * 32, o = n0 & 255, wcc = o >> 6, bj = (o >> 5) & 1;
                p0_transpose_item(w_in, D, INW, Win_t, kb * 64, n0, (n0 & ~255) + 128 * bj + 32 * wcc, scr, lane); continue; }
            r -= I_IN;
            if (r < I_SQ) { p0_transpose_item(w_ab, D, D, Wab_t, (r / 32) * 64, (r % 32) * 32, (r % 32) * 32, scr, lane); continue; } r -= I_SQ;
            if (r < I_SQ) { p0_transpose_item(w_rb, D, D, Wrb_t, (r / 32) * 64, (r % 32) * 32, (r % 32) * 32, scr, lane); continue; } r -= I_SQ;
            if (r < I_SQ) { p0_transpose_item(w_out, D, D, Wout_t, (r / 32) * 64, (r % 32) * 32, (r % 32) * 32, scr, lane); continue; } r -= I_SQ;
            if (r < I_GU) { const int e = r / 1024, q = r % 1024, kb = q / 64, nb = q % 64, n0 = nb * 32, bj = n0 >> 10, rem = n0 & 1023, pn = rem >> 7, cl = rem & 127;
                p0_transpose_item_fp8(w_gu + (size_t)e * D * 2048, D, 2048, Wgu_t + (size_t)e * 2048 * D, kb * 64, n0, 256 * pn + 128 * bj + cl, scr, lane); continue; }
            r -= I_GU;
            { const int e = r / 512, q = r % 512, kb = q / 32, nb = q % 32;
              p0_transpose_item_fp8(w_dn + (size_t)e * DFF * D, DFF, D, Wdn_t + (size_t)e * D * DFF, kb * 64, nb * 32, nb * 32, scr, lane); }
        }
        for (int row = gw; row < NTOK; row += NGW) {
            const f32x4* xr = (const f32x4*)(x + (size_t)row * D) + lane;
            f32x4 v[4]; float ss = 0.f;
#pragma unroll
            for (int j = 0; j < 4; ++j) { v[j] = xr[64 * j]; ss += (v[j][0] * v[j][0] + v[j][1] * v[j][1]) + (v[j][2] * v[j][2] + v[j][3] * v[j][3]); }
            const float rstd = rsqrtf(wave_sum(ss) * (1.0f / D) + EPS);
            u32x2* o8 = (u32x2*)(xb + (size_t)row * D) + lane;
#pragma unroll
            for (int j = 0; j < 4; ++j) { const f32x4 gg = ((const f32x4*)g1)[64 * j + lane]; u32x2 w; w.x = pk2(v[j][0] * rstd * gg[0], v[j][1] * rstd * gg[1]); w.y = pk2(v[j][2] * rstd * gg[2], v[j][3] * rstd * gg[3]); o8[64 * j] = w; }
        }
        __syncthreads();
        for (int item = vcu; item < 28; item += G) {
            const int c0 = (item < 4) ? 1024 + 64 * item : 1792 + 64 * (item - 4);
            LAS float* red = (LAS float*)lds;
            LAS float* rst = (LAS float*)(lds + 32768);
            {
#pragma unroll
              for (int q = 0; q < 2; ++q) { const int r = 2 * wave + q; float ss = 0.f;
                for (int j = 0; j < 4; ++j) { const f32x4 v = ((const f32x4*)(meta + (size_t)r * D))[64 * j + lane]; ss += v[0] * v[0] + v[1] * v[1] + v[2] * v[2] + v[3] * v[3]; }
                ss = wave_sum(ss); if (lane == 0) rst[r] = rsqrtf(ss * (1.0f / D) + EPS); } }
            __syncthreads();
            float a[16];
#pragma unroll
            for (int r = 0; r < 16; ++r) a[r] = 0.f;
            for (int k = wave * 128; k < wave * 128 + 128; ++k) {
                const float w = w_in[(size_t)k * INW + c0 + lane]; const float gk = g1[k];
#pragma unroll
                for (int r = 0; r < 16; ++r) a[r] += bf2f(f2bf(meta[(size_t)r * D + k] * rst[r] * gk)) * w;
            }
#pragma unroll
            for (int r = 0; r < 16; ++r) red[(wave * 16 + r) * 64 + lane] = a[r];
            __syncthreads();
#pragma unroll
            for (int q = 0; q < 2; ++q) { const int r = 2 * wave + q; float v = 0.f;
#pragma unroll
                for (int w8 = 0; w8 < 8; ++w8) v += red[(w8 * 16 + r) * 64 + lane];
                if (item < 2) { const float ss = wave_sum(v * v); v = v * rsqrtf(ss * (1.0f / 64.0f) + EPS) * kg[lane]; }
                else if (item >= 4 && item < 12) v *= 0.08838834764831845f;
                pmeta[(size_t)r * INW + c0 + lane] = f2bf(v); }
            __syncthreads();
        }
        __syncthreads(); }
        if (BOTH(0)) GRID_BAR();
    }
    if (IN(1)) {
        SchedDense S; S.init(xb, Win_t, NTOK, INW, D, G, bx);
        EpiProj E{proj, qg, kg};
        for (int rep_ = 0; rep_ < ((PROBE_PHASE == 1) ? 2 : 1); ++rep_) pg8::gemm_phase<EpiProj, SchedDense>(lds, 2 * D, S, E);
        if (BOTH(1)) GRID_BAR();
    }
    if (IN(2)) {
        float mq = fabsf(qg[lane]), mk = fabsf(kg[lane]);
#pragma unroll
        for (int o = 1; o < 64; o <<= 1) { mq = fmaxf(mq, __shfl_xor(mq, o)); mk = fmaxf(mk, __shfl_xor(mk, o)); }
        const float bshift = 8.0f * mq * mk;
        for (int rep_ = 0; rep_ < ((PROBE_PHASE == 20) ? 2 : 1); ++rep_) for (int u = bx; u < NB * 32 * 2; u += G) attn::unit(lds, u >> 6, (u >> 1) & 31, u & 1, proj, pmeta, sinks, bshift, yatt);
        for (int rep_ = 0; rep_ < ((PROBE_PHASE == 21) ? 2 : 1); ++rep_) for (int u = bx; u < NB * 4 * 8; u += G) ret::state_chain(lds, u >> 5, (u >> 3) & 3, u & 7, proj, pmeta, states);
        if (BOTH(2)) GRID_BAR();
    }
    if (IN(3)) {
        for (int rep_ = 0; rep_ < ((PROBE_PHASE == 3) ? 2 : 1); ++rep_) for (int u = bx; u < NB * 4 * 32; u += G) ret::out_unit(lds, u >> 7, (u >> 5) & 3, u & 31, proj, states, yret);
        if (BOTH(3)) GRID_BAR();
    }
    if (IN(4)) {
        SchedBranch S{(const char*)yatt, (const char*)yret, (const char*)Wab_t, (const char*)Wrb_t, G, bx};
        EpiBranch E{merged, proj};
        for (int rep_ = 0; rep_ < ((PROBE_PHASE == 4) ? 2 : 1); ++rep_) pg8::gemm_phase<EpiBranch, SchedBranch>(lds, 2 * D, S, E);
        if (BOTH(4)) GRID_BAR();
    }
    if (IN(5)) {
        SchedDense S; S.init(merged, Wout_t, NTOK, D, D, G, bx);
        EpiOut E{x, out};
        for (int rep_ = 0; rep_ < ((PROBE_PHASE == 5) ? 2 : 1); ++rep_) pg8::gemm_phase<EpiOut, SchedDense>(lds, 2 * D, S, E);
        if (BOTH(5)) GRID_BAR();
    }
    if (IN(6)) {
        route_phase(lds, out, g2, w_r, b_r, xn8, tke, tkpos, tkw, list, wlist, ctl + CW_CNT, G, bx);
        if (BOTH(6)) GRID_BAR();
    }
    if (hi > 7 && lo <= 9) moe_tables(misc, ctl + CW_CNT);
    if (IN(7)) {
        SchedMoe<true, 8> S{(const char*)xn8, (const char*)Wgu_t, misc, list, G, bx};
        EpiGU E{act, b_gu};
        for (int rep_ = 0; rep_ < ((PROBE_PHASE == 7) ? 2 : 1); ++rep_) pg8::gemm_phase<EpiGU, SchedMoe<true, 8>, true>(lds, D, S, E);
        if (BOTH(7)) GRID_BAR();
    }
    if (IN(8)) {
        SchedMoe<false, 4> S{(const char*)act, (const char*)Wdn_t, misc, list, G, bx};
        EpiDown E{rows, b_dn, wlist, misc};
        for (int rep_ = 0; rep_ < ((PROBE_PHASE == 8) ? 2 : 1); ++rep_) pg8::gemm_phase<EpiDown, SchedMoe<false, 4>, true>(lds, DFF, S, E);
        if (BOTH(8)) GRID_BAR();
    }
    if (IN(9)) combine_phase(misc, out, rows, tke, tkpos, vcu * NWAVES + wave, G * NWAVES, lane);
#undef IN
#undef BOTH
#undef GRID_BAR
}

extern "C" void kernel_launch(void* const* d_in, const int* in_sizes, int n_in, void* d_out, int out_size, void* d_ws, size_t ws_size, hipStream_t stream) {
    static int grid = 0;
    if (grid == 0) {
        if (n_in != 17 || in_sizes[0] != NTOK * D || out_size != NTOK * D || ws_size < WS_END) {
            fprintf(stderr, "kernel_launch: unexpected shapes (n_in %d in0 %d out %d ws %zu)\n", n_in, n_in > 0 ? in_sizes[0] : -1, out_size, ws_size); grid = -1; return; }
        int dev = 0, cus = 0;
        if (hipGetDevice(&dev) != hipSuccess || hipDeviceGetAttribute(&cus, hipDeviceAttributeMultiprocessorCount, dev) != hipSuccess) { grid = -1; return; }
        if (hipFuncSetAttribute((const void*)mk_fwd, hipFuncAttributeMaxDynamicSharedMemorySize, LDS_BYTES) != hipSuccess) { fprintf(stderr, "kernel_launch: hipFuncSetAttribute failed\n"); grid = -1; return; }
        grid = cus;
    }
    if (grid < 0) return;
    unsigned char* ws = (unsigned char*)d_ws;
    (void)hipMemsetAsync(ws + WS_CTL, 0, 1 * MiB, stream);
    Args a{};
    for (int i = 0; i < 17; ++i) a.in[i] = (const float*)d_in[i];
    a.out = (float*)d_out; a.ws = ws; a.ph_lo = 0; a.ph_hi = 10; a.li = 0; a.pad = 0;
    hipLaunchKernelGGL(mk_fwd, dim3(grid), dim3(512), LDS_BYTES, stream, a);
}
```

```cpp
#include <hip/hip_runtime.h>
#include <cstdio>
#include <cstdint>

typedef unsigned short bf16;
__device__ __forceinline__ float bf2f(bf16 v) { return __uint_as_float(((unsigned)v) << 16); }
__device__ __forceinline__ bf16 f2bf(float f) { unsigned u = __float_as_uint(f); return (bf16)((u + 0x7fffu + ((u >> 16) & 1u)) >> 16); }
__device__ __forceinline__ float sigmoidf_(float x) { return 1.0f / (1.0f + __expf(-x)); }

constexpr int NB = 8, SEQ = 4096, D = 1024, NTOK = NB * SEQ;
constexpr int NMETA = 16;
constexpr int INW = 6400;
constexpr int C_AQ = 0, C_AK = 1024, C_AV = 1152, C_RQ = 1280, C_RK = 1792, C_RV = 2304, C_RG = 3328, C_GA = 4352, C_GR = 5376;
constexpr int NE = 32, TOPK = 4, DFF = 1024;
constexpr int NROWS = (NTOK * TOPK / 256 + NE) * 256;
constexpr int NTILE = NROWS / 256;
constexpr float EPS = 1e-5f;

constexpr size_t MiB = 1u << 20;
constexpr size_t WS_CTL = 0;
constexpr size_t WS_SMALL = 1 * MiB;
constexpr size_t WS_W = 16 * MiB;
constexpr size_t WS_XB = 232 * MiB;
constexpr size_t WS_PROJ = 297 * MiB;
constexpr size_t WS_YATT = 701 * MiB;
constexpr size_t WS_YRET = 765 * MiB;
constexpr size_t WS_MERGED = 829 * MiB;
constexpr size_t WS_END = 1020 * MiB;
constexpr size_t WS_ACT = 297 * MiB;
constexpr size_t WS_ROWS = 568 * MiB;
constexpr size_t SM_UMETA = WS_SMALL;
constexpr size_t SM_PMETA = WS_SMALL + 64 * 1024;
constexpr size_t SM_TKE = WS_SMALL + 512 * 1024;
constexpr size_t SM_TKW = SM_TKE + 512 * 1024;
constexpr size_t SM_TKPOS = SM_TKW + 512 * 1024;
constexpr size_t SM_TKROW = SM_TKPOS + 512 * 1024;
constexpr size_t SM_ROWTOK = SM_TKROW + 512 * 1024;
constexpr size_t SM_ROWW = SM_ROWTOK + 1024 * 1024;
constexpr size_t SM_TILEE = SM_ROWW + 1024 * 1024;
constexpr int CW_CNT = 1024;

#define LAS __attribute__((address_space(3)))
#define GAS __attribute__((address_space(1)))
typedef short bf16x8 __attribute__((ext_vector_type(8)));
typedef float f32x4 __attribute__((ext_vector_type(4)));
typedef float f32x2 __attribute__((ext_vector_type(2)));
typedef unsigned u32x4 __attribute__((ext_vector_type(4)));
typedef unsigned u32x2 __attribute__((ext_vector_type(2)));
#define LDS_WAIT() asm volatile("s_waitcnt lgkmcnt(0)" ::: "memory")
#define VM_WAIT() asm volatile("s_waitcnt vmcnt(0)" ::: "memory")
__device__ __forceinline__ unsigned pk2(float lo, float hi) { return (unsigned)f2bf(lo) | ((unsigned)f2bf(hi) << 16); }
__device__ __forceinline__ unsigned pk4_fp8(float a, float b, float c, float d) { int w = __builtin_amdgcn_cvt_pk_fp8_f32(a, b, 0, false); w = __builtin_amdgcn_cvt_pk_fp8_f32(c, d, w, true); return (unsigned)w; }
constexpr float W8_SCALE = 64.0f, W8_INV = 1.0f / 64.0f;
__device__ __forceinline__ float wave_sum(float v) {
#pragma unroll
    for (int o = 1; o < 64; o <<= 1) v += __shfl_xor(v, o);
    return v;
}

constexpr size_t WS_WIN = WS_W;
constexpr size_t WS_WAB = WS_W + 13 * MiB;
constexpr size_t WS_WRB = WS_W + 15 * MiB;
constexpr size_t WS_WOUT = WS_W + 17 * MiB;
constexpr size_t WS_WGU = WS_W + 19 * MiB;
constexpr size_t WS_WDN = WS_W + 147 * MiB;
static_assert(WS_WDN + 64 * MiB <= WS_XB, "weight map");
constexpr size_t SM_ATILE = SM_TILEE + 4096;
constexpr int CW_NACT = 1088;
constexpr int CW_BAR = 4096;

constexpr int RING_BYTES = 131072;
constexpr int MISC_OFF = RING_BYTES;
constexpr int LDS_BYTES = 147456;
constexpr int NWAVES = 8;

#define XB_TMO      128
#define XB_XCNT(j)  (256  + 64 * (j))
#define XB_XSUB(j)  (1280 + 64 * (j))
#define XB_XGEN(j)  (2304 + 64 * (j))
#define XB_TOP      3328
#define XB_TOPGEN   3392
#define XCD_BAR_WORDS 3456
#define XB_SPIN_CAP (1u << 20)
__device__ __forceinline__ unsigned xb_ld(unsigned* p)              { return __hip_atomic_load(p, __ATOMIC_RELAXED, __HIP_MEMORY_SCOPE_AGENT); }
__device__ __forceinline__ unsigned xb_add(unsigned* p, unsigned v) { return __hip_atomic_fetch_add(p, v, __ATOMIC_RELAXED, __HIP_MEMORY_SCOPE_AGENT); }
__device__ __forceinline__ unsigned xb_xcc_id() { return (unsigned)__builtin_amdgcn_s_getreg((3 << 11) | 20) & 0xFu; }
#define XB_SPIN(cond, bar) do { unsigned _sp = 0; while (cond) { __builtin_amdgcn_s_sleep(1); \
    if ((++_sp & 255u) == 0u) { if (xb_ld(&(bar)[XB_TMO])) break; if (_sp > XB_SPIN_CAP) { atomicAdd(&(bar)[XB_TMO], 1u); break; } } } } while (0)
struct XcdBarrier { unsigned* bar; unsigned x; volatile LAS unsigned* st; };
__device__ __forceinline__ XcdBarrier xcd_barrier_post(unsigned* bar, volatile LAS unsigned* st) {
    XcdBarrier b; b.bar = bar; b.x = xb_xcc_id(); b.st = st;
    if (threadIdx.x == 0) (void)xb_add(&bar[XB_XCNT(b.x)], 1u);
    return b;
}
__device__ __forceinline__ void xcd_barrier_complete(unsigned* bar, unsigned x, unsigned& nloc, unsigned& nx) {
    const unsigned G = gridDim.x * gridDim.y * gridDim.z;
    unsigned sum, cnt, mine, sp = 0u;
    for (;;) {
        sum = 0u; cnt = 0u; mine = 0u;
#pragma unroll
        for (unsigned j = 0; j < 16; ++j) { const unsigned c = xb_ld(&bar[XB_XCNT(j)]); sum += c; cnt += (c > 0u) ? 1u : 0u; mine = (j == x) ? c : mine; }
        if (sum == G) break;
        __builtin_amdgcn_s_sleep(1);
        if ((++sp & 255u) == 0u) { if (xb_ld(&bar[XB_TMO])) break; if (sp > XB_SPIN_CAP) { atomicAdd(&bar[XB_TMO], 1u); break; } }
    }
    nloc = mine > 0u ? mine : 1u; nx = cnt > 0u ? cnt : 1u;
}
__device__ __forceinline__ void xcd_barrier(const XcdBarrier& b) {
    asm volatile("s_waitcnt vmcnt(0)" ::: "memory");
    __syncthreads();
    if (threadIdx.x == 0) {
        unsigned* bar = b.bar;
        __builtin_amdgcn_s_waitcnt(0);
        unsigned nloc = b.st[0], nx = b.st[1];
        if (nloc == 0u) { xcd_barrier_complete(bar, b.x, nloc, nx); b.st[0] = nloc; b.st[1] = nx; }
        const unsigned old = xb_add(&bar[XB_XSUB(b.x)], 1u);
        const unsigned gen = old / nloc;
        if (old + 1u == (gen + 1u) * nloc) {
            __builtin_amdgcn_fence(__ATOMIC_RELEASE, "agent");
            asm volatile("s_waitcnt vmcnt(0)" ::: "memory");
            const unsigned og = xb_add(&bar[XB_TOP], 1u);
            const unsigned tg = og / nx;
            if (og + 1u == (tg + 1u) * nx) xb_add(&bar[XB_TOPGEN], 1u);
            else XB_SPIN(xb_ld(&bar[XB_TOPGEN]) == tg, bar);
            __builtin_amdgcn_fence(__ATOMIC_ACQUIRE, "agent");
            xb_add(&bar[XB_XGEN(b.x)], 1u);
            asm volatile("s_waitcnt vmcnt(0)" ::: "memory");
        } else {
            XB_SPIN(xb_ld(&bar[XB_XGEN(b.x)]) == gen, bar);
            __builtin_amdgcn_fence(__ATOMIC_ACQUIRE, "agent");
            asm volatile("s_waitcnt vmcnt(0)" ::: "memory");
        }
    }
    __syncthreads();
}

namespace pg8 {
constexpr int BM = 256, BK = 64, HALF = 128, HTB = HALF * BK * 2, STAGE_BYTES = 8 * HTB;
__host__ __device__ __forceinline__ int lds_byte(int r, int c) { const int st = (r >> 4) * 2 + (c >> 5), rr = r & 15, cc = c & 31, ob = rr * 64 + cc * 2; return st * 1024 + (ob ^ (((ob >> 9) & 1) << 5)); }
__host__ __device__ __forceinline__ void stage_rc(int b, int& R, int& C) { const int st = b / 1024, sb = b % 1024, swz = sb ^ (((sb >> 9) & 1) << 5); R = (st >> 1) * 16 + swz / 64; C = (st & 1) * 32 + (swz % 64) / 2; }
__host__ __device__ __forceinline__ int perm32(int rho) { const int n = rho >> 4, i = rho & 15; return 8 * (i >> 2) + 4 * n + (i & 3); }
struct Unit { int pm, pn, aux, tl; const char* A; const char* B; };
typedef f32x4 Acc[2][2][4][2];
typedef int u32x4_i __attribute__((ext_vector_type(4)));

typedef int v8i32 __attribute__((ext_vector_type(8)));
template <class Epi, class Sched, bool FP8 = false>
__device__ __forceinline__ void gemm_phase(LAS unsigned char* lds, const int Kb, const Sched& S, const Epi& E) {
    const int tid = threadIdx.x, wid = __builtin_amdgcn_readfirstlane(tid >> 6), lane = tid & 63, wr = wid >> 2, wc = wid & 3, fr = lane & 15, fq = lane >> 4;
    const int nt = Kb / 128;
    int RA[2], CA[2]; unsigned voffB[2];
#pragma unroll
    for (int i = 0; i < 2; ++i) { int R, C; stage_rc(tid * 16 + i * 8192, R, C); const int Rb = Epi::PERM ? ((R & ~31) + perm32(R & 31)) : R;
        RA[i] = R; CA[i] = C; voffB[i] = (unsigned)(Rb * Kb + C * 2); }
    const size_t kstep = (size_t)(BK * 2);
    const size_t hstep = (size_t)HALF * Kb;
    const unsigned ldsw = (unsigned)wid * 1024u;
    const int aoff = lds_byte(wr * 64 + fr, fq * 8), boff = lds_byte(wc * 32 + fr, fq * 8);
#define PG8_SA(b, h) (((b) * 2 + (h)) * HTB)
#define PG8_SB(b, h) ((4 + (b) * 2 + (h)) * HTB)
#define PG8_STAGE(bufoff, gbase, voff) do { _Pragma("unroll") for (int _i = 0; _i < 2; ++_i) \
        __builtin_amdgcn_global_load_lds((const unsigned*)((const char*)(gbase) + (voff)[_i]), (LAS unsigned*)(lds + (bufoff) + ldsw + _i * 8192), 16, 0, 0); } while (0)
#define PG8_LDA(dst, b, h) do { _Pragma("unroll") for (int m = 0; m < 4; ++m) _Pragma("unroll") for (int k = 0; k < 2; ++k) dst[m][k] = *(const LAS bf16x8*)(lds + PG8_SA(b, h) + aoff + m * 2048 + k * 1024); } while (0)
#define PG8_LDB(dst, b, h) do { _Pragma("unroll") for (int n = 0; n < 2; ++n) _Pragma("unroll") for (int k = 0; k < 2; ++k) dst[n][k] = *(const LAS bf16x8*)(lds + PG8_SB(b, h) + boff + n * 2048 + k * 1024); } while (0)
#define PG8_MMA(ai, bj, At, Bt) do { __builtin_amdgcn_s_setprio(1); _Pragma("unroll") for (int m = 0; m < 4; ++m) _Pragma("unroll") for (int n = 0; n < 2; ++n) { \
        if constexpr (FP8) { const v8i32 bq = __builtin_shufflevector(__builtin_bit_cast(u32x4_i, Bt[n][0]), __builtin_bit_cast(u32x4_i, Bt[n][1]), 0, 1, 2, 3, 4, 5, 6, 7), \
                                         aq = __builtin_shufflevector(__builtin_bit_cast(u32x4_i, At[m][0]), __builtin_bit_cast(u32x4_i, At[m][1]), 0, 1, 2, 3, 4, 5, 6, 7); \
            asm volatile("v_mfma_scale_f32_16x16x128_f8f6f4 %0, %1, %2, %0, %3, %3 op_sel_hi:[0,0,0]" : "+v"(acc[ai][bj][m][n]) : "v"(bq), "v"(aq), "v"(scale1)); } \
        else { _Pragma("unroll") for (int k = 0; k < 2; ++k) acc[ai][bj][m][n] = __builtin_amdgcn_mfma_f32_16x16x32_bf16(Bt[n][k], At[m][k], acc[ai][bj][m][n], 0, 0, 0); } } \
        __builtin_amdgcn_s_setprio(0); } while (0)
#define PG8_WAIT_V(n) asm volatile("s_waitcnt vmcnt(" #n ")" ::: "memory")
#define PG8_WAIT_L(n) asm volatile("s_waitcnt lgkmcnt(" #n ")" ::: "memory")
#define PG8_BAR __builtin_amdgcn_s_barrier()
#define PG8_SCHED __builtin_amdgcn_sched_barrier(0)
    int scale1 = 0x7f7f7f7f; asm volatile("" : "+v"(scale1));
    Unit cur, nxt; int ui = 0;
    if (!S.next(0, cur)) return;
    unsigned ca[2][2], na[2][2];
    S.aoff(cur, RA, CA, ca);
    f32x4 acc[2][2][4][2];
#pragma unroll
    for (int a = 0; a < 2; ++a)
#pragma unroll
        for (int b = 0; b < 2; ++b)
#pragma unroll
            for (int m = 0; m < 4; ++m)
#pragma unroll
                for (int n = 0; n < 2; ++n) acc[a][b][m][n] = (f32x4){0.f, 0.f, 0.f, 0.f};
    bf16x8 At[4][2], B0[2][2], B1[2][2];
    const char* cA = cur.A; const char* cB = cur.B;
    PG8_STAGE(PG8_SB(0, 0), cB, voffB); PG8_STAGE(PG8_SB(0, 1), cB + hstep, voffB); PG8_STAGE(PG8_SA(0, 0), cA, ca[0]); PG8_STAGE(PG8_SA(0, 1), cA, ca[1]);
    if (wr == 1) PG8_BAR;
    PG8_WAIT_V(2); PG8_BAR;
    PG8_STAGE(PG8_SB(1, 0), cB + kstep, voffB); PG8_STAGE(PG8_SA(1, 0), cA + kstep, ca[0]); PG8_STAGE(PG8_SB(1, 1), cB + hstep + kstep, voffB);
    PG8_WAIT_V(6); PG8_BAR;
    for (;;) {
        const bool has_next = S.next(ui + 1, nxt);
        if constexpr (Sched::GATHER) {
            if (has_next) S.aoff(nxt, RA, CA, na);
            else {
#pragma unroll
                for (int h = 0; h < 2; ++h)
#pragma unroll
                    for (int i = 0; i < 2; ++i) na[h][i] = ca[h][i];
            }
        }
        const char* nA = has_next ? nxt.A : cA; const char* nB = has_next ? nxt.B : cB;
#pragma nounroll
        for (int t = 0; t < nt; t += 2) {
            const bool last = (t == nt - 2);
            const char* a1 = cA + (size_t)(t + 1) * kstep;
            const char* a2 = last ? nA : cA + (size_t)(t + 2) * kstep; const char* b2 = last ? nB : cB + (size_t)(t + 2) * kstep;
            const char* a3 = a2 + kstep; const char* b3 = b2 + kstep;
            unsigned o2[2][2];
#pragma unroll
            for (int h = 0; h < 2; ++h)
#pragma unroll
                for (int i = 0; i < 2; ++i) { if constexpr (Sched::GATHER) o2[h][i] = last ? na[h][i] : ca[h][i]; else o2[h][i] = ca[h][i]; }
            PG8_LDB(B0, 0, 0); PG8_LDB(B1, 0, 1); PG8_SCHED; PG8_LDA(At, 0, 0); PG8_STAGE(PG8_SA(1, 1), a1, ca[1]);
            PG8_WAIT_V(8); PG8_WAIT_L(0); PG8_BAR; PG8_MMA(0, 0, At, B0); PG8_MMA(0, 1, At, B1); PG8_BAR; PG8_SCHED;
            PG8_LDA(At, 0, 1); PG8_STAGE(PG8_SB(0, 0), b2, voffB); PG8_STAGE(PG8_SB(0, 1), b2 + hstep, voffB); PG8_STAGE(PG8_SA(0, 0), a2, o2[0]);
            PG8_WAIT_V(8); PG8_WAIT_L(0); PG8_BAR; PG8_MMA(1, 0, At, B0); PG8_MMA(1, 1, At, B1); PG8_BAR; PG8_SCHED;
            PG8_LDB(B0, 1, 0); PG8_LDB(B1, 1, 1); PG8_SCHED; PG8_LDA(At, 1, 0); PG8_STAGE(PG8_SA(0, 1), a2, o2[1]);
            PG8_WAIT_V(8); PG8_WAIT_L(0); PG8_BAR; PG8_MMA(0, 0, At, B0); PG8_MMA(0, 1, At, B1); PG8_BAR; PG8_SCHED;
            PG8_LDA(At, 1, 1); PG8_STAGE(PG8_SB(1, 0), b3, voffB); PG8_STAGE(PG8_SB(1, 1), b3 + hstep, voffB); PG8_STAGE(PG8_SA(1, 0), a3, o2[0]);
            PG8_WAIT_V(8); PG8_WAIT_L(0); PG8_BAR; PG8_MMA(1, 0, At, B0); PG8_MMA(1, 1, At, B1); PG8_BAR; PG8_SCHED;
        }
        if constexpr (FP8) { asm volatile("s_nop 15\n\ts_nop 15\n\ts_nop 15" ::: "memory"); PG8_SCHED; }
        if (wr == 0) PG8_BAR;
        E(acc, cur, wr, wc, fr, fq);
        if (!has_next) break;
#pragma unroll
        for (int a = 0; a < 2; ++a)
#pragma unroll
            for (int b = 0; b < 2; ++b)
#pragma unroll
                for (int m = 0; m < 4; ++m)
#pragma unroll
                    for (int n = 0; n < 2; ++n) acc[a][b][m][n] = (f32x4){0.f, 0.f, 0.f, 0.f};
        cur = nxt; cA = nA; cB = nB; ++ui;
        if constexpr (Sched::GATHER) {
#pragma unroll
            for (int h = 0; h < 2; ++h)
#pragma unroll
                for (int i = 0; i < 2; ++i) ca[h][i] = na[h][i];
        }
        if (wr == 1) PG8_BAR;
    }
    PG8_WAIT_V(0);
    PG8_BAR;
#undef PG8_SA
#undef PG8_SB
#undef PG8_STAGE
#undef PG8_LDA
#undef PG8_LDB
#undef PG8_MMA
#undef PG8_WAIT_V
#undef PG8_WAIT_L
#undef PG8_BAR
#undef PG8_SCHED
}
}
#ifndef PROBE_PHASE
#define PROBE_PHASE (-1)
#endif
constexpr size_t SM_LIST = WS_SMALL + 5 * MiB;
constexpr size_t SM_WLIST = WS_SMALL + 9 * MiB;
constexpr int MT_PSTART = 256;
constexpr int MT_CNT = 512;
constexpr int MT_NACT = 768;
constexpr int MT_ATILE = 1024;
constexpr int MT_HIST = 4096;
constexpr int MT_BASE = 4224;
constexpr int MT_REC = 4352;

__device__ __forceinline__ void moe_tables(LAS unsigned char* misc, const unsigned* cnt) {
    LAS int* pstart = (LAS int*)(misc + MT_PSTART); LAS int* cl = (LAS int*)(misc + MT_CNT); LAS int* at = (LAS int*)(misc + MT_ATILE);
    __syncthreads();
    if (threadIdx.x < 64) {
        const int lane = threadIdx.x, e = lane & 31;
        const int c = (int)__hip_atomic_load(cnt + e, __ATOMIC_RELAXED, __HIP_MEMORY_SCOPE_AGENT), nt = (c + 255) >> 8;
        int incl = nt;
#pragma unroll
        for (int o = 1; o < 32; o <<= 1) { const int v = __shfl_up(incl, o); if (e >= o) incl += v; }
        const int t0 = incl - nt;
        if (lane < 32) { cl[e] = c; pstart[e] = t0 << 8; for (int t = 0; t < nt; ++t) at[t0 + t] = (t0 + t) | (e << 12) | (t << 20);
            if (e == 31) { pstart[NE] = incl << 8; *(LAS int*)(misc + MT_NACT) = incl; } }
    }
    __syncthreads();
}

template <int N, int XR>
__device__ __forceinline__ void tr_step(float (&v)[64], int lane) {
    const bool up = (lane & XR) != 0;
#pragma unroll
    for (int i = 0; i < N; ++i) { const float keep = up ? v[i + N] : v[i], send = up ? v[i] : v[i + N]; v[i] = keep + __shfl_xor(send, XR); }
}

__device__ __forceinline__ void route_phase(LAS unsigned char* lds, const float* __restrict__ h2, const float* __restrict__ g2, const float* __restrict__ wr, const float* __restrict__ br,
                                            unsigned char* __restrict__ xn2, int* __restrict__ tke, int* __restrict__ tkpos, float* __restrict__ tkw, int* __restrict__ list, float* __restrict__ wlist,
                                            unsigned* __restrict__ cnt, int G, int bx) {
    const int tid = threadIdx.x, lane = tid & 63; const int wave = __builtin_amdgcn_readfirstlane(tid >> 6);
    LAS float* wT = (LAS float*)lds;
    LAS unsigned char* misc = lds + MISC_OFF;
    LAS int* hist = (LAS int*)(misc + MT_HIST); LAS int* base = (LAS int*)(misc + MT_BASE); LAS int* rec = (LAS int*)(misc + MT_REC);
    for (int idx = tid; idx < NE * D; idx += 512) { const int e = idx >> 10, k = idx & 1023; wT[idx] = wr[(size_t)k * NE + e]; }
    const float bias = br[lane & 31];
    for (int tb = bx; tb < NTOK / 128; tb += G) {
        if (tid < 32) hist[tid] = 0;
        __syncthreads();
        for (int rep_ = 0; rep_ < ((PROBE_PHASE == 6) ? 2 : 1); ++rep_)
        for (int pp = 0; pp < 8; ++pp) {
            const int tl0 = wave * 16 + pp * 2;
            const int row0 = tb * 128 + tl0;
            float xv[2][16];
#pragma unroll
            for (int t = 0; t < 2; ++t) {
                const f32x4* xr = (const f32x4*)(h2 + (size_t)(row0 + t) * D) + lane;
                float ss = 0.f; f32x4 v[4];
#pragma unroll
                for (int j = 0; j < 4; ++j) { v[j] = xr[64 * j]; ss += (v[j][0] * v[j][0] + v[j][1] * v[j][1]) + (v[j][2] * v[j][2] + v[j][3] * v[j][3]); }
                const float rstd = rsqrtf(wave_sum(ss) * (1.0f / D) + EPS);
                unsigned* o4 = (unsigned*)(xn2 + (size_t)(row0 + t) * D) + lane;
#pragma unroll
                for (int j = 0; j < 4; ++j) { const f32x4 gg = ((const f32x4*)g2)[64 * j + lane];
#pragma unroll
                    for (int q = 0; q < 4; ++q) xv[t][4 * j + q] = v[j][q] * rstd * gg[q];
                    o4[64 * j] = pk4_fp8(xv[t][4 * j], xv[t][4 * j + 1], xv[t][4 * j + 2], xv[t][4 * j + 3]); }
            }
            float acc[64];
#pragma unroll
            for (int i = 0; i < 64; ++i) acc[i] = 0.f;
#pragma unroll
            for (int e = 0; e < 32; ++e)
#pragma unroll
                for (int j = 0; j < 4; ++j) {
                    const f32x4 w = *(const LAS f32x4*)(wT + e * 1024 + (64 * j + lane) * 4);
                    acc[e] += (xv[0][4 * j] * w[0] + xv[0][4 * j + 1] * w[1]) + (xv[0][4 * j + 2] * w[2] + xv[0][4 * j + 3] * w[3]);
                    acc[32 + e] += (xv[1][4 * j] * w[0] + xv[1][4 * j + 1] * w[1]) + (xv[1][4 * j + 2] * w[2] + xv[1][4 * j + 3] * w[3]);
                }
            tr_step<32, 32>(acc, lane); tr_step<16, 16>(acc, lane); tr_step<8, 8>(acc, lane); tr_step<4, 4>(acc, lane); tr_step<2, 2>(acc, lane); tr_step<1, 1>(acc, lane);
            const float logit = acc[0] + bias;
            float cur = logit, m0 = 0.f; int myrank = -1;
#pragma unroll
            for (int k = 0; k < 4; ++k) {
                float m = cur;
#pragma unroll
                for (int o = 1; o < 32; o <<= 1) m = fmaxf(m, __shfl_xor(m, o));
                if (k == 0) m0 = m;
                const unsigned long long mask = __ballot(cur == m);
                const unsigned half = (lane < 32) ? (unsigned)mask : (unsigned)(mask >> 32);
                const int sel = __ffs(half) - 1;
                if ((lane & 31) == sel) { myrank = k; cur = -3.0e38f; }
            }
            float ex = (myrank >= 0) ? __expf(logit - m0) : 0.f, sum = ex;
#pragma unroll
            for (int o = 1; o < 32; o <<= 1) sum += __shfl_xor(sum, o);
            if (myrank >= 0 && (PROBE_PHASE != 6 || rep_ == 1)) {
                const int e = lane & 31, tl = tl0 + (lane >> 5);
                const int lp = __hip_atomic_fetch_add(hist + e, 1, __ATOMIC_RELAXED, __HIP_MEMORY_SCOPE_WORKGROUP);
                LAS int* r = rec + (tl * 4 + myrank) * 3; r[0] = e; r[1] = lp; r[2] = __float_as_int(ex / sum);
            }
        }
        __syncthreads();
        if (tid < 32) base[tid] = (int)atomicAdd(&cnt[tid], (unsigned)hist[tid]);
        __syncthreads();
        { const int tl = tid >> 2; const int token = tb * 128 + tl; LAS int* r = rec + tid * 3; const int e = r[0], pos = base[e] + r[1]; const float w = __int_as_float(r[2]);
          tke[token * 4 + (tid & 3)] = e; tkpos[token * 4 + (tid & 3)] = pos; tkw[token * 4 + (tid & 3)] = w;
          list[e * NTOK + pos] = token; wlist[e * NTOK + pos] = w; }
        __syncthreads();
    }
}

__device__ __forceinline__ void combine_phase(LAS unsigned char* misc, void* scratch_out, float* __restrict__ out, const bf16* __restrict__ rows, const int* __restrict__ tke, const int* __restrict__ tkpos, int gw, int NGW, int lane) {
    LAS const int* pstart = (LAS const int*)(misc + MT_PSTART);
    for (int rep_ = 0; rep_ < ((PROBE_PHASE == 9) ? 2 : 1); ++rep_)
    for (int token = gw; token < NTOK; token += NGW) {
        int rr[4];
#pragma unroll
        for (int k = 0; k < 4; ++k) rr[k] = pstart[tke[token * 4 + k]] + tkpos[token * 4 + k];
        f32x4* o = (f32x4*)(out + (size_t)token * D) + lane;
        f32x4 v[4];
#pragma unroll
        for (int j = 0; j < 4; ++j) v[j] = o[64 * j];
#pragma unroll
        for (int k = 0; k < 4; ++k) {
            const u32x2* rp = (const u32x2*)(rows + (size_t)rr[k] * D) + lane;
#pragma unroll
            for (int j = 0; j < 4; ++j) { const u32x2 w = rp[64 * j];
                v[j][0] += __uint_as_float(w.x << 16); v[j][1] += __uint_as_float(w.x & 0xffff0000u); v[j][2] += __uint_as_float(w.y << 16); v[j][3] += __uint_as_float(w.y & 0xffff0000u); }
        }
        if (PROBE_PHASE == 9 && rep_ == 0) {
#pragma unroll
            for (int j = 0; j < 4; ++j) { asm volatile("" :: "v"(v[j])); *(f32x4*)((float*)scratch_out + (size_t)token * D + (64 * j + lane) * 4) = v[j]; }
        } else {
#pragma unroll
        for (int j = 0; j < 4; ++j) o[64 * j] = v[j];
        }
    }
}
struct SchedDense {
    static constexpr bool GATHER = false;
    const char* A; const char* Bt; int K, nM, nN, nwg, G, c;
    __device__ void init(const bf16* A_, const bf16* Bt_, int M, int N, int K_, int G_, int c_) { A = (const char*)A_; Bt = (const char*)Bt_; K = K_; nM = M / 256; nN = N / 256; nwg = nM * nN; G = G_; c = c_; }
    __device__ __forceinline__ bool next(int i, pg8::Unit& u) const {
        const long L = (long)i * G + c; if (L >= nwg) return false;
        int wgid = (int)L; { const int q = nwg / 8, r = nwg % 8, xcd = wgid % 8, off = wgid / 8; wgid = (xcd < r ? xcd * (q + 1) : r * (q + 1) + (xcd - r) * q) + off; }
        const int nig = 8 * nN, gid = wgid / nig, fm = gid * 8, gsz = (nM - fm) < 8 ? (nM - fm) : 8;
        u.pm = fm + ((wgid % nig) % gsz); u.pn = (wgid % nig) / gsz; u.aux = 0; u.tl = 0;
        u.A = A + (size_t)u.pm * 256 * K * 2; u.B = Bt + (size_t)u.pn * 256 * K * 2; return true;
    }
    __device__ __forceinline__ void aoff(const pg8::Unit&, const int (&R)[2], const int (&C)[2], unsigned (&o)[2][2]) const {
#pragma unroll
        for (int h = 0; h < 2; ++h)
#pragma unroll
            for (int i = 0; i < 2; ++i) o[h][i] = (unsigned)((128 * h + R[i]) * K + C[i]) * 2u;
    }
};
struct SchedBranch {
    static constexpr bool GATHER = false;
    const char* A0; const char* A1; const char* B0; const char* B1; int G, c;
    __device__ __forceinline__ bool next(int i, pg8::Unit& u) const {
        const int L = (i >> 1) * G + c; if (L >= 512) return false;
        int wgid = L; { const int off = wgid / 8, xcd = wgid % 8; wgid = xcd * 64 + off; }
        const int nig = 8 * 4, gid = wgid / nig;
        u.pm = gid * 8 + ((wgid % nig) % 8); u.pn = (wgid % nig) / 8; u.aux = i & 1; u.tl = 0;
        u.A = ((i & 1) ? A1 : A0) + (size_t)u.pm * 256 * D * 2; u.B = ((i & 1) ? B1 : B0) + (size_t)u.pn * 256 * D * 2; return true;
    }
    __device__ __forceinline__ void aoff(const pg8::Unit&, const int (&R)[2], const int (&C)[2], unsigned (&o)[2][2]) const {
#pragma unroll
        for (int h = 0; h < 2; ++h)
#pragma unroll
            for (int i = 0; i < 2; ++i) o[h][i] = (unsigned)((128 * h + R[i]) * D + C[i]) * 2u;
    }
};
template <bool GATHER_, int NPN>
struct SchedMoe {
    static constexpr bool GATHER = GATHER_;
    const char* A; const char* Bt; LAS const unsigned char* misc; const int* list; int G, c;
    __device__ __forceinline__ bool next(int i, pg8::Unit& u) const {
        const int nact = *(LAS const int*)(misc + MT_NACT);
        const int L = i * G + c; if (L >= nact * NPN) return false;
        const int k = L / NPN; u.pn = L % NPN; const int w = ((LAS const int*)(misc + MT_ATILE))[k];
        u.pm = w & 0xfff; u.aux = (w >> 12) & 0xff; u.tl = w >> 20;
        u.A = GATHER ? A : A + (size_t)u.pm * 256 * 1024;
        u.B = Bt + ((size_t)u.aux * NPN + u.pn) * 256 * 1024; return true;
    }
    __device__ __forceinline__ void aoff(const pg8::Unit& u, const int (&R)[2], const int (&C)[2], unsigned (&o)[2][2]) const {
        const int ce = ((LAS const int*)(misc + MT_CNT))[u.aux];
#pragma unroll
        for (int h = 0; h < 2; ++h)
#pragma unroll
            for (int i = 0; i < 2; ++i) {
                if (GATHER) { const int idx = u.tl * 256 + 128 * h + R[i]; const int tok = (idx < ce) ? list[u.aux * NTOK + idx] : 0; o[h][i] = (unsigned)tok * 1024u + (unsigned)C[i] * 2u; }
                else o[h][i] = (unsigned)((128 * h + R[i]) * 1024 + C[i] * 2);
            }
    }
};

__device__ __forceinline__ u32x4 pack8(const f32x4& a, const f32x4& b) { u32x4 w; w.x = pk2(a[0], a[1]); w.y = pk2(a[2], a[3]); w.z = pk2(b[0], b[1]); w.w = pk2(b[2], b[3]); return w; }
__device__ __forceinline__ void unpack8(const u32x4& w, float (&f)[8]) {
    f[0] = __uint_as_float(w.x << 16); f[1] = __uint_as_float(w.x & 0xffff0000u); f[2] = __uint_as_float(w.y << 16); f[3] = __uint_as_float(w.y & 0xffff0000u);
    f[4] = __uint_as_float(w.z << 16); f[5] = __uint_as_float(w.z & 0xffff0000u); f[6] = __uint_as_float(w.w << 16); f[7] = __uint_as_float(w.w & 0xffff0000u);
}
struct EpiProj {
    static constexpr bool PERM = true;
    bf16* proj; const float* qg; const float* kg;
    __device__ __forceinline__ void operator()(pg8::Acc& acc, const pg8::Unit& u, int wr, int wc, int fr, int fq) const {
        const int pn = u.pn;
        int mode;
        if (pn < 4) mode = 1; else if (pn == 4) mode = (wc < 2) ? 2 : 0; else if (pn < 7) mode = 0; else if (pn < 9) mode = 3; else if (pn < 13) mode = 0; else if (pn < 17) mode = 4; else mode = 5;
        float gn[2][8];
        if (mode == 1 || mode == 2) { const float* g = (mode == 1) ? qg : kg; const float s = (mode == 1) ? 0.125f : 1.0f;
#pragma unroll
            for (int bj = 0; bj < 2; ++bj)
#pragma unroll
                for (int j = 0; j < 8; ++j) gn[bj][j] = g[32 * bj + 8 * fq + j] * s; }
#pragma unroll
        for (int ai = 0; ai < 2; ++ai)
#pragma unroll
            for (int m = 0; m < 4; ++m) {
                const int r = u.pm * 256 + ai * 128 + wr * 64 + m * 16 + fr;
                bf16* rowp = proj + (size_t)r * INW + pn * 256 + wc * 64 + 8 * fq;
                f32x4 v[2][2];
#pragma unroll
                for (int bj = 0; bj < 2; ++bj) { v[bj][0] = acc[ai][bj][m][0]; v[bj][1] = acc[ai][bj][m][1]; }
                if (mode == 1 || mode == 2) {
                    float ss = 0.f;
#pragma unroll
                    for (int bj = 0; bj < 2; ++bj)
#pragma unroll
                        for (int n = 0; n < 2; ++n) ss += v[bj][n][0] * v[bj][n][0] + v[bj][n][1] * v[bj][n][1] + v[bj][n][2] * v[bj][n][2] + v[bj][n][3] * v[bj][n][3];
                    ss += __shfl_xor(ss, 16); ss += __shfl_xor(ss, 32);
                    const float rs = rsqrtf(ss * (1.0f / 64.0f) + EPS);
#pragma unroll
                    for (int bj = 0; bj < 2; ++bj)
#pragma unroll
                        for (int n = 0; n < 2; ++n)
#pragma unroll
                            for (int i = 0; i < 4; ++i) v[bj][n][i] = v[bj][n][i] * rs * gn[bj][4 * n + i];
                } else if (mode == 3) {
#pragma unroll
                    for (int bj = 0; bj < 2; ++bj)
#pragma unroll
                        for (int n = 0; n < 2; ++n) v[bj][n] = v[bj][n] * 0.08838834764831845f;
                } else if (mode == 4) {
#pragma unroll
                    for (int bj = 0; bj < 2; ++bj)
#pragma unroll
                        for (int n = 0; n < 2; ++n)
#pragma unroll
                            for (int i = 0; i < 4; ++i) { const float x = v[bj][n][i]; v[bj][n][i] = x * sigmoidf_(x); }
                } else if (mode == 5) {
#pragma unroll
                    for (int bj = 0; bj < 2; ++bj)
#pragma unroll
                        for (int n = 0; n < 2; ++n)
#pragma unroll
                            for (int i = 0; i < 4; ++i) v[bj][n][i] = sigmoidf_(v[bj][n][i]);
                }
#pragma unroll
                for (int bj = 0; bj < 2; ++bj) *(u32x4*)(rowp + 32 * bj) = pack8(v[bj][0], v[bj][1]);
            }
    }
};
struct EpiBranch {
    static constexpr bool PERM = true;
    bf16* merged; const bf16* proj;
    __device__ __forceinline__ void operator()(pg8::Acc& acc, const pg8::Unit& u, int wr, int wc, int fr, int fq) const {
        const int gcol = u.aux ? C_GR : C_GA;
#pragma unroll
        for (int ai = 0; ai < 2; ++ai)
#pragma unroll
            for (int m = 0; m < 4; ++m) {
                const int r = u.pm * 256 + ai * 128 + wr * 64 + m * 16 + fr;
#pragma unroll
                for (int bj = 0; bj < 2; ++bj) {
                    const int col = u.pn * 256 + bj * 128 + wc * 32 + 8 * fq;
                    const u32x4 gw = *(const u32x4*)(proj + (size_t)r * INW + gcol + col);
                    float g[8]; unpack8(gw, g);
                    f32x4 a = acc[ai][bj][m][0], b = acc[ai][bj][m][1];
                    a[0] *= g[0]; a[1] *= g[1]; a[2] *= g[2]; a[3] *= g[3]; b[0] *= g[4]; b[1] *= g[5]; b[2] *= g[6]; b[3] *= g[7];
                    bf16* mp = merged + (size_t)r * D + col;
                    if (u.aux) { const u32x4 pw = *(const u32x4*)mp; float p[8]; unpack8(pw, p);
                        a[0] += p[0]; a[1] += p[1]; a[2] += p[2]; a[3] += p[3]; b[0] += p[4]; b[1] += p[5]; b[2] += p[6]; b[3] += p[7]; }
                    *(u32x4*)mp = pack8(a, b);
                }
            }
    }
};
struct EpiOut {
    static constexpr bool PERM = false;
    const float* x; float* out;
    __device__ __forceinline__ void operator()(pg8::Acc& acc, const pg8::Unit& u, int wr, int wc, int fr, int fq) const {
#pragma unroll
        for (int ai = 0; ai < 2; ++ai)
#pragma unroll
            for (int m = 0; m < 4; ++m) {
                const size_t off = (size_t)(u.pm * 256 + ai * 128 + wr * 64 + m * 16 + fr) * D + u.pn * 256 + wc * 32 + 4 * fq;
#pragma unroll
                for (int bj = 0; bj < 2; ++bj)
#pragma unroll
                    for (int n = 0; n < 2; ++n) { const f32x4 xv = *(const f32x4*)(x + off + bj * 128 + n * 16); *(f32x4*)(out + off + bj * 128 + n * 16) = xv + acc[ai][bj][m][n]; }
            }
    }
};
struct EpiGU {
    static constexpr bool PERM = true;
    unsigned char* act; const float* bgu;
    __device__ __forceinline__ void operator()(pg8::Acc& acc, const pg8::Unit& u, int wr, int wc, int fr, int fq) const {
        const int col = u.pn * 128 + wc * 32 + 8 * fq;
        const float* bg = bgu + (size_t)u.aux * 2048 + col;
        float bgate[8], bup[8];
#pragma unroll
        for (int j = 0; j < 8; ++j) { bgate[j] = bg[j]; bup[j] = bg[1024 + j]; }
#pragma unroll
        for (int ai = 0; ai < 2; ++ai)
#pragma unroll
            for (int m = 0; m < 4; ++m) {
                const int r = u.pm * 256 + ai * 128 + wr * 64 + m * 16 + fr;
                float o[8];
#pragma unroll
                for (int n = 0; n < 2; ++n)
#pragma unroll
                    for (int i = 0; i < 4; ++i) {
                        float gate = acc[ai][0][m][n][i] * W8_INV + bgate[4 * n + i], up = acc[ai][1][m][n][i] * W8_INV + bup[4 * n + i];
                        gate = fminf(gate, 7.0f); up = fminf(fmaxf(up, -7.0f), 7.0f);
                        o[4 * n + i] = (up + 1.0f) * gate * sigmoidf_(1.702f * gate);
                    }
                u32x2 w; w.x = pk4_fp8(o[0], o[1], o[2], o[3]); w.y = pk4_fp8(o[4], o[5], o[6], o[7]);
                *(u32x2*)(act + (size_t)r * DFF + col) = w;
            }
    }
};
struct EpiDown {
    static constexpr bool PERM = true;
    bf16* rows; const float* bdn; const float* wlist; LAS const unsigned char* misc;
    __device__ __forceinline__ void operator()(pg8::Acc& acc, const pg8::Unit& u, int wr, int wc, int fr, int fq) const {
        const int ce = ((LAS const int*)(misc + MT_CNT))[u.aux];
        float bb[2][8];
#pragma unroll
        for (int bj = 0; bj < 2; ++bj)
#pragma unroll
            for (int j = 0; j < 8; ++j) bb[bj][j] = bdn[(size_t)u.aux * D + u.pn * 256 + bj * 128 + wc * 32 + 8 * fq + j];
#pragma unroll
        for (int ai = 0; ai < 2; ++ai)
#pragma unroll
            for (int m = 0; m < 4; ++m) {
                const int lr = ai * 128 + wr * 64 + m * 16 + fr, r = u.pm * 256 + lr, idx = u.tl * 256 + lr;
                const float w = (idx < ce) ? wlist[u.aux * NTOK + idx] : 0.f;
#pragma unroll
                for (int bj = 0; bj < 2; ++bj) {
                    f32x4 a = acc[ai][bj][m][0], b = acc[ai][bj][m][1];
#pragma unroll
                    for (int i = 0; i < 4; ++i) { a[i] = (a[i] * W8_INV + bb[bj][i]) * w; b[i] = (b[i] * W8_INV + bb[bj][4 + i]) * w; }
                    *(u32x4*)(rows + (size_t)r * D + u.pn * 256 + bj * 128 + wc * 32 + 8 * fq) = pack8(a, b);
                }
            }
    }
};
namespace attn {
typedef float f32x16 __attribute__((ext_vector_type(16)));
typedef short s16x4 __attribute__((ext_vector_type(4)));
constexpr int NK = 272, K_OFF = 0, V_OFF = 34816, WS_OFF = 69632, OST_OFF = 71680, LDS_END = OST_OFF + 8 * 4096;
constexpr float LOG2E = 1.4426950408889634f;
__device__ __forceinline__ s16x4 vtr(LAS const unsigned char* p) { return __builtin_bit_cast(s16x4, __builtin_amdgcn_ds_read_tr16_b64_v4i16((LAS s16x4*)p)); }
__device__ __forceinline__ int crowc(int r) { return (r & 3) + 8 * (r >> 2); }

template <int TYPE, bool DIAG>
__device__ __forceinline__ void tile(LAS const unsigned char* lds, int kbase, const bf16x8 (&qr)[4], f32x16 (&o)[2], float& l, float lanebase, float c1, int tt, int lane) {
    const int r32 = lane & 31, hi = lane >> 5;
    f32x16 p = {};
#pragma unroll
    for (int d0 = 0; d0 < 4; ++d0) {
        const bf16x8 kf = *(const LAS bf16x8*)(lds + K_OFF + (2 * d0 + hi) * (NK * 16) + (kbase + r32) * 16);
        p = __builtin_amdgcn_mfma_f32_32x32x16_bf16(kf, qr[d0], p, 0, 0, 0);
    }
    constexpr int NR = (TYPE == 0) ? 8 : 16;
    float e[16];
#pragma unroll
    for (int r = 0; r < NR; ++r) {
        const float add = __builtin_fmaf(c1, (float)crowc(r), lanebase);
        float v = __builtin_amdgcn_exp2f(__builtin_fmaf(p[r], LOG2E, add));
        if (DIAG) { const bool ok = (TYPE == 1) ? (crowc(r) > tt) : (crowc(r) <= tt); v = ok ? v : 0.f; }
        e[r] = v; l += v;
    }
    constexpr int NS = (TYPE == 0) ? 1 : 2;
    u32x4 pw[2];
#pragma unroll
    for (int s = 0; s < NS; ++s) { pw[s].x = pk2(e[8 * s + 0], e[8 * s + 1]); pw[s].y = pk2(e[8 * s + 2], e[8 * s + 3]); pw[s].z = pk2(e[8 * s + 4], e[8 * s + 5]); pw[s].w = pk2(e[8 * s + 6], e[8 * s + 7]); }
    LAS const unsigned char* vb = lds + V_OFF + (kbase + 4 * hi + ((lane & 15) >> 2)) * 64 + ((lane >> 4) & 1) * 32 + (lane & 3) * 8;
#pragma unroll
    for (int d0 = 0; d0 < 2; ++d0)
#pragma unroll
        for (int s = 0; s < NS; ++s) {
            const s16x4 lo = vtr(vb + d0 * (NK * 64) + s * 1024), hh = vtr(vb + d0 * (NK * 64) + s * 1024 + 512);
            const bf16x8 vf = (bf16x8){lo[0], lo[1], lo[2], lo[3], hh[0], hh[1], hh[2], hh[3]};
            o[d0] = __builtin_amdgcn_mfma_f32_32x32x16_bf16(__builtin_bit_cast(bf16x8, pw[s]), vf, o[d0], 0, 0, 0);
        }
}

__device__ __forceinline__ void unit(LAS unsigned char* lds, int b, int qb, int kvh, const bf16* __restrict__ proj, const bf16* __restrict__ pmeta, const float* __restrict__ sinks, float bshift, bf16* __restrict__ yatt) {
    const int tid = threadIdx.x, lane = tid & 63, r32 = lane & 31, hi = lane >> 5; const int wave = __builtin_amdgcn_readfirstlane(tid >> 6);
    for (int idx = tid; idx < NK * 8; idx += 512) {
        const int key = idx >> 3, c = idx & 7;
        const bf16* rowp;
        if (key < 16) rowp = pmeta + (size_t)key * INW;
        else { int j = qb * 128 - 128 + (key - 16); if (j < 0) j = 0; rowp = proj + ((size_t)b * SEQ + j) * INW; }
        const u32x4 kv = *(const u32x4*)(rowp + C_AK + kvh * 64 + c * 8);
        const u32x4 vv = *(const u32x4*)(rowp + C_AV + kvh * 64 + c * 8);
        *(LAS u32x4*)(lds + K_OFF + c * (NK * 16) + key * 16) = kv;
        *(LAS u32x4*)(lds + V_OFF + (c >> 2) * (NK * 64) + key * 64 + (c & 3) * 16) = vv;
    }
    __syncthreads();
    const int h = kvh * 8 + wave;
    const float slope = exp2f(-0.5f * (float)(h + 1)), sink = sinks[h];
    const float M = fmaxf(bshift, sink);
    const float c1 = slope * LOG2E;
    LAS float* wsf = (LAS float*)(lds + WS_OFF) + wave * 64;
    LAS bf16* stg = (LAS bf16*)(lds + OST_OFF) + wave * 2048;
    for (int a = 0; a < 4; ++a) {
        const size_t qrow = (size_t)b * SEQ + qb * 128 + 32 * a + r32;
        bf16x8 qr[4];
#pragma unroll
        for (int d0 = 0; d0 < 4; ++d0) qr[d0] = *(const bf16x8*)(proj + qrow * INW + C_AQ + h * 64 + d0 * 16 + hi * 8);
        f32x16 o[2]; o[0] = f32x16{}; o[1] = f32x16{};
        float l = 0.f;
        const int t = 32 * a + r32;
        const int tt = r32 - 4 * hi;
        const float hi4 = c1 * 4.0f * (float)hi;
        tile<0, false>(lds, 0, qr, o, l, -(slope * (float)(qb * 128 + t + 16) + M) * LOG2E + hi4, c1, tt, lane);
        if (qb > 0) {
            tile<1, true>(lds, 16 + 32 * a, qr, o, l, -(slope * (float)(128 + r32) + M) * LOG2E + hi4, c1, tt, lane);
            for (int bb = a + 1; bb < 4; ++bb) tile<1, false>(lds, 16 + 32 * bb, qr, o, l, -(slope * (float)(128 + t - 32 * bb) + M) * LOG2E + hi4, c1, tt, lane);
        }
        for (int bb = 0; bb < a; ++bb) tile<2, false>(lds, 144 + 32 * bb, qr, o, l, -(slope * (float)(t - 32 * bb) + M) * LOG2E + hi4, c1, tt, lane);
        tile<2, true>(lds, 144 + 32 * a, qr, o, l, -(slope * (float)r32 + M) * LOG2E + hi4, c1, tt, lane);
        l += __shfl_xor(l, 32);
        l += exp2f((sink - M) * LOG2E);
        if (hi == 0) wsf[r32] = l;
        LDS_WAIT();
        float rli[16];
#pragma unroll
        for (int r = 0; r < 16; ++r) rli[r] = __builtin_amdgcn_rcpf(wsf[crowc(r) + 4 * hi]);
#pragma unroll
        for (int r = 0; r < 16; ++r) { const int orow = crowc(r) + 4 * hi;
#pragma unroll
            for (int d0 = 0; d0 < 2; ++d0) stg[orow * 64 + d0 * 32 + r32] = f2bf(o[d0][r] * rli[r]); }
        LDS_WAIT();
        bf16* Ow = yatt + ((size_t)b * SEQ + qb * 128 + 32 * a) * D + h * 64;
#pragma unroll
        for (int i = 0; i < 4; ++i) { const int row = i * 8 + (lane >> 3), ch = lane & 7; const u32x4 v = *(const LAS u32x4*)(stg + row * 64 + ch * 8); *(u32x4*)(Ow + (size_t)row * D + ch * 8) = v; }
        LDS_WAIT();
    }
    __syncthreads();
}
}
namespace ret {
typedef float f32x16 __attribute__((ext_vector_type(16)));
typedef short s16x4 __attribute__((ext_vector_type(4)));
constexpr size_t WS_STATES = 893 * MiB;
__device__ __forceinline__ s16x4 vtr(LAS const unsigned char* p) { return __builtin_bit_cast(s16x4, __builtin_amdgcn_ds_read_tr16_b64_v4i16((LAS s16x4*)p)); }
__device__ __forceinline__ int crowc(int r) { return (r & 3) + 8 * (r >> 2); }
__device__ __forceinline__ float lg2gamma(int h) { return log2f(1.0f - exp2f(-5.0f - (float)h)); }

constexpr int R1_BUF = 40960;
__device__ __forceinline__ void state_chain(LAS unsigned char* lds, int b, int h, int dvs, const bf16* __restrict__ proj, const bf16* __restrict__ pmeta, bf16* __restrict__ states) {
    const int tid = threadIdx.x, lane = tid & 63, hi = lane >> 5; const int wave = __builtin_amdgcn_readfirstlane(tid >> 6);
    const float lg = lg2gamma(h), g128 = exp2f(lg * 128.0f);
    u32x4 kreg[4], vreg;
#define RET_ISSUE(c_) do { const int c__ = (c_); \
        _Pragma("unroll") for (int i = 0; i < 4; ++i) { const int idx = tid + 512 * i, key = idx >> 4, ch = idx & 15; \
            if (c__ == 0) { kreg[i] = (key >= 112) ? *(const u32x4*)(pmeta + (size_t)(key - 112) * INW + C_RK + h * 128 + ch * 8) : (u32x4){0u, 0u, 0u, 0u}; } \
            else kreg[i] = *(const u32x4*)(proj + ((size_t)b * SEQ + (c__ - 1) * 128 + key) * INW + C_RK + h * 128 + ch * 8); } \
        { const int key = tid >> 2, ch = tid & 3; \
          if (c__ == 0) vreg = (key >= 112) ? *(const u32x4*)(pmeta + (size_t)(key - 112) * INW + C_RV + h * 256 + dvs * 32 + ch * 8) : (u32x4){0u, 0u, 0u, 0u}; \
          else vreg = *(const u32x4*)(proj + ((size_t)b * SEQ + (c__ - 1) * 128 + key) * INW + C_RV + h * 256 + dvs * 32 + ch * 8); } } while (0)
    const float vscale = exp2f(lg * (float)(127 - (tid >> 2)));
    f32x16 acc = {};
    RET_ISSUE(0);
    for (int c = 0; c < 32; ++c) {
        LAS unsigned char* buf = lds + (c & 1) * R1_BUF;
#pragma unroll
        for (int i = 0; i < 4; ++i) { const int idx = tid + 512 * i, key = idx >> 4, ch = idx & 15; *(LAS u32x4*)(buf + (ch >> 2) * (128 * 64) + key * 64 + (ch & 3) * 16) = kreg[i]; }
        { const int key = tid >> 2, ch = tid & 3; float f[8]; unpack8(vreg, f); u32x4 w;
          w.x = pk2(f[0] * vscale, f[1] * vscale); w.y = pk2(f[2] * vscale, f[3] * vscale); w.z = pk2(f[4] * vscale, f[5] * vscale); w.w = pk2(f[6] * vscale, f[7] * vscale);
          *(LAS u32x4*)(buf + 32768 + key * 64 + ch * 16) = w; }
        if (c + 1 < 32) RET_ISSUE(c + 1);
        __syncthreads();
        if (wave < 4) {
            const int dt = wave;
            acc = acc * g128;
            LAS const unsigned char* ab = buf + dt * (128 * 64) + (4 * hi + ((lane & 15) >> 2)) * 64 + ((lane >> 4) & 1) * 32 + (lane & 3) * 8;
            LAS const unsigned char* bb = buf + 32768 + (4 * hi + ((lane & 15) >> 2)) * 64 + ((lane >> 4) & 1) * 32 + (lane & 3) * 8;
#pragma unroll
            for (int ks = 0; ks < 8; ++ks) {
                const s16x4 al = vtr(ab + ks * 1024), ah = vtr(ab + ks * 1024 + 512), bl = vtr(bb + ks * 1024), bh = vtr(bb + ks * 1024 + 512);
                const bf16x8 af = (bf16x8){al[0], al[1], al[2], al[3], ah[0], ah[1], ah[2], ah[3]}, bfr = (bf16x8){bl[0], bl[1], bl[2], bl[3], bh[0], bh[1], bh[2], bh[3]};
                acc = __builtin_amdgcn_mfma_f32_32x32x16_bf16(af, bfr, acc, 0, 0, 0);
            }
            bf16* sb = states + ((((size_t)(b * 4 + h) * 32 + c) * 8 + dvs) * 8) * 512;
#pragma unroll
            for (int g = 0; g < 4; ++g) { u32x2 w; w.x = pk2(acc[4 * g], acc[4 * g + 1]); w.y = pk2(acc[4 * g + 2], acc[4 * g + 3]);
                *(u32x2*)(sb + (size_t)(2 * dt + (g >> 1)) * 512 + (32 * (g & 1) + (lane & 31)) * 8 + 4 * hi) = w; }
        }
    }
    __syncthreads();
#undef RET_ISSUE
}

constexpr int R3_K = 0, R3_V = 32768;
__device__ __forceinline__ void out_unit(LAS unsigned char* lds, int b, int h, int tb, const bf16* __restrict__ proj, const bf16* __restrict__ states, bf16* __restrict__ yret) {
    const int tid = threadIdx.x, lane = tid & 63, r32 = lane & 31, hi = lane >> 5; const int wave = __builtin_amdgcn_readfirstlane(tid >> 6);
    const float lg = lg2gamma(h);
    const size_t row0 = (size_t)b * SEQ + tb * 128;
    for (int idx = tid; idx < 128 * 16; idx += 512) { const int key = idx >> 4, ch = idx & 15;
        *(LAS u32x4*)(lds + R3_K + ch * (128 * 16) + key * 16) = *(const u32x4*)(proj + (row0 + key) * INW + C_RK + h * 128 + ch * 8); }
    for (int idx = tid; idx < 128 * 32; idx += 512) { const int key = idx >> 5, ch = idx & 31;
        *(LAS u32x4*)(lds + R3_V + (ch >> 2) * (128 * 64) + key * 64 + (ch & 3) * 16) = *(const u32x4*)(proj + (row0 + key) * INW + C_RV + h * 256 + ch * 8); }
    const int a = wave & 3, dvh = wave >> 2;
    bf16x8 qr[8];
#pragma unroll
    for (int k = 0; k < 8; ++k) qr[k] = *(const bf16x8*)(proj + (row0 + 32 * a + r32) * INW + C_RQ + h * 128 + k * 16 + hi * 8);
    __syncthreads();
    f32x16 o[4];
#pragma unroll
    for (int d = 0; d < 4; ++d) o[d] = f32x16{};
    const float cpos = -lg;
    const int tt = r32 - 4 * hi;
    for (int bb = 0; bb <= a; ++bb) {
        f32x16 p = {};
#pragma unroll
        for (int k = 0; k < 8; ++k) { const bf16x8 kf = *(const LAS bf16x8*)(lds + R3_K + (2 * k + hi) * (128 * 16) + (32 * bb + r32) * 16); p = __builtin_amdgcn_mfma_f32_32x32x16_bf16(kf, qr[k], p, 0, 0, 0); }
        const float lanebase = lg * (float)(32 * (a - bb) + r32 - 4 * hi);
        float e[16];
#pragma unroll
        for (int r = 0; r < 16; ++r) { float v = p[r] * __builtin_amdgcn_exp2f(__builtin_fmaf(cpos, (float)crowc(r), lanebase)); if (bb == a) v = (crowc(r) <= tt) ? v : 0.f; e[r] = v; }
        u32x4 pw[2];
#pragma unroll
        for (int s = 0; s < 2; ++s) { pw[s].x = pk2(e[8 * s + 0], e[8 * s + 1]); pw[s].y = pk2(e[8 * s + 2], e[8 * s + 3]); pw[s].z = pk2(e[8 * s + 4], e[8 * s + 5]); pw[s].w = pk2(e[8 * s + 6], e[8 * s + 7]); }
        LAS const unsigned char* vb = lds + R3_V + (32 * bb + 4 * hi + ((lane & 15) >> 2)) * 64 + ((lane >> 4) & 1) * 32 + (lane & 3) * 8;
#pragma unroll
        for (int d = 0; d < 4; ++d)
#pragma unroll
            for (int s = 0; s < 2; ++s) {
                const s16x4 lo = vtr(vb + (4 * dvh + d) * (128 * 64) + s * 1024), hh = vtr(vb + (4 * dvh + d) * (128 * 64) + s * 1024 + 512);
                const bf16x8 vf = (bf16x8){lo[0], lo[1], lo[2], lo[3], hh[0], hh[1], hh[2], hh[3]};
                o[d] = __builtin_amdgcn_mfma_f32_32x32x16_bf16(__builtin_bit_cast(bf16x8, pw[s]), vf, o[d], 0, 0, 0);
            }
    }
    {
        float din[16];
#pragma unroll
        for (int r = 0; r < 16; ++r) din[r] = __builtin_amdgcn_exp2f(lg * (float)(32 * a + crowc(r) + 4 * hi + 1));
        const bf16* sb = states + (((size_t)(b * 4 + h) * 32 + tb) * 64) * 512 + lane * 8;
#pragma unroll
        for (int d = 0; d < 4; ++d) {
            f32x16 x = {};
#pragma unroll
            for (int k = 0; k < 8; ++k) { const bf16x8 sf = *(const bf16x8*)(sb + (size_t)((4 * dvh + d) * 8 + k) * 512); x = __builtin_amdgcn_mfma_f32_32x32x16_bf16(qr[k], sf, x, 0, 0, 0); }
#pragma unroll
            for (int r = 0; r < 16; ++r) o[d][r] += din[r] * x[r];
        }
    }
    __syncthreads();
    LAS float* stg = (LAS float*)lds;
#pragma unroll
    for (int d = 0; d < 4; ++d)
#pragma unroll
        for (int r = 0; r < 16; ++r) stg[(32 * a + crowc(r) + 4 * hi) * 256 + (4 * dvh + d) * 32 + r32] = o[d][r];
    __syncthreads();
    for (int i = 0; i < 16; ++i) {
        const int q = wave * 16 + i;
        const f32x4 v = *(const LAS f32x4*)(stg + q * 256 + lane * 4);
        const float ss = wave_sum((v[0] * v[0] + v[1] * v[1]) + (v[2] * v[2] + v[3] * v[3]));
        const float rs = rsqrtf(ss * (1.0f / 256.0f) + EPS);
        const u32x2 gw = *(const u32x2*)(proj + (row0 + q) * INW + C_RG + h * 256 + lane * 4);
        u32x2 w; w.x = pk2(v[0] * rs * __uint_as_float(gw.x << 16), v[1] * rs * __uint_as_float(gw.x & 0xffff0000u)); w.y = pk2(v[2] * rs * __uint_as_float(gw.y << 16), v[3] * rs * __uint_as_float(gw.y & 0xffff0000u));
        *(u32x2*)(yret + (row0 + q) * D + h * 256 + lane * 4) = w;
    }
    __syncthreads();
}
}
template <bool FP8>
__device__ __forceinline__ void p0_item(const float* __restrict__ W, int K, int N, void* __restrict__ WT, int k0, int n0, int dst_row0, int lane) {
    const int kblk = lane >> 3, nq = lane & 7;
    const float* src = W + (size_t)(k0 + 16 * kblk) * N + n0 + 4 * nq;
    f32x4 v[16];
#pragma unroll
    for (int i = 0; i < 16; ++i) v[i] = *(const f32x4*)(src + (size_t)i * N);
#pragma unroll
    for (int j = 0; j < 4; ++j) {
        const size_t row = (size_t)(dst_row0 + 4 * nq + j);
        if constexpr (FP8) {
            u32x4 o;
            o.x = pk4_fp8(v[0][j] * W8_SCALE, v[1][j] * W8_SCALE, v[2][j] * W8_SCALE, v[3][j] * W8_SCALE); o.y = pk4_fp8(v[4][j] * W8_SCALE, v[5][j] * W8_SCALE, v[6][j] * W8_SCALE, v[7][j] * W8_SCALE);
            o.z = pk4_fp8(v[8][j] * W8_SCALE, v[9][j] * W8_SCALE, v[10][j] * W8_SCALE, v[11][j] * W8_SCALE); o.w = pk4_fp8(v[12][j] * W8_SCALE, v[13][j] * W8_SCALE, v[14][j] * W8_SCALE, v[15][j] * W8_SCALE);
            *(u32x4*)((unsigned char*)WT + row * K + k0 + 16 * kblk) = o;
        } else {
            u32x4 a, b;
            a.x = pk2(v[0][j], v[1][j]); a.y = pk2(v[2][j], v[3][j]); a.z = pk2(v[4][j], v[5][j]); a.w = pk2(v[6][j], v[7][j]);
            b.x = pk2(v[8][j], v[9][j]); b.y = pk2(v[10][j], v[11][j]); b.z = pk2(v[12][j], v[13][j]); b.w = pk2(v[14][j], v[15][j]);
            bf16* d = (bf16*)WT + row * K + k0 + 16 * kblk;
            *(u32x4*)d = a; *(u32x4*)(d + 8) = b;
        }
    }
}
#ifndef PROBE_PHASE
#define PROBE_PHASE (-1)
#endif
__device__ __forceinline__ void p0_transpose_item_fp8(const float* W, int K, int N, unsigned char* WT, int k0, int n0, int dst_row0, LAS float* scr, int lane) {
#pragma unroll 8
    for (int i = 0; i < 32; ++i) { const int kk = 2 * i + (lane >> 5); scr[kk * 33 + (lane & 31)] = W[(size_t)(k0 + kk) * N + n0 + (lane & 31)]; }
    LDS_WAIT(); asm volatile("" ::: "memory");
    const int c = lane & 3;
#pragma unroll
    for (int j = 0; j < 2; ++j) { const int n = (lane >> 2) + 16 * j; const LAS float* s = scr + (16 * c) * 33 + n;
        u32x4 o;
        o.x = pk4_fp8(s[0 * 33] * W8_SCALE, s[1 * 33] * W8_SCALE, s[2 * 33] * W8_SCALE, s[3 * 33] * W8_SCALE); o.y = pk4_fp8(s[4 * 33] * W8_SCALE, s[5 * 33] * W8_SCALE, s[6 * 33] * W8_SCALE, s[7 * 33] * W8_SCALE);
        o.z = pk4_fp8(s[8 * 33] * W8_SCALE, s[9 * 33] * W8_SCALE, s[10 * 33] * W8_SCALE, s[11 * 33] * W8_SCALE); o.w = pk4_fp8(s[12 * 33] * W8_SCALE, s[13 * 33] * W8_SCALE, s[14 * 33] * W8_SCALE, s[15 * 33] * W8_SCALE);
        *(u32x4*)(WT + (size_t)(dst_row0 + n) * K + k0 + 16 * c) = o; }
    LDS_WAIT(); asm volatile("" ::: "memory");
}
struct Args { const float* in[17]; float* out; unsigned char* ws; int ph_lo, ph_hi, li, pad; };

__global__ void __launch_bounds__(512, 2) mk_fwd(Args args) {
    extern __shared__ __attribute__((aligned(16))) unsigned char lds_raw[];
    LAS unsigned char* lds = (LAS unsigned char*)lds_raw;
    volatile LAS unsigned* MISC = (volatile LAS unsigned*)(lds + MISC_OFF);
    const int tid = threadIdx.x, lane = tid & 63, wave = __builtin_amdgcn_readfirstlane(tid >> 6);
    const int G = gridDim.x, bx = blockIdx.x;
    const int vcu = (G % 8 == 0) ? (bx % 8) * (G / 8) + bx / 8 : bx;
    unsigned char* ws = args.ws;
    unsigned* ctl = (unsigned*)(ws + WS_CTL);
    const float* x = args.in[0]; const float* meta = args.in[1]; const float* g1 = args.in[2]; const float* w_in = args.in[3];
    const float* qg = args.in[4]; const float* kg = args.in[5];
    const float* w_ab = args.in[7]; const float* w_rb = args.in[8]; const float* w_out = args.in[9];
    const float* w_gu = args.in[13]; const float* b_gu = args.in[14]; const float* w_dn = args.in[15]; const float* b_dn = args.in[16];
    float* out = args.out;
    bf16* Win_t = (bf16*)(ws + WS_WIN); bf16* Wab_t = (bf16*)(ws + WS_WAB); bf16* Wrb_t = (bf16*)(ws + WS_WRB); bf16* Wout_t = (bf16*)(ws + WS_WOUT);
    unsigned char* Wgu_t = ws + WS_WGU; unsigned char* Wdn_t = ws + WS_WDN;
    bf16* xb = (bf16*)(ws + WS_XB); bf16* proj = (bf16*)(ws + WS_PROJ); bf16* yatt = (bf16*)(ws + WS_YATT); bf16* yret = (bf16*)(ws + WS_YRET); bf16* merged = (bf16*)(ws + WS_MERGED);
    bf16* pmeta = proj + (size_t)NTOK * INW;
    const float* sinks = args.in[6]; const float* g2 = args.in[10]; const float* w_r = args.in[11]; const float* b_r = args.in[12];
    int* tke = (int*)(ws + SM_TKE); float* tkw = (float*)(ws + SM_TKW); int* tkpos = (int*)(ws + SM_TKPOS); int* list = (int*)(ws + SM_LIST); float* wlist = (float*)(ws + SM_WLIST);
    LAS unsigned char* misc = lds + MISC_OFF;
    bf16* states = (bf16*)(ws + ret::WS_STATES);
    unsigned char* act = ws + WS_ACT; bf16* rows = (bf16*)(ws + WS_ROWS); unsigned char* xn8 = ws + WS_XB;

    for (int u = tid; u < (LDS_BYTES - MISC_OFF) / 4; u += 512) ((LAS unsigned*)(lds + MISC_OFF))[u] = 0u;
    __syncthreads();
    XcdBarrier bar = xcd_barrier_post(ctl + CW_BAR + args.li * XCD_BAR_WORDS, MISC + 8);
    const int lo = args.ph_lo, hi = args.ph_hi;
#define IN(k) (lo <= (k) && (k) < hi)
#define BOTH(k) (IN(k) && IN((k) + 1))
#define GRID_BAR() xcd_barrier(bar)

    if (IN(0)) { for (int rep_ = 0; rep_ < ((PROBE_PHASE == 0) ? 2 : 1); ++rep_) {
        const int gw = vcu * NWAVES + wave, NGW = G * NWAVES;
        constexpr int I_IN = 8 * 200, I_SQ = 8 * 32, I_GU = 32 * 8 * 64, I_DN = 32 * 8 * 32;
        constexpr int NITEMS = I_IN + 3 * I_SQ + I_GU + I_DN;
        for (int rep2_ = 0; rep2_ < ((PROBE_PHASE == 100) ? 2 : 1); ++rep2_)
        for (int it = gw; it < NITEMS; it += NGW) {
            int r = it;
            if (r < I_IN) { const int kb = r / 200, nb = r % 200, n0 = nb * 32, o = n0 & 255, wcc = o >> 6, bj = (o >> 5) & 1;
                p0_item<false>(w_in, D, INW, Win_t, kb * 128, n0, (n0 & ~255) + 128 * bj + 32 * wcc, lane); continue; }
            r -= I_IN;
            if (r < I_SQ) { p0_item<false>(w_ab, D, D, Wab_t, (r / 32) * 128, (r % 32) * 32, (r % 32) * 32, lane); continue; } r -= I_SQ;
            if (r < I_SQ) { p0_item<false>(w_rb, D, D, Wrb_t, (r / 32) * 128, (r % 32) * 32, (r % 32) * 32, lane); continue; } r -= I_SQ;
            if (r < I_SQ) { p0_item<false>(w_out, D, D, Wout_t, (r / 32) * 128, (r % 32) * 32, (r % 32) * 32, lane); continue; } r -= I_SQ;
            if (r < I_GU) { const int e = r / 512, q = r % 512, kb = q / 64, nb = q % 64, n0 = nb * 32, bj = n0 >> 10, rem = n0 & 1023, pn = rem >> 7, cl = rem & 127;
                p0_item<true>(w_gu + (size_t)e * D * 2048, D, 2048, Wgu_t + (size_t)e * 2048 * D, kb * 128, n0, 256 * pn + 128 * bj + cl, lane); continue; }
            r -= I_GU;
            { const int e = r / 256, q = r % 256, kb = q / 32, nb = q % 32;
              p0_item<true>(w_dn + (size_t)e * DFF * D, DFF, D, Wdn_t + (size_t)e * D * DFF, kb * 128, nb * 32, nb * 32, lane); }
        }
        for (int rep2_ = 0; rep2_ < ((PROBE_PHASE == 101) ? 2 : 1); ++rep2_)
        for (int row = gw; row < NTOK; row += NGW) {
            const f32x4* xr = (const f32x4*)(x + (size_t)row * D) + lane;
            f32x4 v[4]; float ss = 0.f;
#pragma unroll
            for (int j = 0; j < 4; ++j) { v[j] = xr[64 * j]; ss += (v[j][0] * v[j][0] + v[j][1] * v[j][1]) + (v[j][2] * v[j][2] + v[j][3] * v[j][3]); }
            const float rstd = rsqrtf(wave_sum(ss) * (1.0f / D) + EPS);
            u32x2* o8 = (u32x2*)(xb + (size_t)row * D) + lane;
#pragma unroll
            for (int j = 0; j < 4; ++j) { const f32x4 gg = ((const f32x4*)g1)[64 * j + lane]; u32x2 w; w.x = pk2(v[j][0] * rstd * gg[0], v[j][1] * rstd * gg[1]); w.y = pk2(v[j][2] * rstd * gg[2], v[j][3] * rstd * gg[3]); o8[64 * j] = w; }
        }
        for (int row = gw; row < 256; row += NGW) {
            u32x2* o8 = (u32x2*)(xb + (size_t)(NTOK + row) * D) + lane;
            if (row < NMETA) {
                const f32x4* xr = (const f32x4*)(meta + (size_t)row * D) + lane;
                f32x4 v[4]; float ss = 0.f;
#pragma unroll
                for (int j = 0; j < 4; ++j) { v[j] = xr[64 * j]; ss += (v[j][0] * v[j][0] + v[j][1] * v[j][1]) + (v[j][2] * v[j][2] + v[j][3] * v[j][3]); }
                const float rstd = rsqrtf(wave_sum(ss) * (1.0f / D) + EPS);
#pragma unroll
                for (int j = 0; j < 4; ++j) { const f32x4 gg = ((const f32x4*)g1)[64 * j + lane]; u32x2 w; w.x = pk2(v[j][0] * rstd * gg[0], v[j][1] * rstd * gg[1]); w.y = pk2(v[j][2] * rstd * gg[2], v[j][3] * rstd * gg[3]); o8[64 * j] = w; }
            } else {
#pragma unroll
                for (int j = 0; j < 4; ++j) o8[64 * j] = (u32x2){0u, 0u};
            }
        }
        __syncthreads(); }
        if (BOTH(0)) GRID_BAR();
    }
    if (IN(1)) {
        SchedDense S; S.init(xb, Win_t, NTOK + 256, INW, D, G, bx);
        EpiProj E{proj, qg, kg};
        for (int rep_ = 0; rep_ < ((PROBE_PHASE == 1) ? 2 : 1); ++rep_) pg8::gemm_phase<EpiProj, SchedDense>(lds, 2 * D, S, E);
        if (BOTH(1)) GRID_BAR();
    }
    if (IN(2)) {
        float mq = fabsf(qg[lane]), mk = fabsf(kg[lane]);
#pragma unroll
        for (int o = 1; o < 64; o <<= 1) { mq = fmaxf(mq, __shfl_xor(mq, o)); mk = fmaxf(mk, __shfl_xor(mk, o)); }
        const float bshift = 8.0f * mq * mk;
        for (int rep_ = 0; rep_ < ((PROBE_PHASE == 20) ? 2 : 1); ++rep_) for (int u = bx; u < NB * 32 * 2; u += G) attn::unit(lds, u >> 6, (u >> 1) & 31, u & 1, proj, pmeta, sinks, bshift, yatt);
        for (int rep_ = 0; rep_ < ((PROBE_PHASE == 21) ? 2 : 1); ++rep_) for (int u = bx; u < NB * 4 * 8; u += G) ret::state_chain(lds, u >> 5, (u >> 3) & 3, u & 7, proj, pmeta, states);
        if (BOTH(2)) GRID_BAR();
    }
    if (IN(3)) {
        for (int rep_ = 0; rep_ < ((PROBE_PHASE == 3) ? 2 : 1); ++rep_) for (int u = bx; u < NB * 4 * 32; u += G) ret::out_unit(lds, u >> 7, (u >> 5) & 3, u & 31, proj, states, yret);
        if (BOTH(3)) GRID_BAR();
    }
    if (IN(4)) {
        SchedBranch S{(const char*)yatt, (const char*)yret, (const char*)Wab_t, (const char*)Wrb_t, G, bx};
        EpiBranch E{merged, proj};
        for (int rep_ = 0; rep_ < ((PROBE_PHASE == 4) ? 2 : 1); ++rep_) pg8::gemm_phase<EpiBranch, SchedBranch>(lds, 2 * D, S, E);
        if (BOTH(4)) GRID_BAR();
    }
    if (IN(5)) {
        SchedDense S; S.init(merged, Wout_t, NTOK, D, D, G, bx);
        EpiOut E{x, out};
        for (int rep_ = 0; rep_ < ((PROBE_PHASE == 5) ? 2 : 1); ++rep_) pg8::gemm_phase<EpiOut, SchedDense>(lds, 2 * D, S, E);
        if (BOTH(5)) GRID_BAR();
    }
    if (IN(6)) {
        route_phase(lds, out, g2, w_r, b_r, xn8, tke, tkpos, tkw, list, wlist, ctl + CW_CNT, G, bx);
        if (BOTH(6)) GRID_BAR();
    }
    if (hi > 7 && lo <= 9) moe_tables(misc, ctl + CW_CNT);
    if (IN(7)) {
        SchedMoe<true, 8> S{(const char*)xn8, (const char*)Wgu_t, misc, list, G, bx};
        EpiGU E{act, b_gu};
        for (int rep_ = 0; rep_ < ((PROBE_PHASE == 7) ? 2 : 1); ++rep_) pg8::gemm_phase<EpiGU, SchedMoe<true, 8>, true>(lds, D, S, E);
        if (BOTH(7)) GRID_BAR();
    }
    if (IN(8)) {
        SchedMoe<false, 4> S{(const char*)act, (const char*)Wdn_t, misc, list, G, bx};
        EpiDown E{rows, b_dn, wlist, misc};
        for (int rep_ = 0; rep_ < ((PROBE_PHASE == 8) ? 2 : 1); ++rep_) pg8::gemm_phase<EpiDown, SchedMoe<false, 4>, true>(lds, DFF, S, E);
        if (BOTH(8)) GRID_BAR();
    }
    if (IN(9)) combine_phase(misc, (void*)proj, out, rows, tke, tkpos, vcu * NWAVES + wave, G * NWAVES, lane);
#undef IN
#undef BOTH
#undef GRID_BAR
}

extern "C" void kernel_launch(void* const* d_in, const int* in_sizes, int n_in, void* d_out, int out_size, void* d_ws, size_t ws_size, hipStream_t stream) {
    static int grid = 0;
    if (grid == 0) {
        if (n_in != 17 || in_sizes[0] != NTOK * D || out_size != NTOK * D || ws_size < WS_END) {
            fprintf(stderr, "kernel_launch: unexpected shapes (n_in %d in0 %d out %d ws %zu)\n", n_in, n_in > 0 ? in_sizes[0] : -1, out_size, ws_size); grid = -1; return; }
        int dev = 0, cus = 0;
        if (hipGetDevice(&dev) != hipSuccess || hipDeviceGetAttribute(&cus, hipDeviceAttributeMultiprocessorCount, dev) != hipSuccess) { grid = -1; return; }
        if (hipFuncSetAttribute((const void*)mk_fwd, hipFuncAttributeMaxDynamicSharedMemorySize, LDS_BYTES) != hipSuccess) { fprintf(stderr, "kernel_launch: hipFuncSetAttribute failed\n"); grid = -1; return; }
        grid = cus;
    }
    if (grid < 0) return;
    unsigned char* ws = (unsigned char*)d_ws;
    (void)hipMemsetAsync(ws + WS_CTL, 0, 1 * MiB, stream);
    Args a{};
    for (int i = 0; i < 17; ++i) a.in[i] = (const float*)d_in[i];
    a.out = (float*)d_out; a.ws = ws; a.ph_lo = 0; a.ph_hi = 10; a.li = 0; a.pad = 0;
    hipLaunchKernelGGL(mk_fwd, dim3(grid), dim3(512), LDS_BYTES, stream, a);
}
```

```cpp
#include <hip/hip_runtime.h>
#include <cstdio>
#include <cstdint>

typedef unsigned short bf16;
__device__ __forceinline__ float bf2f(bf16 v) { return __uint_as_float(((unsigned)v) << 16); }
__device__ __forceinline__ bf16 f2bf(float f) { unsigned u = __float_as_uint(f); return (bf16)((u + 0x7fffu + ((u >> 16) & 1u)) >> 16); }
__device__ __forceinline__ float sigmoidf_(float x) { return 1.0f / (1.0f + __expf(-x)); }

constexpr int NB = 8, SEQ = 4096, D = 1024, NTOK = NB * SEQ;
constexpr int NMETA = 16;
constexpr int INW = 6400;
constexpr int C_AQ = 0, C_AK = 1024, C_AV = 1152, C_RQ = 1280, C_RK = 1792, C_RV = 2304, C_RG = 3328, C_GA = 4352, C_GR = 5376;
constexpr int NE = 32, TOPK = 4, DFF = 1024;
constexpr int NROWS = (NTOK * TOPK / 256 + NE) * 256;
constexpr int NTILE = NROWS / 256;
constexpr float EPS = 1e-5f;

constexpr size_t MiB = 1u << 20;
constexpr size_t WS_CTL = 0;
constexpr size_t WS_SMALL = 1 * MiB;
constexpr size_t WS_W = 16 * MiB;
constexpr size_t WS_XB = 232 * MiB;
constexpr size_t WS_PROJ = 297 * MiB;
constexpr size_t WS_YATT = 701 * MiB;
constexpr size_t WS_YRET = 765 * MiB;
constexpr size_t WS_MERGED = 829 * MiB;
constexpr size_t WS_END = 1020 * MiB;
constexpr size_t WS_ACT = 297 * MiB;
constexpr size_t WS_ROWS = 568 * MiB;
constexpr size_t SM_UMETA = WS_SMALL;
constexpr size_t SM_PMETA = WS_SMALL + 64 * 1024;
constexpr size_t SM_TKE = WS_SMALL + 512 * 1024;
constexpr size_t SM_TKW = SM_TKE + 512 * 1024;
constexpr size_t SM_TKPOS = SM_TKW + 512 * 1024;
constexpr size_t SM_TKROW = SM_TKPOS + 512 * 1024;
constexpr size_t SM_ROWTOK = SM_TKROW + 512 * 1024;
constexpr size_t SM_ROWW = SM_ROWTOK + 1024 * 1024;
constexpr size_t SM_TILEE = SM_ROWW + 1024 * 1024;
constexpr int CW_CNT = 1024;

#define LAS __attribute__((address_space(3)))
#define GAS __attribute__((address_space(1)))
typedef short bf16x8 __attribute__((ext_vector_type(8)));
typedef float f32x4 __attribute__((ext_vector_type(4)));
typedef float f32x2 __attribute__((ext_vector_type(2)));
typedef unsigned u32x4 __attribute__((ext_vector_type(4)));
typedef unsigned u32x2 __attribute__((ext_vector_type(2)));
#define LDS_WAIT() asm volatile("s_waitcnt lgkmcnt(0)" ::: "memory")
#define VM_WAIT() asm volatile("s_waitcnt vmcnt(0)" ::: "memory")
__device__ __forceinline__ unsigned pk2(float lo, float hi) { return (unsigned)f2bf(lo) | ((unsigned)f2bf(hi) << 16); }
__device__ __forceinline__ unsigned pk4_fp8(float a, float b, float c, float d) { int w = __builtin_amdgcn_cvt_pk_fp8_f32(a, b, 0, false); w = __builtin_amdgcn_cvt_pk_fp8_f32(c, d, w, true); return (unsigned)w; }
constexpr float W8_SCALE = 64.0f, W8_INV = 1.0f / 64.0f;
__device__ __forceinline__ float wave_sum(float v) {
#pragma unroll
    for (int o = 1; o < 64; o <<= 1) v += __shfl_xor(v, o);
    return v;
}

constexpr size_t WS_WIN = WS_W;
constexpr size_t WS_WAB = WS_W + 13 * MiB;
constexpr size_t WS_WRB = WS_W + 15 * MiB;
constexpr size_t WS_WOUT = WS_W + 17 * MiB;
constexpr size_t WS_WGU = WS_W + 19 * MiB;
constexpr size_t WS_WDN = WS_W + 147 * MiB;
static_assert(WS_WDN + 64 * MiB <= WS_XB, "weight map");
constexpr size_t SM_ATILE = SM_TILEE + 4096;
constexpr int CW_NACT = 1088;
constexpr int CW_BAR = 4096;

constexpr int RING_BYTES = 131072;
constexpr int MISC_OFF = RING_BYTES;
constexpr int LDS_BYTES = 147456;
constexpr int NWAVES = 8;

#define XB_TMO      128
#define XB_XCNT(j)  (256  + 64 * (j))
#define XB_XSUB(j)  (1280 + 64 * (j))
#define XB_XGEN(j)  (2304 + 64 * (j))
#define XB_TOP      3328
#define XB_TOPGEN   3392
#define XCD_BAR_WORDS 3456
#define XB_SPIN_CAP (1u << 20)
__device__ __forceinline__ unsigned xb_ld(unsigned* p)              { return __hip_atomic_load(p, __ATOMIC_RELAXED, __HIP_MEMORY_SCOPE_AGENT); }
__device__ __forceinline__ unsigned xb_add(unsigned* p, unsigned v) { return __hip_atomic_fetch_add(p, v, __ATOMIC_RELAXED, __HIP_MEMORY_SCOPE_AGENT); }
__device__ __forceinline__ unsigned xb_xcc_id() { return (unsigned)__builtin_amdgcn_s_getreg((3 << 11) | 20) & 0xFu; }
#define XB_SPIN(cond, bar) do { unsigned _sp = 0; while (cond) { __builtin_amdgcn_s_sleep(1); \
    if ((++_sp & 255u) == 0u) { if (xb_ld(&(bar)[XB_TMO])) break; if (_sp > XB_SPIN_CAP) { atomicAdd(&(bar)[XB_TMO], 1u); break; } } } } while (0)
struct XcdBarrier { unsigned* bar; unsigned x; volatile LAS unsigned* st; };
__device__ __forceinline__ XcdBarrier xcd_barrier_post(unsigned* bar, volatile LAS unsigned* st) {
    XcdBarrier b; b.bar = bar; b.x = xb_xcc_id(); b.st = st;
    if (threadIdx.x == 0) (void)xb_add(&bar[XB_XCNT(b.x)], 1u);
    return b;
}
__device__ __forceinline__ void xcd_barrier_complete(unsigned* bar, unsigned x, unsigned& nloc, unsigned& nx) {
    const unsigned G = gridDim.x * gridDim.y * gridDim.z;
    unsigned sum, cnt, mine, sp = 0u;
    for (;;) {
        sum = 0u; cnt = 0u; mine = 0u;
#pragma unroll
        for (unsigned j = 0; j < 16; ++j) { const unsigned c = xb_ld(&bar[XB_XCNT(j)]); sum += c; cnt += (c > 0u) ? 1u : 0u; mine = (j == x) ? c : mine; }
        if (sum == G) break;
        __builtin_amdgcn_s_sleep(1);
        if ((++sp & 255u) == 0u) { if (xb_ld(&bar[XB_TMO])) break; if (sp > XB_SPIN_CAP) { atomicAdd(&bar[XB_TMO], 1u); break; } }
    }
    nloc = mine > 0u ? mine : 1u; nx = cnt > 0u ? cnt : 1u;
}
__device__ __forceinline__ void xcd_barrier(const XcdBarrier& b) {
    asm volatile("s_waitcnt vmcnt(0)" ::: "memory");
    __syncthreads();
    if (threadIdx.x == 0) {
        unsigned* bar = b.bar;
        __builtin_amdgcn_s_waitcnt(0);
        unsigned nloc = b.st[0], nx = b.st[1];
        if (nloc == 0u) { xcd_barrier_complete(bar, b.x, nloc, nx); b.st[0] = nloc; b.st[1] = nx; }
        const unsigned old = xb_add(&bar[XB_XSUB(b.x)], 1u);
        const unsigned gen = old / nloc;
        if (old + 1u == (gen + 1u) * nloc) {
            __builtin_amdgcn_fence(__ATOMIC_RELEASE, "agent");
            asm volatile("s_waitcnt vmcnt(0)" ::: "memory");
            const unsigned og = xb_add(&bar[XB_TOP], 1u);
            const unsigned tg = og / nx;
            if (og + 1u == (tg + 1u) * nx) xb_add(&bar[XB_TOPGEN], 1u);
            else XB_SPIN(xb_ld(&bar[XB_TOPGEN]) == tg, bar);
            __builtin_amdgcn_fence(__ATOMIC_ACQUIRE, "agent");
            xb_add(&bar[XB_XGEN(b.x)], 1u);
            asm volatile("s_waitcnt vmcnt(0)" ::: "memory");
        } else {
            XB_SPIN(xb_ld(&bar[XB_XGEN(b.x)]) == gen, bar);
            __builtin_amdgcn_fence(__ATOMIC_ACQUIRE, "agent");
            asm volatile("s_waitcnt vmcnt(0)" ::: "memory");
        }
    }
    __syncthreads();
}

namespace pg8 {
constexpr int BM = 256, BK = 64, HALF = 128, HTB = HALF * BK * 2, STAGE_BYTES = 8 * HTB;
__host__ __device__ __forceinline__ int lds_byte(int r, int c) { const int st = (r >> 4) * 2 + (c >> 5), rr = r & 15, cc = c & 31, ob = rr * 64 + cc * 2; return st * 1024 + (ob ^ (((ob >> 9) & 1) << 5)); }
__host__ __device__ __forceinline__ void stage_rc(int b, int& R, int& C) { const int st = b / 1024, sb = b % 1024, swz = sb ^ (((sb >> 9) & 1) << 5); R = (st >> 1) * 16 + swz / 64; C = (st & 1) * 32 + (swz % 64) / 2; }
__host__ __device__ __forceinline__ int perm32(int rho) { const int n = rho >> 4, i = rho & 15; return 8 * (i >> 2) + 4 * n + (i & 3); }
struct Unit { int pm, pn, aux, tl; const char* A; const char* B; };
typedef f32x4 Acc[2][2][4][2];
typedef int u32x4_i __attribute__((ext_vector_type(4)));

typedef int v8i32 __attribute__((ext_vector_type(8)));
template <class Epi, class Sched, bool FP8 = false>
__device__ __forceinline__ void gemm_phase(LAS unsigned char* lds, const int Kb, const Sched& S, const Epi& E) {
    const int tid = threadIdx.x, wid = __builtin_amdgcn_readfirstlane(tid >> 6), lane = tid & 63, wr = wid >> 2, wc = wid & 3, fr = lane & 15, fq = lane >> 4;
    const int nt = Kb / 128;
    int RA[2], CA[2]; unsigned voffB[2];
#pragma unroll
    for (int i = 0; i < 2; ++i) { int R, C; stage_rc(tid * 16 + i * 8192, R, C); const int Rb = Epi::PERM ? ((R & ~31) + perm32(R & 31)) : R;
        RA[i] = R; CA[i] = C; voffB[i] = (unsigned)(Rb * Kb + C * 2); }
    const size_t kstep = (size_t)(BK * 2);
    const size_t hstep = (size_t)HALF * Kb;
    const unsigned ldsw = (unsigned)wid * 1024u;
    const int aoff = lds_byte(wr * 64 + fr, fq * 8), boff = lds_byte(wc * 32 + fr, fq * 8);
#define PG8_SA(b, h) (((b) * 2 + (h)) * HTB)
#define PG8_SB(b, h) ((4 + (b) * 2 + (h)) * HTB)
#define PG8_STAGE(bufoff, gbase, voff) do { _Pragma("unroll") for (int _i = 0; _i < 2; ++_i) \
        __builtin_amdgcn_global_load_lds((const unsigned*)((const char*)(gbase) + (voff)[_i]), (LAS unsigned*)(lds + (bufoff) + ldsw + _i * 8192), 16, 0, 0); } while (0)
#define PG8_LDA(dst, b, h) do { _Pragma("unroll") for (int m = 0; m < 4; ++m) _Pragma("unroll") for (int k = 0; k < 2; ++k) dst[m][k] = *(const LAS bf16x8*)(lds + PG8_SA(b, h) + aoff + m * 2048 + k * 1024); } while (0)
#define PG8_LDB(dst, b, h) do { _Pragma("unroll") for (int n = 0; n < 2; ++n) _Pragma("unroll") for (int k = 0; k < 2; ++k) dst[n][k] = *(const LAS bf16x8*)(lds + PG8_SB(b, h) + boff + n * 2048 + k * 1024); } while (0)
#define PG8_MMA(ai, bj, At, Bt) do { __builtin_amdgcn_s_setprio(1); _Pragma("unroll") for (int m = 0; m < 4; ++m) _Pragma("unroll") for (int n = 0; n < 2; ++n) { \
        if constexpr (FP8) { const v8i32 bq = __builtin_shufflevector(__builtin_bit_cast(u32x4_i, Bt[n][0]), __builtin_bit_cast(u32x4_i, Bt[n][1]), 0, 1, 2, 3, 4, 5, 6, 7), \
                                         aq = __builtin_shufflevector(__builtin_bit_cast(u32x4_i, At[m][0]), __builtin_bit_cast(u32x4_i, At[m][1]), 0, 1, 2, 3, 4, 5, 6, 7); \
            asm volatile("v_mfma_scale_f32_16x16x128_f8f6f4 %0, %1, %2, %0, %3, %3 op_sel_hi:[0,0,0]" : "+v"(acc[ai][bj][m][n]) : "v"(bq), "v"(aq), "v"(scale1)); } \
        else { _Pragma("unroll") for (int k = 0; k < 2; ++k) acc[ai][bj][m][n] = __builtin_amdgcn_mfma_f32_16x16x32_bf16(Bt[n][k], At[m][k], acc[ai][bj][m][n], 0, 0, 0); } } \
        __builtin_amdgcn_s_setprio(0); } while (0)
#define PG8_WAIT_V(n) asm volatile("s_waitcnt vmcnt(" #n ")" ::: "memory")
#define PG8_WAIT_L(n) asm volatile("s_waitcnt lgkmcnt(" #n ")" ::: "memory")
#define PG8_BAR __builtin_amdgcn_s_barrier()
#define PG8_SCHED __builtin_amdgcn_sched_barrier(0)
    int scale1 = 0x7f7f7f7f; asm volatile("" : "+v"(scale1));
    Unit cur, nxt; int ui = 0;
    if (!S.next(0, cur)) return;
    unsigned ca[2][2], na[2][2];
    S.aoff(cur, RA, CA, ca);
    f32x4 acc[2][2][4][2];
#pragma unroll
    for (int a = 0; a < 2; ++a)
#pragma unroll
        for (int b = 0; b < 2; ++b)
#pragma unroll
            for (int m = 0; m < 4; ++m)
#pragma unroll
                for (int n = 0; n < 2; ++n) acc[a][b][m][n] = (f32x4){0.f, 0.f, 0.f, 0.f};
    bf16x8 At[4][2], B0[2][2], B1[2][2];
    const char* cA = cur.A; const char* cB = cur.B;
    PG8_STAGE(PG8_SB(0, 0), cB, voffB); PG8_STAGE(PG8_SB(0, 1), cB + hstep, voffB); PG8_STAGE(PG8_SA(0, 0), cA, ca[0]); PG8_STAGE(PG8_SA(0, 1), cA, ca[1]);
    if (wr == 1) PG8_BAR;
    PG8_WAIT_V(2); PG8_BAR;
    PG8_STAGE(PG8_SB(1, 0), cB + kstep, voffB); PG8_STAGE(PG8_SA(1, 0), cA + kstep, ca[0]); PG8_STAGE(PG8_SB(1, 1), cB + hstep + kstep, voffB);
    PG8_WAIT_V(6); PG8_BAR;
    for (;;) {
        const bool has_next = S.next(ui + 1, nxt);
        if constexpr (Sched::GATHER) {
            if (has_next) S.aoff(nxt, RA, CA, na);
            else {
#pragma unroll
                for (int h = 0; h < 2; ++h)
#pragma unroll
                    for (int i = 0; i < 2; ++i) na[h][i] = ca[h][i];
            }
        }
        const char* nA = has_next ? nxt.A : cA; const char* nB = has_next ? nxt.B : cB;
#pragma nounroll
        for (int t = 0; t < nt; t += 2) {
            const bool last = (t == nt - 2);
            const char* a1 = cA + (size_t)(t + 1) * kstep;
            const char* a2 = last ? nA : cA + (size_t)(t + 2) * kstep; const char* b2 = last ? nB : cB + (size_t)(t + 2) * kstep;
            const char* a3 = a2 + kstep; const char* b3 = b2 + kstep;
            unsigned o2[2][2];
#pragma unroll
            for (int h = 0; h < 2; ++h)
#pragma unroll
                for (int i = 0; i < 2; ++i) { if constexpr (Sched::GATHER) o2[h][i] = last ? na[h][i] : ca[h][i]; else o2[h][i] = ca[h][i]; }
            PG8_LDB(B0, 0, 0); PG8_LDB(B1, 0, 1); PG8_SCHED; PG8_LDA(At, 0, 0); PG8_STAGE(PG8_SA(1, 1), a1, ca[1]);
            PG8_WAIT_V(8); PG8_WAIT_L(0); PG8_BAR; PG8_MMA(0, 0, At, B0); PG8_MMA(0, 1, At, B1); PG8_BAR; PG8_SCHED;
            PG8_LDA(At, 0, 1); PG8_STAGE(PG8_SB(0, 0), b2, voffB); PG8_STAGE(PG8_SB(0, 1), b2 + hstep, voffB); PG8_STAGE(PG8_SA(0, 0), a2, o2[0]);
            PG8_WAIT_V(8); PG8_WAIT_L(0); PG8_BAR; PG8_MMA(1, 0, At, B0); PG8_MMA(1, 1, At, B1); PG8_BAR; PG8_SCHED;
            PG8_LDB(B0, 1, 0); PG8_LDB(B1, 1, 1); PG8_SCHED; PG8_LDA(At, 1, 0); PG8_STAGE(PG8_SA(0, 1), a2, o2[1]);
            PG8_WAIT_V(8); PG8_WAIT_L(0); PG8_BAR; PG8_MMA(0, 0, At, B0); PG8_MMA(0, 1, At, B1); PG8_BAR; PG8_SCHED;
            PG8_LDA(At, 1, 1); PG8_STAGE(PG8_SB(1, 0), b3, voffB); PG8_STAGE(PG8_SB(1, 1), b3 + hstep, voffB); PG8_STAGE(PG8_SA(1, 0), a3, o2[0]);
            PG8_WAIT_V(8); PG8_WAIT_L(0); PG8_BAR; PG8_MMA(1, 0, At, B0); PG8_MMA(1, 1, At, B1); PG8_BAR; PG8_SCHED;
        }
        if constexpr (FP8) { asm volatile("s_nop 15\n\ts_nop 15\n\ts_nop 15" ::: "memory"); PG8_SCHED; }
        if (wr == 0) PG8_BAR;
        E(acc, cur, wr, wc, fr, fq);
        if (!has_next) break;
#pragma unroll
        for (int a = 0; a < 2; ++a)
#pragma unroll
            for (int b = 0; b < 2; ++b)
#pragma unroll
                for (int m = 0; m < 4; ++m)
#pragma unroll
                    for (int n = 0; n < 2; ++n) acc[a][b][m][n] = (f32x4){0.f, 0.f, 0.f, 0.f};
        cur = nxt; cA = nA; cB = nB; ++ui;
        if constexpr (Sched::GATHER) {
#pragma unroll
            for (int h = 0; h < 2; ++h)
#pragma unroll
                for (int i = 0; i < 2; ++i) ca[h][i] = na[h][i];
        }
        if (wr == 1) PG8_BAR;
    }
    PG8_WAIT_V(0);
    PG8_BAR;
#undef PG8_SA
#undef PG8_SB
#undef PG8_STAGE
#undef PG8_LDA
#undef PG8_LDB
#undef PG8_MMA
#undef PG8_WAIT_V
#undef PG8_WAIT_L
#undef PG8_BAR
#undef PG8_SCHED
}
}
#ifndef PROBE_PHASE
#define PROBE_PHASE (-1)
#endif
constexpr size_t SM_LIST = WS_SMALL + 5 * MiB;
constexpr size_t SM_WLIST = WS_SMALL + 9 * MiB;
constexpr int MT_PSTART = 256;
constexpr int MT_CNT = 512;
constexpr int MT_NACT = 768;
constexpr int MT_ATILE = 1024;
constexpr int MT_HIST = 4096;
constexpr int MT_BASE = 4224;
constexpr int MT_REC = 4352;

__device__ __forceinline__ void moe_tables(LAS unsigned char* misc, const unsigned* cnt) {
    LAS int* pstart = (LAS int*)(misc + MT_PSTART); LAS int* cl = (LAS int*)(misc + MT_CNT); LAS int* at = (LAS int*)(misc + MT_ATILE);
    __syncthreads();
    if (threadIdx.x < 64) {
        const int lane = threadIdx.x, e = lane & 31;
        const int c = (int)__hip_atomic_load(cnt + e, __ATOMIC_RELAXED, __HIP_MEMORY_SCOPE_AGENT), nt = (c + 255) >> 8;
        int incl = nt;
#pragma unroll
        for (int o = 1; o < 32; o <<= 1) { const int v = __shfl_up(incl, o); if (e >= o) incl += v; }
        const int t0 = incl - nt;
        if (lane < 32) { cl[e] = c; pstart[e] = t0 << 8; for (int t = 0; t < nt; ++t) at[t0 + t] = (t0 + t) | (e << 12) | (t << 20);
            if (e == 31) { pstart[NE] = incl << 8; *(LAS int*)(misc + MT_NACT) = incl; } }
    }
    __syncthreads();
}

template <int N, int XR>
__device__ __forceinline__ void tr_step(float (&v)[64], int lane) {
    const bool up = (lane & XR) != 0;
#pragma unroll
    for (int i = 0; i < N; ++i) { const float keep = up ? v[i + N] : v[i], send = up ? v[i] : v[i + N]; v[i] = keep + __shfl_xor(send, XR); }
}

__device__ __forceinline__ void route_phase(LAS unsigned char* lds, const float* __restrict__ h2, const float* __restrict__ g2, const float* __restrict__ wr, const float* __restrict__ br,
                                            unsigned char* __restrict__ xn2, int* __restrict__ tke, int* __restrict__ tkpos, float* __restrict__ tkw, int* __restrict__ list, float* __restrict__ wlist,
                                            unsigned* __restrict__ cnt, int G, int bx) {
    const int tid = threadIdx.x, lane = tid & 63; const int wave = __builtin_amdgcn_readfirstlane(tid >> 6);
    LAS float* wT = (LAS float*)lds;
    LAS unsigned char* misc = lds + MISC_OFF;
    LAS int* hist = (LAS int*)(misc + MT_HIST); LAS int* base = (LAS int*)(misc + MT_BASE); LAS int* rec = (LAS int*)(misc + MT_REC);
    for (int idx = tid; idx < NE * D; idx += 512) { const int e = idx >> 10, k = idx & 1023; wT[idx] = wr[(size_t)k * NE + e]; }
    const float bias = br[lane & 31];
    for (int tb = bx; tb < NTOK / 128; tb += G) {
        if (tid < 32) hist[tid] = 0;
        __syncthreads();
        for (int rep_ = 0; rep_ < ((PROBE_PHASE == 6) ? 2 : 1); ++rep_)
        for (int pp = 0; pp < 8; ++pp) {
            const int tl0 = wave * 16 + pp * 2;
            const int row0 = tb * 128 + tl0;
            float xv[2][16];
#pragma unroll
            for (int t = 0; t < 2; ++t) {
                const f32x4* xr = (const f32x4*)(h2 + (size_t)(row0 + t) * D) + lane;
                float ss = 0.f; f32x4 v[4];
#pragma unroll
                for (int j = 0; j < 4; ++j) { v[j] = xr[64 * j]; ss += (v[j][0] * v[j][0] + v[j][1] * v[j][1]) + (v[j][2] * v[j][2] + v[j][3] * v[j][3]); }
                const float rstd = rsqrtf(wave_sum(ss) * (1.0f / D) + EPS);
                unsigned* o4 = (unsigned*)(xn2 + (size_t)(row0 + t) * D) + lane;
#pragma unroll
                for (int j = 0; j < 4; ++j) { const f32x4 gg = ((const f32x4*)g2)[64 * j + lane];
#pragma unroll
                    for (int q = 0; q < 4; ++q) xv[t][4 * j + q] = v[j][q] * rstd * gg[q];
                    o4[64 * j] = pk4_fp8(xv[t][4 * j], xv[t][4 * j + 1], xv[t][4 * j + 2], xv[t][4 * j + 3]); }
            }
            float acc[64];
#pragma unroll
            for (int i = 0; i < 64; ++i) acc[i] = 0.f;
#pragma unroll
            for (int e = 0; e < 32; ++e)
#pragma unroll
                for (int j = 0; j < 4; ++j) {
                    const f32x4 w = *(const LAS f32x4*)(wT + e * 1024 + (64 * j + lane) * 4);
                    acc[e] += (xv[0][4 * j] * w[0] + xv[0][4 * j + 1] * w[1]) + (xv[0][4 * j + 2] * w[2] + xv[0][4 * j + 3] * w[3]);
                    acc[32 + e] += (xv[1][4 * j] * w[0] + xv[1][4 * j + 1] * w[1]) + (xv[1][4 * j + 2] * w[2] + xv[1][4 * j + 3] * w[3]);
                }
            tr_step<32, 32>(acc, lane); tr_step<16, 16>(acc, lane); tr_step<8, 8>(acc, lane); tr_step<4, 4>(acc, lane); tr_step<2, 2>(acc, lane); tr_step<1, 1>(acc, lane);
            const float logit = acc[0] + bias;
            float cur = logit, m0 = 0.f; int myrank = -1;
#pragma unroll
            for (int k = 0; k < 4; ++k) {
                float m = cur;
#pragma unroll
                for (int o = 1; o < 32; o <<= 1) m = fmaxf(m, __shfl_xor(m, o));
                if (k == 0) m0 = m;
                const unsigned long long mask = __ballot(cur == m);
                const unsigned half = (lane < 32) ? (unsigned)mask : (unsigned)(mask >> 32);
                const int sel = __ffs(half) - 1;
                if ((lane & 31) == sel) { myrank = k; cur = -3.0e38f; }
            }
            float ex = (myrank >= 0) ? __expf(logit - m0) : 0.f, sum = ex;
#pragma unroll
            for (int o = 1; o < 32; o <<= 1) sum += __shfl_xor(sum, o);
            if (myrank >= 0 && (PROBE_PHASE != 6 || rep_ == 1)) {
                const int e = lane & 31, tl = tl0 + (lane >> 5);
                const int lp = __hip_atomic_fetch_add(hist + e, 1, __ATOMIC_RELAXED, __HIP_MEMORY_SCOPE_WORKGROUP);
                LAS int* r = rec + (tl * 4 + myrank) * 3; r[0] = e; r[1] = lp; r[2] = __float_as_int(ex / sum);
            }
        }
        __syncthreads();
        if (tid < 32) base[tid] = (int)atomicAdd(&cnt[tid], (unsigned)hist[tid]);
        __syncthreads();
        { const int tl = tid >> 2; const int token = tb * 128 + tl; LAS int* r = rec + tid * 3; const int e = r[0], pos = base[e] + r[1]; const float w = __int_as_float(r[2]);
          tke[token * 4 + (tid & 3)] = e; tkpos[token * 4 + (tid & 3)] = pos; tkw[token * 4 + (tid & 3)] = w;
          list[e * NTOK + pos] = token; wlist[e * NTOK + pos] = w; }
        __syncthreads();
    }
}

__device__ __forceinline__ void combine_phase(LAS unsigned char* misc, void* scratch_out, float* __restrict__ out, const bf16* __restrict__ rows, const int* __restrict__ tke, const int* __restrict__ tkpos, int gw, int NGW, int lane) {
    LAS const int* pstart = (LAS const int*)(misc + MT_PSTART);
    for (int rep_ = 0; rep_ < ((PROBE_PHASE == 9) ? 2 : 1); ++rep_)
    for (int token = gw; token < NTOK; token += NGW) {
        int rr[4];
#pragma unroll
        for (int k = 0; k < 4; ++k) rr[k] = pstart[tke[token * 4 + k]] + tkpos[token * 4 + k];
        f32x4* o = (f32x4*)(out + (size_t)token * D) + lane;
        f32x4 v[4];
#pragma unroll
        for (int j = 0; j < 4; ++j) v[j] = o[64 * j];
#pragma unroll
        for (int k = 0; k < 4; ++k) {
            const u32x2* rp = (const u32x2*)(rows + (size_t)rr[k] * D) + lane;
#pragma unroll
            for (int j = 0; j < 4; ++j) { const u32x2 w = rp[64 * j];
                v[j][0] += __uint_as_float(w.x << 16); v[j][1] += __uint_as_float(w.x & 0xffff0000u); v[j][2] += __uint_as_float(w.y << 16); v[j][3] += __uint_as_float(w.y & 0xffff0000u); }
        }
        if (PROBE_PHASE == 9 && rep_ == 0) {
#pragma unroll
            for (int j = 0; j < 4; ++j) { asm volatile("" :: "v"(v[j])); *(f32x4*)((float*)scratch_out + (size_t)token * D + (64 * j + lane) * 4) = v[j]; }
        } else {
#pragma unroll
        for (int j = 0; j < 4; ++j) o[64 * j] = v[j];
        }
    }
}
struct SchedDense {
    static constexpr bool GATHER = false;
    const char* A; const char* Bt; int K, nM, nN, nwg, G, c;
    __device__ void init(const bf16* A_, const bf16* Bt_, int M, int N, int K_, int G_, int c_) { A = (const char*)A_; Bt = (const char*)Bt_; K = K_; nM = M / 256; nN = N / 256; nwg = nM * nN; G = G_; c = c_; }
    __device__ __forceinline__ bool next(int i, pg8::Unit& u) const {
        const long L = (long)i * G + c; if (L >= nwg) return false;
        int wgid = (int)L; { const int q = nwg / 8, r = nwg % 8, xcd = wgid % 8, off = wgid / 8; wgid = (xcd < r ? xcd * (q + 1) : r * (q + 1) + (xcd - r) * q) + off; }
        const int nig = 8 * nN, gid = wgid / nig, fm = gid * 8, gsz = (nM - fm) < 8 ? (nM - fm) : 8;
        u.pm = fm + ((wgid % nig) % gsz); u.pn = (wgid % nig) / gsz; u.aux = 0; u.tl = 0;
        u.A = A + (size_t)u.pm * 256 * K * 2; u.B = Bt + (size_t)u.pn * 256 * K * 2; return true;
    }
    __device__ __forceinline__ void aoff(const pg8::Unit&, const int (&R)[2], const int (&C)[2], unsigned (&o)[2][2]) const {
#pragma unroll
        for (int h = 0; h < 2; ++h)
#pragma unroll
            for (int i = 0; i < 2; ++i) o[h][i] = (unsigned)((128 * h + R[i]) * K + C[i]) * 2u;
    }
};
struct SchedBranch {
    static constexpr bool GATHER = false;
    const char* A0; const char* A1; const char* B0; const char* B1; int G, c;
    __device__ __forceinline__ bool next(int i, pg8::Unit& u) const {
        const int L = (i >> 1) * G + c; if (L >= 512) return false;
        int wgid = L; { const int off = wgid / 8, xcd = wgid % 8; wgid = xcd * 64 + off; }
        const int nig = 8 * 4, gid = wgid / nig;
        u.pm = gid * 8 + ((wgid % nig) % 8); u.pn = (wgid % nig) / 8; u.aux = i & 1; u.tl = 0;
        u.A = ((i & 1) ? A1 : A0) + (size_t)u.pm * 256 * D * 2; u.B = ((i & 1) ? B1 : B0) + (size_t)u.pn * 256 * D * 2; return true;
    }
    __device__ __forceinline__ void aoff(const pg8::Unit&, const int (&R)[2], const int (&C)[2], unsigned (&o)[2][2]) const {
#pragma unroll
        for (int h = 0; h < 2; ++h)
#pragma unroll
            for (int i = 0; i < 2; ++i) o[h][i] = (unsigned)((128 * h + R[i]) * D + C[i]) * 2u;
    }
};
template <bool GATHER_, int NPN>
struct SchedMoe {
    static constexpr bool GATHER = GATHER_;
    const char* A; const char* Bt; LAS const unsigned char* misc; const int* list; int G, c;
    __device__ __forceinline__ bool next(int i, pg8::Unit& u) const {
        LAS const int* cl = (LAS const int*)(misc + MT_CNT); LAS const int* ps = (LAS const int*)(misc + MT_PSTART);
        if ((G & 7) == 0) {
            const int x = c & 7, r = c >> 3, n = G >> 3;
            int k = (i * n + r) / NPN; const int pn = (i * n + r) % NPN;
#pragma unroll
            for (int j = 0; j < 4; ++j) { const int e = x + 8 * j, nt = (cl[e] + 255) >> 8;
                if (k < nt) { u.pn = pn; u.aux = e; u.tl = k; u.pm = (ps[e] >> 8) + k;
                    u.A = GATHER ? A : A + (size_t)u.pm * 256 * 1024; u.B = Bt + ((size_t)e * NPN + pn) * 256 * 1024; return true; }
                k -= nt; }
            return false;
        }
        const int nact = *(LAS const int*)(misc + MT_NACT);
        const int L = i * G + c; if (L >= nact * NPN) return false;
        const int k = L / NPN; u.pn = L % NPN; const int w = ((LAS const int*)(misc + MT_ATILE))[k];
        u.pm = w & 0xfff; u.aux = (w >> 12) & 0xff; u.tl = w >> 20;
        u.A = GATHER ? A : A + (size_t)u.pm * 256 * 1024;
        u.B = Bt + ((size_t)u.aux * NPN + u.pn) * 256 * 1024; return true;
    }
    __device__ __forceinline__ void aoff(const pg8::Unit& u, const int (&R)[2], const int (&C)[2], unsigned (&o)[2][2]) const {
        const int ce = ((LAS const int*)(misc + MT_CNT))[u.aux];
#pragma unroll
        for (int h = 0; h < 2; ++h)
#pragma unroll
            for (int i = 0; i < 2; ++i) {
                if (GATHER) { const int idx = u.tl * 256 + 128 * h + R[i]; const int tok = (idx < ce) ? list[u.aux * NTOK + idx] : 0; o[h][i] = (unsigned)tok * 1024u + (unsigned)C[i] * 2u; }
                else o[h][i] = (unsigned)((128 * h + R[i]) * 1024 + C[i] * 2);
            }
    }
};

__device__ __forceinline__ u32x4 pack8(const f32x4& a, const f32x4& b) { u32x4 w; w.x = pk2(a[0], a[1]); w.y = pk2(a[2], a[3]); w.z = pk2(b[0], b[1]); w.w = pk2(b[2], b[3]); return w; }
__device__ __forceinline__ void unpack8(const u32x4& w, float (&f)[8]) {
    f[0] = __uint_as_float(w.x << 16); f[1] = __uint_as_float(w.x & 0xffff0000u); f[2] = __uint_as_float(w.y << 16); f[3] = __uint_as_float(w.y & 0xffff0000u);
    f[4] = __uint_as_float(w.z << 16); f[5] = __uint_as_float(w.z & 0xffff0000u); f[6] = __uint_as_float(w.w << 16); f[7] = __uint_as_float(w.w & 0xffff0000u);
}
struct EpiProj {
    static constexpr bool PERM = true;
    bf16* proj; const float* qg; const float* kg;
    __device__ __forceinline__ void operator()(pg8::Acc& acc, const pg8::Unit& u, int wr, int wc, int fr, int fq) const {
        const int pn = u.pn;
        int mode;
        if (pn < 4) mode = 1; else if (pn == 4) mode = (wc < 2) ? 2 : 0; else if (pn < 7) mode = 0; else if (pn < 9) mode = 3; else if (pn < 13) mode = 0; else if (pn < 17) mode = 4; else mode = 5;
        float gn[2][8];
        if (mode == 1 || mode == 2) { const float* g = (mode == 1) ? qg : kg; const float s = (mode == 1) ? 0.125f : 1.0f;
#pragma unroll
            for (int bj = 0; bj < 2; ++bj)
#pragma unroll
                for (int j = 0; j < 8; ++j) gn[bj][j] = g[32 * bj + 8 * fq + j] * s; }
#pragma unroll
        for (int ai = 0; ai < 2; ++ai)
#pragma unroll
            for (int m = 0; m < 4; ++m) {
                const int r = u.pm * 256 + ai * 128 + wr * 64 + m * 16 + fr;
                bf16* rowp = proj + (size_t)r * INW + pn * 256 + wc * 64 + 8 * fq;
                f32x4 v[2][2];
#pragma unroll
                for (int bj = 0; bj < 2; ++bj) { v[bj][0] = acc[ai][bj][m][0]; v[bj][1] = acc[ai][bj][m][1]; }
                if (mode == 1 || mode == 2) {
                    float ss = 0.f;
#pragma unroll
                    for (int bj = 0; bj < 2; ++bj)
#pragma unroll
                        for (int n = 0; n < 2; ++n) ss += v[bj][n][0] * v[bj][n][0] + v[bj][n][1] * v[bj][n][1] + v[bj][n][2] * v[bj][n][2] + v[bj][n][3] * v[bj][n][3];
                    ss += __shfl_xor(ss, 16); ss += __shfl_xor(ss, 32);
                    const float rs = rsqrtf(ss * (1.0f / 64.0f) + EPS);
#pragma unroll
                    for (int bj = 0; bj < 2; ++bj)
#pragma unroll
                        for (int n = 0; n < 2; ++n)
#pragma unroll
                            for (int i = 0; i < 4; ++i) v[bj][n][i] = v[bj][n][i] * rs * gn[bj][4 * n + i];
                } else if (mode == 3) {
#pragma unroll
                    for (int bj = 0; bj < 2; ++bj)
#pragma unroll
                        for (int n = 0; n < 2; ++n) v[bj][n] = v[bj][n] * 0.08838834764831845f;
                } else if (mode == 4) {
#pragma unroll
                    for (int bj = 0; bj < 2; ++bj)
#pragma unroll
                        for (int n = 0; n < 2; ++n)
#pragma unroll
                            for (int i = 0; i < 4; ++i) { const float x = v[bj][n][i]; v[bj][n][i] = x * sigmoidf_(x); }
                } else if (mode == 5) {
#pragma unroll
                    for (int bj = 0; bj < 2; ++bj)
#pragma unroll
                        for (int n = 0; n < 2; ++n)
#pragma unroll
                            for (int i = 0; i < 4; ++i) v[bj][n][i] = sigmoidf_(v[bj][n][i]);
                }
#pragma unroll
                for (int bj = 0; bj < 2; ++bj) *(u32x4*)(rowp + 32 * bj) = pack8(v[bj][0], v[bj][1]);
            }
    }
};
struct EpiBranch {
    static constexpr bool PERM = true;
    bf16* merged; const bf16* proj;
    __device__ __forceinline__ void operator()(pg8::Acc& acc, const pg8::Unit& u, int wr, int wc, int fr, int fq) const {
        const int gcol = u.aux ? C_GR : C_GA;
#pragma unroll
        for (int ai = 0; ai < 2; ++ai)
#pragma unroll
            for (int m = 0; m < 4; ++m) {
                const int r = u.pm * 256 + ai * 128 + wr * 64 + m * 16 + fr;
#pragma unroll
                for (int bj = 0; bj < 2; ++bj) {
                    const int col = u.pn * 256 + bj * 128 + wc * 32 + 8 * fq;
                    const u32x4 gw = *(const u32x4*)(proj + (size_t)r * INW + gcol + col);
                    float g[8]; unpack8(gw, g);
                    f32x4 a = acc[ai][bj][m][0], b = acc[ai][bj][m][1];
                    a[0] *= g[0]; a[1] *= g[1]; a[2] *= g[2]; a[3] *= g[3]; b[0] *= g[4]; b[1] *= g[5]; b[2] *= g[6]; b[3] *= g[7];
                    bf16* mp = merged + (size_t)r * D + col;
                    if (u.aux) { const u32x4 pw = *(const u32x4*)mp; float p[8]; unpack8(pw, p);
                        a[0] += p[0]; a[1] += p[1]; a[2] += p[2]; a[3] += p[3]; b[0] += p[4]; b[1] += p[5]; b[2] += p[6]; b[3] += p[7]; }
                    *(u32x4*)mp = pack8(a, b);
                }
            }
    }
};
struct EpiOut {
    static constexpr bool PERM = false;
    const float* x; float* out;
    __device__ __forceinline__ void operator()(pg8::Acc& acc, const pg8::Unit& u, int wr, int wc, int fr, int fq) const {
#pragma unroll
        for (int ai = 0; ai < 2; ++ai)
#pragma unroll
            for (int m = 0; m < 4; ++m) {
                const size_t off = (size_t)(u.pm * 256 + ai * 128 + wr * 64 + m * 16 + fr) * D + u.pn * 256 + wc * 32 + 4 * fq;
#pragma unroll
                for (int bj = 0; bj < 2; ++bj)
#pragma unroll
                    for (int n = 0; n < 2; ++n) { const f32x4 xv = *(const f32x4*)(x + off + bj * 128 + n * 16); *(f32x4*)(out + off + bj * 128 + n * 16) = xv + acc[ai][bj][m][n]; }
            }
    }
};
struct EpiGU {
    static constexpr bool PERM = true;
    unsigned char* act; const float* bgu;
    __device__ __forceinline__ void operator()(pg8::Acc& acc, const pg8::Unit& u, int wr, int wc, int fr, int fq) const {
        const int col = u.pn * 128 + wc * 32 + 8 * fq;
        const float* bg = bgu + (size_t)u.aux * 2048 + col;
        float bgate[8], bup[8];
#pragma unroll
        for (int j = 0; j < 8; ++j) { bgate[j] = bg[j]; bup[j] = bg[1024 + j]; }
#pragma unroll
        for (int ai = 0; ai < 2; ++ai)
#pragma unroll
            for (int m = 0; m < 4; ++m) {
                const int r = u.pm * 256 + ai * 128 + wr * 64 + m * 16 + fr;
                float o[8];
#pragma unroll
                for (int n = 0; n < 2; ++n)
#pragma unroll
                    for (int i = 0; i < 4; ++i) {
                        float gate = acc[ai][0][m][n][i] * W8_INV + bgate[4 * n + i], up = acc[ai][1][m][n][i] * W8_INV + bup[4 * n + i];
                        gate = fminf(gate, 7.0f); up = fminf(fmaxf(up, -7.0f), 7.0f);
                        o[4 * n + i] = (up + 1.0f) * gate * sigmoidf_(1.702f * gate);
                    }
                u32x2 w; w.x = pk4_fp8(o[0], o[1], o[2], o[3]); w.y = pk4_fp8(o[4], o[5], o[6], o[7]);
                *(u32x2*)(act + (size_t)r * DFF + col) = w;
            }
    }
};
struct EpiDown {
    static constexpr bool PERM = true;
    bf16* rows; const float* bdn; const float* wlist; LAS const unsigned char* misc;
    __device__ __forceinline__ void operator()(pg8::Acc& acc, const pg8::Unit& u, int wr, int wc, int fr, int fq) const {
        const int ce = ((LAS const int*)(misc + MT_CNT))[u.aux];
        float bb[2][8];
#pragma unroll
        for (int bj = 0; bj < 2; ++bj)
#pragma unroll
            for (int j = 0; j < 8; ++j) bb[bj][j] = bdn[(size_t)u.aux * D + u.pn * 256 + bj * 128 + wc * 32 + 8 * fq + j];
#pragma unroll
        for (int ai = 0; ai < 2; ++ai)
#pragma unroll
            for (int m = 0; m < 4; ++m) {
                const int lr = ai * 128 + wr * 64 + m * 16 + fr, r = u.pm * 256 + lr, idx = u.tl * 256 + lr;
                const float w = (idx < ce) ? wlist[u.aux * NTOK + idx] : 0.f;
#pragma unroll
                for (int bj = 0; bj < 2; ++bj) {
                    f32x4 a = acc[ai][bj][m][0], b = acc[ai][bj][m][1];
#pragma unroll
                    for (int i = 0; i < 4; ++i) { a[i] = (a[i] * W8_INV + bb[bj][i]) * w; b[i] = (b[i] * W8_INV + bb[bj][4 + i]) * w; }
                    *(u32x4*)(rows + (size_t)r * D + u.pn * 256 + bj * 128 + wc * 32 + 8 * fq) = pack8(a, b);
                }
            }
    }
};
namespace attn {
typedef float f32x16 __attribute__((ext_vector_type(16)));
typedef short s16x4 __attribute__((ext_vector_type(4)));
constexpr int NK = 272, K_OFF = 0, V_OFF = 34816, WS_OFF = 69632, OST_OFF = 71680, LDS_END = OST_OFF + 8 * 4096;
constexpr float LOG2E = 1.4426950408889634f;
__device__ __forceinline__ s16x4 vtr(LAS const unsigned char* p) { return __builtin_bit_cast(s16x4, __builtin_amdgcn_ds_read_tr16_b64_v4i16((LAS s16x4*)p)); }
__device__ __forceinline__ int crowc(int r) { return (r & 3) + 8 * (r >> 2); }

template <int TYPE, bool DIAG>
__device__ __forceinline__ void tile(LAS const unsigned char* lds, int kbase, const bf16x8 (&qr)[4], f32x16 (&o)[2], float& l, float lanebase, float c1, int tt, int lane) {
    const int r32 = lane & 31, hi = lane >> 5;
    f32x16 p = {};
#pragma unroll
    for (int d0 = 0; d0 < 4; ++d0) {
        const bf16x8 kf = *(const LAS bf16x8*)(lds + K_OFF + (2 * d0 + hi) * (NK * 16) + (kbase + r32) * 16);
        p = __builtin_amdgcn_mfma_f32_32x32x16_bf16(kf, qr[d0], p, 0, 0, 0);
    }
    constexpr int NR = (TYPE == 0) ? 8 : 16;
    float e[16];
#pragma unroll
    for (int r = 0; r < NR; ++r) {
        const float add = __builtin_fmaf(c1, (float)crowc(r), lanebase);
        float v = __builtin_amdgcn_exp2f(__builtin_fmaf(p[r], LOG2E, add));
        if (DIAG) { const bool ok = (TYPE == 1) ? (crowc(r) > tt) : (crowc(r) <= tt); v = ok ? v : 0.f; }
        e[r] = v; l += v;
    }
    constexpr int NS = (TYPE == 0) ? 1 : 2;
    u32x4 pw[2];
#pragma unroll
    for (int s = 0; s < NS; ++s) { pw[s].x = pk2(e[8 * s + 0], e[8 * s + 1]); pw[s].y = pk2(e[8 * s + 2], e[8 * s + 3]); pw[s].z = pk2(e[8 * s + 4], e[8 * s + 5]); pw[s].w = pk2(e[8 * s + 6], e[8 * s + 7]); }
    LAS const unsigned char* vb = lds + V_OFF + (kbase + 4 * hi + ((lane & 15) >> 2)) * 64 + ((lane >> 4) & 1) * 32 + (lane & 3) * 8;
#pragma unroll
    for (int d0 = 0; d0 < 2; ++d0)
#pragma unroll
        for (int s = 0; s < NS; ++s) {
            const s16x4 lo = vtr(vb + d0 * (NK * 64) + s * 1024), hh = vtr(vb + d0 * (NK * 64) + s * 1024 + 512);
            const bf16x8 vf = (bf16x8){lo[0], lo[1], lo[2], lo[3], hh[0], hh[1], hh[2], hh[3]};
            o[d0] = __builtin_amdgcn_mfma_f32_32x32x16_bf16(__builtin_bit_cast(bf16x8, pw[s]), vf, o[d0], 0, 0, 0);
        }
}

__device__ __forceinline__ void unit(LAS unsigned char* lds, int b, int qb, int kvh, const bf16* __restrict__ proj, const bf16* __restrict__ pmeta, const float* __restrict__ sinks, float bshift, bf16* __restrict__ yatt) {
    const int tid = threadIdx.x, lane = tid & 63, r32 = lane & 31, hi = lane >> 5; const int wave = __builtin_amdgcn_readfirstlane(tid >> 6);
    for (int idx = tid; idx < NK * 8; idx += 512) {
        const int key = idx >> 3, c = idx & 7;
        const bf16* rowp;
        if (key < 16) rowp = pmeta + (size_t)key * INW;
        else { int j = qb * 128 - 128 + (key - 16); if (j < 0) j = 0; rowp = proj + ((size_t)b * SEQ + j) * INW; }
        const u32x4 kv = *(const u32x4*)(rowp + C_AK + kvh * 64 + c * 8);
        const u32x4 vv = *(const u32x4*)(rowp + C_AV + kvh * 64 + c * 8);
        *(LAS u32x4*)(lds + K_OFF + c * (NK * 16) + key * 16) = kv;
        *(LAS u32x4*)(lds + V_OFF + (c >> 2) * (NK * 64) + key * 64 + (c & 3) * 16) = vv;
    }
    __syncthreads();
    const int h = kvh * 8 + wave;
    const float slope = exp2f(-0.5f * (float)(h + 1)), sink = sinks[h];
    const float M = fmaxf(bshift, sink);
    const float c1 = slope * LOG2E;
    LAS float* wsf = (LAS float*)(lds + WS_OFF) + wave * 64;
    LAS bf16* stg = (LAS bf16*)(lds + OST_OFF) + wave * 2048;
    for (int a = 0; a < 4; ++a) {
        const size_t qrow = (size_t)b * SEQ + qb * 128 + 32 * a + r32;
        bf16x8 qr[4];
#pragma unroll
        for (int d0 = 0; d0 < 4; ++d0) qr[d0] = *(const bf16x8*)(proj + qrow * INW + C_AQ + h * 64 + d0 * 16 + hi * 8);
        f32x16 o[2]; o[0] = f32x16{}; o[1] = f32x16{};
        float l = 0.f;
        const int t = 32 * a + r32;
        const int tt = r32 - 4 * hi;
        const float hi4 = c1 * 4.0f * (float)hi;
        tile<0, false>(lds, 0, qr, o, l, -(slope * (float)(qb * 128 + t + 16) + M) * LOG2E + hi4, c1, tt, lane);
        if (qb > 0) {
            tile<1, true>(lds, 16 + 32 * a, qr, o, l, -(slope * (float)(128 + r32) + M) * LOG2E + hi4, c1, tt, lane);
            for (int bb = a + 1; bb < 4; ++bb) tile<1, false>(lds, 16 + 32 * bb, qr, o, l, -(slope * (float)(128 + t - 32 * bb) + M) * LOG2E + hi4, c1, tt, lane);
        }
        for (int bb = 0; bb < a; ++bb) tile<2, false>(lds, 144 + 32 * bb, qr, o, l, -(slope * (float)(t - 32 * bb) + M) * LOG2E + hi4, c1, tt, lane);
        tile<2, true>(lds, 144 + 32 * a, qr, o, l, -(slope * (float)r32 + M) * LOG2E + hi4, c1, tt, lane);
        l += __shfl_xor(l, 32);
        l += exp2f((sink - M) * LOG2E);
        if (hi == 0) wsf[r32] = l;
        LDS_WAIT();
        float rli[16];
#pragma unroll
        for (int r = 0; r < 16; ++r) rli[r] = __builtin_amdgcn_rcpf(wsf[crowc(r) + 4 * hi]);
#pragma unroll
        for (int r = 0; r < 16; ++r) { const int orow = crowc(r) + 4 * hi;
#pragma unroll
            for (int d0 = 0; d0 < 2; ++d0) stg[orow * 64 + d0 * 32 + r32] = f2bf(o[d0][r] * rli[r]); }
        LDS_WAIT();
        bf16* Ow = yatt + ((size_t)b * SEQ + qb * 128 + 32 * a) * D + h * 64;
#pragma unroll
        for (int i = 0; i < 4; ++i) { const int row = i * 8 + (lane >> 3), ch = lane & 7; const u32x4 v = *(const LAS u32x4*)(stg + row * 64 + ch * 8); *(u32x4*)(Ow + (size_t)row * D + ch * 8) = v; }
        LDS_WAIT();
    }
    __syncthreads();
}
}
namespace ret {
typedef float f32x16 __attribute__((ext_vector_type(16)));
typedef short s16x4 __attribute__((ext_vector_type(4)));
constexpr size_t WS_STATES = 893 * MiB;
__device__ __forceinline__ s16x4 vtr(LAS const unsigned char* p) { return __builtin_bit_cast(s16x4, __builtin_amdgcn_ds_read_tr16_b64_v4i16((LAS s16x4*)p)); }
__device__ __forceinline__ int crowc(int r) { return (r & 3) + 8 * (r >> 2); }
__device__ __forceinline__ float lg2gamma(int h) { return log2f(1.0f - exp2f(-5.0f - (float)h)); }

constexpr int R1_BUF = 40960;
__device__ __forceinline__ void state_chain(LAS unsigned char* lds, int b, int h, int dvs, const bf16* __restrict__ proj, const bf16* __restrict__ pmeta, bf16* __restrict__ states) {
    const int tid = threadIdx.x, lane = tid & 63, hi = lane >> 5; const int wave = __builtin_amdgcn_readfirstlane(tid >> 6);
    const float lg = lg2gamma(h), g128 = exp2f(lg * 128.0f);
    u32x4 kreg[4], vreg;
#define RET_ISSUE(c_) do { const int c__ = (c_); \
        _Pragma("unroll") for (int i = 0; i < 4; ++i) { const int idx = tid + 512 * i, key = idx >> 4, ch = idx & 15; \
            if (c__ == 0) { kreg[i] = (key >= 112) ? *(const u32x4*)(pmeta + (size_t)(key - 112) * INW + C_RK + h * 128 + ch * 8) : (u32x4){0u, 0u, 0u, 0u}; } \
            else kreg[i] = *(const u32x4*)(proj + ((size_t)b * SEQ + (c__ - 1) * 128 + key) * INW + C_RK + h * 128 + ch * 8); } \
        { const int key = tid >> 2, ch = tid & 3; \
          if (c__ == 0) vreg = (key >= 112) ? *(const u32x4*)(pmeta + (size_t)(key - 112) * INW + C_RV + h * 256 + dvs * 32 + ch * 8) : (u32x4){0u, 0u, 0u, 0u}; \
          else vreg = *(const u32x4*)(proj + ((size_t)b * SEQ + (c__ - 1) * 128 + key) * INW + C_RV + h * 256 + dvs * 32 + ch * 8); } } while (0)
    const float vscale = exp2f(lg * (float)(127 - (tid >> 2)));
    f32x16 acc = {};
    RET_ISSUE(0);
    for (int c = 0; c < 32; ++c) {
        LAS unsigned char* buf = lds + (c & 1) * R1_BUF;
#pragma unroll
        for (int i = 0; i < 4; ++i) { const int idx = tid + 512 * i, key = idx >> 4, ch = idx & 15; *(LAS u32x4*)(buf + (ch >> 2) * (128 * 64) + key * 64 + (ch & 3) * 16) = kreg[i]; }
        { const int key = tid >> 2, ch = tid & 3; float f[8]; unpack8(vreg, f); u32x4 w;
          w.x = pk2(f[0] * vscale, f[1] * vscale); w.y = pk2(f[2] * vscale, f[3] * vscale); w.z = pk2(f[4] * vscale, f[5] * vscale); w.w = pk2(f[6] * vscale, f[7] * vscale);
          *(LAS u32x4*)(buf + 32768 + key * 64 + ch * 16) = w; }
        if (c + 1 < 32) RET_ISSUE(c + 1);
        __syncthreads();
        if (wave < 4) {
            const int dt = wave;
            acc = acc * g128;
            LAS const unsigned char* ab = buf + dt * (128 * 64) + (4 * hi + ((lane & 15) >> 2)) * 64 + ((lane >> 4) & 1) * 32 + (lane & 3) * 8;
            LAS const unsigned char* bb = buf + 32768 + (4 * hi + ((lane & 15) >> 2)) * 64 + ((lane >> 4) & 1) * 32 + (lane & 3) * 8;
#pragma unroll
            for (int ks = 0; ks < 8; ++ks) {
                const s16x4 al = vtr(ab + ks * 1024), ah = vtr(ab + ks * 1024 + 512), bl = vtr(bb + ks * 1024), bh = vtr(bb + ks * 1024 + 512);
                const bf16x8 af = (bf16x8){al[0], al[1], al[2], al[3], ah[0], ah[1], ah[2], ah[3]}, bfr = (bf16x8){bl[0], bl[1], bl[2], bl[3], bh[0], bh[1], bh[2], bh[3]};
                acc = __builtin_amdgcn_mfma_f32_32x32x16_bf16(af, bfr, acc, 0, 0, 0);
            }
            bf16* sb = states + ((((size_t)(b * 4 + h) * 32 + c) * 8 + dvs) * 8) * 512;
#pragma unroll
            for (int g = 0; g < 4; ++g) { u32x2 w; w.x = pk2(acc[4 * g], acc[4 * g + 1]); w.y = pk2(acc[4 * g + 2], acc[4 * g + 3]);
                *(u32x2*)(sb + (size_t)(2 * dt + (g >> 1)) * 512 + (32 * (g & 1) + (lane & 31)) * 8 + 4 * hi) = w; }
        }
    }
    __syncthreads();
#undef RET_ISSUE
}

constexpr int R3_K = 0, R3_Q = 32768, R3_V = 65536;
#define R3_ISSUE(u_) do { const int u__ = (u_); const size_t rw = (size_t)(u__ >> 7) * SEQ + (u__ & 31) * 128; const int hh = (u__ >> 5) & 3; \
        _Pragma("unroll") for (int i = 0; i < 4; ++i) { const int idx = tid + 512 * i, key = idx >> 4, ch = idx & 15; \
            kq[i] = *(const u32x4*)(proj + (rw + key) * INW + C_RK + hh * 128 + ch * 8); kq[4 + i] = *(const u32x4*)(proj + (rw + key) * INW + C_RQ + hh * 128 + ch * 8); } \
        _Pragma("unroll") for (int i = 0; i < 8; ++i) { const int idx = tid + 512 * i, key = idx >> 5, ch = idx & 31; vv[i] = *(const u32x4*)(proj + (rw + key) * INW + C_RV + hh * 256 + ch * 8); } } while (0)
__device__ __forceinline__ void out_phase(LAS unsigned char* lds, const bf16* __restrict__ proj, const bf16* __restrict__ states, bf16* __restrict__ yret, int G, int bx) {
    const int tid = threadIdx.x, lane = tid & 63, r32 = lane & 31, hi = lane >> 5; const int wave = __builtin_amdgcn_readfirstlane(tid >> 6);
    constexpr int NU = NB * 4 * 32;
    if (bx >= NU) return;
    u32x4 kq[8], vv[8];
    R3_ISSUE(bx);
    for (int u = bx; u < NU; u += G) {
        const int b = u >> 7, h = (u >> 5) & 3, tb = u & 31;
        const float lg = lg2gamma(h);
        const size_t row0 = (size_t)b * SEQ + tb * 128;
#pragma unroll
        for (int i = 0; i < 4; ++i) { const int idx = tid + 512 * i, key = idx >> 4, ch = idx & 15;
            *(LAS u32x4*)(lds + R3_K + ch * 2048 + key * 16) = kq[i]; *(LAS u32x4*)(lds + R3_Q + ch * 2048 + key * 16) = kq[4 + i]; }
#pragma unroll
        for (int i = 0; i < 8; ++i) { const int idx = tid + 512 * i, key = idx >> 5, ch = idx & 31; *(LAS u32x4*)(lds + R3_V + (ch >> 2) * 8192 + key * 64 + (ch & 3) * 16) = vv[i]; }
        if (u + G < NU) R3_ISSUE(u + G);
        __syncthreads();
        u32x2 pw[2][4];
#pragma unroll
        for (int ti = 0; ti < 2; ++ti) {
            const int t = wave + 8 * ti;
            if (t < 10) {
                const int a = (t >= 6) ? 3 : (t >= 3) ? 2 : (t >= 1) ? 1 : 0, bb = t - ((a * (a + 1)) >> 1);
                f32x16 p = {};
#pragma unroll
                for (int k = 0; k < 8; ++k) {
                    const bf16x8 kf = *(const LAS bf16x8*)(lds + R3_K + (2 * k + hi) * 2048 + (32 * bb + r32) * 16);
                    const bf16x8 qf = *(const LAS bf16x8*)(lds + R3_Q + (2 * k + hi) * 2048 + (32 * a + r32) * 16);
                    p = __builtin_amdgcn_mfma_f32_32x32x16_bf16(kf, qf, p, 0, 0, 0);
                }
                const float lanebase = lg * (float)(32 * (a - bb) + r32 - 4 * hi), cpos = -lg; const int tt = r32 - 4 * hi;
                float e[16];
#pragma unroll
                for (int r = 0; r < 16; ++r) { float v = p[r] * __builtin_amdgcn_exp2f(__builtin_fmaf(cpos, (float)crowc(r), lanebase)); if (bb == a) v = (crowc(r) <= tt) ? v : 0.f; e[r] = v; }
#pragma unroll
                for (int g = 0; g < 4; ++g) { pw[ti][g].x = pk2(e[4 * g], e[4 * g + 1]); pw[ti][g].y = pk2(e[4 * g + 2], e[4 * g + 3]); }
            }
        }
        __builtin_amdgcn_sched_barrier(0);
        bf16x8 sf[8];
        { const bf16* sb = states + (((size_t)(b * 4 + h) * 32 + tb) * 64 + (size_t)wave * 8) * 512 + lane * 8;
#pragma unroll
          for (int k = 0; k < 8; ++k) sf[k] = *(const bf16x8*)(sb + (size_t)k * 512); }
        bf16x8 vf[8];
        { LAS const unsigned char* vb = lds + R3_V + wave * 8192 + (8 * hi + ((lane & 15) >> 2)) * 64 + ((lane >> 4) & 1) * 32 + (lane & 3) * 8;
#pragma unroll
          for (int ks = 0; ks < 8; ++ks) { const s16x4 lo = vtr(vb + ks * 1024), hh = vtr(vb + ks * 1024 + 256); vf[ks] = (bf16x8){lo[0], lo[1], lo[2], lo[3], hh[0], hh[1], hh[2], hh[3]}; } }
        __syncthreads();
#pragma unroll
        for (int ti = 0; ti < 2; ++ti) {
            const int t = wave + 8 * ti;
            if (t < 10) {
                const int a = (t >= 6) ? 3 : (t >= 3) ? 2 : (t >= 1) ? 1 : 0, bb = t - ((a * (a + 1)) >> 1);
#pragma unroll
                for (int g = 0; g < 4; ++g) *(LAS u32x2*)(lds + R3_K + (4 * bb + g) * 2048 + (32 * a + r32) * 16 + hi * 8) = pw[ti][g];
            }
        }
        __syncthreads();
        LAS bf16* stg = (LAS bf16*)(lds + R3_V);
#pragma unroll 1
        for (int a = 0; a < 4; ++a) {
            f32x16 o = {};
#pragma unroll
            for (int ks = 0; ks < 8; ++ks) if (ks < 2 * (a + 1)) {
                const bf16x8 pa = *(const LAS bf16x8*)(lds + R3_K + (2 * ks + hi) * 2048 + (32 * a + r32) * 16);
                o = __builtin_amdgcn_mfma_f32_32x32x16_bf16(pa, vf[ks], o, 0, 0, 0);
            }
            f32x16 x = {};
#pragma unroll
            for (int k = 0; k < 8; ++k) { const bf16x8 qa = *(const LAS bf16x8*)(lds + R3_Q + (2 * k + hi) * 2048 + (32 * a + r32) * 16); x = __builtin_amdgcn_mfma_f32_32x32x16_bf16(qa, sf[k], x, 0, 0, 0); }
#pragma unroll
            for (int r = 0; r < 16; ++r) {
                const float din = __builtin_amdgcn_exp2f(lg * (float)(32 * a + crowc(r) + 4 * hi + 1));
                stg[(32 * a + crowc(r) + 4 * hi) * 256 + wave * 32 + r32] = f2bf(o[r] + din * x[r]);
            }
        }
        __syncthreads();
#pragma unroll 4
        for (int i = 0; i < 16; ++i) {
            const int q = wave * 16 + i;
            const u32x2 sw = *(const LAS u32x2*)(stg + q * 256 + lane * 4);
            const float v0 = __uint_as_float(sw.x << 16), v1 = __uint_as_float(sw.x & 0xffff0000u), v2 = __uint_as_float(sw.y << 16), v3 = __uint_as_float(sw.y & 0xffff0000u);
            const float ss = wave_sum((v0 * v0 + v1 * v1) + (v2 * v2 + v3 * v3));
            const float rs = rsqrtf(ss * (1.0f / 256.0f) + EPS);
            const u32x2 gw = *(const u32x2*)(proj + (row0 + q) * INW + C_RG + h * 256 + lane * 4);
            u32x2 w; w.x = pk2(v0 * rs * __uint_as_float(gw.x << 16), v1 * rs * __uint_as_float(gw.x & 0xffff0000u)); w.y = pk2(v2 * rs * __uint_as_float(gw.y << 16), v3 * rs * __uint_as_float(gw.y & 0xffff0000u));
            *(u32x2*)(yret + (row0 + q) * D + h * 256 + lane * 4) = w;
        }
        __syncthreads();
    }
}
#undef R3_ISSUE
}
template <bool FP8>
__device__ __forceinline__ void p0_item(const float* __restrict__ W, int K, int N, void* __restrict__ WT, int k0, int n0, int dst_row0, int lane) {
    const int kblk = lane >> 3, nq = lane & 7;
    const float* src = W + (size_t)(k0 + 16 * kblk) * N + n0 + 4 * nq;
    f32x4 v[16];
#pragma unroll
    for (int i = 0; i < 16; ++i) v[i] = *(const f32x4*)(src + (size_t)i * N);
#pragma unroll
    for (int j = 0; j < 4; ++j) {
        const size_t row = (size_t)(dst_row0 + 4 * nq + j);
        if constexpr (FP8) {
            u32x4 o;
            o.x = pk4_fp8(v[0][j] * W8_SCALE, v[1][j] * W8_SCALE, v[2][j] * W8_SCALE, v[3][j] * W8_SCALE); o.y = pk4_fp8(v[4][j] * W8_SCALE, v[5][j] * W8_SCALE, v[6][j] * W8_SCALE, v[7][j] * W8_SCALE);
            o.z = pk4_fp8(v[8][j] * W8_SCALE, v[9][j] * W8_SCALE, v[10][j] * W8_SCALE, v[11][j] * W8_SCALE); o.w = pk4_fp8(v[12][j] * W8_SCALE, v[13][j] * W8_SCALE, v[14][j] * W8_SCALE, v[15][j] * W8_SCALE);
            *(u32x4*)((unsigned char*)WT + row * K + k0 + 16 * kblk) = o;
        } else {
            u32x4 a, b;
            a.x = pk2(v[0][j], v[1][j]); a.y = pk2(v[2][j], v[3][j]); a.z = pk2(v[4][j], v[5][j]); a.w = pk2(v[6][j], v[7][j]);
            b.x = pk2(v[8][j], v[9][j]); b.y = pk2(v[10][j], v[11][j]); b.z = pk2(v[12][j], v[13][j]); b.w = pk2(v[14][j], v[15][j]);
            bf16* d = (bf16*)WT + row * K + k0 + 16 * kblk;
            *(u32x4*)d = a; *(u32x4*)(d + 8) = b;
        }
    }
}
#ifndef PROBE_PHASE
#define PROBE_PHASE (-1)
#endif
__device__ __forceinline__ void p0_transpose_item_fp8(const float* W, int K, int N, unsigned char* WT, int k0, int n0, int dst_row0, LAS float* scr, int lane) {
#pragma unroll 8
    for (int i = 0; i < 32; ++i) { const int kk = 2 * i + (lane >> 5); scr[kk * 33 + (lane & 31)] = W[(size_t)(k0 + kk) * N + n0 + (lane & 31)]; }
    LDS_WAIT(); asm volatile("" ::: "memory");
    const int c = lane & 3;
#pragma unroll
    for (int j = 0; j < 2; ++j) { const int n = (lane >> 2) + 16 * j; const LAS float* s = scr + (16 * c) * 33 + n;
        u32x4 o;
        o.x = pk4_fp8(s[0 * 33] * W8_SCALE, s[1 * 33] * W8_SCALE, s[2 * 33] * W8_SCALE, s[3 * 33] * W8_SCALE); o.y = pk4_fp8(s[4 * 33] * W8_SCALE, s[5 * 33] * W8_SCALE, s[6 * 33] * W8_SCALE, s[7 * 33] * W8_SCALE);
        o.z = pk4_fp8(s[8 * 33] * W8_SCALE, s[9 * 33] * W8_SCALE, s[10 * 33] * W8_SCALE, s[11 * 33] * W8_SCALE); o.w = pk4_fp8(s[12 * 33] * W8_SCALE, s[13 * 33] * W8_SCALE, s[14 * 33] * W8_SCALE, s[15 * 33] * W8_SCALE);
        *(u32x4*)(WT + (size_t)(dst_row0 + n) * K + k0 + 16 * c) = o; }
    LDS_WAIT(); asm volatile("" ::: "memory");
}
struct Args { const float* in[17]; float* out; unsigned char* ws; int ph_lo, ph_hi, li, pad; };

__global__ void __launch_bounds__(512, 2) mk_fwd(Args args) {
    extern __shared__ __attribute__((aligned(16))) unsigned char lds_raw[];
    LAS unsigned char* lds = (LAS unsigned char*)lds_raw;
    volatile LAS unsigned* MISC = (volatile LAS unsigned*)(lds + MISC_OFF);
    const int tid = threadIdx.x, lane = tid & 63, wave = __builtin_amdgcn_readfirstlane(tid >> 6);
    const int G = gridDim.x, bx = blockIdx.x;
    const int vcu = (G % 8 == 0) ? (bx % 8) * (G / 8) + bx / 8 : bx;
    unsigned char* ws = args.ws;
    unsigned* ctl = (unsigned*)(ws + WS_CTL);
    const float* x = args.in[0]; const float* meta = args.in[1]; const float* g1 = args.in[2]; const float* w_in = args.in[3];
    const float* qg = args.in[4]; const float* kg = args.in[5];
    const float* w_ab = args.in[7]; const float* w_rb = args.in[8]; const float* w_out = args.in[9];
    const float* w_gu = args.in[13]; const float* b_gu = args.in[14]; const float* w_dn = args.in[15]; const float* b_dn = args.in[16];
    float* out = args.out;
    bf16* Win_t = (bf16*)(ws + WS_WIN); bf16* Wab_t = (bf16*)(ws + WS_WAB); bf16* Wrb_t = (bf16*)(ws + WS_WRB); bf16* Wout_t = (bf16*)(ws + WS_WOUT);
    unsigned char* Wgu_t = ws + WS_WGU; unsigned char* Wdn_t = ws + WS_WDN;
    bf16* xb = (bf16*)(ws + WS_XB); bf16* proj = (bf16*)(ws + WS_PROJ); bf16* yatt = (bf16*)(ws + WS_YATT); bf16* yret = (bf16*)(ws + WS_YRET); bf16* merged = (bf16*)(ws + WS_MERGED);
    bf16* pmeta = proj + (size_t)NTOK * INW;
    const float* sinks = args.in[6]; const float* g2 = args.in[10]; const float* w_r = args.in[11]; const float* b_r = args.in[12];
    int* tke = (int*)(ws + SM_TKE); float* tkw = (float*)(ws + SM_TKW); int* tkpos = (int*)(ws + SM_TKPOS); int* list = (int*)(ws + SM_LIST); float* wlist = (float*)(ws + SM_WLIST);
    LAS unsigned char* misc = lds + MISC_OFF;
    bf16* states = (bf16*)(ws + ret::WS_STATES);
    unsigned char* act = ws + WS_ACT; bf16* rows = (bf16*)(ws + WS_ROWS); unsigned char* xn8 = ws + WS_XB;

    for (int u = tid; u < (LDS_BYTES - MISC_OFF) / 4; u += 512) ((LAS unsigned*)(lds + MISC_OFF))[u] = 0u;
    __syncthreads();
    XcdBarrier bar = xcd_barrier_post(ctl + CW_BAR + args.li * XCD_BAR_WORDS, MISC + 8);
    const int lo = args.ph_lo, hi = args.ph_hi;
#define IN(k) (lo <= (k) && (k) < hi)
#define BOTH(k) (IN(k) && IN((k) + 1))
#define GRID_BAR() xcd_barrier(bar)

    if (IN(0)) { for (int rep_ = 0; rep_ < ((PROBE_PHASE == 0) ? 2 : 1); ++rep_) {
        const int gw = vcu * NWAVES + wave, NGW = G * NWAVES;
        constexpr int I_IN = 8 * 200, I_SQ = 8 * 32, I_GU = 32 * 8 * 64, I_DN = 32 * 8 * 32;
        constexpr int NITEMS = I_IN + 3 * I_SQ + I_GU + I_DN;
        for (int rep2_ = 0; rep2_ < ((PROBE_PHASE == 100) ? 2 : 1); ++rep2_)
        for (int it = gw; it < NITEMS; it += NGW) {
            int r = it;
            if (r < I_IN) { const int kb = r / 200, nb = r % 200, n0 = nb * 32, o = n0 & 255, wcc = o >> 6, bj = (o >> 5) & 1;
                p0_item<false>(w_in, D, INW, Win_t, kb * 128, n0, (n0 & ~255) + 128 * bj + 32 * wcc, lane); continue; }
            r -= I_IN;
            if (r < I_SQ) { p0_item<false>(w_ab, D, D, Wab_t, (r / 32) * 128, (r % 32) * 32, (r % 32) * 32, lane); continue; } r -= I_SQ;
            if (r < I_SQ) { p0_item<false>(w_rb, D, D, Wrb_t, (r / 32) * 128, (r % 32) * 32, (r % 32) * 32, lane); continue; } r -= I_SQ;
            if (r < I_SQ) { p0_item<false>(w_out, D, D, Wout_t, (r / 32) * 128, (r % 32) * 32, (r % 32) * 32, lane); continue; } r -= I_SQ;
            if (r < I_GU) { const int e = r / 512, q = r % 512, kb = q / 64, nb = q % 64, n0 = nb * 32, bj = n0 >> 10, rem = n0 & 1023, pn = rem >> 7, cl = rem & 127;
                p0_item<true>(w_gu + (size_t)e * D * 2048, D, 2048, Wgu_t + (size_t)e * 2048 * D, kb * 128, n0, 256 * pn + 128 * bj + cl, lane); continue; }
            r -= I_GU;
            { const int e = r / 256, q = r % 256, kb = q / 32, nb = q % 32;
              p0_item<true>(w_dn + (size_t)e * DFF * D, DFF, D, Wdn_t + (size_t)e * D * DFF, kb * 128, nb * 32, nb * 32, lane); }
        }
        for (int rep2_ = 0; rep2_ < ((PROBE_PHASE == 101) ? 2 : 1); ++rep2_)
        for (int row = gw; row < NTOK; row += NGW) {
            const f32x4* xr = (const f32x4*)(x + (size_t)row * D) + lane;
            f32x4 v[4]; float ss = 0.f;
#pragma unroll
            for (int j = 0; j < 4; ++j) { v[j] = xr[64 * j]; ss += (v[j][0] * v[j][0] + v[j][1] * v[j][1]) + (v[j][2] * v[j][2] + v[j][3] * v[j][3]); }
            const float rstd = rsqrtf(wave_sum(ss) * (1.0f / D) + EPS);
            u32x2* o8 = (u32x2*)(xb + (size_t)row * D) + lane;
#pragma unroll
            for (int j = 0; j < 4; ++j) { const f32x4 gg = ((const f32x4*)g1)[64 * j + lane]; u32x2 w; w.x = pk2(v[j][0] * rstd * gg[0], v[j][1] * rstd * gg[1]); w.y = pk2(v[j][2] * rstd * gg[2], v[j][3] * rstd * gg[3]); o8[64 * j] = w; }
        }
        for (int row = gw; row < 256; row += NGW) {
            u32x2* o8 = (u32x2*)(xb + (size_t)(NTOK + row) * D) + lane;
            if (row < NMETA) {
                const f32x4* xr = (const f32x4*)(meta + (size_t)row * D) + lane;
                f32x4 v[4]; float ss = 0.f;
#pragma unroll
                for (int j = 0; j < 4; ++j) { v[j] = xr[64 * j]; ss += (v[j][0] * v[j][0] + v[j][1] * v[j][1]) + (v[j][2] * v[j][2] + v[j][3] * v[j][3]); }
                const float rstd = rsqrtf(wave_sum(ss) * (1.0f / D) + EPS);
#pragma unroll
                for (int j = 0; j < 4; ++j) { const f32x4 gg = ((const f32x4*)g1)[64 * j + lane]; u32x2 w; w.x = pk2(v[j][0] * rstd * gg[0], v[j][1] * rstd * gg[1]); w.y = pk2(v[j][2] * rstd * gg[2], v[j][3] * rstd * gg[3]); o8[64 * j] = w; }
            } else {
#pragma unroll
                for (int j = 0; j < 4; ++j) o8[64 * j] = (u32x2){0u, 0u};
            }
        }
        __syncthreads(); }
        if (BOTH(0)) GRID_BAR();
    }
    if (IN(1)) {
        SchedDense S; S.init(xb, Win_t, NTOK + 256, INW, D, G, bx);
        EpiProj E{proj, qg, kg};
        for (int rep_ = 0; rep_ < ((PROBE_PHASE == 1) ? 2 : 1); ++rep_) pg8::gemm_phase<EpiProj, SchedDense>(lds, 2 * D, S, E);
        if (BOTH(1)) GRID_BAR();
    }
    if (IN(2)) {
        float mq = fabsf(qg[lane]), mk = fabsf(kg[lane]);
#pragma unroll
        for (int o = 1; o < 64; o <<= 1) { mq = fmaxf(mq, __shfl_xor(mq, o)); mk = fmaxf(mk, __shfl_xor(mk, o)); }
        const float bshift = 8.0f * mq * mk;
        for (int rep_ = 0; rep_ < ((PROBE_PHASE == 20) ? 2 : 1); ++rep_) for (int u = bx; u < NB * 32 * 2; u += G) attn::unit(lds, u >> 6, (u >> 1) & 31, u & 1, proj, pmeta, sinks, bshift, yatt);
        for (int rep_ = 0; rep_ < ((PROBE_PHASE == 21) ? 2 : 1); ++rep_) for (int u = bx; u < NB * 4 * 8; u += G) ret::state_chain(lds, u >> 5, (u >> 3) & 3, u & 7, proj, pmeta, states);
        if (BOTH(2)) GRID_BAR();
    }
    if (IN(3)) {
        for (int rep_ = 0; rep_ < ((PROBE_PHASE == 3) ? 2 : 1); ++rep_) ret::out_phase(lds, proj, states, yret, G, bx);
        if (BOTH(3)) GRID_BAR();
    }
    if (IN(4)) {
        SchedBranch S{(const char*)yatt, (const char*)yret, (const char*)Wab_t, (const char*)Wrb_t, G, bx};
        EpiBranch E{merged, proj};
        for (int rep_ = 0; rep_ < ((PROBE_PHASE == 4) ? 2 : 1); ++rep_) pg8::gemm_phase<EpiBranch, SchedBranch>(lds, 2 * D, S, E);
        if (BOTH(4)) GRID_BAR();
    }
    if (IN(5)) {
        SchedDense S; S.init(merged, Wout_t, NTOK, D, D, G, bx);
        EpiOut E{x, out};
        for (int rep_ = 0; rep_ < ((PROBE_PHASE == 5) ? 2 : 1); ++rep_) pg8::gemm_phase<EpiOut, SchedDense>(lds, 2 * D, S, E);
        if (BOTH(5)) GRID_BAR();
    }
    if (IN(6)) {
        route_phase(lds, out, g2, w_r, b_r, xn8, tke, tkpos, tkw, list, wlist, ctl + CW_CNT, G, bx);
        if (BOTH(6)) GRID_BAR();
    }
    if (hi > 7 && lo <= 9) moe_tables(misc, ctl + CW_CNT);
    if (IN(7)) {
        SchedMoe<true, 8> S{(const char*)xn8, (const char*)Wgu_t, misc, list, G, bx};
        EpiGU E{act, b_gu};
        for (int rep_ = 0; rep_ < ((PROBE_PHASE == 7) ? 2 : 1); ++rep_) pg8::gemm_phase<EpiGU, SchedMoe<true, 8>, true>(lds, D, S, E);
        if (BOTH(7)) GRID_BAR();
    }
    if (IN(8)) {
        SchedMoe<false, 4> S{(const char*)act, (const char*)Wdn_t, misc, list, G, bx};
        EpiDown E{rows, b_dn, wlist, misc};
        for (int rep_ = 0; rep_ < ((PROBE_PHASE == 8) ? 2 : 1); ++rep_) pg8::gemm_phase<EpiDown, SchedMoe<false, 4>, true>(lds, DFF, S, E);
        if (BOTH(8)) GRID_BAR();
    }
    if (IN(9)) combine_phase(misc, (void*)proj, out, rows, tke, tkpos, vcu * NWAVES + wave, G * NWAVES, lane);
#undef IN
#undef BOTH
#undef GRID_BAR
}

extern "C" void kernel_launch(void* const* d_in, const int* in_sizes, int n_in, void* d_out, int out_size, void* d_ws, size_t ws_size, hipStream_t stream) {
    static int grid = 0;
    if (grid == 0) {
        if (n_in != 17 || in_sizes[0] != NTOK * D || out_size != NTOK * D || ws_size < WS_END) {
            fprintf(stderr, "kernel_launch: unexpected shapes (n_in %d in0 %d out %d ws %zu)\n", n_in, n_in > 0 ? in_sizes[0] : -1, out_size, ws_size); grid = -1; return; }
        int dev = 0, cus = 0;
        if (hipGetDevice(&dev) != hipSuccess || hipDeviceGetAttribute(&cus, hipDeviceAttributeMultiprocessorCount, dev) != hipSuccess) { grid = -1; return; }
        if (hipFuncSetAttribute((const void*)mk_fwd, hipFuncAttributeMaxDynamicSharedMemorySize, LDS_BYTES) != hipSuccess) { fprintf(stderr, "kernel_launch: hipFuncSetAttribute failed\n"); grid = -1; return; }
        grid = cus;
    }
    if (grid < 0) return;
    unsigned char* ws = (unsigned char*)d_ws;
    (void)hipMemsetAsync(ws + WS_CTL, 0, 1 * MiB, stream);
    Args a{};
    for (int i = 0; i < 17; ++i) a.in[i] = (const float*)d_in[i];
    a.out = (float*)d_out; a.ws = ws; a.ph_lo = 0; a.ph_hi = 10; a.li = 0; a.pad = 0;
    hipLaunchKernelGGL(mk_fwd, dim3(grid), dim3(512), LDS_BYTES, stream, a);
}
```

```cpp
#include <hip/hip_runtime.h>
#include <cstdio>
#include <cstdint>

typedef unsigned short bf16;
__device__ __forceinline__ float bf2f(bf16 v) { return __uint_as_float(((unsigned)v) << 16); }
__device__ __forceinline__ bf16 f2bf(float f) { unsigned u = __float_as_uint(f); return (bf16)((u + 0x7fffu + ((u >> 16) & 1u)) >> 16); }
__device__ __forceinline__ float sigmoidf_(float x) { return 1.0f / (1.0f + __expf(-x)); }

constexpr int NB = 8, SEQ = 4096, D = 1024, NTOK = NB * SEQ;
constexpr int NMETA = 16;
constexpr int INW = 6400;
constexpr int C_AQ = 0, C_AK = 1024, C_AV = 1152, C_RQ = 1280, C_RK = 1792, C_RV = 2304, C_RG = 3328, C_GA = 4352, C_GR = 5376;
constexpr int NE = 32, TOPK = 4, DFF = 1024;
constexpr int NROWS = (NTOK * TOPK / 256 + NE) * 256;
constexpr int NTILE = NROWS / 256;
constexpr float EPS = 1e-5f;

constexpr size_t MiB = 1u << 20;
constexpr size_t WS_CTL = 0;
constexpr size_t WS_SMALL = 1 * MiB;
constexpr size_t WS_W = 16 * MiB;
constexpr size_t WS_XB = 232 * MiB;
constexpr size_t WS_PROJ = 297 * MiB;
constexpr size_t WS_YATT = 701 * MiB;
constexpr size_t WS_YRET = 765 * MiB;
constexpr size_t WS_MERGED = 829 * MiB;
constexpr size_t WS_END = 1020 * MiB;
constexpr size_t WS_ACT = 297 * MiB;
constexpr size_t WS_ROWS = 568 * MiB;
constexpr size_t SM_UMETA = WS_SMALL;
constexpr size_t SM_PMETA = WS_SMALL + 64 * 1024;
constexpr size_t SM_TKE = WS_SMALL + 512 * 1024;
constexpr size_t SM_TKW = SM_TKE + 512 * 1024;
constexpr size_t SM_TKPOS = SM_TKW + 512 * 1024;
constexpr size_t SM_TKROW = SM_TKPOS + 512 * 1024;
constexpr size_t SM_ROWTOK = SM_TKROW + 512 * 1024;
constexpr size_t SM_ROWW = SM_ROWTOK + 1024 * 1024;
constexpr size_t SM_TILEE = SM_ROWW + 1024 * 1024;
constexpr int CW_CNT = 1024;

#define LAS __attribute__((address_space(3)))
#define GAS __attribute__((address_space(1)))
typedef short bf16x8 __attribute__((ext_vector_type(8)));
typedef float f32x4 __attribute__((ext_vector_type(4)));
typedef float f32x2 __attribute__((ext_vector_type(2)));
typedef unsigned u32x4 __attribute__((ext_vector_type(4)));
typedef unsigned u32x2 __attribute__((ext_vector_type(2)));
#define LDS_WAIT() asm volatile("s_waitcnt lgkmcnt(0)" ::: "memory")
#define VM_WAIT() asm volatile("s_waitcnt vmcnt(0)" ::: "memory")
__device__ __forceinline__ unsigned pk2(float lo, float hi) { return (unsigned)f2bf(lo) | ((unsigned)f2bf(hi) << 16); }
__device__ __forceinline__ unsigned pk4_fp8(float a, float b, float c, float d) { int w = __builtin_amdgcn_cvt_pk_fp8_f32(a, b, 0, false); w = __builtin_amdgcn_cvt_pk_fp8_f32(c, d, w, true); return (unsigned)w; }
constexpr float W8_SCALE = 64.0f, W8_INV = 1.0f / 64.0f;
constexpr float ROW8_SCALE = 16.0f, ROW8_INV = 1.0f / 16.0f;
__device__ __forceinline__ float wave_sum(float v) {
#pragma unroll
    for (int o = 1; o < 64; o <<= 1) v += __shfl_xor(v, o);
    return v;
}

constexpr size_t WS_WIN = WS_W;
constexpr size_t WS_WAB = WS_W + 13 * MiB;
constexpr size_t WS_WRB = WS_W + 15 * MiB;
constexpr size_t WS_WOUT = WS_W + 17 * MiB;
constexpr size_t WS_WGU = WS_W + 19 * MiB;
constexpr size_t WS_WDN = WS_W + 147 * MiB;
static_assert(WS_WDN + 64 * MiB <= WS_XB, "weight map");
constexpr size_t SM_ATILE = SM_TILEE + 4096;
constexpr int CW_NACT = 1088;
constexpr int CW_BAR = 4096;

constexpr int RING_BYTES = 131072;
constexpr int MISC_OFF = RING_BYTES;
constexpr int LDS_BYTES = 147456;
constexpr int NWAVES = 8;

#define XB_TMO      128
#define XB_XCNT(j)  (256  + 64 * (j))
#define XB_XSUB(j)  (1280 + 64 * (j))
#define XB_XGEN(j)  (2304 + 64 * (j))
#define XB_TOP      3328
#define XB_TOPGEN   3392
#define XCD_BAR_WORDS 3456
#define XB_SPIN_CAP (1u << 20)
__device__ __forceinline__ unsigned xb_ld(unsigned* p)              { return __hip_atomic_load(p, __ATOMIC_RELAXED, __HIP_MEMORY_SCOPE_AGENT); }
__device__ __forceinline__ unsigned xb_add(unsigned* p, unsigned v) { return __hip_atomic_fetch_add(p, v, __ATOMIC_RELAXED, __HIP_MEMORY_SCOPE_AGENT); }
__device__ __forceinline__ unsigned xb_xcc_id() { return (unsigned)__builtin_amdgcn_s_getreg((3 << 11) | 20) & 0xFu; }
#define XB_SPIN(cond, bar) do { unsigned _sp = 0; while (cond) { __builtin_amdgcn_s_sleep(1); \
    if ((++_sp & 255u) == 0u) { if (xb_ld(&(bar)[XB_TMO])) break; if (_sp > XB_SPIN_CAP) { atomicAdd(&(bar)[XB_TMO], 1u); break; } } } } while (0)
struct XcdBarrier { unsigned* bar; unsigned x; volatile LAS unsigned* st; };
__device__ __forceinline__ XcdBarrier xcd_barrier_post(unsigned* bar, volatile LAS unsigned* st) {
    XcdBarrier b; b.bar = bar; b.x = xb_xcc_id(); b.st = st;
    if (threadIdx.x == 0) (void)xb_add(&bar[XB_XCNT(b.x)], 1u);
    return b;
}
__device__ __forceinline__ void xcd_barrier_complete(unsigned* bar, unsigned x, unsigned& nloc, unsigned& nx) {
    const unsigned G = gridDim.x * gridDim.y * gridDim.z;
    unsigned sum, cnt, mine, sp = 0u;
    for (;;) {
        sum = 0u; cnt = 0u; mine = 0u;
#pragma unroll
        for (unsigned j = 0; j < 16; ++j) { const unsigned c = xb_ld(&bar[XB_XCNT(j)]); sum += c; cnt += (c > 0u) ? 1u : 0u; mine = (j == x) ? c : mine; }
        if (sum == G) break;
        __builtin_amdgcn_s_sleep(1);
        if ((++sp & 255u) == 0u) { if (xb_ld(&bar[XB_TMO])) break; if (sp > XB_SPIN_CAP) { atomicAdd(&bar[XB_TMO], 1u); break; } }
    }
    nloc = mine > 0u ? mine : 1u; nx = cnt > 0u ? cnt : 1u;
}
__device__ __forceinline__ void xcd_barrier(const XcdBarrier& b) {
    asm volatile("s_waitcnt vmcnt(0)" ::: "memory");
    __syncthreads();
    if (threadIdx.x == 0) {
        unsigned* bar = b.bar;
        __builtin_amdgcn_s_waitcnt(0);
        unsigned nloc = b.st[0], nx = b.st[1];
        if (nloc == 0u) { xcd_barrier_complete(bar, b.x, nloc, nx); b.st[0] = nloc; b.st[1] = nx; }
        const unsigned old = xb_add(&bar[XB_XSUB(b.x)], 1u);
        const unsigned gen = old / nloc;
        if (old + 1u == (gen + 1u) * nloc) {
            __builtin_amdgcn_fence(__ATOMIC_RELEASE, "agent");
            asm volatile("s_waitcnt vmcnt(0)" ::: "memory");
            const unsigned og = xb_add(&bar[XB_TOP], 1u);
            const unsigned tg = og / nx;
            if (og + 1u == (tg + 1u) * nx) xb_add(&bar[XB_TOPGEN], 1u);
            else XB_SPIN(xb_ld(&bar[XB_TOPGEN]) == tg, bar);
            __builtin_amdgcn_fence(__ATOMIC_ACQUIRE, "agent");
            xb_add(&bar[XB_XGEN(b.x)], 1u);
            asm volatile("s_waitcnt vmcnt(0)" ::: "memory");
        } else {
            XB_SPIN(xb_ld(&bar[XB_XGEN(b.x)]) == gen, bar);
            __builtin_amdgcn_fence(__ATOMIC_ACQUIRE, "agent");
            asm volatile("s_waitcnt vmcnt(0)" ::: "memory");
        }
    }
    __syncthreads();
}

namespace pg8 {
constexpr int BM = 256, BK = 64, HALF = 128, HTB = HALF * BK * 2, STAGE_BYTES = 8 * HTB;
__host__ __device__ __forceinline__ int lds_byte(int r, int c) { const int st = (r >> 4) * 2 + (c >> 5), rr = r & 15, cc = c & 31, ob = rr * 64 + cc * 2; return st * 1024 + (ob ^ (((ob >> 9) & 1) << 5)); }
__host__ __device__ __forceinline__ void stage_rc(int b, int& R, int& C) { const int st = b / 1024, sb = b % 1024, swz = sb ^ (((sb >> 9) & 1) << 5); R = (st >> 1) * 16 + swz / 64; C = (st & 1) * 32 + (swz % 64) / 2; }
__host__ __device__ __forceinline__ int perm32(int rho) { const int n = rho >> 4, i = rho & 15; return 8 * (i >> 2) + 4 * n + (i & 3); }
struct Unit { int pm, pn, aux, tl; const char* A; const char* B; };
typedef f32x4 Acc[2][2][4][2];
typedef int u32x4_i __attribute__((ext_vector_type(4)));

typedef int v8i32 __attribute__((ext_vector_type(8)));
template <class Epi, class Sched, bool FP8 = false>
__device__ __forceinline__ void gemm_phase(LAS unsigned char* lds, const int Kb, const Sched& S, const Epi& E) {
    const int tid = threadIdx.x, wid = __builtin_amdgcn_readfirstlane(tid >> 6), lane = tid & 63, wr = wid >> 2, wc = wid & 3, fr = lane & 15, fq = lane >> 4;
    const int nt = Kb / 128;
    int RA[2], CA[2]; unsigned voffB[2];
#pragma unroll
    for (int i = 0; i < 2; ++i) { int R, C; stage_rc(tid * 16 + i * 8192, R, C); const int Rb = Epi::PERM ? ((R & ~31) + perm32(R & 31)) : R;
        RA[i] = R; CA[i] = C; voffB[i] = (unsigned)(Rb * Kb + C * 2); }
    const size_t kstep = (size_t)(BK * 2);
    const size_t hstep = (size_t)HALF * Kb;
    const unsigned ldsw = (unsigned)wid * 1024u;
    const int aoff = lds_byte(wr * 64 + fr, fq * 8), boff = lds_byte(wc * 32 + fr, fq * 8);
#define PG8_SA(b, h) (((b) * 2 + (h)) * HTB)
#define PG8_SB(b, h) ((4 + (b) * 2 + (h)) * HTB)
#define PG8_STAGE(bufoff, gbase, voff) do { _Pragma("unroll") for (int _i = 0; _i < 2; ++_i) \
        __builtin_amdgcn_global_load_lds((const unsigned*)((const char*)(gbase) + (voff)[_i]), (LAS unsigned*)(lds + (bufoff) + ldsw + _i * 8192), 16, 0, 0); } while (0)
#define PG8_LDA(dst, b, h) do { _Pragma("unroll") for (int m = 0; m < 4; ++m) _Pragma("unroll") for (int k = 0; k < 2; ++k) dst[m][k] = *(const LAS bf16x8*)(lds + PG8_SA(b, h) + aoff + m * 2048 + k * 1024); } while (0)
#define PG8_LDB(dst, b, h) do { _Pragma("unroll") for (int n = 0; n < 2; ++n) _Pragma("unroll") for (int k = 0; k < 2; ++k) dst[n][k] = *(const LAS bf16x8*)(lds + PG8_SB(b, h) + boff + n * 2048 + k * 1024); } while (0)
#define PG8_MMA(ai, bj, At, Bt) do { __builtin_amdgcn_s_setprio(1); _Pragma("unroll") for (int m = 0; m < 4; ++m) _Pragma("unroll") for (int n = 0; n < 2; ++n) { \
        if constexpr (FP8) { const v8i32 bq = __builtin_shufflevector(__builtin_bit_cast(u32x4_i, Bt[n][0]), __builtin_bit_cast(u32x4_i, Bt[n][1]), 0, 1, 2, 3, 4, 5, 6, 7), \
                                         aq = __builtin_shufflevector(__builtin_bit_cast(u32x4_i, At[m][0]), __builtin_bit_cast(u32x4_i, At[m][1]), 0, 1, 2, 3, 4, 5, 6, 7); \
            asm volatile("v_mfma_scale_f32_16x16x128_f8f6f4 %0, %1, %2, %0, %3, %3 op_sel_hi:[0,0,0]" : "+v"(acc[ai][bj][m][n]) : "v"(bq), "v"(aq), "v"(scale1)); } \
        else { _Pragma("unroll") for (int k = 0; k < 2; ++k) acc[ai][bj][m][n] = __builtin_amdgcn_mfma_f32_16x16x32_bf16(Bt[n][k], At[m][k], acc[ai][bj][m][n], 0, 0, 0); } } \
        __builtin_amdgcn_s_setprio(0); } while (0)
#define PG8_WAIT_V(n) asm volatile("s_waitcnt vmcnt(" #n ")" ::: "memory")
#define PG8_WAIT_L(n) asm volatile("s_waitcnt lgkmcnt(" #n ")" ::: "memory")
#define PG8_BAR __builtin_amdgcn_s_barrier()
#define PG8_SCHED __builtin_amdgcn_sched_barrier(0)
    int scale1 = 0x7f7f7f7f; asm volatile("" : "+v"(scale1));
    Unit cur, nxt; int ui = 0;
    if (!S.next(0, cur)) return;
    unsigned ca[2][2], na[2][2];
    S.aoff(cur, RA, CA, ca);
    f32x4 acc[2][2][4][2];
#pragma unroll
    for (int a = 0; a < 2; ++a)
#pragma unroll
        for (int b = 0; b < 2; ++b)
#pragma unroll
            for (int m = 0; m < 4; ++m)
#pragma unroll
                for (int n = 0; n < 2; ++n) acc[a][b][m][n] = (f32x4){0.f, 0.f, 0.f, 0.f};
    bf16x8 At[4][2], B0[2][2], B1[2][2];
    const char* cA = cur.A; const char* cB = cur.B;
    PG8_STAGE(PG8_SB(0, 0), cB, voffB); PG8_STAGE(PG8_SB(0, 1), cB + hstep, voffB); PG8_STAGE(PG8_SA(0, 0), cA, ca[0]); PG8_STAGE(PG8_SA(0, 1), cA, ca[1]);
    if (wr == 1) PG8_BAR;
    PG8_WAIT_V(2); PG8_BAR;
    PG8_STAGE(PG8_SB(1, 0), cB + kstep, voffB); PG8_STAGE(PG8_SA(1, 0), cA + kstep, ca[0]); PG8_STAGE(PG8_SB(1, 1), cB + hstep + kstep, voffB);
    PG8_WAIT_V(6); PG8_BAR;
    for (;;) {
        const bool has_next = S.next(ui + 1, nxt);
        if constexpr (Sched::GATHER) {
            if (has_next) S.aoff(nxt, RA, CA, na);
            else {
#pragma unroll
                for (int h = 0; h < 2; ++h)
#pragma unroll
                    for (int i = 0; i < 2; ++i) na[h][i] = ca[h][i];
            }
        }
        const char* nA = has_next ? nxt.A : cA; const char* nB = has_next ? nxt.B : cB;
#pragma nounroll
        for (int t = 0; t < nt; t += 2) {
            const bool last = (t == nt - 2);
            const char* a1 = cA + (size_t)(t + 1) * kstep;
            const char* a2 = last ? nA : cA + (size_t)(t + 2) * kstep; const char* b2 = last ? nB : cB + (size_t)(t + 2) * kstep;
            const char* a3 = a2 + kstep; const char* b3 = b2 + kstep;
            unsigned o2[2][2];
#pragma unroll
            for (int h = 0; h < 2; ++h)
#pragma unroll
                for (int i = 0; i < 2; ++i) { if constexpr (Sched::GATHER) o2[h][i] = last ? na[h][i] : ca[h][i]; else o2[h][i] = ca[h][i]; }
            PG8_LDB(B0, 0, 0); PG8_LDB(B1, 0, 1); PG8_SCHED; PG8_LDA(At, 0, 0); PG8_STAGE(PG8_SA(1, 1), a1, ca[1]);
            PG8_WAIT_V(8); PG8_WAIT_L(0); PG8_BAR; PG8_MMA(0, 0, At, B0); PG8_MMA(0, 1, At, B1); PG8_BAR; PG8_SCHED;
            PG8_LDA(At, 0, 1); PG8_STAGE(PG8_SB(0, 0), b2, voffB); PG8_STAGE(PG8_SB(0, 1), b2 + hstep, voffB); PG8_STAGE(PG8_SA(0, 0), a2, o2[0]);
            PG8_WAIT_V(8); PG8_WAIT_L(0); PG8_BAR; PG8_MMA(1, 0, At, B0); PG8_MMA(1, 1, At, B1); PG8_BAR; PG8_SCHED;
            PG8_LDB(B0, 1, 0); PG8_LDB(B1, 1, 1); PG8_SCHED; PG8_LDA(At, 1, 0); PG8_STAGE(PG8_SA(0, 1), a2, o2[1]);
            PG8_WAIT_V(8); PG8_WAIT_L(0); PG8_BAR; PG8_MMA(0, 0, At, B0); PG8_MMA(0, 1, At, B1); PG8_BAR; PG8_SCHED;
            PG8_LDA(At, 1, 1); PG8_STAGE(PG8_SB(1, 0), b3, voffB); PG8_STAGE(PG8_SB(1, 1), b3 + hstep, voffB); PG8_STAGE(PG8_SA(1, 0), a3, o2[0]);
            PG8_WAIT_V(8); PG8_WAIT_L(0); PG8_BAR; PG8_MMA(1, 0, At, B0); PG8_MMA(1, 1, At, B1); PG8_BAR; PG8_SCHED;
        }
        if constexpr (FP8) { asm volatile("s_nop 15\n\ts_nop 15\n\ts_nop 15" ::: "memory"); PG8_SCHED; }
        if (wr == 0) PG8_BAR;
        E(acc, cur, wr, wc, fr, fq);
        if (!has_next) break;
#pragma unroll
        for (int a = 0; a < 2; ++a)
#pragma unroll
            for (int b = 0; b < 2; ++b)
#pragma unroll
                for (int m = 0; m < 4; ++m)
#pragma unroll
                    for (int n = 0; n < 2; ++n) acc[a][b][m][n] = (f32x4){0.f, 0.f, 0.f, 0.f};
        cur = nxt; cA = nA; cB = nB; ++ui;
        if constexpr (Sched::GATHER) {
#pragma unroll
            for (int h = 0; h < 2; ++h)
#pragma unroll
                for (int i = 0; i < 2; ++i) ca[h][i] = na[h][i];
        }
        if (wr == 1) PG8_BAR;
    }
    PG8_WAIT_V(0);
    PG8_BAR;
#undef PG8_SA
#undef PG8_SB
#undef PG8_STAGE
#undef PG8_LDA
#undef PG8_LDB
#undef PG8_MMA
#undef PG8_WAIT_V
#undef PG8_WAIT_L
#undef PG8_BAR
#undef PG8_SCHED
}
}
#ifndef PROBE_PHASE
#define PROBE_PHASE (-1)
#endif
constexpr size_t SM_LIST = WS_SMALL + 5 * MiB;
constexpr size_t SM_WLIST = WS_SMALL + 9 * MiB;
constexpr int MT_PSTART = 256;
constexpr int MT_CNT = 512;
constexpr int MT_NACT = 768;
constexpr int MT_ATILE = 1024;
constexpr int MT_HIST = 4096;
constexpr int MT_BASE = 4224;
constexpr int MT_REC = 4352;

__device__ __forceinline__ void moe_tables(LAS unsigned char* misc, const unsigned* cnt) {
    LAS int* pstart = (LAS int*)(misc + MT_PSTART); LAS int* cl = (LAS int*)(misc + MT_CNT); LAS int* at = (LAS int*)(misc + MT_ATILE);
    __syncthreads();
    if (threadIdx.x < 64) {
        const int lane = threadIdx.x, e = lane & 31;
        const int c = (int)__hip_atomic_load(cnt + e, __ATOMIC_RELAXED, __HIP_MEMORY_SCOPE_AGENT), nt = (c + 255) >> 8;
        int incl = nt;
#pragma unroll
        for (int o = 1; o < 32; o <<= 1) { const int v = __shfl_up(incl, o); if (e >= o) incl += v; }
        const int t0 = incl - nt;
        if (lane < 32) { cl[e] = c; pstart[e] = t0 << 8; for (int t = 0; t < nt; ++t) at[t0 + t] = (t0 + t) | (e << 12) | (t << 20);
            if (e == 31) { pstart[NE] = incl << 8; *(LAS int*)(misc + MT_NACT) = incl; } }
    }
    __syncthreads();
}

template <int N, int XR>
__device__ __forceinline__ void tr_step(float (&v)[64], int lane) {
    const bool up = (lane & XR) != 0;
#pragma unroll
    for (int i = 0; i < N; ++i) { const float keep = up ? v[i + N] : v[i], send = up ? v[i] : v[i + N]; v[i] = keep + __shfl_xor(send, XR); }
}

__device__ __forceinline__ void route_phase(LAS unsigned char* lds, const float* __restrict__ h2, const float* __restrict__ g2, const float* __restrict__ wr, const float* __restrict__ br,
                                            unsigned char* __restrict__ xn2, int* __restrict__ tke, int* __restrict__ tkpos, float* __restrict__ tkw, int* __restrict__ list, float* __restrict__ wlist,
                                            unsigned* __restrict__ cnt, int G, int bx) {
    const int tid = threadIdx.x, lane = tid & 63; const int wave = __builtin_amdgcn_readfirstlane(tid >> 6);
    LAS float* wT = (LAS float*)lds;
    LAS unsigned char* misc = lds + MISC_OFF;
    LAS int* hist = (LAS int*)(misc + MT_HIST); LAS int* base = (LAS int*)(misc + MT_BASE); LAS int* rec = (LAS int*)(misc + MT_REC);
    for (int idx = tid; idx < NE * D; idx += 512) { const int e = idx >> 10, k = idx & 1023; wT[idx] = wr[(size_t)k * NE + e]; }
    const float bias = br[lane & 31];
    for (int tb = bx; tb < NTOK / 128; tb += G) {
        if (tid < 32) hist[tid] = 0;
        __syncthreads();
        for (int rep_ = 0; rep_ < ((PROBE_PHASE == 6) ? 2 : 1); ++rep_)
        for (int pp = 0; pp < 8; ++pp) {
            const int tl0 = wave * 16 + pp * 2;
            const int row0 = tb * 128 + tl0;
            float xv[2][16];
#pragma unroll
            for (int t = 0; t < 2; ++t) {
                const f32x4* xr = (const f32x4*)(h2 + (size_t)(row0 + t) * D) + lane;
                float ss = 0.f; f32x4 v[4];
#pragma unroll
                for (int j = 0; j < 4; ++j) { v[j] = xr[64 * j]; ss += (v[j][0] * v[j][0] + v[j][1] * v[j][1]) + (v[j][2] * v[j][2] + v[j][3] * v[j][3]); }
                const float rstd = rsqrtf(wave_sum(ss) * (1.0f / D) + EPS);
                unsigned* o4 = (unsigned*)(xn2 + (size_t)(row0 + t) * D) + lane;
#pragma unroll
                for (int j = 0; j < 4; ++j) { const f32x4 gg = ((const f32x4*)g2)[64 * j + lane];
#pragma unroll
                    for (int q = 0; q < 4; ++q) xv[t][4 * j + q] = v[j][q] * rstd * gg[q];
                    o4[64 * j] = pk4_fp8(xv[t][4 * j], xv[t][4 * j + 1], xv[t][4 * j + 2], xv[t][4 * j + 3]); }
            }
            float acc[64];
#pragma unroll
            for (int i = 0; i < 64; ++i) acc[i] = 0.f;
#pragma unroll
            for (int e = 0; e < 32; ++e)
#pragma unroll
                for (int j = 0; j < 4; ++j) {
                    const f32x4 w = *(const LAS f32x4*)(wT + e * 1024 + (64 * j + lane) * 4);
                    acc[e] += (xv[0][4 * j] * w[0] + xv[0][4 * j + 1] * w[1]) + (xv[0][4 * j + 2] * w[2] + xv[0][4 * j + 3] * w[3]);
                    acc[32 + e] += (xv[1][4 * j] * w[0] + xv[1][4 * j + 1] * w[1]) + (xv[1][4 * j + 2] * w[2] + xv[1][4 * j + 3] * w[3]);
                }
            tr_step<32, 32>(acc, lane); tr_step<16, 16>(acc, lane); tr_step<8, 8>(acc, lane); tr_step<4, 4>(acc, lane); tr_step<2, 2>(acc, lane); tr_step<1, 1>(acc, lane);
            const float logit = acc[0] + bias;
            float cur = logit, m0 = 0.f; int myrank = -1;
#pragma unroll
            for (int k = 0; k < 4; ++k) {
                float m = cur;
#pragma unroll
                for (int o = 1; o < 32; o <<= 1) m = fmaxf(m, __shfl_xor(m, o));
                if (k == 0) m0 = m;
                const unsigned long long mask = __ballot(cur == m);
                const unsigned half = (lane < 32) ? (unsigned)mask : (unsigned)(mask >> 32);
                const int sel = __ffs(half) - 1;
                if ((lane & 31) == sel) { myrank = k; cur = -3.0e38f; }
            }
            float ex = (myrank >= 0) ? __expf(logit - m0) : 0.f, sum = ex;
#pragma unroll
            for (int o = 1; o < 32; o <<= 1) sum += __shfl_xor(sum, o);
            if (myrank >= 0 && (PROBE_PHASE != 6 || rep_ == 1)) {
                const int e = lane & 31, tl = tl0 + (lane >> 5);
                const int lp = __hip_atomic_fetch_add(hist + e, 1, __ATOMIC_RELAXED, __HIP_MEMORY_SCOPE_WORKGROUP);
                LAS int* r = rec + (tl * 4 + myrank) * 3; r[0] = e; r[1] = lp; r[2] = __float_as_int(ex / sum);
            }
        }
        __syncthreads();
        if (tid < 32) base[tid] = (int)atomicAdd(&cnt[tid], (unsigned)hist[tid]);
        __syncthreads();
        { const int tl = tid >> 2; const int token = tb * 128 + tl; LAS int* r = rec + tid * 3; const int e = r[0], pos = base[e] + r[1]; const float w = __int_as_float(r[2]);
          tke[token * 4 + (tid & 3)] = e; tkpos[token * 4 + (tid & 3)] = pos; tkw[token * 4 + (tid & 3)] = w;
          list[e * NTOK + pos] = token; wlist[e * NTOK + pos] = w; }
        __syncthreads();
    }
}

__device__ __forceinline__ void combine_phase(LAS unsigned char* misc, void* scratch_out, float* __restrict__ out, const unsigned char* __restrict__ rows, const int* __restrict__ tke, const int* __restrict__ tkpos, int gw, int NGW, int lane) {
    LAS const int* pstart = (LAS const int*)(misc + MT_PSTART);
    for (int rep_ = 0; rep_ < ((PROBE_PHASE == 9) ? 2 : 1); ++rep_)
    for (int token = gw; token < NTOK; token += NGW) {
        int rr[4];
#pragma unroll
        for (int k = 0; k < 4; ++k) rr[k] = pstart[tke[token * 4 + k]] + tkpos[token * 4 + k];
        f32x4* o = (f32x4*)(out + (size_t)token * D) + lane;
        f32x4 v[4], s[4];
#pragma unroll
        for (int j = 0; j < 4; ++j) { v[j] = o[64 * j]; s[j] = (f32x4){0.f, 0.f, 0.f, 0.f}; }
#pragma unroll
        for (int k = 0; k < 4; ++k) {
            const unsigned* rp = (const unsigned*)(rows + (size_t)rr[k] * D) + lane;
#pragma unroll
            for (int j = 0; j < 4; ++j) { const unsigned w = rp[64 * j];
                const f32x2 lo = __builtin_amdgcn_cvt_pk_f32_fp8((int)w, false), hh = __builtin_amdgcn_cvt_pk_f32_fp8((int)w, true);
                s[j][0] += lo[0]; s[j][1] += lo[1]; s[j][2] += hh[0]; s[j][3] += hh[1]; }
        }
#pragma unroll
        for (int j = 0; j < 4; ++j) v[j] = v[j] + s[j] * ROW8_INV;
        if (PROBE_PHASE == 9 && rep_ == 0) {
#pragma unroll
            for (int j = 0; j < 4; ++j) { asm volatile("" :: "v"(v[j])); *(f32x4*)((float*)scratch_out + (size_t)token * D + (64 * j + lane) * 4) = v[j]; }
        } else {
#pragma unroll
        for (int j = 0; j < 4; ++j) o[64 * j] = v[j];
        }
    }
}
struct SchedDense {
    static constexpr bool GATHER = false;
    const char* A; const char* Bt; int K, nM, nN, nwg, G, c;
    __device__ void init(const bf16* A_, const bf16* Bt_, int M, int N, int K_, int G_, int c_) { A = (const char*)A_; Bt = (const char*)Bt_; K = K_; nM = M / 256; nN = N / 256; nwg = nM * nN; G = G_; c = c_; }
    __device__ __forceinline__ bool next(int i, pg8::Unit& u) const {
        const long L = (long)i * G + c; if (L >= nwg) return false;
        int wgid = (int)L; { const int q = nwg / 8, r = nwg % 8, xcd = wgid % 8, off = wgid / 8; wgid = (xcd < r ? xcd * (q + 1) : r * (q + 1) + (xcd - r) * q) + off; }
        const int nig = 8 * nN, gid = wgid / nig, fm = gid * 8, gsz = (nM - fm) < 8 ? (nM - fm) : 8;
        u.pm = fm + ((wgid % nig) % gsz); u.pn = (wgid % nig) / gsz; u.aux = 0; u.tl = 0;
        u.A = A + (size_t)u.pm * 256 * K * 2; u.B = Bt + (size_t)u.pn * 256 * K * 2; return true;
    }
    __device__ __forceinline__ void aoff(const pg8::Unit&, const int (&R)[2], const int (&C)[2], unsigned (&o)[2][2]) const {
#pragma unroll
        for (int h = 0; h < 2; ++h)
#pragma unroll
            for (int i = 0; i < 2; ++i) o[h][i] = (unsigned)((128 * h + R[i]) * K + C[i]) * 2u;
    }
};
struct SchedBranch {
    static constexpr bool GATHER = false;
    const char* A0; const char* A1; const char* B0; const char* B1; int G, c;
    __device__ __forceinline__ bool next(int i, pg8::Unit& u) const {
        const int L = (i >> 1) * G + c; if (L >= 512) return false;
        int wgid = L; { const int off = wgid / 8, xcd = wgid % 8; wgid = xcd * 64 + off; }
        const int nig = 8 * 4, gid = wgid / nig;
        u.pm = gid * 8 + ((wgid % nig) % 8); u.pn = (wgid % nig) / 8; u.aux = i & 1; u.tl = 0;
        u.A = ((i & 1) ? A1 : A0) + (size_t)u.pm * 256 * D * 2; u.B = ((i & 1) ? B1 : B0) + (size_t)u.pn * 256 * D * 2; return true;
    }
    __device__ __forceinline__ void aoff(const pg8::Unit&, const int (&R)[2], const int (&C)[2], unsigned (&o)[2][2]) const {
#pragma unroll
        for (int h = 0; h < 2; ++h)
#pragma unroll
            for (int i = 0; i < 2; ++i) o[h][i] = (unsigned)((128 * h + R[i]) * D + C[i]) * 2u;
    }
};
template <bool GATHER_, int NPN>
struct SchedMoe {
    static constexpr bool GATHER = GATHER_;
    const char* A; const char* Bt; LAS const unsigned char* misc; const int* list; int G, c;
    __device__ __forceinline__ bool next(int i, pg8::Unit& u) const {
        LAS const int* cl = (LAS const int*)(misc + MT_CNT); LAS const int* ps = (LAS const int*)(misc + MT_PSTART);
        if ((G & 7) == 0) {
            const int x = c & 7, r = c >> 3, n = G >> 3;
            int k = (i * n + r) / NPN; const int pn = (i * n + r) % NPN;
#pragma unroll
            for (int j = 0; j < 4; ++j) { const int e = x + 8 * j, nt = (cl[e] + 255) >> 8;
                if (k < nt) { u.pn = pn; u.aux = e; u.tl = k; u.pm = (ps[e] >> 8) + k;
                    u.A = GATHER ? A : A + (size_t)u.pm * 256 * 1024; u.B = Bt + ((size_t)e * NPN + pn) * 256 * 1024; return true; }
                k -= nt; }
            return false;
        }
        const int nact = *(LAS const int*)(misc + MT_NACT);
        const int L = i * G + c; if (L >= nact * NPN) return false;
        const int k = L / NPN; u.pn = L % NPN; const int w = ((LAS const int*)(misc + MT_ATILE))[k];
        u.pm = w & 0xfff; u.aux = (w >> 12) & 0xff; u.tl = w >> 20;
        u.A = GATHER ? A : A + (size_t)u.pm * 256 * 1024;
        u.B = Bt + ((size_t)u.aux * NPN + u.pn) * 256 * 1024; return true;
    }
    __device__ __forceinline__ void aoff(const pg8::Unit& u, const int (&R)[2], const int (&C)[2], unsigned (&o)[2][2]) const {
        const int ce = ((LAS const int*)(misc + MT_CNT))[u.aux];
#pragma unroll
        for (int h = 0; h < 2; ++h)
#pragma unroll
            for (int i = 0; i < 2; ++i) {
                if (GATHER) { const int idx = u.tl * 256 + 128 * h + R[i]; const int tok = (idx < ce) ? list[u.aux * NTOK + idx] : 0; o[h][i] = (unsigned)tok * 1024u + (unsigned)C[i] * 2u; }
                else o[h][i] = (unsigned)((128 * h + R[i]) * 1024 + C[i] * 2);
            }
    }
};

__device__ __forceinline__ u32x4 pack8(const f32x4& a, const f32x4& b) { u32x4 w; w.x = pk2(a[0], a[1]); w.y = pk2(a[2], a[3]); w.z = pk2(b[0], b[1]); w.w = pk2(b[2], b[3]); return w; }
__device__ __forceinline__ void unpack8(const u32x4& w, float (&f)[8]) {
    f[0] = __uint_as_float(w.x << 16); f[1] = __uint_as_float(w.x & 0xffff0000u); f[2] = __uint_as_float(w.y << 16); f[3] = __uint_as_float(w.y & 0xffff0000u);
    f[4] = __uint_as_float(w.z << 16); f[5] = __uint_as_float(w.z & 0xffff0000u); f[6] = __uint_as_float(w.w << 16); f[7] = __uint_as_float(w.w & 0xffff0000u);
}
struct EpiProj {
    static constexpr bool PERM = true;
    bf16* proj; const float* qg; const float* kg;
    __device__ __forceinline__ void operator()(pg8::Acc& acc, const pg8::Unit& u, int wr, int wc, int fr, int fq) const {
        const int pn = u.pn;
        int mode;
        if (pn < 4) mode = 1; else if (pn == 4) mode = (wc < 2) ? 2 : 0; else if (pn < 7) mode = 0; else if (pn < 9) mode = 3; else if (pn < 13) mode = 0; else if (pn < 17) mode = 4; else mode = 5;
        float gn[2][8];
        if (mode == 1 || mode == 2) { const float* g = (mode == 1) ? qg : kg; const float s = (mode == 1) ? 0.125f : 1.0f;
#pragma unroll
            for (int bj = 0; bj < 2; ++bj)
#pragma unroll
                for (int j = 0; j < 8; ++j) gn[bj][j] = g[32 * bj + 8 * fq + j] * s; }
#pragma unroll
        for (int ai = 0; ai < 2; ++ai)
#pragma unroll
            for (int m = 0; m < 4; ++m) {
                const int r = u.pm * 256 + ai * 128 + wr * 64 + m * 16 + fr;
                bf16* rowp = proj + (size_t)r * INW + pn * 256 + wc * 64 + 8 * fq;
                f32x4 v[2][2];
#pragma unroll
                for (int bj = 0; bj < 2; ++bj) { v[bj][0] = acc[ai][bj][m][0]; v[bj][1] = acc[ai][bj][m][1]; }
                if (mode == 1 || mode == 2) {
                    float ss = 0.f;
#pragma unroll
                    for (int bj = 0; bj < 2; ++bj)
#pragma unroll
                        for (int n = 0; n < 2; ++n) ss += v[bj][n][0] * v[bj][n][0] + v[bj][n][1] * v[bj][n][1] + v[bj][n][2] * v[bj][n][2] + v[bj][n][3] * v[bj][n][3];
                    ss += __shfl_xor(ss, 16); ss += __shfl_xor(ss, 32);
                    const float rs = rsqrtf(ss * (1.0f / 64.0f) + EPS);
#pragma unroll
                    for (int bj = 0; bj < 2; ++bj)
#pragma unroll
                        for (int n = 0; n < 2; ++n)
#pragma unroll
                            for (int i = 0; i < 4; ++i) v[bj][n][i] = v[bj][n][i] * rs * gn[bj][4 * n + i];
                } else if (mode == 3) {
#pragma unroll
                    for (int bj = 0; bj < 2; ++bj)
#pragma unroll
                        for (int n = 0; n < 2; ++n) v[bj][n] = v[bj][n] * 0.08838834764831845f;
                } else if (mode == 4) {
#pragma unroll
                    for (int bj = 0; bj < 2; ++bj)
#pragma unroll
                        for (int n = 0; n < 2; ++n)
#pragma unroll
                            for (int i = 0; i < 4; ++i) { const float x = v[bj][n][i]; v[bj][n][i] = x * sigmoidf_(x); }
                } else if (mode == 5) {
#pragma unroll
                    for (int bj = 0; bj < 2; ++bj)
#pragma unroll
                        for (int n = 0; n < 2; ++n)
#pragma unroll
                            for (int i = 0; i < 4; ++i) v[bj][n][i] = sigmoidf_(v[bj][n][i]);
                }
#pragma unroll
                for (int bj = 0; bj < 2; ++bj) *(u32x4*)(rowp + 32 * bj) = pack8(v[bj][0], v[bj][1]);
            }
    }
};
struct EpiBranch {
    static constexpr bool PERM = true;
    bf16* merged; const bf16* proj;
    __device__ __forceinline__ void operator()(pg8::Acc& acc, const pg8::Unit& u, int wr, int wc, int fr, int fq) const {
        const int gcol = u.aux ? C_GR : C_GA;
#pragma unroll
        for (int ai = 0; ai < 2; ++ai)
#pragma unroll
            for (int m = 0; m < 4; ++m) {
                const int r = u.pm * 256 + ai * 128 + wr * 64 + m * 16 + fr;
#pragma unroll
                for (int bj = 0; bj < 2; ++bj) {
                    const int col = u.pn * 256 + bj * 128 + wc * 32 + 8 * fq;
                    const u32x4 gw = *(const u32x4*)(proj + (size_t)r * INW + gcol + col);
                    float g[8]; unpack8(gw, g);
                    f32x4 a = acc[ai][bj][m][0], b = acc[ai][bj][m][1];
                    a[0] *= g[0]; a[1] *= g[1]; a[2] *= g[2]; a[3] *= g[3]; b[0] *= g[4]; b[1] *= g[5]; b[2] *= g[6]; b[3] *= g[7];
                    bf16* mp = merged + (size_t)r * D + col;
                    if (u.aux) { const u32x4 pw = *(const u32x4*)mp; float p[8]; unpack8(pw, p);
                        a[0] += p[0]; a[1] += p[1]; a[2] += p[2]; a[3] += p[3]; b[0] += p[4]; b[1] += p[5]; b[2] += p[6]; b[3] += p[7]; }
                    *(u32x4*)mp = pack8(a, b);
                }
            }
    }
};
struct EpiOut {
    static constexpr bool PERM = false;
    const float* x; float* out;
    __device__ __forceinline__ void operator()(pg8::Acc& acc, const pg8::Unit& u, int wr, int wc, int fr, int fq) const {
#pragma unroll
        for (int ai = 0; ai < 2; ++ai)
#pragma unroll
            for (int m = 0; m < 4; ++m) {
                const size_t off = (size_t)(u.pm * 256 + ai * 128 + wr * 64 + m * 16 + fr) * D + u.pn * 256 + wc * 32 + 4 * fq;
#pragma unroll
                for (int bj = 0; bj < 2; ++bj)
#pragma unroll
                    for (int n = 0; n < 2; ++n) { const f32x4 xv = *(const f32x4*)(x + off + bj * 128 + n * 16); *(f32x4*)(out + off + bj * 128 + n * 16) = xv + acc[ai][bj][m][n]; }
            }
    }
};
struct EpiGU {
    static constexpr bool PERM = true;
    unsigned char* act; const float* bgu;
    __device__ __forceinline__ void operator()(pg8::Acc& acc, const pg8::Unit& u, int wr, int wc, int fr, int fq) const {
        const int col = u.pn * 128 + wc * 32 + 8 * fq;
        const float* bg = bgu + (size_t)u.aux * 2048 + col;
        float bgate[8], bup[8];
#pragma unroll
        for (int j = 0; j < 8; ++j) { bgate[j] = bg[j]; bup[j] = bg[1024 + j]; }
#pragma unroll
        for (int ai = 0; ai < 2; ++ai)
#pragma unroll
            for (int m = 0; m < 4; ++m) {
                const int r = u.pm * 256 + ai * 128 + wr * 64 + m * 16 + fr;
                float o[8];
#pragma unroll
                for (int n = 0; n < 2; ++n)
#pragma unroll
                    for (int i = 0; i < 4; ++i) {
                        float gate = acc[ai][0][m][n][i] * W8_INV + bgate[4 * n + i], up = acc[ai][1][m][n][i] * W8_INV + bup[4 * n + i];
                        gate = fminf(gate, 7.0f); up = fminf(fmaxf(up, -7.0f), 7.0f);
                        o[4 * n + i] = (up + 1.0f) * gate * sigmoidf_(1.702f * gate);
                    }
                u32x2 w; w.x = pk4_fp8(o[0], o[1], o[2], o[3]); w.y = pk4_fp8(o[4], o[5], o[6], o[7]);
                *(u32x2*)(act + (size_t)r * DFF + col) = w;
            }
    }
};
struct EpiDown {
    static constexpr bool PERM = true;
    unsigned char* rows; const float* bdn; const float* wlist; LAS const unsigned char* misc;
    __device__ __forceinline__ void operator()(pg8::Acc& acc, const pg8::Unit& u, int wr, int wc, int fr, int fq) const {
        const int ce = ((LAS const int*)(misc + MT_CNT))[u.aux];
        float bb[2][8];
#pragma unroll
        for (int bj = 0; bj < 2; ++bj)
#pragma unroll
            for (int j = 0; j < 8; ++j) bb[bj][j] = bdn[(size_t)u.aux * D + u.pn * 256 + bj * 128 + wc * 32 + 8 * fq + j];
#pragma unroll
        for (int ai = 0; ai < 2; ++ai)
#pragma unroll
            for (int m = 0; m < 4; ++m) {
                const int lr = ai * 128 + wr * 64 + m * 16 + fr, r = u.pm * 256 + lr, idx = u.tl * 256 + lr;
                const float w = ((idx < ce) ? wlist[u.aux * NTOK + idx] : 0.f) * ROW8_SCALE;
#pragma unroll
                for (int bj = 0; bj < 2; ++bj) {
                    f32x4 a = acc[ai][bj][m][0], b = acc[ai][bj][m][1];
#pragma unroll
                    for (int i = 0; i < 4; ++i) { a[i] = (a[i] * W8_INV + bb[bj][i]) * w; b[i] = (b[i] * W8_INV + bb[bj][4 + i]) * w; }
                    u32x2 o; o.x = pk4_fp8(a[0], a[1], a[2], a[3]); o.y = pk4_fp8(b[0], b[1], b[2], b[3]);
                    *(u32x2*)(rows + (size_t)r * D + u.pn * 256 + bj * 128 + wc * 32 + 8 * fq) = o;
                }
            }
    }
};
namespace attn {
typedef float f32x16 __attribute__((ext_vector_type(16)));
typedef short s16x4 __attribute__((ext_vector_type(4)));
constexpr int NK = 272, K_OFF = 0, V_OFF = 34816, WS_OFF = 69632, OST_OFF = 71680, LDS_END = OST_OFF + 8 * 4096;
constexpr float LOG2E = 1.4426950408889634f;
__device__ __forceinline__ s16x4 vtr(LAS const unsigned char* p) { return __builtin_bit_cast(s16x4, __builtin_amdgcn_ds_read_tr16_b64_v4i16((LAS s16x4*)p)); }
__device__ __forceinline__ int crowc(int r) { return (r & 3) + 8 * (r >> 2); }

template <int TYPE, bool DIAG>
__device__ __forceinline__ void tile(LAS const unsigned char* lds, int kbase, const bf16x8 (&qr)[4], f32x16 (&o)[2], float& l, float lanebase, float c1, int tt, int lane) {
    const int r32 = lane & 31, hi = lane >> 5;
    f32x16 p = {};
#pragma unroll
    for (int d0 = 0; d0 < 4; ++d0) {
        const bf16x8 kf = *(const LAS bf16x8*)(lds + K_OFF + (2 * d0 + hi) * (NK * 16) + (kbase + r32) * 16);
        p = __builtin_amdgcn_mfma_f32_32x32x16_bf16(kf, qr[d0], p, 0, 0, 0);
    }
    constexpr int NR = (TYPE == 0) ? 8 : 16;
    float e[16];
#pragma unroll
    for (int r = 0; r < NR; ++r) {
        const float add = __builtin_fmaf(c1, (float)crowc(r), lanebase);
        float v = __builtin_amdgcn_exp2f(__builtin_fmaf(p[r], LOG2E, add));
        if (DIAG) { const bool ok = (TYPE == 1) ? (crowc(r) > tt) : (crowc(r) <= tt); v = ok ? v : 0.f; }
        e[r] = v; l += v;
    }
    constexpr int NS = (TYPE == 0) ? 1 : 2;
    u32x4 pw[2];
#pragma unroll
    for (int s = 0; s < NS; ++s) { pw[s].x = pk2(e[8 * s + 0], e[8 * s + 1]); pw[s].y = pk2(e[8 * s + 2], e[8 * s + 3]); pw[s].z = pk2(e[8 * s + 4], e[8 * s + 5]); pw[s].w = pk2(e[8 * s + 6], e[8 * s + 7]); }
    LAS const unsigned char* vb = lds + V_OFF + (kbase + 4 * hi + ((lane & 15) >> 2)) * 64 + ((lane >> 4) & 1) * 32 + (lane & 3) * 8;
#pragma unroll
    for (int d0 = 0; d0 < 2; ++d0)
#pragma unroll
        for (int s = 0; s < NS; ++s) {
            const s16x4 lo = vtr(vb + d0 * (NK * 64) + s * 1024), hh = vtr(vb + d0 * (NK * 64) + s * 1024 + 512);
            const bf16x8 vf = (bf16x8){lo[0], lo[1], lo[2], lo[3], hh[0], hh[1], hh[2], hh[3]};
            o[d0] = __builtin_amdgcn_mfma_f32_32x32x16_bf16(__builtin_bit_cast(bf16x8, pw[s]), vf, o[d0], 0, 0, 0);
        }
}

#define AT_ISSUE(u_) do { const int u__ = (u_); const int b_ = u__ >> 6, qb_ = (u__ >> 1) & 31, kvh_ = u__ & 1; \
        _Pragma("unroll") for (int i = 0; i < 5; ++i) { const int idx = tid + 512 * i; if (idx < NK * 8) { const int key = idx >> 3, c = idx & 7; const bf16* rowp; \
            if (key < 16) rowp = pmeta + (size_t)key * INW; else { int j = qb_ * 128 - 128 + (key - 16); if (j < 0) j = 0; rowp = proj + ((size_t)b_ * SEQ + j) * INW; } \
            pk[i] = *(const u32x4*)(rowp + C_AK + kvh_ * 64 + c * 8); pv[i] = *(const u32x4*)(rowp + C_AV + kvh_ * 64 + c * 8); } } } while (0)
#define AT_QLOAD(dst, a_) do { const size_t qrow_ = (size_t)b * SEQ + qb * 128 + 32 * (a_) + r32; \
        _Pragma("unroll") for (int d0 = 0; d0 < 4; ++d0) dst[d0] = *(const bf16x8*)(proj + qrow_ * INW + C_AQ + h * 64 + d0 * 16 + hi * 8); } while (0)
__device__ __forceinline__ void phase(LAS unsigned char* lds, const bf16* __restrict__ proj, const bf16* __restrict__ pmeta, const float* __restrict__ sinks, float bshift, bf16* __restrict__ yatt, int G, int bx) {
    const int tid = threadIdx.x, lane = tid & 63, r32 = lane & 31, hi = lane >> 5; const int wave = __builtin_amdgcn_readfirstlane(tid >> 6);
    constexpr int NU = NB * 32 * 2;
    if (bx >= NU) return;
    u32x4 pk[5], pv[5];
    AT_ISSUE(bx);
    for (int u = bx; u < NU; u += G) {
        const int b = u >> 6, qb = (u >> 1) & 31, kvh = u & 1;
#pragma unroll
        for (int i = 0; i < 5; ++i) { const int idx = tid + 512 * i; if (idx < NK * 8) { const int key = idx >> 3, c = idx & 7;
            *(LAS u32x4*)(lds + K_OFF + c * (NK * 16) + key * 16) = pk[i];
            *(LAS u32x4*)(lds + V_OFF + (c >> 2) * (NK * 64) + key * 64 + (c & 3) * 16) = pv[i]; } }
        if (u + G < NU) AT_ISSUE(u + G);
        const int h = kvh * 8 + wave;
        bf16x8 qr[4], qn[4];
        AT_QLOAD(qr, 0);
        __syncthreads();
        const float slope = exp2f(-0.5f * (float)(h + 1)), sink = sinks[h];
        const float M = fmaxf(bshift, sink);
        const float c1 = slope * LOG2E;
        LAS float* wsf = (LAS float*)(lds + WS_OFF) + wave * 64;
        LAS bf16* stg = (LAS bf16*)(lds + OST_OFF) + wave * 2048;
#pragma unroll 1
        for (int a = 0; a < 4; ++a) {
            if (a < 3) AT_QLOAD(qn, a + 1);
            f32x16 o[2]; o[0] = f32x16{}; o[1] = f32x16{};
            float l = 0.f;
            const int t = 32 * a + r32;
            const int tt = r32 - 4 * hi;
            const float hi4 = c1 * 4.0f * (float)hi;
            tile<0, false>(lds, 0, qr, o, l, -(slope * (float)(qb * 128 + t + 16) + M) * LOG2E + hi4, c1, tt, lane);
            if (qb > 0) {
                tile<1, true>(lds, 16 + 32 * a, qr, o, l, -(slope * (float)(128 + r32) + M) * LOG2E + hi4, c1, tt, lane);
                for (int bb = a + 1; bb < 4; ++bb) tile<1, false>(lds, 16 + 32 * bb, qr, o, l, -(slope * (float)(128 + t - 32 * bb) + M) * LOG2E + hi4, c1, tt, lane);
            }
            for (int bb = 0; bb < a; ++bb) tile<2, false>(lds, 144 + 32 * bb, qr, o, l, -(slope * (float)(t - 32 * bb) + M) * LOG2E + hi4, c1, tt, lane);
            tile<2, true>(lds, 144 + 32 * a, qr, o, l, -(slope * (float)r32 + M) * LOG2E + hi4, c1, tt, lane);
            l += __shfl_xor(l, 32);
            l += exp2f((sink - M) * LOG2E);
            if (hi == 0) wsf[r32] = l;
            LDS_WAIT();
            float rli[16];
#pragma unroll
            for (int r = 0; r < 16; ++r) rli[r] = __builtin_amdgcn_rcpf(wsf[crowc(r) + 4 * hi]);
#pragma unroll
            for (int r = 0; r < 16; ++r) { const int orow = crowc(r) + 4 * hi;
#pragma unroll
                for (int d0 = 0; d0 < 2; ++d0) stg[orow * 64 + d0 * 32 + r32] = f2bf(o[d0][r] * rli[r]); }
            LDS_WAIT();
            bf16* Ow = yatt + ((size_t)b * SEQ + qb * 128 + 32 * a) * D + h * 64;
#pragma unroll
            for (int i = 0; i < 4; ++i) { const int row = i * 8 + (lane >> 3), ch = lane & 7; const u32x4 v = *(const LAS u32x4*)(stg + row * 64 + ch * 8); *(u32x4*)(Ow + (size_t)row * D + ch * 8) = v; }
            LDS_WAIT();
#pragma unroll
            for (int d0 = 0; d0 < 4; ++d0) qr[d0] = qn[d0];
        }
        __syncthreads();
    }
}
#undef AT_ISSUE
#undef AT_QLOAD
}
namespace ret {
typedef float f32x16 __attribute__((ext_vector_type(16)));
typedef short s16x4 __attribute__((ext_vector_type(4)));
constexpr size_t WS_STATES = 893 * MiB;
__device__ __forceinline__ s16x4 vtr(LAS const unsigned char* p) { return __builtin_bit_cast(s16x4, __builtin_amdgcn_ds_read_tr16_b64_v4i16((LAS s16x4*)p)); }
__device__ __forceinline__ int crowc(int r) { return (r & 3) + 8 * (r >> 2); }
__device__ __forceinline__ float lg2gamma(int h) { return log2f(1.0f - exp2f(-5.0f - (float)h)); }

constexpr int R1_BUF = 40960;
#define RET_ISSUE(KR, VR, c_) do { const int ci__ = (c_); \
        _Pragma("unroll") for (int i = 0; i < 4; ++i) { const int idx = tid + 512 * i, key = idx >> 4, ch = idx & 15; \
            if (ci__ == 0) { KR[i] = (key >= 112) ? *(const u32x4*)(pmeta + (size_t)(key - 112) * INW + C_RK + h * 128 + ch * 8) : (u32x4){0u, 0u, 0u, 0u}; } \
            else KR[i] = *(const u32x4*)(proj + ((size_t)b * SEQ + (ci__ - 1) * 128 + key) * INW + C_RK + h * 128 + ch * 8); } \
        { const int key = tid >> 2, ch = tid & 3; \
          if (ci__ == 0) VR = (key >= 112) ? *(const u32x4*)(pmeta + (size_t)(key - 112) * INW + C_RV + h * 256 + dvs * 32 + ch * 8) : (u32x4){0u, 0u, 0u, 0u}; \
          else VR = *(const u32x4*)(proj + ((size_t)b * SEQ + (ci__ - 1) * 128 + key) * INW + C_RV + h * 256 + dvs * 32 + ch * 8); } } while (0)
#define RET_STEP(KR, VR, c_) do { const int c__ = (c_); LAS unsigned char* buf = lds + (c__ & 1) * R1_BUF; \
        _Pragma("unroll") for (int i = 0; i < 4; ++i) { const int idx = tid + 512 * i, key = idx >> 4, ch = idx & 15; *(LAS u32x4*)(buf + (ch >> 2) * (128 * 64) + key * 64 + (ch & 3) * 16) = KR[i]; } \
        { const int key = tid >> 2, ch = tid & 3; float f[8]; unpack8(VR, f); u32x4 w; \
          w.x = pk2(f[0] * vscale, f[1] * vscale); w.y = pk2(f[2] * vscale, f[3] * vscale); w.z = pk2(f[4] * vscale, f[5] * vscale); w.w = pk2(f[6] * vscale, f[7] * vscale); \
          *(LAS u32x4*)(buf + 32768 + key * 64 + ch * 16) = w; } \
        if (c__ + 2 < 32) RET_ISSUE(KR, VR, c__ + 2); \
        __syncthreads(); \
        if (wave < 4) { \
            const int dt = wave; \
            acc = acc * g128; \
            LAS const unsigned char* ab = buf + dt * (128 * 64) + (4 * hi + ((lane & 15) >> 2)) * 64 + ((lane >> 4) & 1) * 32 + (lane & 3) * 8; \
            LAS const unsigned char* bb = buf + 32768 + (4 * hi + ((lane & 15) >> 2)) * 64 + ((lane >> 4) & 1) * 32 + (lane & 3) * 8; \
            _Pragma("unroll") for (int ks = 0; ks < 8; ++ks) { \
                const s16x4 al = vtr(ab + ks * 1024), ah = vtr(ab + ks * 1024 + 512), bl = vtr(bb + ks * 1024), bh = vtr(bb + ks * 1024 + 512); \
                const bf16x8 af = (bf16x8){al[0], al[1], al[2], al[3], ah[0], ah[1], ah[2], ah[3]}, bfr = (bf16x8){bl[0], bl[1], bl[2], bl[3], bh[0], bh[1], bh[2], bh[3]}; \
                acc = __builtin_amdgcn_mfma_f32_32x32x16_bf16(af, bfr, acc, 0, 0, 0); } \
            bf16* sb = states + ((((size_t)(b * 4 + h) * 32 + c__) * 8 + dvs) * 8) * 512; \
            _Pragma("unroll") for (int g = 0; g < 4; ++g) { u32x2 w; w.x = pk2(acc[4 * g], acc[4 * g + 1]); w.y = pk2(acc[4 * g + 2], acc[4 * g + 3]); \
                *(u32x2*)(sb + (size_t)(2 * dt + (g >> 1)) * 512 + (32 * (g & 1) + (lane & 31)) * 8 + 4 * hi) = w; } \
        } } while (0)
__device__ __forceinline__ void state_chain(LAS unsigned char* lds, int b, int h, int dvs, const bf16* __restrict__ proj, const bf16* __restrict__ pmeta, bf16* __restrict__ states) {
    const int tid = threadIdx.x, lane = tid & 63, hi = lane >> 5; const int wave = __builtin_amdgcn_readfirstlane(tid >> 6);
    const float lg = lg2gamma(h), g128 = exp2f(lg * 128.0f);
    u32x4 kA[4], kB[4], vA, vB;
    const float vscale = exp2f(lg * (float)(127 - (tid >> 2)));
    f32x16 acc = {};
    RET_ISSUE(kA, vA, 0); RET_ISSUE(kB, vB, 1);
#pragma unroll 1
    for (int c = 0; c < 32; c += 2) { RET_STEP(kA, vA, c); RET_STEP(kB, vB, c + 1); }
    __syncthreads();
}
#undef RET_ISSUE
#undef RET_STEP

constexpr int R3_K = 0, R3_Q = 32768, R3_V = 65536;
#define R3_ISSUE(u_) do { const int u__ = (u_); const size_t rw = (size_t)(u__ >> 7) * SEQ + (u__ & 31) * 128; const int hh = (u__ >> 5) & 3; \
        _Pragma("unroll") for (int i = 0; i < 4; ++i) { const int idx = tid + 512 * i, key = idx >> 4, ch = idx & 15; \
            kq[i] = *(const u32x4*)(proj + (rw + key) * INW + C_RK + hh * 128 + ch * 8); kq[4 + i] = *(const u32x4*)(proj + (rw + key) * INW + C_RQ + hh * 128 + ch * 8); } \
        _Pragma("unroll") for (int i = 0; i < 8; ++i) { const int idx = tid + 512 * i, key = idx >> 5, ch = idx & 31; vv[i] = *(const u32x4*)(proj + (rw + key) * INW + C_RV + hh * 256 + ch * 8); } } while (0)
__device__ __forceinline__ void out_phase(LAS unsigned char* lds, const bf16* __restrict__ proj, const bf16* __restrict__ states, bf16* __restrict__ yret, int G, int bx) {
    const int tid = threadIdx.x, lane = tid & 63, r32 = lane & 31, hi = lane >> 5; const int wave = __builtin_amdgcn_readfirstlane(tid >> 6);
    constexpr int NU = NB * 4 * 32;
    if (bx >= NU) return;
    u32x4 kq[8], vv[8];
    R3_ISSUE(bx);
    for (int u = bx; u < NU; u += G) {
        const int b = u >> 7, h = (u >> 5) & 3, tb = u & 31;
        const float lg = lg2gamma(h);
        const size_t row0 = (size_t)b * SEQ + tb * 128;
#pragma unroll
        for (int i = 0; i < 4; ++i) { const int idx = tid + 512 * i, key = idx >> 4, ch = idx & 15;
            *(LAS u32x4*)(lds + R3_K + ch * 2048 + key * 16) = kq[i]; *(LAS u32x4*)(lds + R3_Q + ch * 2048 + key * 16) = kq[4 + i]; }
#pragma unroll
        for (int i = 0; i < 8; ++i) { const int idx = tid + 512 * i, key = idx >> 5, ch = idx & 31; *(LAS u32x4*)(lds + R3_V + (ch >> 2) * 8192 + key * 64 + (ch & 3) * 16) = vv[i]; }
        if (u + G < NU) R3_ISSUE(u + G);
        __syncthreads();
        u32x2 pw[2][4];
#pragma unroll
        for (int ti = 0; ti < 2; ++ti) {
            const int t = wave + 8 * ti;
            if (t < 10) {
                const int a = (t >= 6) ? 3 : (t >= 3) ? 2 : (t >= 1) ? 1 : 0, bb = t - ((a * (a + 1)) >> 1);
                f32x16 p = {};
#pragma unroll
                for (int k = 0; k < 8; ++k) {
                    const bf16x8 kf = *(const LAS bf16x8*)(lds + R3_K + (2 * k + hi) * 2048 + (32 * bb + r32) * 16);
                    const bf16x8 qf = *(const LAS bf16x8*)(lds + R3_Q + (2 * k + hi) * 2048 + (32 * a + r32) * 16);
                    p = __builtin_amdgcn_mfma_f32_32x32x16_bf16(kf, qf, p, 0, 0, 0);
                }
                const float lanebase = lg * (float)(32 * (a - bb) + r32 - 4 * hi), cpos = -lg; const int tt = r32 - 4 * hi;
                float e[16];
#pragma unroll
                for (int r = 0; r < 16; ++r) { float v = p[r] * __builtin_amdgcn_exp2f(__builtin_fmaf(cpos, (float)crowc(r), lanebase)); if (bb == a) v = (crowc(r) <= tt) ? v : 0.f; e[r] = v; }
#pragma unroll
                for (int g = 0; g < 4; ++g) { pw[ti][g].x = pk2(e[4 * g], e[4 * g + 1]); pw[ti][g].y = pk2(e[4 * g + 2], e[4 * g + 3]); }
            }
        }
        __builtin_amdgcn_sched_barrier(0);
        bf16x8 sf[8];
        { const bf16* sb = states + (((size_t)(b * 4 + h) * 32 + tb) * 64 + (size_t)wave * 8) * 512 + lane * 8;
#pragma unroll
          for (int k = 0; k < 8; ++k) sf[k] = *(const bf16x8*)(sb + (size_t)k * 512); }
        bf16x8 vf[8];
        { LAS const unsigned char* vb = lds + R3_V + wave * 8192 + (8 * hi + ((lane & 15) >> 2)) * 64 + ((lane >> 4) & 1) * 32 + (lane & 3) * 8;
#pragma unroll
          for (int ks = 0; ks < 8; ++ks) { const s16x4 lo = vtr(vb + ks * 1024), hh = vtr(vb + ks * 1024 + 256); vf[ks] = (bf16x8){lo[0], lo[1], lo[2], lo[3], hh[0], hh[1], hh[2], hh[3]}; } }
        __syncthreads();
#pragma unroll
        for (int ti = 0; ti < 2; ++ti) {
            const int t = wave + 8 * ti;
            if (t < 10) {
                const int a = (t >= 6) ? 3 : (t >= 3) ? 2 : (t >= 1) ? 1 : 0, bb = t - ((a * (a + 1)) >> 1);
#pragma unroll
                for (int g = 0; g < 4; ++g) *(LAS u32x2*)(lds + R3_K + (4 * bb + g) * 2048 + (32 * a + r32) * 16 + hi * 8) = pw[ti][g];
            }
        }
        __syncthreads();
        LAS bf16* stg = (LAS bf16*)(lds + R3_V);
#pragma unroll 1
        for (int a = 0; a < 4; ++a) {
            f32x16 o = {};
#pragma unroll
            for (int ks = 0; ks < 8; ++ks) if (ks < 2 * (a + 1)) {
                const bf16x8 pa = *(const LAS bf16x8*)(lds + R3_K + (2 * ks + hi) * 2048 + (32 * a + r32) * 16);
                o = __builtin_amdgcn_mfma_f32_32x32x16_bf16(pa, vf[ks], o, 0, 0, 0);
            }
            f32x16 x = {};
#pragma unroll
            for (int k = 0; k < 8; ++k) { const bf16x8 qa = *(const LAS bf16x8*)(lds + R3_Q + (2 * k + hi) * 2048 + (32 * a + r32) * 16); x = __builtin_amdgcn_mfma_f32_32x32x16_bf16(qa, sf[k], x, 0, 0, 0); }
#pragma unroll
            for (int r = 0; r < 16; ++r) {
                const float din = __builtin_amdgcn_exp2f(lg * (float)(32 * a + crowc(r) + 4 * hi + 1));
                stg[(32 * a + crowc(r) + 4 * hi) * 256 + wave * 32 + r32] = f2bf(o[r] + din * x[r]);
            }
        }
        __syncthreads();
#pragma unroll 4
        for (int i = 0; i < 16; ++i) {
            const int q = wave * 16 + i;
            const u32x2 sw = *(const LAS u32x2*)(stg + q * 256 + lane * 4);
            const float v0 = __uint_as_float(sw.x << 16), v1 = __uint_as_float(sw.x & 0xffff0000u), v2 = __uint_as_float(sw.y << 16), v3 = __uint_as_float(sw.y & 0xffff0000u);
            const float ss = wave_sum((v0 * v0 + v1 * v1) + (v2 * v2 + v3 * v3));
            const float rs = rsqrtf(ss * (1.0f / 256.0f) + EPS);
            const u32x2 gw = *(const u32x2*)(proj + (row0 + q) * INW + C_RG + h * 256 + lane * 4);
            u32x2 w; w.x = pk2(v0 * rs * __uint_as_float(gw.x << 16), v1 * rs * __uint_as_float(gw.x & 0xffff0000u)); w.y = pk2(v2 * rs * __uint_as_float(gw.y << 16), v3 * rs * __uint_as_float(gw.y & 0xffff0000u));
            *(u32x2*)(yret + (row0 + q) * D + h * 256 + lane * 4) = w;
        }
        __syncthreads();
    }
}
#undef R3_ISSUE
}
template <bool FP8>
__device__ __forceinline__ void p0_item(const float* __restrict__ W, int K, int N, void* __restrict__ WT, int k0, int n0, int dst_row0, int lane) {
    const int kblk = lane >> 3, nq = lane & 7;
    const float* src = W + (size_t)(k0 + 16 * kblk) * N + n0 + 4 * nq;
    f32x4 v[16];
#pragma unroll
    for (int i = 0; i < 16; ++i) v[i] = *(const f32x4*)(src + (size_t)i * N);
#pragma unroll
    for (int j = 0; j < 4; ++j) {
        const size_t row = (size_t)(dst_row0 + 4 * nq + j);
        if constexpr (FP8) {
            u32x4 o;
            o.x = pk4_fp8(v[0][j] * W8_SCALE, v[1][j] * W8_SCALE, v[2][j] * W8_SCALE, v[3][j] * W8_SCALE); o.y = pk4_fp8(v[4][j] * W8_SCALE, v[5][j] * W8_SCALE, v[6][j] * W8_SCALE, v[7][j] * W8_SCALE);
            o.z = pk4_fp8(v[8][j] * W8_SCALE, v[9][j] * W8_SCALE, v[10][j] * W8_SCALE, v[11][j] * W8_SCALE); o.w = pk4_fp8(v[12][j] * W8_SCALE, v[13][j] * W8_SCALE, v[14][j] * W8_SCALE, v[15][j] * W8_SCALE);
            *(u32x4*)((unsigned char*)WT + row * K + k0 + 16 * kblk) = o;
        } else {
            u32x4 a, b;
            a.x = pk2(v[0][j], v[1][j]); a.y = pk2(v[2][j], v[3][j]); a.z = pk2(v[4][j], v[5][j]); a.w = pk2(v[6][j], v[7][j]);
            b.x = pk2(v[8][j], v[9][j]); b.y = pk2(v[10][j], v[11][j]); b.z = pk2(v[12][j], v[13][j]); b.w = pk2(v[14][j], v[15][j]);
            bf16* d = (bf16*)WT + row * K + k0 + 16 * kblk;
            *(u32x4*)d = a; *(u32x4*)(d + 8) = b;
        }
    }
}
#ifndef PROBE_PHASE
#define PROBE_PHASE (-1)
#endif
__device__ __forceinline__ void p0_transpose_item_fp8(const float* W, int K, int N, unsigned char* WT, int k0, int n0, int dst_row0, LAS float* scr, int lane) {
#pragma unroll 8
    for (int i = 0; i < 32; ++i) { const int kk = 2 * i + (lane >> 5); scr[kk * 33 + (lane & 31)] = W[(size_t)(k0 + kk) * N + n0 + (lane & 31)]; }
    LDS_WAIT(); asm volatile("" ::: "memory");
    const int c = lane & 3;
#pragma unroll
    for (int j = 0; j < 2; ++j) { const int n = (lane >> 2) + 16 * j; const LAS float* s = scr + (16 * c) * 33 + n;
        u32x4 o;
        o.x = pk4_fp8(s[0 * 33] * W8_SCALE, s[1 * 33] * W8_SCALE, s[2 * 33] * W8_SCALE, s[3 * 33] * W8_SCALE); o.y = pk4_fp8(s[4 * 33] * W8_SCALE, s[5 * 33] * W8_SCALE, s[6 * 33] * W8_SCALE, s[7 * 33] * W8_SCALE);
        o.z = pk4_fp8(s[8 * 33] * W8_SCALE, s[9 * 33] * W8_SCALE, s[10 * 33] * W8_SCALE, s[11 * 33] * W8_SCALE); o.w = pk4_fp8(s[12 * 33] * W8_SCALE, s[13 * 33] * W8_SCALE, s[14 * 33] * W8_SCALE, s[15 * 33] * W8_SCALE);
        *(u32x4*)(WT + (size_t)(dst_row0 + n) * K + k0 + 16 * c) = o; }
    LDS_WAIT(); asm volatile("" ::: "memory");
}
struct Args { const float* in[17]; float* out; unsigned char* ws; int ph_lo, ph_hi, li, pad; };

__global__ void __launch_bounds__(512, 2) mk_fwd(Args args) {
    extern __shared__ __attribute__((aligned(16))) unsigned char lds_raw[];
    LAS unsigned char* lds = (LAS unsigned char*)lds_raw;
    volatile LAS unsigned* MISC = (volatile LAS unsigned*)(lds + MISC_OFF);
    const int tid = threadIdx.x, lane = tid & 63, wave = __builtin_amdgcn_readfirstlane(tid >> 6);
    const int G = gridDim.x, bx = blockIdx.x;
    const int vcu = (G % 8 == 0) ? (bx % 8) * (G / 8) + bx / 8 : bx;
    unsigned char* ws = args.ws;
    unsigned* ctl = (unsigned*)(ws + WS_CTL);
    const float* x = args.in[0]; const float* meta = args.in[1]; const float* g1 = args.in[2]; const float* w_in = args.in[3];
    const float* qg = args.in[4]; const float* kg = args.in[5];
    const float* w_ab = args.in[7]; const float* w_rb = args.in[8]; const float* w_out = args.in[9];
    const float* w_gu = args.in[13]; const float* b_gu = args.in[14]; const float* w_dn = args.in[15]; const float* b_dn = args.in[16];
    float* out = args.out;
    bf16* Win_t = (bf16*)(ws + WS_WIN); bf16* Wab_t = (bf16*)(ws + WS_WAB); bf16* Wrb_t = (bf16*)(ws + WS_WRB); bf16* Wout_t = (bf16*)(ws + WS_WOUT);
    unsigned char* Wgu_t = ws + WS_WGU; unsigned char* Wdn_t = ws + WS_WDN;
    bf16* xb = (bf16*)(ws + WS_XB); bf16* proj = (bf16*)(ws + WS_PROJ); bf16* yatt = (bf16*)(ws + WS_YATT); bf16* yret = (bf16*)(ws + WS_YRET); bf16* merged = (bf16*)(ws + WS_MERGED);
    bf16* pmeta = proj + (size_t)NTOK * INW;
    const float* sinks = args.in[6]; const float* g2 = args.in[10]; const float* w_r = args.in[11]; const float* b_r = args.in[12];
    int* tke = (int*)(ws + SM_TKE); float* tkw = (float*)(ws + SM_TKW); int* tkpos = (int*)(ws + SM_TKPOS); int* list = (int*)(ws + SM_LIST); float* wlist = (float*)(ws + SM_WLIST);
    LAS unsigned char* misc = lds + MISC_OFF;
    bf16* states = (bf16*)(ws + ret::WS_STATES);
    unsigned char* act = ws + WS_ACT; unsigned char* rows = ws + WS_ROWS; unsigned char* xn8 = ws + WS_XB;

    for (int u = tid; u < (LDS_BYTES - MISC_OFF) / 4; u += 512) ((LAS unsigned*)(lds + MISC_OFF))[u] = 0u;
    __syncthreads();
    XcdBarrier bar = xcd_barrier_post(ctl + CW_BAR + args.li * XCD_BAR_WORDS, MISC + 8);
    const int lo = args.ph_lo, hi = args.ph_hi;
#define IN(k) (lo <= (k) && (k) < hi)
#define BOTH(k) (IN(k) && IN((k) + 1))
#define GRID_BAR() xcd_barrier(bar)

    if (IN(0)) { for (int rep_ = 0; rep_ < ((PROBE_PHASE == 0) ? 2 : 1); ++rep_) {
        const int gw = vcu * NWAVES + wave, NGW = G * NWAVES;
        constexpr int I_IN = 8 * 200, I_SQ = 8 * 32, I_GU = 32 * 8 * 64, I_DN = 32 * 8 * 32;
        constexpr int NITEMS = I_IN + 3 * I_SQ + I_GU + I_DN;
        for (int rep2_ = 0; rep2_ < ((PROBE_PHASE == 100) ? 2 : 1); ++rep2_)
        for (int it = gw; it < NITEMS; it += NGW) {
            int r = it;
            if (r < I_IN) { const int kb = r / 200, nb = r % 200, n0 = nb * 32, o = n0 & 255, wcc = o >> 6, bj = (o >> 5) & 1;
                p0_item<false>(w_in, D, INW, Win_t, kb * 128, n0, (n0 & ~255) + 128 * bj + 32 * wcc, lane); continue; }
            r -= I_IN;
            if (r < I_SQ) { p0_item<false>(w_ab, D, D, Wab_t, (r / 32) * 128, (r % 32) * 32, (r % 32) * 32, lane); continue; } r -= I_SQ;
            if (r < I_SQ) { p0_item<false>(w_rb, D, D, Wrb_t, (r / 32) * 128, (r % 32) * 32, (r % 32) * 32, lane); continue; } r -= I_SQ;
            if (r < I_SQ) { p0_item<false>(w_out, D, D, Wout_t, (r / 32) * 128, (r % 32) * 32, (r % 32) * 32, lane); continue; } r -= I_SQ;
            if (r < I_GU) { const int e = r / 512, q = r % 512, kb = q / 64, nb = q % 64, n0 = nb * 32, bj = n0 >> 10, rem = n0 & 1023, pn = rem >> 7, cl = rem & 127;
                p0_item<true>(w_gu + (size_t)e * D * 2048, D, 2048, Wgu_t + (size_t)e * 2048 * D, kb * 128, n0, 256 * pn + 128 * bj + cl, lane); continue; }
            r -= I_GU;
            { const int e = r / 256, q = r % 256, kb = q / 32, nb = q % 32;
              p0_item<true>(w_dn + (size_t)e * DFF * D, DFF, D, Wdn_t + (size_t)e * D * DFF, kb * 128, nb * 32, nb * 32, lane); }
        }
        for (int rep2_ = 0; rep2_ < ((PROBE_PHASE == 101) ? 2 : 1); ++rep2_)
        for (int row = gw; row < NTOK; row += NGW) {
            const f32x4* xr = (const f32x4*)(x + (size_t)row * D) + lane;
            f32x4 v[4]; float ss = 0.f;
#pragma unroll
            for (int j = 0; j < 4; ++j) { v[j] = xr[64 * j]; ss += (v[j][0] * v[j][0] + v[j][1] * v[j][1]) + (v[j][2] * v[j][2] + v[j][3] * v[j][3]); }
            const float rstd = rsqrtf(wave_sum(ss) * (1.0f / D) + EPS);
            u32x2* o8 = (u32x2*)(xb + (size_t)row * D) + lane;
#pragma unroll
            for (int j = 0; j < 4; ++j) { const f32x4 gg = ((const f32x4*)g1)[64 * j + lane]; u32x2 w; w.x = pk2(v[j][0] * rstd * gg[0], v[j][1] * rstd * gg[1]); w.y = pk2(v[j][2] * rstd * gg[2], v[j][3] * rstd * gg[3]); o8[64 * j] = w; }
        }
        for (int row = gw; row < 256; row += NGW) {
            u32x2* o8 = (u32x2*)(xb + (size_t)(NTOK + row) * D) + lane;
            if (row < NMETA) {
                const f32x4* xr = (const f32x4*)(meta + (size_t)row * D) + lane;
                f32x4 v[4]; float ss = 0.f;
#pragma unroll
                for (int j = 0; j < 4; ++j) { v[j] = xr[64 * j]; ss += (v[j][0] * v[j][0] + v[j][1] * v[j][1]) + (v[j][2] * v[j][2] + v[j][3] * v[j][3]); }
                const float rstd = rsqrtf(wave_sum(ss) * (1.0f / D) + EPS);
#pragma unroll
                for (int j = 0; j < 4; ++j) { const f32x4 gg = ((const f32x4*)g1)[64 * j + lane]; u32x2 w; w.x = pk2(v[j][0] * rstd * gg[0], v[j][1] * rstd * gg[1]); w.y = pk2(v[j][2] * rstd * gg[2], v[j][3] * rstd * gg[3]); o8[64 * j] = w; }
            } else {
#pragma unroll
                for (int j = 0; j < 4; ++j) o8[64 * j] = (u32x2){0u, 0u};
            }
        }
        __syncthreads(); }
        if (BOTH(0)) GRID_BAR();
    }
    if (IN(1)) {
        SchedDense S; S.init(xb, Win_t, NTOK + 256, INW, D, G, bx);
        EpiProj E{proj, qg, kg};
        for (int rep_ = 0; rep_ < ((PROBE_PHASE == 1) ? 2 : 1); ++rep_) pg8::gemm_phase<EpiProj, SchedDense>(lds, 2 * D, S, E);
        if (BOTH(1)) GRID_BAR();
    }
    if (IN(2)) {
        float mq = fabsf(qg[lane]), mk = fabsf(kg[lane]);
#pragma unroll
        for (int o = 1; o < 64; o <<= 1) { mq = fmaxf(mq, __shfl_xor(mq, o)); mk = fmaxf(mk, __shfl_xor(mk, o)); }
        const float bshift = 8.0f * mq * mk;
        for (int rep_ = 0; rep_ < ((PROBE_PHASE == 20) ? 2 : 1); ++rep_) attn::phase(lds, proj, pmeta, sinks, bshift, yatt, G, bx);
        for (int rep_ = 0; rep_ < ((PROBE_PHASE == 21) ? 2 : 1); ++rep_) for (int u = bx; u < NB * 4 * 8; u += G) { const int v = ((G & 7) == 0 && G == 256) ? ((u & 7) * 32 + (u >> 3)) : u;
            ret::state_chain(lds, v >> 5, (v >> 3) & 3, v & 7, proj, pmeta, states); }
        if (BOTH(2)) GRID_BAR();
    }
    if (IN(3)) {
        for (int rep_ = 0; rep_ < ((PROBE_PHASE == 3) ? 2 : 1); ++rep_) ret::out_phase(lds, proj, states, yret, G, bx);
        if (BOTH(3)) GRID_BAR();
    }
    if (IN(4)) {
        SchedBranch S{(const char*)yatt, (const char*)yret, (const char*)Wab_t, (const char*)Wrb_t, G, bx};
        EpiBranch E{merged, proj};
        for (int rep_ = 0; rep_ < ((PROBE_PHASE == 4) ? 2 : 1); ++rep_) pg8::gemm_phase<EpiBranch, SchedBranch>(lds, 2 * D, S, E);
        if (BOTH(4)) GRID_BAR();
    }
    if (IN(5)) {
        SchedDense S; S.init(merged, Wout_t, NTOK, D, D, G, bx);
        EpiOut E{x, out};
        for (int rep_ = 0; rep_ < ((PROBE_PHASE == 5) ? 2 : 1); ++rep_) pg8::gemm_phase<EpiOut, SchedDense>(lds, 2 * D, S, E);
        if (BOTH(5)) GRID_BAR();
    }
    if (IN(6)) {
        route_phase(lds, out, g2, w_r, b_r, xn8, tke, tkpos, tkw, list, wlist, ctl + CW_CNT, G, bx);
        if (BOTH(6)) GRID_BAR();
    }
    if (hi > 7 && lo <= 9) moe_tables(misc, ctl + CW_CNT);
    if (IN(7)) {
        SchedMoe<true, 8> S{(const char*)xn8, (const char*)Wgu_t, misc, list, G, bx};
        EpiGU E{act, b_gu};
        for (int rep_ = 0; rep_ < ((PROBE_PHASE == 7) ? 2 : 1); ++rep_) pg8::gemm_phase<EpiGU, SchedMoe<true, 8>, true>(lds, D, S, E);
        if (BOTH(7)) GRID_BAR();
    }
    if (IN(8)) {
        SchedMoe<false, 4> S{(const char*)act, (const char*)Wdn_t, misc, list, G, bx};
        EpiDown E{rows, b_dn, wlist, misc};
        for (int rep_ = 0; rep_ < ((PROBE_PHASE == 8) ? 2 : 1); ++rep_) pg8::gemm_phase<EpiDown, SchedMoe<false, 4>, true>(lds, DFF, S, E);
        if (BOTH(8)) GRID_BAR();
    }
    if (IN(9)) combine_phase(misc, (void*)proj, out, rows, tke, tkpos, vcu * NWAVES + wave, G * NWAVES, lane);
#undef IN
#undef BOTH
#undef GRID_BAR
}

extern "C" void kernel_launch(void* const* d_in, const int* in_sizes, int n_in, void* d_out, int out_size, void* d_ws, size_t ws_size, hipStream_t stream) {
    static int grid = 0;
    if (grid == 0) {
        if (n_in != 17 || in_sizes[0] != NTOK * D || out_size != NTOK * D || ws_size < WS_END) {
            fprintf(stderr, "kernel_launch: unexpected shapes (n_in %d in0 %d out %d ws %zu)\n", n_in, n_in > 0 ? in_sizes[0] : -1, out_size, ws_size); grid = -1; return; }
        int dev = 0, cus = 0;
        if (hipGetDevice(&dev) != hipSuccess || hipDeviceGetAttribute(&cus, hipDeviceAttributeMultiprocessorCount, dev) != hipSuccess) { grid = -1; return; }
        if (hipFuncSetAttribute((const void*)mk_fwd, hipFuncAttributeMaxDynamicSharedMemorySize, LDS_BYTES) != hipSuccess) { fprintf(stderr, "kernel_launch: hipFuncSetAttribute failed\n"); grid = -1; return; }
        grid = cus;
    }
    if (grid < 0) return;
    unsigned char* ws = (unsigned char*)d_ws;
    (void)hipMemsetAsync(ws + WS_CTL, 0, 1 * MiB, stream);
    Args a{};
    for (int i = 0; i < 17; ++i) a.in[i] = (const float*)d_in[i];
    a.out = (float*)d_out; a.ws = ws; a.ph_lo = 0; a.ph_hi = 10; a.li = 0; a.pad = 0;
    hipLaunchKernelGGL(mk_fwd, dim3(grid), dim3(512), LDS_BYTES, stream, a);
}
```

```cpp
#include <hip/hip_runtime.h>
#include <cstdio>
#include <cstdint>

typedef unsigned short bf16;
__device__ __forceinline__ float bf2f(bf16 v) { return __uint_as_float(((unsigned)v) << 16); }
__device__ __forceinline__ bf16 f2bf(float f) { const __bf16 b = (__bf16)f; return __builtin_bit_cast(unsigned short, b); }
__device__ __forceinline__ float sigmoidf_(float x) { return __builtin_amdgcn_rcpf(1.0f + __builtin_amdgcn_exp2f(-1.4426950408889634f * x)); }

constexpr int NB = 8, SEQ = 4096, D = 1024, NTOK = NB * SEQ;
constexpr int NMETA = 16;
constexpr int INW = 6400;
constexpr int C_AQ = 0, C_AK = 1024, C_AV = 1152, C_RQ = 1280, C_RK = 1792, C_RV = 2304, C_RG = 3328, C_GA = 4352, C_GR = 5376;
constexpr int NE = 32, TOPK = 4, DFF = 1024;
constexpr int NROWS = (NTOK * TOPK / 256 + NE) * 256;
constexpr int NTILE = NROWS / 256;
constexpr float EPS = 1e-5f;

constexpr size_t MiB = 1u << 20;
constexpr size_t WS_CTL = 0;
constexpr size_t WS_SMALL = 1 * MiB;
constexpr size_t WS_W = 16 * MiB;
constexpr size_t WS_XB = 232 * MiB;
constexpr size_t WS_PROJ = 297 * MiB;
constexpr size_t WS_YATT = 701 * MiB;
constexpr size_t WS_YRET = 765 * MiB;
constexpr size_t WS_MERGED = 829 * MiB;
constexpr size_t WS_END = 1020 * MiB;
constexpr size_t WS_ACT = 297 * MiB;
constexpr size_t WS_ROWS = 568 * MiB;
constexpr size_t SM_UMETA = WS_SMALL;
constexpr size_t SM_PMETA = WS_SMALL + 64 * 1024;
constexpr size_t SM_TKE = WS_SMALL + 512 * 1024;
constexpr size_t SM_TKW = SM_TKE + 512 * 1024;
constexpr size_t SM_TKPOS = SM_TKW + 512 * 1024;
constexpr size_t SM_TKROW = SM_TKPOS + 512 * 1024;
constexpr size_t SM_ROWTOK = SM_TKROW + 512 * 1024;
constexpr size_t SM_ROWW = SM_ROWTOK + 1024 * 1024;
constexpr size_t SM_TILEE = SM_ROWW + 1024 * 1024;
constexpr int CW_CNT = 1024;

#define LAS __attribute__((address_space(3)))
#define GAS __attribute__((address_space(1)))
typedef short bf16x8 __attribute__((ext_vector_type(8)));
typedef float f32x4 __attribute__((ext_vector_type(4)));
typedef float f32x2 __attribute__((ext_vector_type(2)));
typedef unsigned u32x4 __attribute__((ext_vector_type(4)));
typedef unsigned u32x2 __attribute__((ext_vector_type(2)));
#define LDS_WAIT() asm volatile("s_waitcnt lgkmcnt(0)" ::: "memory")
#define VM_WAIT() asm volatile("s_waitcnt vmcnt(0)" ::: "memory")
typedef __bf16 bf16x2_t __attribute__((ext_vector_type(2)));
__device__ __forceinline__ unsigned pk2(float lo, float hi) { const f32x2 v = {lo, hi}; const bf16x2_t b = __builtin_convertvector(v, bf16x2_t); return __builtin_bit_cast(unsigned, b); }
__device__ __forceinline__ unsigned pk4_fp8(float a, float b, float c, float d) { int w = __builtin_amdgcn_cvt_pk_fp8_f32(a, b, 0, false); w = __builtin_amdgcn_cvt_pk_fp8_f32(c, d, w, true); return (unsigned)w; }
constexpr float W8_SCALE = 64.0f, W8_INV = 1.0f / 64.0f;
constexpr float ROW8_SCALE = 16.0f, ROW8_INV = 1.0f / 16.0f;
__device__ __forceinline__ float wave_sum(float v) {
#pragma unroll
    for (int o = 1; o < 64; o <<= 1) v += __shfl_xor(v, o);
    return v;
}

constexpr size_t WS_WIN = WS_W;
constexpr size_t WS_WAB = WS_W + 13 * MiB;
constexpr size_t WS_WRB = WS_W + 15 * MiB;
constexpr size_t WS_WOUT = WS_W + 17 * MiB;
constexpr size_t WS_WGU = WS_W + 19 * MiB;
constexpr size_t WS_WDN = WS_W + 147 * MiB;
static_assert(WS_WDN + 64 * MiB <= WS_XB, "weight map");
constexpr size_t SM_ATILE = SM_TILEE + 4096;
constexpr int CW_NACT = 1088;
constexpr int CW_BAR = 4096;

constexpr int RING_BYTES = 131072;
constexpr int MISC_OFF = RING_BYTES;
constexpr int LDS_BYTES = 147456;
constexpr int NWAVES = 8;

#define XB_TMO      128
#define XB_XCNT(j)  (256  + 64 * (j))
#define XB_XSUB(j)  (1280 + 64 * (j))
#define XB_XGEN(j)  (2304 + 64 * (j))
#define XB_TOP      3328
#define XB_TOPGEN   3392
#define XCD_BAR_WORDS 3456
#define XB_SPIN_CAP (1u << 20)
__device__ __forceinline__ unsigned xb_ld(unsigned* p)              { return __hip_atomic_load(p, __ATOMIC_RELAXED, __HIP_MEMORY_SCOPE_AGENT); }
__device__ __forceinline__ unsigned xb_add(unsigned* p, unsigned v) { return __hip_atomic_fetch_add(p, v, __ATOMIC_RELAXED, __HIP_MEMORY_SCOPE_AGENT); }
__device__ __forceinline__ unsigned xb_xcc_id() { return (unsigned)__builtin_amdgcn_s_getreg((3 << 11) | 20) & 0xFu; }
#define XB_SPIN(cond, bar) do { unsigned _sp = 0; while (cond) { __builtin_amdgcn_s_sleep(1); \
    if ((++_sp & 255u) == 0u) { if (xb_ld(&(bar)[XB_TMO])) break; if (_sp > XB_SPIN_CAP) { atomicAdd(&(bar)[XB_TMO], 1u); break; } } } } while (0)
struct XcdBarrier { unsigned* bar; unsigned x; volatile LAS unsigned* st; };
__device__ __forceinline__ XcdBarrier xcd_barrier_post(unsigned* bar, volatile LAS unsigned* st) {
    XcdBarrier b; b.bar = bar; b.x = xb_xcc_id(); b.st = st;
    if (threadIdx.x == 0) (void)xb_add(&bar[XB_XCNT(b.x)], 1u);
    return b;
}
__device__ __forceinline__ void xcd_barrier_complete(unsigned* bar, unsigned x, unsigned& nloc, unsigned& nx) {
    const unsigned G = gridDim.x * gridDim.y * gridDim.z;
    unsigned sum, cnt, mine, sp = 0u;
    for (;;) {
        sum = 0u; cnt = 0u; mine = 0u;
#pragma unroll
        for (unsigned j = 0; j < 16; ++j) { const unsigned c = xb_ld(&bar[XB_XCNT(j)]); sum += c; cnt += (c > 0u) ? 1u : 0u; mine = (j == x) ? c : mine; }
        if (sum == G) break;
        __builtin_amdgcn_s_sleep(1);
        if ((++sp & 255u) == 0u) { if (xb_ld(&bar[XB_TMO])) break; if (sp > XB_SPIN_CAP) { atomicAdd(&bar[XB_TMO], 1u); break; } }
    }
    nloc = mine > 0u ? mine : 1u; nx = cnt > 0u ? cnt : 1u;
}
__device__ __forceinline__ void xcd_barrier(const XcdBarrier& b) {
    asm volatile("s_waitcnt vmcnt(0)" ::: "memory");
    __syncthreads();
    if (threadIdx.x == 0) {
        unsigned* bar = b.bar;
        __builtin_amdgcn_s_waitcnt(0);
        unsigned nloc = b.st[0], nx = b.st[1];
        if (nloc == 0u) { xcd_barrier_complete(bar, b.x, nloc, nx); b.st[0] = nloc; b.st[1] = nx; }
        const unsigned old = xb_add(&bar[XB_XSUB(b.x)], 1u);
        const unsigned gen = old / nloc;
        if (old + 1u == (gen + 1u) * nloc) {
            __builtin_amdgcn_fence(__ATOMIC_RELEASE, "agent");
            asm volatile("s_waitcnt vmcnt(0)" ::: "memory");
            const unsigned og = xb_add(&bar[XB_TOP], 1u);
            const unsigned tg = og / nx;
            if (og + 1u == (tg + 1u) * nx) xb_add(&bar[XB_TOPGEN], 1u);
            else XB_SPIN(xb_ld(&bar[XB_TOPGEN]) == tg, bar);
            __builtin_amdgcn_fence(__ATOMIC_ACQUIRE, "agent");
            xb_add(&bar[XB_XGEN(b.x)], 1u);
            asm volatile("s_waitcnt vmcnt(0)" ::: "memory");
        } else {
            XB_SPIN(xb_ld(&bar[XB_XGEN(b.x)]) == gen, bar);
            __builtin_amdgcn_fence(__ATOMIC_ACQUIRE, "agent");
            asm volatile("s_waitcnt vmcnt(0)" ::: "memory");
        }
    }
    __syncthreads();
}

namespace pg8 {
constexpr int BM = 256, BK = 64, HALF = 128, HTB = HALF * BK * 2, STAGE_BYTES = 8 * HTB;
__host__ __device__ __forceinline__ int lds_byte(int r, int c) { const int st = (r >> 4) * 2 + (c >> 5), rr = r & 15, cc = c & 31, ob = rr * 64 + cc * 2; return st * 1024 + (ob ^ (((ob >> 9) & 1) << 5)); }
__host__ __device__ __forceinline__ void stage_rc(int b, int& R, int& C) { const int st = b / 1024, sb = b % 1024, swz = sb ^ (((sb >> 9) & 1) << 5); R = (st >> 1) * 16 + swz / 64; C = (st & 1) * 32 + (swz % 64) / 2; }
__host__ __device__ __forceinline__ int perm32(int rho) { const int n = rho >> 4, i = rho & 15; return 8 * (i >> 2) + 4 * n + (i & 3); }
struct Unit { int pm, pn, aux, tl; const char* A; const char* B; };
typedef f32x4 Acc[2][2][4][2];
typedef int u32x4_i __attribute__((ext_vector_type(4)));

typedef int v8i32 __attribute__((ext_vector_type(8)));
template <class Epi, class Sched, bool FP8 = false>
__device__ __forceinline__ void gemm_phase(LAS unsigned char* lds, const int Kb, const Sched& S, const Epi& E) {
    const int tid = threadIdx.x, wid = __builtin_amdgcn_readfirstlane(tid >> 6), lane = tid & 63, wr = wid >> 2, wc = wid & 3, fr = lane & 15, fq = lane >> 4;
    const int nt = Kb / 128;
    int RA[2], CA[2]; unsigned voffB[2];
#pragma unroll
    for (int i = 0; i < 2; ++i) { int R, C; stage_rc(tid * 16 + i * 8192, R, C); const int Rb = Epi::PERM ? ((R & ~31) + perm32(R & 31)) : R;
        RA[i] = R; CA[i] = C; voffB[i] = (unsigned)(Rb * Kb + C * 2); }
    const size_t kstep = (size_t)(BK * 2);
    const size_t hstep = (size_t)HALF * Kb;
    const unsigned ldsw = (unsigned)wid * 1024u;
    const int aoff = lds_byte(wr * 64 + fr, fq * 8), boff = lds_byte(wc * 32 + fr, fq * 8);
#define PG8_SA(b, h) (((b) * 2 + (h)) * HTB)
#define PG8_SB(b, h) ((4 + (b) * 2 + (h)) * HTB)
#define PG8_STAGE(bufoff, gbase, voff) do { _Pragma("unroll") for (int _i = 0; _i < 2; ++_i) \
        __builtin_amdgcn_global_load_lds((const unsigned*)((const char*)(gbase) + (voff)[_i]), (LAS unsigned*)(lds + (bufoff) + ldsw + _i * 8192), 16, 0, 0); } while (0)
#define PG8_LDA(dst, b, h) do { _Pragma("unroll") for (int m = 0; m < 4; ++m) _Pragma("unroll") for (int k = 0; k < 2; ++k) dst[m][k] = *(const LAS bf16x8*)(lds + PG8_SA(b, h) + aoff + m * 2048 + k * 1024); } while (0)
#define PG8_LDB(dst, b, h) do { _Pragma("unroll") for (int n = 0; n < 2; ++n) _Pragma("unroll") for (int k = 0; k < 2; ++k) dst[n][k] = *(const LAS bf16x8*)(lds + PG8_SB(b, h) + boff + n * 2048 + k * 1024); } while (0)
#define PG8_MMA(ai, bj, At, Bt) do { __builtin_amdgcn_s_setprio(1); _Pragma("unroll") for (int m = 0; m < 4; ++m) _Pragma("unroll") for (int n = 0; n < 2; ++n) { \
        if constexpr (FP8) { const v8i32 bq = __builtin_shufflevector(__builtin_bit_cast(u32x4_i, Bt[n][0]), __builtin_bit_cast(u32x4_i, Bt[n][1]), 0, 1, 2, 3, 4, 5, 6, 7), \
                                         aq = __builtin_shufflevector(__builtin_bit_cast(u32x4_i, At[m][0]), __builtin_bit_cast(u32x4_i, At[m][1]), 0, 1, 2, 3, 4, 5, 6, 7); \
            asm volatile("v_mfma_scale_f32_16x16x128_f8f6f4 %0, %1, %2, %0, %3, %3 op_sel_hi:[0,0,0]" : "+v"(acc[ai][bj][m][n]) : "v"(bq), "v"(aq), "v"(scale1)); } \
        else { _Pragma("unroll") for (int k = 0; k < 2; ++k) acc[ai][bj][m][n] = __builtin_amdgcn_mfma_f32_16x16x32_bf16(Bt[n][k], At[m][k], acc[ai][bj][m][n], 0, 0, 0); } } \
        __builtin_amdgcn_s_setprio(0); } while (0)
#define PG8_WAIT_V(n) asm volatile("s_waitcnt vmcnt(" #n ")" ::: "memory")
#define PG8_WAIT_L(n) asm volatile("s_waitcnt lgkmcnt(" #n ")" ::: "memory")
#define PG8_BAR __builtin_amdgcn_s_barrier()
#define PG8_SCHED __builtin_amdgcn_sched_barrier(0)
    int scale1 = 0x7f7f7f7f; asm volatile("" : "+v"(scale1));
    Unit cur, nxt; int ui = 0;
    if (!S.next(0, cur)) return;
    unsigned ca[2][2], na[2][2];
    S.aoff(cur, RA, CA, ca);
    f32x4 acc[2][2][4][2];
#pragma unroll
    for (int a = 0; a < 2; ++a)
#pragma unroll
        for (int b = 0; b < 2; ++b)
#pragma unroll
            for (int m = 0; m < 4; ++m)
#pragma unroll
                for (int n = 0; n < 2; ++n) acc[a][b][m][n] = (f32x4){0.f, 0.f, 0.f, 0.f};
    bf16x8 At[4][2], B0[2][2], B1[2][2];
    const char* cA = cur.A; const char* cB = cur.B;
    PG8_STAGE(PG8_SB(0, 0), cB, voffB); PG8_STAGE(PG8_SB(0, 1), cB + hstep, voffB); PG8_STAGE(PG8_SA(0, 0), cA, ca[0]); PG8_STAGE(PG8_SA(0, 1), cA, ca[1]);
    if (wr == 1) PG8_BAR;
    PG8_WAIT_V(2); PG8_BAR;
    PG8_STAGE(PG8_SB(1, 0), cB + kstep, voffB); PG8_STAGE(PG8_SA(1, 0), cA + kstep, ca[0]); PG8_STAGE(PG8_SB(1, 1), cB + hstep + kstep, voffB);
    PG8_WAIT_V(6); PG8_BAR;
    for (;;) {
        const bool has_next = S.next(ui + 1, nxt);
        if constexpr (Sched::GATHER) {
            if (has_next) S.aoff(nxt, RA, CA, na);
            else {
#pragma unroll
                for (int h = 0; h < 2; ++h)
#pragma unroll
                    for (int i = 0; i < 2; ++i) na[h][i] = ca[h][i];
            }
        }
        const char* nA = has_next ? nxt.A : cA; const char* nB = has_next ? nxt.B : cB;
#pragma nounroll
        for (int t = 0; t < nt; t += 2) {
            const bool last = (t == nt - 2);
            const char* a1 = cA + (size_t)(t + 1) * kstep;
            const char* a2 = last ? nA : cA + (size_t)(t + 2) * kstep; const char* b2 = last ? nB : cB + (size_t)(t + 2) * kstep;
            const char* a3 = a2 + kstep; const char* b3 = b2 + kstep;
            unsigned o2[2][2];
#pragma unroll
            for (int h = 0; h < 2; ++h)
#pragma unroll
                for (int i = 0; i < 2; ++i) { if constexpr (Sched::GATHER) o2[h][i] = last ? na[h][i] : ca[h][i]; else o2[h][i] = ca[h][i]; }
            PG8_LDB(B0, 0, 0); PG8_LDB(B1, 0, 1); PG8_SCHED; PG8_LDA(At, 0, 0); PG8_STAGE(PG8_SA(1, 1), a1, ca[1]);
            PG8_WAIT_V(8); PG8_WAIT_L(0); PG8_BAR; PG8_MMA(0, 0, At, B0); PG8_MMA(0, 1, At, B1); PG8_BAR; PG8_SCHED;
            PG8_LDA(At, 0, 1); PG8_STAGE(PG8_SB(0, 0), b2, voffB); PG8_STAGE(PG8_SB(0, 1), b2 + hstep, voffB); PG8_STAGE(PG8_SA(0, 0), a2, o2[0]);
            PG8_WAIT_V(8); PG8_WAIT_L(0); PG8_BAR; PG8_MMA(1, 0, At, B0); PG8_MMA(1, 1, At, B1); PG8_BAR; PG8_SCHED;
            PG8_LDB(B0, 1, 0); PG8_LDB(B1, 1, 1); PG8_SCHED; PG8_LDA(At, 1, 0); PG8_STAGE(PG8_SA(0, 1), a2, o2[1]);
            PG8_WAIT_V(8); PG8_WAIT_L(0); PG8_BAR; PG8_MMA(0, 0, At, B0); PG8_MMA(0, 1, At, B1); PG8_BAR; PG8_SCHED;
            PG8_LDA(At, 1, 1); PG8_STAGE(PG8_SB(1, 0), b3, voffB); PG8_STAGE(PG8_SB(1, 1), b3 + hstep, voffB); PG8_STAGE(PG8_SA(1, 0), a3, o2[0]);
            PG8_WAIT_V(8); PG8_WAIT_L(0); PG8_BAR; PG8_MMA(1, 0, At, B0); PG8_MMA(1, 1, At, B1); PG8_BAR; PG8_SCHED;
        }
        if constexpr (FP8) { asm volatile("s_nop 15\n\ts_nop 15\n\ts_nop 15" ::: "memory"); PG8_SCHED; }
        if (wr == 0) PG8_BAR;
        E(acc, cur, wr, wc, fr, fq);
        if (!has_next) break;
#pragma unroll
        for (int a = 0; a < 2; ++a)
#pragma unroll
            for (int b = 0; b < 2; ++b)
#pragma unroll
                for (int m = 0; m < 4; ++m)
#pragma unroll
                    for (int n = 0; n < 2; ++n) acc[a][b][m][n] = (f32x4){0.f, 0.f, 0.f, 0.f};
        cur = nxt; cA = nA; cB = nB; ++ui;
        if constexpr (Sched::GATHER) {
#pragma unroll
            for (int h = 0; h < 2; ++h)
#pragma unroll
                for (int i = 0; i < 2; ++i) ca[h][i] = na[h][i];
        }
        if (wr == 1) PG8_BAR;
    }
    PG8_WAIT_V(0);
    PG8_BAR;
#undef PG8_SA
#undef PG8_SB
#undef PG8_STAGE
#undef PG8_LDA
#undef PG8_LDB
#undef PG8_MMA
#undef PG8_WAIT_V
#undef PG8_WAIT_L
#undef PG8_BAR
#undef PG8_SCHED
}
}
#ifndef PROBE_PHASE
#define PROBE_PHASE (-1)
#endif
constexpr size_t SM_LIST = WS_SMALL + 5 * MiB;
constexpr size_t SM_WLIST = WS_SMALL + 9 * MiB;
constexpr int MT_PSTART = 256;
constexpr int MT_CNT = 512;
constexpr int MT_NACT = 768;
constexpr int MT_ATILE = 1024;
constexpr int MT_HIST = 4096;
constexpr int MT_BASE = 4224;
constexpr int MT_REC = 4352;

__device__ __forceinline__ void moe_tables(LAS unsigned char* misc, const unsigned* cnt) {
    LAS int* pstart = (LAS int*)(misc + MT_PSTART); LAS int* cl = (LAS int*)(misc + MT_CNT); LAS int* at = (LAS int*)(misc + MT_ATILE);
    __syncthreads();
    if (threadIdx.x < 64) {
        const int lane = threadIdx.x, e = lane & 31;
        const int c = (int)__hip_atomic_load(cnt + e, __ATOMIC_RELAXED, __HIP_MEMORY_SCOPE_AGENT), nt = (c + 255) >> 8;
        int incl = nt;
#pragma unroll
        for (int o = 1; o < 32; o <<= 1) { const int v = __shfl_up(incl, o); if (e >= o) incl += v; }
        const int t0 = incl - nt;
        if (lane < 32) { cl[e] = c; pstart[e] = t0 << 8; for (int t = 0; t < nt; ++t) at[t0 + t] = (t0 + t) | (e << 12) | (t << 20);
            if (e == 31) { pstart[NE] = incl << 8; *(LAS int*)(misc + MT_NACT) = incl; } }
    }
    __syncthreads();
}

template <int N, int XR>
__device__ __forceinline__ void tr_step(float (&v)[64], int lane) {
    const bool up = (lane & XR) != 0;
#pragma unroll
    for (int i = 0; i < N; ++i) { const float keep = up ? v[i + N] : v[i], send = up ? v[i] : v[i + N]; v[i] = keep + __shfl_xor(send, XR); }
}

__device__ __forceinline__ void route_phase(LAS unsigned char* lds, const float* __restrict__ h2, const float* __restrict__ g2, const float* __restrict__ wr, const float* __restrict__ br,
                                            unsigned char* __restrict__ xn2, int* __restrict__ tke, int* __restrict__ tkpos, float* __restrict__ tkw, int* __restrict__ list, float* __restrict__ wlist,
                                            unsigned* __restrict__ cnt, int G, int bx) {
    const int tid = threadIdx.x, lane = tid & 63; const int wave = __builtin_amdgcn_readfirstlane(tid >> 6);
    LAS float* wT = (LAS float*)lds;
    LAS unsigned char* misc = lds + MISC_OFF;
    LAS int* hist = (LAS int*)(misc + MT_HIST); LAS int* base = (LAS int*)(misc + MT_BASE); LAS int* rec = (LAS int*)(misc + MT_REC);
    for (int idx = tid; idx < NE * D; idx += 512) { const int e = idx >> 10, k = idx & 1023; wT[idx] = wr[(size_t)k * NE + e]; }
    const float bias = br[lane & 31];
    for (int tb = bx; tb < NTOK / 128; tb += G) {
        if (tid < 32) hist[tid] = 0;
        __syncthreads();
        for (int rep_ = 0; rep_ < ((PROBE_PHASE == 6) ? 2 : 1); ++rep_)
        for (int pp = 0; pp < 8; ++pp) {
            const int tl0 = wave * 16 + pp * 2;
            const int row0 = tb * 128 + tl0;
            float xv[2][16];
#pragma unroll
            for (int t = 0; t < 2; ++t) {
                const f32x4* xr = (const f32x4*)(h2 + (size_t)(row0 + t) * D) + lane;
                float ss = 0.f; f32x4 v[4];
#pragma unroll
                for (int j = 0; j < 4; ++j) { v[j] = xr[64 * j]; ss += (v[j][0] * v[j][0] + v[j][1] * v[j][1]) + (v[j][2] * v[j][2] + v[j][3] * v[j][3]); }
                const float rstd = rsqrtf(wave_sum(ss) * (1.0f / D) + EPS);
                unsigned* o4 = (unsigned*)(xn2 + (size_t)(row0 + t) * D) + lane;
#pragma unroll
                for (int j = 0; j < 4; ++j) { const f32x4 gg = ((const f32x4*)g2)[64 * j + lane];
#pragma unroll
                    for (int q = 0; q < 4; ++q) xv[t][4 * j + q] = v[j][q] * rstd * gg[q];
                    o4[64 * j] = pk4_fp8(xv[t][4 * j], xv[t][4 * j + 1], xv[t][4 * j + 2], xv[t][4 * j + 3]); }
            }
            float acc[64];
#pragma unroll
            for (int i = 0; i < 64; ++i) acc[i] = 0.f;
#pragma unroll
            for (int e = 0; e < 32; ++e)
#pragma unroll
                for (int j = 0; j < 4; ++j) {
                    const f32x4 w = *(const LAS f32x4*)(wT + e * 1024 + (64 * j + lane) * 4);
                    acc[e] += (xv[0][4 * j] * w[0] + xv[0][4 * j + 1] * w[1]) + (xv[0][4 * j + 2] * w[2] + xv[0][4 * j + 3] * w[3]);
                    acc[32 + e] += (xv[1][4 * j] * w[0] + xv[1][4 * j + 1] * w[1]) + (xv[1][4 * j + 2] * w[2] + xv[1][4 * j + 3] * w[3]);
                }
            tr_step<32, 32>(acc, lane); tr_step<16, 16>(acc, lane); tr_step<8, 8>(acc, lane); tr_step<4, 4>(acc, lane); tr_step<2, 2>(acc, lane); tr_step<1, 1>(acc, lane);
            const float logit = acc[0] + bias;
            float cur = logit, m0 = 0.f; int myrank = -1;
#pragma unroll
            for (int k = 0; k < 4; ++k) {
                float m = cur;
#pragma unroll
                for (int o = 1; o < 32; o <<= 1) m = fmaxf(m, __shfl_xor(m, o));
                if (k == 0) m0 = m;
                const unsigned long long mask = __ballot(cur == m);
                const unsigned half = (lane < 32) ? (unsigned)mask : (unsigned)(mask >> 32);
                const int sel = __ffs(half) - 1;
                if ((lane & 31) == sel) { myrank = k; cur = -3.0e38f; }
            }
            float ex = (myrank >= 0) ? __expf(logit - m0) : 0.f, sum = ex;
#pragma unroll
            for (int o = 1; o < 32; o <<= 1) sum += __shfl_xor(sum, o);
            if (myrank >= 0 && (PROBE_PHASE != 6 || rep_ == 1)) {
                const int e = lane & 31, tl = tl0 + (lane >> 5);
                const int lp = __hip_atomic_fetch_add(hist + e, 1, __ATOMIC_RELAXED, __HIP_MEMORY_SCOPE_WORKGROUP);
                LAS int* r = rec + (tl * 4 + myrank) * 3; r[0] = e; r[1] = lp; r[2] = __float_as_int(ex / sum);
            }
        }
        __syncthreads();
        if (tid < 32) base[tid] = (int)atomicAdd(&cnt[tid], (unsigned)hist[tid]);
        __syncthreads();
        { const int tl = tid >> 2; const int token = tb * 128 + tl; LAS int* r = rec + tid * 3; const int e = r[0], pos = base[e] + r[1]; const float w = __int_as_float(r[2]);
          tke[token * 4 + (tid & 3)] = e; tkpos[token * 4 + (tid & 3)] = pos; tkw[token * 4 + (tid & 3)] = w;
          list[e * NTOK + pos] = token; wlist[e * NTOK + pos] = w; }
        __syncthreads();
    }
}

__device__ __forceinline__ void combine_phase(LAS unsigned char* misc, void* scratch_out, float* __restrict__ out, const unsigned char* __restrict__ rows, const int* __restrict__ tke, const int* __restrict__ tkpos, int gw, int NGW, int lane) {
    LAS const int* pstart = (LAS const int*)(misc + MT_PSTART);
    for (int rep_ = 0; rep_ < ((PROBE_PHASE == 9) ? 2 : 1); ++rep_)
    for (int token = gw; token < NTOK; token += NGW) {
        int rr[4];
#pragma unroll
        for (int k = 0; k < 4; ++k) rr[k] = pstart[tke[token * 4 + k]] + tkpos[token * 4 + k];
        f32x4* o = (f32x4*)(out + (size_t)token * D) + lane;
        f32x4 v[4], s[4];
#pragma unroll
        for (int j = 0; j < 4; ++j) { v[j] = o[64 * j]; s[j] = (f32x4){0.f, 0.f, 0.f, 0.f}; }
#pragma unroll
        for (int k = 0; k < 4; ++k) {
            const unsigned* rp = (const unsigned*)(rows + (size_t)rr[k] * D) + lane;
#pragma unroll
            for (int j = 0; j < 4; ++j) { const unsigned w = rp[64 * j];
                const f32x2 lo = __builtin_amdgcn_cvt_pk_f32_fp8((int)w, false), hh = __builtin_amdgcn_cvt_pk_f32_fp8((int)w, true);
                s[j][0] += lo[0]; s[j][1] += lo[1]; s[j][2] += hh[0]; s[j][3] += hh[1]; }
        }
#pragma unroll
        for (int j = 0; j < 4; ++j) v[j] = v[j] + s[j] * ROW8_INV;
        if (PROBE_PHASE == 9 && rep_ == 0) {
#pragma unroll
            for (int j = 0; j < 4; ++j) { asm volatile("" :: "v"(v[j])); *(f32x4*)((float*)scratch_out + (size_t)token * D + (64 * j + lane) * 4) = v[j]; }
        } else {
#pragma unroll
        for (int j = 0; j < 4; ++j) o[64 * j] = v[j];
        }
    }
}
struct SchedDense {
    static constexpr bool GATHER = false;
    const char* A; const char* Bt; int K, nM, nN, nwg, G, c;
    __device__ void init(const bf16* A_, const bf16* Bt_, int M, int N, int K_, int G_, int c_) { A = (const char*)A_; Bt = (const char*)Bt_; K = K_; nM = M / 256; nN = N / 256; nwg = nM * nN; G = G_; c = c_; }
    __device__ __forceinline__ bool next(int i, pg8::Unit& u) const {
        const long L = (long)i * G + c; if (L >= nwg) return false;
        int wgid = (int)L; { const int q = nwg / 8, r = nwg % 8, xcd = wgid % 8, off = wgid / 8; wgid = (xcd < r ? xcd * (q + 1) : r * (q + 1) + (xcd - r) * q) + off; }
        const int nig = 8 * nN, gid = wgid / nig, fm = gid * 8, gsz = (nM - fm) < 8 ? (nM - fm) : 8;
        u.pm = fm + ((wgid % nig) % gsz); u.pn = (wgid % nig) / gsz; u.aux = 0; u.tl = 0;
        u.A = A + (size_t)u.pm * 256 * K * 2; u.B = Bt + (size_t)u.pn * 256 * K * 2; return true;
    }
    __device__ __forceinline__ void aoff(const pg8::Unit&, const int (&R)[2], const int (&C)[2], unsigned (&o)[2][2]) const {
#pragma unroll
        for (int h = 0; h < 2; ++h)
#pragma unroll
            for (int i = 0; i < 2; ++i) o[h][i] = (unsigned)((128 * h + R[i]) * K + C[i]) * 2u;
    }
};
struct SchedBranch {
    static constexpr bool GATHER = false;
    const char* A0; const char* A1; const char* B0; const char* B1; int G, c;
    __device__ __forceinline__ bool next(int i, pg8::Unit& u) const {
        const int L = (i >> 1) * G + c; if (L >= 512) return false;
        int wgid = L; { const int off = wgid / 8, xcd = wgid % 8; wgid = xcd * 64 + off; }
        const int nig = 8 * 4, gid = wgid / nig;
        u.pm = gid * 8 + ((wgid % nig) % 8); u.pn = (wgid % nig) / 8; u.aux = i & 1; u.tl = 0;
        u.A = ((i & 1) ? A1 : A0) + (size_t)u.pm * 256 * D * 2; u.B = ((i & 1) ? B1 : B0) + (size_t)u.pn * 256 * D * 2; return true;
    }
    __device__ __forceinline__ void aoff(const pg8::Unit&, const int (&R)[2], const int (&C)[2], unsigned (&o)[2][2]) const {
#pragma unroll
        for (int h = 0; h < 2; ++h)
#pragma unroll
            for (int i = 0; i < 2; ++i) o[h][i] = (unsigned)((128 * h + R[i]) * D + C[i]) * 2u;
    }
};
template <bool GATHER_, int NPN>
struct SchedMoe {
    static constexpr bool GATHER = GATHER_;
    const char* A; const char* Bt; LAS const unsigned char* misc; const int* list; int G, c;
    __device__ __forceinline__ bool next(int i, pg8::Unit& u) const {
        LAS const int* cl = (LAS const int*)(misc + MT_CNT); LAS const int* ps = (LAS const int*)(misc + MT_PSTART);
        if ((G & 7) == 0) {
            const int x = c & 7, r = c >> 3, n = G >> 3;
            int k = (i * n + r) / NPN; const int pn = (i * n + r) % NPN;
#pragma unroll
            for (int j = 0; j < 4; ++j) { const int e = x + 8 * j, nt = (cl[e] + 255) >> 8;
                if (k < nt) { u.pn = pn; u.aux = e; u.tl = k; u.pm = (ps[e] >> 8) + k;
                    u.A = GATHER ? A : A + (size_t)u.pm * 256 * 1024; u.B = Bt + ((size_t)e * NPN + pn) * 256 * 1024; return true; }
                k -= nt; }
            return false;
        }
        const int nact = *(LAS const int*)(misc + MT_NACT);
        const int L = i * G + c; if (L >= nact * NPN) return false;
        const int k = L / NPN; u.pn = L % NPN; const int w = ((LAS const int*)(misc + MT_ATILE))[k];
        u.pm = w & 0xfff; u.aux = (w >> 12) & 0xff; u.tl = w >> 20;
        u.A = GATHER ? A : A + (size_t)u.pm * 256 * 1024;
        u.B = Bt + ((size_t)u.aux * NPN + u.pn) * 256 * 1024; return true;
    }
    __device__ __forceinline__ void aoff(const pg8::Unit& u, const int (&R)[2], const int (&C)[2], unsigned (&o)[2][2]) const {
        const int ce = ((LAS const int*)(misc + MT_CNT))[u.aux];
#pragma unroll
        for (int h = 0; h < 2; ++h)
#pragma unroll
            for (int i = 0; i < 2; ++i) {
                if (GATHER) { const int idx = u.tl * 256 + 128 * h + R[i]; const int tok = (idx < ce) ? list[u.aux * NTOK + idx] : 0; o[h][i] = (unsigned)tok * 1024u + (unsigned)C[i] * 2u; }
                else o[h][i] = (unsigned)((128 * h + R[i]) * 1024 + C[i] * 2);
            }
    }
};

__device__ __forceinline__ u32x4 pack8(const f32x4& a, const f32x4& b) { u32x4 w; w.x = pk2(a[0], a[1]); w.y = pk2(a[2], a[3]); w.z = pk2(b[0], b[1]); w.w = pk2(b[2], b[3]); return w; }
__device__ __forceinline__ void unpack8(const u32x4& w, float (&f)[8]) {
    f[0] = __uint_as_float(w.x << 16); f[1] = __uint_as_float(w.x & 0xffff0000u); f[2] = __uint_as_float(w.y << 16); f[3] = __uint_as_float(w.y & 0xffff0000u);
    f[4] = __uint_as_float(w.z << 16); f[5] = __uint_as_float(w.z & 0xffff0000u); f[6] = __uint_as_float(w.w << 16); f[7] = __uint_as_float(w.w & 0xffff0000u);
}
struct EpiProj {
    static constexpr bool PERM = true;
    bf16* proj; const float* qg; const float* kg;
    __device__ __forceinline__ void operator()(pg8::Acc& acc, const pg8::Unit& u, int wr, int wc, int fr, int fq) const {
        const int pn = u.pn;
        int mode;
        if (pn < 4) mode = 1; else if (pn == 4) mode = (wc < 2) ? 2 : 0; else if (pn < 7) mode = 0; else if (pn < 9) mode = 3; else if (pn < 13) mode = 0; else if (pn < 17) mode = 4; else mode = 5;
        float gn[2][8];
        if (mode == 1 || mode == 2) { const float* g = (mode == 1) ? qg : kg; const float s = (mode == 1) ? 0.125f : 1.0f;
#pragma unroll
            for (int bj = 0; bj < 2; ++bj)
#pragma unroll
                for (int j = 0; j < 8; ++j) gn[bj][j] = g[32 * bj + 8 * fq + j] * s; }
#pragma unroll
        for (int ai = 0; ai < 2; ++ai)
#pragma unroll
            for (int m = 0; m < 4; ++m) {
                const int r = u.pm * 256 + ai * 128 + wr * 64 + m * 16 + fr;
                bf16* rowp = proj + (size_t)r * INW + pn * 256 + wc * 64 + 8 * fq;
                f32x4 v[2][2];
#pragma unroll
                for (int bj = 0; bj < 2; ++bj) { v[bj][0] = acc[ai][bj][m][0]; v[bj][1] = acc[ai][bj][m][1]; }
                if (mode == 1 || mode == 2) {
                    float ss = 0.f;
#pragma unroll
                    for (int bj = 0; bj < 2; ++bj)
#pragma unroll
                        for (int n = 0; n < 2; ++n) ss += v[bj][n][0] * v[bj][n][0] + v[bj][n][1] * v[bj][n][1] + v[bj][n][2] * v[bj][n][2] + v[bj][n][3] * v[bj][n][3];
                    ss += __shfl_xor(ss, 16); ss += __shfl_xor(ss, 32);
                    const float rs = rsqrtf(ss * (1.0f / 64.0f) + EPS);
#pragma unroll
                    for (int bj = 0; bj < 2; ++bj)
#pragma unroll
                        for (int n = 0; n < 2; ++n)
#pragma unroll
                            for (int i = 0; i < 4; ++i) v[bj][n][i] = v[bj][n][i] * rs * gn[bj][4 * n + i];
                } else if (mode == 3) {
#pragma unroll
                    for (int bj = 0; bj < 2; ++bj)
#pragma unroll
                        for (int n = 0; n < 2; ++n) v[bj][n] = v[bj][n] * 0.08838834764831845f;
                } else if (mode == 4) {
#pragma unroll
                    for (int bj = 0; bj < 2; ++bj)
#pragma unroll
                        for (int n = 0; n < 2; ++n)
#pragma unroll
                            for (int i = 0; i < 4; ++i) { const float x = v[bj][n][i]; v[bj][n][i] = x * sigmoidf_(x); }
                } else if (mode == 5) {
#pragma unroll
                    for (int bj = 0; bj < 2; ++bj)
#pragma unroll
                        for (int n = 0; n < 2; ++n)
#pragma unroll
                            for (int i = 0; i < 4; ++i) v[bj][n][i] = sigmoidf_(v[bj][n][i]);
                }
#pragma unroll
                for (int bj = 0; bj < 2; ++bj) *(u32x4*)(rowp + 32 * bj) = pack8(v[bj][0], v[bj][1]);
            }
    }
};
struct EpiBranch {
    static constexpr bool PERM = true;
    bf16* merged; const bf16* proj;
    __device__ __forceinline__ void operator()(pg8::Acc& acc, const pg8::Unit& u, int wr, int wc, int fr, int fq) const {
        const int gcol = u.aux ? C_GR : C_GA;
#pragma unroll
        for (int ai = 0; ai < 2; ++ai)
#pragma unroll
            for (int m = 0; m < 4; ++m) {
                const int r = u.pm * 256 + ai * 128 + wr * 64 + m * 16 + fr;
#pragma unroll
                for (int bj = 0; bj < 2; ++bj) {
                    const int col = u.pn * 256 + bj * 128 + wc * 32 + 8 * fq;
                    const u32x4 gw = *(const u32x4*)(proj + (size_t)r * INW + gcol + col);
                    float g[8]; unpack8(gw, g);
                    f32x4 a = acc[ai][bj][m][0], b = acc[ai][bj][m][1];
                    a[0] *= g[0]; a[1] *= g[1]; a[2] *= g[2]; a[3] *= g[3]; b[0] *= g[4]; b[1] *= g[5]; b[2] *= g[6]; b[3] *= g[7];
                    bf16* mp = merged + (size_t)r * D + col;
                    if (u.aux) { const u32x4 pw = *(const u32x4*)mp; float p[8]; unpack8(pw, p);
                        a[0] += p[0]; a[1] += p[1]; a[2] += p[2]; a[3] += p[3]; b[0] += p[4]; b[1] += p[5]; b[2] += p[6]; b[3] += p[7]; }
                    *(u32x4*)mp = pack8(a, b);
                }
            }
    }
};
struct EpiOut {
    static constexpr bool PERM = false;
    const float* x; float* out;
    __device__ __forceinline__ void operator()(pg8::Acc& acc, const pg8::Unit& u, int wr, int wc, int fr, int fq) const {
#pragma unroll
        for (int ai = 0; ai < 2; ++ai)
#pragma unroll
            for (int m = 0; m < 4; ++m) {
                const size_t off = (size_t)(u.pm * 256 + ai * 128 + wr * 64 + m * 16 + fr) * D + u.pn * 256 + wc * 32 + 4 * fq;
#pragma unroll
                for (int bj = 0; bj < 2; ++bj)
#pragma unroll
                    for (int n = 0; n < 2; ++n) { const f32x4 xv = *(const f32x4*)(x + off + bj * 128 + n * 16); *(f32x4*)(out + off + bj * 128 + n * 16) = xv + acc[ai][bj][m][n]; }
            }
    }
};
struct EpiGU {
    static constexpr bool PERM = true;
    unsigned char* act; const float* bgu;
    __device__ __forceinline__ void operator()(pg8::Acc& acc, const pg8::Unit& u, int wr, int wc, int fr, int fq) const {
        const int col = u.pn * 128 + wc * 32 + 8 * fq;
        const float* bg = bgu + (size_t)u.aux * 2048 + col;
        float bgate[8], bup[8];
#pragma unroll
        for (int j = 0; j < 8; ++j) { bgate[j] = bg[j]; bup[j] = bg[1024 + j]; }
#pragma unroll
        for (int ai = 0; ai < 2; ++ai)
#pragma unroll
            for (int m = 0; m < 4; ++m) {
                const int r = u.pm * 256 + ai * 128 + wr * 64 + m * 16 + fr;
                float o[8];
#pragma unroll
                for (int n = 0; n < 2; ++n)
#pragma unroll
                    for (int i = 0; i < 4; ++i) {
                        float gate = acc[ai][0][m][n][i] * W8_INV + bgate[4 * n + i], up = acc[ai][1][m][n][i] * W8_INV + bup[4 * n + i];
                        gate = fminf(gate, 7.0f); up = fminf(fmaxf(up, -7.0f), 7.0f);
                        o[4 * n + i] = (up + 1.0f) * gate * sigmoidf_(1.702f * gate);
                    }
                u32x2 w; w.x = pk4_fp8(o[0], o[1], o[2], o[3]); w.y = pk4_fp8(o[4], o[5], o[6], o[7]);
                *(u32x2*)(act + (size_t)r * DFF + col) = w;
            }
    }
};
struct EpiDown {
    static constexpr bool PERM = true;
    unsigned char* rows; const float* bdn; const float* wlist; LAS const unsigned char* misc;
    __device__ __forceinline__ void operator()(pg8::Acc& acc, const pg8::Unit& u, int wr, int wc, int fr, int fq) const {
        const int ce = ((LAS const int*)(misc + MT_CNT))[u.aux];
        float bb[2][8];
#pragma unroll
        for (int bj = 0; bj < 2; ++bj)
#pragma unroll
            for (int j = 0; j < 8; ++j) bb[bj][j] = bdn[(size_t)u.aux * D + u.pn * 256 + bj * 128 + wc * 32 + 8 * fq + j];
#pragma unroll
        for (int ai = 0; ai < 2; ++ai)
#pragma unroll
            for (int m = 0; m < 4; ++m) {
                const int lr = ai * 128 + wr * 64 + m * 16 + fr, r = u.pm * 256 + lr, idx = u.tl * 256 + lr;
                const float w = ((idx < ce) ? wlist[u.aux * NTOK + idx] : 0.f) * ROW8_SCALE;
#pragma unroll
                for (int bj = 0; bj < 2; ++bj) {
                    f32x4 a = acc[ai][bj][m][0], b = acc[ai][bj][m][1];
#pragma unroll
                    for (int i = 0; i < 4; ++i) { a[i] = (a[i] * W8_INV + bb[bj][i]) * w; b[i] = (b[i] * W8_INV + bb[bj][4 + i]) * w; }
                    u32x2 o; o.x = pk4_fp8(a[0], a[1], a[2], a[3]); o.y = pk4_fp8(b[0], b[1], b[2], b[3]);
                    *(u32x2*)(rows + (size_t)r * D + u.pn * 256 + bj * 128 + wc * 32 + 8 * fq) = o;
                }
            }
    }
};
namespace attn {
typedef float f32x16 __attribute__((ext_vector_type(16)));
typedef short s16x4 __attribute__((ext_vector_type(4)));
constexpr int NK = 272, K_OFF = 0, V_OFF = 34816, WS_OFF = 69632, OST_OFF = 71680, LDS_END = OST_OFF + 8 * 4096;
constexpr float LOG2E = 1.4426950408889634f;
__device__ __forceinline__ s16x4 vtr(LAS const unsigned char* p) { return __builtin_bit_cast(s16x4, __builtin_amdgcn_ds_read_tr16_b64_v4i16((LAS s16x4*)p)); }
__device__ __forceinline__ int crowc(int r) { return (r & 3) + 8 * (r >> 2); }

template <int TYPE, bool DIAG>
__device__ __forceinline__ void tile(LAS const unsigned char* lds, int kbase, const bf16x8 (&qr)[4], f32x16 (&o)[2], float& l, float lanebase, float c1, int tt, int lane) {
    const int r32 = lane & 31, hi = lane >> 5;
    f32x16 p = {};
#pragma unroll
    for (int d0 = 0; d0 < 4; ++d0) {
        const bf16x8 kf = *(const LAS bf16x8*)(lds + K_OFF + (2 * d0 + hi) * (NK * 16) + (kbase + r32) * 16);
        p = __builtin_amdgcn_mfma_f32_32x32x16_bf16(kf, qr[d0], p, 0, 0, 0);
    }
    constexpr int NR = (TYPE == 0) ? 8 : 16;
    float e[16];
#pragma unroll
    for (int r = 0; r < NR; ++r) {
        const float add = __builtin_fmaf(c1, (float)crowc(r), lanebase);
        float v = __builtin_amdgcn_exp2f(__builtin_fmaf(p[r], LOG2E, add));
        if (DIAG) { const bool ok = (TYPE == 1) ? (crowc(r) > tt) : (crowc(r) <= tt); v = ok ? v : 0.f; }
        e[r] = v; l += v;
    }
    constexpr int NS = (TYPE == 0) ? 1 : 2;
    u32x4 pw[2];
#pragma unroll
    for (int s = 0; s < NS; ++s) { pw[s].x = pk2(e[8 * s + 0], e[8 * s + 1]); pw[s].y = pk2(e[8 * s + 2], e[8 * s + 3]); pw[s].z = pk2(e[8 * s + 4], e[8 * s + 5]); pw[s].w = pk2(e[8 * s + 6], e[8 * s + 7]); }
    LAS const unsigned char* vb = lds + V_OFF + (kbase + 4 * hi + ((lane & 15) >> 2)) * 64 + ((lane >> 4) & 1) * 32 + (lane & 3) * 8;
#pragma unroll
    for (int d0 = 0; d0 < 2; ++d0)
#pragma unroll
        for (int s = 0; s < NS; ++s) {
            const s16x4 lo = vtr(vb + d0 * (NK * 64) + s * 1024), hh = vtr(vb + d0 * (NK * 64) + s * 1024 + 512);
            const bf16x8 vf = (bf16x8){lo[0], lo[1], lo[2], lo[3], hh[0], hh[1], hh[2], hh[3]};
            o[d0] = __builtin_amdgcn_mfma_f32_32x32x16_bf16(__builtin_bit_cast(bf16x8, pw[s]), vf, o[d0], 0, 0, 0);
        }
}

#define AT_ISSUE(u_) do { const int u__ = (u_); const int b_ = u__ >> 6, qb_ = (u__ >> 1) & 31, kvh_ = u__ & 1; \
        _Pragma("unroll") for (int i = 0; i < 5; ++i) { const int idx = tid + 512 * i; if (idx < NK * 8) { const int key = idx >> 3, c = idx & 7; const bf16* rowp; \
            if (key < 16) rowp = pmeta + (size_t)key * INW; else { int j = qb_ * 128 - 128 + (key - 16); if (j < 0) j = 0; rowp = proj + ((size_t)b_ * SEQ + j) * INW; } \
            pk[i] = *(const u32x4*)(rowp + C_AK + kvh_ * 64 + c * 8); pv[i] = *(const u32x4*)(rowp + C_AV + kvh_ * 64 + c * 8); } } } while (0)
#define AT_QLOAD(dst, a_) do { const size_t qrow_ = (size_t)b * SEQ + qb * 128 + 32 * (a_) + r32; \
        _Pragma("unroll") for (int d0 = 0; d0 < 4; ++d0) dst[d0] = *(const bf16x8*)(proj + qrow_ * INW + C_AQ + h * 64 + d0 * 16 + hi * 8); } while (0)
__device__ __forceinline__ void phase(LAS unsigned char* lds, const bf16* __restrict__ proj, const bf16* __restrict__ pmeta, const float* __restrict__ sinks, float bshift, bf16* __restrict__ yatt, int G, int bx) {
    const int tid = threadIdx.x, lane = tid & 63, r32 = lane & 31, hi = lane >> 5; const int wave = __builtin_amdgcn_readfirstlane(tid >> 6);
    constexpr int NU = NB * 32 * 2;
    if (bx >= NU) return;
    u32x4 pk[5], pv[5];
    AT_ISSUE(bx);
    for (int u = bx; u < NU; u += G) {
        const int b = u >> 6, qb = (u >> 1) & 31, kvh = u & 1;
#pragma unroll
        for (int i = 0; i < 5; ++i) { const int idx = tid + 512 * i; if (idx < NK * 8) { const int key = idx >> 3, c = idx & 7;
            *(LAS u32x4*)(lds + K_OFF + c * (NK * 16) + key * 16) = pk[i];
            *(LAS u32x4*)(lds + V_OFF + (c >> 2) * (NK * 64) + key * 64 + (c & 3) * 16) = pv[i]; } }
        if (u + G < NU) AT_ISSUE(u + G);
        const int h = kvh * 8 + wave;
        bf16x8 qr[4], qn[4];
        AT_QLOAD(qr, 0);
        __syncthreads();
        const float slope = exp2f(-0.5f * (float)(h + 1)), sink = sinks[h];
        const float M = fmaxf(bshift, sink);
        const float c1 = slope * LOG2E;
        LAS float* wsf = (LAS float*)(lds + WS_OFF) + wave * 64;
        LAS bf16* stg = (LAS bf16*)(lds + OST_OFF) + wave * 2048;
#pragma unroll 1
        for (int a = 0; a < 4; ++a) {
            if (a < 3) AT_QLOAD(qn, a + 1);
            f32x16 o[2]; o[0] = f32x16{}; o[1] = f32x16{};
            float l = 0.f;
            const int t = 32 * a + r32;
            const int tt = r32 - 4 * hi;
            const float hi4 = c1 * 4.0f * (float)hi;
            tile<0, false>(lds, 0, qr, o, l, -(slope * (float)(qb * 128 + t + 16) + M) * LOG2E + hi4, c1, tt, lane);
            if (qb > 0) {
                tile<1, true>(lds, 16 + 32 * a, qr, o, l, -(slope * (float)(128 + r32) + M) * LOG2E + hi4, c1, tt, lane);
                for (int bb = a + 1; bb < 4; ++bb) tile<1, false>(lds, 16 + 32 * bb, qr, o, l, -(slope * (float)(128 + t - 32 * bb) + M) * LOG2E + hi4, c1, tt, lane);
            }
            for (int bb = 0; bb < a; ++bb) tile<2, false>(lds, 144 + 32 * bb, qr, o, l, -(slope * (float)(t - 32 * bb) + M) * LOG2E + hi4, c1, tt, lane);
            tile<2, true>(lds, 144 + 32 * a, qr, o, l, -(slope * (float)r32 + M) * LOG2E + hi4, c1, tt, lane);
            l += __shfl_xor(l, 32);
            l += exp2f((sink - M) * LOG2E);
            if (hi == 0) wsf[r32] = l;
            LDS_WAIT();
            float rli[16];
#pragma unroll
            for (int r = 0; r < 16; ++r) rli[r] = __builtin_amdgcn_rcpf(wsf[crowc(r) + 4 * hi]);
#pragma unroll
            for (int r = 0; r < 16; ++r) { const int orow = crowc(r) + 4 * hi;
#pragma unroll
                for (int d0 = 0; d0 < 2; ++d0) stg[orow * 64 + d0 * 32 + r32] = f2bf(o[d0][r] * rli[r]); }
            LDS_WAIT();
            bf16* Ow = yatt + ((size_t)b * SEQ + qb * 128 + 32 * a) * D + h * 64;
#pragma unroll
            for (int i = 0; i < 4; ++i) { const int row = i * 8 + (lane >> 3), ch = lane & 7; const u32x4 v = *(const LAS u32x4*)(stg + row * 64 + ch * 8); *(u32x4*)(Ow + (size_t)row * D + ch * 8) = v; }
            LDS_WAIT();
#pragma unroll
            for (int d0 = 0; d0 < 4; ++d0) qr[d0] = qn[d0];
        }
        __syncthreads();
    }
}
#undef AT_ISSUE
#undef AT_QLOAD
}
namespace ret {
typedef float f32x16 __attribute__((ext_vector_type(16)));
typedef short s16x4 __attribute__((ext_vector_type(4)));
constexpr size_t WS_STATES = 893 * MiB;
__device__ __forceinline__ s16x4 vtr(LAS const unsigned char* p) { return __builtin_bit_cast(s16x4, __builtin_amdgcn_ds_read_tr16_b64_v4i16((LAS s16x4*)p)); }
__device__ __forceinline__ int crowc(int r) { return (r & 3) + 8 * (r >> 2); }
__device__ __forceinline__ float lg2gamma(int h) { return log2f(1.0f - exp2f(-5.0f - (float)h)); }

constexpr int R1_BUF = 40960;
#define RET_ISSUE(KR, VR, c_) do { const int ci__ = (c_); \
        _Pragma("unroll") for (int i = 0; i < 4; ++i) { const int idx = tid + 512 * i, key = idx >> 4, ch = idx & 15; \
            if (ci__ == 0) { KR[i] = (key >= 112) ? *(const u32x4*)(pmeta + (size_t)(key - 112) * INW + C_RK + h * 128 + ch * 8) : (u32x4){0u, 0u, 0u, 0u}; } \
            else KR[i] = *(const u32x4*)(proj + ((size_t)b * SEQ + (ci__ - 1) * 128 + key) * INW + C_RK + h * 128 + ch * 8); } \
        { const int key = tid >> 2, ch = tid & 3; \
          if (ci__ == 0) VR = (key >= 112) ? *(const u32x4*)(pmeta + (size_t)(key - 112) * INW + C_RV + h * 256 + dvs * 32 + ch * 8) : (u32x4){0u, 0u, 0u, 0u}; \
          else VR = *(const u32x4*)(proj + ((size_t)b * SEQ + (ci__ - 1) * 128 + key) * INW + C_RV + h * 256 + dvs * 32 + ch * 8); } } while (0)
#define RET_STEP(KR, VR, c_) do { const int c__ = (c_); LAS unsigned char* buf = lds + (c__ & 1) * R1_BUF; \
        _Pragma("unroll") for (int i = 0; i < 4; ++i) { const int idx = tid + 512 * i, key = idx >> 4, ch = idx & 15; *(LAS u32x4*)(buf + (ch >> 2) * (128 * 64) + key * 64 + (ch & 3) * 16) = KR[i]; } \
        { const int key = tid >> 2, ch = tid & 3; float f[8]; unpack8(VR, f); u32x4 w; \
          w.x = pk2(f[0] * vscale, f[1] * vscale); w.y = pk2(f[2] * vscale, f[3] * vscale); w.z = pk2(f[4] * vscale, f[5] * vscale); w.w = pk2(f[6] * vscale, f[7] * vscale); \
          *(LAS u32x4*)(buf + 32768 + key * 64 + ch * 16) = w; } \
        if (c__ + 2 < 32) RET_ISSUE(KR, VR, c__ + 2); \
        __syncthreads(); \
        if (wave < 4) { \
            const int dt = wave; \
            acc = acc * g128; \
            LAS const unsigned char* ab = buf + dt * (128 * 64) + (4 * hi + ((lane & 15) >> 2)) * 64 + ((lane >> 4) & 1) * 32 + (lane & 3) * 8; \
            LAS const unsigned char* bb = buf + 32768 + (4 * hi + ((lane & 15) >> 2)) * 64 + ((lane >> 4) & 1) * 32 + (lane & 3) * 8; \
            _Pragma("unroll") for (int ks = 0; ks < 8; ++ks) { \
                const s16x4 al = vtr(ab + ks * 1024), ah = vtr(ab + ks * 1024 + 512), bl = vtr(bb + ks * 1024), bh = vtr(bb + ks * 1024 + 512); \
                const bf16x8 af = (bf16x8){al[0], al[1], al[2], al[3], ah[0], ah[1], ah[2], ah[3]}, bfr = (bf16x8){bl[0], bl[1], bl[2], bl[3], bh[0], bh[1], bh[2], bh[3]}; \
                acc = __builtin_amdgcn_mfma_f32_32x32x16_bf16(af, bfr, acc, 0, 0, 0); } \
            bf16* sb = states + ((((size_t)(b * 4 + h) * 32 + c__) * 8 + dvs) * 8) * 512; \
            _Pragma("unroll") for (int g = 0; g < 4; ++g) { u32x2 w; w.x = pk2(acc[4 * g], acc[4 * g + 1]); w.y = pk2(acc[4 * g + 2], acc[4 * g + 3]); \
                *(u32x2*)(sb + (size_t)(2 * dt + (g >> 1)) * 512 + (32 * (g & 1) + (lane & 31)) * 8 + 4 * hi) = w; } \
        } } while (0)
__device__ __forceinline__ void state_chain(LAS unsigned char* lds, int b, int h, int dvs, const bf16* __restrict__ proj, const bf16* __restrict__ pmeta, bf16* __restrict__ states) {
    const int tid = threadIdx.x, lane = tid & 63, hi = lane >> 5; const int wave = __builtin_amdgcn_readfirstlane(tid >> 6);
    const float lg = lg2gamma(h), g128 = exp2f(lg * 128.0f);
    u32x4 kA[4], kB[4], vA, vB;
    const float vscale = exp2f(lg * (float)(127 - (tid >> 2)));
    f32x16 acc = {};
    RET_ISSUE(kA, vA, 0); RET_ISSUE(kB, vB, 1);
#pragma unroll 1
    for (int c = 0; c < 32; c += 2) { RET_STEP(kA, vA, c); RET_STEP(kB, vB, c + 1); }
    __syncthreads();
}
#undef RET_ISSUE
#undef RET_STEP

constexpr int R3_K = 0, R3_Q = 32768, R3_V = 65536;
#define R3_ISSUE(u_) do { const int u__ = (u_); const size_t rw = (size_t)(u__ >> 7) * SEQ + (u__ & 31) * 128; const int hh = (u__ >> 5) & 3; \
        _Pragma("unroll") for (int i = 0; i < 4; ++i) { const int idx = tid + 512 * i, key = idx >> 4, ch = idx & 15; \
            kq[i] = *(const u32x4*)(proj + (rw + key) * INW + C_RK + hh * 128 + ch * 8); kq[4 + i] = *(const u32x4*)(proj + (rw + key) * INW + C_RQ + hh * 128 + ch * 8); } \
        _Pragma("unroll") for (int i = 0; i < 8; ++i) { const int idx = tid + 512 * i, key = idx >> 5, ch = idx & 31; vv[i] = *(const u32x4*)(proj + (rw + key) * INW + C_RV + hh * 256 + ch * 8); } } while (0)
__device__ __forceinline__ void out_phase(LAS unsigned char* lds, const bf16* __restrict__ proj, const bf16* __restrict__ states, bf16* __restrict__ yret, int G, int bx) {
    const int tid = threadIdx.x, lane = tid & 63, r32 = lane & 31, hi = lane >> 5; const int wave = __builtin_amdgcn_readfirstlane(tid >> 6);
    constexpr int NU = NB * 4 * 32;
    if (bx >= NU) return;
    u32x4 kq[8], vv[8];
    R3_ISSUE(bx);
    for (int u = bx; u < NU; u += G) {
        const int b = u >> 7, h = (u >> 5) & 3, tb = u & 31;
        const float lg = lg2gamma(h);
        const size_t row0 = (size_t)b * SEQ + tb * 128;
#pragma unroll
        for (int i = 0; i < 4; ++i) { const int idx = tid + 512 * i, key = idx >> 4, ch = idx & 15;
            *(LAS u32x4*)(lds + R3_K + ch * 2048 + key * 16) = kq[i]; *(LAS u32x4*)(lds + R3_Q + ch * 2048 + key * 16) = kq[4 + i]; }
#pragma unroll
        for (int i = 0; i < 8; ++i) { const int idx = tid + 512 * i, key = idx >> 5, ch = idx & 31; *(LAS u32x4*)(lds + R3_V + (ch >> 2) * 8192 + key * 64 + (ch & 3) * 16) = vv[i]; }
        if (u + G < NU) R3_ISSUE(u + G);
        __syncthreads();
        u32x2 pw[2][4];
#pragma unroll
        for (int ti = 0; ti < 2; ++ti) {
            const int t = wave + 8 * ti;
            if (t < 10) {
                const int a = (t >= 6) ? 3 : (t >= 3) ? 2 : (t >= 1) ? 1 : 0, bb = t - ((a * (a + 1)) >> 1);
                f32x16 p = {};
#pragma unroll
                for (int k = 0; k < 8; ++k) {
                    const bf16x8 kf = *(const LAS bf16x8*)(lds + R3_K + (2 * k + hi) * 2048 + (32 * bb + r32) * 16);
                    const bf16x8 qf = *(const LAS bf16x8*)(lds + R3_Q + (2 * k + hi) * 2048 + (32 * a + r32) * 16);
                    p = __builtin_amdgcn_mfma_f32_32x32x16_bf16(kf, qf, p, 0, 0, 0);
                }
                const float lanebase = lg * (float)(32 * (a - bb) + r32 - 4 * hi), cpos = -lg; const int tt = r32 - 4 * hi;
                float e[16];
#pragma unroll
                for (int r = 0; r < 16; ++r) { float v = p[r] * __builtin_amdgcn_exp2f(__builtin_fmaf(cpos, (float)crowc(r), lanebase)); if (bb == a) v = (crowc(r) <= tt) ? v : 0.f; e[r] = v; }
#pragma unroll
                for (int g = 0; g < 4; ++g) { pw[ti][g].x = pk2(e[4 * g], e[4 * g + 1]); pw[ti][g].y = pk2(e[4 * g + 2], e[4 * g + 3]); }
            }
        }
        __builtin_amdgcn_sched_barrier(0);
        bf16x8 sf[8];
        { const bf16* sb = states + (((size_t)(b * 4 + h) * 32 + tb) * 64 + (size_t)wave * 8) * 512 + lane * 8;
#pragma unroll
          for (int k = 0; k < 8; ++k) sf[k] = *(const bf16x8*)(sb + (size_t)k * 512); }
        bf16x8 vf[8];
        { LAS const unsigned char* vb = lds + R3_V + wave * 8192 + (8 * hi + ((lane & 15) >> 2)) * 64 + ((lane >> 4) & 1) * 32 + (lane & 3) * 8;
#pragma unroll
          for (int ks = 0; ks < 8; ++ks) { const s16x4 lo = vtr(vb + ks * 1024), hh = vtr(vb + ks * 1024 + 256); vf[ks] = (bf16x8){lo[0], lo[1], lo[2], lo[3], hh[0], hh[1], hh[2], hh[3]}; } }
        __syncthreads();
#pragma unroll
        for (int ti = 0; ti < 2; ++ti) {
            const int t = wave + 8 * ti;
            if (t < 10) {
                const int a = (t >= 6) ? 3 : (t >= 3) ? 2 : (t >= 1) ? 1 : 0, bb = t - ((a * (a + 1)) >> 1);
#pragma unroll
                for (int g = 0; g < 4; ++g) *(LAS u32x2*)(lds + R3_K + (4 * bb + g) * 2048 + (32 * a + r32) * 16 + hi * 8) = pw[ti][g];
            }
        }
        __syncthreads();
        LAS bf16* stg = (LAS bf16*)(lds + R3_V);
#pragma unroll 1
        for (int a = 0; a < 4; ++a) {
            f32x16 o = {};
#pragma unroll
            for (int ks = 0; ks < 8; ++ks) if (ks < 2 * (a + 1)) {
                const bf16x8 pa = *(const LAS bf16x8*)(lds + R3_K + (2 * ks + hi) * 2048 + (32 * a + r32) * 16);
                o = __builtin_amdgcn_mfma_f32_32x32x16_bf16(pa, vf[ks], o, 0, 0, 0);
            }
            f32x16 x = {};
#pragma unroll
            for (int k = 0; k < 8; ++k) { const bf16x8 qa = *(const LAS bf16x8*)(lds + R3_Q + (2 * k + hi) * 2048 + (32 * a + r32) * 16); x = __builtin_amdgcn_mfma_f32_32x32x16_bf16(qa, sf[k], x, 0, 0, 0); }
#pragma unroll
            for (int r = 0; r < 16; ++r) {
                const float din = __builtin_amdgcn_exp2f(lg * (float)(32 * a + crowc(r) + 4 * hi + 1));
                stg[(32 * a + crowc(r) + 4 * hi) * 256 + wave * 32 + r32] = f2bf(o[r] + din * x[r]);
            }
        }
        __syncthreads();
#pragma unroll 4
        for (int i = 0; i < 16; ++i) {
            const int q = wave * 16 + i;
            const u32x2 sw = *(const LAS u32x2*)(stg + q * 256 + lane * 4);
            const float v0 = __uint_as_float(sw.x << 16), v1 = __uint_as_float(sw.x & 0xffff0000u), v2 = __uint_as_float(sw.y << 16), v3 = __uint_as_float(sw.y & 0xffff0000u);
            const float ss = wave_sum((v0 * v0 + v1 * v1) + (v2 * v2 + v3 * v3));
            const float rs = rsqrtf(ss * (1.0f / 256.0f) + EPS);
            const u32x2 gw = *(const u32x2*)(proj + (row0 + q) * INW + C_RG + h * 256 + lane * 4);
            u32x2 w; w.x = pk2(v0 * rs * __uint_as_float(gw.x << 16), v1 * rs * __uint_as_float(gw.x & 0xffff0000u)); w.y = pk2(v2 * rs * __uint_as_float(gw.y << 16), v3 * rs * __uint_as_float(gw.y & 0xffff0000u));
            *(u32x2*)(yret + (row0 + q) * D + h * 256 + lane * 4) = w;
        }
        __syncthreads();
    }
}
#undef R3_ISSUE
}
template <bool FP8>
__device__ __forceinline__ void p0_item(const float* __restrict__ W, int K, int N, void* __restrict__ WT, int k0, int n0, int dst_row0, int lane) {
    const int kblk = lane >> 3, nq = lane & 7;
    const float* src = W + (size_t)(k0 + 16 * kblk) * N + n0 + 4 * nq;
    f32x4 v[16];
#pragma unroll
    for (int i = 0; i < 16; ++i) v[i] = *(const f32x4*)(src + (size_t)i * N);
#pragma unroll
    for (int j = 0; j < 4; ++j) {
        const size_t row = (size_t)(dst_row0 + 4 * nq + j);
        if constexpr (FP8) {
            u32x4 o;
            o.x = pk4_fp8(v[0][j] * W8_SCALE, v[1][j] * W8_SCALE, v[2][j] * W8_SCALE, v[3][j] * W8_SCALE); o.y = pk4_fp8(v[4][j] * W8_SCALE, v[5][j] * W8_SCALE, v[6][j] * W8_SCALE, v[7][j] * W8_SCALE);
            o.z = pk4_fp8(v[8][j] * W8_SCALE, v[9][j] * W8_SCALE, v[10][j] * W8_SCALE, v[11][j] * W8_SCALE); o.w = pk4_fp8(v[12][j] * W8_SCALE, v[13][j] * W8_SCALE, v[14][j] * W8_SCALE, v[15][j] * W8_SCALE);
            *(u32x4*)((unsigned char*)WT + row * K + k0 + 16 * kblk) = o;
        } else {
            u32x4 a, b;
            a.x = pk2(v[0][j], v[1][j]); a.y = pk2(v[2][j], v[3][j]); a.z = pk2(v[4][j], v[5][j]); a.w = pk2(v[6][j], v[7][j]);
            b.x = pk2(v[8][j], v[9][j]); b.y = pk2(v[10][j], v[11][j]); b.z = pk2(v[12][j], v[13][j]); b.w = pk2(v[14][j], v[15][j]);
            bf16* d = (bf16*)WT + row * K + k0 + 16 * kblk;
            *(u32x4*)d = a; *(u32x4*)(d + 8) = b;
        }
    }
}
#ifndef PROBE_PHASE
#define PROBE_PHASE (-1)
#endif
__device__ __forceinline__ void p0_transpose_item_fp8(const float* W, int K, int N, unsigned char* WT, int k0, int n0, int dst_row0, LAS float* scr, int lane) {
#pragma unroll 8
    for (int i = 0; i < 32; ++i) { const int kk = 2 * i + (lane >> 5); scr[kk * 33 + (lane & 31)] = W[(size_t)(k0 + kk) * N + n0 + (lane & 31)]; }
    LDS_WAIT(); asm volatile("" ::: "memory");
    const int c = lane & 3;
#pragma unroll
    for (int j = 0; j < 2; ++j) { const int n = (lane >> 2) + 16 * j; const LAS float* s = scr + (16 * c) * 33 + n;
        u32x4 o;
        o.x = pk4_fp8(s[0 * 33] * W8_SCALE, s[1 * 33] * W8_SCALE, s[2 * 33] * W8_SCALE, s[3 * 33] * W8_SCALE); o.y = pk4_fp8(s[4 * 33] * W8_SCALE, s[5 * 33] * W8_SCALE, s[6 * 33] * W8_SCALE, s[7 * 33] * W8_SCALE);
        o.z = pk4_fp8(s[8 * 33] * W8_SCALE, s[9 * 33] * W8_SCALE, s[10 * 33] * W8_SCALE, s[11 * 33] * W8_SCALE); o.w = pk4_fp8(s[12 * 33] * W8_SCALE, s[13 * 33] * W8_SCALE, s[14 * 33] * W8_SCALE, s[15 * 33] * W8_SCALE);
        *(u32x4*)(WT + (size_t)(dst_row0 + n) * K + k0 + 16 * c) = o; }
    LDS_WAIT(); asm volatile("" ::: "memory");
}
struct Args { const float* in[17]; float* out; unsigned char* ws; int ph_lo, ph_hi, li, pad; };

__global__ void __launch_bounds__(512, 2) mk_fwd(Args args) {
    extern __shared__ __attribute__((aligned(16))) unsigned char lds_raw[];
    LAS unsigned char* lds = (LAS unsigned char*)lds_raw;
    volatile LAS unsigned* MISC = (volatile LAS unsigned*)(lds + MISC_OFF);
    const int tid = threadIdx.x, lane = tid & 63, wave = __builtin_amdgcn_readfirstlane(tid >> 6);
    const int G = gridDim.x, bx = blockIdx.x;
    const int vcu = (G % 8 == 0) ? (bx % 8) * (G / 8) + bx / 8 : bx;
    unsigned char* ws = args.ws;
    unsigned* ctl = (unsigned*)(ws + WS_CTL);
    const float* x = args.in[0]; const float* meta = args.in[1]; const float* g1 = args.in[2]; const float* w_in = args.in[3];
    const float* qg = args.in[4]; const float* kg = args.in[5];
    const float* w_ab = args.in[7]; const float* w_rb = args.in[8]; const float* w_out = args.in[9];
    const float* w_gu = args.in[13]; const float* b_gu = args.in[14]; const float* w_dn = args.in[15]; const float* b_dn = args.in[16];
    float* out = args.out;
    bf16* Win_t = (bf16*)(ws + WS_WIN); bf16* Wab_t = (bf16*)(ws + WS_WAB); bf16* Wrb_t = (bf16*)(ws + WS_WRB); bf16* Wout_t = (bf16*)(ws + WS_WOUT);
    unsigned char* Wgu_t = ws + WS_WGU; unsigned char* Wdn_t = ws + WS_WDN;
    bf16* xb = (bf16*)(ws + WS_XB); bf16* proj = (bf16*)(ws + WS_PROJ); bf16* yatt = (bf16*)(ws + WS_YATT); bf16* yret = (bf16*)(ws + WS_YRET); bf16* merged = (bf16*)(ws + WS_MERGED);
    bf16* pmeta = proj + (size_t)NTOK * INW;
    const float* sinks = args.in[6]; const float* g2 = args.in[10]; const float* w_r = args.in[11]; const float* b_r = args.in[12];
    int* tke = (int*)(ws + SM_TKE); float* tkw = (float*)(ws + SM_TKW); int* tkpos = (int*)(ws + SM_TKPOS); int* list = (int*)(ws + SM_LIST); float* wlist = (float*)(ws + SM_WLIST);
    LAS unsigned char* misc = lds + MISC_OFF;
    bf16* states = (bf16*)(ws + ret::WS_STATES);
    unsigned char* act = ws + WS_ACT; unsigned char* rows = ws + WS_ROWS; unsigned char* xn8 = ws + WS_XB;

    for (int u = tid; u < (LDS_BYTES - MISC_OFF) / 4; u += 512) ((LAS unsigned*)(lds + MISC_OFF))[u] = 0u;
    __syncthreads();
    XcdBarrier bar = xcd_barrier_post(ctl + CW_BAR + args.li * XCD_BAR_WORDS, MISC + 8);
    const int lo = args.ph_lo, hi = args.ph_hi;
#define IN(k) (lo <= (k) && (k) < hi)
#define BOTH(k) (IN(k) && IN((k) + 1))
#define GRID_BAR() xcd_barrier(bar)

    if (IN(0)) { for (int rep_ = 0; rep_ < ((PROBE_PHASE == 0) ? 2 : 1); ++rep_) {
        const int gw = vcu * NWAVES + wave, NGW = G * NWAVES;
        constexpr int I_IN = 8 * 200, I_SQ = 8 * 32, I_GU = 32 * 8 * 64, I_DN = 32 * 8 * 32;
        constexpr int NITEMS = I_IN + 3 * I_SQ + I_GU + I_DN;
        for (int rep2_ = 0; rep2_ < ((PROBE_PHASE == 100) ? 2 : 1); ++rep2_)
        for (int it = gw; it < NITEMS; it += NGW) {
            int r = it;
            if (r < I_IN) { const int kb = r / 200, nb = r % 200, n0 = nb * 32, o = n0 & 255, wcc = o >> 6, bj = (o >> 5) & 1;
                p0_item<false>(w_in, D, INW, Win_t, kb * 128, n0, (n0 & ~255) + 128 * bj + 32 * wcc, lane); continue; }
            r -= I_IN;
            if (r < I_SQ) { p0_item<false>(w_ab, D, D, Wab_t, (r / 32) * 128, (r % 32) * 32, (r % 32) * 32, lane); continue; } r -= I_SQ;
            if (r < I_SQ) { p0_item<false>(w_rb, D, D, Wrb_t, (r / 32) * 128, (r % 32) * 32, (r % 32) * 32, lane); continue; } r -= I_SQ;
            if (r < I_SQ) { p0_item<false>(w_out, D, D, Wout_t, (r / 32) * 128, (r % 32) * 32, (r % 32) * 32, lane); continue; } r -= I_SQ;
            if (r < I_GU) { const int e = r / 512, q = r % 512, kb = q / 64, nb = q % 64, n0 = nb * 32, bj = n0 >> 10, rem = n0 & 1023, pn = rem >> 7, cl = rem & 127;
                p0_item<true>(w_gu + (size_t)e * D * 2048, D, 2048, Wgu_t + (size_t)e * 2048 * D, kb * 128, n0, 256 * pn + 128 * bj + cl, lane); continue; }
            r -= I_GU;
            { const int e = r / 256, q = r % 256, kb = q / 32, nb = q % 32;
              p0_item<true>(w_dn + (size_t)e * DFF * D, DFF, D, Wdn_t + (size_t)e * D * DFF, kb * 128, nb * 32, nb * 32, lane); }
        }
        for (int rep2_ = 0; rep2_ < ((PROBE_PHASE == 101) ? 2 : 1); ++rep2_)
        for (int row = gw; row < NTOK; row += NGW) {
            const f32x4* xr = (const f32x4*)(x + (size_t)row * D) + lane;
            f32x4 v[4]; float ss = 0.f;
#pragma unroll
            for (int j = 0; j < 4; ++j) { v[j] = xr[64 * j]; ss += (v[j][0] * v[j][0] + v[j][1] * v[j][1]) + (v[j][2] * v[j][2] + v[j][3] * v[j][3]); }
            const float rstd = rsqrtf(wave_sum(ss) * (1.0f / D) + EPS);
            u32x2* o8 = (u32x2*)(xb + (size_t)row * D) + lane;
#pragma unroll
            for (int j = 0; j < 4; ++j) { const f32x4 gg = ((const f32x4*)g1)[64 * j + lane]; u32x2 w; w.x = pk2(v[j][0] * rstd * gg[0], v[j][1] * rstd * gg[1]); w.y = pk2(v[j][2] * rstd * gg[2], v[j][3] * rstd * gg[3]); o8[64 * j] = w; }
        }
        for (int row = gw; row < 256; row += NGW) {
            u32x2* o8 = (u32x2*)(xb + (size_t)(NTOK + row) * D) + lane;
            if (row < NMETA) {
                const f32x4* xr = (const f32x4*)(meta + (size_t)row * D) + lane;
                f32x4 v[4]; float ss = 0.f;
#pragma unroll
                for (int j = 0; j < 4; ++j) { v[j] = xr[64 * j]; ss += (v[j][0] * v[j][0] + v[j][1] * v[j][1]) + (v[j][2] * v[j][2] + v[j][3] * v[j][3]); }
                const float rstd = rsqrtf(wave_sum(ss) * (1.0f / D) + EPS);
#pragma unroll
                for (int j = 0; j < 4; ++j) { const f32x4 gg = ((const f32x4*)g1)[64 * j + lane]; u32x2 w; w.x = pk2(v[j][0] * rstd * gg[0], v[j][1] * rstd * gg[1]); w.y = pk2(v[j][2] * rstd * gg[2], v[j][3] * rstd * gg[3]); o8[64 * j] = w; }
            } else {
#pragma unroll
                for (int j = 0; j < 4; ++j) o8[64 * j] = (u32x2){0u, 0u};
            }
        }
        __syncthreads(); }
        if (BOTH(0)) GRID_BAR();
    }
    if (IN(1)) {
        SchedDense S; S.init(xb, Win_t, NTOK + 256, INW, D, G, bx);
        EpiProj E{proj, qg, kg};
        for (int rep_ = 0; rep_ < ((PROBE_PHASE == 1) ? 2 : 1); ++rep_) pg8::gemm_phase<EpiProj, SchedDense>(lds, 2 * D, S, E);
        if (BOTH(1)) GRID_BAR();
    }
    if (IN(2)) {
        float mq = fabsf(qg[lane]), mk = fabsf(kg[lane]);
#pragma unroll
        for (int o = 1; o < 64; o <<= 1) { mq = fmaxf(mq, __shfl_xor(mq, o)); mk = fmaxf(mk, __shfl_xor(mk, o)); }
        const float bshift = 8.0f * mq * mk;
        for (int rep_ = 0; rep_ < ((PROBE_PHASE == 20) ? 2 : 1); ++rep_) attn::phase(lds, proj, pmeta, sinks, bshift, yatt, G, bx);
        for (int rep_ = 0; rep_ < ((PROBE_PHASE == 21) ? 2 : 1); ++rep_) for (int u = bx; u < NB * 4 * 8; u += G) { const int v = ((G & 7) == 0 && G == 256) ? ((u & 7) * 32 + (u >> 3)) : u;
            ret::state_chain(lds, v >> 5, (v >> 3) & 3, v & 7, proj, pmeta, states); }
        if (BOTH(2)) GRID_BAR();
    }
    if (IN(3)) {
        for (int rep_ = 0; rep_ < ((PROBE_PHASE == 3) ? 2 : 1); ++rep_) ret::out_phase(lds, proj, states, yret, G, bx);
        if (BOTH(3)) GRID_BAR();
    }
    if (IN(4)) {
        SchedBranch S{(const char*)yatt, (const char*)yret, (const char*)Wab_t, (const char*)Wrb_t, G, bx};
        EpiBranch E{merged, proj};
        for (int rep_ = 0; rep_ < ((PROBE_PHASE == 4) ? 2 : 1); ++rep_) pg8::gemm_phase<EpiBranch, SchedBranch>(lds, 2 * D, S, E);
        if (BOTH(4)) GRID_BAR();
    }
    if (IN(5)) {
        SchedDense S; S.init(merged, Wout_t, NTOK, D, D, G, bx);
        EpiOut E{x, out};
        for (int rep_ = 0; rep_ < ((PROBE_PHASE == 5) ? 2 : 1); ++rep_) pg8::gemm_phase<EpiOut, SchedDense>(lds, 2 * D, S, E);
        if (BOTH(5)) GRID_BAR();
    }
    if (IN(6)) {
        route_phase(lds, out, g2, w_r, b_r, xn8, tke, tkpos, tkw, list, wlist, ctl + CW_CNT, G, bx);
        if (BOTH(6)) GRID_BAR();
    }
    if (hi > 7 && lo <= 9) moe_tables(misc, ctl + CW_CNT);
    if (IN(7)) {
        SchedMoe<true, 8> S{(const char*)xn8, (const char*)Wgu_t, misc, list, G, bx};
        EpiGU E{act, b_gu};
        for (int rep_ = 0; rep_ < ((PROBE_PHASE == 7) ? 2 : 1); ++rep_) pg8::gemm_phase<EpiGU, SchedMoe<true, 8>, true>(lds, D, S, E);
        if (BOTH(7)) GRID_BAR();
    }
    if (IN(8)) {
        SchedMoe<false, 4> S{(const char*)act, (const char*)Wdn_t, misc, list, G, bx};
        EpiDown E{rows, b_dn, wlist, misc};
        for (int rep_ = 0; rep_ < ((PROBE_PHASE == 8) ? 2 : 1); ++rep_) pg8::gemm_phase<EpiDown, SchedMoe<false, 4>, true>(lds, DFF, S, E);
        if (BOTH(8)) GRID_BAR();
    }
    if (IN(9)) combine_phase(misc, (void*)proj, out, rows, tke, tkpos, vcu * NWAVES + wave, G * NWAVES, lane);
#undef IN
#undef BOTH
#undef GRID_BAR
}

extern "C" void kernel_launch(void* const* d_in, const int* in_sizes, int n_in, void* d_out, int out_size, void* d_ws, size_t ws_size, hipStream_t stream) {
    static int grid = 0;
    if (grid == 0) {
        if (n_in != 17 || in_sizes[0] != NTOK * D || out_size != NTOK * D || ws_size < WS_END) {
            fprintf(stderr, "kernel_launch: unexpected shapes (n_in %d in0 %d out %d ws %zu)\n", n_in, n_in > 0 ? in_sizes[0] : -1, out_size, ws_size); grid = -1; return; }
        int dev = 0, cus = 0;
        if (hipGetDevice(&dev) != hipSuccess || hipDeviceGetAttribute(&cus, hipDeviceAttributeMultiprocessorCount, dev) != hipSuccess) { grid = -1; return; }
        if (hipFuncSetAttribute((const void*)mk_fwd, hipFuncAttributeMaxDynamicSharedMemorySize, LDS_BYTES) != hipSuccess) { fprintf(stderr, "kernel_launch: hipFuncSetAttribute failed\n"); grid = -1; return; }
        grid = cus;
    }
    if (grid < 0) return;
    unsigned char* ws = (unsigned char*)d_ws;
    (void)hipMemsetAsync(ws + WS_CTL, 0, 1 * MiB, stream);
    Args a{};
    for (int i = 0; i < 17; ++i) a.in[i] = (const float*)d_in[i];
    a.out = (float*)d_out; a.ws = ws; a.ph_lo = 0; a.ph_hi = 10; a.li = 0; a.pad = 0;
    hipLaunchKernelGGL(mk_fwd, dim3(grid), dim3(512), LDS_BYTES, stream, a);
}
```

```cpp
#include <hip/hip_runtime.h>
#include <cstdio>
#include <cstdint>

typedef unsigned short bf16;
__device__ __forceinline__ float bf2f(bf16 v) { return __uint_as_float(((unsigned)v) << 16); }
__device__ __forceinline__ bf16 f2bf(float f) { const __bf16 b = (__bf16)f; return __builtin_bit_cast(unsigned short, b); }
__device__ __forceinline__ float sigmoidf_(float x) { return __builtin_amdgcn_rcpf(1.0f + __builtin_amdgcn_exp2f(-1.4426950408889634f * x)); }

constexpr int NB = 8, SEQ = 4096, D = 1024, NTOK = NB * SEQ;
constexpr int NMETA = 16;
constexpr int INW = 6400;
constexpr int C_AQ = 0, C_AK = 1024, C_AV = 1152, C_RQ = 1280, C_RK = 1792, C_RV = 2304, C_RG = 3328, C_GA = 4352, C_GR = 5376;
constexpr int NE = 32, TOPK = 4, DFF = 1024;
constexpr int NROWS = (NTOK * TOPK / 256 + NE) * 256;
constexpr int NTILE = NROWS / 256;
constexpr float EPS = 1e-5f;

constexpr size_t MiB = 1u << 20;
constexpr size_t WS_CTL = 0;
constexpr size_t WS_SMALL = 1 * MiB;
constexpr size_t WS_W = 16 * MiB;
constexpr size_t WS_XB = 232 * MiB;
constexpr size_t WS_PROJ = 297 * MiB;
constexpr size_t WS_YATT = 701 * MiB;
constexpr size_t WS_YRET = 765 * MiB;
constexpr size_t WS_MERGED = 829 * MiB;
constexpr size_t WS_END = 1020 * MiB;
constexpr size_t WS_ACT = 297 * MiB;
constexpr size_t WS_ROWS = 568 * MiB;
constexpr size_t SM_UMETA = WS_SMALL;
constexpr size_t SM_PMETA = WS_SMALL + 64 * 1024;
constexpr size_t SM_TKE = WS_SMALL + 512 * 1024;
constexpr size_t SM_TKW = SM_TKE + 512 * 1024;
constexpr size_t SM_TKPOS = SM_TKW + 512 * 1024;
constexpr size_t SM_TKROW = SM_TKPOS + 512 * 1024;
constexpr size_t SM_ROWTOK = SM_TKROW + 512 * 1024;
constexpr size_t SM_ROWW = SM_ROWTOK + 1024 * 1024;
constexpr size_t SM_TILEE = SM_ROWW + 1024 * 1024;
constexpr int CW_CNT = 1024;

#define LAS __attribute__((address_space(3)))
#define GAS __attribute__((address_space(1)))
typedef short bf16x8 __attribute__((ext_vector_type(8)));
typedef float f32x4 __attribute__((ext_vector_type(4)));
typedef float f32x2 __attribute__((ext_vector_type(2)));
typedef unsigned u32x4 __attribute__((ext_vector_type(4)));
typedef unsigned u32x2 __attribute__((ext_vector_type(2)));
#define LDS_WAIT() asm volatile("s_waitcnt lgkmcnt(0)" ::: "memory")
#define VM_WAIT() asm volatile("s_waitcnt vmcnt(0)" ::: "memory")
typedef __bf16 bf16x2_t __attribute__((ext_vector_type(2)));
__device__ __forceinline__ unsigned pk2(float lo, float hi) { const f32x2 v = {lo, hi}; const bf16x2_t b = __builtin_convertvector(v, bf16x2_t); return __builtin_bit_cast(unsigned, b); }
__device__ __forceinline__ unsigned pk4_fp8(float a, float b, float c, float d) { int w = __builtin_amdgcn_cvt_pk_fp8_f32(a, b, 0, false); w = __builtin_amdgcn_cvt_pk_fp8_f32(c, d, w, true); return (unsigned)w; }
constexpr float W8_SCALE = 64.0f, W8_INV = 1.0f / 64.0f;
constexpr float ROW8_SCALE = 16.0f, ROW8_INV = 1.0f / 16.0f;
__device__ __forceinline__ float wave_sum(float v) {
#pragma unroll
    for (int o = 1; o < 64; o <<= 1) v += __shfl_xor(v, o);
    return v;
}

constexpr size_t WS_WIN = WS_W;
constexpr size_t WS_WAB = WS_W + 13 * MiB;
constexpr size_t WS_WRB = WS_W + 15 * MiB;
constexpr size_t WS_WOUT = WS_W + 17 * MiB;
constexpr size_t WS_WGU = WS_W + 19 * MiB;
constexpr size_t WS_WDN = WS_W + 147 * MiB;
static_assert(WS_WDN + 64 * MiB <= WS_XB, "weight map");
constexpr size_t SM_ATILE = SM_TILEE + 4096;
constexpr int CW_NACT = 1088;
constexpr int CW_BAR = 4096;

constexpr int RING_BYTES = 131072;
constexpr int MISC_OFF = RING_BYTES;
constexpr int LDS_BYTES = 147456;
constexpr int NWAVES = 8;

#define XB_TMO      128
#define XB_XCNT(j)  (256  + 64 * (j))
#define XB_XSUB(j)  (1280 + 64 * (j))
#define XB_XGEN(j)  (2304 + 64 * (j))
#define XB_TOP      3328
#define XB_TOPGEN   3392
#define XCD_BAR_WORDS 3456
#define XB_SPIN_CAP (1u << 20)
__device__ __forceinline__ unsigned xb_ld(unsigned* p)              { return __hip_atomic_load(p, __ATOMIC_RELAXED, __HIP_MEMORY_SCOPE_AGENT); }
__device__ __forceinline__ unsigned xb_add(unsigned* p, unsigned v) { return __hip_atomic_fetch_add(p, v, __ATOMIC_RELAXED, __HIP_MEMORY_SCOPE_AGENT); }
__device__ __forceinline__ unsigned xb_xcc_id() { return (unsigned)__builtin_amdgcn_s_getreg((3 << 11) | 20) & 0xFu; }
#define XB_SPIN(cond, bar) do { unsigned _sp = 0; while (cond) { __builtin_amdgcn_s_sleep(1); \
    if ((++_sp & 255u) == 0u) { if (xb_ld(&(bar)[XB_TMO])) break; if (_sp > XB_SPIN_CAP) { atomicAdd(&(bar)[XB_TMO], 1u); break; } } } } while (0)
struct XcdBarrier { unsigned* bar; unsigned x; volatile LAS unsigned* st; };
__device__ __forceinline__ XcdBarrier xcd_barrier_post(unsigned* bar, volatile LAS unsigned* st) {
    XcdBarrier b; b.bar = bar; b.x = xb_xcc_id(); b.st = st;
    if (threadIdx.x == 0) (void)xb_add(&bar[XB_XCNT(b.x)], 1u);
    return b;
}
__device__ __forceinline__ void xcd_barrier_complete(unsigned* bar, unsigned x, unsigned& nloc, unsigned& nx) {
    const unsigned G = gridDim.x * gridDim.y * gridDim.z;
    unsigned sum, cnt, mine, sp = 0u;
    for (;;) {
        sum = 0u; cnt = 0u; mine = 0u;
#pragma unroll
        for (unsigned j = 0; j < 16; ++j) { const unsigned c = xb_ld(&bar[XB_XCNT(j)]); sum += c; cnt += (c > 0u) ? 1u : 0u; mine = (j == x) ? c : mine; }
        if (sum == G) break;
        __builtin_amdgcn_s_sleep(1);
        if ((++sp & 255u) == 0u) { if (xb_ld(&bar[XB_TMO])) break; if (sp > XB_SPIN_CAP) { atomicAdd(&bar[XB_TMO], 1u); break; } }
    }
    nloc = mine > 0u ? mine : 1u; nx = cnt > 0u ? cnt : 1u;
}
__device__ __forceinline__ void xcd_barrier(const XcdBarrier& b) {
    asm volatile("s_waitcnt vmcnt(0)" ::: "memory");
    __syncthreads();
    if (threadIdx.x == 0) {
        unsigned* bar = b.bar;
        __builtin_amdgcn_s_waitcnt(0);
        unsigned nloc = b.st[0], nx = b.st[1];
        if (nloc == 0u) { xcd_barrier_complete(bar, b.x, nloc, nx); b.st[0] = nloc; b.st[1] = nx; }
        const unsigned old = xb_add(&bar[XB_XSUB(b.x)], 1u);
        const unsigned gen = old / nloc;
        if (old + 1u == (gen + 1u) * nloc) {
            __builtin_amdgcn_fence(__ATOMIC_RELEASE, "agent");
            asm volatile("s_waitcnt vmcnt(0)" ::: "memory");
            const unsigned og = xb_add(&bar[XB_TOP], 1u);
            const unsigned tg = og / nx;
            if (og + 1u == (tg + 1u) * nx) xb_add(&bar[XB_TOPGEN], 1u);
            else XB_SPIN(xb_ld(&bar[XB_TOPGEN]) == tg, bar);
            __builtin_amdgcn_fence(__ATOMIC_ACQUIRE, "agent");
            xb_add(&bar[XB_XGEN(b.x)], 1u);
            asm volatile("s_waitcnt vmcnt(0)" ::: "memory");
        } else {
            XB_SPIN(xb_ld(&bar[XB_XGEN(b.x)]) == gen, bar);
            __builtin_amdgcn_fence(__ATOMIC_ACQUIRE, "agent");
            asm volatile("s_waitcnt vmcnt(0)" ::: "memory");
        }
    }
    __syncthreads();
}

namespace pg8 {
constexpr int BM = 256, BK = 64, HALF = 128, HTB = HALF * BK * 2, STAGE_BYTES = 8 * HTB;
__host__ __device__ __forceinline__ int lds_byte(int r, int c) { const int st = (r >> 4) * 2 + (c >> 5), rr = r & 15, cc = c & 31, ob = rr * 64 + cc * 2; return st * 1024 + (ob ^ (((ob >> 9) & 1) << 5)); }
__host__ __device__ __forceinline__ void stage_rc(int b, int& R, int& C) { const int st = b / 1024, sb = b % 1024, swz = sb ^ (((sb >> 9) & 1) << 5); R = (st >> 1) * 16 + swz / 64; C = (st & 1) * 32 + (swz % 64) / 2; }
__host__ __device__ __forceinline__ int perm32(int rho) { const int n = rho >> 4, i = rho & 15; return 8 * (i >> 2) + 4 * n + (i & 3); }
struct Unit { int pm, pn, aux, tl; const char* A; const char* B; };
typedef f32x4 Acc[2][2][4][2];
typedef int u32x4_i __attribute__((ext_vector_type(4)));

typedef int v8i32 __attribute__((ext_vector_type(8)));
template <class Epi, class Sched, bool FP8 = false>
__device__ __forceinline__ void gemm_phase(LAS unsigned char* lds, const int Kb, const Sched& S, const Epi& E) {
    const int tid = threadIdx.x, wid = __builtin_amdgcn_readfirstlane(tid >> 6), lane = tid & 63, wr = wid >> 2, wc = wid & 3, fr = lane & 15, fq = lane >> 4;
    const int nt = Kb / 128;
    int RA[2], CA[2]; unsigned voffB[2];
#pragma unroll
    for (int i = 0; i < 2; ++i) { int R, C; stage_rc(tid * 16 + i * 8192, R, C); const int Rb = Epi::PERM ? ((R & ~31) + perm32(R & 31)) : R;
        RA[i] = R; CA[i] = C; voffB[i] = (unsigned)(Rb * Kb + C * 2); }
    const size_t kstep = (size_t)(BK * 2);
    const size_t hstep = (size_t)HALF * Kb;
    const unsigned ldsw = (unsigned)wid * 1024u;
    const int aoff = lds_byte(wr * 64 + fr, fq * 8), boff = lds_byte(wc * 32 + fr, fq * 8);
#define PG8_SA(b, h) (((b) * 2 + (h)) * HTB)
#define PG8_SB(b, h) ((4 + (b) * 2 + (h)) * HTB)
#define PG8_STAGE(bufoff, gbase, voff) do { _Pragma("unroll") for (int _i = 0; _i < 2; ++_i) \
        __builtin_amdgcn_global_load_lds((const unsigned*)((const char*)(gbase) + (voff)[_i]), (LAS unsigned*)(lds + (bufoff) + ldsw + _i * 8192), 16, 0, 0); } while (0)
#define PG8_LDA(dst, b, h) do { _Pragma("unroll") for (int m = 0; m < 4; ++m) _Pragma("unroll") for (int k = 0; k < 2; ++k) dst[m][k] = *(const LAS bf16x8*)(lds + PG8_SA(b, h) + aoff + m * 2048 + k * 1024); } while (0)
#define PG8_LDB(dst, b, h) do { _Pragma("unroll") for (int n = 0; n < 2; ++n) _Pragma("unroll") for (int k = 0; k < 2; ++k) dst[n][k] = *(const LAS bf16x8*)(lds + PG8_SB(b, h) + boff + n * 2048 + k * 1024); } while (0)
#define PG8_MMA(ai, bj, At, Bt) do { __builtin_amdgcn_s_setprio(1); _Pragma("unroll") for (int m = 0; m < 4; ++m) _Pragma("unroll") for (int n = 0; n < 2; ++n) { \
        if constexpr (FP8) { const v8i32 bq = __builtin_shufflevector(__builtin_bit_cast(u32x4_i, Bt[n][0]), __builtin_bit_cast(u32x4_i, Bt[n][1]), 0, 1, 2, 3, 4, 5, 6, 7), \
                                         aq = __builtin_shufflevector(__builtin_bit_cast(u32x4_i, At[m][0]), __builtin_bit_cast(u32x4_i, At[m][1]), 0, 1, 2, 3, 4, 5, 6, 7); \
            asm volatile("v_mfma_scale_f32_16x16x128_f8f6f4 %0, %1, %2, %0, %3, %3 op_sel_hi:[0,0,0]" : "+v"(acc[ai][bj][m][n]) : "v"(bq), "v"(aq), "v"(scale1)); } \
        else { _Pragma("unroll") for (int k = 0; k < 2; ++k) acc[ai][bj][m][n] = __builtin_amdgcn_mfma_f32_16x16x32_bf16(Bt[n][k], At[m][k], acc[ai][bj][m][n], 0, 0, 0); } } \
        __builtin_amdgcn_s_setprio(0); } while (0)
#define PG8_WAIT_V(n) asm volatile("s_waitcnt vmcnt(" #n ")" ::: "memory")
#define PG8_WAIT_L(n) asm volatile("s_waitcnt lgkmcnt(" #n ")" ::: "memory")
#define PG8_BAR __builtin_amdgcn_s_barrier()
#define PG8_SCHED __builtin_amdgcn_sched_barrier(0)
    int scale1 = 0x7f7f7f7f; asm volatile("" : "+v"(scale1));
    Unit cur, nxt; int ui = 0;
    if (!S.next(0, cur)) return;
    unsigned ca[2][2], na[2][2];
    S.aoff(cur, RA, CA, ca);
    f32x4 acc[2][2][4][2];
#pragma unroll
    for (int a = 0; a < 2; ++a)
#pragma unroll
        for (int b = 0; b < 2; ++b)
#pragma unroll
            for (int m = 0; m < 4; ++m)
#pragma unroll
                for (int n = 0; n < 2; ++n) acc[a][b][m][n] = (f32x4){0.f, 0.f, 0.f, 0.f};
    bf16x8 At[4][2], B0[2][2], B1[2][2];
    const char* cA = cur.A; const char* cB = cur.B;
    E.prefetch(cur, 0, wid, lane);
    PG8_STAGE(PG8_SB(0, 0), cB, voffB); PG8_STAGE(PG8_SB(0, 1), cB + hstep, voffB); PG8_STAGE(PG8_SA(0, 0), cA, ca[0]); PG8_STAGE(PG8_SA(0, 1), cA, ca[1]);
    if (wr == 1) PG8_BAR;
    PG8_WAIT_V(2); PG8_BAR;
    PG8_STAGE(PG8_SB(1, 0), cB + kstep, voffB); PG8_STAGE(PG8_SA(1, 0), cA + kstep, ca[0]); PG8_STAGE(PG8_SB(1, 1), cB + hstep + kstep, voffB);
    PG8_WAIT_V(6); PG8_BAR;
    for (;;) {
        const bool has_next = S.next(ui + 1, nxt);
        if constexpr (Sched::GATHER) {
            if (has_next) S.aoff(nxt, RA, CA, na);
            else {
#pragma unroll
                for (int h = 0; h < 2; ++h)
#pragma unroll
                    for (int i = 0; i < 2; ++i) na[h][i] = ca[h][i];
            }
        }
        const char* nA = has_next ? nxt.A : cA; const char* nB = has_next ? nxt.B : cB;
#pragma nounroll
        for (int t = 0; t < nt; t += 2) {
            const bool last = (t == nt - 2);
            const char* a1 = cA + (size_t)(t + 1) * kstep;
            const char* a2 = last ? nA : cA + (size_t)(t + 2) * kstep; const char* b2 = last ? nB : cB + (size_t)(t + 2) * kstep;
            const char* a3 = a2 + kstep; const char* b3 = b2 + kstep;
            unsigned o2[2][2];
#pragma unroll
            for (int h = 0; h < 2; ++h)
#pragma unroll
                for (int i = 0; i < 2; ++i) { if constexpr (Sched::GATHER) o2[h][i] = last ? na[h][i] : ca[h][i]; else o2[h][i] = ca[h][i]; }
            PG8_LDB(B0, 0, 0); PG8_LDB(B1, 0, 1); PG8_SCHED; PG8_LDA(At, 0, 0); PG8_STAGE(PG8_SA(1, 1), a1, ca[1]);
            PG8_WAIT_V(8); PG8_WAIT_L(0); PG8_BAR; PG8_MMA(0, 0, At, B0); PG8_MMA(0, 1, At, B1); PG8_BAR; PG8_SCHED;
            PG8_LDA(At, 0, 1); PG8_STAGE(PG8_SB(0, 0), b2, voffB); PG8_STAGE(PG8_SB(0, 1), b2 + hstep, voffB); PG8_STAGE(PG8_SA(0, 0), a2, o2[0]);
            PG8_WAIT_V(8); PG8_WAIT_L(0); PG8_BAR; PG8_MMA(1, 0, At, B0); PG8_MMA(1, 1, At, B1); PG8_BAR; PG8_SCHED;
            PG8_LDB(B0, 1, 0); PG8_LDB(B1, 1, 1); PG8_SCHED; PG8_LDA(At, 1, 0); PG8_STAGE(PG8_SA(0, 1), a2, o2[1]);
            PG8_WAIT_V(8); PG8_WAIT_L(0); PG8_BAR; PG8_MMA(0, 0, At, B0); PG8_MMA(0, 1, At, B1); PG8_BAR; PG8_SCHED;
            PG8_LDA(At, 1, 1); PG8_STAGE(PG8_SB(1, 0), b3, voffB); PG8_STAGE(PG8_SB(1, 1), b3 + hstep, voffB); PG8_STAGE(PG8_SA(1, 0), a3, o2[0]);
            PG8_WAIT_V(8); PG8_WAIT_L(0); PG8_BAR; PG8_MMA(1, 0, At, B0); PG8_MMA(1, 1, At, B1); PG8_BAR; PG8_SCHED;
        }
        if constexpr (FP8) { asm volatile("s_nop 15\n\ts_nop 15\n\ts_nop 15" ::: "memory"); PG8_SCHED; }
        if (wr == 0) PG8_BAR;
        E(acc, cur, wr, wc, fr, fq, ui & 1);
        if (!has_next) break;
#pragma unroll
        for (int a = 0; a < 2; ++a)
#pragma unroll
            for (int b = 0; b < 2; ++b)
#pragma unroll
                for (int m = 0; m < 4; ++m)
#pragma unroll
                    for (int n = 0; n < 2; ++n) acc[a][b][m][n] = (f32x4){0.f, 0.f, 0.f, 0.f};
        cur = nxt; cA = nA; cB = nB; ++ui;
        E.prefetch(cur, ui & 1, wid, lane);
        if constexpr (Sched::GATHER) {
#pragma unroll
            for (int h = 0; h < 2; ++h)
#pragma unroll
                for (int i = 0; i < 2; ++i) ca[h][i] = na[h][i];
        }
        if (wr == 1) PG8_BAR;
    }
    PG8_WAIT_V(0);
    PG8_BAR;
#undef PG8_SA
#undef PG8_SB
#undef PG8_STAGE
#undef PG8_LDA
#undef PG8_LDB
#undef PG8_MMA
#undef PG8_WAIT_V
#undef PG8_WAIT_L
#undef PG8_BAR
#undef PG8_SCHED
}
}
#ifndef PROBE_PHASE
#define PROBE_PHASE (-1)
#endif
constexpr size_t SM_LIST = WS_SMALL + 2 * MiB;
constexpr size_t SM_WLIST = WS_SMALL + 6 * MiB;
constexpr size_t SM_RLIST = WS_SMALL + 10 * MiB;
constexpr int MT_PSTART = 256;
constexpr int MT_CNT = 512;
constexpr int MT_NACT = 768;
constexpr int MT_ATILE = 1024;
constexpr int MT_HIST = 4096;
constexpr int MT_BASE = 4224;
constexpr int MT_REC = 4352;
constexpr int MT_RSTD = 10496;
constexpr int MT_EPI = 11264;

__device__ __forceinline__ void moe_tables(LAS unsigned char* misc, const unsigned* cnt) {
    LAS int* pstart = (LAS int*)(misc + MT_PSTART); LAS int* cl = (LAS int*)(misc + MT_CNT); LAS int* at = (LAS int*)(misc + MT_ATILE);
    __syncthreads();
    if (threadIdx.x < 64) {
        const int lane = threadIdx.x, e = lane & 31;
        const int c = (int)__hip_atomic_load(cnt + e, __ATOMIC_RELAXED, __HIP_MEMORY_SCOPE_AGENT), nt = (c + 255) >> 8;
        int incl = nt;
#pragma unroll
        for (int o = 1; o < 32; o <<= 1) { const int v = __shfl_up(incl, o); if (e >= o) incl += v; }
        const int t0 = incl - nt;
        if (lane < 32) { cl[e] = c; pstart[e] = t0 << 8; for (int t = 0; t < nt; ++t) at[t0 + t] = (t0 + t) | (e << 12) | (t << 20);
            if (e == 31) { pstart[NE] = incl << 8; *(LAS int*)(misc + MT_NACT) = incl; } }
    }
    __syncthreads();
}

__device__ __forceinline__ void route_phase(LAS unsigned char* lds, const float* __restrict__ h2, const float* __restrict__ g2, const float* __restrict__ wr, const float* __restrict__ br,
                                            unsigned char* __restrict__ xg8, int* __restrict__ tke, int* __restrict__ tkpos, float* __restrict__ tkw, int* __restrict__ list, float* __restrict__ wlist,
                                            float* __restrict__ rlist, unsigned* __restrict__ cnt, int G, int bx) {
    typedef float f32x16 __attribute__((ext_vector_type(16)));
    const int tid = threadIdx.x, lane = tid & 63, r32 = lane & 31, hi = lane >> 5; const int wave = __builtin_amdgcn_readfirstlane(tid >> 6);
    LAS unsigned char* misc = lds + MISC_OFF;
    LAS int* hist = (LAS int*)(misc + MT_HIST); LAS int* base = (LAS int*)(misc + MT_BASE); LAS int* rec = (LAS int*)(misc + MT_REC); LAS float* rstd_l = (LAS float*)(misc + MT_RSTD);
    for (int idx = tid; idx < 128 * 32; idx += 512) {
        const int c = idx >> 5, e = idx & 31; float v[8]; unsigned hw[4], lw[4];
#pragma unroll
        for (int j = 0; j < 8; ++j) v[j] = wr[(size_t)(8 * c + j) * NE + e] * g2[8 * c + j];
#pragma unroll
        for (int j = 0; j < 4; ++j) { hw[j] = pk2(v[2 * j], v[2 * j + 1]); lw[j] = pk2(v[2 * j] - __uint_as_float(hw[j] << 16), v[2 * j + 1] - __uint_as_float(hw[j] & 0xffff0000u)); }
        *(LAS u32x4*)(lds + idx * 16) = (u32x4){hw[0], hw[1], hw[2], hw[3]};
        *(LAS u32x4*)(lds + 65536 + idx * 16) = (u32x4){lw[0], lw[1], lw[2], lw[3]};
    }
    __syncthreads();
    const int tile = wave & 3;
    for (int tb = bx; tb < NTOK / 128; tb += G) {
        if (tid < 32) hist[tid] = 0;
        __syncthreads();
        for (int rep_ = 0; rep_ < ((PROBE_PHASE == 6) ? 2 : 1); ++rep_)
        if (wave < 4) {
        const int token = tb * 128 + tile * 32 + r32;
        const float* xp = h2 + (size_t)token * D + 8 * hi;
        unsigned char* x8p = xg8 + (size_t)token * D + 8 * hi;
        const float* gp = g2 + 8 * hi;
        f32x16 c = {};
        float ss = 0.f;
        f32x4 xa[8][2];
#pragma unroll
        for (int p = 0; p < 8; ++p) { xa[p][0] = *(const f32x4*)(xp + 16 * p); xa[p][1] = *(const f32x4*)(xp + 16 * p + 4); }
#pragma unroll 1
        for (int ks0 = 0; ks0 < 64; ks0 += 8) {
#pragma unroll
            for (int p = 0; p < 8; ++p) {
                const int ks = ks0 + p;
                const f32x4 x0 = xa[p][0], x1 = xa[p][1];
                if (ks + 8 < 64) { xa[p][0] = *(const f32x4*)(xp + 16 * (ks + 8)); xa[p][1] = *(const f32x4*)(xp + 16 * (ks + 8) + 4); }
                ss += (x0[0] * x0[0] + x0[1] * x0[1]) + (x0[2] * x0[2] + x0[3] * x0[3]) + (x1[0] * x1[0] + x1[1] * x1[1]) + (x1[2] * x1[2] + x1[3] * x1[3]);
                { const f32x4 g0 = *(const f32x4*)(gp + 16 * ks), g1 = *(const f32x4*)(gp + 16 * ks + 4);
                  u32x2 w8; w8.x = pk4_fp8(x0[0] * g0[0], x0[1] * g0[1], x0[2] * g0[2], x0[3] * g0[3]); w8.y = pk4_fp8(x1[0] * g1[0], x1[1] * g1[1], x1[2] * g1[2], x1[3] * g1[3]);
                  *(u32x2*)(x8p + 16 * ks) = w8; }
                u32x4 xh, xl;
                xh.x = pk2(x0[0], x0[1]); xh.y = pk2(x0[2], x0[3]); xh.z = pk2(x1[0], x1[1]); xh.w = pk2(x1[2], x1[3]);
                xl.x = pk2(x0[0] - __uint_as_float(xh.x << 16), x0[1] - __uint_as_float(xh.x & 0xffff0000u)); xl.y = pk2(x0[2] - __uint_as_float(xh.y << 16), x0[3] - __uint_as_float(xh.y & 0xffff0000u));
                xl.z = pk2(x1[0] - __uint_as_float(xh.z << 16), x1[1] - __uint_as_float(xh.z & 0xffff0000u)); xl.w = pk2(x1[2] - __uint_as_float(xh.w << 16), x1[3] - __uint_as_float(xh.w & 0xffff0000u));
                const int chunk = 2 * ks + hi;
                const bf16x8 wh = *(const LAS bf16x8*)(lds + (chunk * 32 + r32) * 16), wl = *(const LAS bf16x8*)(lds + 65536 + (chunk * 32 + r32) * 16);
                c = __builtin_amdgcn_mfma_f32_32x32x16_bf16(wh, __builtin_bit_cast(bf16x8, xh), c, 0, 0, 0);
                c = __builtin_amdgcn_mfma_f32_32x32x16_bf16(wl, __builtin_bit_cast(bf16x8, xh), c, 0, 0, 0);
                c = __builtin_amdgcn_mfma_f32_32x32x16_bf16(wh, __builtin_bit_cast(bf16x8, xl), c, 0, 0, 0);
            }
        }
        {
            ss += __shfl_xor(ss, 32);
            const float rstd = rsqrtf(ss * (1.0f / D) + EPS);
            float vals[16];
#pragma unroll
            for (int r = 0; r < 16; ++r) vals[r] = c[r] * rstd + br[(r & 3) + 8 * (r >> 2) + 4 * hi];
            float tv[4]; int te[4];
#pragma unroll
            for (int k = 0; k < 4; ++k) {
                float m = -3.0e38f; int mi = 0;
#pragma unroll
                for (int r = 0; r < 16; ++r) { const bool gt = vals[r] > m; m = gt ? vals[r] : m; mi = gt ? r : mi; }
                tv[k] = m; te[k] = (mi & 3) + 8 * (mi >> 2) + 4 * hi;
#pragma unroll
                for (int r = 0; r < 16; ++r) vals[r] = (r == mi) ? -3.0e38f : vals[r];
            }
            float cv[8]; int ce[8];
#pragma unroll
            for (int k = 0; k < 4; ++k) { cv[k] = tv[k]; ce[k] = te[k]; cv[4 + k] = __shfl_xor(tv[k], 32); ce[4 + k] = __shfl_xor(te[k], 32); }
            float fv[4]; int fe[4];
#pragma unroll
            for (int k = 0; k < 4; ++k) {
                float m = -3.0e38f; int me = 64; int mi = 0;
#pragma unroll
                for (int q = 0; q < 8; ++q) { const bool better = (cv[q] > m) || (cv[q] == m && ce[q] < me); m = better ? cv[q] : m; me = better ? ce[q] : me; mi = better ? q : mi; }
                fv[k] = m; fe[k] = me;
#pragma unroll
                for (int q = 0; q < 8; ++q) cv[q] = (q == mi) ? -3.0e38f : cv[q];
            }
            if (hi == 0 && (PROBE_PHASE != 6 || rep_ == 1)) {
                const float e0 = 1.0f, e1 = __expf(fv[1] - fv[0]), e2 = __expf(fv[2] - fv[0]), e3 = __expf(fv[3] - fv[0]);
                const float inv = 1.0f / (e0 + e1 + e2 + e3);
                const float wts[4] = {e0 * inv, e1 * inv, e2 * inv, e3 * inv};
                const int tl = tile * 32 + r32;
                rstd_l[tl] = rstd;
#pragma unroll
                for (int k = 0; k < 4; ++k) {
                    const int lp = __hip_atomic_fetch_add(hist + fe[k], 1, __ATOMIC_RELAXED, __HIP_MEMORY_SCOPE_WORKGROUP);
                    LAS int* r = rec + (tl * 4 + k) * 3; r[0] = fe[k]; r[1] = lp; r[2] = __float_as_int(wts[k]);
                }
            }
        }
        }
        __syncthreads();
        if (tid < 32) base[tid] = (int)atomicAdd(&cnt[tid], (unsigned)hist[tid]);
        __syncthreads();
        { const int tl = tid >> 2; const int tok = tb * 128 + tl; LAS int* r = rec + tid * 3; const int e = r[0], pos = base[e] + r[1]; const float w = __int_as_float(r[2]);
          tke[tok * 4 + (tid & 3)] = e; tkpos[tok * 4 + (tid & 3)] = pos; tkw[tok * 4 + (tid & 3)] = w;
          list[e * NTOK + pos] = tok; wlist[e * NTOK + pos] = w; rlist[e * NTOK + pos] = rstd_l[tl]; }
        __syncthreads();
    }
}

__device__ __forceinline__ void combine_phase(LAS unsigned char* misc, void* scratch_out, float* __restrict__ out, const unsigned char* __restrict__ rows, const int* __restrict__ tke, const int* __restrict__ tkpos, int gw, int NGW, int lane) {
    LAS const int* pstart = (LAS const int*)(misc + MT_PSTART);
    for (int rep_ = 0; rep_ < ((PROBE_PHASE == 9) ? 2 : 1); ++rep_)
    for (int token = gw; token < NTOK; token += NGW) {
        int rr[4];
#pragma unroll
        for (int k = 0; k < 4; ++k) rr[k] = pstart[tke[token * 4 + k]] + tkpos[token * 4 + k];
        f32x4* o = (f32x4*)(out + (size_t)token * D) + lane;
        f32x4 v[4], s[4];
#pragma unroll
        for (int j = 0; j < 4; ++j) { v[j] = o[64 * j]; s[j] = (f32x4){0.f, 0.f, 0.f, 0.f}; }
#pragma unroll
        for (int k = 0; k < 4; ++k) {
            const unsigned* rp = (const unsigned*)(rows + (size_t)rr[k] * D) + lane;
#pragma unroll
            for (int j = 0; j < 4; ++j) { const unsigned w = rp[64 * j];
                const f32x2 lo = __builtin_amdgcn_cvt_pk_f32_fp8((int)w, false), hh = __builtin_amdgcn_cvt_pk_f32_fp8((int)w, true);
                s[j][0] += lo[0]; s[j][1] += lo[1]; s[j][2] += hh[0]; s[j][3] += hh[1]; }
        }
#pragma unroll
        for (int j = 0; j < 4; ++j) v[j] = v[j] + s[j] * ROW8_INV;
        if (PROBE_PHASE == 9 && rep_ == 0) {
#pragma unroll
            for (int j = 0; j < 4; ++j) { asm volatile("" :: "v"(v[j])); *(f32x4*)((float*)scratch_out + (size_t)token * D + (64 * j + lane) * 4) = v[j]; }
        } else {
#pragma unroll
        for (int j = 0; j < 4; ++j) o[64 * j] = v[j];
        }
    }
}
struct SchedDense {
    static constexpr bool GATHER = false;
    const char* A; const char* Bt; int K, nM, nN, nwg, G, c;
    __device__ void init(const bf16* A_, const bf16* Bt_, int M, int N, int K_, int G_, int c_) { A = (const char*)A_; Bt = (const char*)Bt_; K = K_; nM = M / 256; nN = N / 256; nwg = nM * nN; G = G_; c = c_; }
    __device__ __forceinline__ bool next(int i, pg8::Unit& u) const {
        const long L = (long)i * G + c; if (L >= nwg) return false;
        int wgid = (int)L; { const int q = nwg / 8, r = nwg % 8, xcd = wgid % 8, off = wgid / 8; wgid = (xcd < r ? xcd * (q + 1) : r * (q + 1) + (xcd - r) * q) + off; }
        const int nig = 8 * nN, gid = wgid / nig, fm = gid * 8, gsz = (nM - fm) < 8 ? (nM - fm) : 8;
        u.pm = fm + ((wgid % nig) % gsz); u.pn = (wgid % nig) / gsz; u.aux = 0; u.tl = 0;
        u.A = A + (size_t)u.pm * 256 * K * 2; u.B = Bt + (size_t)u.pn * 256 * K * 2; return true;
    }
    __device__ __forceinline__ void aoff(const pg8::Unit&, const int (&R)[2], const int (&C)[2], unsigned (&o)[2][2]) const {
#pragma unroll
        for (int h = 0; h < 2; ++h)
#pragma unroll
            for (int i = 0; i < 2; ++i) o[h][i] = (unsigned)((128 * h + R[i]) * K + C[i]) * 2u;
    }
};
struct SchedBranch {
    static constexpr bool GATHER = false;
    const char* A0; const char* A1; const char* B0; const char* B1; int G, c;
    __device__ __forceinline__ bool next(int i, pg8::Unit& u) const {
        const int L = (i >> 1) * G + c; if (L >= 512) return false;
        int wgid = L; { const int off = wgid / 8, xcd = wgid % 8; wgid = xcd * 64 + off; }
        const int nig = 8 * 4, gid = wgid / nig;
        u.pm = gid * 8 + ((wgid % nig) % 8); u.pn = (wgid % nig) / 8; u.aux = i & 1; u.tl = 0;
        u.A = ((i & 1) ? A1 : A0) + (size_t)u.pm * 256 * D * 2; u.B = ((i & 1) ? B1 : B0) + (size_t)u.pn * 256 * D * 2; return true;
    }
    __device__ __forceinline__ void aoff(const pg8::Unit&, const int (&R)[2], const int (&C)[2], unsigned (&o)[2][2]) const {
#pragma unroll
        for (int h = 0; h < 2; ++h)
#pragma unroll
            for (int i = 0; i < 2; ++i) o[h][i] = (unsigned)((128 * h + R[i]) * D + C[i]) * 2u;
    }
};
template <bool GATHER_, int NPN>
struct SchedMoe {
    static constexpr bool GATHER = GATHER_;
    const char* A; const char* Bt; LAS const unsigned char* misc; const int* list; int G, c;
    __device__ __forceinline__ bool next(int i, pg8::Unit& u) const {
        LAS const int* cl = (LAS const int*)(misc + MT_CNT); LAS const int* ps = (LAS const int*)(misc + MT_PSTART);
        if ((G & 7) == 0) {
            const int x = c & 7, r = c >> 3, n = G >> 3;
            int k = (i * n + r) / NPN; const int pn = (i * n + r) % NPN;
#pragma unroll
            for (int j = 0; j < 4; ++j) { const int e = x + 8 * j, nt = (cl[e] + 255) >> 8;
                if (k < nt) { u.pn = pn; u.aux = e; u.tl = k; u.pm = (ps[e] >> 8) + k;
                    u.A = GATHER ? A : A + (size_t)u.pm * 256 * 1024; u.B = Bt + ((size_t)e * NPN + pn) * 256 * 1024; return true; }
                k -= nt; }
            return false;
        }
        const int nact = *(LAS const int*)(misc + MT_NACT);
        const int L = i * G + c; if (L >= nact * NPN) return false;
        const int k = L / NPN; u.pn = L % NPN; const int w = ((LAS const int*)(misc + MT_ATILE))[k];
        u.pm = w & 0xfff; u.aux = (w >> 12) & 0xff; u.tl = w >> 20;
        u.A = GATHER ? A : A + (size_t)u.pm * 256 * 1024;
        u.B = Bt + ((size_t)u.aux * NPN + u.pn) * 256 * 1024; return true;
    }
    __device__ __forceinline__ void aoff(const pg8::Unit& u, const int (&R)[2], const int (&C)[2], unsigned (&o)[2][2]) const {
        const int ce = ((LAS const int*)(misc + MT_CNT))[u.aux];
#pragma unroll
        for (int h = 0; h < 2; ++h)
#pragma unroll
            for (int i = 0; i < 2; ++i) {
                if (GATHER) { const int idx = u.tl * 256 + 128 * h + R[i]; const int tok = (idx < ce) ? list[u.aux * NTOK + idx] : 0; o[h][i] = (unsigned)tok * 1024u + (unsigned)C[i] * 2u; }
                else o[h][i] = (unsigned)((128 * h + R[i]) * 1024 + C[i] * 2);
            }
    }
};

__device__ __forceinline__ u32x4 pack8(const f32x4& a, const f32x4& b) { u32x4 w; w.x = pk2(a[0], a[1]); w.y = pk2(a[2], a[3]); w.z = pk2(b[0], b[1]); w.w = pk2(b[2], b[3]); return w; }
__device__ __forceinline__ void unpack8(const u32x4& w, float (&f)[8]) {
    f[0] = __uint_as_float(w.x << 16); f[1] = __uint_as_float(w.x & 0xffff0000u); f[2] = __uint_as_float(w.y << 16); f[3] = __uint_as_float(w.y & 0xffff0000u);
    f[4] = __uint_as_float(w.z << 16); f[5] = __uint_as_float(w.z & 0xffff0000u); f[6] = __uint_as_float(w.w << 16); f[7] = __uint_as_float(w.w & 0xffff0000u);
}
struct EpiProj {
    static constexpr bool PERM = true;
    __device__ __forceinline__ void prefetch(const pg8::Unit&, int, int, int) const {}
    bf16* proj; const float* qg; const float* kg;
    __device__ __forceinline__ void operator()(pg8::Acc& acc, const pg8::Unit& u, int wr, int wc, int fr, int fq, int slot) const {
        const int pn = u.pn;
        int mode;
        if (pn < 4) mode = 1; else if (pn == 4) mode = (wc < 2) ? 2 : 0; else if (pn < 7) mode = 0; else if (pn < 9) mode = 3; else if (pn < 13) mode = 0; else if (pn < 17) mode = 4; else mode = 5;
        float gn[2][8];
        if (mode == 1 || mode == 2) { const float* g = (mode == 1) ? qg : kg; const float s = (mode == 1) ? 0.125f : 1.0f;
#pragma unroll
            for (int bj = 0; bj < 2; ++bj)
#pragma unroll
                for (int j = 0; j < 8; ++j) gn[bj][j] = g[32 * bj + 8 * fq + j] * s; }
#pragma unroll
        for (int ai = 0; ai < 2; ++ai)
#pragma unroll
            for (int m = 0; m < 4; ++m) {
                const int r = u.pm * 256 + ai * 128 + wr * 64 + m * 16 + fr;
                bf16* rowp = proj + (size_t)r * INW + pn * 256 + wc * 64 + 8 * fq;
                f32x4 v[2][2];
#pragma unroll
                for (int bj = 0; bj < 2; ++bj) { v[bj][0] = acc[ai][bj][m][0]; v[bj][1] = acc[ai][bj][m][1]; }
                if (mode == 1 || mode == 2) {
                    float ss = 0.f;
#pragma unroll
                    for (int bj = 0; bj < 2; ++bj)
#pragma unroll
                        for (int n = 0; n < 2; ++n) ss += v[bj][n][0] * v[bj][n][0] + v[bj][n][1] * v[bj][n][1] + v[bj][n][2] * v[bj][n][2] + v[bj][n][3] * v[bj][n][3];
                    ss += __shfl_xor(ss, 16); ss += __shfl_xor(ss, 32);
                    const float rs = rsqrtf(ss * (1.0f / 64.0f) + EPS);
#pragma unroll
                    for (int bj = 0; bj < 2; ++bj)
#pragma unroll
                        for (int n = 0; n < 2; ++n)
#pragma unroll
                            for (int i = 0; i < 4; ++i) v[bj][n][i] = v[bj][n][i] * rs * gn[bj][4 * n + i];
                } else if (mode == 3) {
#pragma unroll
                    for (int bj = 0; bj < 2; ++bj)
#pragma unroll
                        for (int n = 0; n < 2; ++n) v[bj][n] = v[bj][n] * 0.08838834764831845f;
                } else if (mode == 4) {
#pragma unroll
                    for (int bj = 0; bj < 2; ++bj)
#pragma unroll
                        for (int n = 0; n < 2; ++n)
#pragma unroll
                            for (int i = 0; i < 4; ++i) { const float x = v[bj][n][i]; v[bj][n][i] = x * sigmoidf_(x); }
                } else if (mode == 5) {
#pragma unroll
                    for (int bj = 0; bj < 2; ++bj)
#pragma unroll
                        for (int n = 0; n < 2; ++n)
#pragma unroll
                            for (int i = 0; i < 4; ++i) v[bj][n][i] = sigmoidf_(v[bj][n][i]);
                }
#pragma unroll
                for (int bj = 0; bj < 2; ++bj) *(u32x4*)(rowp + 32 * bj) = pack8(v[bj][0], v[bj][1]);
            }
    }
};
struct EpiBranch {
    static constexpr bool PERM = true;
    __device__ __forceinline__ void prefetch(const pg8::Unit&, int, int, int) const {}
    bf16* merged; const bf16* proj;
    __device__ __forceinline__ void operator()(pg8::Acc& acc, const pg8::Unit& u, int wr, int wc, int fr, int fq, int slot) const {
        const int gcol = u.aux ? C_GR : C_GA;
#pragma unroll
        for (int ai = 0; ai < 2; ++ai)
#pragma unroll
            for (int m = 0; m < 4; ++m) {
                const int r = u.pm * 256 + ai * 128 + wr * 64 + m * 16 + fr;
#pragma unroll
                for (int bj = 0; bj < 2; ++bj) {
                    const int col = u.pn * 256 + bj * 128 + wc * 32 + 8 * fq;
                    const u32x4 gw = *(const u32x4*)(proj + (size_t)r * INW + gcol + col);
                    float g[8]; unpack8(gw, g);
                    f32x4 a = acc[ai][bj][m][0], b = acc[ai][bj][m][1];
                    a[0] *= g[0]; a[1] *= g[1]; a[2] *= g[2]; a[3] *= g[3]; b[0] *= g[4]; b[1] *= g[5]; b[2] *= g[6]; b[3] *= g[7];
                    bf16* mp = merged + (size_t)r * D + col;
                    if (u.aux) { const u32x4 pw = *(const u32x4*)mp; float p[8]; unpack8(pw, p);
                        a[0] += p[0]; a[1] += p[1]; a[2] += p[2]; a[3] += p[3]; b[0] += p[4]; b[1] += p[5]; b[2] += p[6]; b[3] += p[7]; }
                    *(u32x4*)mp = pack8(a, b);
                }
            }
    }
};
struct EpiOut {
    static constexpr bool PERM = false;
    __device__ __forceinline__ void prefetch(const pg8::Unit&, int, int, int) const {}
    const float* x; float* out;
    __device__ __forceinline__ void operator()(pg8::Acc& acc, const pg8::Unit& u, int wr, int wc, int fr, int fq, int slot) const {
#pragma unroll
        for (int ai = 0; ai < 2; ++ai)
#pragma unroll
            for (int m = 0; m < 4; ++m) {
                const size_t off = (size_t)(u.pm * 256 + ai * 128 + wr * 64 + m * 16 + fr) * D + u.pn * 256 + wc * 32 + 4 * fq;
#pragma unroll
                for (int bj = 0; bj < 2; ++bj)
#pragma unroll
                    for (int n = 0; n < 2; ++n) { const f32x4 xv = *(const f32x4*)(x + off + bj * 128 + n * 16); *(f32x4*)(out + off + bj * 128 + n * 16) = xv + acc[ai][bj][m][n]; }
            }
    }
};
struct EpiGU {
    static constexpr bool PERM = true;
    unsigned char* act; const float* bgu; const float* rlist; LAS unsigned char* misc;
    __device__ __forceinline__ void prefetch(const pg8::Unit& u, int slot, int wid, int lane) const {
        if (wid < 4) __builtin_amdgcn_global_load_lds((const unsigned*)(rlist + (size_t)u.aux * NTOK + u.tl * 256 + wid * 64 + lane), (LAS unsigned*)(misc + MT_EPI + slot * 1024 + wid * 256), 4, 0, 0);
    }
    __device__ __forceinline__ void operator()(pg8::Acc& acc, const pg8::Unit& u, int wr, int wc, int fr, int fq, int slot) const {
        const int ce = ((LAS const int*)(misc + MT_CNT))[u.aux];
        const int col = u.pn * 128 + wc * 32 + 8 * fq;
        const float* bg = bgu + (size_t)u.aux * 2048 + col;
        float bgate[8], bup[8];
#pragma unroll
        for (int j = 0; j < 8; ++j) { bgate[j] = bg[j]; bup[j] = bg[1024 + j]; }
#pragma unroll
        for (int ai = 0; ai < 2; ++ai)
#pragma unroll
            for (int m = 0; m < 4; ++m) {
                const int lr = ai * 128 + wr * 64 + m * 16 + fr, r = u.pm * 256 + lr;
                const float rs = ((LAS const float*)(misc + MT_EPI + slot * 1024))[lr] * W8_INV;
                float o[8];
#pragma unroll
                for (int n = 0; n < 2; ++n)
#pragma unroll
                    for (int i = 0; i < 4; ++i) {
                        float gate = acc[ai][0][m][n][i] * rs + bgate[4 * n + i], up = acc[ai][1][m][n][i] * rs + bup[4 * n + i];
                        gate = fminf(gate, 7.0f); up = fminf(fmaxf(up, -7.0f), 7.0f);
                        o[4 * n + i] = (up + 1.0f) * gate * sigmoidf_(1.702f * gate);
                    }
                u32x2 w; w.x = pk4_fp8(o[0], o[1], o[2], o[3]); w.y = pk4_fp8(o[4], o[5], o[6], o[7]);
                *(u32x2*)(act + (size_t)r * DFF + col) = w;
            }
    }
};
struct EpiDown {
    static constexpr bool PERM = true;
    unsigned char* rows; const float* bdn; const float* wlist; LAS const unsigned char* misc;
    __device__ __forceinline__ void prefetch(const pg8::Unit& u, int slot, int wid, int lane) const {
        if (wid < 4) __builtin_amdgcn_global_load_lds((const unsigned*)(wlist + (size_t)u.aux * NTOK + u.tl * 256 + wid * 64 + lane), (LAS unsigned*)(misc + MT_EPI + slot * 1024 + wid * 256), 4, 0, 0);
    }
    __device__ __forceinline__ void operator()(pg8::Acc& acc, const pg8::Unit& u, int wr, int wc, int fr, int fq, int slot) const {
        const int ce = ((LAS const int*)(misc + MT_CNT))[u.aux];
        float bb[2][8];
#pragma unroll
        for (int bj = 0; bj < 2; ++bj)
#pragma unroll
            for (int j = 0; j < 8; ++j) bb[bj][j] = bdn[(size_t)u.aux * D + u.pn * 256 + bj * 128 + wc * 32 + 8 * fq + j];
#pragma unroll
        for (int ai = 0; ai < 2; ++ai)
#pragma unroll
            for (int m = 0; m < 4; ++m) {
                const int lr = ai * 128 + wr * 64 + m * 16 + fr, r = u.pm * 256 + lr, idx = u.tl * 256 + lr;
                const float w = (idx < ce) ? ((LAS const float*)(misc + MT_EPI + slot * 1024))[lr] * ROW8_SCALE : 0.f;
#pragma unroll
                for (int bj = 0; bj < 2; ++bj) {
                    f32x4 a = acc[ai][bj][m][0], b = acc[ai][bj][m][1];
#pragma unroll
                    for (int i = 0; i < 4; ++i) { a[i] = (a[i] * W8_INV + bb[bj][i]) * w; b[i] = (b[i] * W8_INV + bb[bj][4 + i]) * w; }
                    u32x2 o; o.x = pk4_fp8(a[0], a[1], a[2], a[3]); o.y = pk4_fp8(b[0], b[1], b[2], b[3]);
                    *(u32x2*)(rows + (size_t)r * D + u.pn * 256 + bj * 128 + wc * 32 + 8 * fq) = o;
                }
            }
    }
};
namespace attn {
typedef float f32x16 __attribute__((ext_vector_type(16)));
typedef short s16x4 __attribute__((ext_vector_type(4)));
constexpr int NK = 272, K_OFF = 0, V_OFF = 34816, WS_OFF = 69632, OST_OFF = 71680, LDS_END = OST_OFF + 8 * 4096;
constexpr float LOG2E = 1.4426950408889634f;
__device__ __forceinline__ s16x4 vtr(LAS const unsigned char* p) { return __builtin_bit_cast(s16x4, __builtin_amdgcn_ds_read_tr16_b64_v4i16((LAS s16x4*)p)); }
__device__ __forceinline__ int crowc(int r) { return (r & 3) + 8 * (r >> 2); }

template <int TYPE, bool DIAG>
__device__ __forceinline__ void tile(LAS const unsigned char* lds, int kbase, const bf16x8 (&qr)[4], f32x16 (&o)[2], float& l, float lanebase, float c1, int tt, int lane) {
    const int r32 = lane & 31, hi = lane >> 5;
    f32x16 p = {};
#pragma unroll
    for (int d0 = 0; d0 < 4; ++d0) {
        const bf16x8 kf = *(const LAS bf16x8*)(lds + K_OFF + (2 * d0 + hi) * (NK * 16) + (kbase + r32) * 16);
        p = __builtin_amdgcn_mfma_f32_32x32x16_bf16(kf, qr[d0], p, 0, 0, 0);
    }
    constexpr int NR = (TYPE == 0) ? 8 : 16;
    float e[16];
#pragma unroll
    for (int r = 0; r < NR; ++r) {
        const float add = __builtin_fmaf(c1, (float)crowc(r), lanebase);
        float v = __builtin_amdgcn_exp2f(__builtin_fmaf(p[r], LOG2E, add));
        if (DIAG) { const bool ok = (TYPE == 1) ? (crowc(r) > tt) : (crowc(r) <= tt); v = ok ? v : 0.f; }
        e[r] = v; l += v;
    }
    constexpr int NS = (TYPE == 0) ? 1 : 2;
    u32x4 pw[2];
#pragma unroll
    for (int s = 0; s < NS; ++s) { pw[s].x = pk2(e[8 * s + 0], e[8 * s + 1]); pw[s].y = pk2(e[8 * s + 2], e[8 * s + 3]); pw[s].z = pk2(e[8 * s + 4], e[8 * s + 5]); pw[s].w = pk2(e[8 * s + 6], e[8 * s + 7]); }
    LAS const unsigned char* vb = lds + V_OFF + (kbase + 4 * hi + ((lane & 15) >> 2)) * 64 + ((lane >> 4) & 1) * 32 + (lane & 3) * 8;
#pragma unroll
    for (int d0 = 0; d0 < 2; ++d0)
#pragma unroll
        for (int s = 0; s < NS; ++s) {
            const s16x4 lo = vtr(vb + d0 * (NK * 64) + s * 1024), hh = vtr(vb + d0 * (NK * 64) + s * 1024 + 512);
            const bf16x8 vf = (bf16x8){lo[0], lo[1], lo[2], lo[3], hh[0], hh[1], hh[2], hh[3]};
            o[d0] = __builtin_amdgcn_mfma_f32_32x32x16_bf16(__builtin_bit_cast(bf16x8, pw[s]), vf, o[d0], 0, 0, 0);
        }
}

#define AT_ISSUE(u_) do { const int u__ = (u_); const int b_ = u__ >> 6, qb_ = (u__ >> 1) & 31, kvh_ = u__ & 1; \
        _Pragma("unroll") for (int i = 0; i < 5; ++i) { const int idx = tid + 512 * i; if (idx < NK * 8) { const int key = idx >> 3, c = idx & 7; const bf16* rowp; \
            if (key < 16) rowp = pmeta + (size_t)key * INW; else { int j = qb_ * 128 - 128 + (key - 16); if (j < 0) j = 0; rowp = proj + ((size_t)b_ * SEQ + j) * INW; } \
            pk[i] = *(const u32x4*)(rowp + C_AK + kvh_ * 64 + c * 8); pv[i] = *(const u32x4*)(rowp + C_AV + kvh_ * 64 + c * 8); } } } while (0)
#define AT_QLOAD(dst, a_) do { const size_t qrow_ = (size_t)b * SEQ + qb * 128 + 32 * (a_) + r32; \
        _Pragma("unroll") for (int d0 = 0; d0 < 4; ++d0) dst[d0] = *(const bf16x8*)(proj + qrow_ * INW + C_AQ + h * 64 + d0 * 16 + hi * 8); } while (0)
__device__ __forceinline__ void phase(LAS unsigned char* lds, const bf16* __restrict__ proj, const bf16* __restrict__ pmeta, const float* __restrict__ sinks, float bshift, bf16* __restrict__ yatt, int G, int bx) {
    const int tid = threadIdx.x, lane = tid & 63, r32 = lane & 31, hi = lane >> 5; const int wave = __builtin_amdgcn_readfirstlane(tid >> 6);
    constexpr int NU = NB * 32 * 2;
    if (bx >= NU) return;
    u32x4 pk[5], pv[5];
    AT_ISSUE(bx);
    for (int u = bx; u < NU; u += G) {
        const int b = u >> 6, qb = (u >> 1) & 31, kvh = u & 1;
#pragma unroll
        for (int i = 0; i < 5; ++i) { const int idx = tid + 512 * i; if (idx < NK * 8) { const int key = idx >> 3, c = idx & 7;
            *(LAS u32x4*)(lds + K_OFF + c * (NK * 16) + key * 16) = pk[i];
            *(LAS u32x4*)(lds + V_OFF + (c >> 2) * (NK * 64) + key * 64 + (c & 3) * 16) = pv[i]; } }
        if (u + G < NU) AT_ISSUE(u + G);
        const int h = kvh * 8 + wave;
        bf16x8 qr[4], qn[4];
        AT_QLOAD(qr, 0);
        __syncthreads();
        const float slope = exp2f(-0.5f * (float)(h + 1)), sink = sinks[h];
        const float M = fmaxf(bshift, sink);
        const float c1 = slope * LOG2E;
        LAS float* wsf = (LAS float*)(lds + WS_OFF) + wave * 64;
        LAS bf16* stg = (LAS bf16*)(lds + OST_OFF) + wave * 2048;
#pragma unroll 1
        for (int a = 0; a < 4; ++a) {
            if (a < 3) AT_QLOAD(qn, a + 1);
            f32x16 o[2]; o[0] = f32x16{}; o[1] = f32x16{};
            float l = 0.f;
            const int t = 32 * a + r32;
            const int tt = r32 - 4 * hi;
            const float hi4 = c1 * 4.0f * (float)hi;
            tile<0, false>(lds, 0, qr, o, l, -(slope * (float)(qb * 128 + t + 16) + M) * LOG2E + hi4, c1, tt, lane);
            if (qb > 0) {
                tile<1, true>(lds, 16 + 32 * a, qr, o, l, -(slope * (float)(128 + r32) + M) * LOG2E + hi4, c1, tt, lane);
                for (int bb = a + 1; bb < 4; ++bb) tile<1, false>(lds, 16 + 32 * bb, qr, o, l, -(slope * (float)(128 + t - 32 * bb) + M) * LOG2E + hi4, c1, tt, lane);
            }
            for (int bb = 0; bb < a; ++bb) tile<2, false>(lds, 144 + 32 * bb, qr, o, l, -(slope * (float)(t - 32 * bb) + M) * LOG2E + hi4, c1, tt, lane);
            tile<2, true>(lds, 144 + 32 * a, qr, o, l, -(slope * (float)r32 + M) * LOG2E + hi4, c1, tt, lane);
            l += __shfl_xor(l, 32);
            l += exp2f((sink - M) * LOG2E);
            if (hi == 0) wsf[r32] = l;
            LDS_WAIT();
            float rli[16];
#pragma unroll
            for (int r = 0; r < 16; ++r) rli[r] = __builtin_amdgcn_rcpf(wsf[crowc(r) + 4 * hi]);
#pragma unroll
            for (int r = 0; r < 16; ++r) { const int orow = crowc(r) + 4 * hi;
#pragma unroll
                for (int d0 = 0; d0 < 2; ++d0) stg[orow * 64 + d0 * 32 + r32] = f2bf(o[d0][r] * rli[r]); }
            LDS_WAIT();
            bf16* Ow = yatt + ((size_t)b * SEQ + qb * 128 + 32 * a) * D + h * 64;
#pragma unroll
            for (int i = 0; i < 4; ++i) { const int row = i * 8 + (lane >> 3), ch = lane & 7; const u32x4 v = *(const LAS u32x4*)(stg + row * 64 + ch * 8); *(u32x4*)(Ow + (size_t)row * D + ch * 8) = v; }
            LDS_WAIT();
#pragma unroll
            for (int d0 = 0; d0 < 4; ++d0) qr[d0] = qn[d0];
        }
        __syncthreads();
    }
}
#undef AT_ISSUE
#undef AT_QLOAD
}
namespace ret {
typedef float f32x16 __attribute__((ext_vector_type(16)));
typedef short s16x4 __attribute__((ext_vector_type(4)));
constexpr size_t WS_STATES = 893 * MiB;
__device__ __forceinline__ s16x4 vtr(LAS const unsigned char* p) { return __builtin_bit_cast(s16x4, __builtin_amdgcn_ds_read_tr16_b64_v4i16((LAS s16x4*)p)); }
__device__ __forceinline__ int crowc(int r) { return (r & 3) + 8 * (r >> 2); }
__device__ __forceinline__ float lg2gamma(int h) { return log2f(1.0f - exp2f(-5.0f - (float)h)); }

constexpr int R1_BUF = 40960;
#define RET_ISSUE(KR, VR, c_) do { const int ci__ = (c_); \
        _Pragma("unroll") for (int i = 0; i < 4; ++i) { const int idx = tid + 512 * i, key = idx >> 4, ch = idx & 15; \
            if (ci__ == 0) { KR[i] = (key >= 112) ? *(const u32x4*)(pmeta + (size_t)(key - 112) * INW + C_RK + h * 128 + ch * 8) : (u32x4){0u, 0u, 0u, 0u}; } \
            else KR[i] = *(const u32x4*)(proj + ((size_t)b * SEQ + (ci__ - 1) * 128 + key) * INW + C_RK + h * 128 + ch * 8); } \
        { const int key = tid >> 2, ch = tid & 3; \
          if (ci__ == 0) VR = (key >= 112) ? *(const u32x4*)(pmeta + (size_t)(key - 112) * INW + C_RV + h * 256 + dvs * 32 + ch * 8) : (u32x4){0u, 0u, 0u, 0u}; \
          else VR = *(const u32x4*)(proj + ((size_t)b * SEQ + (ci__ - 1) * 128 + key) * INW + C_RV + h * 256 + dvs * 32 + ch * 8); } } while (0)
#define RET_STEP(KR, VR, c_) do { const int c__ = (c_); LAS unsigned char* buf = lds + (c__ & 1) * R1_BUF; \
        _Pragma("unroll") for (int i = 0; i < 4; ++i) { const int idx = tid + 512 * i, key = idx >> 4, ch = idx & 15; *(LAS u32x4*)(buf + (ch >> 2) * (128 * 64) + key * 64 + (ch & 3) * 16) = KR[i]; } \
        { const int key = tid >> 2, ch = tid & 3; float f[8]; unpack8(VR, f); u32x4 w; \
          w.x = pk2(f[0] * vscale, f[1] * vscale); w.y = pk2(f[2] * vscale, f[3] * vscale); w.z = pk2(f[4] * vscale, f[5] * vscale); w.w = pk2(f[6] * vscale, f[7] * vscale); \
          *(LAS u32x4*)(buf + 32768 + key * 64 + ch * 16) = w; } \
        if (c__ + 2 < 32) RET_ISSUE(KR, VR, c__ + 2); \
        __syncthreads(); \
        if (wave < 4) { \
            const int dt = wave; \
            acc = acc * g128; \
            LAS const unsigned char* ab = buf + dt * (128 * 64) + (4 * hi + ((lane & 15) >> 2)) * 64 + ((lane >> 4) & 1) * 32 + (lane & 3) * 8; \
            LAS const unsigned char* bb = buf + 32768 + (4 * hi + ((lane & 15) >> 2)) * 64 + ((lane >> 4) & 1) * 32 + (lane & 3) * 8; \
            _Pragma("unroll") for (int ks = 0; ks < 8; ++ks) { \
                const s16x4 al = vtr(ab + ks * 1024), ah = vtr(ab + ks * 1024 + 512), bl = vtr(bb + ks * 1024), bh = vtr(bb + ks * 1024 + 512); \
                const bf16x8 af = (bf16x8){al[0], al[1], al[2], al[3], ah[0], ah[1], ah[2], ah[3]}, bfr = (bf16x8){bl[0], bl[1], bl[2], bl[3], bh[0], bh[1], bh[2], bh[3]}; \
                acc = __builtin_amdgcn_mfma_f32_32x32x16_bf16(af, bfr, acc, 0, 0, 0); } \
            bf16* sb = states + ((((size_t)(b * 4 + h) * 32 + c__) * 8 + dvs) * 8) * 512; \
            _Pragma("unroll") for (int g = 0; g < 4; ++g) { u32x2 w; w.x = pk2(acc[4 * g], acc[4 * g + 1]); w.y = pk2(acc[4 * g + 2], acc[4 * g + 3]); \
                *(u32x2*)(sb + (size_t)(2 * dt + (g >> 1)) * 512 + (32 * (g & 1) + (lane & 31)) * 8 + 4 * hi) = w; } \
        } } while (0)
__device__ __forceinline__ void state_chain(LAS unsigned char* lds, int b, int h, int dvs, const bf16* __restrict__ proj, const bf16* __restrict__ pmeta, bf16* __restrict__ states) {
    const int tid = threadIdx.x, lane = tid & 63, hi = lane >> 5; const int wave = __builtin_amdgcn_readfirstlane(tid >> 6);
    const float lg = lg2gamma(h), g128 = exp2f(lg * 128.0f);
    u32x4 kA[4], kB[4], vA, vB;
    const float vscale = exp2f(lg * (float)(127 - (tid >> 2)));
    f32x16 acc = {};
    RET_ISSUE(kA, vA, 0); RET_ISSUE(kB, vB, 1);
#pragma unroll 1
    for (int c = 0; c < 32; c += 2) { RET_STEP(kA, vA, c); RET_STEP(kB, vB, c + 1); }
    __syncthreads();
}
#undef RET_ISSUE
#undef RET_STEP

constexpr int R3_K = 0, R3_Q = 32768, R3_V = 65536;
#define R3_ISSUE(u_) do { const int u__ = (u_); const size_t rw = (size_t)(u__ >> 7) * SEQ + (u__ & 31) * 128; const int hh = (u__ >> 5) & 3; \
        _Pragma("unroll") for (int i = 0; i < 4; ++i) { const int idx = tid + 512 * i, key = idx >> 4, ch = idx & 15; \
            kq[i] = *(const u32x4*)(proj + (rw + key) * INW + C_RK + hh * 128 + ch * 8); kq[4 + i] = *(const u32x4*)(proj + (rw + key) * INW + C_RQ + hh * 128 + ch * 8); } \
        _Pragma("unroll") for (int i = 0; i < 8; ++i) { const int idx = tid + 512 * i, key = idx >> 5, ch = idx & 31; vv[i] = *(const u32x4*)(proj + (rw + key) * INW + C_RV + hh * 256 + ch * 8); } } while (0)
__device__ __forceinline__ void out_phase(LAS unsigned char* lds, const bf16* __restrict__ proj, const bf16* __restrict__ states, bf16* __restrict__ yret, int G, int bx) {
    const int tid = threadIdx.x, lane = tid & 63, r32 = lane & 31, hi = lane >> 5; const int wave = __builtin_amdgcn_readfirstlane(tid >> 6);
    constexpr int NU = NB * 4 * 32;
    if (bx >= NU) return;
    u32x4 kq[8], vv[8];
    R3_ISSUE(bx);
    for (int u = bx; u < NU; u += G) {
        const int b = u >> 7, h = (u >> 5) & 3, tb = u & 31;
        const float lg = lg2gamma(h);
        const size_t row0 = (size_t)b * SEQ + tb * 128;
#pragma unroll
        for (int i = 0; i < 4; ++i) { const int idx = tid + 512 * i, key = idx >> 4, ch = idx & 15;
            *(LAS u32x4*)(lds + R3_K + ch * 2048 + key * 16) = kq[i]; *(LAS u32x4*)(lds + R3_Q + ch * 2048 + key * 16) = kq[4 + i]; }
#pragma unroll
        for (int i = 0; i < 8; ++i) { const int idx = tid + 512 * i, key = idx >> 5, ch = idx & 31; *(LAS u32x4*)(lds + R3_V + (ch >> 2) * 8192 + key * 64 + (ch & 3) * 16) = vv[i]; }
        if (u + G < NU) R3_ISSUE(u + G);
        __syncthreads();
        u32x2 pw[2][4];
#pragma unroll
        for (int ti = 0; ti < 2; ++ti) {
            const int t = wave + 8 * ti;
            if (t < 10) {
                const int a = (t >= 6) ? 3 : (t >= 3) ? 2 : (t >= 1) ? 1 : 0, bb = t - ((a * (a + 1)) >> 1);
                f32x16 p = {};
#pragma unroll
                for (int k = 0; k < 8; ++k) {
                    const bf16x8 kf = *(const LAS bf16x8*)(lds + R3_K + (2 * k + hi) * 2048 + (32 * bb + r32) * 16);
                    const bf16x8 qf = *(const LAS bf16x8*)(lds + R3_Q + (2 * k + hi) * 2048 + (32 * a + r32) * 16);
                    p = __builtin_amdgcn_mfma_f32_32x32x16_bf16(kf, qf, p, 0, 0, 0);
                }
                const float lanebase = lg * (float)(32 * (a - bb) + r32 - 4 * hi), cpos = -lg; const int tt = r32 - 4 * hi;
                float e[16];
#pragma unroll
                for (int r = 0; r < 16; ++r) { float v = p[r] * __builtin_amdgcn_exp2f(__builtin_fmaf(cpos, (float)crowc(r), lanebase)); if (bb == a) v = (crowc(r) <= tt) ? v : 0.f; e[r] = v; }
#pragma unroll
                for (int g = 0; g < 4; ++g) { pw[ti][g].x = pk2(e[4 * g], e[4 * g + 1]); pw[ti][g].y = pk2(e[4 * g + 2], e[4 * g + 3]); }
            }
        }
        __builtin_amdgcn_sched_barrier(0);
        bf16x8 sf[8];
        { const bf16* sb = states + (((size_t)(b * 4 + h) * 32 + tb) * 64 + (size_t)wave * 8) * 512 + lane * 8;
#pragma unroll
          for (int k = 0; k < 8; ++k) sf[k] = *(const bf16x8*)(sb + (size_t)k * 512); }
        bf16x8 vf[8];
        { LAS const unsigned char* vb = lds + R3_V + wave * 8192 + (8 * hi + ((lane & 15) >> 2)) * 64 + ((lane >> 4) & 1) * 32 + (lane & 3) * 8;
#pragma unroll
          for (int ks = 0; ks < 8; ++ks) { const s16x4 lo = vtr(vb + ks * 1024), hh = vtr(vb + ks * 1024 + 256); vf[ks] = (bf16x8){lo[0], lo[1], lo[2], lo[3], hh[0], hh[1], hh[2], hh[3]}; } }
        __syncthreads();
#pragma unroll
        for (int ti = 0; ti < 2; ++ti) {
            const int t = wave + 8 * ti;
            if (t < 10) {
                const int a = (t >= 6) ? 3 : (t >= 3) ? 2 : (t >= 1) ? 1 : 0, bb = t - ((a * (a + 1)) >> 1);
#pragma unroll
                for (int g = 0; g < 4; ++g) *(LAS u32x2*)(lds + R3_K + (4 * bb + g) * 2048 + (32 * a + r32) * 16 + hi * 8) = pw[ti][g];
            }
        }
        __syncthreads();
        LAS bf16* stg = (LAS bf16*)(lds + R3_V);
#pragma unroll 1
        for (int a = 0; a < 4; ++a) {
            f32x16 o = {};
#pragma unroll
            for (int ks = 0; ks < 8; ++ks) if (ks < 2 * (a + 1)) {
                const bf16x8 pa = *(const LAS bf16x8*)(lds + R3_K + (2 * ks + hi) * 2048 + (32 * a + r32) * 16);
                o = __builtin_amdgcn_mfma_f32_32x32x16_bf16(pa, vf[ks], o, 0, 0, 0);
            }
            f32x16 x = {};
#pragma unroll
            for (int k = 0; k < 8; ++k) { const bf16x8 qa = *(const LAS bf16x8*)(lds + R3_Q + (2 * k + hi) * 2048 + (32 * a + r32) * 16); x = __builtin_amdgcn_mfma_f32_32x32x16_bf16(qa, sf[k], x, 0, 0, 0); }
#pragma unroll
            for (int r = 0; r < 16; ++r) {
                const float din = __builtin_amdgcn_exp2f(lg * (float)(32 * a + crowc(r) + 4 * hi + 1));
                stg[(32 * a + crowc(r) + 4 * hi) * 256 + wave * 32 + r32] = f2bf(o[r] + din * x[r]);
            }
        }
        __syncthreads();
#pragma unroll 4
        for (int i = 0; i < 16; ++i) {
            const int q = wave * 16 + i;
            const u32x2 sw = *(const LAS u32x2*)(stg + q * 256 + lane * 4);
            const float v0 = __uint_as_float(sw.x << 16), v1 = __uint_as_float(sw.x & 0xffff0000u), v2 = __uint_as_float(sw.y << 16), v3 = __uint_as_float(sw.y & 0xffff0000u);
            const float ss = wave_sum((v0 * v0 + v1 * v1) + (v2 * v2 + v3 * v3));
            const float rs = rsqrtf(ss * (1.0f / 256.0f) + EPS);
            const u32x2 gw = *(const u32x2*)(proj + (row0 + q) * INW + C_RG + h * 256 + lane * 4);
            u32x2 w; w.x = pk2(v0 * rs * __uint_as_float(gw.x << 16), v1 * rs * __uint_as_float(gw.x & 0xffff0000u)); w.y = pk2(v2 * rs * __uint_as_float(gw.y << 16), v3 * rs * __uint_as_float(gw.y & 0xffff0000u));
            *(u32x2*)(yret + (row0 + q) * D + h * 256 + lane * 4) = w;
        }
        __syncthreads();
    }
}
#undef R3_ISSUE
}
template <bool FP8>
__device__ __forceinline__ void p0_item(const float* __restrict__ W, int K, int N, void* __restrict__ WT, int k0, int n0, int dst_row0, int lane) {
    const int kblk = lane >> 3, nq = lane & 7;
    const float* src = W + (size_t)(k0 + 16 * kblk) * N + n0 + 4 * nq;
    f32x4 v[16];
#pragma unroll
    for (int i = 0; i < 16; ++i) v[i] = *(const f32x4*)(src + (size_t)i * N);
#pragma unroll
    for (int j = 0; j < 4; ++j) {
        const size_t row = (size_t)(dst_row0 + 4 * nq + j);
        if constexpr (FP8) {
            u32x4 o;
            o.x = pk4_fp8(v[0][j] * W8_SCALE, v[1][j] * W8_SCALE, v[2][j] * W8_SCALE, v[3][j] * W8_SCALE); o.y = pk4_fp8(v[4][j] * W8_SCALE, v[5][j] * W8_SCALE, v[6][j] * W8_SCALE, v[7][j] * W8_SCALE);
            o.z = pk4_fp8(v[8][j] * W8_SCALE, v[9][j] * W8_SCALE, v[10][j] * W8_SCALE, v[11][j] * W8_SCALE); o.w = pk4_fp8(v[12][j] * W8_SCALE, v[13][j] * W8_SCALE, v[14][j] * W8_SCALE, v[15][j] * W8_SCALE);
            *(u32x4*)((unsigned char*)WT + row * K + k0 + 16 * kblk) = o;
        } else {
            u32x4 a, b;
            a.x = pk2(v[0][j], v[1][j]); a.y = pk2(v[2][j], v[3][j]); a.z = pk2(v[4][j], v[5][j]); a.w = pk2(v[6][j], v[7][j]);
            b.x = pk2(v[8][j], v[9][j]); b.y = pk2(v[10][j], v[11][j]); b.z = pk2(v[12][j], v[13][j]); b.w = pk2(v[14][j], v[15][j]);
            bf16* d = (bf16*)WT + row * K + k0 + 16 * kblk;
            *(u32x4*)d = a; *(u32x4*)(d + 8) = b;
        }
    }
}
#ifndef PROBE_PHASE
#define PROBE_PHASE (-1)
#endif
__device__ __forceinline__ void p0_transpose_item_fp8(const float* W, int K, int N, unsigned char* WT, int k0, int n0, int dst_row0, LAS float* scr, int lane) {
#pragma unroll 8
    for (int i = 0; i < 32; ++i) { const int kk = 2 * i + (lane >> 5); scr[kk * 33 + (lane & 31)] = W[(size_t)(k0 + kk) * N + n0 + (lane & 31)]; }
    LDS_WAIT(); asm volatile("" ::: "memory");
    const int c = lane & 3;
#pragma unroll
    for (int j = 0; j < 2; ++j) { const int n = (lane >> 2) + 16 * j; const LAS float* s = scr + (16 * c) * 33 + n;
        u32x4 o;
        o.x = pk4_fp8(s[0 * 33] * W8_SCALE, s[1 * 33] * W8_SCALE, s[2 * 33] * W8_SCALE, s[3 * 33] * W8_SCALE); o.y = pk4_fp8(s[4 * 33] * W8_SCALE, s[5 * 33] * W8_SCALE, s[6 * 33] * W8_SCALE, s[7 * 33] * W8_SCALE);
        o.z = pk4_fp8(s[8 * 33] * W8_SCALE, s[9 * 33] * W8_SCALE, s[10 * 33] * W8_SCALE, s[11 * 33] * W8_SCALE); o.w = pk4_fp8(s[12 * 33] * W8_SCALE, s[13 * 33] * W8_SCALE, s[14 * 33] * W8_SCALE, s[15 * 33] * W8_SCALE);
        *(u32x4*)(WT + (size_t)(dst_row0 + n) * K + k0 + 16 * c) = o; }
    LDS_WAIT(); asm volatile("" ::: "memory");
}
struct Args { const float* in[17]; float* out; unsigned char* ws; int ph_lo, ph_hi, li, pad; };

__global__ void __launch_bounds__(512, 2) mk_fwd(Args args) {
    extern __shared__ __attribute__((aligned(16))) unsigned char lds_raw[];
    LAS unsigned char* lds = (LAS unsigned char*)lds_raw;
    volatile LAS unsigned* MISC = (volatile LAS unsigned*)(lds + MISC_OFF);
    const int tid = threadIdx.x, lane = tid & 63, wave = __builtin_amdgcn_readfirstlane(tid >> 6);
    const int G = gridDim.x, bx = blockIdx.x;
    const int vcu = (G % 8 == 0) ? (bx % 8) * (G / 8) + bx / 8 : bx;
    unsigned char* ws = args.ws;
    unsigned* ctl = (unsigned*)(ws + WS_CTL);
    const float* x = args.in[0]; const float* meta = args.in[1]; const float* g1 = args.in[2]; const float* w_in = args.in[3];
    const float* qg = args.in[4]; const float* kg = args.in[5];
    const float* w_ab = args.in[7]; const float* w_rb = args.in[8]; const float* w_out = args.in[9];
    const float* w_gu = args.in[13]; const float* b_gu = args.in[14]; const float* w_dn = args.in[15]; const float* b_dn = args.in[16];
    float* out = args.out;
    bf16* Win_t = (bf16*)(ws + WS_WIN); bf16* Wab_t = (bf16*)(ws + WS_WAB); bf16* Wrb_t = (bf16*)(ws + WS_WRB); bf16* Wout_t = (bf16*)(ws + WS_WOUT);
    unsigned char* Wgu_t = ws + WS_WGU; unsigned char* Wdn_t = ws + WS_WDN;
    bf16* xb = (bf16*)(ws + WS_XB); bf16* proj = (bf16*)(ws + WS_PROJ); bf16* yatt = (bf16*)(ws + WS_YATT); bf16* yret = (bf16*)(ws + WS_YRET); bf16* merged = (bf16*)(ws + WS_MERGED);
    bf16* pmeta = proj + (size_t)NTOK * INW;
    const float* sinks = args.in[6]; const float* g2 = args.in[10]; const float* w_r = args.in[11]; const float* b_r = args.in[12];
    int* tke = (int*)(ws + SM_TKE); float* tkw = (float*)(ws + SM_TKW); int* tkpos = (int*)(ws + SM_TKPOS); int* list = (int*)(ws + SM_LIST); float* wlist = (float*)(ws + SM_WLIST); float* rlist = (float*)(ws + SM_RLIST);
    LAS unsigned char* misc = lds + MISC_OFF;
    bf16* states = (bf16*)(ws + ret::WS_STATES);
    unsigned char* act = ws + WS_ACT; unsigned char* rows = ws + WS_ROWS; unsigned char* xn8 = ws + WS_XB;

    for (int u = tid; u < (LDS_BYTES - MISC_OFF) / 4; u += 512) ((LAS unsigned*)(lds + MISC_OFF))[u] = 0u;
    __syncthreads();
    XcdBarrier bar = xcd_barrier_post(ctl + CW_BAR + args.li * XCD_BAR_WORDS, MISC + 8);
    const int lo = args.ph_lo, hi = args.ph_hi;
#define IN(k) (lo <= (k) && (k) < hi)
#define BOTH(k) (IN(k) && IN((k) + 1))
#define GRID_BAR() xcd_barrier(bar)

    if (IN(0)) { for (int rep_ = 0; rep_ < ((PROBE_PHASE == 0) ? 2 : 1); ++rep_) {
        const int gw = vcu * NWAVES + wave, NGW = G * NWAVES;
        constexpr int I_IN = 8 * 200, I_SQ = 8 * 32, I_GU = 32 * 8 * 64, I_DN = 32 * 8 * 32;
        constexpr int NITEMS = I_IN + 3 * I_SQ + I_GU + I_DN;
        for (int rep2_ = 0; rep2_ < ((PROBE_PHASE == 100) ? 2 : 1); ++rep2_)
        for (int it = gw; it < NITEMS; it += NGW) {
            int r = it;
            if (r < I_IN) { const int kb = r / 200, nb = r % 200, n0 = nb * 32, o = n0 & 255, wcc = o >> 6, bj = (o >> 5) & 1;
                p0_item<false>(w_in, D, INW, Win_t, kb * 128, n0, (n0 & ~255) + 128 * bj + 32 * wcc, lane); continue; }
            r -= I_IN;
            if (r < I_SQ) { p0_item<false>(w_ab, D, D, Wab_t, (r / 32) * 128, (r % 32) * 32, (r % 32) * 32, lane); continue; } r -= I_SQ;
            if (r < I_SQ) { p0_item<false>(w_rb, D, D, Wrb_t, (r / 32) * 128, (r % 32) * 32, (r % 32) * 32, lane); continue; } r -= I_SQ;
            if (r < I_SQ) { p0_item<false>(w_out, D, D, Wout_t, (r / 32) * 128, (r % 32) * 32, (r % 32) * 32, lane); continue; } r -= I_SQ;
            if (r < I_GU) { const int e = r / 512, q = r % 512, kb = q / 64, nb = q % 64, n0 = nb * 32, bj = n0 >> 10, rem = n0 & 1023, pn = rem >> 7, cl = rem & 127;
                p0_item<true>(w_gu + (size_t)e * D * 2048, D, 2048, Wgu_t + (size_t)e * 2048 * D, kb * 128, n0, 256 * pn + 128 * bj + cl, lane); continue; }
            r -= I_GU;
            { const int e = r / 256, q = r % 256, kb = q / 32, nb = q % 32;
              p0_item<true>(w_dn + (size_t)e * DFF * D, DFF, D, Wdn_t + (size_t)e * D * DFF, kb * 128, nb * 32, nb * 32, lane); }
        }
        for (int rep2_ = 0; rep2_ < ((PROBE_PHASE == 101) ? 2 : 1); ++rep2_)
        for (int row = gw; row < NTOK; row += NGW) {
            const f32x4* xr = (const f32x4*)(x + (size_t)row * D) + lane;
            f32x4 v[4]; float ss = 0.f;
#pragma unroll
            for (int j = 0; j < 4; ++j) { v[j] = xr[64 * j]; ss += (v[j][0] * v[j][0] + v[j][1] * v[j][1]) + (v[j][2] * v[j][2] + v[j][3] * v[j][3]); }
            const float rstd = rsqrtf(wave_sum(ss) * (1.0f / D) + EPS);
            u32x2* o8 = (u32x2*)(xb + (size_t)row * D) + lane;
#pragma unroll
            for (int j = 0; j < 4; ++j) { const f32x4 gg = ((const f32x4*)g1)[64 * j + lane]; u32x2 w; w.x = pk2(v[j][0] * rstd * gg[0], v[j][1] * rstd * gg[1]); w.y = pk2(v[j][2] * rstd * gg[2], v[j][3] * rstd * gg[3]); o8[64 * j] = w; }
        }
        for (int row = gw; row < 256; row += NGW) {
            u32x2* o8 = (u32x2*)(xb + (size_t)(NTOK + row) * D) + lane;
            if (row < NMETA) {
                const f32x4* xr = (const f32x4*)(meta + (size_t)row * D) + lane;
                f32x4 v[4]; float ss = 0.f;
#pragma unroll
                for (int j = 0; j < 4; ++j) { v[j] = xr[64 * j]; ss += (v[j][0] * v[j][0] + v[j][1] * v[j][1]) + (v[j][2] * v[j][2] + v[j][3] * v[j][3]); }
                const float rstd = rsqrtf(wave_sum(ss) * (1.0f / D) + EPS);
#pragma unroll
                for (int j = 0; j < 4; ++j) { const f32x4 gg = ((const f32x4*)g1)[64 * j + lane]; u32x2 w; w.x = pk2(v[j][0] * rstd * gg[0], v[j][1] * rstd * gg[1]); w.y = pk2(v[j][2] * rstd * gg[2], v[j][3] * rstd * gg[3]); o8[64 * j] = w; }
            } else {
#pragma unroll
                for (int j = 0; j < 4; ++j) o8[64 * j] = (u32x2){0u, 0u};
            }
        }
        __syncthreads(); }
        if (BOTH(0)) GRID_BAR();
    }
    if (PROBE_PHASE == 200) { GRID_BAR(); GRID_BAR(); GRID_BAR(); GRID_BAR(); }
    if (IN(1)) {
        SchedDense S; S.init(xb, Win_t, NTOK + 256, INW, D, G, bx);
        EpiProj E{proj, qg, kg};
        for (int rep_ = 0; rep_ < ((PROBE_PHASE == 1) ? 2 : 1); ++rep_) pg8::gemm_phase<EpiProj, SchedDense>(lds, 2 * D, S, E);
        if (BOTH(1)) GRID_BAR();
    }
    if (IN(2)) {
        float mq = fabsf(qg[lane]), mk = fabsf(kg[lane]);
#pragma unroll
        for (int o = 1; o < 64; o <<= 1) { mq = fmaxf(mq, __shfl_xor(mq, o)); mk = fmaxf(mk, __shfl_xor(mk, o)); }
        const float bshift = 8.0f * mq * mk;
        for (int rep_ = 0; rep_ < ((PROBE_PHASE == 20) ? 2 : 1); ++rep_) attn::phase(lds, proj, pmeta, sinks, bshift, yatt, G, bx);
        for (int rep_ = 0; rep_ < ((PROBE_PHASE == 21) ? 2 : 1); ++rep_) for (int u = bx; u < NB * 4 * 8; u += G) { const int v = ((G & 7) == 0 && G == 256) ? ((u & 7) * 32 + (u >> 3)) : u;
            ret::state_chain(lds, v >> 5, (v >> 3) & 3, v & 7, proj, pmeta, states); }
        if (BOTH(2)) GRID_BAR();
    }
    if (IN(3)) {
        for (int rep_ = 0; rep_ < ((PROBE_PHASE == 3) ? 2 : 1); ++rep_) ret::out_phase(lds, proj, states, yret, G, bx);
        if (BOTH(3)) GRID_BAR();
    }
    if (IN(4)) {
        SchedBranch S{(const char*)yatt, (const char*)yret, (const char*)Wab_t, (const char*)Wrb_t, G, bx};
        EpiBranch E{merged, proj};
        for (int rep_ = 0; rep_ < ((PROBE_PHASE == 4) ? 2 : 1); ++rep_) pg8::gemm_phase<EpiBranch, SchedBranch>(lds, 2 * D, S, E);
        if (BOTH(4)) GRID_BAR();
    }
    if (IN(5)) {
        SchedDense S; S.init(merged, Wout_t, NTOK, D, D, G, bx);
        EpiOut E{x, out};
        for (int rep_ = 0; rep_ < ((PROBE_PHASE == 5) ? 2 : 1); ++rep_) pg8::gemm_phase<EpiOut, SchedDense>(lds, 2 * D, S, E);
        if (BOTH(5)) GRID_BAR();
    }
    if (IN(6)) {
        route_phase(lds, out, g2, w_r, b_r, xn8, tke, tkpos, tkw, list, wlist, rlist, ctl + CW_CNT, G, bx);
        if (BOTH(6)) GRID_BAR();
    }
    if (hi > 7 && lo <= 9) moe_tables(misc, ctl + CW_CNT);
    if (IN(7)) {
        SchedMoe<true, 8> S{(const char*)xn8, (const char*)Wgu_t, misc, list, G, bx};
        EpiGU E{act, b_gu, rlist, misc};
        for (int rep_ = 0; rep_ < ((PROBE_PHASE == 7) ? 2 : 1); ++rep_) pg8::gemm_phase<EpiGU, SchedMoe<true, 8>, true>(lds, D, S, E);
        if (BOTH(7)) GRID_BAR();
    }
    if (IN(8)) {
        SchedMoe<false, 4> S{(const char*)act, (const char*)Wdn_t, misc, list, G, bx};
        EpiDown E{rows, b_dn, wlist, misc};
        for (int rep_ = 0; rep_ < ((PROBE_PHASE == 8) ? 2 : 1); ++rep_) pg8::gemm_phase<EpiDown, SchedMoe<false, 4>, true>(lds, DFF, S, E);
        if (BOTH(8)) GRID_BAR();
    }
    if (IN(9)) combine_phase(misc, (void*)proj, out, rows, tke, tkpos, vcu * NWAVES + wave, G * NWAVES, lane);
#undef IN
#undef BOTH
#undef GRID_BAR
}

extern "C" void kernel_launch(void* const* d_in, const int* in_sizes, int n_in, void* d_out, int out_size, void* d_ws, size_t ws_size, hipStream_t stream) {
    static int grid = 0;
    if (grid == 0) {
        if (n_in != 17 || in_sizes[0] != NTOK * D || out_size != NTOK * D || ws_size < WS_END) {
            fprintf(stderr, "kernel_launch: unexpected shapes (n_in %d in0 %d out %d ws %zu)\n", n_in, n_in > 0 ? in_sizes[0] : -1, out_size, ws_size); grid = -1; return; }
        int dev = 0, cus = 0;
        if (hipGetDevice(&dev) != hipSuccess || hipDeviceGetAttribute(&cus, hipDeviceAttributeMultiprocessorCount, dev) != hipSuccess) { grid = -1; return; }
        if (hipFuncSetAttribute((const void*)mk_fwd, hipFuncAttributeMaxDynamicSharedMemorySize, LDS_BYTES) != hipSuccess) { fprintf(stderr, "kernel_launch: hipFuncSetAttribute failed\n"); grid = -1; return; }
        grid = cus;
    }
    if (grid < 0) return;
    unsigned char* ws = (unsigned char*)d_ws;
    (void)hipMemsetAsync(ws + WS_CTL, 0, 1 * MiB, stream);
    Args a{};
    for (int i = 0; i < 17; ++i) a.in[i] = (const float*)d_in[i];
    a.out = (float*)d_out; a.ws = ws; a.ph_lo = 0; a.ph_hi = 10; a.li = 0; a.pad = 0;
    hipLaunchKernelGGL(mk_fwd, dim3(grid), dim3(512), LDS_BYTES, stream, a);
}
```

```cpp
#include <hip/hip_runtime.h>
#include <cstdio>
#include <cstdint>

typedef unsigned short bf16;
__device__ __forceinline__ float bf2f(bf16 v) { return __uint_as_float(((unsigned)v) << 16); }
__device__ __forceinline__ bf16 f2bf(float f) { const __bf16 b = (__bf16)f; return __builtin_bit_cast(unsigned short, b); }
__device__ __forceinline__ float sigmoidf_(float x) { return __builtin_amdgcn_rcpf(1.0f + __builtin_amdgcn_exp2f(-1.4426950408889634f * x)); }

constexpr int NB = 8, SEQ = 4096, D = 1024, NTOK = NB * SEQ;
constexpr int NMETA = 16;
constexpr int INW = 6400;
constexpr int C_AQ = 0, C_AK = 1024, C_AV = 1152, C_RQ = 1280, C_RK = 1792, C_RV = 2304, C_RG = 3328, C_GA = 4352, C_GR = 5376;
constexpr int NE = 32, TOPK = 4, DFF = 1024;
constexpr int NROWS = (NTOK * TOPK / 256 + NE) * 256;
constexpr int NTILE = NROWS / 256;
constexpr float EPS = 1e-5f;

constexpr size_t MiB = 1u << 20;
constexpr size_t WS_CTL = 0;
constexpr size_t WS_SMALL = 1 * MiB;
constexpr size_t WS_W = 16 * MiB;
constexpr size_t WS_XB = 232 * MiB;
constexpr size_t WS_PROJ = 297 * MiB;
constexpr size_t WS_YATT = 701 * MiB;
constexpr size_t WS_YRET = 765 * MiB;
constexpr size_t WS_MERGED = 829 * MiB;
constexpr size_t WS_END = 1020 * MiB;
constexpr size_t WS_ACT = 297 * MiB;
constexpr size_t WS_ROWS = 568 * MiB;
constexpr size_t SM_UMETA = WS_SMALL;
constexpr size_t SM_PMETA = WS_SMALL + 64 * 1024;
constexpr size_t SM_TKE = WS_SMALL + 512 * 1024;
constexpr size_t SM_TKW = SM_TKE + 512 * 1024;
constexpr size_t SM_TKPOS = SM_TKW + 512 * 1024;
constexpr size_t SM_TKROW = SM_TKPOS + 512 * 1024;
constexpr size_t SM_ROWTOK = SM_TKROW + 512 * 1024;
constexpr size_t SM_ROWW = SM_ROWTOK + 1024 * 1024;
constexpr size_t SM_TILEE = SM_ROWW + 1024 * 1024;
constexpr int CW_CNT = 1024;

#define LAS __attribute__((address_space(3)))
#define GAS __attribute__((address_space(1)))
typedef short bf16x8 __attribute__((ext_vector_type(8)));
typedef float f32x4 __attribute__((ext_vector_type(4)));
typedef float f32x2 __attribute__((ext_vector_type(2)));
typedef unsigned u32x4 __attribute__((ext_vector_type(4)));
typedef unsigned u32x2 __attribute__((ext_vector_type(2)));
#define LDS_WAIT() asm volatile("s_waitcnt lgkmcnt(0)" ::: "memory")
#define VM_WAIT() asm volatile("s_waitcnt vmcnt(0)" ::: "memory")
typedef __bf16 bf16x2_t __attribute__((ext_vector_type(2)));
__device__ __forceinline__ unsigned pk2(float lo, float hi) { const f32x2 v = {lo, hi}; const bf16x2_t b = __builtin_convertvector(v, bf16x2_t); return __builtin_bit_cast(unsigned, b); }
__device__ __forceinline__ unsigned pk4_fp8(float a, float b, float c, float d) { int w = __builtin_amdgcn_cvt_pk_fp8_f32(a, b, 0, false); w = __builtin_amdgcn_cvt_pk_fp8_f32(c, d, w, true); return (unsigned)w; }
constexpr float W8_SCALE = 64.0f, W8_INV = 1.0f / 64.0f;
constexpr float ROW8_SCALE = 16.0f, ROW8_INV = 1.0f / 16.0f;
__device__ __forceinline__ float wave_sum(float v) {
#pragma unroll
    for (int o = 1; o < 64; o <<= 1) v += __shfl_xor(v, o);
    return v;
}

constexpr size_t WS_WIN = WS_W;
constexpr size_t WS_WAB = WS_W + 13 * MiB;
constexpr size_t WS_WRB = WS_W + 15 * MiB;
constexpr size_t WS_WOUT = WS_W + 17 * MiB;
constexpr size_t WS_WGU = WS_W + 19 * MiB;
constexpr size_t WS_WDN = WS_W + 147 * MiB;
static_assert(WS_WDN + 64 * MiB <= WS_XB, "weight map");
constexpr size_t SM_ATILE = SM_TILEE + 4096;
constexpr int CW_NACT = 1088;
constexpr int CW_BAR = 4096;

constexpr int RING_BYTES = 131072;
constexpr int MISC_OFF = RING_BYTES;
constexpr int LDS_BYTES = 147456;
constexpr int NWAVES = 8;

#define XB_TMO      128
#define XB_XCNT(j)  (256  + 64 * (j))
#define XB_XSUB(j)  (1280 + 64 * (j))
#define XB_XGEN(j)  (2304 + 64 * (j))
#define XB_TOP      3328
#define XB_TOPGEN   3392
#define XCD_BAR_WORDS 3456
#define XB_SPIN_CAP (1u << 20)
__device__ __forceinline__ unsigned xb_ld(unsigned* p)              { return __hip_atomic_load(p, __ATOMIC_RELAXED, __HIP_MEMORY_SCOPE_AGENT); }
__device__ __forceinline__ unsigned xb_add(unsigned* p, unsigned v) { return __hip_atomic_fetch_add(p, v, __ATOMIC_RELAXED, __HIP_MEMORY_SCOPE_AGENT); }
__device__ __forceinline__ unsigned xb_xcc_id() { return (unsigned)__builtin_amdgcn_s_getreg((3 << 11) | 20) & 0xFu; }
#define XB_SPIN(cond, bar) do { unsigned _sp = 0; while (cond) { __builtin_amdgcn_s_sleep(1); \
    if ((++_sp & 255u) == 0u) { if (xb_ld(&(bar)[XB_TMO])) break; if (_sp > XB_SPIN_CAP) { atomicAdd(&(bar)[XB_TMO], 1u); break; } } } } while (0)
struct XcdBarrier { unsigned* bar; unsigned x; volatile LAS unsigned* st; };
__device__ __forceinline__ XcdBarrier xcd_barrier_post(unsigned* bar, volatile LAS unsigned* st) {
    XcdBarrier b; b.bar = bar; b.x = xb_xcc_id(); b.st = st;
    if (threadIdx.x == 0) (void)xb_add(&bar[XB_XCNT(b.x)], 1u);
    return b;
}
__device__ __forceinline__ void xcd_barrier_complete(unsigned* bar, unsigned x, unsigned& nloc, unsigned& nx) {
    const unsigned G = gridDim.x * gridDim.y * gridDim.z;
    unsigned sum, cnt, mine, sp = 0u;
    for (;;) {
        sum = 0u; cnt = 0u; mine = 0u;
#pragma unroll
        for (unsigned j = 0; j < 16; ++j) { const unsigned c = xb_ld(&bar[XB_XCNT(j)]); sum += c; cnt += (c > 0u) ? 1u : 0u; mine = (j == x) ? c : mine; }
        if (sum == G) break;
        __builtin_amdgcn_s_sleep(1);
        if ((++sp & 255u) == 0u) { if (xb_ld(&bar[XB_TMO])) break; if (sp > XB_SPIN_CAP) { atomicAdd(&bar[XB_TMO], 1u); break; } }
    }
    nloc = mine > 0u ? mine : 1u; nx = cnt > 0u ? cnt : 1u;
}
__device__ __forceinline__ void xcd_barrier(const XcdBarrier& b) {
    asm volatile("s_waitcnt vmcnt(0)" ::: "memory");
    __syncthreads();
    if (threadIdx.x == 0) {
        unsigned* bar = b.bar;
        __builtin_amdgcn_s_waitcnt(0);
        unsigned nloc = b.st[0], nx = b.st[1];
        if (nloc == 0u) { xcd_barrier_complete(bar, b.x, nloc, nx); b.st[0] = nloc; b.st[1] = nx; }
        const unsigned old = xb_add(&bar[XB_XSUB(b.x)], 1u);
        const unsigned gen = old / nloc;
        if (old + 1u == (gen + 1u) * nloc) {
            __builtin_amdgcn_fence(__ATOMIC_RELEASE, "agent");
            asm volatile("s_waitcnt vmcnt(0)" ::: "memory");
            const unsigned og = xb_add(&bar[XB_TOP], 1u);
            const unsigned tg = og / nx;
            if (og + 1u == (tg + 1u) * nx) xb_add(&bar[XB_TOPGEN], 1u);
            else XB_SPIN(xb_ld(&bar[XB_TOPGEN]) == tg, bar);
            __builtin_amdgcn_fence(__ATOMIC_ACQUIRE, "agent");
            xb_add(&bar[XB_XGEN(b.x)], 1u);
            asm volatile("s_waitcnt vmcnt(0)" ::: "memory");
        } else {
            XB_SPIN(xb_ld(&bar[XB_XGEN(b.x)]) == gen, bar);
            __builtin_amdgcn_fence(__ATOMIC_ACQUIRE, "agent");
            asm volatile("s_waitcnt vmcnt(0)" ::: "memory");
        }
    }
    __syncthreads();
}

namespace pg8 {
constexpr int BM = 256, BK = 64, HALF = 128, HTB = HALF * BK * 2, STAGE_BYTES = 8 * HTB;
__host__ __device__ __forceinline__ int lds_byte(int r, int c) { const int st = (r >> 4) * 2 + (c >> 5), rr = r & 15, cc = c & 31, ob = rr * 64 + cc * 2; return st * 1024 + (ob ^ (((ob >> 9) & 1) << 5)); }
__host__ __device__ __forceinline__ void stage_rc(int b, int& R, int& C) { const int st = b / 1024, sb = b % 1024, swz = sb ^ (((sb >> 9) & 1) << 5); R = (st >> 1) * 16 + swz / 64; C = (st & 1) * 32 + (swz % 64) / 2; }
__host__ __device__ __forceinline__ int perm32(int rho) { const int n = rho >> 4, i = rho & 15; return 8 * (i >> 2) + 4 * n + (i & 3); }
struct Unit { int pm, pn, aux, tl; const char* A; const char* B; };
typedef f32x4 Acc[2][2][4][2];
typedef int u32x4_i __attribute__((ext_vector_type(4)));

typedef int v8i32 __attribute__((ext_vector_type(8)));
template <class Epi, class Sched, bool FP8 = false>
__device__ __forceinline__ void gemm_phase(LAS unsigned char* lds, const int Kb, const Sched& S, const Epi& E) {
    const int tid = threadIdx.x, wid = __builtin_amdgcn_readfirstlane(tid >> 6), lane = tid & 63, wr = wid >> 2, wc = wid & 3, fr = lane & 15, fq = lane >> 4;
    const int nt = Kb / 128;
    int RA[2], CA[2]; unsigned voffB[2];
#pragma unroll
    for (int i = 0; i < 2; ++i) { int R, C; stage_rc(tid * 16 + i * 8192, R, C); const int Rb = Epi::PERM ? ((R & ~31) + perm32(R & 31)) : R;
        RA[i] = R; CA[i] = C; voffB[i] = (unsigned)(Rb * Kb + C * 2); }
    const size_t kstep = (size_t)(BK * 2);
    const size_t hstep = (size_t)HALF * Kb;
    const unsigned ldsw = (unsigned)wid * 1024u;
    const int aoff = lds_byte(wr * 64 + fr, fq * 8), boff = lds_byte(wc * 32 + fr, fq * 8);
#define PG8_SA(b, h) (((b) * 2 + (h)) * HTB)
#define PG8_SB(b, h) ((4 + (b) * 2 + (h)) * HTB)
#define PG8_STAGE(bufoff, gbase, voff) do { _Pragma("unroll") for (int _i = 0; _i < 2; ++_i) \
        __builtin_amdgcn_global_load_lds((const unsigned*)((const char*)(gbase) + (voff)[_i]), (LAS unsigned*)(lds + (bufoff) + ldsw + _i * 8192), 16, 0, 0); } while (0)
#define PG8_LDA(dst, b, h) do { _Pragma("unroll") for (int m = 0; m < 4; ++m) _Pragma("unroll") for (int k = 0; k < 2; ++k) dst[m][k] = *(const LAS bf16x8*)(lds + PG8_SA(b, h) + aoff + m * 2048 + k * 1024); } while (0)
#define PG8_LDB(dst, b, h) do { _Pragma("unroll") for (int n = 0; n < 2; ++n) _Pragma("unroll") for (int k = 0; k < 2; ++k) dst[n][k] = *(const LAS bf16x8*)(lds + PG8_SB(b, h) + boff + n * 2048 + k * 1024); } while (0)
#define PG8_MMA(ai, bj, At, Bt) do { __builtin_amdgcn_s_setprio(1); _Pragma("unroll") for (int m = 0; m < 4; ++m) _Pragma("unroll") for (int n = 0; n < 2; ++n) { \
        if constexpr (FP8) { const v8i32 bq = __builtin_shufflevector(__builtin_bit_cast(u32x4_i, Bt[n][0]), __builtin_bit_cast(u32x4_i, Bt[n][1]), 0, 1, 2, 3, 4, 5, 6, 7), \
                                         aq = __builtin_shufflevector(__builtin_bit_cast(u32x4_i, At[m][0]), __builtin_bit_cast(u32x4_i, At[m][1]), 0, 1, 2, 3, 4, 5, 6, 7); \
            asm volatile("v_mfma_scale_f32_16x16x128_f8f6f4 %0, %1, %2, %0, %3, %3 op_sel_hi:[0,0,0]" : "+v"(acc[ai][bj][m][n]) : "v"(bq), "v"(aq), "v"(scale1)); } \
        else { _Pragma("unroll") for (int k = 0; k < 2; ++k) acc[ai][bj][m][n] = __builtin_amdgcn_mfma_f32_16x16x32_bf16(Bt[n][k], At[m][k], acc[ai][bj][m][n], 0, 0, 0); } } \
        __builtin_amdgcn_s_setprio(0); } while (0)
#define PG8_WAIT_V(n) asm volatile("s_waitcnt vmcnt(" #n ")" ::: "memory")
#define PG8_WAIT_L(n) asm volatile("s_waitcnt lgkmcnt(" #n ")" ::: "memory")
#define PG8_BAR __builtin_amdgcn_s_barrier()
#define PG8_SCHED __builtin_amdgcn_sched_barrier(0)
    int scale1 = 0x7f7f7f7f; asm volatile("" : "+v"(scale1));
    Unit cur, nxt; int ui = 0;
    if (!S.next(0, cur)) return;
    unsigned ca[2][2], na[2][2];
    S.aoff(cur, RA, CA, ca);
    f32x4 acc[2][2][4][2];
#pragma unroll
    for (int a = 0; a < 2; ++a)
#pragma unroll
        for (int b = 0; b < 2; ++b)
#pragma unroll
            for (int m = 0; m < 4; ++m)
#pragma unroll
                for (int n = 0; n < 2; ++n) acc[a][b][m][n] = (f32x4){0.f, 0.f, 0.f, 0.f};
    bf16x8 At[4][2], B0[2][2], B1[2][2];
    const char* cA = cur.A; const char* cB = cur.B;
    E.prefetch(cur, 0, wid, lane);
    PG8_STAGE(PG8_SB(0, 0), cB, voffB); PG8_STAGE(PG8_SB(0, 1), cB + hstep, voffB); PG8_STAGE(PG8_SA(0, 0), cA, ca[0]); PG8_STAGE(PG8_SA(0, 1), cA, ca[1]);
    if (wr == 1) PG8_BAR;
    PG8_WAIT_V(2); PG8_BAR;
    PG8_STAGE(PG8_SB(1, 0), cB + kstep, voffB); PG8_STAGE(PG8_SA(1, 0), cA + kstep, ca[0]); PG8_STAGE(PG8_SB(1, 1), cB + hstep + kstep, voffB);
    PG8_WAIT_V(6); PG8_BAR;
    for (;;) {
        const bool has_next = S.next(ui + 1, nxt);
        if constexpr (Sched::GATHER) {
            if (has_next) S.aoff(nxt, RA, CA, na);
            else {
#pragma unroll
                for (int h = 0; h < 2; ++h)
#pragma unroll
                    for (int i = 0; i < 2; ++i) na[h][i] = ca[h][i];
            }
        }
        const char* nA = has_next ? nxt.A : cA; const char* nB = has_next ? nxt.B : cB;
#pragma nounroll
        for (int t = 0; t < nt; t += 2) {
            const bool last = (t == nt - 2);
            const char* a1 = cA + (size_t)(t + 1) * kstep;
            const char* a2 = last ? nA : cA + (size_t)(t + 2) * kstep; const char* b2 = last ? nB : cB + (size_t)(t + 2) * kstep;
            const char* a3 = a2 + kstep; const char* b3 = b2 + kstep;
            unsigned o2[2][2];
#pragma unroll
            for (int h = 0; h < 2; ++h)
#pragma unroll
                for (int i = 0; i < 2; ++i) { if constexpr (Sched::GATHER) o2[h][i] = last ? na[h][i] : ca[h][i]; else o2[h][i] = ca[h][i]; }
            PG8_LDB(B0, 0, 0); PG8_LDB(B1, 0, 1); PG8_SCHED; PG8_LDA(At, 0, 0); PG8_STAGE(PG8_SA(1, 1), a1, ca[1]);
            PG8_WAIT_V(8); PG8_WAIT_L(0); PG8_BAR; PG8_MMA(0, 0, At, B0); PG8_MMA(0, 1, At, B1); PG8_BAR; PG8_SCHED;
            PG8_LDA(At, 0, 1); PG8_STAGE(PG8_SB(0, 0), b2, voffB); PG8_STAGE(PG8_SB(0, 1), b2 + hstep, voffB); PG8_STAGE(PG8_SA(0, 0), a2, o2[0]);
            PG8_WAIT_V(8); PG8_WAIT_L(0); PG8_BAR; PG8_MMA(1, 0, At, B0); PG8_MMA(1, 1, At, B1); PG8_BAR; PG8_SCHED;
            PG8_LDB(B0, 1, 0); PG8_LDB(B1, 1, 1); PG8_SCHED; PG8_LDA(At, 1, 0); PG8_STAGE(PG8_SA(0, 1), a2, o2[1]);
            PG8_WAIT_V(8); PG8_WAIT_L(0); PG8_BAR; PG8_MMA(0, 0, At, B0); PG8_MMA(0, 1, At, B1); PG8_BAR; PG8_SCHED;
            PG8_LDA(At, 1, 1); PG8_STAGE(PG8_SB(1, 0), b3, voffB); PG8_STAGE(PG8_SB(1, 1), b3 + hstep, voffB); PG8_STAGE(PG8_SA(1, 0), a3, o2[0]);
            PG8_WAIT_V(8); PG8_WAIT_L(0); PG8_BAR; PG8_MMA(1, 0, At, B0); PG8_MMA(1, 1, At, B1); PG8_BAR; PG8_SCHED;
        }
        if constexpr (FP8) { asm volatile("s_nop 15\n\ts_nop 15\n\ts_nop 15" ::: "memory"); PG8_SCHED; }
        if (wr == 0) PG8_BAR;
        { int fr_ = fr, fq_ = fq; asm volatile("" : "+v"(fr_), "+v"(fq_));
          E(acc, cur, wr, wc, fr_, fq_, ui & 1); }
        if (!has_next) break;
#pragma unroll
        for (int a = 0; a < 2; ++a)
#pragma unroll
            for (int b = 0; b < 2; ++b)
#pragma unroll
                for (int m = 0; m < 4; ++m)
#pragma unroll
                    for (int n = 0; n < 2; ++n) acc[a][b][m][n] = (f32x4){0.f, 0.f, 0.f, 0.f};
        cur = nxt; cA = nA; cB = nB; ++ui;
        E.prefetch(cur, ui & 1, wid, lane);
        if constexpr (Sched::GATHER) {
#pragma unroll
            for (int h = 0; h < 2; ++h)
#pragma unroll
                for (int i = 0; i < 2; ++i) ca[h][i] = na[h][i];
        }
        if (wr == 1) PG8_BAR;
    }
    PG8_WAIT_V(0);
    PG8_BAR;
#undef PG8_SA
#undef PG8_SB
#undef PG8_STAGE
#undef PG8_LDA
#undef PG8_LDB
#undef PG8_MMA
#undef PG8_WAIT_V
#undef PG8_WAIT_L
#undef PG8_BAR
#undef PG8_SCHED
}
}
#ifndef PROBE_PHASE
#define PROBE_PHASE (-1)
#endif
constexpr size_t SM_LIST = WS_SMALL + 2 * MiB;
constexpr size_t SM_WLIST = WS_SMALL + 6 * MiB;
constexpr size_t SM_RLIST = WS_SMALL + 10 * MiB;
constexpr int MT_PSTART = 256;
constexpr int MT_CNT = 512;
constexpr int MT_NACT = 768;
constexpr int MT_ATILE = 1024;
constexpr int MT_HIST = 4096;
constexpr int MT_BASE = 4224;
constexpr int MT_REC = 4352;
constexpr int MT_RSTD = 10496;
constexpr int MT_EPI = 11264;
constexpr int MT_EPI2 = 13312;
constexpr int MT_GAIN = 15360;

__device__ __forceinline__ void moe_tables(LAS unsigned char* misc, const unsigned* cnt) {
    LAS int* pstart = (LAS int*)(misc + MT_PSTART); LAS int* cl = (LAS int*)(misc + MT_CNT); LAS int* at = (LAS int*)(misc + MT_ATILE);
    __syncthreads();
    if (threadIdx.x < 64) {
        const int lane = threadIdx.x, e = lane & 31;
        const int c = (int)__hip_atomic_load(cnt + e, __ATOMIC_RELAXED, __HIP_MEMORY_SCOPE_AGENT), nt = (c + 255) >> 8;
        int incl = nt;
#pragma unroll
        for (int o = 1; o < 32; o <<= 1) { const int v = __shfl_up(incl, o); if (e >= o) incl += v; }
        const int t0 = incl - nt;
        if (lane < 32) { cl[e] = c; pstart[e] = t0 << 8; for (int t = 0; t < nt; ++t) at[t0 + t] = (t0 + t) | (e << 12) | (t << 20);
            if (e == 31) { pstart[NE] = incl << 8; *(LAS int*)(misc + MT_NACT) = incl; } }
    }
    __syncthreads();
}

__device__ __forceinline__ void route_phase(LAS unsigned char* lds, const float* __restrict__ h2, const float* __restrict__ g2, const float* __restrict__ wr, const float* __restrict__ br,
                                            unsigned char* __restrict__ xg8, int* __restrict__ tke, int* __restrict__ tkpos, float* __restrict__ tkw, int* __restrict__ list, float* __restrict__ wlist,
                                            float* __restrict__ rlist, unsigned* __restrict__ cnt, int G, int bx) {
    typedef float f32x16 __attribute__((ext_vector_type(16)));
    const int tid = threadIdx.x, lane = tid & 63, r32 = lane & 31, hi = lane >> 5; const int wave = __builtin_amdgcn_readfirstlane(tid >> 6);
    LAS unsigned char* misc = lds + MISC_OFF;
    LAS int* hist = (LAS int*)(misc + MT_HIST); LAS int* base = (LAS int*)(misc + MT_BASE); LAS int* rec = (LAS int*)(misc + MT_REC); LAS float* rstd_l = (LAS float*)(misc + MT_RSTD);
    for (int idx = tid; idx < 128 * 32; idx += 512) {
        const int c = idx >> 5, e = idx & 31; float v[8]; unsigned hw[4], lw[4];
#pragma unroll
        for (int j = 0; j < 8; ++j) v[j] = wr[(size_t)(8 * c + j) * NE + e] * g2[8 * c + j];
#pragma unroll
        for (int j = 0; j < 4; ++j) { hw[j] = pk2(v[2 * j], v[2 * j + 1]); lw[j] = pk2(v[2 * j] - __uint_as_float(hw[j] << 16), v[2 * j + 1] - __uint_as_float(hw[j] & 0xffff0000u)); }
        *(LAS u32x4*)(lds + idx * 16) = (u32x4){hw[0], hw[1], hw[2], hw[3]};
        *(LAS u32x4*)(lds + 65536 + idx * 16) = (u32x4){lw[0], lw[1], lw[2], lw[3]};
    }
    __syncthreads();
    const int tile = wave & 3;
    for (int tb = bx; tb < NTOK / 128; tb += G) {
        if (tid < 32) hist[tid] = 0;
        __syncthreads();
        for (int rep_ = 0; rep_ < ((PROBE_PHASE == 6) ? 2 : 1); ++rep_)
        if (wave < 4) {
        const int token = tb * 128 + tile * 32 + r32;
        const float* xp = h2 + (size_t)token * D + 8 * hi;
        unsigned char* x8p = xg8 + (size_t)token * D + 8 * hi;
        const float* gp = g2 + 8 * hi;
        f32x16 c = {};
        float ss = 0.f;
        f32x4 xa[8][2];
#pragma unroll
        for (int p = 0; p < 8; ++p) { xa[p][0] = *(const f32x4*)(xp + 16 * p); xa[p][1] = *(const f32x4*)(xp + 16 * p + 4); }
#pragma unroll 1
        for (int ks0 = 0; ks0 < 64; ks0 += 8) {
#pragma unroll
            for (int p = 0; p < 8; ++p) {
                const int ks = ks0 + p;
                const f32x4 x0 = xa[p][0], x1 = xa[p][1];
                if (ks + 8 < 64) { xa[p][0] = *(const f32x4*)(xp + 16 * (ks + 8)); xa[p][1] = *(const f32x4*)(xp + 16 * (ks + 8) + 4); }
                ss += (x0[0] * x0[0] + x0[1] * x0[1]) + (x0[2] * x0[2] + x0[3] * x0[3]) + (x1[0] * x1[0] + x1[1] * x1[1]) + (x1[2] * x1[2] + x1[3] * x1[3]);
                { const f32x4 g0 = *(const f32x4*)(gp + 16 * ks), g1 = *(const f32x4*)(gp + 16 * ks + 4);
                  u32x2 w8; w8.x = pk4_fp8(x0[0] * g0[0], x0[1] * g0[1], x0[2] * g0[2], x0[3] * g0[3]); w8.y = pk4_fp8(x1[0] * g1[0], x1[1] * g1[1], x1[2] * g1[2], x1[3] * g1[3]);
                  *(u32x2*)(x8p + 16 * ks) = w8; }
                u32x4 xh, xl;
                xh.x = pk2(x0[0], x0[1]); xh.y = pk2(x0[2], x0[3]); xh.z = pk2(x1[0], x1[1]); xh.w = pk2(x1[2], x1[3]);
                xl.x = pk2(x0[0] - __uint_as_float(xh.x << 16), x0[1] - __uint_as_float(xh.x & 0xffff0000u)); xl.y = pk2(x0[2] - __uint_as_float(xh.y << 16), x0[3] - __uint_as_float(xh.y & 0xffff0000u));
                xl.z = pk2(x1[0] - __uint_as_float(xh.z << 16), x1[1] - __uint_as_float(xh.z & 0xffff0000u)); xl.w = pk2(x1[2] - __uint_as_float(xh.w << 16), x1[3] - __uint_as_float(xh.w & 0xffff0000u));
                const int chunk = 2 * ks + hi;
                const bf16x8 wh = *(const LAS bf16x8*)(lds + (chunk * 32 + r32) * 16), wl = *(const LAS bf16x8*)(lds + 65536 + (chunk * 32 + r32) * 16);
                c = __builtin_amdgcn_mfma_f32_32x32x16_bf16(wh, __builtin_bit_cast(bf16x8, xh), c, 0, 0, 0);
                c = __builtin_amdgcn_mfma_f32_32x32x16_bf16(wl, __builtin_bit_cast(bf16x8, xh), c, 0, 0, 0);
                c = __builtin_amdgcn_mfma_f32_32x32x16_bf16(wh, __builtin_bit_cast(bf16x8, xl), c, 0, 0, 0);
            }
        }
        {
            ss += __shfl_xor(ss, 32);
            const float rstd = rsqrtf(ss * (1.0f / D) + EPS);
            float vals[16];
#pragma unroll
            for (int r = 0; r < 16; ++r) vals[r] = c[r] * rstd + br[(r & 3) + 8 * (r >> 2) + 4 * hi];
            float tv[4]; int te[4];
#pragma unroll
            for (int k = 0; k < 4; ++k) {
                float m = -3.0e38f; int mi = 0;
#pragma unroll
                for (int r = 0; r < 16; ++r) { const bool gt = vals[r] > m; m = gt ? vals[r] : m; mi = gt ? r : mi; }
                tv[k] = m; te[k] = (mi & 3) + 8 * (mi >> 2) + 4 * hi;
#pragma unroll
                for (int r = 0; r < 16; ++r) vals[r] = (r == mi) ? -3.0e38f : vals[r];
            }
            float cv[8]; int ce[8];
#pragma unroll
            for (int k = 0; k < 4; ++k) { cv[k] = tv[k]; ce[k] = te[k]; cv[4 + k] = __shfl_xor(tv[k], 32); ce[4 + k] = __shfl_xor(te[k], 32); }
            float fv[4]; int fe[4];
#pragma unroll
            for (int k = 0; k < 4; ++k) {
                float m = -3.0e38f; int me = 64; int mi = 0;
#pragma unroll
                for (int q = 0; q < 8; ++q) { const bool better = (cv[q] > m) || (cv[q] == m && ce[q] < me); m = better ? cv[q] : m; me = better ? ce[q] : me; mi = better ? q : mi; }
                fv[k] = m; fe[k] = me;
#pragma unroll
                for (int q = 0; q < 8; ++q) cv[q] = (q == mi) ? -3.0e38f : cv[q];
            }
            if (hi == 0 && (PROBE_PHASE != 6 || rep_ == 1)) {
                const float e0 = 1.0f, e1 = __expf(fv[1] - fv[0]), e2 = __expf(fv[2] - fv[0]), e3 = __expf(fv[3] - fv[0]);
                const float inv = 1.0f / (e0 + e1 + e2 + e3);
                const float wts[4] = {e0 * inv, e1 * inv, e2 * inv, e3 * inv};
                const int tl = tile * 32 + r32;
                rstd_l[tl] = rstd;
#pragma unroll
                for (int k = 0; k < 4; ++k) {
                    const int lp = __hip_atomic_fetch_add(hist + fe[k], 1, __ATOMIC_RELAXED, __HIP_MEMORY_SCOPE_WORKGROUP);
                    LAS int* r = rec + (tl * 4 + k) * 3; r[0] = fe[k]; r[1] = lp; r[2] = __float_as_int(wts[k]);
                }
            }
        }
        }
        __syncthreads();
        if (tid < 32) base[tid] = (int)atomicAdd(&cnt[tid], (unsigned)hist[tid]);
        __syncthreads();
        { const int tl = tid >> 2; const int tok = tb * 128 + tl; LAS int* r = rec + tid * 3; const int e = r[0], pos = base[e] + r[1]; const float w = __int_as_float(r[2]);
          tke[tok * 4 + (tid & 3)] = e; tkpos[tok * 4 + (tid & 3)] = pos; tkw[tok * 4 + (tid & 3)] = w;
          list[e * NTOK + pos] = tok; wlist[e * NTOK + pos] = w; rlist[e * NTOK + pos] = rstd_l[tl]; }
        __syncthreads();
    }
}

__device__ __forceinline__ void combine_phase(LAS unsigned char* misc, void* scratch_out, float* __restrict__ out, const unsigned char* __restrict__ rows, const int* __restrict__ tke, const int* __restrict__ tkpos, int gw, int NGW, int lane) {
    LAS const int* pstart = (LAS const int*)(misc + MT_PSTART);
    for (int rep_ = 0; rep_ < ((PROBE_PHASE == 9) ? 2 : 1); ++rep_)
    for (int token = gw; token < NTOK; token += NGW) {
        int rr[4];
#pragma unroll
        for (int k = 0; k < 4; ++k) rr[k] = pstart[tke[token * 4 + k]] + tkpos[token * 4 + k];
        f32x4* o = (f32x4*)(out + (size_t)token * D) + lane;
        f32x4 v[4], s[4];
#pragma unroll
        for (int j = 0; j < 4; ++j) { v[j] = o[64 * j]; s[j] = (f32x4){0.f, 0.f, 0.f, 0.f}; }
#pragma unroll
        for (int k = 0; k < 4; ++k) {
            const unsigned* rp = (const unsigned*)(rows + (size_t)rr[k] * D) + lane;
#pragma unroll
            for (int j = 0; j < 4; ++j) { const unsigned w = rp[64 * j];
                const f32x2 lo = __builtin_amdgcn_cvt_pk_f32_fp8((int)w, false), hh = __builtin_amdgcn_cvt_pk_f32_fp8((int)w, true);
                s[j][0] += lo[0]; s[j][1] += lo[1]; s[j][2] += hh[0]; s[j][3] += hh[1]; }
        }
#pragma unroll
        for (int j = 0; j < 4; ++j) v[j] = v[j] + s[j] * ROW8_INV;
        if (PROBE_PHASE == 9 && rep_ == 0) {
#pragma unroll
            for (int j = 0; j < 4; ++j) { asm volatile("" :: "v"(v[j])); *(f32x4*)((float*)scratch_out + (size_t)token * D + (64 * j + lane) * 4) = v[j]; }
        } else {
#pragma unroll
        for (int j = 0; j < 4; ++j) o[64 * j] = v[j];
        }
    }
}
struct SchedDense {
    static constexpr bool GATHER = false;
    const char* A; const char* Bt; int K, nM, nN, nwg, G, c;
    __device__ void init(const bf16* A_, const bf16* Bt_, int M, int N, int K_, int G_, int c_) { A = (const char*)A_; Bt = (const char*)Bt_; K = K_; nM = M / 256; nN = N / 256; nwg = nM * nN; G = G_; c = c_; }
    __device__ __forceinline__ bool next(int i, pg8::Unit& u) const {
        const long L = (long)i * G + c; if (L >= nwg) return false;
        int wgid = (int)L; { const int q = nwg / 8, r = nwg % 8, xcd = wgid % 8, off = wgid / 8; wgid = (xcd < r ? xcd * (q + 1) : r * (q + 1) + (xcd - r) * q) + off; }
        const int nig = 8 * nN, gid = wgid / nig, fm = gid * 8, gsz = (nM - fm) < 8 ? (nM - fm) : 8;
        u.pm = fm + ((wgid % nig) % gsz); u.pn = (wgid % nig) / gsz; u.aux = 0; u.tl = 0;
        u.A = A + (size_t)u.pm * 256 * K * 2; u.B = Bt + (size_t)u.pn * 256 * K * 2; return true;
    }
    __device__ __forceinline__ void aoff(const pg8::Unit&, const int (&R)[2], const int (&C)[2], unsigned (&o)[2][2]) const {
#pragma unroll
        for (int h = 0; h < 2; ++h)
#pragma unroll
            for (int i = 0; i < 2; ++i) o[h][i] = (unsigned)((128 * h + R[i]) * K + C[i]) * 2u;
    }
};
struct SchedBranch {
    static constexpr bool GATHER = false;
    const char* A0; const char* A1; const char* B0; const char* B1; int G, c;
    __device__ __forceinline__ bool next(int i, pg8::Unit& u) const {
        const int L = (i >> 1) * G + c; if (L >= 512) return false;
        int wgid = L; { const int off = wgid / 8, xcd = wgid % 8; wgid = xcd * 64 + off; }
        const int nig = 8 * 4, gid = wgid / nig;
        u.pm = gid * 8 + ((wgid % nig) % 8); u.pn = (wgid % nig) / 8; u.aux = i & 1; u.tl = 0;
        u.A = ((i & 1) ? A1 : A0) + (size_t)u.pm * 256 * D * 2; u.B = ((i & 1) ? B1 : B0) + (size_t)u.pn * 256 * D * 2; return true;
    }
    __device__ __forceinline__ void aoff(const pg8::Unit&, const int (&R)[2], const int (&C)[2], unsigned (&o)[2][2]) const {
#pragma unroll
        for (int h = 0; h < 2; ++h)
#pragma unroll
            for (int i = 0; i < 2; ++i) o[h][i] = (unsigned)((128 * h + R[i]) * D + C[i]) * 2u;
    }
};
template <bool GATHER_, int NPN>
struct SchedMoe {
    static constexpr bool GATHER = GATHER_;
    const char* A; const char* Bt; LAS const unsigned char* misc; const int* list; int G, c;
    __device__ __forceinline__ bool next(int i, pg8::Unit& u) const {
        LAS const int* cl = (LAS const int*)(misc + MT_CNT); LAS const int* ps = (LAS const int*)(misc + MT_PSTART);
        if ((G & 7) == 0) {
            const int x = c & 7, r = c >> 3, n = G >> 3;
            int k = (i * n + r) / NPN; const int pn = (i * n + r) % NPN;
#pragma unroll
            for (int j = 0; j < 4; ++j) { const int e = x + 8 * j, nt = (cl[e] + 255) >> 8;
                if (k < nt) { u.pn = pn; u.aux = e; u.tl = k; u.pm = (ps[e] >> 8) + k;
                    u.A = GATHER ? A : A + (size_t)u.pm * 256 * 1024; u.B = Bt + ((size_t)e * NPN + pn) * 256 * 1024; return true; }
                k -= nt; }
            return false;
        }
        const int nact = *(LAS const int*)(misc + MT_NACT);
        const int L = i * G + c; if (L >= nact * NPN) return false;
        const int k = L / NPN; u.pn = L % NPN; const int w = ((LAS const int*)(misc + MT_ATILE))[k];
        u.pm = w & 0xfff; u.aux = (w >> 12) & 0xff; u.tl = w >> 20;
        u.A = GATHER ? A : A + (size_t)u.pm * 256 * 1024;
        u.B = Bt + ((size_t)u.aux * NPN + u.pn) * 256 * 1024; return true;
    }
    __device__ __forceinline__ void aoff(const pg8::Unit& u, const int (&R)[2], const int (&C)[2], unsigned (&o)[2][2]) const {
        const int ce = ((LAS const int*)(misc + MT_CNT))[u.aux];
#pragma unroll
        for (int h = 0; h < 2; ++h)
#pragma unroll
            for (int i = 0; i < 2; ++i) {
                if (GATHER) { const int idx = u.tl * 256 + 128 * h + R[i]; const int tok = (idx < ce) ? list[u.aux * NTOK + idx] : 0; o[h][i] = (unsigned)tok * 1024u + (unsigned)C[i] * 2u; }
                else o[h][i] = (unsigned)((128 * h + R[i]) * 1024 + C[i] * 2);
            }
    }
};

__device__ __forceinline__ u32x4 pack8(const f32x4& a, const f32x4& b) { u32x4 w; w.x = pk2(a[0], a[1]); w.y = pk2(a[2], a[3]); w.z = pk2(b[0], b[1]); w.w = pk2(b[2], b[3]); return w; }
__device__ __forceinline__ void unpack8(const u32x4& w, float (&f)[8]) {
    f[0] = __uint_as_float(w.x << 16); f[1] = __uint_as_float(w.x & 0xffff0000u); f[2] = __uint_as_float(w.y << 16); f[3] = __uint_as_float(w.y & 0xffff0000u);
    f[4] = __uint_as_float(w.z << 16); f[5] = __uint_as_float(w.z & 0xffff0000u); f[6] = __uint_as_float(w.w << 16); f[7] = __uint_as_float(w.w & 0xffff0000u);
}
struct EpiProj {
    static constexpr bool PERM = true;
    __device__ __forceinline__ void prefetch(const pg8::Unit&, int, int, int) const {}
    bf16* proj; LAS const float* gtab;
    __device__ __forceinline__ void operator()(pg8::Acc& acc, const pg8::Unit& u, int wr, int wc, int fr, int fq, int slot) const {
        const int pn = u.pn;
        int mode;
        if (pn < 4) mode = 1; else if (pn == 4) mode = (wc < 2) ? 2 : 0; else if (pn < 7) mode = 0; else if (pn < 9) mode = 3; else if (pn < 13) mode = 0; else if (pn < 17) mode = 4; else mode = 5;
        float gn[2][8];
        if (mode == 1 || mode == 2) { LAS const float* g = gtab + ((mode == 1) ? 0 : 64);
#pragma unroll
            for (int bj = 0; bj < 2; ++bj)
#pragma unroll
                for (int j = 0; j < 8; ++j) gn[bj][j] = g[32 * bj + 8 * fq + j]; }
#pragma unroll
        for (int ai = 0; ai < 2; ++ai)
#pragma unroll
            for (int m = 0; m < 4; ++m) {
                const int r = u.pm * 256 + ai * 128 + wr * 64 + m * 16 + fr;
                bf16* rowp = proj + (size_t)r * INW + pn * 256 + wc * 64 + 8 * fq;
                f32x4 v[2][2];
#pragma unroll
                for (int bj = 0; bj < 2; ++bj) { v[bj][0] = acc[ai][bj][m][0]; v[bj][1] = acc[ai][bj][m][1]; }
                if (mode == 1 || mode == 2) {
                    float ss = 0.f;
#pragma unroll
                    for (int bj = 0; bj < 2; ++bj)
#pragma unroll
                        for (int n = 0; n < 2; ++n) ss += v[bj][n][0] * v[bj][n][0] + v[bj][n][1] * v[bj][n][1] + v[bj][n][2] * v[bj][n][2] + v[bj][n][3] * v[bj][n][3];
                    ss += __shfl_xor(ss, 16); ss += __shfl_xor(ss, 32);
                    const float rs = rsqrtf(ss * (1.0f / 64.0f) + EPS);
#pragma unroll
                    for (int bj = 0; bj < 2; ++bj)
#pragma unroll
                        for (int n = 0; n < 2; ++n)
#pragma unroll
                            for (int i = 0; i < 4; ++i) v[bj][n][i] = v[bj][n][i] * rs * gn[bj][4 * n + i];
                } else if (mode == 3) {
#pragma unroll
                    for (int bj = 0; bj < 2; ++bj)
#pragma unroll
                        for (int n = 0; n < 2; ++n) v[bj][n] = v[bj][n] * 0.08838834764831845f;
                } else if (mode == 4) {
#pragma unroll
                    for (int bj = 0; bj < 2; ++bj)
#pragma unroll
                        for (int n = 0; n < 2; ++n)
#pragma unroll
                            for (int i = 0; i < 4; ++i) { const float x = v[bj][n][i]; v[bj][n][i] = x * sigmoidf_(x); }
                } else if (mode == 5) {
#pragma unroll
                    for (int bj = 0; bj < 2; ++bj)
#pragma unroll
                        for (int n = 0; n < 2; ++n)
#pragma unroll
                            for (int i = 0; i < 4; ++i) v[bj][n][i] = sigmoidf_(v[bj][n][i]);
                }
#pragma unroll
                for (int bj = 0; bj < 2; ++bj) *(u32x4*)(rowp + 32 * bj) = pack8(v[bj][0], v[bj][1]);
            }
    }
};
struct EpiBranch {
    static constexpr bool PERM = true;
    __device__ __forceinline__ void prefetch(const pg8::Unit&, int, int, int) const {}
    bf16* merged; const bf16* proj;
    __device__ __forceinline__ void operator()(pg8::Acc& acc, const pg8::Unit& u, int wr, int wc, int fr, int fq, int slot) const {
        const int gcol = u.aux ? C_GR : C_GA;
#pragma unroll
        for (int ai = 0; ai < 2; ++ai)
#pragma unroll
            for (int mp = 0; mp < 2; ++mp) {
                u32x4 gw[2][2], pw[2][2];
#pragma unroll
                for (int mm = 0; mm < 2; ++mm)
#pragma unroll
                    for (int bj = 0; bj < 2; ++bj) {
                        const int r = u.pm * 256 + ai * 128 + wr * 64 + (2 * mp + mm) * 16 + fr, col = u.pn * 256 + bj * 128 + wc * 32 + 8 * fq;
                        gw[mm][bj] = *(const u32x4*)(proj + (size_t)r * INW + gcol + col);
                        if (u.aux) pw[mm][bj] = *(const u32x4*)(merged + (size_t)r * D + col);
                    }
#pragma unroll
                for (int mm = 0; mm < 2; ++mm)
#pragma unroll
                    for (int bj = 0; bj < 2; ++bj) {
                        const int m = 2 * mp + mm;
                        const int r = u.pm * 256 + ai * 128 + wr * 64 + m * 16 + fr, col = u.pn * 256 + bj * 128 + wc * 32 + 8 * fq;
                        float g[8]; unpack8(gw[mm][bj], g);
                        f32x4 a = acc[ai][bj][m][0], b = acc[ai][bj][m][1];
                        a[0] *= g[0]; a[1] *= g[1]; a[2] *= g[2]; a[3] *= g[3]; b[0] *= g[4]; b[1] *= g[5]; b[2] *= g[6]; b[3] *= g[7];
                        if (u.aux) { float p[8]; unpack8(pw[mm][bj], p);
                            a[0] += p[0]; a[1] += p[1]; a[2] += p[2]; a[3] += p[3]; b[0] += p[4]; b[1] += p[5]; b[2] += p[6]; b[3] += p[7]; }
                        *(u32x4*)(merged + (size_t)r * D + col) = pack8(a, b);
                    }
            }
    }
};
struct EpiOut {
    static constexpr bool PERM = false;
    __device__ __forceinline__ void prefetch(const pg8::Unit&, int, int, int) const {}
    const float* x; float* out;
    __device__ __forceinline__ void operator()(pg8::Acc& acc, const pg8::Unit& u, int wr, int wc, int fr, int fq, int slot) const {
#pragma unroll
        for (int ai = 0; ai < 2; ++ai)
#pragma unroll
            for (int mp = 0; mp < 2; ++mp) {
                f32x4 xv[2][2][2];
#pragma unroll
                for (int mm = 0; mm < 2; ++mm) { const size_t off = (size_t)(u.pm * 256 + ai * 128 + wr * 64 + (2 * mp + mm) * 16 + fr) * D + u.pn * 256 + wc * 32 + 4 * fq;
#pragma unroll
                    for (int bj = 0; bj < 2; ++bj)
#pragma unroll
                        for (int n = 0; n < 2; ++n) xv[mm][bj][n] = *(const f32x4*)(x + off + bj * 128 + n * 16); }
#pragma unroll
                for (int mm = 0; mm < 2; ++mm) { const size_t off = (size_t)(u.pm * 256 + ai * 128 + wr * 64 + (2 * mp + mm) * 16 + fr) * D + u.pn * 256 + wc * 32 + 4 * fq;
#pragma unroll
                    for (int bj = 0; bj < 2; ++bj)
#pragma unroll
                        for (int n = 0; n < 2; ++n) *(f32x4*)(out + off + bj * 128 + n * 16) = xv[mm][bj][n] + acc[ai][bj][2 * mp + mm][n]; }
            }
    }
};
struct EpiGU {
    static constexpr bool PERM = true;
    unsigned char* act; const float* bgu; const float* rlist; LAS unsigned char* misc;
    __device__ __forceinline__ void prefetch(const pg8::Unit& u, int slot, int wid, int lane) const {
        if (wid < 4) __builtin_amdgcn_global_load_lds((const unsigned*)(rlist + (size_t)u.aux * NTOK + u.tl * 256 + wid * 64 + lane), (LAS unsigned*)(misc + MT_EPI + slot * 1024 + wid * 256), 4, 0, 0);
        else __builtin_amdgcn_global_load_lds((const unsigned*)(bgu + (size_t)u.aux * 2048 + ((wid - 4) >> 1) * 1024 + u.pn * 128 + ((wid - 4) & 1) * 64 + lane), (LAS unsigned*)(misc + MT_EPI2 + slot * 1024 + (wid - 4) * 256), 4, 0, 0);
    }
    __device__ __forceinline__ void operator()(pg8::Acc& acc, const pg8::Unit& u, int wr, int wc, int fr, int fq, int slot) const {
        const int ce = ((LAS const int*)(misc + MT_CNT))[u.aux];
        const int col = u.pn * 128 + wc * 32 + 8 * fq;
        LAS const float* bl = (LAS const float*)(misc + MT_EPI2 + slot * 1024) + wc * 32 + 8 * fq;
        float bgate[8], bup[8];
#pragma unroll
        for (int j = 0; j < 8; ++j) { bgate[j] = bl[j]; bup[j] = bl[128 + j]; }
#pragma unroll
        for (int ai = 0; ai < 2; ++ai)
#pragma unroll
            for (int m = 0; m < 4; ++m) {
                const int lr = ai * 128 + wr * 64 + m * 16 + fr, r = u.pm * 256 + lr;
                const float rs = ((LAS const float*)(misc + MT_EPI + slot * 1024))[lr] * W8_INV;
                float o[8];
#pragma unroll
                for (int n = 0; n < 2; ++n)
#pragma unroll
                    for (int i = 0; i < 4; ++i) {
                        float gate = acc[ai][0][m][n][i] * rs + bgate[4 * n + i], up = acc[ai][1][m][n][i] * rs + bup[4 * n + i];
                        gate = fminf(gate, 7.0f); up = fminf(fmaxf(up, -7.0f), 7.0f);
                        o[4 * n + i] = (up + 1.0f) * gate * sigmoidf_(1.702f * gate);
                    }
                u32x2 w; w.x = pk4_fp8(o[0], o[1], o[2], o[3]); w.y = pk4_fp8(o[4], o[5], o[6], o[7]);
                *(u32x2*)(act + (size_t)r * DFF + col) = w;
            }
    }
};
struct EpiDown {
    static constexpr bool PERM = true;
    unsigned char* rows; const float* bdn; const float* wlist; LAS const unsigned char* misc;
    __device__ __forceinline__ void prefetch(const pg8::Unit& u, int slot, int wid, int lane) const {
        if (wid < 4) __builtin_amdgcn_global_load_lds((const unsigned*)(wlist + (size_t)u.aux * NTOK + u.tl * 256 + wid * 64 + lane), (LAS unsigned*)(misc + MT_EPI + slot * 1024 + wid * 256), 4, 0, 0);
        else __builtin_amdgcn_global_load_lds((const unsigned*)(bdn + (size_t)u.aux * D + u.pn * 256 + (wid - 4) * 64 + lane), (LAS unsigned*)(misc + MT_EPI2 + slot * 1024 + (wid - 4) * 256), 4, 0, 0);
    }
    __device__ __forceinline__ void operator()(pg8::Acc& acc, const pg8::Unit& u, int wr, int wc, int fr, int fq, int slot) const {
        const int ce = ((LAS const int*)(misc + MT_CNT))[u.aux];
#pragma unroll
        for (int ai = 0; ai < 2; ++ai)
#pragma unroll
            for (int m = 0; m < 4; ++m) {
                const int lr = ai * 128 + wr * 64 + m * 16 + fr, r = u.pm * 256 + lr, idx = u.tl * 256 + lr;
                const float w = (idx < ce) ? ((LAS const float*)(misc + MT_EPI + slot * 1024))[lr] * ROW8_SCALE : 0.f;
                LAS const float* bl = (LAS const float*)(misc + MT_EPI2 + slot * 1024) + wc * 32 + 8 * fq;
                asm volatile("" : "+v"(bl));
#pragma unroll
                for (int bj = 0; bj < 2; ++bj) {
                    const f32x4 b0 = *(const LAS f32x4*)(bl + bj * 128), b1 = *(const LAS f32x4*)(bl + bj * 128 + 4);
                    f32x4 a = acc[ai][bj][m][0], b = acc[ai][bj][m][1];
#pragma unroll
                    for (int i = 0; i < 4; ++i) { a[i] = (a[i] * W8_INV + b0[i]) * w; b[i] = (b[i] * W8_INV + b1[i]) * w; }
                    u32x2 o; o.x = pk4_fp8(a[0], a[1], a[2], a[3]); o.y = pk4_fp8(b[0], b[1], b[2], b[3]);
                    *(u32x2*)(rows + (size_t)r * D + u.pn * 256 + bj * 128 + wc * 32 + 8 * fq) = o;
                }
            }
    }
};
namespace attn {
typedef float f32x16 __attribute__((ext_vector_type(16)));
typedef short s16x4 __attribute__((ext_vector_type(4)));
constexpr int NK = 272, K_OFF = 0, V_OFF = 34816, WS_OFF = 69632, OST_OFF = 71680, LDS_END = OST_OFF + 8 * 4096;
constexpr float LOG2E = 1.4426950408889634f;
__device__ __forceinline__ s16x4 vtr(LAS const unsigned char* p) { return __builtin_bit_cast(s16x4, __builtin_amdgcn_ds_read_tr16_b64_v4i16((LAS s16x4*)p)); }
__device__ __forceinline__ int crowc(int r) { return (r & 3) + 8 * (r >> 2); }

template <int TYPE, bool DIAG>
__device__ __forceinline__ void tile(LAS const unsigned char* lds, int kbase, const bf16x8 (&qr)[4], f32x16 (&o)[2], float& l, float lanebase, float c1, int tt, int lane) {
    const int r32 = lane & 31, hi = lane >> 5;
    f32x16 p = {};
#pragma unroll
    for (int d0 = 0; d0 < 4; ++d0) {
        const bf16x8 kf = *(const LAS bf16x8*)(lds + K_OFF + (2 * d0 + hi) * (NK * 16) + (kbase + r32) * 16);
        p = __builtin_amdgcn_mfma_f32_32x32x16_bf16(kf, qr[d0], p, 0, 0, 0);
    }
    constexpr int NR = (TYPE == 0) ? 8 : 16;
    float e[16];
#pragma unroll
    for (int r = 0; r < NR; ++r) {
        const float add = __builtin_fmaf(c1, (float)crowc(r), lanebase);
        float v = __builtin_amdgcn_exp2f(__builtin_fmaf(p[r], LOG2E, add));
        if (DIAG) { const bool ok = (TYPE == 1) ? (crowc(r) > tt) : (crowc(r) <= tt); v = ok ? v : 0.f; }
        e[r] = v; l += v;
    }
    constexpr int NS = (TYPE == 0) ? 1 : 2;
    u32x4 pw[2];
#pragma unroll
    for (int s = 0; s < NS; ++s) { pw[s].x = pk2(e[8 * s + 0], e[8 * s + 1]); pw[s].y = pk2(e[8 * s + 2], e[8 * s + 3]); pw[s].z = pk2(e[8 * s + 4], e[8 * s + 5]); pw[s].w = pk2(e[8 * s + 6], e[8 * s + 7]); }
    LAS const unsigned char* vb = lds + V_OFF + (kbase + 4 * hi + ((lane & 15) >> 2)) * 64 + ((lane >> 4) & 1) * 32 + (lane & 3) * 8;
#pragma unroll
    for (int d0 = 0; d0 < 2; ++d0)
#pragma unroll
        for (int s = 0; s < NS; ++s) {
            const s16x4 lo = vtr(vb + d0 * (NK * 64) + s * 1024), hh = vtr(vb + d0 * (NK * 64) + s * 1024 + 512);
            const bf16x8 vf = (bf16x8){lo[0], lo[1], lo[2], lo[3], hh[0], hh[1], hh[2], hh[3]};
            o[d0] = __builtin_amdgcn_mfma_f32_32x32x16_bf16(__builtin_bit_cast(bf16x8, pw[s]), vf, o[d0], 0, 0, 0);
        }
}

#define AT_ISSUE(u_) do { const int u__ = (u_); const int b_ = u__ >> 6, qb_ = (u__ >> 1) & 31, kvh_ = u__ & 1; \
        _Pragma("unroll") for (int i = 0; i < 5; ++i) { const int idx = tid + 512 * i; if (idx < NK * 8) { const int key = idx >> 3, c = idx & 7; const bf16* rowp; \
            if (key < 16) rowp = pmeta + (size_t)key * INW; else { int j = qb_ * 128 - 128 + (key - 16); if (j < 0) j = 0; rowp = proj + ((size_t)b_ * SEQ + j) * INW; } \
            pk[i] = *(const u32x4*)(rowp + C_AK + kvh_ * 64 + c * 8); pv[i] = *(const u32x4*)(rowp + C_AV + kvh_ * 64 + c * 8); } } } while (0)
#define AT_QLOAD(dst, a_) do { const size_t qrow_ = (size_t)b * SEQ + qb * 128 + 32 * (a_) + r32; \
        _Pragma("unroll") for (int d0 = 0; d0 < 4; ++d0) dst[d0] = *(const bf16x8*)(proj + qrow_ * INW + C_AQ + h * 64 + d0 * 16 + hi * 8); } while (0)
__device__ __forceinline__ void phase(LAS unsigned char* lds, const bf16* __restrict__ proj, const bf16* __restrict__ pmeta, const float* __restrict__ sinks, float bshift, bf16* __restrict__ yatt, int G, int bx) {
    const int tid = threadIdx.x, lane = tid & 63, r32 = lane & 31, hi = lane >> 5; const int wave = __builtin_amdgcn_readfirstlane(tid >> 6);
    constexpr int NU = NB * 32 * 2;
    if (bx >= NU) return;
    u32x4 pk[5], pv[5];
    AT_ISSUE(bx);
    for (int u = bx; u < NU; u += G) {
        const int b = u >> 6, qb = (u >> 1) & 31, kvh = u & 1;
#pragma unroll
        for (int i = 0; i < 5; ++i) { const int idx = tid + 512 * i; if (idx < NK * 8) { const int key = idx >> 3, c = idx & 7;
            *(LAS u32x4*)(lds + K_OFF + c * (NK * 16) + key * 16) = pk[i];
            *(LAS u32x4*)(lds + V_OFF + (c >> 2) * (NK * 64) + key * 64 + (c & 3) * 16) = pv[i]; } }
        if (u + G < NU) AT_ISSUE(u + G);
        const int h = kvh * 8 + wave;
        bf16x8 qr[4], qn[4];
        AT_QLOAD(qr, 0);
        __syncthreads();
        const float slope = exp2f(-0.5f * (float)(h + 1)), sink = sinks[h];
        const float M = fmaxf(bshift, sink);
        const float c1 = slope * LOG2E;
        LAS float* wsf = (LAS float*)(lds + WS_OFF) + wave * 64;
        LAS bf16* stg = (LAS bf16*)(lds + OST_OFF) + wave * 2048;
#pragma unroll 1
        for (int a = 0; a < 4; ++a) {
            if (a < 3) AT_QLOAD(qn, a + 1);
            f32x16 o[2]; o[0] = f32x16{}; o[1] = f32x16{};
            float l = 0.f;
            const int t = 32 * a + r32;
            const int tt = r32 - 4 * hi;
            const float hi4 = c1 * 4.0f * (float)hi;
            tile<0, false>(lds, 0, qr, o, l, -(slope * (float)(qb * 128 + t + 16) + M) * LOG2E + hi4, c1, tt, lane);
            if (qb > 0) {
                tile<1, true>(lds, 16 + 32 * a, qr, o, l, -(slope * (float)(128 + r32) + M) * LOG2E + hi4, c1, tt, lane);
                for (int bb = a + 1; bb < 4; ++bb) tile<1, false>(lds, 16 + 32 * bb, qr, o, l, -(slope * (float)(128 + t - 32 * bb) + M) * LOG2E + hi4, c1, tt, lane);
            }
            for (int bb = 0; bb < a; ++bb) tile<2, false>(lds, 144 + 32 * bb, qr, o, l, -(slope * (float)(t - 32 * bb) + M) * LOG2E + hi4, c1, tt, lane);
            tile<2, true>(lds, 144 + 32 * a, qr, o, l, -(slope * (float)r32 + M) * LOG2E + hi4, c1, tt, lane);
            l += __shfl_xor(l, 32);
            l += exp2f((sink - M) * LOG2E);
            if (hi == 0) wsf[r32] = l;
            LDS_WAIT();
            float rli[16];
#pragma unroll
            for (int r = 0; r < 16; ++r) rli[r] = __builtin_amdgcn_rcpf(wsf[crowc(r) + 4 * hi]);
#pragma unroll
            for (int r = 0; r < 16; ++r) { const int orow = crowc(r) + 4 * hi;
#pragma unroll
                for (int d0 = 0; d0 < 2; ++d0) stg[orow * 64 + d0 * 32 + r32] = f2bf(o[d0][r] * rli[r]); }
            LDS_WAIT();
            bf16* Ow = yatt + ((size_t)b * SEQ + qb * 128 + 32 * a) * D + h * 64;
#pragma unroll
            for (int i = 0; i < 4; ++i) { const int row = i * 8 + (lane >> 3), ch = lane & 7; const u32x4 v = *(const LAS u32x4*)(stg + row * 64 + ch * 8); *(u32x4*)(Ow + (size_t)row * D + ch * 8) = v; }
            LDS_WAIT();
#pragma unroll
            for (int d0 = 0; d0 < 4; ++d0) qr[d0] = qn[d0];
        }
        __syncthreads();
    }
}
#undef AT_ISSUE
#undef AT_QLOAD
}
namespace ret {
typedef float f32x16 __attribute__((ext_vector_type(16)));
typedef short s16x4 __attribute__((ext_vector_type(4)));
constexpr size_t WS_STATES = 893 * MiB;
__device__ __forceinline__ s16x4 vtr(LAS const unsigned char* p) { return __builtin_bit_cast(s16x4, __builtin_amdgcn_ds_read_tr16_b64_v4i16((LAS s16x4*)p)); }
__device__ __forceinline__ int crowc(int r) { return (r & 3) + 8 * (r >> 2); }
__device__ __forceinline__ float lg2gamma(int h) { return log2f(1.0f - exp2f(-5.0f - (float)h)); }

constexpr int R1_BUF = 40960;
#define RET_ISSUE(KR, VR, c_) do { const int ci__ = (c_); \
        _Pragma("unroll") for (int i = 0; i < 4; ++i) { const int idx = tid + 512 * i, key = idx >> 4, ch = idx & 15; \
            if (ci__ == 0) { KR[i] = (key >= 112) ? *(const u32x4*)(pmeta + (size_t)(key - 112) * INW + C_RK + h * 128 + ch * 8) : (u32x4){0u, 0u, 0u, 0u}; } \
            else KR[i] = *(const u32x4*)(proj + ((size_t)b * SEQ + (ci__ - 1) * 128 + key) * INW + C_RK + h * 128 + ch * 8); } \
        { const int key = tid >> 2, ch = tid & 3; \
          if (ci__ == 0) VR = (key >= 112) ? *(const u32x4*)(pmeta + (size_t)(key - 112) * INW + C_RV + h * 256 + dvs * 32 + ch * 8) : (u32x4){0u, 0u, 0u, 0u}; \
          else VR = *(const u32x4*)(proj + ((size_t)b * SEQ + (ci__ - 1) * 128 + key) * INW + C_RV + h * 256 + dvs * 32 + ch * 8); } } while (0)
#define RET_STEP(KR, VR, c_) do { const int c__ = (c_); LAS unsigned char* buf = lds + (c__ & 1) * R1_BUF; \
        _Pragma("unroll") for (int i = 0; i < 4; ++i) { const int idx = tid + 512 * i, key = idx >> 4, ch = idx & 15; *(LAS u32x4*)(buf + (ch >> 2) * (128 * 64) + key * 64 + (ch & 3) * 16) = KR[i]; } \
        { const int key = tid >> 2, ch = tid & 3; float f[8]; unpack8(VR, f); u32x4 w; \
          w.x = pk2(f[0] * vscale, f[1] * vscale); w.y = pk2(f[2] * vscale, f[3] * vscale); w.z = pk2(f[4] * vscale, f[5] * vscale); w.w = pk2(f[6] * vscale, f[7] * vscale); \
          *(LAS u32x4*)(buf + 32768 + key * 64 + ch * 16) = w; } \
        if (c__ + 2 < 32) RET_ISSUE(KR, VR, c__ + 2); \
        __syncthreads(); \
        if (wave < 4) { \
            const int dt = wave; \
            acc = acc * g128; \
            LAS const unsigned char* ab = buf + dt * (128 * 64) + (4 * hi + ((lane & 15) >> 2)) * 64 + ((lane >> 4) & 1) * 32 + (lane & 3) * 8; \
            LAS const unsigned char* bb = buf + 32768 + (4 * hi + ((lane & 15) >> 2)) * 64 + ((lane >> 4) & 1) * 32 + (lane & 3) * 8; \
            _Pragma("unroll") for (int ks = 0; ks < 8; ++ks) { \
                const s16x4 al = vtr(ab + ks * 1024), ah = vtr(ab + ks * 1024 + 512), bl = vtr(bb + ks * 1024), bh = vtr(bb + ks * 1024 + 512); \
                const bf16x8 af = (bf16x8){al[0], al[1], al[2], al[3], ah[0], ah[1], ah[2], ah[3]}, bfr = (bf16x8){bl[0], bl[1], bl[2], bl[3], bh[0], bh[1], bh[2], bh[3]}; \
                acc = __builtin_amdgcn_mfma_f32_32x32x16_bf16(af, bfr, acc, 0, 0, 0); } \
            bf16* sb = states + ((((size_t)(b * 4 + h) * 32 + c__) * 8 + dvs) * 8) * 512; \
            _Pragma("unroll") for (int g = 0; g < 4; ++g) { u32x2 w; w.x = pk2(acc[4 * g], acc[4 * g + 1]); w.y = pk2(acc[4 * g + 2], acc[4 * g + 3]); \
                *(u32x2*)(sb + (size_t)(2 * dt + (g >> 1)) * 512 + (32 * (g & 1) + (lane & 31)) * 8 + 4 * hi) = w; } \
        } } while (0)
__device__ __forceinline__ void state_chain(LAS unsigned char* lds, int b, int h, int dvs, const bf16* __restrict__ proj, const bf16* __restrict__ pmeta, bf16* __restrict__ states) {
    const int tid = threadIdx.x, lane = tid & 63, hi = lane >> 5; const int wave = __builtin_amdgcn_readfirstlane(tid >> 6);
    const float lg = lg2gamma(h), g128 = exp2f(lg * 128.0f);
    u32x4 kA[4], kB[4], vA, vB;
    const float vscale = exp2f(lg * (float)(127 - (tid >> 2)));
    f32x16 acc = {};
    RET_ISSUE(kA, vA, 0); RET_ISSUE(kB, vB, 1);
#pragma unroll 1
    for (int c = 0; c < 32; c += 2) { RET_STEP(kA, vA, c); RET_STEP(kB, vB, c + 1); }
    __syncthreads();
}
#undef RET_ISSUE
#undef RET_STEP

constexpr int R3_K = 0, R3_Q = 32768, R3_V = 65536;
#define R3_ISSUE(u_) do { const int u__ = (u_); const size_t rw = (size_t)(u__ >> 7) * SEQ + (u__ & 31) * 128; const int hh = (u__ >> 5) & 3; \
        _Pragma("unroll") for (int i = 0; i < 4; ++i) { const int idx = tid + 512 * i, key = idx >> 4, ch = idx & 15; \
            kq[i] = *(const u32x4*)(proj + (rw + key) * INW + C_RK + hh * 128 + ch * 8); kq[4 + i] = *(const u32x4*)(proj + (rw + key) * INW + C_RQ + hh * 128 + ch * 8); } \
        _Pragma("unroll") for (int i = 0; i < 8; ++i) { const int idx = tid + 512 * i, key = idx >> 5, ch = idx & 31; vv[i] = *(const u32x4*)(proj + (rw + key) * INW + C_RV + hh * 256 + ch * 8); } } while (0)
__device__ __forceinline__ void out_phase(LAS unsigned char* lds, const bf16* __restrict__ proj, const bf16* __restrict__ states, bf16* __restrict__ yret, int G, int bx) {
    const int tid = threadIdx.x, lane = tid & 63, r32 = lane & 31, hi = lane >> 5; const int wave = __builtin_amdgcn_readfirstlane(tid >> 6);
    constexpr int NU = NB * 4 * 32;
    if (bx >= NU) return;
    u32x4 kq[8], vv[8];
    R3_ISSUE(bx);
    for (int u = bx; u < NU; u += G) {
        const int b = u >> 7, h = (u >> 5) & 3, tb = u & 31;
        const float lg = lg2gamma(h);
        const size_t row0 = (size_t)b * SEQ + tb * 128;
#pragma unroll
        for (int i = 0; i < 4; ++i) { const int idx = tid + 512 * i, key = idx >> 4, ch = idx & 15;
            *(LAS u32x4*)(lds + R3_K + ch * 2048 + key * 16) = kq[i]; *(LAS u32x4*)(lds + R3_Q + ch * 2048 + key * 16) = kq[4 + i]; }
#pragma unroll
        for (int i = 0; i < 8; ++i) { const int idx = tid + 512 * i, key = idx >> 5, ch = idx & 31; *(LAS u32x4*)(lds + R3_V + (ch >> 2) * 8192 + key * 64 + (ch & 3) * 16) = vv[i]; }
        if (u + G < NU) R3_ISSUE(u + G);
        __syncthreads();
        u32x2 pw[2][4];
#pragma unroll
        for (int ti = 0; ti < 2; ++ti) {
            const int t = wave + 8 * ti;
            if (t < 10) {
                const int a = (t >= 6) ? 3 : (t >= 3) ? 2 : (t >= 1) ? 1 : 0, bb = t - ((a * (a + 1)) >> 1);
                f32x16 p = {};
#pragma unroll
                for (int k = 0; k < 8; ++k) {
                    const bf16x8 kf = *(const LAS bf16x8*)(lds + R3_K + (2 * k + hi) * 2048 + (32 * bb + r32) * 16);
                    const bf16x8 qf = *(const LAS bf16x8*)(lds + R3_Q + (2 * k + hi) * 2048 + (32 * a + r32) * 16);
                    p = __builtin_amdgcn_mfma_f32_32x32x16_bf16(kf, qf, p, 0, 0, 0);
                }
                const float lanebase = lg * (float)(32 * (a - bb) + r32 - 4 * hi), cpos = -lg; const int tt = r32 - 4 * hi;
                float e[16];
#pragma unroll
                for (int r = 0; r < 16; ++r) { float v = p[r] * __builtin_amdgcn_exp2f(__builtin_fmaf(cpos, (float)crowc(r), lanebase)); if (bb == a) v = (crowc(r) <= tt) ? v : 0.f; e[r] = v; }
#pragma unroll
                for (int g = 0; g < 4; ++g) { pw[ti][g].x = pk2(e[4 * g], e[4 * g + 1]); pw[ti][g].y = pk2(e[4 * g + 2], e[4 * g + 3]); }
            }
        }
        __builtin_amdgcn_sched_barrier(0);
        bf16x8 sf[8];
        { const bf16* sb = states + (((size_t)(b * 4 + h) * 32 + tb) * 64 + (size_t)wave * 8) * 512 + lane * 8;
#pragma unroll
          for (int k = 0; k < 8; ++k) sf[k] = *(const bf16x8*)(sb + (size_t)k * 512); }
        bf16x8 vf[8];
        { LAS const unsigned char* vb = lds + R3_V + wave * 8192 + (8 * hi + ((lane & 15) >> 2)) * 64 + ((lane >> 4) & 1) * 32 + (lane & 3) * 8;
#pragma unroll
          for (int ks = 0; ks < 8; ++ks) { const s16x4 lo = vtr(vb + ks * 1024), hh = vtr(vb + ks * 1024 + 256); vf[ks] = (bf16x8){lo[0], lo[1], lo[2], lo[3], hh[0], hh[1], hh[2], hh[3]}; } }
        __syncthreads();
#pragma unroll
        for (int ti = 0; ti < 2; ++ti) {
            const int t = wave + 8 * ti;
            if (t < 10) {
                const int a = (t >= 6) ? 3 : (t >= 3) ? 2 : (t >= 1) ? 1 : 0, bb = t - ((a * (a + 1)) >> 1);
#pragma unroll
                for (int g = 0; g < 4; ++g) *(LAS u32x2*)(lds + R3_K + (4 * bb + g) * 2048 + (32 * a + r32) * 16 + hi * 8) = pw[ti][g];
            }
        }
        __syncthreads();
        LAS bf16* stg = (LAS bf16*)(lds + R3_V);
#pragma unroll 1
        for (int a = 0; a < 4; ++a) {
            f32x16 o = {};
#pragma unroll
            for (int ks = 0; ks < 8; ++ks) if (ks < 2 * (a + 1)) {
                const bf16x8 pa = *(const LAS bf16x8*)(lds + R3_K + (2 * ks + hi) * 2048 + (32 * a + r32) * 16);
                o = __builtin_amdgcn_mfma_f32_32x32x16_bf16(pa, vf[ks], o, 0, 0, 0);
            }
            f32x16 x = {};
#pragma unroll
            for (int k = 0; k < 8; ++k) { const bf16x8 qa = *(const LAS bf16x8*)(lds + R3_Q + (2 * k + hi) * 2048 + (32 * a + r32) * 16); x = __builtin_amdgcn_mfma_f32_32x32x16_bf16(qa, sf[k], x, 0, 0, 0); }
#pragma unroll
            for (int r = 0; r < 16; ++r) {
                const float din = __builtin_amdgcn_exp2f(lg * (float)(32 * a + crowc(r) + 4 * hi + 1));
                stg[(32 * a + crowc(r) + 4 * hi) * 256 + wave * 32 + r32] = f2bf(o[r] + din * x[r]);
            }
        }
        __syncthreads();
#pragma unroll 4
        for (int i = 0; i < 16; ++i) {
            const int q = wave * 16 + i;
            const u32x2 sw = *(const LAS u32x2*)(stg + q * 256 + lane * 4);
            const float v0 = __uint_as_float(sw.x << 16), v1 = __uint_as_float(sw.x & 0xffff0000u), v2 = __uint_as_float(sw.y << 16), v3 = __uint_as_float(sw.y & 0xffff0000u);
            const float ss = wave_sum((v0 * v0 + v1 * v1) + (v2 * v2 + v3 * v3));
            const float rs = rsqrtf(ss * (1.0f / 256.0f) + EPS);
            const u32x2 gw = *(const u32x2*)(proj + (row0 + q) * INW + C_RG + h * 256 + lane * 4);
            u32x2 w; w.x = pk2(v0 * rs * __uint_as_float(gw.x << 16), v1 * rs * __uint_as_float(gw.x & 0xffff0000u)); w.y = pk2(v2 * rs * __uint_as_float(gw.y << 16), v3 * rs * __uint_as_float(gw.y & 0xffff0000u));
            *(u32x2*)(yret + (row0 + q) * D + h * 256 + lane * 4) = w;
        }
        __syncthreads();
    }
}
#undef R3_ISSUE
}
template <bool FP8>
__device__ __forceinline__ void p0_item(const float* __restrict__ W, int K, int N, void* __restrict__ WT, int k0, int n0, int dst_row0, int lane) {
    const int kblk = lane >> 3, nq = lane & 7;
    const float* src = W + (size_t)(k0 + 16 * kblk) * N + n0 + 4 * nq;
    f32x4 v[16];
#pragma unroll
    for (int i = 0; i < 16; ++i) v[i] = *(const f32x4*)(src + (size_t)i * N);
#pragma unroll
    for (int j = 0; j < 4; ++j) {
        const size_t row = (size_t)(dst_row0 + 4 * nq + j);
        if constexpr (FP8) {
            u32x4 o;
            o.x = pk4_fp8(v[0][j] * W8_SCALE, v[1][j] * W8_SCALE, v[2][j] * W8_SCALE, v[3][j] * W8_SCALE); o.y = pk4_fp8(v[4][j] * W8_SCALE, v[5][j] * W8_SCALE, v[6][j] * W8_SCALE, v[7][j] * W8_SCALE);
            o.z = pk4_fp8(v[8][j] * W8_SCALE, v[9][j] * W8_SCALE, v[10][j] * W8_SCALE, v[11][j] * W8_SCALE); o.w = pk4_fp8(v[12][j] * W8_SCALE, v[13][j] * W8_SCALE, v[14][j] * W8_SCALE, v[15][j] * W8_SCALE);
            *(u32x4*)((unsigned char*)WT + row * K + k0 + 16 * kblk) = o;
        } else {
            u32x4 a, b;
            a.x = pk2(v[0][j], v[1][j]); a.y = pk2(v[2][j], v[3][j]); a.z = pk2(v[4][j], v[5][j]); a.w = pk2(v[6][j], v[7][j]);
            b.x = pk2(v[8][j], v[9][j]); b.y = pk2(v[10][j], v[11][j]); b.z = pk2(v[12][j], v[13][j]); b.w = pk2(v[14][j], v[15][j]);
            bf16* d = (bf16*)WT + row * K + k0 + 16 * kblk;
            *(u32x4*)d = a; *(u32x4*)(d + 8) = b;
        }
    }
}
#ifndef PROBE_PHASE
#define PROBE_PHASE (-1)
#endif
__device__ __forceinline__ void p0_transpose_item_fp8(const float* W, int K, int N, unsigned char* WT, int k0, int n0, int dst_row0, LAS float* scr, int lane) {
#pragma unroll 8
    for (int i = 0; i < 32; ++i) { const int kk = 2 * i + (lane >> 5); scr[kk * 33 + (lane & 31)] = W[(size_t)(k0 + kk) * N + n0 + (lane & 31)]; }
    LDS_WAIT(); asm volatile("" ::: "memory");
    const int c = lane & 3;
#pragma unroll
    for (int j = 0; j < 2; ++j) { const int n = (lane >> 2) + 16 * j; const LAS float* s = scr + (16 * c) * 33 + n;
        u32x4 o;
        o.x = pk4_fp8(s[0 * 33] * W8_SCALE, s[1 * 33] * W8_SCALE, s[2 * 33] * W8_SCALE, s[3 * 33] * W8_SCALE); o.y = pk4_fp8(s[4 * 33] * W8_SCALE, s[5 * 33] * W8_SCALE, s[6 * 33] * W8_SCALE, s[7 * 33] * W8_SCALE);
        o.z = pk4_fp8(s[8 * 33] * W8_SCALE, s[9 * 33] * W8_SCALE, s[10 * 33] * W8_SCALE, s[11 * 33] * W8_SCALE); o.w = pk4_fp8(s[12 * 33] * W8_SCALE, s[13 * 33] * W8_SCALE, s[14 * 33] * W8_SCALE, s[15 * 33] * W8_SCALE);
        *(u32x4*)(WT + (size_t)(dst_row0 + n) * K + k0 + 16 * c) = o; }
    LDS_WAIT(); asm volatile("" ::: "memory");
}
struct Args { const float* in[17]; float* out; unsigned char* ws; int ph_lo, ph_hi, li, pad; };

__global__ void __launch_bounds__(512, 2) mk_fwd(Args args) {
    extern __shared__ __attribute__((aligned(16))) unsigned char lds_raw[];
    LAS unsigned char* lds = (LAS unsigned char*)lds_raw;
    volatile LAS unsigned* MISC = (volatile LAS unsigned*)(lds + MISC_OFF);
    const int tid = threadIdx.x, lane = tid & 63, wave = __builtin_amdgcn_readfirstlane(tid >> 6);
    const int G = gridDim.x, bx = blockIdx.x;
    const int vcu = (G % 8 == 0) ? (bx % 8) * (G / 8) + bx / 8 : bx;
    unsigned char* ws = args.ws;
    unsigned* ctl = (unsigned*)(ws + WS_CTL);
    const float* x = args.in[0]; const float* meta = args.in[1]; const float* g1 = args.in[2]; const float* w_in = args.in[3];
    const float* qg = args.in[4]; const float* kg = args.in[5];
    const float* w_ab = args.in[7]; const float* w_rb = args.in[8]; const float* w_out = args.in[9];
    const float* w_gu = args.in[13]; const float* b_gu = args.in[14]; const float* w_dn = args.in[15]; const float* b_dn = args.in[16];
    float* out = args.out;
    bf16* Win_t = (bf16*)(ws + WS_WIN); bf16* Wab_t = (bf16*)(ws + WS_WAB); bf16* Wrb_t = (bf16*)(ws + WS_WRB); bf16* Wout_t = (bf16*)(ws + WS_WOUT);
    unsigned char* Wgu_t = ws + WS_WGU; unsigned char* Wdn_t = ws + WS_WDN;
    bf16* xb = (bf16*)(ws + WS_XB); bf16* proj = (bf16*)(ws + WS_PROJ); bf16* yatt = (bf16*)(ws + WS_YATT); bf16* yret = (bf16*)(ws + WS_YRET); bf16* merged = (bf16*)(ws + WS_MERGED);
    bf16* pmeta = proj + (size_t)NTOK * INW;
    const float* sinks = args.in[6]; const float* g2 = args.in[10]; const float* w_r = args.in[11]; const float* b_r = args.in[12];
    int* tke = (int*)(ws + SM_TKE); float* tkw = (float*)(ws + SM_TKW); int* tkpos = (int*)(ws + SM_TKPOS); int* list = (int*)(ws + SM_LIST); float* wlist = (float*)(ws + SM_WLIST); float* rlist = (float*)(ws + SM_RLIST);
    LAS unsigned char* misc = lds + MISC_OFF;
    bf16* states = (bf16*)(ws + ret::WS_STATES);
    unsigned char* act = ws + WS_ACT; unsigned char* rows = ws + WS_ROWS; unsigned char* xn8 = ws + WS_XB;

    for (int u = tid; u < (LDS_BYTES - MISC_OFF) / 4; u += 512) ((LAS unsigned*)(lds + MISC_OFF))[u] = 0u;
    __syncthreads();
    XcdBarrier bar = xcd_barrier_post(ctl + CW_BAR + args.li * XCD_BAR_WORDS, MISC + 8);
    const int lo = args.ph_lo, hi = args.ph_hi;
#define IN(k) (lo <= (k) && (k) < hi)
#define BOTH(k) (IN(k) && IN((k) + 1))
#define GRID_BAR() xcd_barrier(bar)

    if (IN(0)) { for (int rep_ = 0; rep_ < ((PROBE_PHASE == 0) ? 2 : 1); ++rep_) {
        const int gw = vcu * NWAVES + wave, NGW = G * NWAVES;
        constexpr int I_IN = 8 * 200, I_SQ = 8 * 32, I_GU = 32 * 8 * 64, I_DN = 32 * 8 * 32;
        constexpr int NITEMS = I_IN + 3 * I_SQ + I_GU + I_DN;
        for (int rep2_ = 0; rep2_ < ((PROBE_PHASE == 100) ? 2 : 1); ++rep2_)
        for (int it = gw; it < NITEMS; it += NGW) {
            int r = it;
            if (r < I_IN) { const int kb = r / 200, nb = r % 200, n0 = nb * 32, o = n0 & 255, wcc = o >> 6, bj = (o >> 5) & 1;
                p0_item<false>(w_in, D, INW, Win_t, kb * 128, n0, (n0 & ~255) + 128 * bj + 32 * wcc, lane); continue; }
            r -= I_IN;
            if (r < I_SQ) { p0_item<false>(w_ab, D, D, Wab_t, (r / 32) * 128, (r % 32) * 32, (r % 32) * 32, lane); continue; } r -= I_SQ;
            if (r < I_SQ) { p0_item<false>(w_rb, D, D, Wrb_t, (r / 32) * 128, (r % 32) * 32, (r % 32) * 32, lane); continue; } r -= I_SQ;
            if (r < I_SQ) { p0_item<false>(w_out, D, D, Wout_t, (r / 32) * 128, (r % 32) * 32, (r % 32) * 32, lane); continue; } r -= I_SQ;
            if (r < I_GU) { const int e = r / 512, q = r % 512, kb = q / 64, nb = q % 64, n0 = nb * 32, bj = n0 >> 10, rem = n0 & 1023, pn = rem >> 7, cl = rem & 127;
                p0_item<true>(w_gu + (size_t)e * D * 2048, D, 2048, Wgu_t + (size_t)e * 2048 * D, kb * 128, n0, 256 * pn + 128 * bj + cl, lane); continue; }
            r -= I_GU;
            { const int e = r / 256, q = r % 256, kb = q / 32, nb = q % 32;
              p0_item<true>(w_dn + (size_t)e * DFF * D, DFF, D, Wdn_t + (size_t)e * D * DFF, kb * 128, nb * 32, nb * 32, lane); }
        }
        for (int rep2_ = 0; rep2_ < ((PROBE_PHASE == 101) ? 2 : 1); ++rep2_)
        for (int row = gw; row < NTOK; row += NGW) {
            const f32x4* xr = (const f32x4*)(x + (size_t)row * D) + lane;
            f32x4 v[4]; float ss = 0.f;
#pragma unroll
            for (int j = 0; j < 4; ++j) { v[j] = xr[64 * j]; ss += (v[j][0] * v[j][0] + v[j][1] * v[j][1]) + (v[j][2] * v[j][2] + v[j][3] * v[j][3]); }
            const float rstd = rsqrtf(wave_sum(ss) * (1.0f / D) + EPS);
            u32x2* o8 = (u32x2*)(xb + (size_t)row * D) + lane;
#pragma unroll
            for (int j = 0; j < 4; ++j) { const f32x4 gg = ((const f32x4*)g1)[64 * j + lane]; u32x2 w; w.x = pk2(v[j][0] * rstd * gg[0], v[j][1] * rstd * gg[1]); w.y = pk2(v[j][2] * rstd * gg[2], v[j][3] * rstd * gg[3]); o8[64 * j] = w; }
        }
        for (int row = gw; row < 256; row += NGW) {
            u32x2* o8 = (u32x2*)(xb + (size_t)(NTOK + row) * D) + lane;
            if (row < NMETA) {
                const f32x4* xr = (const f32x4*)(meta + (size_t)row * D) + lane;
                f32x4 v[4]; float ss = 0.f;
#pragma unroll
                for (int j = 0; j < 4; ++j) { v[j] = xr[64 * j]; ss += (v[j][0] * v[j][0] + v[j][1] * v[j][1]) + (v[j][2] * v[j][2] + v[j][3] * v[j][3]); }
                const float rstd = rsqrtf(wave_sum(ss) * (1.0f / D) + EPS);
#pragma unroll
                for (int j = 0; j < 4; ++j) { const f32x4 gg = ((const f32x4*)g1)[64 * j + lane]; u32x2 w; w.x = pk2(v[j][0] * rstd * gg[0], v[j][1] * rstd * gg[1]); w.y = pk2(v[j][2] * rstd * gg[2], v[j][3] * rstd * gg[3]); o8[64 * j] = w; }
            } else {
#pragma unroll
                for (int j = 0; j < 4; ++j) o8[64 * j] = (u32x2){0u, 0u};
            }
        }
        __syncthreads(); }
        if (BOTH(0)) GRID_BAR();
    }
    if (PROBE_PHASE == 200) { GRID_BAR(); GRID_BAR(); GRID_BAR(); GRID_BAR(); }
    if (IN(1)) {
        SchedDense S; S.init(xb, Win_t, NTOK + 256, INW, D, G, bx);
        { LAS float* gt = (LAS float*)(misc + MT_GAIN); if (tid < 64) { gt[tid] = 0.125f * qg[tid]; gt[64 + tid] = kg[tid]; } __syncthreads(); }
        EpiProj E{proj, (LAS const float*)(misc + MT_GAIN)};
        for (int rep_ = 0; rep_ < ((PROBE_PHASE == 1) ? 2 : 1); ++rep_) pg8::gemm_phase<EpiProj, SchedDense>(lds, 2 * D, S, E);
        if (BOTH(1)) GRID_BAR();
    }
    if (IN(2)) {
        float mq = fabsf(qg[lane]), mk = fabsf(kg[lane]);
#pragma unroll
        for (int o = 1; o < 64; o <<= 1) { mq = fmaxf(mq, __shfl_xor(mq, o)); mk = fmaxf(mk, __shfl_xor(mk, o)); }
        const float bshift = 8.0f * mq * mk;
        for (int rep_ = 0; rep_ < ((PROBE_PHASE == 20) ? 2 : 1); ++rep_) attn::phase(lds, proj, pmeta, sinks, bshift, yatt, G, bx);
        for (int rep_ = 0; rep_ < ((PROBE_PHASE == 21) ? 2 : 1); ++rep_) for (int u = bx; u < NB * 4 * 8; u += G) { const int v = ((G & 7) == 0 && G == 256) ? ((u & 7) * 32 + (u >> 3)) : u;
            ret::state_chain(lds, v >> 5, (v >> 3) & 3, v & 7, proj, pmeta, states); }
        if (BOTH(2)) GRID_BAR();
    }
    if (IN(3)) {
        for (int rep_ = 0; rep_ < ((PROBE_PHASE == 3) ? 2 : 1); ++rep_) ret::out_phase(lds, proj, states, yret, G, bx);
        if (BOTH(3)) GRID_BAR();
    }
    if (IN(4)) {
        SchedBranch S{(const char*)yatt, (const char*)yret, (const char*)Wab_t, (const char*)Wrb_t, G, bx};
        EpiBranch E{merged, proj};
        for (int rep_ = 0; rep_ < ((PROBE_PHASE == 4) ? 2 : 1); ++rep_) pg8::gemm_phase<EpiBranch, SchedBranch>(lds, 2 * D, S, E);
        if (BOTH(4)) GRID_BAR();
    }
    if (IN(5)) {
        SchedDense S; S.init(merged, Wout_t, NTOK, D, D, G, bx);
        EpiOut E{x, out};
        for (int rep_ = 0; rep_ < ((PROBE_PHASE == 5) ? 2 : 1); ++rep_) pg8::gemm_phase<EpiOut, SchedDense>(lds, 2 * D, S, E);
        if (BOTH(5)) GRID_BAR();
    }
    if (IN(6)) {
        route_phase(lds, out, g2, w_r, b_r, xn8, tke, tkpos, tkw, list, wlist, rlist, ctl + CW_CNT, G, bx);
        if (BOTH(6)) GRID_BAR();
    }
    if (hi > 7 && lo <= 9) moe_tables(misc, ctl + CW_CNT);
    if (IN(7)) {
        SchedMoe<true, 8> S{(const char*)xn8, (const char*)Wgu_t, misc, list, G, bx};
        EpiGU E{act, b_gu, rlist, misc};
        for (int rep_ = 0; rep_ < ((PROBE_PHASE == 7) ? 2 : 1); ++rep_) pg8::gemm_phase<EpiGU, SchedMoe<true, 8>, true>(lds, D, S, E);
        if (BOTH(7)) GRID_BAR();
    }
    if (IN(8)) {
        SchedMoe<false, 4> S{(const char*)act, (const char*)Wdn_t, misc, list, G, bx};
        EpiDown E{rows, b_dn, wlist, misc};
        for (int rep_ = 0; rep_ < ((PROBE_PHASE == 8) ? 2 : 1); ++rep_) pg8::gemm_phase<EpiDown, SchedMoe<false, 4>, true>(lds, DFF, S, E);
        if (BOTH(8)) GRID_BAR();
    }
    if (IN(9)) combine_phase(misc, (void*)proj, out, rows, tke, tkpos, vcu * NWAVES + wave, G * NWAVES, lane);
#undef IN
#undef BOTH
#undef GRID_BAR
}

extern "C" void kernel_launch(void* const* d_in, const int* in_sizes, int n_in, void* d_out, int out_size, void* d_ws, size_t ws_size, hipStream_t stream) {
    static int grid = 0;
    if (grid == 0) {
        if (n_in != 17 || in_sizes[0] != NTOK * D || out_size != NTOK * D || ws_size < WS_END) {
            fprintf(stderr, "kernel_launch: unexpected shapes (n_in %d in0 %d out %d ws %zu)\n", n_in, n_in > 0 ? in_sizes[0] : -1, out_size, ws_size); grid = -1; return; }
        int dev = 0, cus = 0;
        if (hipGetDevice(&dev) != hipSuccess || hipDeviceGetAttribute(&cus, hipDeviceAttributeMultiprocessorCount, dev) != hipSuccess) { grid = -1; return; }
        if (hipFuncSetAttribute((const void*)mk_fwd, hipFuncAttributeMaxDynamicSharedMemorySize, LDS_BYTES) != hipSuccess) { fprintf(stderr, "kernel_launch: hipFuncSetAttribute failed\n"); grid = -1; return; }
        grid = cus;
    }
    if (grid < 0) return;
    unsigned char* ws = (unsigned char*)d_ws;
    (void)hipMemsetAsync(ws + WS_CTL, 0, 1 * MiB, stream);
    Args a{};
    for (int i = 0; i < 17; ++i) a.in[i] = (const float*)d_in[i];
    a.out = (float*)d_out; a.ws = ws; a.ph_lo = 0; a.ph_hi = 10; a.li = 0; a.pad = 0;
    hipLaunchKernelGGL(mk_fwd, dim3(grid), dim3(512), LDS_BYTES, stream, a);
}
```

```cpp
#include <hip/hip_runtime.h>
#include <cstdio>
#include <cstdint>

typedef unsigned short bf16;
__device__ __forceinline__ float bf2f(bf16 v) { return __uint_as_float(((unsigned)v) << 16); }
__device__ __forceinline__ bf16 f2bf(float f) { const __bf16 b = (__bf16)f; return __builtin_bit_cast(unsigned short, b); }
__device__ __forceinline__ float sigmoidf_(float x) { return __builtin_amdgcn_rcpf(1.0f + __builtin_amdgcn_exp2f(-1.4426950408889634f * x)); }

constexpr int NB = 8, SEQ = 4096, D = 1024, NTOK = NB * SEQ;
constexpr int NMETA = 16;
constexpr int INW = 6400;
constexpr int C_AQ = 0, C_AK = 1024, C_AV = 1152, C_RQ = 1280, C_RK = 1792, C_RV = 2304, C_RG = 3328, C_GA = 4352, C_GR = 5376;
constexpr int NE = 32, TOPK = 4, DFF = 1024;
constexpr int NROWS = (NTOK * TOPK / 256 + NE) * 256;
constexpr int NTILE = NROWS / 256;
constexpr float EPS = 1e-5f;

constexpr size_t MiB = 1u << 20;
constexpr size_t WS_CTL = 0;
constexpr size_t WS_SMALL = 1 * MiB;
constexpr size_t WS_W = 16 * MiB;
constexpr size_t WS_XB = 232 * MiB;
constexpr size_t WS_PROJ = 297 * MiB;
constexpr size_t WS_YATT = 701 * MiB;
constexpr size_t WS_YRET = 765 * MiB;
constexpr size_t WS_MERGED = 829 * MiB;
constexpr size_t WS_END = 1020 * MiB;
constexpr size_t WS_ACT = 297 * MiB;
constexpr size_t WS_ROWS = 568 * MiB;
constexpr size_t SM_UMETA = WS_SMALL;
constexpr size_t SM_PMETA = WS_SMALL + 64 * 1024;
constexpr size_t SM_TKE = WS_SMALL + 512 * 1024;
constexpr size_t SM_TKW = SM_TKE + 512 * 1024;
constexpr size_t SM_TKPOS = SM_TKW + 512 * 1024;
constexpr size_t SM_TKROW = SM_TKPOS + 512 * 1024;
constexpr size_t SM_ROWTOK = SM_TKROW + 512 * 1024;
constexpr size_t SM_ROWW = SM_ROWTOK + 1024 * 1024;
constexpr size_t SM_TILEE = SM_ROWW + 1024 * 1024;
constexpr int CW_CNT = 1024;

#define LAS __attribute__((address_space(3)))
#define GAS __attribute__((address_space(1)))
typedef short bf16x8 __attribute__((ext_vector_type(8)));
typedef float f32x4 __attribute__((ext_vector_type(4)));
typedef float f32x2 __attribute__((ext_vector_type(2)));
typedef unsigned u32x4 __attribute__((ext_vector_type(4)));
typedef unsigned u32x2 __attribute__((ext_vector_type(2)));
#define LDS_WAIT() asm volatile("s_waitcnt lgkmcnt(0)" ::: "memory")
#define VM_WAIT() asm volatile("s_waitcnt vmcnt(0)" ::: "memory")
typedef __bf16 bf16x2_t __attribute__((ext_vector_type(2)));
__device__ __forceinline__ unsigned pk2(float lo, float hi) { const f32x2 v = {lo, hi}; const bf16x2_t b = __builtin_convertvector(v, bf16x2_t); return __builtin_bit_cast(unsigned, b); }
__device__ __forceinline__ unsigned pk4_fp8(float a, float b, float c, float d) { int w = __builtin_amdgcn_cvt_pk_fp8_f32(a, b, 0, false); w = __builtin_amdgcn_cvt_pk_fp8_f32(c, d, w, true); return (unsigned)w; }
constexpr float W8_SCALE = 64.0f, W8_INV = 1.0f / 64.0f;
constexpr float ROW8_SCALE = 16.0f, ROW8_INV = 1.0f / 16.0f;
__device__ __forceinline__ float wave_sum(float v) {
#pragma unroll
    for (int o = 1; o < 64; o <<= 1) v += __shfl_xor(v, o);
    return v;
}

constexpr size_t WS_WIN = WS_W;
constexpr size_t WS_WAB = WS_W + 13 * MiB;
constexpr size_t WS_WRB = WS_W + 15 * MiB;
constexpr size_t WS_WOUT = WS_W + 17 * MiB;
constexpr size_t WS_WGU = WS_W + 19 * MiB;
constexpr size_t WS_WDN = WS_W + 147 * MiB;
static_assert(WS_WDN + 64 * MiB <= WS_XB, "weight map");
constexpr size_t SM_ATILE = SM_TILEE + 4096;
constexpr int CW_NACT = 1088;
constexpr int CW_BAR = 4096;

constexpr int RING_BYTES = 131072;
constexpr int MISC_OFF = RING_BYTES;
constexpr int LDS_BYTES = 147456;
constexpr int NWAVES = 8;

#define XB_TMO      128
#define XB_XCNT(j)  (256  + 64 * (j))
#define XB_XSUB(j)  (1280 + 64 * (j))
#define XB_XGEN(j)  (2304 + 64 * (j))
#define XB_TOP      3328
#define XB_TOPGEN   3392
#define XCD_BAR_WORDS 3456
#define XB_SPIN_CAP (1u << 20)
__device__ __forceinline__ unsigned xb_ld(unsigned* p)              { return __hip_atomic_load(p, __ATOMIC_RELAXED, __HIP_MEMORY_SCOPE_AGENT); }
__device__ __forceinline__ unsigned xb_add(unsigned* p, unsigned v) { return __hip_atomic_fetch_add(p, v, __ATOMIC_RELAXED, __HIP_MEMORY_SCOPE_AGENT); }
__device__ __forceinline__ unsigned xb_xcc_id() { return (unsigned)__builtin_amdgcn_s_getreg((3 << 11) | 20) & 0xFu; }
#define XB_SPIN(cond, bar) do { unsigned _sp = 0; while (cond) { __builtin_amdgcn_s_sleep(1); \
    if ((++_sp & 255u) == 0u) { if (xb_ld(&(bar)[XB_TMO])) break; if (_sp > XB_SPIN_CAP) { atomicAdd(&(bar)[XB_TMO], 1u); break; } } } } while (0)
struct XcdBarrier { unsigned* bar; unsigned x; volatile LAS unsigned* st; };
__device__ __forceinline__ XcdBarrier xcd_barrier_post(unsigned* bar, volatile LAS unsigned* st) {
    XcdBarrier b; b.bar = bar; b.x = xb_xcc_id(); b.st = st;
    if (threadIdx.x == 0) (void)xb_add(&bar[XB_XCNT(b.x)], 1u);
    return b;
}
__device__ __forceinline__ void xcd_barrier_complete(unsigned* bar, unsigned x, unsigned& nloc, unsigned& nx) {
    const unsigned G = gridDim.x * gridDim.y * gridDim.z;
    unsigned sum, cnt, mine, sp = 0u;
    for (;;) {
        sum = 0u; cnt = 0u; mine = 0u;
#pragma unroll
        for (unsigned j = 0; j < 16; ++j) { const unsigned c = xb_ld(&bar[XB_XCNT(j)]); sum += c; cnt += (c > 0u) ? 1u : 0u; mine = (j == x) ? c : mine; }
        if (sum == G) break;
        __builtin_amdgcn_s_sleep(1);
        if ((++sp & 255u) == 0u) { if (xb_ld(&bar[XB_TMO])) break; if (sp > XB_SPIN_CAP) { atomicAdd(&bar[XB_TMO], 1u); break; } }
    }
    nloc = mine > 0u ? mine : 1u; nx = cnt > 0u ? cnt : 1u;
}
__device__ __forceinline__ void xcd_barrier(const XcdBarrier& b) {
    asm volatile("s_waitcnt vmcnt(0)" ::: "memory");
    __syncthreads();
    if (threadIdx.x == 0) {
        unsigned* bar = b.bar;
        __builtin_amdgcn_s_waitcnt(0);
        unsigned nloc = b.st[0], nx = b.st[1];
        if (nloc == 0u) { xcd_barrier_complete(bar, b.x, nloc, nx); b.st[0] = nloc; b.st[1] = nx; }
        const unsigned old = xb_add(&bar[XB_XSUB(b.x)], 1u);
        const unsigned gen = old / nloc;
        if (old + 1u == (gen + 1u) * nloc) {
            __builtin_amdgcn_fence(__ATOMIC_RELEASE, "agent");
            asm volatile("s_waitcnt vmcnt(0)" ::: "memory");
            const unsigned og = xb_add(&bar[XB_TOP], 1u);
            const unsigned tg = og / nx;
            if (og + 1u == (tg + 1u) * nx) xb_add(&bar[XB_TOPGEN], 1u);
            else XB_SPIN(xb_ld(&bar[XB_TOPGEN]) == tg, bar);
            __builtin_amdgcn_fence(__ATOMIC_ACQUIRE, "agent");
            xb_add(&bar[XB_XGEN(b.x)], 1u);
            asm volatile("s_waitcnt vmcnt(0)" ::: "memory");
        } else {
            XB_SPIN(xb_ld(&bar[XB_XGEN(b.x)]) == gen, bar);
            __builtin_amdgcn_fence(__ATOMIC_ACQUIRE, "agent");
            asm volatile("s_waitcnt vmcnt(0)" ::: "memory");
        }
    }
    __syncthreads();
}

namespace pg8 {
constexpr int BM = 256, BK = 64, HALF = 128, HTB = HALF * BK * 2, STAGE_BYTES = 8 * HTB;
__host__ __device__ __forceinline__ int lds_byte(int r, int c) { const int st = (r >> 4) * 2 + (c >> 5), rr = r & 15, cc = c & 31, ob = rr * 64 + cc * 2; return st * 1024 + (ob ^ (((ob >> 9) & 1) << 5)); }
__host__ __device__ __forceinline__ void stage_rc(int b, int& R, int& C) { const int st = b / 1024, sb = b % 1024, swz = sb ^ (((sb >> 9) & 1) << 5); R = (st >> 1) * 16 + swz / 64; C = (st & 1) * 32 + (swz % 64) / 2; }
__host__ __device__ __forceinline__ int perm32(int rho) { const int n = rho >> 4, i = rho & 15; return 8 * (i >> 2) + 4 * n + (i & 3); }
struct Unit { int pm, pn, aux, tl; const char* A; const char* B; };
typedef f32x4 Acc[2][2][4][2];
typedef int u32x4_i __attribute__((ext_vector_type(4)));

typedef int v8i32 __attribute__((ext_vector_type(8)));
template <class Epi, class Sched, bool FP8 = false>
__device__ __forceinline__ void gemm_phase(LAS unsigned char* lds, const int Kb, const Sched& S, const Epi& E) {
    const int tid = threadIdx.x, wid = __builtin_amdgcn_readfirstlane(tid >> 6), lane = tid & 63, wr = wid >> 2, wc = wid & 3, fr = lane & 15, fq = lane >> 4;
    const int nt = Kb / 128;
    int RA[2], CA[2]; unsigned voffB[2];
#pragma unroll
    for (int i = 0; i < 2; ++i) { int R, C; stage_rc(tid * 16 + i * 8192, R, C); const int Rb = Epi::PERM ? ((R & ~31) + perm32(R & 31)) : R;
        RA[i] = R; CA[i] = C; voffB[i] = (unsigned)(Rb * Kb + C * 2); }
    const size_t kstep = (size_t)(BK * 2);
    const size_t hstep = (size_t)HALF * Kb;
    const unsigned ldsw = (unsigned)wid * 1024u;
    const int aoff = lds_byte(wr * 64 + fr, fq * 8), boff = lds_byte(wc * 32 + fr, fq * 8);
#define PG8_SA(b, h) (((b) * 2 + (h)) * HTB)
#define PG8_SB(b, h) ((4 + (b) * 2 + (h)) * HTB)
#define PG8_STAGE(bufoff, gbase, voff) do { _Pragma("unroll") for (int _i = 0; _i < 2; ++_i) \
        __builtin_amdgcn_global_load_lds((const unsigned*)((const char*)(gbase) + (voff)[_i]), (LAS unsigned*)(lds + (bufoff) + ldsw + _i * 8192), 16, 0, 0); } while (0)
#define PG8_LDA(dst, b, h) do { _Pragma("unroll") for (int m = 0; m < 4; ++m) _Pragma("unroll") for (int k = 0; k < 2; ++k) dst[m][k] = *(const LAS bf16x8*)(lds + PG8_SA(b, h) + aoff + m * 2048 + k * 1024); } while (0)
#define PG8_LDB(dst, b, h) do { _Pragma("unroll") for (int n = 0; n < 2; ++n) _Pragma("unroll") for (int k = 0; k < 2; ++k) dst[n][k] = *(const LAS bf16x8*)(lds + PG8_SB(b, h) + boff + n * 2048 + k * 1024); } while (0)
#define PG8_MMA(ai, bj, At, Bt) do { __builtin_amdgcn_s_setprio(1); _Pragma("unroll") for (int m = 0; m < 4; ++m) _Pragma("unroll") for (int n = 0; n < 2; ++n) { \
        if constexpr (FP8) { const v8i32 bq = __builtin_shufflevector(__builtin_bit_cast(u32x4_i, Bt[n][0]), __builtin_bit_cast(u32x4_i, Bt[n][1]), 0, 1, 2, 3, 4, 5, 6, 7), \
                                         aq = __builtin_shufflevector(__builtin_bit_cast(u32x4_i, At[m][0]), __builtin_bit_cast(u32x4_i, At[m][1]), 0, 1, 2, 3, 4, 5, 6, 7); \
            asm volatile("v_mfma_scale_f32_16x16x128_f8f6f4 %0, %1, %2, %0, %3, %3 op_sel_hi:[0,0,0]" : "+v"(acc[ai][bj][m][n]) : "v"(bq), "v"(aq), "v"(scale1)); } \
        else { _Pragma("unroll") for (int k = 0; k < 2; ++k) acc[ai][bj][m][n] = __builtin_amdgcn_mfma_f32_16x16x32_bf16(Bt[n][k], At[m][k], acc[ai][bj][m][n], 0, 0, 0); } } \
        __builtin_amdgcn_s_setprio(0); } while (0)
#define PG8_WAIT_V(n) asm volatile("s_waitcnt vmcnt(" #n ")" ::: "memory")
#define PG8_WAIT_L(n) asm volatile("s_waitcnt lgkmcnt(" #n ")" ::: "memory")
#define PG8_BAR __builtin_amdgcn_s_barrier()
#define PG8_SCHED __builtin_amdgcn_sched_barrier(0)
    int scale1 = 0x7f7f7f7f; asm volatile("" : "+v"(scale1));
    Unit cur, nxt; int ui = 0;
    if (!S.next(0, cur)) return;
    unsigned ca[2][2], na[2][2];
    S.aoff(cur, RA, CA, ca);
    f32x4 acc[2][2][4][2];
#pragma unroll
    for (int a = 0; a < 2; ++a)
#pragma unroll
        for (int b = 0; b < 2; ++b)
#pragma unroll
            for (int m = 0; m < 4; ++m)
#pragma unroll
                for (int n = 0; n < 2; ++n) acc[a][b][m][n] = (f32x4){0.f, 0.f, 0.f, 0.f};
    bf16x8 At[4][2], B0[2][2], B1[2][2];
    const char* cA = cur.A; const char* cB = cur.B;
    E.prefetch(cur, 0, wid, lane);
    PG8_STAGE(PG8_SB(0, 0), cB, voffB); PG8_STAGE(PG8_SB(0, 1), cB + hstep, voffB); PG8_STAGE(PG8_SA(0, 0), cA, ca[0]); PG8_STAGE(PG8_SA(0, 1), cA, ca[1]);
    if (wr == 1) PG8_BAR;
    PG8_WAIT_V(2); PG8_BAR;
    PG8_STAGE(PG8_SB(1, 0), cB + kstep, voffB); PG8_STAGE(PG8_SA(1, 0), cA + kstep, ca[0]); PG8_STAGE(PG8_SB(1, 1), cB + hstep + kstep, voffB);
    PG8_WAIT_V(6); PG8_BAR;
    for (;;) {
        const bool has_next = S.next(ui + 1, nxt);
        if constexpr (Sched::GATHER) {
            if (has_next) S.aoff(nxt, RA, CA, na);
            else {
#pragma unroll
                for (int h = 0; h < 2; ++h)
#pragma unroll
                    for (int i = 0; i < 2; ++i) na[h][i] = ca[h][i];
            }
        }
        const char* nA = has_next ? nxt.A : cA; const char* nB = has_next ? nxt.B : cB;
#pragma nounroll
        for (int t = 0; t < nt; t += 2) {
            const bool last = (t == nt - 2);
            const char* a1 = cA + (size_t)(t + 1) * kstep;
            const char* a2 = last ? nA : cA + (size_t)(t + 2) * kstep; const char* b2 = last ? nB : cB + (size_t)(t + 2) * kstep;
            const char* a3 = a2 + kstep; const char* b3 = b2 + kstep;
            unsigned o2[2][2];
#pragma unroll
            for (int h = 0; h < 2; ++h)
#pragma unroll
                for (int i = 0; i < 2; ++i) { if constexpr (Sched::GATHER) o2[h][i] = last ? na[h][i] : ca[h][i]; else o2[h][i] = ca[h][i]; }
            PG8_LDB(B0, 0, 0); PG8_LDB(B1, 0, 1); PG8_SCHED; PG8_LDA(At, 0, 0); PG8_STAGE(PG8_SA(1, 1), a1, ca[1]);
            PG8_WAIT_V(8); PG8_WAIT_L(0); PG8_BAR; PG8_MMA(0, 0, At, B0); PG8_MMA(0, 1, At, B1); PG8_BAR; PG8_SCHED;
            PG8_LDA(At, 0, 1); PG8_STAGE(PG8_SB(0, 0), b2, voffB); PG8_STAGE(PG8_SB(0, 1), b2 + hstep, voffB); PG8_STAGE(PG8_SA(0, 0), a2, o2[0]);
            PG8_WAIT_V(8); PG8_WAIT_L(0); PG8_BAR; PG8_MMA(1, 0, At, B0); PG8_MMA(1, 1, At, B1); PG8_BAR; PG8_SCHED;
            PG8_LDB(B0, 1, 0); PG8_LDB(B1, 1, 1); PG8_SCHED; PG8_LDA(At, 1, 0); PG8_STAGE(PG8_SA(0, 1), a2, o2[1]);
            PG8_WAIT_V(8); PG8_WAIT_L(0); PG8_BAR; PG8_MMA(0, 0, At, B0); PG8_MMA(0, 1, At, B1); PG8_BAR; PG8_SCHED;
            PG8_LDA(At, 1, 1); PG8_STAGE(PG8_SB(1, 0), b3, voffB); PG8_STAGE(PG8_SB(1, 1), b3 + hstep, voffB); PG8_STAGE(PG8_SA(1, 0), a3, o2[0]);
            PG8_WAIT_V(8); PG8_WAIT_L(0); PG8_BAR; PG8_MMA(1, 0, At, B0); PG8_MMA(1, 1, At, B1); PG8_BAR; PG8_SCHED;
        }
        if constexpr (FP8) { asm volatile("s_nop 15\n\ts_nop 15\n\ts_nop 15" ::: "memory"); PG8_SCHED; }
        if (wr == 0) PG8_BAR;
        { int fr_ = fr, fq_ = fq; asm volatile("" : "+v"(fr_), "+v"(fq_));
          E(acc, cur, wr, wc, fr_, fq_, ui & 1); }
        if (!has_next) break;
#pragma unroll
        for (int a = 0; a < 2; ++a)
#pragma unroll
            for (int b = 0; b < 2; ++b)
#pragma unroll
                for (int m = 0; m < 4; ++m)
#pragma unroll
                    for (int n = 0; n < 2; ++n) acc[a][b][m][n] = (f32x4){0.f, 0.f, 0.f, 0.f};
        cur = nxt; cA = nA; cB = nB; ++ui;
        E.prefetch(cur, ui & 1, wid, lane);
        if constexpr (Sched::GATHER) {
#pragma unroll
            for (int h = 0; h < 2; ++h)
#pragma unroll
                for (int i = 0; i < 2; ++i) ca[h][i] = na[h][i];
        }
        if (wr == 1) PG8_BAR;
    }
    PG8_WAIT_V(0);
    PG8_BAR;
#undef PG8_SA
#undef PG8_SB
#undef PG8_STAGE
#undef PG8_LDA
#undef PG8_LDB
#undef PG8_MMA
#undef PG8_WAIT_V
#undef PG8_WAIT_L
#undef PG8_BAR
#undef PG8_SCHED
}
}
#ifndef PROBE_PHASE
#define PROBE_PHASE (-1)
#endif
constexpr size_t SM_LIST = WS_SMALL + 2 * MiB;
constexpr size_t SM_WLIST = WS_SMALL + 6 * MiB;
constexpr size_t SM_RLIST = WS_SMALL + 10 * MiB;
constexpr int MT_PSTART = 256;
constexpr int MT_CNT = 512;
constexpr int MT_NACT = 768;
constexpr int MT_ATILE = 1024;
constexpr int MT_HIST = 4096;
constexpr int MT_BASE = 4224;
constexpr int MT_REC = 4352;
constexpr int MT_RSTD = 10496;
constexpr int MT_EPI = 11264;
constexpr int MT_EPI2 = 13312;
constexpr int MT_GAIN = 15360;

__device__ __forceinline__ void moe_tables(LAS unsigned char* misc, const unsigned* cnt) {
    LAS int* pstart = (LAS int*)(misc + MT_PSTART); LAS int* cl = (LAS int*)(misc + MT_CNT); LAS int* at = (LAS int*)(misc + MT_ATILE);
    __syncthreads();
    if (threadIdx.x < 64) {
        const int lane = threadIdx.x, e = lane & 31;
        const int c = (int)__hip_atomic_load(cnt + e, __ATOMIC_RELAXED, __HIP_MEMORY_SCOPE_AGENT), nt = (c + 255) >> 8;
        int incl = nt;
#pragma unroll
        for (int o = 1; o < 32; o <<= 1) { const int v = __shfl_up(incl, o); if (e >= o) incl += v; }
        const int t0 = incl - nt;
        if (lane < 32) { cl[e] = c; pstart[e] = t0 << 8; for (int t = 0; t < nt; ++t) at[t0 + t] = (t0 + t) | (e << 12) | (t << 20);
            if (e == 31) { pstart[NE] = incl << 8; *(LAS int*)(misc + MT_NACT) = incl; } }
    }
    __syncthreads();
}

__device__ __forceinline__ void route_phase(LAS unsigned char* lds, const float* __restrict__ h2, const float* __restrict__ g2, const float* __restrict__ wr, const float* __restrict__ br,
                                            unsigned char* __restrict__ xg8, int* __restrict__ tke, int* __restrict__ tkpos, float* __restrict__ tkw, int* __restrict__ list, float* __restrict__ wlist,
                                            float* __restrict__ rlist, unsigned* __restrict__ cnt, int G, int bx) {
    typedef float f32x16 __attribute__((ext_vector_type(16)));
    const int tid = threadIdx.x, lane = tid & 63, r32 = lane & 31, hi = lane >> 5; const int wave = __builtin_amdgcn_readfirstlane(tid >> 6);
    LAS unsigned char* misc = lds + MISC_OFF;
    LAS int* hist = (LAS int*)(misc + MT_HIST); LAS int* base = (LAS int*)(misc + MT_BASE); LAS int* rec = (LAS int*)(misc + MT_REC); LAS float* rstd_l = (LAS float*)(misc + MT_RSTD);
    for (int idx = tid; idx < 128 * 32; idx += 512) {
        const int c = idx >> 5, e = idx & 31; float v[8]; unsigned hw[4], lw[4];
#pragma unroll
        for (int j = 0; j < 8; ++j) v[j] = wr[(size_t)(8 * c + j) * NE + e] * g2[8 * c + j];
#pragma unroll
        for (int j = 0; j < 4; ++j) { hw[j] = pk2(v[2 * j], v[2 * j + 1]); lw[j] = pk2(v[2 * j] - __uint_as_float(hw[j] << 16), v[2 * j + 1] - __uint_as_float(hw[j] & 0xffff0000u)); }
        *(LAS u32x4*)(lds + idx * 16) = (u32x4){hw[0], hw[1], hw[2], hw[3]};
        *(LAS u32x4*)(lds + 65536 + idx * 16) = (u32x4){lw[0], lw[1], lw[2], lw[3]};
    }
    __syncthreads();
    const int tile = wave & 3;
    for (int tb = bx; tb < NTOK / 128; tb += G) {
        if (tid < 32) hist[tid] = 0;
        __syncthreads();
        for (int rep_ = 0; rep_ < ((PROBE_PHASE == 6) ? 2 : 1); ++rep_)
        if (wave < 4) {
        const int token = tb * 128 + tile * 32 + r32;
        const float* xp = h2 + (size_t)token * D + 8 * hi;
        unsigned char* x8p = xg8 + (size_t)token * D + 8 * hi;
        const float* gp = g2 + 8 * hi;
        f32x16 c = {};
        float ss = 0.f;
        f32x4 xa[8][2];
#pragma unroll
        for (int p = 0; p < 8; ++p) { xa[p][0] = *(const f32x4*)(xp + 16 * p); xa[p][1] = *(const f32x4*)(xp + 16 * p + 4); }
#pragma unroll 1
        for (int ks0 = 0; ks0 < 64; ks0 += 8) {
#pragma unroll
            for (int p = 0; p < 8; ++p) {
                const int ks = ks0 + p;
                const f32x4 x0 = xa[p][0], x1 = xa[p][1];
                if (ks + 8 < 64) { xa[p][0] = *(const f32x4*)(xp + 16 * (ks + 8)); xa[p][1] = *(const f32x4*)(xp + 16 * (ks + 8) + 4); }
                ss += (x0[0] * x0[0] + x0[1] * x0[1]) + (x0[2] * x0[2] + x0[3] * x0[3]) + (x1[0] * x1[0] + x1[1] * x1[1]) + (x1[2] * x1[2] + x1[3] * x1[3]);
                { const f32x4 g0 = *(const f32x4*)(gp + 16 * ks), g1 = *(const f32x4*)(gp + 16 * ks + 4);
                  u32x2 w8; w8.x = pk4_fp8(x0[0] * g0[0], x0[1] * g0[1], x0[2] * g0[2], x0[3] * g0[3]); w8.y = pk4_fp8(x1[0] * g1[0], x1[1] * g1[1], x1[2] * g1[2], x1[3] * g1[3]);
                  *(u32x2*)(x8p + 16 * ks) = w8; }
                u32x4 xh, xl;
                xh.x = pk2(x0[0], x0[1]); xh.y = pk2(x0[2], x0[3]); xh.z = pk2(x1[0], x1[1]); xh.w = pk2(x1[2], x1[3]);
                xl.x = pk2(x0[0] - __uint_as_float(xh.x << 16), x0[1] - __uint_as_float(xh.x & 0xffff0000u)); xl.y = pk2(x0[2] - __uint_as_float(xh.y << 16), x0[3] - __uint_as_float(xh.y & 0xffff0000u));
                xl.z = pk2(x1[0] - __uint_as_float(xh.z << 16), x1[1] - __uint_as_float(xh.z & 0xffff0000u)); xl.w = pk2(x1[2] - __uint_as_float(xh.w << 16), x1[3] - __uint_as_float(xh.w & 0xffff0000u));
                const int chunk = 2 * ks + hi;
                const bf16x8 wh = *(const LAS bf16x8*)(lds + (chunk * 32 + r32) * 16), wl = *(const LAS bf16x8*)(lds + 65536 + (chunk * 32 + r32) * 16);
                c = __builtin_amdgcn_mfma_f32_32x32x16_bf16(wh, __builtin_bit_cast(bf16x8, xh), c, 0, 0, 0);
                c = __builtin_amdgcn_mfma_f32_32x32x16_bf16(wl, __builtin_bit_cast(bf16x8, xh), c, 0, 0, 0);
                c = __builtin_amdgcn_mfma_f32_32x32x16_bf16(wh, __builtin_bit_cast(bf16x8, xl), c, 0, 0, 0);
            }
        }
        {
            ss += __shfl_xor(ss, 32);
            const float rstd = rsqrtf(ss * (1.0f / D) + EPS);
            float vals[16];
#pragma unroll
            for (int r = 0; r < 16; ++r) vals[r] = c[r] * rstd + br[(r & 3) + 8 * (r >> 2) + 4 * hi];
            float tv[4]; int te[4];
#pragma unroll
            for (int k = 0; k < 4; ++k) {
                float m = -3.0e38f; int mi = 0;
#pragma unroll
                for (int r = 0; r < 16; ++r) { const bool gt = vals[r] > m; m = gt ? vals[r] : m; mi = gt ? r : mi; }
                tv[k] = m; te[k] = (mi & 3) + 8 * (mi >> 2) + 4 * hi;
#pragma unroll
                for (int r = 0; r < 16; ++r) vals[r] = (r == mi) ? -3.0e38f : vals[r];
            }
            float cv[8]; int ce[8];
#pragma unroll
            for (int k = 0; k < 4; ++k) { cv[k] = tv[k]; ce[k] = te[k]; cv[4 + k] = __shfl_xor(tv[k], 32); ce[4 + k] = __shfl_xor(te[k], 32); }
            float fv[4]; int fe[4];
#pragma unroll
            for (int k = 0; k < 4; ++k) {
                float m = -3.0e38f; int me = 64; int mi = 0;
#pragma unroll
                for (int q = 0; q < 8; ++q) { const bool better = (cv[q] > m) || (cv[q] == m && ce[q] < me); m = better ? cv[q] : m; me = better ? ce[q] : me; mi = better ? q : mi; }
                fv[k] = m; fe[k] = me;
#pragma unroll
                for (int q = 0; q < 8; ++q) cv[q] = (q == mi) ? -3.0e38f : cv[q];
            }
            if (hi == 0 && (PROBE_PHASE != 6 || rep_ == 1)) {
                const float e0 = 1.0f, e1 = __expf(fv[1] - fv[0]), e2 = __expf(fv[2] - fv[0]), e3 = __expf(fv[3] - fv[0]);
                const float inv = 1.0f / (e0 + e1 + e2 + e3);
                const float wts[4] = {e0 * inv, e1 * inv, e2 * inv, e3 * inv};
                const int tl = tile * 32 + r32;
                rstd_l[tl] = rstd;
#pragma unroll
                for (int k = 0; k < 4; ++k) {
                    const int lp = __hip_atomic_fetch_add(hist + fe[k], 1, __ATOMIC_RELAXED, __HIP_MEMORY_SCOPE_WORKGROUP);
                    LAS int* r = rec + (tl * 4 + k) * 3; r[0] = fe[k]; r[1] = lp; r[2] = __float_as_int(wts[k]);
                }
            }
        }
        }
        __syncthreads();
        if (tid < 32) base[tid] = (int)atomicAdd(&cnt[tid], (unsigned)hist[tid]);
        __syncthreads();
        { const int tl = tid >> 2; const int tok = tb * 128 + tl; LAS int* r = rec + tid * 3; const int e = r[0], pos = base[e] + r[1]; const float w = __int_as_float(r[2]);
          tke[tok * 4 + (tid & 3)] = e; tkpos[tok * 4 + (tid & 3)] = pos; tkw[tok * 4 + (tid & 3)] = w;
          list[e * NTOK + pos] = tok; wlist[e * NTOK + pos] = w; rlist[e * NTOK + pos] = rstd_l[tl]; }
        __syncthreads();
    }
}

__device__ __forceinline__ void combine_phase(LAS unsigned char* misc, void* scratch_out, float* __restrict__ out, const unsigned char* __restrict__ rows, const int* __restrict__ tke, const int* __restrict__ tkpos, int gw, int NGW, int lane) {
    LAS const int* pstart = (LAS const int*)(misc + MT_PSTART);
    for (int rep_ = 0; rep_ < ((PROBE_PHASE == 9) ? 2 : 1); ++rep_)
    for (int token = gw; token < NTOK; token += NGW) {
        int rr[4];
#pragma unroll
        for (int k = 0; k < 4; ++k) rr[k] = pstart[tke[token * 4 + k]] + tkpos[token * 4 + k];
        f32x4* o = (f32x4*)(out + (size_t)token * D) + lane;
        f32x4 v[4], s[4];
#pragma unroll
        for (int j = 0; j < 4; ++j) { v[j] = o[64 * j]; s[j] = (f32x4){0.f, 0.f, 0.f, 0.f}; }
#pragma unroll
        for (int k = 0; k < 4; ++k) {
            const unsigned* rp = (const unsigned*)(rows + (size_t)rr[k] * D) + lane;
#pragma unroll
            for (int j = 0; j < 4; ++j) { const unsigned w = rp[64 * j];
                const f32x2 lo = __builtin_amdgcn_cvt_pk_f32_fp8((int)w, false), hh = __builtin_amdgcn_cvt_pk_f32_fp8((int)w, true);
                s[j][0] += lo[0]; s[j][1] += lo[1]; s[j][2] += hh[0]; s[j][3] += hh[1]; }
        }
#pragma unroll
        for (int j = 0; j < 4; ++j) v[j] = v[j] + s[j] * ROW8_INV;
        if (PROBE_PHASE == 9 && rep_ == 0) {
#pragma unroll
            for (int j = 0; j < 4; ++j) { asm volatile("" :: "v"(v[j])); *(f32x4*)((float*)scratch_out + (size_t)token * D + (64 * j + lane) * 4) = v[j]; }
        } else {
#pragma unroll
        for (int j = 0; j < 4; ++j) o[64 * j] = v[j];
        }
    }
}
struct SchedDense {
    static constexpr bool GATHER = false;
    const char* A; const char* Bt; int K, nM, nN, nwg, G, c;
    __device__ void init(const bf16* A_, const bf16* Bt_, int M, int N, int K_, int G_, int c_) { A = (const char*)A_; Bt = (const char*)Bt_; K = K_; nM = M / 256; nN = N / 256; nwg = nM * nN; G = G_; c = c_; }
    __device__ __forceinline__ bool next(int i, pg8::Unit& u) const {
        const long L = (long)i * G + c; if (L >= nwg) return false;
        int wgid = (int)L; { const int q = nwg / 8, r = nwg % 8, xcd = wgid % 8, off = wgid / 8; wgid = (xcd < r ? xcd * (q + 1) : r * (q + 1) + (xcd - r) * q) + off; }
        const int nig = 8 * nN, gid = wgid / nig, fm = gid * 8, gsz = (nM - fm) < 8 ? (nM - fm) : 8;
        u.pm = fm + ((wgid % nig) % gsz); u.pn = (wgid % nig) / gsz; u.aux = 0; u.tl = 0;
        u.A = A + (size_t)u.pm * 256 * K * 2; u.B = Bt + (size_t)u.pn * 256 * K * 2; return true;
    }
    __device__ __forceinline__ void aoff(const pg8::Unit&, const int (&R)[2], const int (&C)[2], unsigned (&o)[2][2]) const {
#pragma unroll
        for (int h = 0; h < 2; ++h)
#pragma unroll
            for (int i = 0; i < 2; ++i) o[h][i] = (unsigned)((128 * h + R[i]) * K + C[i]) * 2u;
    }
};
struct SchedBranch {
    static constexpr bool GATHER = false;
    const char* A0; const char* A1; const char* B0; const char* B1; int G, c;
    __device__ __forceinline__ bool next(int i, pg8::Unit& u) const {
        const int L = (i >> 1) * G + c; if (L >= 512) return false;
        int wgid = L; { const int off = wgid / 8, xcd = wgid % 8; wgid = xcd * 64 + off; }
        const int nig = 8 * 4, gid = wgid / nig;
        u.pm = gid * 8 + ((wgid % nig) % 8); u.pn = (wgid % nig) / 8; u.aux = i & 1; u.tl = 0;
        u.A = ((i & 1) ? A1 : A0) + (size_t)u.pm * 256 * D * 2; u.B = ((i & 1) ? B1 : B0) + (size_t)u.pn * 256 * D * 2; return true;
    }
    __device__ __forceinline__ void aoff(const pg8::Unit&, const int (&R)[2], const int (&C)[2], unsigned (&o)[2][2]) const {
#pragma unroll
        for (int h = 0; h < 2; ++h)
#pragma unroll
            for (int i = 0; i < 2; ++i) o[h][i] = (unsigned)((128 * h + R[i]) * D + C[i]) * 2u;
    }
};
template <bool GATHER_, int NPN>
struct SchedMoe {
    static constexpr bool GATHER = GATHER_;
    const char* A; const char* Bt; LAS const unsigned char* misc; const int* list; int G, c;
    __device__ __forceinline__ bool next(int i, pg8::Unit& u) const {
        LAS const int* cl = (LAS const int*)(misc + MT_CNT); LAS const int* ps = (LAS const int*)(misc + MT_PSTART);
        if ((G & 7) == 0) {
            const int x = c & 7, r = c >> 3, n = G >> 3;
            int k = (i * n + r) / NPN; const int pn = (i * n + r) % NPN;
#pragma unroll
            for (int j = 0; j < 4; ++j) { const int e = x + 8 * j, nt = (cl[e] + 255) >> 8;
                if (k < nt) { u.pn = pn; u.aux = e; u.tl = k; u.pm = (ps[e] >> 8) + k;
                    u.A = GATHER ? A : A + (size_t)u.pm * 256 * 1024; u.B = Bt + ((size_t)e * NPN + pn) * 256 * 1024; return true; }
                k -= nt; }
            return false;
        }
        const int nact = *(LAS const int*)(misc + MT_NACT);
        const int L = i * G + c; if (L >= nact * NPN) return false;
        const int k = L / NPN; u.pn = L % NPN; const int w = ((LAS const int*)(misc + MT_ATILE))[k];
        u.pm = w & 0xfff; u.aux = (w >> 12) & 0xff; u.tl = w >> 20;
        u.A = GATHER ? A : A + (size_t)u.pm * 256 * 1024;
        u.B = Bt + ((size_t)u.aux * NPN + u.pn) * 256 * 1024; return true;
    }
    __device__ __forceinline__ void aoff(const pg8::Unit& u, const int (&R)[2], const int (&C)[2], unsigned (&o)[2][2]) const {
        const int ce = ((LAS const int*)(misc + MT_CNT))[u.aux];
#pragma unroll
        for (int h = 0; h < 2; ++h)
#pragma unroll
            for (int i = 0; i < 2; ++i) {
                if (GATHER) { const int idx = u.tl * 256 + 128 * h + R[i]; const int tok = (idx < ce) ? list[u.aux * NTOK + idx] : 0; o[h][i] = (unsigned)tok * 1024u + (unsigned)C[i] * 2u; }
                else o[h][i] = (unsigned)((128 * h + R[i]) * 1024 + C[i] * 2);
            }
    }
};

__device__ __forceinline__ u32x4 pack8(const f32x4& a, const f32x4& b) { u32x4 w; w.x = pk2(a[0], a[1]); w.y = pk2(a[2], a[3]); w.z = pk2(b[0], b[1]); w.w = pk2(b[2], b[3]); return w; }
__device__ __forceinline__ void unpack8(const u32x4& w, float (&f)[8]) {
    f[0] = __uint_as_float(w.x << 16); f[1] = __uint_as_float(w.x & 0xffff0000u); f[2] = __uint_as_float(w.y << 16); f[3] = __uint_as_float(w.y & 0xffff0000u);
    f[4] = __uint_as_float(w.z << 16); f[5] = __uint_as_float(w.z & 0xffff0000u); f[6] = __uint_as_float(w.w << 16); f[7] = __uint_as_float(w.w & 0xffff0000u);
}
struct EpiProj {
    static constexpr bool PERM = true;
    __device__ __forceinline__ void prefetch(const pg8::Unit&, int, int, int) const {}
    bf16* proj; LAS const float* gtab;
    __device__ __forceinline__ void operator()(pg8::Acc& acc, const pg8::Unit& u, int wr, int wc, int fr, int fq, int slot) const {
        const int pn = u.pn;
        int mode;
        if (pn < 4) mode = 1; else if (pn == 4) mode = (wc < 2) ? 2 : 0; else if (pn < 7) mode = 0; else if (pn < 9) mode = 3; else if (pn < 13) mode = 0; else if (pn < 17) mode = 4; else mode = 5;
        float gn[2][8];
        if (mode == 1 || mode == 2) { LAS const float* g = gtab + ((mode == 1) ? 0 : 64);
#pragma unroll
            for (int bj = 0; bj < 2; ++bj)
#pragma unroll
                for (int j = 0; j < 8; ++j) gn[bj][j] = g[32 * bj + 8 * fq + j]; }
#pragma unroll
        for (int ai = 0; ai < 2; ++ai)
#pragma unroll
            for (int m = 0; m < 4; ++m) {
                const int r = u.pm * 256 + ai * 128 + wr * 64 + m * 16 + fr;
                bf16* rowp = proj + (size_t)r * INW + pn * 256 + wc * 64 + 8 * fq;
                f32x4 v[2][2];
#pragma unroll
                for (int bj = 0; bj < 2; ++bj) { v[bj][0] = acc[ai][bj][m][0]; v[bj][1] = acc[ai][bj][m][1]; }
                if (mode == 1 || mode == 2) {
                    float ss = 0.f;
#pragma unroll
                    for (int bj = 0; bj < 2; ++bj)
#pragma unroll
                        for (int n = 0; n < 2; ++n) ss += v[bj][n][0] * v[bj][n][0] + v[bj][n][1] * v[bj][n][1] + v[bj][n][2] * v[bj][n][2] + v[bj][n][3] * v[bj][n][3];
                    ss += __shfl_xor(ss, 16); ss += __shfl_xor(ss, 32);
                    const float rs = rsqrtf(ss * (1.0f / 64.0f) + EPS);
#pragma unroll
                    for (int bj = 0; bj < 2; ++bj)
#pragma unroll
                        for (int n = 0; n < 2; ++n)
#pragma unroll
                            for (int i = 0; i < 4; ++i) v[bj][n][i] = v[bj][n][i] * rs * gn[bj][4 * n + i];
                } else if (mode == 3) {
#pragma unroll
                    for (int bj = 0; bj < 2; ++bj)
#pragma unroll
                        for (int n = 0; n < 2; ++n) v[bj][n] = v[bj][n] * 0.08838834764831845f;
                } else if (mode == 4) {
#pragma unroll
                    for (int bj = 0; bj < 2; ++bj)
#pragma unroll
                        for (int n = 0; n < 2; ++n)
#pragma unroll
                            for (int i = 0; i < 4; ++i) { const float x = v[bj][n][i]; v[bj][n][i] = x * sigmoidf_(x); }
                } else if (mode == 5) {
#pragma unroll
                    for (int bj = 0; bj < 2; ++bj)
#pragma unroll
                        for (int n = 0; n < 2; ++n)
#pragma unroll
                            for (int i = 0; i < 4; ++i) v[bj][n][i] = sigmoidf_(v[bj][n][i]);
                }
#pragma unroll
                for (int bj = 0; bj < 2; ++bj) *(u32x4*)(rowp + 32 * bj) = pack8(v[bj][0], v[bj][1]);
            }
    }
};
struct EpiBranch {
    static constexpr bool PERM = true;
    __device__ __forceinline__ void prefetch(const pg8::Unit&, int, int, int) const {}
    bf16* merged; const bf16* proj;
    __device__ __forceinline__ void load(u32x4 (&gw)[2][2], u32x4 (&pw)[2][2], const pg8::Unit& u, int q, int wr, int wc, int fr, int fq, int gcol) const {
#pragma unroll
        for (int mm = 0; mm < 2; ++mm)
#pragma unroll
            for (int bj = 0; bj < 2; ++bj) {
                const int r = u.pm * 256 + (q >> 1) * 128 + wr * 64 + (2 * (q & 1) + mm) * 16 + fr, col = u.pn * 256 + bj * 128 + wc * 32 + 8 * fq;
                gw[mm][bj] = *(const u32x4*)(proj + (size_t)r * INW + gcol + col);
                if (u.aux) pw[mm][bj] = *(const u32x4*)(merged + (size_t)r * D + col);
            }
    }
    __device__ __forceinline__ void operator()(pg8::Acc& acc, const pg8::Unit& u, int wr, int wc, int fr, int fq, int slot) const {
        const int gcol = u.aux ? C_GR : C_GA;
        u32x4 gA[2][2], pA[2][2], gB[2][2], pB[2][2];
        load(gA, pA, u, 0, wr, wc, fr, fq, gcol);
#pragma unroll
        for (int q = 0; q < 4; ++q) {
            if (q < 3) { if (q & 1) load(gA, pA, u, q + 1, wr, wc, fr, fq, gcol); else load(gB, pB, u, q + 1, wr, wc, fr, fq, gcol); }
            const int ai = q >> 1;
#pragma unroll
            for (int mm = 0; mm < 2; ++mm)
#pragma unroll
                for (int bj = 0; bj < 2; ++bj) {
                    const int m = 2 * (q & 1) + mm;
                    const int r = u.pm * 256 + ai * 128 + wr * 64 + m * 16 + fr, col = u.pn * 256 + bj * 128 + wc * 32 + 8 * fq;
                    float g[8]; unpack8((q & 1) ? gB[mm][bj] : gA[mm][bj], g);
                    f32x4 a = acc[ai][bj][m][0], b = acc[ai][bj][m][1];
                    a[0] *= g[0]; a[1] *= g[1]; a[2] *= g[2]; a[3] *= g[3]; b[0] *= g[4]; b[1] *= g[5]; b[2] *= g[6]; b[3] *= g[7];
                    if (u.aux) { float p[8]; unpack8((q & 1) ? pB[mm][bj] : pA[mm][bj], p);
                        a[0] += p[0]; a[1] += p[1]; a[2] += p[2]; a[3] += p[3]; b[0] += p[4]; b[1] += p[5]; b[2] += p[6]; b[3] += p[7]; }
                    *(u32x4*)(merged + (size_t)r * D + col) = pack8(a, b);
                }
        }
    }
};
struct EpiOut {
    static constexpr bool PERM = false;
    __device__ __forceinline__ void prefetch(const pg8::Unit&, int, int, int) const {}
    const float* x; float* out;
    __device__ __forceinline__ void load(f32x4 (&xv)[2][2][2], const pg8::Unit& u, int q, int wr, int wc, int fr, int fq) const {
#pragma unroll
        for (int mm = 0; mm < 2; ++mm) { const size_t off = (size_t)(u.pm * 256 + (q >> 1) * 128 + wr * 64 + (2 * (q & 1) + mm) * 16 + fr) * D + u.pn * 256 + wc * 32 + 4 * fq;
#pragma unroll
            for (int bj = 0; bj < 2; ++bj)
#pragma unroll
                for (int n = 0; n < 2; ++n) xv[mm][bj][n] = *(const f32x4*)(x + off + bj * 128 + n * 16); }
    }
    __device__ __forceinline__ void operator()(pg8::Acc& acc, const pg8::Unit& u, int wr, int wc, int fr, int fq, int slot) const {
        f32x4 xA[2][2][2], xB[2][2][2];
        load(xA, u, 0, wr, wc, fr, fq);
#pragma unroll
        for (int q = 0; q < 4; ++q) {
            if (q < 3) { if (q & 1) load(xA, u, q + 1, wr, wc, fr, fq); else load(xB, u, q + 1, wr, wc, fr, fq); }
            const int ai = q >> 1;
#pragma unroll
            for (int mm = 0; mm < 2; ++mm) { const int m = 2 * (q & 1) + mm; const size_t off = (size_t)(u.pm * 256 + ai * 128 + wr * 64 + m * 16 + fr) * D + u.pn * 256 + wc * 32 + 4 * fq;
#pragma unroll
                for (int bj = 0; bj < 2; ++bj)
#pragma unroll
                    for (int n = 0; n < 2; ++n) *(f32x4*)(out + off + bj * 128 + n * 16) = ((q & 1) ? xB[mm][bj][n] : xA[mm][bj][n]) + acc[ai][bj][m][n]; }
        }
    }
};
struct EpiGU {
    static constexpr bool PERM = true;
    unsigned char* act; const float* bgu; const float* rlist; LAS unsigned char* misc;
    __device__ __forceinline__ void prefetch(const pg8::Unit& u, int slot, int wid, int lane) const {
        if (wid < 4) __builtin_amdgcn_global_load_lds((const unsigned*)(rlist + (size_t)u.aux * NTOK + u.tl * 256 + wid * 64 + lane), (LAS unsigned*)(misc + MT_EPI + slot * 1024 + wid * 256), 4, 0, 0);
        else __builtin_amdgcn_global_load_lds((const unsigned*)(bgu + (size_t)u.aux * 2048 + ((wid - 4) >> 1) * 1024 + u.pn * 128 + ((wid - 4) & 1) * 64 + lane), (LAS unsigned*)(misc + MT_EPI2 + slot * 1024 + (wid - 4) * 256), 4, 0, 0);
    }
    __device__ __forceinline__ void operator()(pg8::Acc& acc, const pg8::Unit& u, int wr, int wc, int fr, int fq, int slot) const {
        const int ce = ((LAS const int*)(misc + MT_CNT))[u.aux];
        const int col = u.pn * 128 + wc * 32 + 8 * fq;
        LAS const float* bl = (LAS const float*)(misc + MT_EPI2 + slot * 1024) + wc * 32 + 8 * fq;
        float bgate[8], bup[8];
#pragma unroll
        for (int j = 0; j < 8; ++j) { bgate[j] = bl[j]; bup[j] = bl[128 + j]; }
#pragma unroll
        for (int ai = 0; ai < 2; ++ai)
#pragma unroll
            for (int m = 0; m < 4; ++m) {
                const int lr = ai * 128 + wr * 64 + m * 16 + fr, r = u.pm * 256 + lr;
                const float rs = ((LAS const float*)(misc + MT_EPI + slot * 1024))[lr] * W8_INV;
                float o[8];
#pragma unroll
                for (int n = 0; n < 2; ++n)
#pragma unroll
                    for (int i = 0; i < 4; ++i) {
                        float gate = acc[ai][0][m][n][i] * rs + bgate[4 * n + i], up = acc[ai][1][m][n][i] * rs + bup[4 * n + i];
                        gate = fminf(gate, 7.0f); up = fminf(fmaxf(up, -7.0f), 7.0f);
                        o[4 * n + i] = (up + 1.0f) * gate * sigmoidf_(1.702f * gate);
                    }
                u32x2 w; w.x = pk4_fp8(o[0], o[1], o[2], o[3]); w.y = pk4_fp8(o[4], o[5], o[6], o[7]);
                *(u32x2*)(act + (size_t)r * DFF + col) = w;
            }
    }
};
struct EpiDown {
    static constexpr bool PERM = true;
    unsigned char* rows; const float* bdn; const float* wlist; LAS const unsigned char* misc;
    __device__ __forceinline__ void prefetch(const pg8::Unit& u, int slot, int wid, int lane) const {
        if (wid < 4) __builtin_amdgcn_global_load_lds((const unsigned*)(wlist + (size_t)u.aux * NTOK + u.tl * 256 + wid * 64 + lane), (LAS unsigned*)(misc + MT_EPI + slot * 1024 + wid * 256), 4, 0, 0);
        else __builtin_amdgcn_global_load_lds((const unsigned*)(bdn + (size_t)u.aux * D + u.pn * 256 + (wid - 4) * 64 + lane), (LAS unsigned*)(misc + MT_EPI2 + slot * 1024 + (wid - 4) * 256), 4, 0, 0);
    }
    __device__ __forceinline__ void operator()(pg8::Acc& acc, const pg8::Unit& u, int wr, int wc, int fr, int fq, int slot) const {
        const int ce = ((LAS const int*)(misc + MT_CNT))[u.aux];
#pragma unroll
        for (int ai = 0; ai < 2; ++ai)
#pragma unroll
            for (int m = 0; m < 4; ++m) {
                const int lr = ai * 128 + wr * 64 + m * 16 + fr, r = u.pm * 256 + lr, idx = u.tl * 256 + lr;
                const float w = (idx < ce) ? ((LAS const float*)(misc + MT_EPI + slot * 1024))[lr] * ROW8_SCALE : 0.f;
                LAS const float* bl = (LAS const float*)(misc + MT_EPI2 + slot * 1024) + wc * 32 + 8 * fq;
                asm volatile("" : "+v"(bl));
#pragma unroll
                for (int bj = 0; bj < 2; ++bj) {
                    const f32x4 b0 = *(const LAS f32x4*)(bl + bj * 128), b1 = *(const LAS f32x4*)(bl + bj * 128 + 4);
                    f32x4 a = acc[ai][bj][m][0], b = acc[ai][bj][m][1];
#pragma unroll
                    for (int i = 0; i < 4; ++i) { a[i] = (a[i] * W8_INV + b0[i]) * w; b[i] = (b[i] * W8_INV + b1[i]) * w; }
                    u32x2 o; o.x = pk4_fp8(a[0], a[1], a[2], a[3]); o.y = pk4_fp8(b[0], b[1], b[2], b[3]);
                    *(u32x2*)(rows + (size_t)r * D + u.pn * 256 + bj * 128 + wc * 32 + 8 * fq) = o;
                }
            }
    }
};
namespace attn {
typedef float f32x16 __attribute__((ext_vector_type(16)));
typedef short s16x4 __attribute__((ext_vector_type(4)));
constexpr int NK = 272, K_OFF = 0, V_OFF = 34816, WS_OFF = 69632, OST_OFF = 71680, LDS_END = OST_OFF + 8 * 4096;
constexpr float LOG2E = 1.4426950408889634f;
__device__ __forceinline__ s16x4 vtr(LAS const unsigned char* p) { return __builtin_bit_cast(s16x4, __builtin_amdgcn_ds_read_tr16_b64_v4i16((LAS s16x4*)p)); }
__device__ __forceinline__ int crowc(int r) { return (r & 3) + 8 * (r >> 2); }

template <int TYPE, bool DIAG>
__device__ __forceinline__ void tile(LAS const unsigned char* lds, int kbase, const bf16x8 (&qr)[4], f32x16 (&o)[2], float& l, float lanebase, float c1, int tt, int lane) {
    const int r32 = lane & 31, hi = lane >> 5;
    f32x16 p = {};
#pragma unroll
    for (int d0 = 0; d0 < 4; ++d0) {
        const bf16x8 kf = *(const LAS bf16x8*)(lds + K_OFF + (2 * d0 + hi) * (NK * 16) + (kbase + r32) * 16);
        p = __builtin_amdgcn_mfma_f32_32x32x16_bf16(kf, qr[d0], p, 0, 0, 0);
    }
    constexpr int NR = (TYPE == 0) ? 8 : 16;
    float e[16];
#pragma unroll
    for (int r = 0; r < NR; ++r) {
        const float add = __builtin_fmaf(c1, (float)crowc(r), lanebase);
        float v = __builtin_amdgcn_exp2f(__builtin_fmaf(p[r], LOG2E, add));
        if (DIAG) { const bool ok = (TYPE == 1) ? (crowc(r) > tt) : (crowc(r) <= tt); v = ok ? v : 0.f; }
        e[r] = v; l += v;
    }
    constexpr int NS = (TYPE == 0) ? 1 : 2;
    u32x4 pw[2];
#pragma unroll
    for (int s = 0; s < NS; ++s) { pw[s].x = pk2(e[8 * s + 0], e[8 * s + 1]); pw[s].y = pk2(e[8 * s + 2], e[8 * s + 3]); pw[s].z = pk2(e[8 * s + 4], e[8 * s + 5]); pw[s].w = pk2(e[8 * s + 6], e[8 * s + 7]); }
    LAS const unsigned char* vb = lds + V_OFF + (kbase + 4 * hi + ((lane & 15) >> 2)) * 64 + ((lane >> 4) & 1) * 32 + (lane & 3) * 8;
#pragma unroll
    for (int d0 = 0; d0 < 2; ++d0)
#pragma unroll
        for (int s = 0; s < NS; ++s) {
            const s16x4 lo = vtr(vb + d0 * (NK * 64) + s * 1024), hh = vtr(vb + d0 * (NK * 64) + s * 1024 + 512);
            const bf16x8 vf = (bf16x8){lo[0], lo[1], lo[2], lo[3], hh[0], hh[1], hh[2], hh[3]};
            o[d0] = __builtin_amdgcn_mfma_f32_32x32x16_bf16(__builtin_bit_cast(bf16x8, pw[s]), vf, o[d0], 0, 0, 0);
        }
}

#define AT_ISSUE(u_) do { const int u__ = (u_); const int b_ = u__ >> 6, qb_ = (u__ >> 1) & 31, kvh_ = u__ & 1; \
        _Pragma("unroll") for (int i = 0; i < 5; ++i) { const int idx = tid + 512 * i; if (idx < NK * 8) { const int key = idx >> 3, c = idx & 7; const bf16* rowp; \
            if (key < 16) rowp = pmeta + (size_t)key * INW; else { int j = qb_ * 128 - 128 + (key - 16); if (j < 0) j = 0; rowp = proj + ((size_t)b_ * SEQ + j) * INW; } \
            pk[i] = *(const u32x4*)(rowp + C_AK + kvh_ * 64 + c * 8); pv[i] = *(const u32x4*)(rowp + C_AV + kvh_ * 64 + c * 8); } } } while (0)
#define AT_QLOAD(dst, a_) do { const size_t qrow_ = (size_t)b * SEQ + qb * 128 + 32 * (a_) + r32; \
        _Pragma("unroll") for (int d0 = 0; d0 < 4; ++d0) dst[d0] = *(const bf16x8*)(proj + qrow_ * INW + C_AQ + h * 64 + d0 * 16 + hi * 8); } while (0)
__device__ __forceinline__ void phase(LAS unsigned char* lds, const bf16* __restrict__ proj, const bf16* __restrict__ pmeta, const float* __restrict__ sinks, float bshift, bf16* __restrict__ yatt, int G, int bx) {
    const int tid = threadIdx.x, lane = tid & 63, r32 = lane & 31, hi = lane >> 5; const int wave = __builtin_amdgcn_readfirstlane(tid >> 6);
    constexpr int NU = NB * 32 * 2;
    if (bx >= NU) return;
    u32x4 pk[5], pv[5];
    AT_ISSUE(bx);
    for (int u = bx; u < NU; u += G) {
        const int b = u >> 6, qb = (u >> 1) & 31, kvh = u & 1;
#pragma unroll
        for (int i = 0; i < 5; ++i) { const int idx = tid + 512 * i; if (idx < NK * 8) { const int key = idx >> 3, c = idx & 7;
            *(LAS u32x4*)(lds + K_OFF + c * (NK * 16) + key * 16) = pk[i];
            *(LAS u32x4*)(lds + V_OFF + (c >> 2) * (NK * 64) + key * 64 + (c & 3) * 16) = pv[i]; } }
        if (u + G < NU) AT_ISSUE(u + G);
        const int h = kvh * 8 + wave;
        bf16x8 qr[4], qn[4];
        AT_QLOAD(qr, 0);
        __syncthreads();
        const float slope = exp2f(-0.5f * (float)(h + 1)), sink = sinks[h];
        const float M = fmaxf(bshift, sink);
        const float c1 = slope * LOG2E;
        LAS float* wsf = (LAS float*)(lds + WS_OFF) + wave * 64;
        LAS bf16* stg = (LAS bf16*)(lds + OST_OFF) + wave * 2048;
#pragma unroll 1
        for (int a = 0; a < 4; ++a) {
            if (a < 3) AT_QLOAD(qn, a + 1);
            f32x16 o[2]; o[0] = f32x16{}; o[1] = f32x16{};
            float l = 0.f;
            const int t = 32 * a + r32;
            const int tt = r32 - 4 * hi;
            const float hi4 = c1 * 4.0f * (float)hi;
            tile<0, false>(lds, 0, qr, o, l, -(slope * (float)(qb * 128 + t + 16) + M) * LOG2E + hi4, c1, tt, lane);
            if (qb > 0) {
                tile<1, true>(lds, 16 + 32 * a, qr, o, l, -(slope * (float)(128 + r32) + M) * LOG2E + hi4, c1, tt, lane);
                for (int bb = a + 1; bb < 4; ++bb) tile<1, false>(lds, 16 + 32 * bb, qr, o, l, -(slope * (float)(128 + t - 32 * bb) + M) * LOG2E + hi4, c1, tt, lane);
            }
            for (int bb = 0; bb < a; ++bb) tile<2, false>(lds, 144 + 32 * bb, qr, o, l, -(slope * (float)(t - 32 * bb) + M) * LOG2E + hi4, c1, tt, lane);
            tile<2, true>(lds, 144 + 32 * a, qr, o, l, -(slope * (float)r32 + M) * LOG2E + hi4, c1, tt, lane);
            l += __shfl_xor(l, 32);
            l += exp2f((sink - M) * LOG2E);
            if (hi == 0) wsf[r32] = l;
            LDS_WAIT();
            float rli[16];
#pragma unroll
            for (int r = 0; r < 16; ++r) rli[r] = __builtin_amdgcn_rcpf(wsf[crowc(r) + 4 * hi]);
#pragma unroll
            for (int r = 0; r < 16; ++r) { const int orow = crowc(r) + 4 * hi;
#pragma unroll
                for (int d0 = 0; d0 < 2; ++d0) stg[orow * 64 + d0 * 32 + r32] = f2bf(o[d0][r] * rli[r]); }
            LDS_WAIT();
            bf16* Ow = yatt + ((size_t)b * SEQ + qb * 128 + 32 * a) * D + h * 64;
#pragma unroll
            for (int i = 0; i < 4; ++i) { const int row = i * 8 + (lane >> 3), ch = lane & 7; const u32x4 v = *(const LAS u32x4*)(stg + row * 64 + ch * 8); *(u32x4*)(Ow + (size_t)row * D + ch * 8) = v; }
            LDS_WAIT();
#pragma unroll
            for (int d0 = 0; d0 < 4; ++d0) qr[d0] = qn[d0];
        }
        __syncthreads();
    }
}
#undef AT_ISSUE
#undef AT_QLOAD
}
namespace ret {
typedef float f32x16 __attribute__((ext_vector_type(16)));
typedef short s16x4 __attribute__((ext_vector_type(4)));
constexpr size_t WS_STATES = 893 * MiB;
__device__ __forceinline__ s16x4 vtr(LAS const unsigned char* p) { return __builtin_bit_cast(s16x4, __builtin_amdgcn_ds_read_tr16_b64_v4i16((LAS s16x4*)p)); }
__device__ __forceinline__ int crowc(int r) { return (r & 3) + 8 * (r >> 2); }
__device__ __forceinline__ float lg2gamma(int h) { return log2f(1.0f - exp2f(-5.0f - (float)h)); }

constexpr int R1_BUF = 40960;
#define RET_ISSUE(KR, VR, c_) do { const int ci__ = (c_); \
        _Pragma("unroll") for (int i = 0; i < 4; ++i) { const int idx = tid + 512 * i, key = idx >> 4, ch = idx & 15; \
            if (ci__ == 0) { KR[i] = (key >= 112) ? *(const u32x4*)(pmeta + (size_t)(key - 112) * INW + C_RK + h * 128 + ch * 8) : (u32x4){0u, 0u, 0u, 0u}; } \
            else KR[i] = *(const u32x4*)(proj + ((size_t)b * SEQ + (ci__ - 1) * 128 + key) * INW + C_RK + h * 128 + ch * 8); } \
        { const int key = tid >> 2, ch = tid & 3; \
          if (ci__ == 0) VR = (key >= 112) ? *(const u32x4*)(pmeta + (size_t)(key - 112) * INW + C_RV + h * 256 + dvs * 32 + ch * 8) : (u32x4){0u, 0u, 0u, 0u}; \
          else VR = *(const u32x4*)(proj + ((size_t)b * SEQ + (ci__ - 1) * 128 + key) * INW + C_RV + h * 256 + dvs * 32 + ch * 8); } } while (0)
#define RET_STEP(KR, VR, c_) do { const int c__ = (c_); LAS unsigned char* buf = lds + (c__ & 1) * R1_BUF; \
        _Pragma("unroll") for (int i = 0; i < 4; ++i) { const int idx = tid + 512 * i, key = idx >> 4, ch = idx & 15; *(LAS u32x4*)(buf + (ch >> 2) * (128 * 64) + key * 64 + (ch & 3) * 16) = KR[i]; } \
        { const int key = tid >> 2, ch = tid & 3; float f[8]; unpack8(VR, f); u32x4 w; \
          w.x = pk2(f[0] * vscale, f[1] * vscale); w.y = pk2(f[2] * vscale, f[3] * vscale); w.z = pk2(f[4] * vscale, f[5] * vscale); w.w = pk2(f[6] * vscale, f[7] * vscale); \
          *(LAS u32x4*)(buf + 32768 + key * 64 + ch * 16) = w; } \
        if (c__ + 2 < 32) RET_ISSUE(KR, VR, c__ + 2); \
        __syncthreads(); \
        if (wave < 4) { \
            const int dt = wave; \
            acc = acc * g128; \
            LAS const unsigned char* ab = buf + dt * (128 * 64) + (4 * hi + ((lane & 15) >> 2)) * 64 + ((lane >> 4) & 1) * 32 + (lane & 3) * 8; \
            LAS const unsigned char* bb = buf + 32768 + (4 * hi + ((lane & 15) >> 2)) * 64 + ((lane >> 4) & 1) * 32 + (lane & 3) * 8; \
            _Pragma("unroll") for (int ks = 0; ks < 8; ++ks) { \
                const s16x4 al = vtr(ab + ks * 1024), ah = vtr(ab + ks * 1024 + 512), bl = vtr(bb + ks * 1024), bh = vtr(bb + ks * 1024 + 512); \
                const bf16x8 af = (bf16x8){al[0], al[1], al[2], al[3], ah[0], ah[1], ah[2], ah[3]}, bfr = (bf16x8){bl[0], bl[1], bl[2], bl[3], bh[0], bh[1], bh[2], bh[3]}; \
                acc = __builtin_amdgcn_mfma_f32_32x32x16_bf16(af, bfr, acc, 0, 0, 0); } \
            bf16* sb = states + ((((size_t)(b * 4 + h) * 32 + c__) * 8 + dvs) * 8) * 512; \
            _Pragma("unroll") for (int g = 0; g < 4; ++g) { u32x2 w; w.x = pk2(acc[4 * g], acc[4 * g + 1]); w.y = pk2(acc[4 * g + 2], acc[4 * g + 3]); \
                *(u32x2*)(sb + (size_t)(2 * dt + (g >> 1)) * 512 + (32 * (g & 1) + (lane & 31)) * 8 + 4 * hi) = w; } \
        } } while (0)
__device__ __forceinline__ void state_chain(LAS unsigned char* lds, int b, int h, int dvs, const bf16* __restrict__ proj, const bf16* __restrict__ pmeta, bf16* __restrict__ states) {
    const int tid = threadIdx.x, lane = tid & 63, hi = lane >> 5; const int wave = __builtin_amdgcn_readfirstlane(tid >> 6);
    const float lg = lg2gamma(h), g128 = exp2f(lg * 128.0f);
    u32x4 kA[4], kB[4], vA, vB;
    const float vscale = exp2f(lg * (float)(127 - (tid >> 2)));
    f32x16 acc = {};
    RET_ISSUE(kA, vA, 0); RET_ISSUE(kB, vB, 1);
#pragma unroll 1
    for (int c = 0; c < 32; c += 2) { RET_STEP(kA, vA, c); RET_STEP(kB, vB, c + 1); }
    __syncthreads();
}
#undef RET_ISSUE
#undef RET_STEP

constexpr int R3_K = 0, R3_Q = 32768, R3_V = 65536;
#define R3_ISSUE(u_) do { const int u__ = (u_); const size_t rw = (size_t)(u__ >> 7) * SEQ + (u__ & 31) * 128; const int hh = (u__ >> 5) & 3; \
        _Pragma("unroll") for (int i = 0; i < 4; ++i) { const int idx = tid + 512 * i, key = idx >> 4, ch = idx & 15; \
            kq[i] = *(const u32x4*)(proj + (rw + key) * INW + C_RK + hh * 128 + ch * 8); kq[4 + i] = *(const u32x4*)(proj + (rw + key) * INW + C_RQ + hh * 128 + ch * 8); } \
        _Pragma("unroll") for (int i = 0; i < 8; ++i) { const int idx = tid + 512 * i, key = idx >> 5, ch = idx & 31; vv[i] = *(const u32x4*)(proj + (rw + key) * INW + C_RV + hh * 256 + ch * 8); } } while (0)
__device__ __forceinline__ void out_phase(LAS unsigned char* lds, const bf16* __restrict__ proj, const bf16* __restrict__ states, bf16* __restrict__ yret, int G, int bx) {
    const int tid = threadIdx.x, lane = tid & 63, r32 = lane & 31, hi = lane >> 5; const int wave = __builtin_amdgcn_readfirstlane(tid >> 6);
    constexpr int NU = NB * 4 * 32;
    if (bx >= NU) return;
    u32x4 kq[8], vv[8];
    R3_ISSUE(bx);
    for (int u = bx; u < NU; u += G) {
        const int b = u >> 7, h = (u >> 5) & 3, tb = u & 31;
        const float lg = lg2gamma(h);
        const size_t row0 = (size_t)b * SEQ + tb * 128;
#pragma unroll
        for (int i = 0; i < 4; ++i) { const int idx = tid + 512 * i, key = idx >> 4, ch = idx & 15;
            *(LAS u32x4*)(lds + R3_K + ch * 2048 + key * 16) = kq[i]; *(LAS u32x4*)(lds + R3_Q + ch * 2048 + key * 16) = kq[4 + i]; }
#pragma unroll
        for (int i = 0; i < 8; ++i) { const int idx = tid + 512 * i, key = idx >> 5, ch = idx & 31; *(LAS u32x4*)(lds + R3_V + (ch >> 2) * 8192 + key * 64 + (ch & 3) * 16) = vv[i]; }
        if (u + G < NU) R3_ISSUE(u + G);
        bf16x8 sf[8];
        { const bf16* sb = states + (((size_t)(b * 4 + h) * 32 + tb) * 64 + (size_t)wave * 8) * 512 + lane * 8;
#pragma unroll
          for (int k = 0; k < 8; ++k) sf[k] = *(const bf16x8*)(sb + (size_t)k * 512); }
        __syncthreads();
        u32x2 pw[2][4];
        for (int rp_ = 0; rp_ < ((PROBE_PHASE == 31) ? 2 : 1); ++rp_)
#pragma unroll
        for (int ti = 0; ti < 2; ++ti) {
            const int t = wave + 8 * ti;
            if (t < 10) {
                const int a = (t >= 6) ? 3 : (t >= 3) ? 2 : (t >= 1) ? 1 : 0, bb = t - ((a * (a + 1)) >> 1);
                f32x16 p = {};
#pragma unroll
                for (int k = 0; k < 8; ++k) {
                    const bf16x8 kf = *(const LAS bf16x8*)(lds + R3_K + (2 * k + hi) * 2048 + (32 * bb + r32) * 16);
                    const bf16x8 qf = *(const LAS bf16x8*)(lds + R3_Q + (2 * k + hi) * 2048 + (32 * a + r32) * 16);
                    p = __builtin_amdgcn_mfma_f32_32x32x16_bf16(kf, qf, p, 0, 0, 0);
                }
                const float lanebase = lg * (float)(32 * (a - bb) + r32 - 4 * hi), cpos = -lg; const int tt = r32 - 4 * hi;
                float e[16];
#pragma unroll
                for (int r = 0; r < 16; ++r) { float v = p[r] * __builtin_amdgcn_exp2f(__builtin_fmaf(cpos, (float)crowc(r), lanebase)); if (bb == a) v = (crowc(r) <= tt) ? v : 0.f; e[r] = v; }
#pragma unroll
                for (int g = 0; g < 4; ++g) { pw[ti][g].x = pk2(e[4 * g], e[4 * g + 1]); pw[ti][g].y = pk2(e[4 * g + 2], e[4 * g + 3]); }
            }
        }
        __builtin_amdgcn_sched_barrier(0);
        bf16x8 vf[8];
        { LAS const unsigned char* vb = lds + R3_V + wave * 8192 + (8 * hi + ((lane & 15) >> 2)) * 64 + ((lane >> 4) & 1) * 32 + (lane & 3) * 8;
#pragma unroll
          for (int ks = 0; ks < 8; ++ks) { const s16x4 lo = vtr(vb + ks * 1024), hh = vtr(vb + ks * 1024 + 256); vf[ks] = (bf16x8){lo[0], lo[1], lo[2], lo[3], hh[0], hh[1], hh[2], hh[3]}; } }
        __syncthreads();
#pragma unroll
        for (int ti = 0; ti < 2; ++ti) {
            const int t = wave + 8 * ti;
            if (t < 10) {
                const int a = (t >= 6) ? 3 : (t >= 3) ? 2 : (t >= 1) ? 1 : 0, bb = t - ((a * (a + 1)) >> 1);
#pragma unroll
                for (int g = 0; g < 4; ++g) *(LAS u32x2*)(lds + R3_K + (4 * bb + g) * 2048 + (32 * a + r32) * 16 + hi * 8) = pw[ti][g];
            }
        }
        __syncthreads();
        LAS bf16* stg = (LAS bf16*)(lds + R3_V);
        for (int rp_ = 0; rp_ < ((PROBE_PHASE == 32) ? 2 : 1); ++rp_)
#pragma unroll 1
        for (int a = 0; a < 4; ++a) {
            f32x16 o = {};
#pragma unroll
            for (int ks = 0; ks < 8; ++ks) if (ks < 2 * (a + 1)) {
                const bf16x8 pa = *(const LAS bf16x8*)(lds + R3_K + (2 * ks + hi) * 2048 + (32 * a + r32) * 16);
                o = __builtin_amdgcn_mfma_f32_32x32x16_bf16(pa, vf[ks], o, 0, 0, 0);
            }
            f32x16 x = {};
#pragma unroll
            for (int k = 0; k < 8; ++k) { const bf16x8 qa = *(const LAS bf16x8*)(lds + R3_Q + (2 * k + hi) * 2048 + (32 * a + r32) * 16); x = __builtin_amdgcn_mfma_f32_32x32x16_bf16(qa, sf[k], x, 0, 0, 0); }
#pragma unroll
            for (int r = 0; r < 16; ++r) {
                const float din = __builtin_amdgcn_exp2f(lg * (float)(32 * a + crowc(r) + 4 * hi + 1));
                { const int row = 32 * a + crowc(r) + 4 * hi, col = wave * 32 + r32;
                  stg[row * 256 + ((((col >> 3) ^ ((row & 3) << 2)) << 3) | (col & 7))] = f2bf(o[r] + din * x[r]); }
            }
        }
        int nl = lane; asm volatile("" : "+v"(nl));
        const int nrow = wave * 16 + (nl >> 2), c4 = nl & 3, sx = nrow & 3;
        const bf16* rgp = proj + (row0 + nrow) * INW + C_RG + h * 256 + c4 * 8;
        bf16* yp = yret + (row0 + nrow) * D + h * 256 + c4 * 8;
        LAS const bf16* sp = stg + nrow * 256 + c4 * 8;
        u32x4 rgv[8];
#pragma unroll
        for (int j = 0; j < 8; ++j) rgv[j] = *(const u32x4*)(rgp + 32 * j);
        __syncthreads();
        for (int rp_ = 0; rp_ < ((PROBE_PHASE == 33) ? 2 : 1); ++rp_) {
            float ss = 0.f;
#pragma unroll
            for (int j = 0; j < 8; ++j) { const u32x4 sw = *(const LAS u32x4*)(sp + 32 * (j ^ sx)); float f[8]; unpack8(sw, f);
#pragma unroll
                for (int i = 0; i < 8; ++i) ss += f[i] * f[i]; }
            ss += __shfl_xor(ss, 1); ss += __shfl_xor(ss, 2);
            const float rs = rsqrtf(ss * (1.0f / 256.0f) + EPS);
            asm volatile("" ::: "memory");
#pragma unroll
            for (int j = 0; j < 8; ++j) { const u32x4 sw = *(const LAS u32x4*)(sp + 32 * (j ^ sx)); float f[8], g[8]; unpack8(sw, f); unpack8(rgv[j], g); u32x4 w;
                w.x = pk2(f[0] * rs * g[0], f[1] * rs * g[1]); w.y = pk2(f[2] * rs * g[2], f[3] * rs * g[3]); w.z = pk2(f[4] * rs * g[4], f[5] * rs * g[5]); w.w = pk2(f[6] * rs * g[6], f[7] * rs * g[7]);
                *(u32x4*)(yp + 32 * j) = w; }
        }
        __syncthreads();
    }
}
#undef R3_ISSUE
}
template <bool FP8>
__device__ __forceinline__ void p0_item(const float* __restrict__ W, int K, int N, void* __restrict__ WT, int k0, int n0, int dst_row0, int lane) {
    const int kblk = lane >> 3, nq = lane & 7;
    const float* src = W + (size_t)(k0 + 16 * kblk) * N + n0 + 4 * nq;
    f32x4 v[16];
#pragma unroll
    for (int i = 0; i < 16; ++i) v[i] = *(const f32x4*)(src + (size_t)i * N);
#pragma unroll
    for (int j = 0; j < 4; ++j) {
        const size_t row = (size_t)(dst_row0 + 4 * nq + j);
        if constexpr (FP8) {
            u32x4 o;
            o.x = pk4_fp8(v[0][j] * W8_SCALE, v[1][j] * W8_SCALE, v[2][j] * W8_SCALE, v[3][j] * W8_SCALE); o.y = pk4_fp8(v[4][j] * W8_SCALE, v[5][j] * W8_SCALE, v[6][j] * W8_SCALE, v[7][j] * W8_SCALE);
            o.z = pk4_fp8(v[8][j] * W8_SCALE, v[9][j] * W8_SCALE, v[10][j] * W8_SCALE, v[11][j] * W8_SCALE); o.w = pk4_fp8(v[12][j] * W8_SCALE, v[13][j] * W8_SCALE, v[14][j] * W8_SCALE, v[15][j] * W8_SCALE);
            *(u32x4*)((unsigned char*)WT + row * K + k0 + 16 * kblk) = o;
        } else {
            u32x4 a, b;
            a.x = pk2(v[0][j], v[1][j]); a.y = pk2(v[2][j], v[3][j]); a.z = pk2(v[4][j], v[5][j]); a.w = pk2(v[6][j], v[7][j]);
            b.x = pk2(v[8][j], v[9][j]); b.y = pk2(v[10][j], v[11][j]); b.z = pk2(v[12][j], v[13][j]); b.w = pk2(v[14][j], v[15][j]);
            bf16* d = (bf16*)WT + row * K + k0 + 16 * kblk;
            *(u32x4*)d = a; *(u32x4*)(d + 8) = b;
        }
    }
}
#ifndef PROBE_PHASE
#define PROBE_PHASE (-1)
#endif
__device__ __forceinline__ void p0_transpose_item_fp8(const float* W, int K, int N, unsigned char* WT, int k0, int n0, int dst_row0, LAS float* scr, int lane) {
#pragma unroll 8
    for (int i = 0; i < 32; ++i) { const int kk = 2 * i + (lane >> 5); scr[kk * 33 + (lane & 31)] = W[(size_t)(k0 + kk) * N + n0 + (lane & 31)]; }
    LDS_WAIT(); asm volatile("" ::: "memory");
    const int c = lane & 3;
#pragma unroll
    for (int j = 0; j < 2; ++j) { const int n = (lane >> 2) + 16 * j; const LAS float* s = scr + (16 * c) * 33 + n;
        u32x4 o;
        o.x = pk4_fp8(s[0 * 33] * W8_SCALE, s[1 * 33] * W8_SCALE, s[2 * 33] * W8_SCALE, s[3 * 33] * W8_SCALE); o.y = pk4_fp8(s[4 * 33] * W8_SCALE, s[5 * 33] * W8_SCALE, s[6 * 33] * W8_SCALE, s[7 * 33] * W8_SCALE);
        o.z = pk4_fp8(s[8 * 33] * W8_SCALE, s[9 * 33] * W8_SCALE, s[10 * 33] * W8_SCALE, s[11 * 33] * W8_SCALE); o.w = pk4_fp8(s[12 * 33] * W8_SCALE, s[13 * 33] * W8_SCALE, s[14 * 33] * W8_SCALE, s[15 * 33] * W8_SCALE);
        *(u32x4*)(WT + (size_t)(dst_row0 + n) * K + k0 + 16 * c) = o; }
    LDS_WAIT(); asm volatile("" ::: "memory");
}
struct Args { const float* in[17]; float* out; unsigned char* ws; int ph_lo, ph_hi, li, pad; };

__global__ void __launch_bounds__(512, 2) mk_fwd(Args args) {
    extern __shared__ __attribute__((aligned(16))) unsigned char lds_raw[];
    LAS unsigned char* lds = (LAS unsigned char*)lds_raw;
    volatile LAS unsigned* MISC = (volatile LAS unsigned*)(lds + MISC_OFF);
    const int tid = threadIdx.x, lane = tid & 63, wave = __builtin_amdgcn_readfirstlane(tid >> 6);
    const int G = gridDim.x, bx = blockIdx.x;
    const int vcu = (G % 8 == 0) ? (bx % 8) * (G / 8) + bx / 8 : bx;
    unsigned char* ws = args.ws;
    unsigned* ctl = (unsigned*)(ws + WS_CTL);
    const float* x = args.in[0]; const float* meta = args.in[1]; const float* g1 = args.in[2]; const float* w_in = args.in[3];
    const float* qg = args.in[4]; const float* kg = args.in[5];
    const float* w_ab = args.in[7]; const float* w_rb = args.in[8]; const float* w_out = args.in[9];
    const float* w_gu = args.in[13]; const float* b_gu = args.in[14]; const float* w_dn = args.in[15]; const float* b_dn = args.in[16];
    float* out = args.out;
    bf16* Win_t = (bf16*)(ws + WS_WIN); bf16* Wab_t = (bf16*)(ws + WS_WAB); bf16* Wrb_t = (bf16*)(ws + WS_WRB); bf16* Wout_t = (bf16*)(ws + WS_WOUT);
    unsigned char* Wgu_t = ws + WS_WGU; unsigned char* Wdn_t = ws + WS_WDN;
    bf16* xb = (bf16*)(ws + WS_XB); bf16* proj = (bf16*)(ws + WS_PROJ); bf16* yatt = (bf16*)(ws + WS_YATT); bf16* yret = (bf16*)(ws + WS_YRET); bf16* merged = (bf16*)(ws + WS_MERGED);
    bf16* pmeta = proj + (size_t)NTOK * INW;
    const float* sinks = args.in[6]; const float* g2 = args.in[10]; const float* w_r = args.in[11]; const float* b_r = args.in[12];
    int* tke = (int*)(ws + SM_TKE); float* tkw = (float*)(ws + SM_TKW); int* tkpos = (int*)(ws + SM_TKPOS); int* list = (int*)(ws + SM_LIST); float* wlist = (float*)(ws + SM_WLIST); float* rlist = (float*)(ws + SM_RLIST);
    LAS unsigned char* misc = lds + MISC_OFF;
    bf16* states = (bf16*)(ws + ret::WS_STATES);
    unsigned char* act = ws + WS_ACT; unsigned char* rows = ws + WS_ROWS; unsigned char* xn8 = ws + WS_XB;

    for (int u = tid; u < (LDS_BYTES - MISC_OFF) / 4; u += 512) ((LAS unsigned*)(lds + MISC_OFF))[u] = 0u;
    __syncthreads();
    XcdBarrier bar = xcd_barrier_post(ctl + CW_BAR + args.li * XCD_BAR_WORDS, MISC + 8);
    const int lo = args.ph_lo, hi = args.ph_hi;
#define IN(k) (lo <= (k) && (k) < hi)
#define BOTH(k) (IN(k) && IN((k) + 1))
#define GRID_BAR() xcd_barrier(bar)

    if (IN(0)) { for (int rep_ = 0; rep_ < ((PROBE_PHASE == 0) ? 2 : 1); ++rep_) {
        const int gw = vcu * NWAVES + wave, NGW = G * NWAVES;
        constexpr int I_IN = 8 * 200, I_SQ = 8 * 32, I_GU = 32 * 8 * 64, I_DN = 32 * 8 * 32;
        constexpr int NITEMS = I_IN + 3 * I_SQ + I_GU + I_DN;
        for (int rep2_ = 0; rep2_ < ((PROBE_PHASE == 100) ? 2 : 1); ++rep2_)
        for (int it = gw; it < NITEMS; it += NGW) {
            int r = it;
            if (r < I_IN) { const int kb = r / 200, nb = r % 200, n0 = nb * 32, o = n0 & 255, wcc = o >> 6, bj = (o >> 5) & 1;
                p0_item<false>(w_in, D, INW, Win_t, kb * 128, n0, (n0 & ~255) + 128 * bj + 32 * wcc, lane); continue; }
            r -= I_IN;
            if (r < I_SQ) { p0_item<false>(w_ab, D, D, Wab_t, (r / 32) * 128, (r % 32) * 32, (r % 32) * 32, lane); continue; } r -= I_SQ;
            if (r < I_SQ) { p0_item<false>(w_rb, D, D, Wrb_t, (r / 32) * 128, (r % 32) * 32, (r % 32) * 32, lane); continue; } r -= I_SQ;
            if (r < I_SQ) { p0_item<false>(w_out, D, D, Wout_t, (r / 32) * 128, (r % 32) * 32, (r % 32) * 32, lane); continue; } r -= I_SQ;
            if (r < I_GU) { const int e = r / 512, q = r % 512, kb = q / 64, nb = q % 64, n0 = nb * 32, bj = n0 >> 10, rem = n0 & 1023, pn = rem >> 7, cl = rem & 127;
                p0_item<true>(w_gu + (size_t)e * D * 2048, D, 2048, Wgu_t + (size_t)e * 2048 * D, kb * 128, n0, 256 * pn + 128 * bj + cl, lane); continue; }
            r -= I_GU;
            { const int e = r / 256, q = r % 256, kb = q / 32, nb = q % 32;
              p0_item<true>(w_dn + (size_t)e * DFF * D, DFF, D, Wdn_t + (size_t)e * D * DFF, kb * 128, nb * 32, nb * 32, lane); }
        }
        for (int rep2_ = 0; rep2_ < ((PROBE_PHASE == 101) ? 2 : 1); ++rep2_)
        for (int row = gw; row < NTOK; row += NGW) {
            const f32x4* xr = (const f32x4*)(x + (size_t)row * D) + lane;
            f32x4 v[4]; float ss = 0.f;
#pragma unroll
            for (int j = 0; j < 4; ++j) { v[j] = xr[64 * j]; ss += (v[j][0] * v[j][0] + v[j][1] * v[j][1]) + (v[j][2] * v[j][2] + v[j][3] * v[j][3]); }
            const float rstd = rsqrtf(wave_sum(ss) * (1.0f / D) + EPS);
            u32x2* o8 = (u32x2*)(xb + (size_t)row * D) + lane;
#pragma unroll
            for (int j = 0; j < 4; ++j) { const f32x4 gg = ((const f32x4*)g1)[64 * j + lane]; u32x2 w; w.x = pk2(v[j][0] * rstd * gg[0], v[j][1] * rstd * gg[1]); w.y = pk2(v[j][2] * rstd * gg[2], v[j][3] * rstd * gg[3]); o8[64 * j] = w; }
        }
        for (int row = gw; row < 256; row += NGW) {
            u32x2* o8 = (u32x2*)(xb + (size_t)(NTOK + row) * D) + lane;
            if (row < NMETA) {
                const f32x4* xr = (const f32x4*)(meta + (size_t)row * D) + lane;
                f32x4 v[4]; float ss = 0.f;
#pragma unroll
                for (int j = 0; j < 4; ++j) { v[j] = xr[64 * j]; ss += (v[j][0] * v[j][0] + v[j][1] * v[j][1]) + (v[j][2] * v[j][2] + v[j][3] * v[j][3]); }
                const float rstd = rsqrtf(wave_sum(ss) * (1.0f / D) + EPS);
#pragma unroll
                for (int j = 0; j < 4; ++j) { const f32x4 gg = ((const f32x4*)g1)[64 * j + lane]; u32x2 w; w.x = pk2(v[j][0] * rstd * gg[0], v[j][1] * rstd * gg[1]); w.y = pk2(v[j][2] * rstd * gg[2], v[j][3] * rstd * gg[3]); o8[64 * j] = w; }
            } else {
#pragma unroll
                for (int j = 0; j < 4; ++j) o8[64 * j] = (u32x2){0u, 0u};
            }
        }
        __syncthreads(); }
        if (BOTH(0)) GRID_BAR();
    }
    if (PROBE_PHASE == 200) { GRID_BAR(); GRID_BAR(); GRID_BAR(); GRID_BAR(); }
    if (IN(1)) {
        SchedDense S; S.init(xb, Win_t, NTOK + 256, INW, D, G, bx);
        { LAS float* gt = (LAS float*)(misc + MT_GAIN); if (tid < 64) { gt[tid] = 0.125f * qg[tid]; gt[64 + tid] = kg[tid]; } __syncthreads(); }
        EpiProj E{proj, (LAS const float*)(misc + MT_GAIN)};
        for (int rep_ = 0; rep_ < ((PROBE_PHASE == 1) ? 2 : 1); ++rep_) pg8::gemm_phase<EpiProj, SchedDense>(lds, 2 * D, S, E);
        if (BOTH(1)) GRID_BAR();
    }
    if (IN(2)) {
        float mq = fabsf(qg[lane]), mk = fabsf(kg[lane]);
#pragma unroll
        for (int o = 1; o < 64; o <<= 1) { mq = fmaxf(mq, __shfl_xor(mq, o)); mk = fmaxf(mk, __shfl_xor(mk, o)); }
        const float bshift = 8.0f * mq * mk;
        for (int rep_ = 0; rep_ < ((PROBE_PHASE == 20) ? 2 : 1); ++rep_) attn::phase(lds, proj, pmeta, sinks, bshift, yatt, G, bx);
        for (int rep_ = 0; rep_ < ((PROBE_PHASE == 21) ? 2 : 1); ++rep_) for (int u = bx; u < NB * 4 * 8; u += G) { const int v = ((G & 7) == 0 && G == 256) ? ((u & 7) * 32 + (u >> 3)) : u;
            ret::state_chain(lds, v >> 5, (v >> 3) & 3, v & 7, proj, pmeta, states); }
        if (BOTH(2)) GRID_BAR();
    }
    if (IN(3)) {
        for (int rep_ = 0; rep_ < ((PROBE_PHASE == 3) ? 2 : 1); ++rep_) ret::out_phase(lds, proj, states, yret, G, bx);
        if (BOTH(3)) GRID_BAR();
    }
    if (IN(4)) {
        SchedBranch S{(const char*)yatt, (const char*)yret, (const char*)Wab_t, (const char*)Wrb_t, G, bx};
        EpiBranch E{merged, proj};
        for (int rep_ = 0; rep_ < ((PROBE_PHASE == 4) ? 2 : 1); ++rep_) pg8::gemm_phase<EpiBranch, SchedBranch>(lds, 2 * D, S, E);
        if (BOTH(4)) GRID_BAR();
    }
    if (IN(5)) {
        SchedDense S; S.init(merged, Wout_t, NTOK, D, D, G, bx);
        EpiOut E{x, out};
        for (int rep_ = 0; rep_ < ((PROBE_PHASE == 5) ? 2 : 1); ++rep_) pg8::gemm_phase<EpiOut, SchedDense>(lds, 2 * D, S, E);
        if (BOTH(5)) GRID_BAR();
    }
    if (IN(6)) {
        route_phase(lds, out, g2, w_r, b_r, xn8, tke, tkpos, tkw, list, wlist, rlist, ctl + CW_CNT, G, bx);
        if (BOTH(6)) GRID_BAR();
    }
    if (hi > 7 && lo <= 9) moe_tables(misc, ctl + CW_CNT);
    if (IN(7)) {
        SchedMoe<true, 8> S{(const char*)xn8, (const char*)Wgu_t, misc, list, G, bx};
        EpiGU E{act, b_gu, rlist, misc};
        for (int rep_ = 0; rep_ < ((PROBE_PHASE == 7) ? 2 : 1); ++rep_) pg8::gemm_phase<EpiGU, SchedMoe<true, 8>, true>(lds, D, S, E);
        if (BOTH(7)) GRID_BAR();
    }
    if (IN(8)) {
        SchedMoe<false, 4> S{(const char*)act, (const char*)Wdn_t, misc, list, G, bx};
        EpiDown E{rows, b_dn, wlist, misc};
        for (int rep_ = 0; rep_ < ((PROBE_PHASE == 8) ? 2 : 1); ++rep_) pg8::gemm_phase<EpiDown, SchedMoe<false, 4>, true>(lds, DFF, S, E);
        if (BOTH(8)) GRID_BAR();
    }
    if (IN(9)) combine_phase(misc, (void*)proj, out, rows, tke, tkpos, vcu * NWAVES + wave, G * NWAVES, lane);
#undef IN
#undef BOTH
#undef GRID_BAR
}

extern "C" void kernel_launch(void* const* d_in, const int* in_sizes, int n_in, void* d_out, int out_size, void* d_ws, size_t ws_size, hipStream_t stream) {
    static int grid = 0;
    if (grid == 0) {
        if (n_in != 17 || in_sizes[0] != NTOK * D || out_size != NTOK * D || ws_size < WS_END) {
            fprintf(stderr, "kernel_launch: unexpected shapes (n_in %d in0 %d out %d ws %zu)\n", n_in, n_in > 0 ? in_sizes[0] : -1, out_size, ws_size); grid = -1; return; }
        int dev = 0, cus = 0;
        if (hipGetDevice(&dev) != hipSuccess || hipDeviceGetAttribute(&cus, hipDeviceAttributeMultiprocessorCount, dev) != hipSuccess) { grid = -1; return; }
        if (hipFuncSetAttribute((const void*)mk_fwd, hipFuncAttributeMaxDynamicSharedMemorySize, LDS_BYTES) != hipSuccess) { fprintf(stderr, "kernel_launch: hipFuncSetAttribute failed\n"); grid = -1; return; }
        grid = cus;
    }
    if (grid < 0) return;
    unsigned char* ws = (unsigned char*)d_ws;
    (void)hipMemsetAsync(ws + WS_CTL, 0, 1 * MiB, stream);
    Args a{};
    for (int i = 0; i < 17; ++i) a.in[i] = (const float*)d_in[i];
    a.out = (float*)d_out; a.ws = ws; a.ph_lo = 0; a.ph_hi = 10; a.li = 0; a.pad = 0;
    hipLaunchKernelGGL(mk_fwd, dim3(grid), dim3(512), LDS_BYTES, stream, a);
}
```

```cpp
#include <hip/hip_runtime.h>
#include <cstdio>
#include <cstdint>

typedef unsigned short bf16;
__device__ __forceinline__ float bf2f(bf16 v) { return __uint_as_float(((unsigned)v) << 16); }
__device__ __forceinline__ bf16 f2bf(float f) { const __bf16 b = (__bf16)f; return __builtin_bit_cast(unsigned short, b); }
__device__ __forceinline__ float sigmoidf_(float x) { return __builtin_amdgcn_rcpf(1.0f + __builtin_amdgcn_exp2f(-1.4426950408889634f * x)); }

constexpr int NB = 8, SEQ = 4096, D = 1024, NTOK = NB * SEQ;
constexpr int NMETA = 16;
constexpr int INW = 6400;
constexpr int C_AQ = 0, C_AK = 1024, C_AV = 1152, C_RQ = 1280, C_RK = 1792, C_RV = 2304, C_RG = 3328, C_GA = 4352, C_GR = 5376;
constexpr int NE = 32, TOPK = 4, DFF = 1024;
constexpr int NROWS = (NTOK * TOPK / 256 + NE) * 256;
constexpr int NTILE = NROWS / 256;
constexpr float EPS = 1e-5f;

constexpr size_t MiB = 1u << 20;
constexpr size_t WS_CTL = 0;
constexpr size_t WS_SMALL = 1 * MiB;
constexpr size_t WS_W = 16 * MiB;
constexpr size_t WS_XB = 232 * MiB;
constexpr size_t WS_PROJ = 297 * MiB;
constexpr size_t WS_YATT = 701 * MiB;
constexpr size_t WS_YRET = 765 * MiB;
constexpr size_t WS_MERGED = 829 * MiB;
constexpr size_t WS_END = 1020 * MiB;
constexpr size_t WS_ACT = 297 * MiB;
constexpr size_t WS_ROWS = 568 * MiB;
constexpr size_t SM_UMETA = WS_SMALL;
constexpr size_t SM_PMETA = WS_SMALL + 64 * 1024;
constexpr size_t SM_TKE = WS_SMALL + 512 * 1024;
constexpr size_t SM_TKW = SM_TKE + 512 * 1024;
constexpr size_t SM_TKPOS = SM_TKW + 512 * 1024;
constexpr size_t SM_TKROW = SM_TKPOS + 512 * 1024;
constexpr size_t SM_ROWTOK = SM_TKROW + 512 * 1024;
constexpr size_t SM_ROWW = SM_ROWTOK + 1024 * 1024;
constexpr size_t SM_TILEE = SM_ROWW + 1024 * 1024;
constexpr int CW_CNT = 1024;

#define LAS __attribute__((address_space(3)))
#define GAS __attribute__((address_space(1)))
typedef short bf16x8 __attribute__((ext_vector_type(8)));
typedef float f32x4 __attribute__((ext_vector_type(4)));
typedef float f32x2 __attribute__((ext_vector_type(2)));
typedef unsigned u32x4 __attribute__((ext_vector_type(4)));
typedef unsigned u32x2 __attribute__((ext_vector_type(2)));
#define LDS_WAIT() asm volatile("s_waitcnt lgkmcnt(0)" ::: "memory")
#define VM_WAIT() asm volatile("s_waitcnt vmcnt(0)" ::: "memory")
typedef __bf16 bf16x2_t __attribute__((ext_vector_type(2)));
__device__ __forceinline__ unsigned pk2(float lo, float hi) { const f32x2 v = {lo, hi}; const bf16x2_t b = __builtin_convertvector(v, bf16x2_t); return __builtin_bit_cast(unsigned, b); }
__device__ __forceinline__ unsigned pk4_fp8(float a, float b, float c, float d) { int w = __builtin_amdgcn_cvt_pk_fp8_f32(a, b, 0, false); w = __builtin_amdgcn_cvt_pk_fp8_f32(c, d, w, true); return (unsigned)w; }
constexpr float W8_SCALE = 64.0f, W8_INV = 1.0f / 64.0f;
constexpr float ROW8_SCALE = 16.0f, ROW8_INV = 1.0f / 16.0f;
__device__ __forceinline__ float wave_sum(float v) {
#pragma unroll
    for (int o = 1; o < 64; o <<= 1) v += __shfl_xor(v, o);
    return v;
}

constexpr size_t WS_WIN = WS_W;
constexpr size_t WS_WAB = WS_W + 13 * MiB;
constexpr size_t WS_WRB = WS_W + 15 * MiB;
constexpr size_t WS_WOUT = WS_W + 17 * MiB;
constexpr size_t WS_WGU = WS_W + 19 * MiB;
constexpr size_t WS_WDN = WS_W + 147 * MiB;
static_assert(WS_WDN + 64 * MiB <= WS_XB, "weight map");
constexpr size_t SM_ATILE = SM_TILEE + 4096;
constexpr int CW_NACT = 1088;
constexpr int CW_BAR = 4096;

constexpr int RING_BYTES = 131072;
constexpr int MISC_OFF = RING_BYTES;
constexpr int LDS_BYTES = 147456;
constexpr int NWAVES = 8;

#define XB_TMO      128
#define XB_XCNT(j)  (256  + 64 * (j))
#define XB_XSUB(j)  (1280 + 64 * (j))
#define XB_XGEN(j)  (2304 + 64 * (j))
#define XB_TOP      3328
#define XB_TOPGEN   3392
#define XCD_BAR_WORDS 3456
#define XB_SPIN_CAP (1u << 20)
__device__ __forceinline__ unsigned xb_ld(unsigned* p)              { return __hip_atomic_load(p, __ATOMIC_RELAXED, __HIP_MEMORY_SCOPE_AGENT); }
__device__ __forceinline__ unsigned xb_add(unsigned* p, unsigned v) { return __hip_atomic_fetch_add(p, v, __ATOMIC_RELAXED, __HIP_MEMORY_SCOPE_AGENT); }
__device__ __forceinline__ unsigned xb_xcc_id() { return (unsigned)__builtin_amdgcn_s_getreg((3 << 11) | 20) & 0xFu; }
#define XB_SPIN(cond, bar) do { unsigned _sp = 0; while (cond) { __builtin_amdgcn_s_sleep(1); \
    if ((++_sp & 255u) == 0u) { if (xb_ld(&(bar)[XB_TMO])) break; if (_sp > XB_SPIN_CAP) { atomicAdd(&(bar)[XB_TMO], 1u); break; } } } } while (0)
struct XcdBarrier { unsigned* bar; unsigned x; volatile LAS unsigned* st; };
__device__ __forceinline__ XcdBarrier xcd_barrier_post(unsigned* bar, volatile LAS unsigned* st) {
    XcdBarrier b; b.bar = bar; b.x = xb_xcc_id(); b.st = st;
    if (threadIdx.x == 0) (void)xb_add(&bar[XB_XCNT(b.x)], 1u);
    return b;
}
__device__ __forceinline__ void xcd_barrier_complete(unsigned* bar, unsigned x, unsigned& nloc, unsigned& nx) {
    const unsigned G = gridDim.x * gridDim.y * gridDim.z;
    unsigned sum, cnt, mine, sp = 0u;
    for (;;) {
        sum = 0u; cnt = 0u; mine = 0u;
#pragma unroll
        for (unsigned j = 0; j < 16; ++j) { const unsigned c = xb_ld(&bar[XB_XCNT(j)]); sum += c; cnt += (c > 0u) ? 1u : 0u; mine = (j == x) ? c : mine; }
        if (sum == G) break;
        __builtin_amdgcn_s_sleep(1);
        if ((++sp & 255u) == 0u) { if (xb_ld(&bar[XB_TMO])) break; if (sp > XB_SPIN_CAP) { atomicAdd(&bar[XB_TMO], 1u); break; } }
    }
    nloc = mine > 0u ? mine : 1u; nx = cnt > 0u ? cnt : 1u;
}
__device__ __forceinline__ void xcd_barrier(const XcdBarrier& b) {
    asm volatile("s_waitcnt vmcnt(0)" ::: "memory");
    __syncthreads();
    if (threadIdx.x == 0) {
        unsigned* bar = b.bar;
        __builtin_amdgcn_s_waitcnt(0);
        unsigned nloc = b.st[0], nx = b.st[1];
        if (nloc == 0u) { xcd_barrier_complete(bar, b.x, nloc, nx); b.st[0] = nloc; b.st[1] = nx; }
        const unsigned old = xb_add(&bar[XB_XSUB(b.x)], 1u);
        const unsigned gen = old / nloc;
        if (old + 1u == (gen + 1u) * nloc) {
            __builtin_amdgcn_fence(__ATOMIC_RELEASE, "agent");
            asm volatile("s_waitcnt vmcnt(0)" ::: "memory");
            const unsigned og = xb_add(&bar[XB_TOP], 1u);
            const unsigned tg = og / nx;
            if (og + 1u == (tg + 1u) * nx) xb_add(&bar[XB_TOPGEN], 1u);
            else XB_SPIN(xb_ld(&bar[XB_TOPGEN]) == tg, bar);
            __builtin_amdgcn_fence(__ATOMIC_ACQUIRE, "agent");
            xb_add(&bar[XB_XGEN(b.x)], 1u);
            asm volatile("s_waitcnt vmcnt(0)" ::: "memory");
        } else {
            XB_SPIN(xb_ld(&bar[XB_XGEN(b.x)]) == gen, bar);
            __builtin_amdgcn_fence(__ATOMIC_ACQUIRE, "agent");
            asm volatile("s_waitcnt vmcnt(0)" ::: "memory");
        }
    }
    __syncthreads();
}

namespace pg8 {
constexpr int BM = 256, BK = 64, HALF = 128, HTB = HALF * BK * 2, STAGE_BYTES = 8 * HTB;
__host__ __device__ __forceinline__ int lds_byte(int r, int c) { const int st = (r >> 4) * 2 + (c >> 5), rr = r & 15, cc = c & 31, ob = rr * 64 + cc * 2; return st * 1024 + (ob ^ (((ob >> 9) & 1) << 5)); }
__host__ __device__ __forceinline__ void stage_rc(int b, int& R, int& C) { const int st = b / 1024, sb = b % 1024, swz = sb ^ (((sb >> 9) & 1) << 5); R = (st >> 1) * 16 + swz / 64; C = (st & 1) * 32 + (swz % 64) / 2; }
__host__ __device__ __forceinline__ int perm32(int rho) { const int n = rho >> 4, i = rho & 15; return 8 * (i >> 2) + 4 * n + (i & 3); }
struct Unit { int pm, pn, aux, tl; const char* A; const char* B; };
typedef f32x4 Acc[2][2][4][2];
typedef int u32x4_i __attribute__((ext_vector_type(4)));

typedef int v8i32 __attribute__((ext_vector_type(8)));
template <class Epi, class Sched, bool FP8 = false>
__device__ __forceinline__ void gemm_phase(LAS unsigned char* lds, const int Kb, const Sched& S, const Epi& E) {
    const int tid = threadIdx.x, wid = __builtin_amdgcn_readfirstlane(tid >> 6), lane = tid & 63, wr = wid >> 2, wc = wid & 3, fr = lane & 15, fq = lane >> 4;
    const int nt = Kb / 128;
    int RA[2], CA[2]; unsigned voffB[2];
#pragma unroll
    for (int i = 0; i < 2; ++i) { int R, C; stage_rc(tid * 16 + i * 8192, R, C); const int Rb = Epi::PERM ? ((R & ~31) + perm32(R & 31)) : R;
        RA[i] = R; CA[i] = C; voffB[i] = (unsigned)(Rb * Kb + C * 2); }
    const size_t kstep = (size_t)(BK * 2);
    const size_t hstep = (size_t)HALF * Kb;
    const unsigned ldsw = (unsigned)wid * 1024u;
    const int aoff = lds_byte(wr * 64 + fr, fq * 8), boff = lds_byte(wc * 32 + fr, fq * 8);
#define PG8_SA(b, h) (((b) * 2 + (h)) * HTB)
#define PG8_SB(b, h) ((4 + (b) * 2 + (h)) * HTB)
#define PG8_STAGE(bufoff, gbase, voff) do { _Pragma("unroll") for (int _i = 0; _i < 2; ++_i) \
        __builtin_amdgcn_global_load_lds((const unsigned*)((const char*)(gbase) + (voff)[_i]), (LAS unsigned*)(lds + (bufoff) + ldsw + _i * 8192), 16, 0, 0); } while (0)
#define PG8_LDA(dst, b, h) do { _Pragma("unroll") for (int m = 0; m < 4; ++m) _Pragma("unroll") for (int k = 0; k < 2; ++k) dst[m][k] = *(const LAS bf16x8*)(lds + PG8_SA(b, h) + aoff + m * 2048 + k * 1024); } while (0)
#define PG8_LDB(dst, b, h) do { _Pragma("unroll") for (int n = 0; n < 2; ++n) _Pragma("unroll") for (int k = 0; k < 2; ++k) dst[n][k] = *(const LAS bf16x8*)(lds + PG8_SB(b, h) + boff + n * 2048 + k * 1024); } while (0)
#define PG8_MMA(ai, bj, At, Bt) do { __builtin_amdgcn_s_setprio(1); _Pragma("unroll") for (int m = 0; m < 4; ++m) _Pragma("unroll") for (int n = 0; n < 2; ++n) { \
        if constexpr (FP8) { const v8i32 bq = __builtin_shufflevector(__builtin_bit_cast(u32x4_i, Bt[n][0]), __builtin_bit_cast(u32x4_i, Bt[n][1]), 0, 1, 2, 3, 4, 5, 6, 7), \
                                         aq = __builtin_shufflevector(__builtin_bit_cast(u32x4_i, At[m][0]), __builtin_bit_cast(u32x4_i, At[m][1]), 0, 1, 2, 3, 4, 5, 6, 7); \
            asm volatile("v_mfma_scale_f32_16x16x128_f8f6f4 %0, %1, %2, %0, %3, %3 op_sel_hi:[0,0,0]" : "+v"(acc[ai][bj][m][n]) : "v"(bq), "v"(aq), "v"(scale1)); } \
        else { _Pragma("unroll") for (int k = 0; k < 2; ++k) acc[ai][bj][m][n] = __builtin_amdgcn_mfma_f32_16x16x32_bf16(Bt[n][k], At[m][k], acc[ai][bj][m][n], 0, 0, 0); } } \
        __builtin_amdgcn_s_setprio(0); } while (0)
#define PG8_WAIT_V(n) asm volatile("s_waitcnt vmcnt(" #n ")" ::: "memory")
#define PG8_WAIT_L(n) asm volatile("s_waitcnt lgkmcnt(" #n ")" ::: "memory")
#define PG8_BAR __builtin_amdgcn_s_barrier()
#define PG8_SCHED __builtin_amdgcn_sched_barrier(0)
    int scale1 = 0x7f7f7f7f; asm volatile("" : "+v"(scale1));
    Unit cur, nxt; int ui = 0;
    if (!S.next(0, cur)) return;
    unsigned ca[2][2], na[2][2];
    S.aoff(cur, RA, CA, ca);
    f32x4 acc[2][2][4][2];
#pragma unroll
    for (int a = 0; a < 2; ++a)
#pragma unroll
        for (int b = 0; b < 2; ++b)
#pragma unroll
            for (int m = 0; m < 4; ++m)
#pragma unroll
                for (int n = 0; n < 2; ++n) acc[a][b][m][n] = (f32x4){0.f, 0.f, 0.f, 0.f};
    bf16x8 At[4][2], B0[2][2], B1[2][2];
    const char* cA = cur.A; const char* cB = cur.B;
    E.prefetch(cur, 0, wid, lane);
    PG8_STAGE(PG8_SB(0, 0), cB, voffB); PG8_STAGE(PG8_SB(0, 1), cB + hstep, voffB); PG8_STAGE(PG8_SA(0, 0), cA, ca[0]); PG8_STAGE(PG8_SA(0, 1), cA, ca[1]);
    if (wr == 1) PG8_BAR;
    PG8_WAIT_V(2); PG8_BAR;
    PG8_STAGE(PG8_SB(1, 0), cB + kstep, voffB); PG8_STAGE(PG8_SA(1, 0), cA + kstep, ca[0]); PG8_STAGE(PG8_SB(1, 1), cB + hstep + kstep, voffB);
    PG8_WAIT_V(6); PG8_BAR;
    for (;;) {
        const bool has_next = S.next(ui + 1, nxt);
        if constexpr (Sched::GATHER) {
            if (has_next) S.aoff(nxt, RA, CA, na);
            else {
#pragma unroll
                for (int h = 0; h < 2; ++h)
#pragma unroll
                    for (int i = 0; i < 2; ++i) na[h][i] = ca[h][i];
            }
        }
        const char* nA = has_next ? nxt.A : cA; const char* nB = has_next ? nxt.B : cB;
#pragma nounroll
        for (int t = 0; t < nt; t += 2) {
            const bool last = (t == nt - 2);
            const char* a1 = cA + (size_t)(t + 1) * kstep;
            const char* a2 = last ? nA : cA + (size_t)(t + 2) * kstep; const char* b2 = last ? nB : cB + (size_t)(t + 2) * kstep;
            const char* a3 = a2 + kstep; const char* b3 = b2 + kstep;
            unsigned o2[2][2];
#pragma unroll
            for (int h = 0; h < 2; ++h)
#pragma unroll
                for (int i = 0; i < 2; ++i) { if constexpr (Sched::GATHER) o2[h][i] = last ? na[h][i] : ca[h][i]; else o2[h][i] = ca[h][i]; }
            PG8_LDB(B0, 0, 0); PG8_LDB(B1, 0, 1); PG8_SCHED; PG8_LDA(At, 0, 0); PG8_STAGE(PG8_SA(1, 1), a1, ca[1]);
            PG8_WAIT_V(8); PG8_WAIT_L(0); PG8_BAR; PG8_MMA(0, 0, At, B0); PG8_MMA(0, 1, At, B1); PG8_BAR; PG8_SCHED;
            PG8_LDA(At, 0, 1); PG8_STAGE(PG8_SB(0, 0), b2, voffB); PG8_STAGE(PG8_SB(0, 1), b2 + hstep, voffB); PG8_STAGE(PG8_SA(0, 0), a2, o2[0]);
            PG8_WAIT_V(8); PG8_WAIT_L(0); PG8_BAR; PG8_MMA(1, 0, At, B0); PG8_MMA(1, 1, At, B1); PG8_BAR; PG8_SCHED;
            PG8_LDB(B0, 1, 0); PG8_LDB(B1, 1, 1); PG8_SCHED; PG8_LDA(At, 1, 0); PG8_STAGE(PG8_SA(0, 1), a2, o2[1]);
            PG8_WAIT_V(8); PG8_WAIT_L(0); PG8_BAR; PG8_MMA(0, 0, At, B0); PG8_MMA(0, 1, At, B1); PG8_BAR; PG8_SCHED;
            PG8_LDA(At, 1, 1); PG8_STAGE(PG8_SB(1, 0), b3, voffB); PG8_STAGE(PG8_SB(1, 1), b3 + hstep, voffB); PG8_STAGE(PG8_SA(1, 0), a3, o2[0]);
            PG8_WAIT_V(8); PG8_WAIT_L(0); PG8_BAR; PG8_MMA(1, 0, At, B0); PG8_MMA(1, 1, At, B1); PG8_BAR; PG8_SCHED;
        }
        if constexpr (FP8) { asm volatile("s_nop 15\n\ts_nop 15\n\ts_nop 15" ::: "memory"); PG8_SCHED; }
        if (wr == 0) PG8_BAR;
        { int fr_ = fr, fq_ = fq; asm volatile("" : "+v"(fr_), "+v"(fq_));
          E(acc, cur, wr, wc, fr_, fq_, ui & 1); }
        if (!has_next) break;
#pragma unroll
        for (int a = 0; a < 2; ++a)
#pragma unroll
            for (int b = 0; b < 2; ++b)
#pragma unroll
                for (int m = 0; m < 4; ++m)
#pragma unroll
                    for (int n = 0; n < 2; ++n) acc[a][b][m][n] = (f32x4){0.f, 0.f, 0.f, 0.f};
        cur = nxt; cA = nA; cB = nB; ++ui;
        E.prefetch(cur, ui & 1, wid, lane);
        if constexpr (Sched::GATHER) {
#pragma unroll
            for (int h = 0; h < 2; ++h)
#pragma unroll
                for (int i = 0; i < 2; ++i) ca[h][i] = na[h][i];
        }
        if (wr == 1) PG8_BAR;
    }
    PG8_WAIT_V(0);
    PG8_BAR;
#undef PG8_SA
#undef PG8_SB
#undef PG8_STAGE
#undef PG8_LDA
#undef PG8_LDB
#undef PG8_MMA
#undef PG8_WAIT_V
#undef PG8_WAIT_L
#undef PG8_BAR
#undef PG8_SCHED
}
}
#ifndef PROBE_PHASE
#define PROBE_PHASE (-1)
#endif
constexpr size_t SM_LIST = WS_SMALL + 2 * MiB;
constexpr size_t SM_WLIST = WS_SMALL + 6 * MiB;
constexpr size_t SM_RLIST = WS_SMALL + 10 * MiB;
constexpr int MT_PSTART = 256;
constexpr int MT_CNT = 512;
constexpr int MT_NACT = 768;
constexpr int MT_ATILE = 1024;
constexpr int MT_HIST = 4096;
constexpr int MT_BASE = 4224;
constexpr int MT_REC = 4352;
constexpr int MT_RSTD = 10496;
constexpr int MT_EPI = 11264;
constexpr int MT_EPI2 = 13312;
constexpr int MT_GAIN = 15360;

__device__ __forceinline__ void moe_tables(LAS unsigned char* misc, const unsigned* cnt) {
    LAS int* pstart = (LAS int*)(misc + MT_PSTART); LAS int* cl = (LAS int*)(misc + MT_CNT); LAS int* at = (LAS int*)(misc + MT_ATILE);
    __syncthreads();
    if (threadIdx.x < 64) {
        const int lane = threadIdx.x, e = lane & 31;
        const int c = (int)__hip_atomic_load(cnt + e, __ATOMIC_RELAXED, __HIP_MEMORY_SCOPE_AGENT), nt = (c + 255) >> 8;
        int incl = nt;
#pragma unroll
        for (int o = 1; o < 32; o <<= 1) { const int v = __shfl_up(incl, o); if (e >= o) incl += v; }
        const int t0 = incl - nt;
        if (lane < 32) { cl[e] = c; pstart[e] = t0 << 8; for (int t = 0; t < nt; ++t) at[t0 + t] = (t0 + t) | (e << 12) | (t << 20);
            if (e == 31) { pstart[NE] = incl << 8; *(LAS int*)(misc + MT_NACT) = incl; } }
    }
    __syncthreads();
}

__device__ __forceinline__ void route_phase(LAS unsigned char* lds, const float* __restrict__ h2, const float* __restrict__ g2, const float* __restrict__ wr, const float* __restrict__ br,
                                            unsigned char* __restrict__ xg8, int* __restrict__ tke, int* __restrict__ tkpos, float* __restrict__ tkw, int* __restrict__ list, float* __restrict__ wlist,
                                            float* __restrict__ rlist, unsigned* __restrict__ cnt, int G, int bx) {
    typedef float f32x16 __attribute__((ext_vector_type(16)));
    const int tid = threadIdx.x, lane = tid & 63, r32 = lane & 31, hi = lane >> 5; const int wave = __builtin_amdgcn_readfirstlane(tid >> 6);
    LAS unsigned char* misc = lds + MISC_OFF;
    LAS int* hist = (LAS int*)(misc + MT_HIST); LAS int* base = (LAS int*)(misc + MT_BASE); LAS int* rec = (LAS int*)(misc + MT_REC); LAS float* rstd_l = (LAS float*)(misc + MT_RSTD);
    for (int idx = tid; idx < 128 * 32; idx += 512) {
        const int c = idx >> 5, e = idx & 31; float v[8]; unsigned hw[4], lw[4];
#pragma unroll
        for (int j = 0; j < 8; ++j) v[j] = wr[(size_t)(8 * c + j) * NE + e] * g2[8 * c + j];
#pragma unroll
        for (int j = 0; j < 4; ++j) { hw[j] = pk2(v[2 * j], v[2 * j + 1]); lw[j] = pk2(v[2 * j] - __uint_as_float(hw[j] << 16), v[2 * j + 1] - __uint_as_float(hw[j] & 0xffff0000u)); }
        *(LAS u32x4*)(lds + idx * 16) = (u32x4){hw[0], hw[1], hw[2], hw[3]};
        *(LAS u32x4*)(lds + 65536 + idx * 16) = (u32x4){lw[0], lw[1], lw[2], lw[3]};
    }
    __syncthreads();
    const int tile = wave & 3;
    for (int tb = bx; tb < NTOK / 128; tb += G) {
        if (tid < 32) hist[tid] = 0;
        __syncthreads();
        for (int rep_ = 0; rep_ < ((PROBE_PHASE == 6) ? 2 : 1); ++rep_)
        if (wave < 4) {
        const int token = tb * 128 + tile * 32 + r32;
        const float* xp = h2 + (size_t)token * D + 8 * hi;
        unsigned char* x8p = xg8 + (size_t)token * D + 8 * hi;
        const float* gp = g2 + 8 * hi;
        f32x16 c = {};
        float ss = 0.f;
        f32x4 xa[8][2];
#pragma unroll
        for (int p = 0; p < 8; ++p) { xa[p][0] = *(const f32x4*)(xp + 16 * p); xa[p][1] = *(const f32x4*)(xp + 16 * p + 4); }
#pragma unroll 1
        for (int ks0 = 0; ks0 < 64; ks0 += 8) {
#pragma unroll
            for (int p = 0; p < 8; ++p) {
                const int ks = ks0 + p;
                const f32x4 x0 = xa[p][0], x1 = xa[p][1];
                if (ks + 8 < 64) { xa[p][0] = *(const f32x4*)(xp + 16 * (ks + 8)); xa[p][1] = *(const f32x4*)(xp + 16 * (ks + 8) + 4); }
                ss += (x0[0] * x0[0] + x0[1] * x0[1]) + (x0[2] * x0[2] + x0[3] * x0[3]) + (x1[0] * x1[0] + x1[1] * x1[1]) + (x1[2] * x1[2] + x1[3] * x1[3]);
                { const f32x4 g0 = *(const f32x4*)(gp + 16 * ks), g1 = *(const f32x4*)(gp + 16 * ks + 4);
                  u32x2 w8; w8.x = pk4_fp8(x0[0] * g0[0], x0[1] * g0[1], x0[2] * g0[2], x0[3] * g0[3]); w8.y = pk4_fp8(x1[0] * g1[0], x1[1] * g1[1], x1[2] * g1[2], x1[3] * g1[3]);
                  *(u32x2*)(x8p + 16 * ks) = w8; }
                u32x4 xh, xl;
                xh.x = pk2(x0[0], x0[1]); xh.y = pk2(x0[2], x0[3]); xh.z = pk2(x1[0], x1[1]); xh.w = pk2(x1[2], x1[3]);
                xl.x = pk2(x0[0] - __uint_as_float(xh.x << 16), x0[1] - __uint_as_float(xh.x & 0xffff0000u)); xl.y = pk2(x0[2] - __uint_as_float(xh.y << 16), x0[3] - __uint_as_float(xh.y & 0xffff0000u));
                xl.z = pk2(x1[0] - __uint_as_float(xh.z << 16), x1[1] - __uint_as_float(xh.z & 0xffff0000u)); xl.w = pk2(x1[2] - __uint_as_float(xh.w << 16), x1[3] - __uint_as_float(xh.w & 0xffff0000u));
                const int chunk = 2 * ks + hi;
                const bf16x8 wh = *(const LAS bf16x8*)(lds + (chunk * 32 + r32) * 16), wl = *(const LAS bf16x8*)(lds + 65536 + (chunk * 32 + r32) * 16);
                c = __builtin_amdgcn_mfma_f32_32x32x16_bf16(wh, __builtin_bit_cast(bf16x8, xh), c, 0, 0, 0);
                c = __builtin_amdgcn_mfma_f32_32x32x16_bf16(wl, __builtin_bit_cast(bf16x8, xh), c, 0, 0, 0);
                c = __builtin_amdgcn_mfma_f32_32x32x16_bf16(wh, __builtin_bit_cast(bf16x8, xl), c, 0, 0, 0);
            }
        }
        {
            ss += __shfl_xor(ss, 32);
            const float rstd = rsqrtf(ss * (1.0f / D) + EPS);
            float vals[16];
#pragma unroll
            for (int r = 0; r < 16; ++r) vals[r] = c[r] * rstd + br[(r & 3) + 8 * (r >> 2) + 4 * hi];
            float tv[4]; int te[4];
#pragma unroll
            for (int k = 0; k < 4; ++k) {
                float m = -3.0e38f; int mi = 0;
#pragma unroll
                for (int r = 0; r < 16; ++r) { const bool gt = vals[r] > m; m = gt ? vals[r] : m; mi = gt ? r : mi; }
                tv[k] = m; te[k] = (mi & 3) + 8 * (mi >> 2) + 4 * hi;
#pragma unroll
                for (int r = 0; r < 16; ++r) vals[r] = (r == mi) ? -3.0e38f : vals[r];
            }
            float cv[8]; int ce[8];
#pragma unroll
            for (int k = 0; k < 4; ++k) { cv[k] = tv[k]; ce[k] = te[k]; cv[4 + k] = __shfl_xor(tv[k], 32); ce[4 + k] = __shfl_xor(te[k], 32); }
            float fv[4]; int fe[4];
#pragma unroll
            for (int k = 0; k < 4; ++k) {
                float m = -3.0e38f; int me = 64; int mi = 0;
#pragma unroll
                for (int q = 0; q < 8; ++q) { const bool better = (cv[q] > m) || (cv[q] == m && ce[q] < me); m = better ? cv[q] : m; me = better ? ce[q] : me; mi = better ? q : mi; }
                fv[k] = m; fe[k] = me;
#pragma unroll
                for (int q = 0; q < 8; ++q) cv[q] = (q == mi) ? -3.0e38f : cv[q];
            }
            if (hi == 0 && (PROBE_PHASE != 6 || rep_ == 1)) {
                const float e0 = 1.0f, e1 = __expf(fv[1] - fv[0]), e2 = __expf(fv[2] - fv[0]), e3 = __expf(fv[3] - fv[0]);
                const float inv = 1.0f / (e0 + e1 + e2 + e3);
                const float wts[4] = {e0 * inv, e1 * inv, e2 * inv, e3 * inv};
                const int tl = tile * 32 + r32;
                rstd_l[tl] = rstd;
#pragma unroll
                for (int k = 0; k < 4; ++k) {
                    const int lp = __hip_atomic_fetch_add(hist + fe[k], 1, __ATOMIC_RELAXED, __HIP_MEMORY_SCOPE_WORKGROUP);
                    LAS int* r = rec + (tl * 4 + k) * 3; r[0] = fe[k]; r[1] = lp; r[2] = __float_as_int(wts[k]);
                }
            }
        }
        }
        __syncthreads();
        if (tid < 32) base[tid] = (int)atomicAdd(&cnt[tid], (unsigned)hist[tid]);
        __syncthreads();
        { const int tl = tid >> 2; const int tok = tb * 128 + tl; LAS int* r = rec + tid * 3; const int e = r[0], pos = base[e] + r[1]; const float w = __int_as_float(r[2]);
          tke[tok * 4 + (tid & 3)] = e; tkpos[tok * 4 + (tid & 3)] = pos; tkw[tok * 4 + (tid & 3)] = w;
          list[e * NTOK + pos] = tok; wlist[e * NTOK + pos] = w; rlist[e * NTOK + pos] = rstd_l[tl]; }
        __syncthreads();
    }
}

__device__ __forceinline__ void combine_phase(LAS unsigned char* misc, void* scratch_out, float* __restrict__ out, const unsigned char* __restrict__ rows, const int* __restrict__ tke, const int* __restrict__ tkpos, int gw, int NGW, int lane) {
    LAS const int* pstart = (LAS const int*)(misc + MT_PSTART);
    for (int rep_ = 0; rep_ < ((PROBE_PHASE == 9) ? 2 : 1); ++rep_)
    for (int token = gw; token < NTOK; token += NGW) {
        int rr[4];
#pragma unroll
        for (int k = 0; k < 4; ++k) rr[k] = pstart[tke[token * 4 + k]] + tkpos[token * 4 + k];
        f32x4* o = (f32x4*)(out + (size_t)token * D) + lane;
        f32x4 v[4], s[4];
#pragma unroll
        for (int j = 0; j < 4; ++j) { v[j] = __builtin_nontemporal_load(o + 64 * j); s[j] = (f32x4){0.f, 0.f, 0.f, 0.f}; }
#pragma unroll
        for (int k = 0; k < 4; ++k) {
            const unsigned* rp = (const unsigned*)(rows + (size_t)rr[k] * D) + lane;
#pragma unroll
            for (int j = 0; j < 4; ++j) { const unsigned w = __builtin_nontemporal_load(rp + 64 * j);
                const f32x2 lo = __builtin_amdgcn_cvt_pk_f32_fp8((int)w, false), hh = __builtin_amdgcn_cvt_pk_f32_fp8((int)w, true);
                s[j][0] += lo[0]; s[j][1] += lo[1]; s[j][2] += hh[0]; s[j][3] += hh[1]; }
        }
#pragma unroll
        for (int j = 0; j < 4; ++j) v[j] = v[j] + s[j] * ROW8_INV;
        if (PROBE_PHASE == 9 && rep_ == 0) {
#pragma unroll
            for (int j = 0; j < 4; ++j) { asm volatile("" :: "v"(v[j])); *(f32x4*)((float*)scratch_out + (size_t)token * D + (64 * j + lane) * 4) = v[j]; }
        } else {
#pragma unroll
        for (int j = 0; j < 4; ++j) __builtin_nontemporal_store(v[j], o + 64 * j);
        }
    }
}
struct SchedDense {
    static constexpr bool GATHER = false;
    const char* A; const char* Bt; int K, nM, nN, nwg, G, c;
    __device__ void init(const bf16* A_, const bf16* Bt_, int M, int N, int K_, int G_, int c_) { A = (const char*)A_; Bt = (const char*)Bt_; K = K_; nM = M / 256; nN = N / 256; nwg = nM * nN; G = G_; c = c_; }
    __device__ __forceinline__ bool next(int i, pg8::Unit& u) const {
        const long L = (long)i * G + c; if (L >= nwg) return false;
        int wgid = (int)L; { const int q = nwg / 8, r = nwg % 8, xcd = wgid % 8, off = wgid / 8; wgid = (xcd < r ? xcd * (q + 1) : r * (q + 1) + (xcd - r) * q) + off; }
        const int nig = 8 * nN, gid = wgid / nig, fm = gid * 8, gsz = (nM - fm) < 8 ? (nM - fm) : 8;
        u.pm = fm + ((wgid % nig) % gsz); u.pn = (wgid % nig) / gsz; u.aux = 0; u.tl = 0;
        u.A = A + (size_t)u.pm * 256 * K * 2; u.B = Bt + (size_t)u.pn * 256 * K * 2; return true;
    }
    __device__ __forceinline__ void aoff(const pg8::Unit&, const int (&R)[2], const int (&C)[2], unsigned (&o)[2][2]) const {
#pragma unroll
        for (int h = 0; h < 2; ++h)
#pragma unroll
            for (int i = 0; i < 2; ++i) o[h][i] = (unsigned)((128 * h + R[i]) * K + C[i]) * 2u;
    }
};
struct SchedBranch {
    static constexpr bool GATHER = false;
    const char* A0; const char* A1; const char* B0; const char* B1; int G, c;
    __device__ __forceinline__ bool next(int i, pg8::Unit& u) const {
        const int L = (i >> 1) * G + c; if (L >= 512) return false;
        int wgid = L; { const int off = wgid / 8, xcd = wgid % 8; wgid = xcd * 64 + off; }
        const int nig = 8 * 4, gid = wgid / nig;
        u.pm = gid * 8 + ((wgid % nig) % 8); u.pn = (wgid % nig) / 8; u.aux = i & 1; u.tl = 0;
        u.A = ((i & 1) ? A1 : A0) + (size_t)u.pm * 256 * D * 2; u.B = ((i & 1) ? B1 : B0) + (size_t)u.pn * 256 * D * 2; return true;
    }
    __device__ __forceinline__ void aoff(const pg8::Unit&, const int (&R)[2], const int (&C)[2], unsigned (&o)[2][2]) const {
#pragma unroll
        for (int h = 0; h < 2; ++h)
#pragma unroll
            for (int i = 0; i < 2; ++i) o[h][i] = (unsigned)((128 * h + R[i]) * D + C[i]) * 2u;
    }
};
template <bool GATHER_, int NPN>
struct SchedMoe {
    static constexpr bool GATHER = GATHER_;
    const char* A; const char* Bt; LAS const unsigned char* misc; const int* list; int G, c;
    __device__ __forceinline__ bool next(int i, pg8::Unit& u) const {
        LAS const int* cl = (LAS const int*)(misc + MT_CNT); LAS const int* ps = (LAS const int*)(misc + MT_PSTART);
        if ((G & 7) == 0) {
            const int x = c & 7, r = c >> 3, n = G >> 3;
            int k = (i * n + r) / NPN; const int pn = (i * n + r) % NPN;
#pragma unroll
            for (int j = 0; j < 4; ++j) { const int e = x + 8 * j, nt = (cl[e] + 255) >> 8;
                if (k < nt) { u.pn = pn; u.aux = e; u.tl = k; u.pm = (ps[e] >> 8) + k;
                    u.A = GATHER ? A : A + (size_t)u.pm * 256 * 1024; u.B = Bt + ((size_t)e * NPN + pn) * 256 * 1024; return true; }
                k -= nt; }
            return false;
        }
        const int nact = *(LAS const int*)(misc + MT_NACT);
        const int L = i * G + c; if (L >= nact * NPN) return false;
        const int k = L / NPN; u.pn = L % NPN; const int w = ((LAS const int*)(misc + MT_ATILE))[k];
        u.pm = w & 0xfff; u.aux = (w >> 12) & 0xff; u.tl = w >> 20;
        u.A = GATHER ? A : A + (size_t)u.pm * 256 * 1024;
        u.B = Bt + ((size_t)u.aux * NPN + u.pn) * 256 * 1024; return true;
    }
    __device__ __forceinline__ void aoff(const pg8::Unit& u, const int (&R)[2], const int (&C)[2], unsigned (&o)[2][2]) const {
        const int ce = ((LAS const int*)(misc + MT_CNT))[u.aux];
#pragma unroll
        for (int h = 0; h < 2; ++h)
#pragma unroll
            for (int i = 0; i < 2; ++i) {
                if (GATHER) { const int idx = u.tl * 256 + 128 * h + R[i]; const int tok = (idx < ce) ? list[u.aux * NTOK + idx] : 0; o[h][i] = (unsigned)tok * 1024u + (unsigned)C[i] * 2u; }
                else o[h][i] = (unsigned)((128 * h + R[i]) * 1024 + C[i] * 2);
            }
    }
};

__device__ __forceinline__ u32x4 pack8(const f32x4& a, const f32x4& b) { u32x4 w; w.x = pk2(a[0], a[1]); w.y = pk2(a[2], a[3]); w.z = pk2(b[0], b[1]); w.w = pk2(b[2], b[3]); return w; }
__device__ __forceinline__ void unpack8(const u32x4& w, float (&f)[8]) {
    f[0] = __uint_as_float(w.x << 16); f[1] = __uint_as_float(w.x & 0xffff0000u); f[2] = __uint_as_float(w.y << 16); f[3] = __uint_as_float(w.y & 0xffff0000u);
    f[4] = __uint_as_float(w.z << 16); f[5] = __uint_as_float(w.z & 0xffff0000u); f[6] = __uint_as_float(w.w << 16); f[7] = __uint_as_float(w.w & 0xffff0000u);
}
struct EpiProj {
    static constexpr bool PERM = true;
    __device__ __forceinline__ void prefetch(const pg8::Unit&, int, int, int) const {}
    bf16* proj; LAS const float* gtab;
    __device__ __forceinline__ void operator()(pg8::Acc& acc, const pg8::Unit& u, int wr, int wc, int fr, int fq, int slot) const {
        const int pn = u.pn;
        int mode;
        if (pn < 4) mode = 1; else if (pn == 4) mode = (wc < 2) ? 2 : 0; else if (pn < 7) mode = 0; else if (pn < 9) mode = 3; else if (pn < 13) mode = 0; else if (pn < 17) mode = 4; else mode = 5;
        float gn[2][8];
        if (mode == 1 || mode == 2) { LAS const float* g = gtab + ((mode == 1) ? 0 : 64);
#pragma unroll
            for (int bj = 0; bj < 2; ++bj)
#pragma unroll
                for (int j = 0; j < 8; ++j) gn[bj][j] = g[32 * bj + 8 * fq + j]; }
#pragma unroll
        for (int ai = 0; ai < 2; ++ai)
#pragma unroll
            for (int m = 0; m < 4; ++m) {
                const int r = u.pm * 256 + ai * 128 + wr * 64 + m * 16 + fr;
                bf16* rowp = proj + (size_t)r * INW + pn * 256 + wc * 64 + 8 * fq;
                f32x4 v[2][2];
#pragma unroll
                for (int bj = 0; bj < 2; ++bj) { v[bj][0] = acc[ai][bj][m][0]; v[bj][1] = acc[ai][bj][m][1]; }
                if (mode == 1 || mode == 2) {
                    float ss = 0.f;
#pragma unroll
                    for (int bj = 0; bj < 2; ++bj)
#pragma unroll
                        for (int n = 0; n < 2; ++n) ss += v[bj][n][0] * v[bj][n][0] + v[bj][n][1] * v[bj][n][1] + v[bj][n][2] * v[bj][n][2] + v[bj][n][3] * v[bj][n][3];
                    ss += __shfl_xor(ss, 16); ss += __shfl_xor(ss, 32);
                    const float rs = rsqrtf(ss * (1.0f / 64.0f) + EPS);
#pragma unroll
                    for (int bj = 0; bj < 2; ++bj)
#pragma unroll
                        for (int n = 0; n < 2; ++n)
#pragma unroll
                            for (int i = 0; i < 4; ++i) v[bj][n][i] = v[bj][n][i] * rs * gn[bj][4 * n + i];
                } else if (mode == 3) {
#pragma unroll
                    for (int bj = 0; bj < 2; ++bj)
#pragma unroll
                        for (int n = 0; n < 2; ++n) v[bj][n] = v[bj][n] * 0.08838834764831845f;
                } else if (mode == 4) {
#pragma unroll
                    for (int bj = 0; bj < 2; ++bj)
#pragma unroll
                        for (int n = 0; n < 2; ++n)
#pragma unroll
                            for (int i = 0; i < 4; ++i) { const float x = v[bj][n][i]; v[bj][n][i] = x * sigmoidf_(x); }
                } else if (mode == 5) {
#pragma unroll
                    for (int bj = 0; bj < 2; ++bj)
#pragma unroll
                        for (int n = 0; n < 2; ++n)
#pragma unroll
                            for (int i = 0; i < 4; ++i) v[bj][n][i] = sigmoidf_(v[bj][n][i]);
                }
#pragma unroll
                for (int bj = 0; bj < 2; ++bj) *(u32x4*)(rowp + 32 * bj) = pack8(v[bj][0], v[bj][1]);
            }
    }
};
struct EpiBranch {
    static constexpr bool PERM = true;
    __device__ __forceinline__ void prefetch(const pg8::Unit&, int, int, int) const {}
    bf16* merged; const bf16* proj;
    __device__ __forceinline__ void load(u32x4 (&gw)[2][2], u32x4 (&pw)[2][2], const pg8::Unit& u, int q, int wr, int wc, int fr, int fq, int gcol) const {
#pragma unroll
        for (int mm = 0; mm < 2; ++mm)
#pragma unroll
            for (int bj = 0; bj < 2; ++bj) {
                const int r = u.pm * 256 + (q >> 1) * 128 + wr * 64 + (2 * (q & 1) + mm) * 16 + fr, col = u.pn * 256 + bj * 128 + wc * 32 + 8 * fq;
                gw[mm][bj] = *(const u32x4*)(proj + (size_t)r * INW + gcol + col);
                if (u.aux) pw[mm][bj] = *(const u32x4*)(merged + (size_t)r * D + col);
            }
    }
    __device__ __forceinline__ void operator()(pg8::Acc& acc, const pg8::Unit& u, int wr, int wc, int fr, int fq, int slot) const {
        const int gcol = u.aux ? C_GR : C_GA;
        u32x4 gA[2][2], pA[2][2], gB[2][2], pB[2][2];
        load(gA, pA, u, 0, wr, wc, fr, fq, gcol);
#pragma unroll
        for (int q = 0; q < 4; ++q) {
            if (q < 3) { if (q & 1) load(gA, pA, u, q + 1, wr, wc, fr, fq, gcol); else load(gB, pB, u, q + 1, wr, wc, fr, fq, gcol); }
            const int ai = q >> 1;
#pragma unroll
            for (int mm = 0; mm < 2; ++mm)
#pragma unroll
                for (int bj = 0; bj < 2; ++bj) {
                    const int m = 2 * (q & 1) + mm;
                    const int r = u.pm * 256 + ai * 128 + wr * 64 + m * 16 + fr, col = u.pn * 256 + bj * 128 + wc * 32 + 8 * fq;
                    float g[8]; unpack8((q & 1) ? gB[mm][bj] : gA[mm][bj], g);
                    f32x4 a = acc[ai][bj][m][0], b = acc[ai][bj][m][1];
                    a[0] *= g[0]; a[1] *= g[1]; a[2] *= g[2]; a[3] *= g[3]; b[0] *= g[4]; b[1] *= g[5]; b[2] *= g[6]; b[3] *= g[7];
                    if (u.aux) { float p[8]; unpack8((q & 1) ? pB[mm][bj] : pA[mm][bj], p);
                        a[0] += p[0]; a[1] += p[1]; a[2] += p[2]; a[3] += p[3]; b[0] += p[4]; b[1] += p[5]; b[2] += p[6]; b[3] += p[7]; }
                    *(u32x4*)(merged + (size_t)r * D + col) = pack8(a, b);
                }
        }
    }
};
struct EpiOut {
    static constexpr bool PERM = false;
    __device__ __forceinline__ void prefetch(const pg8::Unit&, int, int, int) const {}
    const float* x; float* out;
    __device__ __forceinline__ void load(f32x4 (&xv)[2][2][2], const pg8::Unit& u, int q, int wr, int wc, int fr, int fq) const {
#pragma unroll
        for (int mm = 0; mm < 2; ++mm) { const size_t off = (size_t)(u.pm * 256 + (q >> 1) * 128 + wr * 64 + (2 * (q & 1) + mm) * 16 + fr) * D + u.pn * 256 + wc * 32 + 4 * fq;
#pragma unroll
            for (int bj = 0; bj < 2; ++bj)
#pragma unroll
                for (int n = 0; n < 2; ++n) xv[mm][bj][n] = *(const f32x4*)(x + off + bj * 128 + n * 16); }
    }
    __device__ __forceinline__ void operator()(pg8::Acc& acc, const pg8::Unit& u, int wr, int wc, int fr, int fq, int slot) const {
        f32x4 xA[2][2][2], xB[2][2][2];
        load(xA, u, 0, wr, wc, fr, fq);
#pragma unroll
        for (int q = 0; q < 4; ++q) {
            if (q < 3) { if (q & 1) load(xA, u, q + 1, wr, wc, fr, fq); else load(xB, u, q + 1, wr, wc, fr, fq); }
            const int ai = q >> 1;
#pragma unroll
            for (int mm = 0; mm < 2; ++mm) { const int m = 2 * (q & 1) + mm; const size_t off = (size_t)(u.pm * 256 + ai * 128 + wr * 64 + m * 16 + fr) * D + u.pn * 256 + wc * 32 + 4 * fq;
#pragma unroll
                for (int bj = 0; bj < 2; ++bj)
#pragma unroll
                    for (int n = 0; n < 2; ++n) *(f32x4*)(out + off + bj * 128 + n * 16) = ((q & 1) ? xB[mm][bj][n] : xA[mm][bj][n]) + acc[ai][bj][m][n]; }
        }
    }
};
struct EpiGU {
    static constexpr bool PERM = true;
    unsigned char* act; const float* bgu; const float* rlist; LAS unsigned char* misc;
    __device__ __forceinline__ void prefetch(const pg8::Unit& u, int slot, int wid, int lane) const {
        if (wid < 4) __builtin_amdgcn_global_load_lds((const unsigned*)(rlist + (size_t)u.aux * NTOK + u.tl * 256 + wid * 64 + lane), (LAS unsigned*)(misc + MT_EPI + slot * 1024 + wid * 256), 4, 0, 0);
        else __builtin_amdgcn_global_load_lds((const unsigned*)(bgu + (size_t)u.aux * 2048 + ((wid - 4) >> 1) * 1024 + u.pn * 128 + ((wid - 4) & 1) * 64 + lane), (LAS unsigned*)(misc + MT_EPI2 + slot * 1024 + (wid - 4) * 256), 4, 0, 0);
    }
    __device__ __forceinline__ void operator()(pg8::Acc& acc, const pg8::Unit& u, int wr, int wc, int fr, int fq, int slot) const {
        const int ce = ((LAS const int*)(misc + MT_CNT))[u.aux];
        const int col = u.pn * 128 + wc * 32 + 8 * fq;
        LAS const float* bl = (LAS const float*)(misc + MT_EPI2 + slot * 1024) + wc * 32 + 8 * fq;
        float bgate[8], bup[8];
#pragma unroll
        for (int j = 0; j < 8; ++j) { bgate[j] = bl[j]; bup[j] = bl[128 + j]; }
#pragma unroll
        for (int ai = 0; ai < 2; ++ai)
#pragma unroll
            for (int m = 0; m < 4; ++m) {
                const int lr = ai * 128 + wr * 64 + m * 16 + fr, r = u.pm * 256 + lr;
                const float rs = ((LAS const float*)(misc + MT_EPI + slot * 1024))[lr] * W8_INV;
                float o[8];
#pragma unroll
                for (int n = 0; n < 2; ++n)
#pragma unroll
                    for (int i = 0; i < 4; ++i) {
                        float gate = acc[ai][0][m][n][i] * rs + bgate[4 * n + i], up = acc[ai][1][m][n][i] * rs + bup[4 * n + i];
                        gate = fminf(gate, 7.0f); up = fminf(fmaxf(up, -7.0f), 7.0f);
                        o[4 * n + i] = (up + 1.0f) * gate * sigmoidf_(1.702f * gate);
                    }
                u32x2 w; w.x = pk4_fp8(o[0], o[1], o[2], o[3]); w.y = pk4_fp8(o[4], o[5], o[6], o[7]);
                *(u32x2*)(act + (size_t)r * DFF + col) = w;
            }
    }
};
struct EpiDown {
    static constexpr bool PERM = true;
    unsigned char* rows; const float* bdn; const float* wlist; LAS const unsigned char* misc;
    __device__ __forceinline__ void prefetch(const pg8::Unit& u, int slot, int wid, int lane) const {
        if (wid < 4) __builtin_amdgcn_global_load_lds((const unsigned*)(wlist + (size_t)u.aux * NTOK + u.tl * 256 + wid * 64 + lane), (LAS unsigned*)(misc + MT_EPI + slot * 1024 + wid * 256), 4, 0, 0);
        else __builtin_amdgcn_global_load_lds((const unsigned*)(bdn + (size_t)u.aux * D + u.pn * 256 + (wid - 4) * 64 + lane), (LAS unsigned*)(misc + MT_EPI2 + slot * 1024 + (wid - 4) * 256), 4, 0, 0);
    }
    __device__ __forceinline__ void operator()(pg8::Acc& acc, const pg8::Unit& u, int wr, int wc, int fr, int fq, int slot) const {
        const int ce = ((LAS const int*)(misc + MT_CNT))[u.aux];
#pragma unroll
        for (int ai = 0; ai < 2; ++ai)
#pragma unroll
            for (int m = 0; m < 4; ++m) {
                const int lr = ai * 128 + wr * 64 + m * 16 + fr, r = u.pm * 256 + lr, idx = u.tl * 256 + lr;
                const float w = (idx < ce) ? ((LAS const float*)(misc + MT_EPI + slot * 1024))[lr] * ROW8_SCALE : 0.f;
                LAS const float* bl = (LAS const float*)(misc + MT_EPI2 + slot * 1024) + wc * 32 + 8 * fq;
                asm volatile("" : "+v"(bl));
#pragma unroll
                for (int bj = 0; bj < 2; ++bj) {
                    const f32x4 b0 = *(const LAS f32x4*)(bl + bj * 128), b1 = *(const LAS f32x4*)(bl + bj * 128 + 4);
                    f32x4 a = acc[ai][bj][m][0], b = acc[ai][bj][m][1];
#pragma unroll
                    for (int i = 0; i < 4; ++i) { a[i] = (a[i] * W8_INV + b0[i]) * w; b[i] = (b[i] * W8_INV + b1[i]) * w; }
                    u32x2 o; o.x = pk4_fp8(a[0], a[1], a[2], a[3]); o.y = pk4_fp8(b[0], b[1], b[2], b[3]);
                    *(u32x2*)(rows + (size_t)r * D + u.pn * 256 + bj * 128 + wc * 32 + 8 * fq) = o;
                }
            }
    }
};
namespace attn {
typedef float f32x16 __attribute__((ext_vector_type(16)));
typedef short s16x4 __attribute__((ext_vector_type(4)));
constexpr int NK = 272, K_OFF = 0, V_OFF = 34816, WS_OFF = 69632, OST_OFF = 71680, LDS_END = OST_OFF + 8 * 4096;
constexpr float LOG2E = 1.4426950408889634f;
__device__ __forceinline__ s16x4 vtr(LAS const unsigned char* p) { return __builtin_bit_cast(s16x4, __builtin_amdgcn_ds_read_tr16_b64_v4i16((LAS s16x4*)p)); }
__device__ __forceinline__ int crowc(int r) { return (r & 3) + 8 * (r >> 2); }

template <int TYPE, bool DIAG>
__device__ __forceinline__ void tile(LAS const unsigned char* lds, int kbase, const bf16x8 (&qr)[4], f32x16 (&o)[2], float& l, float lanebase, float c1, int tt, int lane) {
    const int r32 = lane & 31, hi = lane >> 5;
    f32x16 p = {};
#pragma unroll
    for (int d0 = 0; d0 < 4; ++d0) {
        const bf16x8 kf = *(const LAS bf16x8*)(lds + K_OFF + (2 * d0 + hi) * (NK * 16) + (kbase + r32) * 16);
        p = __builtin_amdgcn_mfma_f32_32x32x16_bf16(kf, qr[d0], p, 0, 0, 0);
    }
    constexpr int NR = (TYPE == 0) ? 8 : 16;
    float e[16];
#pragma unroll
    for (int r = 0; r < NR; ++r) {
        const float add = __builtin_fmaf(c1, (float)crowc(r), lanebase);
        float v = __builtin_amdgcn_exp2f(__builtin_fmaf(p[r], LOG2E, add));
        if (DIAG) { const bool ok = (TYPE == 1) ? (crowc(r) > tt) : (crowc(r) <= tt); v = ok ? v : 0.f; }
        e[r] = v; l += v;
    }
    constexpr int NS = (TYPE == 0) ? 1 : 2;
    u32x4 pw[2];
#pragma unroll
    for (int s = 0; s < NS; ++s) { pw[s].x = pk2(e[8 * s + 0], e[8 * s + 1]); pw[s].y = pk2(e[8 * s + 2], e[8 * s + 3]); pw[s].z = pk2(e[8 * s + 4], e[8 * s + 5]); pw[s].w = pk2(e[8 * s + 6], e[8 * s + 7]); }
    LAS const unsigned char* vb = lds + V_OFF + (kbase + 4 * hi + ((lane & 15) >> 2)) * 64 + ((lane >> 4) & 1) * 32 + (lane & 3) * 8;
#pragma unroll
    for (int d0 = 0; d0 < 2; ++d0)
#pragma unroll
        for (int s = 0; s < NS; ++s) {
            const s16x4 lo = vtr(vb + d0 * (NK * 64) + s * 1024), hh = vtr(vb + d0 * (NK * 64) + s * 1024 + 512);
            const bf16x8 vf = (bf16x8){lo[0], lo[1], lo[2], lo[3], hh[0], hh[1], hh[2], hh[3]};
            o[d0] = __builtin_amdgcn_mfma_f32_32x32x16_bf16(__builtin_bit_cast(bf16x8, pw[s]), vf, o[d0], 0, 0, 0);
        }
}

#define AT_ISSUE(u_) do { const int u__ = (u_); const int b_ = u__ >> 6, qb_ = (u__ >> 1) & 31, kvh_ = u__ & 1; \
        _Pragma("unroll") for (int i = 0; i < 5; ++i) { const int idx = tid + 512 * i; if (idx < NK * 8) { const int key = idx >> 3, c = idx & 7; const bf16* rowp; \
            if (key < 16) rowp = pmeta + (size_t)key * INW; else { int j = qb_ * 128 - 128 + (key - 16); if (j < 0) j = 0; rowp = proj + ((size_t)b_ * SEQ + j) * INW; } \
            pk[i] = *(const u32x4*)(rowp + C_AK + kvh_ * 64 + c * 8); pv[i] = *(const u32x4*)(rowp + C_AV + kvh_ * 64 + c * 8); } } } while (0)
#define AT_QLOAD(dst, a_) do { const size_t qrow_ = (size_t)b * SEQ + qb * 128 + 32 * (a_) + r32; \
        _Pragma("unroll") for (int d0 = 0; d0 < 4; ++d0) dst[d0] = *(const bf16x8*)(proj + qrow_ * INW + C_AQ + h * 64 + d0 * 16 + hi * 8); } while (0)
__device__ __forceinline__ void phase(LAS unsigned char* lds, const bf16* __restrict__ proj, const bf16* __restrict__ pmeta, const float* __restrict__ sinks, float bshift, bf16* __restrict__ yatt, int G, int bx) {
    const int tid = threadIdx.x, lane = tid & 63, r32 = lane & 31, hi = lane >> 5; const int wave = __builtin_amdgcn_readfirstlane(tid >> 6);
    constexpr int NU = NB * 32 * 2;
    if (bx >= NU) return;
    u32x4 pk[5], pv[5];
    AT_ISSUE(bx);
    for (int u = bx; u < NU; u += G) {
        const int b = u >> 6, qb = (u >> 1) & 31, kvh = u & 1;
#pragma unroll
        for (int i = 0; i < 5; ++i) { const int idx = tid + 512 * i; if (idx < NK * 8) { const int key = idx >> 3, c = idx & 7;
            *(LAS u32x4*)(lds + K_OFF + c * (NK * 16) + key * 16) = pk[i];
            *(LAS u32x4*)(lds + V_OFF + (c >> 2) * (NK * 64) + key * 64 + (c & 3) * 16) = pv[i]; } }
        if (u + G < NU) AT_ISSUE(u + G);
        const int h = kvh * 8 + wave;
        bf16x8 qr[4], qn[4];
        AT_QLOAD(qr, 0);
        __syncthreads();
        const float slope = exp2f(-0.5f * (float)(h + 1)), sink = sinks[h];
        const float M = fmaxf(bshift, sink);
        const float c1 = slope * LOG2E;
        LAS float* wsf = (LAS float*)(lds + WS_OFF) + wave * 64;
        LAS bf16* stg = (LAS bf16*)(lds + OST_OFF) + wave * 2048;
#pragma unroll 1
        for (int a = 0; a < 4; ++a) {
            if (a < 3) AT_QLOAD(qn, a + 1);
            f32x16 o[2]; o[0] = f32x16{}; o[1] = f32x16{};
            float l = 0.f;
            const int t = 32 * a + r32;
            const int tt = r32 - 4 * hi;
            const float hi4 = c1 * 4.0f * (float)hi;
            tile<0, false>(lds, 0, qr, o, l, -(slope * (float)(qb * 128 + t + 16) + M) * LOG2E + hi4, c1, tt, lane);
            if (qb > 0) {
                tile<1, true>(lds, 16 + 32 * a, qr, o, l, -(slope * (float)(128 + r32) + M) * LOG2E + hi4, c1, tt, lane);
                for (int bb = a + 1; bb < 4; ++bb) tile<1, false>(lds, 16 + 32 * bb, qr, o, l, -(slope * (float)(128 + t - 32 * bb) + M) * LOG2E + hi4, c1, tt, lane);
            }
            for (int bb = 0; bb < a; ++bb) tile<2, false>(lds, 144 + 32 * bb, qr, o, l, -(slope * (float)(t - 32 * bb) + M) * LOG2E + hi4, c1, tt, lane);
            tile<2, true>(lds, 144 + 32 * a, qr, o, l, -(slope * (float)r32 + M) * LOG2E + hi4, c1, tt, lane);
            l += __shfl_xor(l, 32);
            l += exp2f((sink - M) * LOG2E);
            if (hi == 0) wsf[r32] = l;
            LDS_WAIT();
            float rli[16];
#pragma unroll
            for (int r = 0; r < 16; ++r) rli[r] = __builtin_amdgcn_rcpf(wsf[crowc(r) + 4 * hi]);
#pragma unroll
            for (int r = 0; r < 16; ++r) { const int orow = crowc(r) + 4 * hi;
#pragma unroll
                for (int d0 = 0; d0 < 2; ++d0) stg[orow * 64 + d0 * 32 + r32] = f2bf(o[d0][r] * rli[r]); }
            LDS_WAIT();
            bf16* Ow = yatt + ((size_t)b * SEQ + qb * 128 + 32 * a) * D + h * 64;
#pragma unroll
            for (int i = 0; i < 4; ++i) { const int row = i * 8 + (lane >> 3), ch = lane & 7; const u32x4 v = *(const LAS u32x4*)(stg + row * 64 + ch * 8); *(u32x4*)(Ow + (size_t)row * D + ch * 8) = v; }
            LDS_WAIT();
#pragma unroll
            for (int d0 = 0; d0 < 4; ++d0) qr[d0] = qn[d0];
        }
        __syncthreads();
    }
}
#undef AT_ISSUE
#undef AT_QLOAD
}
namespace ret {
typedef float f32x16 __attribute__((ext_vector_type(16)));
typedef short s16x4 __attribute__((ext_vector_type(4)));
constexpr size_t WS_STATES = 893 * MiB;
__device__ __forceinline__ s16x4 vtr(LAS const unsigned char* p) { return __builtin_bit_cast(s16x4, __builtin_amdgcn_ds_read_tr16_b64_v4i16((LAS s16x4*)p)); }
__device__ __forceinline__ int crowc(int r) { return (r & 3) + 8 * (r >> 2); }
__device__ __forceinline__ float lg2gamma(int h) { return log2f(1.0f - exp2f(-5.0f - (float)h)); }

constexpr int R1_BUF = 40960;
#define RET_ISSUE(KR, VR, c_) do { const int ci__ = (c_); \
        _Pragma("unroll") for (int i = 0; i < 4; ++i) { const int idx = tid + 512 * i, key = idx >> 4, ch = idx & 15; \
            if (ci__ == 0) { KR[i] = (key >= 112) ? *(const u32x4*)(pmeta + (size_t)(key - 112) * INW + C_RK + h * 128 + ch * 8) : (u32x4){0u, 0u, 0u, 0u}; } \
            else KR[i] = *(const u32x4*)(proj + ((size_t)b * SEQ + (ci__ - 1) * 128 + key) * INW + C_RK + h * 128 + ch * 8); } \
        { const int key = tid >> 2, ch = tid & 3; \
          if (ci__ == 0) VR = (key >= 112) ? *(const u32x4*)(pmeta + (size_t)(key - 112) * INW + C_RV + h * 256 + dvs * 32 + ch * 8) : (u32x4){0u, 0u, 0u, 0u}; \
          else VR = *(const u32x4*)(proj + ((size_t)b * SEQ + (ci__ - 1) * 128 + key) * INW + C_RV + h * 256 + dvs * 32 + ch * 8); } } while (0)
#define RET_STEP(KR, VR, c_) do { const int c__ = (c_); LAS unsigned char* buf = lds + (c__ & 1) * R1_BUF; \
        _Pragma("unroll") for (int i = 0; i < 4; ++i) { const int idx = tid + 512 * i, key = idx >> 4, ch = idx & 15; *(LAS u32x4*)(buf + (ch >> 2) * (128 * 64) + key * 64 + (ch & 3) * 16) = KR[i]; } \
        { const int key = tid >> 2, ch = tid & 3; float f[8]; unpack8(VR, f); u32x4 w; \
          w.x = pk2(f[0] * vscale, f[1] * vscale); w.y = pk2(f[2] * vscale, f[3] * vscale); w.z = pk2(f[4] * vscale, f[5] * vscale); w.w = pk2(f[6] * vscale, f[7] * vscale); \
          *(LAS u32x4*)(buf + 32768 + key * 64 + ch * 16) = w; } \
        if (c__ + 2 < 32) RET_ISSUE(KR, VR, c__ + 2); \
        __syncthreads(); \
        if (wave < 4) { \
            const int dt = wave; \
            acc = acc * g128; \
            LAS const unsigned char* ab = buf + dt * (128 * 64) + (4 * hi + ((lane & 15) >> 2)) * 64 + ((lane >> 4) & 1) * 32 + (lane & 3) * 8; \
            LAS const unsigned char* bb = buf + 32768 + (4 * hi + ((lane & 15) >> 2)) * 64 + ((lane >> 4) & 1) * 32 + (lane & 3) * 8; \
            _Pragma("unroll") for (int ks = 0; ks < 8; ++ks) { \
                const s16x4 al = vtr(ab + ks * 1024), ah = vtr(ab + ks * 1024 + 512), bl = vtr(bb + ks * 1024), bh = vtr(bb + ks * 1024 + 512); \
                const bf16x8 af = (bf16x8){al[0], al[1], al[2], al[3], ah[0], ah[1], ah[2], ah[3]}, bfr = (bf16x8){bl[0], bl[1], bl[2], bl[3], bh[0], bh[1], bh[2], bh[3]}; \
                acc = __builtin_amdgcn_mfma_f32_32x32x16_bf16(af, bfr, acc, 0, 0, 0); } \
            bf16* sb = states + ((((size_t)(b * 4 + h) * 32 + c__) * 8 + dvs) * 8) * 512; \
            _Pragma("unroll") for (int g = 0; g < 4; ++g) { u32x2 w; w.x = pk2(acc[4 * g], acc[4 * g + 1]); w.y = pk2(acc[4 * g + 2], acc[4 * g + 3]); \
                *(u32x2*)(sb + (size_t)(2 * dt + (g >> 1)) * 512 + (32 * (g & 1) + (lane & 31)) * 8 + 4 * hi) = w; } \
        } } while (0)
__device__ __forceinline__ void state_chain(LAS unsigned char* lds, int b, int h, int dvs, const bf16* __restrict__ proj, const bf16* __restrict__ pmeta, bf16* __restrict__ states) {
    const int tid = threadIdx.x, lane = tid & 63, hi = lane >> 5; const int wave = __builtin_amdgcn_readfirstlane(tid >> 6);
    const float lg = lg2gamma(h), g128 = exp2f(lg * 128.0f);
    u32x4 kA[4], kB[4], vA, vB;
    const float vscale = exp2f(lg * (float)(127 - (tid >> 2)));
    f32x16 acc = {};
    RET_ISSUE(kA, vA, 0); RET_ISSUE(kB, vB, 1);
#pragma unroll 1
    for (int c = 0; c < 32; c += 2) { RET_STEP(kA, vA, c); RET_STEP(kB, vB, c + 1); }
    __syncthreads();
}
#undef RET_ISSUE
#undef RET_STEP

constexpr int R3_K = 0, R3_Q = 32768, R3_V = 65536;
#define R3_ISSUE(u_) do { const int u__ = (u_); const size_t rw = (size_t)(u__ >> 7) * SEQ + (u__ & 31) * 128; const int hh = (u__ >> 5) & 3; \
        _Pragma("unroll") for (int i = 0; i < 4; ++i) { const int idx = tid + 512 * i, key = idx >> 4, ch = idx & 15; \
            kq[i] = *(const u32x4*)(proj + (rw + key) * INW + C_RK + hh * 128 + ch * 8); kq[4 + i] = *(const u32x4*)(proj + (rw + key) * INW + C_RQ + hh * 128 + ch * 8); } \
        _Pragma("unroll") for (int i = 0; i < 8; ++i) { const int idx = tid + 512 * i, key = idx >> 5, ch = idx & 31; vv[i] = *(const u32x4*)(proj + (rw + key) * INW + C_RV + hh * 256 + ch * 8); } } while (0)
__device__ __forceinline__ void out_phase(LAS unsigned char* lds, const bf16* __restrict__ proj, const bf16* __restrict__ states, bf16* __restrict__ yret, int G, int bx) {
    const int tid = threadIdx.x, lane = tid & 63, r32 = lane & 31, hi = lane >> 5; const int wave = __builtin_amdgcn_readfirstlane(tid >> 6);
    constexpr int NU = NB * 4 * 32;
    if (bx >= NU) return;
    u32x4 kq[8], vv[8];
    R3_ISSUE(bx);
    for (int u = bx; u < NU; u += G) {
        const int b = u >> 7, h = (u >> 5) & 3, tb = u & 31;
        const float lg = lg2gamma(h);
        const size_t row0 = (size_t)b * SEQ + tb * 128;
#pragma unroll
        for (int i = 0; i < 4; ++i) { const int idx = tid + 512 * i, key = idx >> 4, ch = idx & 15;
            *(LAS u32x4*)(lds + R3_K + ch * 2048 + key * 16) = kq[i]; *(LAS u32x4*)(lds + R3_Q + ch * 2048 + key * 16) = kq[4 + i]; }
#pragma unroll
        for (int i = 0; i < 8; ++i) { const int idx = tid + 512 * i, key = idx >> 5, ch = idx & 31; *(LAS u32x4*)(lds + R3_V + (ch >> 2) * 8192 + key * 64 + (ch & 3) * 16) = vv[i]; }
        if (u + G < NU) R3_ISSUE(u + G);
        bf16x8 sf[8];
        { const bf16* sb = states + (((size_t)(b * 4 + h) * 32 + tb) * 64 + (size_t)wave * 8) * 512 + lane * 8;
#pragma unroll
          for (int k = 0; k < 8; ++k) sf[k] = *(const bf16x8*)(sb + (size_t)k * 512); }
        __syncthreads();
        u32x2 pw[2][4];
        for (int rp_ = 0; rp_ < ((PROBE_PHASE == 31) ? 2 : 1); ++rp_)
#pragma unroll
        for (int ti = 0; ti < 2; ++ti) {
            const int t = wave + 8 * ti;
            if (t < 10) {
                const int a = (t >= 6) ? 3 : (t >= 3) ? 2 : (t >= 1) ? 1 : 0, bb = t - ((a * (a + 1)) >> 1);
                f32x16 p = {};
#pragma unroll
                for (int k = 0; k < 8; ++k) {
                    const bf16x8 kf = *(const LAS bf16x8*)(lds + R3_K + (2 * k + hi) * 2048 + (32 * bb + r32) * 16);
                    const bf16x8 qf = *(const LAS bf16x8*)(lds + R3_Q + (2 * k + hi) * 2048 + (32 * a + r32) * 16);
                    p = __builtin_amdgcn_mfma_f32_32x32x16_bf16(kf, qf, p, 0, 0, 0);
                }
                const float lanebase = lg * (float)(32 * (a - bb) + r32 - 4 * hi), cpos = -lg; const int tt = r32 - 4 * hi;
                float e[16];
#pragma unroll
                for (int r = 0; r < 16; ++r) { float v = p[r] * __builtin_amdgcn_exp2f(__builtin_fmaf(cpos, (float)crowc(r), lanebase)); if (bb == a) v = (crowc(r) <= tt) ? v : 0.f; e[r] = v; }
#pragma unroll
                for (int g = 0; g < 4; ++g) { pw[ti][g].x = pk2(e[4 * g], e[4 * g + 1]); pw[ti][g].y = pk2(e[4 * g + 2], e[4 * g + 3]); }
            }
        }
        __builtin_amdgcn_sched_barrier(0);
        bf16x8 vf[8];
        { LAS const unsigned char* vb = lds + R3_V + wave * 8192 + (8 * hi + ((lane & 15) >> 2)) * 64 + ((lane >> 4) & 1) * 32 + (lane & 3) * 8;
#pragma unroll
          for (int ks = 0; ks < 8; ++ks) { const s16x4 lo = vtr(vb + ks * 1024), hh = vtr(vb + ks * 1024 + 256); vf[ks] = (bf16x8){lo[0], lo[1], lo[2], lo[3], hh[0], hh[1], hh[2], hh[3]}; } }
        __syncthreads();
#pragma unroll
        for (int ti = 0; ti < 2; ++ti) {
            const int t = wave + 8 * ti;
            if (t < 10) {
                const int a = (t >= 6) ? 3 : (t >= 3) ? 2 : (t >= 1) ? 1 : 0, bb = t - ((a * (a + 1)) >> 1);
#pragma unroll
                for (int g = 0; g < 4; ++g) *(LAS u32x2*)(lds + R3_K + (4 * bb + g) * 2048 + (32 * a + r32) * 16 + hi * 8) = pw[ti][g];
            }
        }
        __syncthreads();
        LAS bf16* stg = (LAS bf16*)(lds + R3_V);
        for (int rp_ = 0; rp_ < ((PROBE_PHASE == 32) ? 2 : 1); ++rp_)
#pragma unroll 1
        for (int a = 0; a < 4; ++a) {
            f32x16 o = {};
#pragma unroll
            for (int ks = 0; ks < 8; ++ks) if (ks < 2 * (a + 1)) {
                const bf16x8 pa = *(const LAS bf16x8*)(lds + R3_K + (2 * ks + hi) * 2048 + (32 * a + r32) * 16);
                o = __builtin_amdgcn_mfma_f32_32x32x16_bf16(pa, vf[ks], o, 0, 0, 0);
            }
            f32x16 x = {};
#pragma unroll
            for (int k = 0; k < 8; ++k) { const bf16x8 qa = *(const LAS bf16x8*)(lds + R3_Q + (2 * k + hi) * 2048 + (32 * a + r32) * 16); x = __builtin_amdgcn_mfma_f32_32x32x16_bf16(qa, sf[k], x, 0, 0, 0); }
#pragma unroll
            for (int r = 0; r < 16; ++r) {
                const float din = __builtin_amdgcn_exp2f(lg * (float)(32 * a + crowc(r) + 4 * hi + 1));
                { const int row = 32 * a + crowc(r) + 4 * hi, col = wave * 32 + r32;
                  stg[row * 256 + ((((col >> 3) ^ ((row & 3) << 2)) << 3) | (col & 7))] = f2bf(o[r] + din * x[r]); }
            }
        }
        int nl = lane; asm volatile("" : "+v"(nl));
        const int nrow = wave * 16 + (nl >> 2), c4 = nl & 3, sx = nrow & 3;
        const bf16* rgp = proj + (row0 + nrow) * INW + C_RG + h * 256 + c4 * 8;
        bf16* yp = yret + (row0 + nrow) * D + h * 256 + c4 * 8;
        LAS const bf16* sp = stg + nrow * 256 + c4 * 8;
        u32x4 rgv[8];
#pragma unroll
        for (int j = 0; j < 8; ++j) rgv[j] = *(const u32x4*)(rgp + 32 * j);
        __syncthreads();
        for (int rp_ = 0; rp_ < ((PROBE_PHASE == 33) ? 2 : 1); ++rp_) {
            float ss = 0.f;
#pragma unroll
            for (int j = 0; j < 8; ++j) { const u32x4 sw = *(const LAS u32x4*)(sp + 32 * (j ^ sx)); float f[8]; unpack8(sw, f);
#pragma unroll
                for (int i = 0; i < 8; ++i) ss += f[i] * f[i]; }
            ss += __shfl_xor(ss, 1); ss += __shfl_xor(ss, 2);
            const float rs = rsqrtf(ss * (1.0f / 256.0f) + EPS);
            asm volatile("" ::: "memory");
#pragma unroll
            for (int j = 0; j < 8; ++j) { const u32x4 sw = *(const LAS u32x4*)(sp + 32 * (j ^ sx)); float f[8], g[8]; unpack8(sw, f); unpack8(rgv[j], g); u32x4 w;
                w.x = pk2(f[0] * rs * g[0], f[1] * rs * g[1]); w.y = pk2(f[2] * rs * g[2], f[3] * rs * g[3]); w.z = pk2(f[4] * rs * g[4], f[5] * rs * g[5]); w.w = pk2(f[6] * rs * g[6], f[7] * rs * g[7]);
                *(u32x4*)(yp + 32 * j) = w; }
        }
        __syncthreads();
    }
}
#undef R3_ISSUE
}
template <bool FP8>
__device__ __forceinline__ void p0_item(const float* __restrict__ W, int K, int N, void* __restrict__ WT, int k0, int n0, int dst_row0, int lane) {
    const int kblk = lane >> 3, nq = lane & 7;
    const float* src = W + (size_t)(k0 + 16 * kblk) * N + n0 + 4 * nq;
    f32x4 v[16];
#pragma unroll
    for (int i = 0; i < 16; ++i) v[i] = __builtin_nontemporal_load((const f32x4*)(src + (size_t)i * N));
#pragma unroll
    for (int j = 0; j < 4; ++j) {
        const size_t row = (size_t)(dst_row0 + 4 * nq + j);
        if constexpr (FP8) {
            u32x4 o;
            o.x = pk4_fp8(v[0][j] * W8_SCALE, v[1][j] * W8_SCALE, v[2][j] * W8_SCALE, v[3][j] * W8_SCALE); o.y = pk4_fp8(v[4][j] * W8_SCALE, v[5][j] * W8_SCALE, v[6][j] * W8_SCALE, v[7][j] * W8_SCALE);
            o.z = pk4_fp8(v[8][j] * W8_SCALE, v[9][j] * W8_SCALE, v[10][j] * W8_SCALE, v[11][j] * W8_SCALE); o.w = pk4_fp8(v[12][j] * W8_SCALE, v[13][j] * W8_SCALE, v[14][j] * W8_SCALE, v[15][j] * W8_SCALE);
            *(u32x4*)((unsigned char*)WT + row * K + k0 + 16 * kblk) = o;
        } else {
            u32x4 a, b;
            a.x = pk2(v[0][j], v[1][j]); a.y = pk2(v[2][j], v[3][j]); a.z = pk2(v[4][j], v[5][j]); a.w = pk2(v[6][j], v[7][j]);
            b.x = pk2(v[8][j], v[9][j]); b.y = pk2(v[10][j], v[11][j]); b.z = pk2(v[12][j], v[13][j]); b.w = pk2(v[14][j], v[15][j]);
            bf16* d = (bf16*)WT + row * K + k0 + 16 * kblk;
            *(u32x4*)d = a; *(u32x4*)(d + 8) = b;
        }
    }
}
#ifndef PROBE_PHASE
#define PROBE_PHASE (-1)
#endif
__device__ __forceinline__ void p0_transpose_item_fp8(const float* W, int K, int N, unsigned char* WT, int k0, int n0, int dst_row0, LAS float* scr, int lane) {
#pragma unroll 8
    for (int i = 0; i < 32; ++i) { const int kk = 2 * i + (lane >> 5); scr[kk * 33 + (lane & 31)] = W[(size_t)(k0 + kk) * N + n0 + (lane & 31)]; }
    LDS_WAIT(); asm volatile("" ::: "memory");
    const int c = lane & 3;
#pragma unroll
    for (int j = 0; j < 2; ++j) { const int n = (lane >> 2) + 16 * j; const LAS float* s = scr + (16 * c) * 33 + n;
        u32x4 o;
        o.x = pk4_fp8(s[0 * 33] * W8_SCALE, s[1 * 33] * W8_SCALE, s[2 * 33] * W8_SCALE, s[3 * 33] * W8_SCALE); o.y = pk4_fp8(s[4 * 33] * W8_SCALE, s[5 * 33] * W8_SCALE, s[6 * 33] * W8_SCALE, s[7 * 33] * W8_SCALE);
        o.z = pk4_fp8(s[8 * 33] * W8_SCALE, s[9 * 33] * W8_SCALE, s[10 * 33] * W8_SCALE, s[11 * 33] * W8_SCALE); o.w = pk4_fp8(s[12 * 33] * W8_SCALE, s[13 * 33] * W8_SCALE, s[14 * 33] * W8_SCALE, s[15 * 33] * W8_SCALE);
        *(u32x4*)(WT + (size_t)(dst_row0 + n) * K + k0 + 16 * c) = o; }
    LDS_WAIT(); asm volatile("" ::: "memory");
}
struct Args { const float* in[17]; float* out; unsigned char* ws; int ph_lo, ph_hi, li, pad; };

__global__ void __launch_bounds__(512, 2) mk_fwd(Args args) {
    extern __shared__ __attribute__((aligned(16))) unsigned char lds_raw[];
    LAS unsigned char* lds = (LAS unsigned char*)lds_raw;
    volatile LAS unsigned* MISC = (volatile LAS unsigned*)(lds + MISC_OFF);
    const int tid = threadIdx.x, lane = tid & 63, wave = __builtin_amdgcn_readfirstlane(tid >> 6);
    const int G = gridDim.x, bx = blockIdx.x;
    const int vcu = (G % 8 == 0) ? (bx % 8) * (G / 8) + bx / 8 : bx;
    unsigned char* ws = args.ws;
    unsigned* ctl = (unsigned*)(ws + WS_CTL);
    const float* x = args.in[0]; const float* meta = args.in[1]; const float* g1 = args.in[2]; const float* w_in = args.in[3];
    const float* qg = args.in[4]; const float* kg = args.in[5];
    const float* w_ab = args.in[7]; const float* w_rb = args.in[8]; const float* w_out = args.in[9];
    const float* w_gu = args.in[13]; const float* b_gu = args.in[14]; const float* w_dn = args.in[15]; const float* b_dn = args.in[16];
    float* out = args.out;
    bf16* Win_t = (bf16*)(ws + WS_WIN); bf16* Wab_t = (bf16*)(ws + WS_WAB); bf16* Wrb_t = (bf16*)(ws + WS_WRB); bf16* Wout_t = (bf16*)(ws + WS_WOUT);
    unsigned char* Wgu_t = ws + WS_WGU; unsigned char* Wdn_t = ws + WS_WDN;
    bf16* xb = (bf16*)(ws + WS_XB); bf16* proj = (bf16*)(ws + WS_PROJ); bf16* yatt = (bf16*)(ws + WS_YATT); bf16* yret = (bf16*)(ws + WS_YRET); bf16* merged = (bf16*)(ws + WS_MERGED);
    bf16* pmeta = proj + (size_t)NTOK * INW;
    const float* sinks = args.in[6]; const float* g2 = args.in[10]; const float* w_r = args.in[11]; const float* b_r = args.in[12];
    int* tke = (int*)(ws + SM_TKE); float* tkw = (float*)(ws + SM_TKW); int* tkpos = (int*)(ws + SM_TKPOS); int* list = (int*)(ws + SM_LIST); float* wlist = (float*)(ws + SM_WLIST); float* rlist = (float*)(ws + SM_RLIST);
    LAS unsigned char* misc = lds + MISC_OFF;
    bf16* states = (bf16*)(ws + ret::WS_STATES);
    unsigned char* act = ws + WS_ACT; unsigned char* rows = ws + WS_ROWS; unsigned char* xn8 = ws + WS_XB;

    for (int u = tid; u < (LDS_BYTES - MISC_OFF) / 4; u += 512) ((LAS unsigned*)(lds + MISC_OFF))[u] = 0u;
    __syncthreads();
    XcdBarrier bar = xcd_barrier_post(ctl + CW_BAR + args.li * XCD_BAR_WORDS, MISC + 8);
    const int lo = args.ph_lo, hi = args.ph_hi;
#define IN(k) (lo <= (k) && (k) < hi)
#define BOTH(k) (IN(k) && IN((k) + 1))
#define GRID_BAR() xcd_barrier(bar)

    if (IN(0)) { for (int rep_ = 0; rep_ < ((PROBE_PHASE == 0) ? 2 : 1); ++rep_) {
        const int gw = vcu * NWAVES + wave, NGW = G * NWAVES;
        constexpr int I_IN = 8 * 200, I_SQ = 8 * 32, I_GU = 32 * 8 * 64, I_DN = 32 * 8 * 32;
        constexpr int NITEMS = I_IN + 3 * I_SQ + I_GU + I_DN;
        for (int rep2_ = 0; rep2_ < ((PROBE_PHASE == 100) ? 2 : 1); ++rep2_)
        for (int it = gw; it < NITEMS; it += NGW) {
            int r = it;
            if (r < I_IN) { const int kb = r / 200, nb = r % 200, n0 = nb * 32, o = n0 & 255, wcc = o >> 6, bj = (o >> 5) & 1;
                p0_item<false>(w_in, D, INW, Win_t, kb * 128, n0, (n0 & ~255) + 128 * bj + 32 * wcc, lane); continue; }
            r -= I_IN;
            if (r < I_SQ) { p0_item<false>(w_ab, D, D, Wab_t, (r / 32) * 128, (r % 32) * 32, (r % 32) * 32, lane); continue; } r -= I_SQ;
            if (r < I_SQ) { p0_item<false>(w_rb, D, D, Wrb_t, (r / 32) * 128, (r % 32) * 32, (r % 32) * 32, lane); continue; } r -= I_SQ;
            if (r < I_SQ) { p0_item<false>(w_out, D, D, Wout_t, (r / 32) * 128, (r % 32) * 32, (r % 32) * 32, lane); continue; } r -= I_SQ;
            if (r < I_GU) { const int e = r / 512, q = r % 512, kb = q / 64, nb = q % 64, n0 = nb * 32, bj = n0 >> 10, rem = n0 & 1023, pn = rem >> 7, cl = rem & 127;
                p0_item<true>(w_gu + (size_t)e * D * 2048, D, 2048, Wgu_t + (size_t)e * 2048 * D, kb * 128, n0, 256 * pn + 128 * bj + cl, lane); continue; }
            r -= I_GU;
            { const int e = r / 256, q = r % 256, kb = q / 32, nb = q % 32;
              p0_item<true>(w_dn + (size_t)e * DFF * D, DFF, D, Wdn_t + (size_t)e * D * DFF, kb * 128, nb * 32, nb * 32, lane); }
        }
        for (int rep2_ = 0; rep2_ < ((PROBE_PHASE == 101) ? 2 : 1); ++rep2_)
        for (int row = gw; row < NTOK; row += NGW) {
            const f32x4* xr = (const f32x4*)(x + (size_t)row * D) + lane;
            f32x4 v[4]; float ss = 0.f;
#pragma unroll
            for (int j = 0; j < 4; ++j) { v[j] = xr[64 * j]; ss += (v[j][0] * v[j][0] + v[j][1] * v[j][1]) + (v[j][2] * v[j][2] + v[j][3] * v[j][3]); }
            const float rstd = rsqrtf(wave_sum(ss) * (1.0f / D) + EPS);
            u32x2* o8 = (u32x2*)(xb + (size_t)row * D) + lane;
#pragma unroll
            for (int j = 0; j < 4; ++j) { const f32x4 gg = ((const f32x4*)g1)[64 * j + lane]; u32x2 w; w.x = pk2(v[j][0] * rstd * gg[0], v[j][1] * rstd * gg[1]); w.y = pk2(v[j][2] * rstd * gg[2], v[j][3] * rstd * gg[3]); o8[64 * j] = w; }
        }
        for (int row = gw; row < 256; row += NGW) {
            u32x2* o8 = (u32x2*)(xb + (size_t)(NTOK + row) * D) + lane;
            if (row < NMETA) {
                const f32x4* xr = (const f32x4*)(meta + (size_t)row * D) + lane;
                f32x4 v[4]; float ss = 0.f;
#pragma unroll
                for (int j = 0; j < 4; ++j) { v[j] = xr[64 * j]; ss += (v[j][0] * v[j][0] + v[j][1] * v[j][1]) + (v[j][2] * v[j][2] + v[j][3] * v[j][3]); }
                const float rstd = rsqrtf(wave_sum(ss) * (1.0f / D) + EPS);
#pragma unroll
                for (int j = 0; j < 4; ++j) { const f32x4 gg = ((const f32x4*)g1)[64 * j + lane]; u32x2 w; w.x = pk2(v[j][0] * rstd * gg[0], v[j][1] * rstd * gg[1]); w.y = pk2(v[j][2] * rstd * gg[2], v[j][3] * rstd * gg[3]); o8[64 * j] = w; }
            } else {
#pragma unroll
                for (int j = 0; j < 4; ++j) o8[64 * j] = (u32x2){0u, 0u};
            }
        }
        __syncthreads(); }
        if (BOTH(0)) GRID_BAR();
    }
    if (PROBE_PHASE == 200) { GRID_BAR(); GRID_BAR(); GRID_BAR(); GRID_BAR(); }
    if (IN(1)) {
        SchedDense S; S.init(xb, Win_t, NTOK + 256, INW, D, G, bx);
        { LAS float* gt = (LAS float*)(misc + MT_GAIN); if (tid < 64) { gt[tid] = 0.125f * qg[tid]; gt[64 + tid] = kg[tid]; } __syncthreads(); }
        EpiProj E{proj, (LAS const float*)(misc + MT_GAIN)};
        for (int rep_ = 0; rep_ < ((PROBE_PHASE == 1) ? 2 : 1); ++rep_) pg8::gemm_phase<EpiProj, SchedDense>(lds, 2 * D, S, E);
        if (BOTH(1)) GRID_BAR();
    }
    if (IN(2)) {
        float mq = fabsf(qg[lane]), mk = fabsf(kg[lane]);
#pragma unroll
        for (int o = 1; o < 64; o <<= 1) { mq = fmaxf(mq, __shfl_xor(mq, o)); mk = fmaxf(mk, __shfl_xor(mk, o)); }
        const float bshift = 8.0f * mq * mk;
        for (int rep_ = 0; rep_ < ((PROBE_PHASE == 20) ? 2 : 1); ++rep_) attn::phase(lds, proj, pmeta, sinks, bshift, yatt, G, bx);
        for (int rep_ = 0; rep_ < ((PROBE_PHASE == 21) ? 2 : 1); ++rep_) for (int u = bx; u < NB * 4 * 8; u += G) { const int v = ((G & 7) == 0 && G == 256) ? ((u & 7) * 32 + (u >> 3)) : u;
            ret::state_chain(lds, v >> 5, (v >> 3) & 3, v & 7, proj, pmeta, states); }
        if (BOTH(2)) GRID_BAR();
    }
    if (IN(3)) {
        for (int rep_ = 0; rep_ < ((PROBE_PHASE == 3) ? 2 : 1); ++rep_) ret::out_phase(lds, proj, states, yret, G, bx);
        if (BOTH(3)) GRID_BAR();
    }
    if (IN(4)) {
        SchedBranch S{(const char*)yatt, (const char*)yret, (const char*)Wab_t, (const char*)Wrb_t, G, bx};
        EpiBranch E{merged, proj};
        for (int rep_ = 0; rep_ < ((PROBE_PHASE == 4) ? 2 : 1); ++rep_) pg8::gemm_phase<EpiBranch, SchedBranch>(lds, 2 * D, S, E);
        if (BOTH(4)) GRID_BAR();
    }
    if (IN(5)) {
        SchedDense S; S.init(merged, Wout_t, NTOK, D, D, G, bx);
        EpiOut E{x, out};
        for (int rep_ = 0; rep_ < ((PROBE_PHASE == 5) ? 2 : 1); ++rep_) pg8::gemm_phase<EpiOut, SchedDense>(lds, 2 * D, S, E);
        if (BOTH(5)) GRID_BAR();
    }
    if (IN(6)) {
        route_phase(lds, out, g2, w_r, b_r, xn8, tke, tkpos, tkw, list, wlist, rlist, ctl + CW_CNT, G, bx);
        if (BOTH(6)) GRID_BAR();
    }
    if (hi > 7 && lo <= 9) moe_tables(misc, ctl + CW_CNT);
    if (IN(7)) {
        SchedMoe<true, 8> S{(const char*)xn8, (const char*)Wgu_t, misc, list, G, bx};
        EpiGU E{act, b_gu, rlist, misc};
        for (int rep_ = 0; rep_ < ((PROBE_PHASE == 7) ? 2 : 1); ++rep_) pg8::gemm_phase<EpiGU, SchedMoe<true, 8>, true>(lds, D, S, E);
        if (BOTH(7)) GRID_BAR();
    }
    if (IN(8)) {
        SchedMoe<false, 4> S{(const char*)act, (const char*)Wdn_t, misc, list, G, bx};
        EpiDown E{rows, b_dn, wlist, misc};
        for (int rep_ = 0; rep_ < ((PROBE_PHASE == 8) ? 2 : 1); ++rep_) pg8::gemm_phase<EpiDown, SchedMoe<false, 4>, true>(lds, DFF, S, E);
        if (BOTH(8)) GRID_BAR();
    }
    if (IN(9)) combine_phase(misc, (void*)proj, out, rows, tke, tkpos, vcu * NWAVES + wave, G * NWAVES, lane);
#undef IN
#undef BOTH
#undef GRID_BAR
}

extern "C" void kernel_launch(void* const* d_in, const int* in_sizes, int n_in, void* d_out, int out_size, void* d_ws, size_t ws_size, hipStream_t stream) {
    static int grid = 0;
    if (grid == 0) {
        if (n_in != 17 || in_sizes[0] != NTOK * D || out_size != NTOK * D || ws_size < WS_END) {
            fprintf(stderr, "kernel_launch: unexpected shapes (n_in %d in0 %d out %d ws %zu)\n", n_in, n_in > 0 ? in_sizes[0] : -1, out_size, ws_size); grid = -1; return; }
        int dev = 0, cus = 0;
        if (hipGetDevice(&dev) != hipSuccess || hipDeviceGetAttribute(&cus, hipDeviceAttributeMultiprocessorCount, dev) != hipSuccess) { grid = -1; return; }
        if (hipFuncSetAttribute((const void*)mk_fwd, hipFuncAttributeMaxDynamicSharedMemorySize, LDS_BYTES) != hipSuccess) { fprintf(stderr, "kernel_launch: hipFuncSetAttribute failed\n"); grid = -1; return; }
        grid = cus;
    }
    if (grid < 0) return;
    unsigned char* ws = (unsigned char*)d_ws;
    (void)hipMemsetAsync(ws + WS_CTL, 0, 1 * MiB, stream);
    Args a{};
    for (int i = 0; i < 17; ++i) a.in[i] = (const float*)d_in[i];
    a.out = (float*)d_out; a.ws = ws; a.ph_lo = 0; a.ph_hi = 10; a.li = 0; a.pad = 0;
    hipLaunchKernelGGL(mk_fwd, dim3(grid), dim3(512), LDS_BYTES, stream, a);
}
```

```cpp
#include <hip/hip_runtime.h>
#include <cstdio>
#include <cstdint>

typedef unsigned short bf16;
__device__ __forceinline__ float bf2f(bf16 v) { return __uint_as_float(((unsigned)v) << 16); }
__device__ __forceinline__ bf16 f2bf(float f) { const __bf16 b = (__bf16)f; return __builtin_bit_cast(unsigned short, b); }
__device__ __forceinline__ float sigmoidf_(float x) { return __builtin_amdgcn_rcpf(1.0f + __builtin_amdgcn_exp2f(-1.4426950408889634f * x)); }

constexpr int NB = 8, SEQ = 4096, D = 1024, NTOK = NB * SEQ;
constexpr int NMETA = 16;
constexpr int INW = 6400;
constexpr int C_AQ = 0, C_AK = 1024, C_AV = 1152, C_RQ = 1280, C_RK = 1792, C_RV = 2304, C_RG = 3328, C_GA = 4352, C_GR = 5376;
constexpr int NE = 32, TOPK = 4, DFF = 1024;
constexpr int NROWS = (NTOK * TOPK / 256 + NE) * 256;
constexpr int NTILE = NROWS / 256;
constexpr float EPS = 1e-5f;

constexpr size_t MiB = 1u << 20;
constexpr size_t WS_CTL = 0;
constexpr size_t WS_SMALL = 1 * MiB;
constexpr size_t WS_W = 16 * MiB;
constexpr size_t WS_XB = 232 * MiB;
constexpr size_t WS_PROJ = 297 * MiB;
constexpr size_t WS_YATT = 701 * MiB;
constexpr size_t WS_YRET = 765 * MiB;
constexpr size_t WS_MERGED = 829 * MiB;
constexpr size_t WS_END = 1020 * MiB;
constexpr size_t WS_ACT = 297 * MiB;
constexpr size_t WS_ROWS = 568 * MiB;
constexpr size_t SM_UMETA = WS_SMALL;
constexpr size_t SM_PMETA = WS_SMALL + 64 * 1024;
constexpr size_t SM_TKE = WS_SMALL + 512 * 1024;
constexpr size_t SM_TKW = SM_TKE + 512 * 1024;
constexpr size_t SM_TKPOS = SM_TKW + 512 * 1024;
constexpr size_t SM_TKROW = SM_TKPOS + 512 * 1024;
constexpr size_t SM_ROWTOK = SM_TKROW + 512 * 1024;
constexpr size_t SM_ROWW = SM_ROWTOK + 1024 * 1024;
constexpr size_t SM_TILEE = SM_ROWW + 1024 * 1024;
constexpr int CW_CNT = 1024;

#ifndef PROBE_PHASE
#define PROBE_PHASE (-1)
#endif
#define LAS __attribute__((address_space(3)))
#define GAS __attribute__((address_space(1)))
typedef short bf16x8 __attribute__((ext_vector_type(8)));
typedef float f32x4 __attribute__((ext_vector_type(4)));
typedef float f32x2 __attribute__((ext_vector_type(2)));
typedef unsigned u32x4 __attribute__((ext_vector_type(4)));
typedef unsigned u32x2 __attribute__((ext_vector_type(2)));
#define LDS_WAIT() asm volatile("s_waitcnt lgkmcnt(0)" ::: "memory")
#define VM_WAIT() asm volatile("s_waitcnt vmcnt(0)" ::: "memory")
typedef __bf16 bf16x2_t __attribute__((ext_vector_type(2)));
__device__ __forceinline__ unsigned pk2(float lo, float hi) { const f32x2 v = {lo, hi}; const bf16x2_t b = __builtin_convertvector(v, bf16x2_t); return __builtin_bit_cast(unsigned, b); }
__device__ __forceinline__ unsigned pk4_fp8(float a, float b, float c, float d) { int w = __builtin_amdgcn_cvt_pk_fp8_f32(a, b, 0, false); w = __builtin_amdgcn_cvt_pk_fp8_f32(c, d, w, true); return (unsigned)w; }
constexpr float W8_SCALE = 64.0f, W8_INV = 1.0f / 64.0f;
constexpr float ROW8_SCALE = 16.0f, ROW8_INV = 1.0f / 16.0f;
__device__ __forceinline__ u32x4 pack8(const f32x4& a, const f32x4& b) { u32x4 w; w.x = pk2(a[0], a[1]); w.y = pk2(a[2], a[3]); w.z = pk2(b[0], b[1]); w.w = pk2(b[2], b[3]); return w; }
__device__ __forceinline__ void unpack8(const u32x4& w, float (&f)[8]) {
    f[0] = __uint_as_float(w.x << 16); f[1] = __uint_as_float(w.x & 0xffff0000u); f[2] = __uint_as_float(w.y << 16); f[3] = __uint_as_float(w.y & 0xffff0000u);
    f[4] = __uint_as_float(w.z << 16); f[5] = __uint_as_float(w.z & 0xffff0000u); f[6] = __uint_as_float(w.w << 16); f[7] = __uint_as_float(w.w & 0xffff0000u);
}
__device__ __forceinline__ float wave_sum(float v) {
#pragma unroll
    for (int o = 1; o < 64; o <<= 1) v += __shfl_xor(v, o);
    return v;
}

constexpr size_t WS_WIN = WS_W;
constexpr size_t WS_WAB = WS_W + 13 * MiB;
constexpr size_t WS_WRB = WS_W + 15 * MiB;
constexpr size_t WS_WOUT = WS_W + 17 * MiB;
constexpr size_t WS_WGU = WS_W + 19 * MiB;
constexpr size_t WS_WDN = WS_W + 147 * MiB;
static_assert(WS_WDN + 64 * MiB <= WS_XB, "weight map");
constexpr size_t SM_ATILE = SM_TILEE + 4096;
constexpr int CW_NACT = 1088;
constexpr int CW_BAR = 4096;

constexpr int RING_BYTES = 131072;
constexpr int MISC_OFF = RING_BYTES;
constexpr int LDS_BYTES = 163840;
constexpr int NWAVES = 8;

#define XB_TMO      128
#define XB_XCNT(j)  (256  + 64 * (j))
#define XB_XSUB(j)  (1280 + 64 * (j))
#define XB_XGEN(j)  (2304 + 64 * (j))
#define XB_TOP      3328
#define XB_TOPGEN   3392
#define XCD_BAR_WORDS 3456
#define XB_SPIN_CAP (1u << 20)
__device__ __forceinline__ unsigned xb_ld(unsigned* p)              { return __hip_atomic_load(p, __ATOMIC_RELAXED, __HIP_MEMORY_SCOPE_AGENT); }
__device__ __forceinline__ unsigned xb_add(unsigned* p, unsigned v) { return __hip_atomic_fetch_add(p, v, __ATOMIC_RELAXED, __HIP_MEMORY_SCOPE_AGENT); }
__device__ __forceinline__ unsigned xb_xcc_id() { return (unsigned)__builtin_amdgcn_s_getreg((3 << 11) | 20) & 0xFu; }
#define XB_SPIN(cond, bar) do { unsigned _sp = 0; while (cond) { __builtin_amdgcn_s_sleep(1); \
    if ((++_sp & 255u) == 0u) { if (xb_ld(&(bar)[XB_TMO])) break; if (_sp > XB_SPIN_CAP) { atomicAdd(&(bar)[XB_TMO], 1u); break; } } } } while (0)
struct XcdBarrier { unsigned* bar; unsigned x; volatile LAS unsigned* st; };
__device__ __forceinline__ XcdBarrier xcd_barrier_post(unsigned* bar, volatile LAS unsigned* st) {
    XcdBarrier b; b.bar = bar; b.x = xb_xcc_id(); b.st = st;
    if (threadIdx.x == 0) (void)xb_add(&bar[XB_XCNT(b.x)], 1u);
    return b;
}
__device__ __forceinline__ void xcd_barrier_complete(unsigned* bar, unsigned x, unsigned& nloc, unsigned& nx) {
    const unsigned G = gridDim.x * gridDim.y * gridDim.z;
    unsigned sum, cnt, mine, sp = 0u;
    for (;;) {
        sum = 0u; cnt = 0u; mine = 0u;
#pragma unroll
        for (unsigned j = 0; j < 16; ++j) { const unsigned c = xb_ld(&bar[XB_XCNT(j)]); sum += c; cnt += (c > 0u) ? 1u : 0u; mine = (j == x) ? c : mine; }
        if (sum == G) break;
        __builtin_amdgcn_s_sleep(1);
        if ((++sp & 255u) == 0u) { if (xb_ld(&bar[XB_TMO])) break; if (sp > XB_SPIN_CAP) { atomicAdd(&bar[XB_TMO], 1u); break; } }
    }
    nloc = mine > 0u ? mine : 1u; nx = cnt > 0u ? cnt : 1u;
}
__device__ __forceinline__ void xcd_barrier(const XcdBarrier& b) {
    asm volatile("s_waitcnt vmcnt(0)" ::: "memory");
    __syncthreads();
    if (threadIdx.x == 0) {
        unsigned* bar = b.bar;
        __builtin_amdgcn_s_waitcnt(0);
        unsigned nloc = b.st[0], nx = b.st[1];
        if (nloc == 0u) { xcd_barrier_complete(bar, b.x, nloc, nx); b.st[0] = nloc; b.st[1] = nx; }
        const unsigned old = xb_add(&bar[XB_XSUB(b.x)], 1u);
        const unsigned gen = old / nloc;
        if (old + 1u == (gen + 1u) * nloc) {
            __builtin_amdgcn_fence(__ATOMIC_RELEASE, "agent");
            asm volatile("s_waitcnt vmcnt(0)" ::: "memory");
            const unsigned og = xb_add(&bar[XB_TOP], 1u);
            const unsigned tg = og / nx;
            if (og + 1u == (tg + 1u) * nx) xb_add(&bar[XB_TOPGEN], 1u);
            else XB_SPIN(xb_ld(&bar[XB_TOPGEN]) == tg, bar);
            __builtin_amdgcn_fence(__ATOMIC_ACQUIRE, "agent");
            xb_add(&bar[XB_XGEN(b.x)], 1u);
            asm volatile("s_waitcnt vmcnt(0)" ::: "memory");
        } else {
            XB_SPIN(xb_ld(&bar[XB_XGEN(b.x)]) == gen, bar);
            __builtin_amdgcn_fence(__ATOMIC_ACQUIRE, "agent");
            asm volatile("s_waitcnt vmcnt(0)" ::: "memory");
        }
    }
    __syncthreads();
}

namespace pg8 {
constexpr int BM = 256, BK = 64, HALF = 128, HTB = HALF * BK * 2, STAGE_BYTES = 8 * HTB;
__host__ __device__ __forceinline__ int lds_byte(int r, int c) { const int st = (r >> 4) * 2 + (c >> 5), rr = r & 15, cc = c & 31, ob = rr * 64 + cc * 2; return st * 1024 + (ob ^ (((ob >> 9) & 1) << 5)); }
__host__ __device__ __forceinline__ void stage_rc(int b, int& R, int& C) { const int st = b / 1024, sb = b % 1024, swz = sb ^ (((sb >> 9) & 1) << 5); R = (st >> 1) * 16 + swz / 64; C = (st & 1) * 32 + (swz % 64) / 2; }
__host__ __device__ __forceinline__ int perm32(int rho) { const int n = rho >> 4, i = rho & 15; return 8 * (i >> 2) + 4 * n + (i & 3); }
struct Unit { int pm, pn, aux, tl; const char* A; const char* B; };
typedef f32x4 Acc[2][2][4][2];
typedef int u32x4_i __attribute__((ext_vector_type(4)));

typedef int v8i32 __attribute__((ext_vector_type(8)));
template <class Epi, class Sched, bool FP8 = false>
__device__ __forceinline__ void gemm_phase(LAS unsigned char* lds, const int Kb, const Sched& S, const Epi& E) {
    const int tid = threadIdx.x, wid = __builtin_amdgcn_readfirstlane(tid >> 6), lane = tid & 63, wr = wid >> 2, wc = wid & 3, fr = lane & 15, fq = lane >> 4;
    const int nt = Sched::SEG ? 2 * Sched::SEG : Kb / 128;
    int RA[2], CA[2]; unsigned voffB[2];
#pragma unroll
    for (int i = 0; i < 2; ++i) { int R, C; stage_rc(tid * 16 + i * 8192, R, C); const int Rb = Epi::PERM ? ((R & ~31) + perm32(R & 31)) : R;
        RA[i] = R; CA[i] = C; voffB[i] = (unsigned)(Rb * Kb + C * 2); }
    const size_t kstep = (size_t)(BK * 2);
    const size_t hstep = (size_t)HALF * Kb;
    const unsigned ldsw = (unsigned)wid * 1024u;
    const int aoff = lds_byte(wr * 64 + fr, fq * 8), boff = lds_byte(wc * 32 + fr, fq * 8);
#define PG8_SA(b, h) (((b) * 2 + (h)) * HTB)
#define PG8_SB(b, h) ((4 + (b) * 2 + (h)) * HTB)
#define PG8_STAGE(bufoff, gbase, voff) do { _Pragma("unroll") for (int _i = 0; _i < 2; ++_i) \
        __builtin_amdgcn_global_load_lds((const unsigned*)((const char*)(gbase) + (voff)[_i]), (LAS unsigned*)(lds + (bufoff) + ldsw + _i * 8192), 16, 0, 0); } while (0)
#define PG8_LDA(dst, b, h) do { _Pragma("unroll") for (int m = 0; m < 4; ++m) _Pragma("unroll") for (int k = 0; k < 2; ++k) dst[m][k] = *(const LAS bf16x8*)(lds + PG8_SA(b, h) + aoff + m * 2048 + k * 1024); } while (0)
#define PG8_LDB(dst, b, h) do { _Pragma("unroll") for (int n = 0; n < 2; ++n) _Pragma("unroll") for (int k = 0; k < 2; ++k) dst[n][k] = *(const LAS bf16x8*)(lds + PG8_SB(b, h) + boff + n * 2048 + k * 1024); } while (0)
#define PG8_MMA(ai, bj, At, Bt) do { __builtin_amdgcn_s_setprio(1); _Pragma("unroll") for (int m = 0; m < 4; ++m) _Pragma("unroll") for (int n = 0; n < 2; ++n) { \
        if constexpr (FP8) { const v8i32 bq = __builtin_shufflevector(__builtin_bit_cast(u32x4_i, Bt[n][0]), __builtin_bit_cast(u32x4_i, Bt[n][1]), 0, 1, 2, 3, 4, 5, 6, 7), \
                                         aq = __builtin_shufflevector(__builtin_bit_cast(u32x4_i, At[m][0]), __builtin_bit_cast(u32x4_i, At[m][1]), 0, 1, 2, 3, 4, 5, 6, 7); \
            asm volatile("v_mfma_scale_f32_16x16x128_f8f6f4 %0, %1, %2, %0, %3, %3 op_sel_hi:[0,0,0]" : "+v"(acc[ai][bj][m][n]) : "v"(bq), "v"(aq), "v"(scale1)); } \
        else { _Pragma("unroll") for (int k = 0; k < 2; ++k) acc[ai][bj][m][n] = __builtin_amdgcn_mfma_f32_16x16x32_bf16(Bt[n][k], At[m][k], acc[ai][bj][m][n], 0, 0, 0); } } \
        __builtin_amdgcn_s_setprio(0); } while (0)
#define PG8_WAIT_V(n) asm volatile("s_waitcnt vmcnt(" #n ")" ::: "memory")
#define PG8_WAIT_L(n) asm volatile("s_waitcnt lgkmcnt(" #n ")" ::: "memory")
#define PG8_BAR __builtin_amdgcn_s_barrier()
#define PG8_SCHED __builtin_amdgcn_sched_barrier(0)
    int scale1 = 0x7f7f7f7f; asm volatile("" : "+v"(scale1));
    Unit cur, nxt; int ui = 0;
    if (!S.next(0, cur)) return;
    unsigned ca[2][2], na[2][2];
    S.aoff(cur, RA, CA, ca);
    f32x4 acc[2][2][4][2];
#pragma unroll
    for (int a = 0; a < 2; ++a)
#pragma unroll
        for (int b = 0; b < 2; ++b)
#pragma unroll
            for (int m = 0; m < 4; ++m)
#pragma unroll
                for (int n = 0; n < 2; ++n) acc[a][b][m][n] = (f32x4){0.f, 0.f, 0.f, 0.f};
    bf16x8 At[4][2], B0[2][2], B1[2][2];
    const char* cA = cur.A; const char* cB = cur.B;
    E.prefetch(cur, 0, wid, lane);
    PG8_STAGE(PG8_SB(0, 0), cB, voffB); PG8_STAGE(PG8_SB(0, 1), cB + hstep, voffB); PG8_STAGE(PG8_SA(0, 0), cA, ca[0]); PG8_STAGE(PG8_SA(0, 1), cA, ca[1]);
    if (wr == 1) PG8_BAR;
    PG8_WAIT_V(2); PG8_BAR;
    PG8_STAGE(PG8_SB(1, 0), cB + kstep, voffB); PG8_STAGE(PG8_SA(1, 0), cA + kstep, ca[0]); PG8_STAGE(PG8_SB(1, 1), cB + hstep + kstep, voffB);
    PG8_WAIT_V(6); PG8_BAR;
    for (;;) {
        const bool has_next = S.next(ui + 1, nxt);
        if constexpr (Sched::GATHER) {
            if (has_next) S.aoff(nxt, RA, CA, na);
            else {
#pragma unroll
                for (int h = 0; h < 2; ++h)
#pragma unroll
                    for (int i = 0; i < 2; ++i) na[h][i] = ca[h][i];
            }
        }
        const char* nA = has_next ? nxt.A : cA; const char* nB = has_next ? nxt.B : cB;
#pragma nounroll
        for (int t = 0; t < nt; t += 2) {
            const bool last = (t == nt - 2);
            if constexpr (Sched::SEG > 0) { if (t == Sched::SEG) { int fr_ = fr, fq_ = fq; asm volatile("" : "+v"(fr_), "+v"(fq_)); E.mid(acc, cur, wr, wc, fr_, fq_); } }
            const size_t sA1 = (Sched::SEG && t + 1 >= Sched::SEG) ? S.dA : 0, sA2 = (Sched::SEG && t + 2 >= Sched::SEG) ? S.dA : 0, sB2 = (Sched::SEG && t + 2 >= Sched::SEG) ? S.dB : 0;
            const char* a1 = cA + (size_t)(t + 1) * kstep + sA1;
            const char* a2 = last ? nA : cA + (size_t)(t + 2) * kstep + sA2; const char* b2 = last ? nB : cB + (size_t)(t + 2) * kstep + sB2;
            const char* a3 = a2 + kstep; const char* b3 = b2 + kstep;
            unsigned o2[2][2];
#pragma unroll
            for (int h = 0; h < 2; ++h)
#pragma unroll
                for (int i = 0; i < 2; ++i) { if constexpr (Sched::GATHER) o2[h][i] = last ? na[h][i] : ca[h][i]; else o2[h][i] = ca[h][i]; }
            PG8_LDB(B0, 0, 0); PG8_LDB(B1, 0, 1); PG8_SCHED; PG8_LDA(At, 0, 0); PG8_STAGE(PG8_SA(1, 1), a1, ca[1]);
            PG8_WAIT_V(8); PG8_WAIT_L(0); PG8_BAR; PG8_MMA(0, 0, At, B0); PG8_MMA(0, 1, At, B1); PG8_BAR; PG8_SCHED;
            PG8_LDA(At, 0, 1); PG8_STAGE(PG8_SB(0, 0), b2, voffB); PG8_STAGE(PG8_SB(0, 1), b2 + hstep, voffB); PG8_STAGE(PG8_SA(0, 0), a2, o2[0]);
            PG8_WAIT_V(8); PG8_WAIT_L(0); PG8_BAR; PG8_MMA(1, 0, At, B0); PG8_MMA(1, 1, At, B1); PG8_BAR; PG8_SCHED;
            PG8_LDB(B0, 1, 0); PG8_LDB(B1, 1, 1); PG8_SCHED; PG8_LDA(At, 1, 0); PG8_STAGE(PG8_SA(0, 1), a2, o2[1]);
            PG8_WAIT_V(8); PG8_WAIT_L(0); PG8_BAR; PG8_MMA(0, 0, At, B0); PG8_MMA(0, 1, At, B1); PG8_BAR; PG8_SCHED;
            PG8_LDA(At, 1, 1); PG8_STAGE(PG8_SB(1, 0), b3, voffB); PG8_STAGE(PG8_SB(1, 1), b3 + hstep, voffB); PG8_STAGE(PG8_SA(1, 0), a3, o2[0]);
            PG8_WAIT_V(8); PG8_WAIT_L(0); PG8_BAR; PG8_MMA(1, 0, At, B0); PG8_MMA(1, 1, At, B1); PG8_BAR; PG8_SCHED;
        }
        if constexpr (FP8) { asm volatile("s_nop 15\n\ts_nop 15\n\ts_nop 15" ::: "memory"); PG8_SCHED; }
        if (wr == 0) PG8_BAR;
        { int fr_ = fr, fq_ = fq; asm volatile("" : "+v"(fr_), "+v"(fq_));
          E(acc, cur, wr, wc, fr_, fq_, ui & 1);
          if (PROBE_PHASE == 50) E(acc, cur, wr, wc, fr_, fq_, ui & 1); }
        if (!has_next) break;
#pragma unroll
        for (int a = 0; a < 2; ++a)
#pragma unroll
            for (int b = 0; b < 2; ++b)
#pragma unroll
                for (int m = 0; m < 4; ++m)
#pragma unroll
                    for (int n = 0; n < 2; ++n) acc[a][b][m][n] = (f32x4){0.f, 0.f, 0.f, 0.f};
        cur = nxt; cA = nA; cB = nB; ++ui;
        E.prefetch(cur, ui & 1, wid, lane);
        if constexpr (Sched::GATHER) {
#pragma unroll
            for (int h = 0; h < 2; ++h)
#pragma unroll
                for (int i = 0; i < 2; ++i) ca[h][i] = na[h][i];
        }
        if (wr == 1) PG8_BAR;
    }
    PG8_WAIT_V(0);
    PG8_BAR;
#undef PG8_SA
#undef PG8_SB
#undef PG8_STAGE
#undef PG8_LDA
#undef PG8_LDB
#undef PG8_MMA
#undef PG8_WAIT_V
#undef PG8_WAIT_L
#undef PG8_BAR
#undef PG8_SCHED
}
}
#ifndef PROBE_PHASE
#define PROBE_PHASE (-1)
#endif
constexpr size_t SM_LIST = WS_SMALL + 2 * MiB;
constexpr size_t SM_WLIST = WS_SMALL + 6 * MiB;
constexpr size_t SM_RLIST = WS_SMALL + 10 * MiB;
constexpr int MT_PSTART = 256;
constexpr int MT_CNT = 512;
constexpr int MT_NACT = 768;
constexpr int MT_ATILE = 1024;
constexpr int MT_HIST = 4096;
constexpr int MT_BASE = 4224;
constexpr int MT_REC = 4352;
constexpr int MT_RSTD = 10496;
constexpr int MT_EPI = 11264;
constexpr int MT_EPI2 = 13312;
constexpr int MT_GAIN = 15360;
constexpr int MT_XCH = 16384;

__device__ __forceinline__ void moe_tables(LAS unsigned char* misc, const unsigned* cnt) {
    LAS int* pstart = (LAS int*)(misc + MT_PSTART); LAS int* cl = (LAS int*)(misc + MT_CNT); LAS int* at = (LAS int*)(misc + MT_ATILE);
    __syncthreads();
    if (threadIdx.x < 64) {
        const int lane = threadIdx.x, e = lane & 31;
        const int c = (int)__hip_atomic_load(cnt + e, __ATOMIC_RELAXED, __HIP_MEMORY_SCOPE_AGENT), nt = (c + 255) >> 8;
        int incl = nt;
#pragma unroll
        for (int o = 1; o < 32; o <<= 1) { const int v = __shfl_up(incl, o); if (e >= o) incl += v; }
        const int t0 = incl - nt;
        if (lane < 32) { cl[e] = c; pstart[e] = t0 << 8; for (int t = 0; t < nt; ++t) at[t0 + t] = (t0 + t) | (e << 12) | (t << 20);
            if (e == 31) { pstart[NE] = incl << 8; *(LAS int*)(misc + MT_NACT) = incl; } }
    }
    __syncthreads();
}

__device__ __forceinline__ void route_images(LAS unsigned char* lds, const float* __restrict__ g2, const float* __restrict__ wr) {
    const int tid = threadIdx.x;
    for (int idx = tid; idx < 128 * 32; idx += 512) {
        const int c = idx >> 5, e = idx & 31; float v[8]; unsigned hw[4], lw[4];
#pragma unroll
        for (int j = 0; j < 8; ++j) v[j] = wr[(size_t)(8 * c + j) * NE + e] * g2[8 * c + j];
#pragma unroll
        for (int j = 0; j < 4; ++j) { hw[j] = pk2(v[2 * j], v[2 * j + 1]); lw[j] = pk2(v[2 * j] - __uint_as_float(hw[j] << 16), v[2 * j + 1] - __uint_as_float(hw[j] & 0xffff0000u)); }
        *(LAS u32x4*)(lds + idx * 16) = (u32x4){hw[0], hw[1], hw[2], hw[3]};
        *(LAS u32x4*)(lds + 65536 + idx * 16) = (u32x4){lw[0], lw[1], lw[2], lw[3]};
    }
    __syncthreads();
}
__device__ __forceinline__ void route_phase(LAS unsigned char* lds, const bf16* __restrict__ h2, const float* __restrict__ g2, const float* __restrict__ wr, const float* __restrict__ br,
                                            unsigned char* __restrict__ xg8, int* __restrict__ tke, int* __restrict__ tkpos, float* __restrict__ tkw, int* __restrict__ list, float* __restrict__ wlist,
                                            float* __restrict__ rlist, unsigned* __restrict__ cnt, int G, int bx) {
    typedef float f32x16 __attribute__((ext_vector_type(16)));
    const int tid = threadIdx.x, lane = tid & 63, r32 = lane & 31, hi = lane >> 5; const int wave = __builtin_amdgcn_readfirstlane(tid >> 6);
    LAS unsigned char* misc = lds + MISC_OFF;
    LAS int* hist = (LAS int*)(misc + MT_HIST); LAS int* base = (LAS int*)(misc + MT_BASE); LAS int* rec = (LAS int*)(misc + MT_REC); LAS float* rstd_l = (LAS float*)(misc + MT_RSTD);
    const int tile = wave & 3, kh = wave >> 2;
    for (int tb = bx; tb < NTOK / 128; tb += G) {
        if (tid < 32) hist[tid] = 0;
        __syncthreads();
        {
        const int token = tb * 128 + tile * 32 + r32;
        const bf16* xp = h2 + (size_t)token * D + kh * 512 + 8 * hi;
        unsigned char* x8p = xg8 + (size_t)token * D + kh * 512 + 8 * hi;
        const float* gp = g2 + kh * 512 + 8 * hi;
        f32x16 c = {};
        float ss = 0.f;
        u32x4 xa[8];
#pragma unroll
        for (int p = 0; p < 8; ++p) xa[p] = *(const u32x4*)(xp + 16 * p);
#pragma unroll 1
        for (int ks0 = 0; ks0 < 32; ks0 += 8) {
#pragma unroll
            for (int p = 0; p < 8; ++p) {
                const int ks = ks0 + p;
                float xf[8]; unpack8(xa[p], xf); const f32x4 x0 = {xf[0], xf[1], xf[2], xf[3]}, x1 = {xf[4], xf[5], xf[6], xf[7]};
                const u32x4 xh = xa[p];
                if (ks + 8 < 32) xa[p] = *(const u32x4*)(xp + 16 * (ks + 8));
                ss += (x0[0] * x0[0] + x0[1] * x0[1]) + (x0[2] * x0[2] + x0[3] * x0[3]) + (x1[0] * x1[0] + x1[1] * x1[1]) + (x1[2] * x1[2] + x1[3] * x1[3]);
                { const f32x4 g0 = *(const f32x4*)(gp + 16 * ks), g1 = *(const f32x4*)(gp + 16 * ks + 4);
                  u32x2 w8; w8.x = pk4_fp8(x0[0] * g0[0], x0[1] * g0[1], x0[2] * g0[2], x0[3] * g0[3]); w8.y = pk4_fp8(x1[0] * g1[0], x1[1] * g1[1], x1[2] * g1[2], x1[3] * g1[3]);
                  *(u32x2*)(x8p + 16 * ks) = w8; }
                const int chunk = kh * 64 + 2 * ks + hi;
                const bf16x8 wh = *(const LAS bf16x8*)(lds + (chunk * 32 + r32) * 16), wl = *(const LAS bf16x8*)(lds + 65536 + (chunk * 32 + r32) * 16);
                c = __builtin_amdgcn_mfma_f32_32x32x16_bf16(wh, __builtin_bit_cast(bf16x8, xh), c, 0, 0, 0);
                c = __builtin_amdgcn_mfma_f32_32x32x16_bf16(wl, __builtin_bit_cast(bf16x8, xh), c, 0, 0, 0);
            }
        }
        LAS float* px = (LAS float*)(misc + MT_XCH);
        LAS float* sx = (LAS float*)(misc + MT_REC + tile * 1536);
        if (kh == 1) {
#pragma unroll
            for (int r = 0; r < 16; ++r) px[(tile * 16 + r) * 64 + lane] = c[r];
            sx[lane] = ss;
        }
        __syncthreads();
        if (kh == 0) {
#pragma unroll
            for (int r = 0; r < 16; ++r) c[r] += px[(tile * 16 + r) * 64 + lane];
            ss += sx[lane];
            ss += __shfl_xor(ss, 32);
            const float rstd = rsqrtf(ss * (1.0f / D) + EPS);
            float vals[16];
#pragma unroll
            for (int r = 0; r < 16; ++r) vals[r] = c[r] * rstd + br[(r & 3) + 8 * (r >> 2) + 4 * hi];
            float tv[4]; int te[4];
#pragma unroll
            for (int k = 0; k < 4; ++k) {
                float m = -3.0e38f; int mi = 0;
#pragma unroll
                for (int r = 0; r < 16; ++r) { const bool gt = vals[r] > m; m = gt ? vals[r] : m; mi = gt ? r : mi; }
                tv[k] = m; te[k] = (mi & 3) + 8 * (mi >> 2) + 4 * hi;
#pragma unroll
                for (int r = 0; r < 16; ++r) vals[r] = (r == mi) ? -3.0e38f : vals[r];
            }
            float cv[8]; int ce[8];
#pragma unroll
            for (int k = 0; k < 4; ++k) { cv[k] = tv[k]; ce[k] = te[k]; cv[4 + k] = __shfl_xor(tv[k], 32); ce[4 + k] = __shfl_xor(te[k], 32); }
            float fv[4]; int fe[4];
#pragma unroll
            for (int k = 0; k < 4; ++k) {
                float m = -3.0e38f; int me = 64; int mi = 0;
#pragma unroll
                for (int q = 0; q < 8; ++q) { const bool better = (cv[q] > m) || (cv[q] == m && ce[q] < me); m = better ? cv[q] : m; me = better ? ce[q] : me; mi = better ? q : mi; }
                fv[k] = m; fe[k] = me;
#pragma unroll
                for (int q = 0; q < 8; ++q) cv[q] = (q == mi) ? -3.0e38f : cv[q];
            }
            if (hi == 0) {
                const float e0 = 1.0f, e1 = __expf(fv[1] - fv[0]), e2 = __expf(fv[2] - fv[0]), e3 = __expf(fv[3] - fv[0]);
                const float inv = 1.0f / (e0 + e1 + e2 + e3);
                const float wts[4] = {e0 * inv, e1 * inv, e2 * inv, e3 * inv};
                const int tl = tile * 32 + r32;
                rstd_l[tl] = rstd;
#pragma unroll
                for (int k = 0; k < 4; ++k) {
                    const int lp = __hip_atomic_fetch_add(hist + fe[k], 1, __ATOMIC_RELAXED, __HIP_MEMORY_SCOPE_WORKGROUP);
                    LAS int* r = rec + (tl * 4 + k) * 3; r[0] = fe[k]; r[1] = lp; r[2] = __float_as_int(wts[k]);
                }
            }
        }
        }
        __syncthreads();
        if (tid < 32) base[tid] = (int)atomicAdd(&cnt[tid], (unsigned)hist[tid]);
        __syncthreads();
        { const int tl = tid >> 2; const int tok = tb * 128 + tl; LAS int* r = rec + tid * 3; const int e = r[0], pos = base[e] + r[1]; const float w = __int_as_float(r[2]);
          tke[tok * 4 + (tid & 3)] = e; tkpos[tok * 4 + (tid & 3)] = pos; tkw[tok * 4 + (tid & 3)] = w;
          list[e * NTOK + pos] = tok; wlist[e * NTOK + pos] = w; rlist[e * NTOK + pos] = rstd_l[tl]; }
        __syncthreads();
    }
}

__device__ __forceinline__ void combine_phase(LAS unsigned char* misc, const bf16* __restrict__ h2b, float* __restrict__ out, const unsigned char* __restrict__ rows, const int* __restrict__ tke, const int* __restrict__ tkpos, int gw, int NGW, int lane) {
    LAS const int* pstart = (LAS const int*)(misc + MT_PSTART);
    for (int token = gw; token < NTOK; token += NGW) {
        int rr[4];
#pragma unroll
        for (int k = 0; k < 4; ++k) rr[k] = pstart[tke[token * 4 + k]] + tkpos[token * 4 + k];
        f32x4* o = (f32x4*)(out + (size_t)token * D) + lane;
        const u32x2* hp = (const u32x2*)(h2b + (size_t)token * D) + lane;
        f32x4 v[4], s[4];
#pragma unroll
        for (int j = 0; j < 4; ++j) { const u32x2 w = __builtin_nontemporal_load(hp + 64 * j);
            v[j] = (f32x4){__uint_as_float(w.x << 16), __uint_as_float(w.x & 0xffff0000u), __uint_as_float(w.y << 16), __uint_as_float(w.y & 0xffff0000u)}; s[j] = (f32x4){0.f, 0.f, 0.f, 0.f}; }
#pragma unroll
        for (int k = 0; k < 4; ++k) {
            const unsigned* rp = (const unsigned*)(rows + (size_t)rr[k] * D) + lane;
#pragma unroll
            for (int j = 0; j < 4; ++j) { const unsigned w = __builtin_nontemporal_load(rp + 64 * j);
                const f32x2 lo = __builtin_amdgcn_cvt_pk_f32_fp8((int)w, false), hh = __builtin_amdgcn_cvt_pk_f32_fp8((int)w, true);
                s[j][0] += lo[0]; s[j][1] += lo[1]; s[j][2] += hh[0]; s[j][3] += hh[1]; }
        }
#pragma unroll
        for (int j = 0; j < 4; ++j) __builtin_nontemporal_store(v[j] + s[j] * ROW8_INV, o + 64 * j);
    }
}
struct SchedDense {
    static constexpr bool GATHER = false; static constexpr int SEG = 0; size_t dA = 0, dB = 0; int rev = 0;
    const char* A; const char* Bt; int K, nM, nN, nwg, G, c;
    __device__ void init(const bf16* A_, const bf16* Bt_, int M, int N, int K_, int G_, int c_) { A = (const char*)A_; Bt = (const char*)Bt_; K = K_; nM = M / 256; nN = N / 256; nwg = nM * nN; G = G_; c = c_; }
    __device__ __forceinline__ bool next(int i, pg8::Unit& u) const {
        const long L = (long)i * G + c; if (L >= nwg) return false;
        int wgid = (int)L; { const int q = nwg / 8, r = nwg % 8, xcd = wgid % 8, off = wgid / 8; wgid = (xcd < r ? xcd * (q + 1) : r * (q + 1) + (xcd - r) * q) + off; }
        const int nig = 8 * nN, gid = wgid / nig, fm = gid * 8, gsz = (nM - fm) < 8 ? (nM - fm) : 8;
        u.pm = fm + ((wgid % nig) % gsz); u.pn = (wgid % nig) / gsz; if (rev) u.pn = nN - 1 - u.pn; u.aux = 0; u.tl = 0;
        u.A = A + (size_t)u.pm * 256 * K * 2; u.B = Bt + (size_t)u.pn * 256 * K * 2; return true;
    }
    __device__ __forceinline__ void aoff(const pg8::Unit&, const int (&R)[2], const int (&C)[2], unsigned (&o)[2][2]) const {
#pragma unroll
        for (int h = 0; h < 2; ++h)
#pragma unroll
            for (int i = 0; i < 2; ++i) o[h][i] = (unsigned)((128 * h + R[i]) * K + C[i]) * 2u;
    }
};
struct SchedBranch2 : SchedDense { static constexpr int SEG = 16; };
template <bool GATHER_, int NPN>
struct SchedMoe {
    static constexpr bool GATHER = GATHER_; static constexpr int SEG = 0; static constexpr size_t dA = 0, dB = 0;
    const char* A; const char* Bt; LAS const unsigned char* misc; const int* list; int G, c;
    __device__ __forceinline__ bool next(int i, pg8::Unit& u) const {
        LAS const int* cl = (LAS const int*)(misc + MT_CNT); LAS const int* ps = (LAS const int*)(misc + MT_PSTART);
        if ((G & 7) == 0) {
            const int x = c & 7, r = c >> 3, n = G >> 3;
            int k = (i * n + r) / NPN; const int pn = (i * n + r) % NPN;
#pragma unroll
            for (int j = 0; j < 4; ++j) { const int e = x + 8 * j, nt = (cl[e] + 255) >> 8;
                if (k < nt) { u.pn = pn; u.aux = e; u.tl = k; u.pm = (ps[e] >> 8) + k;
                    u.A = GATHER ? A : A + (size_t)u.pm * 256 * 1024; u.B = Bt + ((size_t)e * NPN + pn) * 256 * 1024; return true; }
                k -= nt; }
            return false;
        }
        const int nact = *(LAS const int*)(misc + MT_NACT);
        const int L = i * G + c; if (L >= nact * NPN) return false;
        const int k = L / NPN; u.pn = L % NPN; const int w = ((LAS const int*)(misc + MT_ATILE))[k];
        u.pm = w & 0xfff; u.aux = (w >> 12) & 0xff; u.tl = w >> 20;
        u.A = GATHER ? A : A + (size_t)u.pm * 256 * 1024;
        u.B = Bt + ((size_t)u.aux * NPN + u.pn) * 256 * 1024; return true;
    }
    __device__ __forceinline__ void aoff(const pg8::Unit& u, const int (&R)[2], const int (&C)[2], unsigned (&o)[2][2]) const {
        const int ce = ((LAS const int*)(misc + MT_CNT))[u.aux];
#pragma unroll
        for (int h = 0; h < 2; ++h)
#pragma unroll
            for (int i = 0; i < 2; ++i) {
                if (GATHER) { const int idx = u.tl * 256 + 128 * h + R[i]; const int tok = (idx < ce) ? list[u.aux * NTOK + idx] : 0; o[h][i] = (unsigned)tok * 1024u + (unsigned)C[i] * 2u; }
                else o[h][i] = (unsigned)((128 * h + R[i]) * 1024 + C[i] * 2);
            }
    }
};

struct EpiProj {
    static constexpr bool PERM = true;
    __device__ __forceinline__ void prefetch(const pg8::Unit&, int, int, int) const {}
    bf16* proj; LAS const float* gtab;
    __device__ __forceinline__ void operator()(pg8::Acc& acc, const pg8::Unit& u, int wr, int wc, int fr, int fq, int slot) const {
        const int pn = u.pn;
        int mode;
        if (pn < 4) mode = 1; else if (pn == 4) mode = (wc < 2) ? 2 : 0; else if (pn < 7) mode = 0; else if (pn < 9) mode = 3; else if (pn < 13) mode = 0; else if (pn < 17) mode = 4; else mode = 5;
        float gn[2][8];
        if (mode == 1 || mode == 2) { LAS const float* g = gtab + ((mode == 1) ? 0 : 64);
#pragma unroll
            for (int bj = 0; bj < 2; ++bj)
#pragma unroll
                for (int j = 0; j < 8; ++j) gn[bj][j] = g[32 * bj + 8 * fq + j]; }
#pragma unroll
        for (int ai = 0; ai < 2; ++ai)
#pragma unroll
            for (int m = 0; m < 4; ++m) {
                const int r = u.pm * 256 + ai * 128 + wr * 64 + m * 16 + fr;
                bf16* rowp = proj + (size_t)r * INW + pn * 256 + wc * 64 + 8 * fq;
                f32x4 v[2][2];
#pragma unroll
                for (int bj = 0; bj < 2; ++bj) { v[bj][0] = acc[ai][bj][m][0]; v[bj][1] = acc[ai][bj][m][1]; }
                if (mode == 1 || mode == 2) {
                    float ss = 0.f;
#pragma unroll
                    for (int bj = 0; bj < 2; ++bj)
#pragma unroll
                        for (int n = 0; n < 2; ++n) ss += v[bj][n][0] * v[bj][n][0] + v[bj][n][1] * v[bj][n][1] + v[bj][n][2] * v[bj][n][2] + v[bj][n][3] * v[bj][n][3];
                    ss += __shfl_xor(ss, 16); ss += __shfl_xor(ss, 32);
                    const float rs = rsqrtf(ss * (1.0f / 64.0f) + EPS);
#pragma unroll
                    for (int bj = 0; bj < 2; ++bj)
#pragma unroll
                        for (int n = 0; n < 2; ++n)
#pragma unroll
                            for (int i = 0; i < 4; ++i) v[bj][n][i] = v[bj][n][i] * rs * gn[bj][4 * n + i];
                } else if (mode == 3) {
#pragma unroll
                    for (int bj = 0; bj < 2; ++bj)
#pragma unroll
                        for (int n = 0; n < 2; ++n) v[bj][n] = v[bj][n] * 0.08838834764831845f;
                } else if (mode == 4) {
#pragma unroll
                    for (int bj = 0; bj < 2; ++bj)
#pragma unroll
                        for (int n = 0; n < 2; ++n)
#pragma unroll
                            for (int i = 0; i < 4; ++i) { const float x = v[bj][n][i]; v[bj][n][i] = x * sigmoidf_(x); }
                } else if (mode == 5) {
#pragma unroll
                    for (int bj = 0; bj < 2; ++bj)
#pragma unroll
                        for (int n = 0; n < 2; ++n)
#pragma unroll
                            for (int i = 0; i < 4; ++i) v[bj][n][i] = sigmoidf_(v[bj][n][i]);
                }
#pragma unroll
                for (int bj = 0; bj < 2; ++bj) *(u32x4*)(rowp + 32 * bj) = pack8(v[bj][0], v[bj][1]);
            }
    }
};
struct EpiBranch2 {
    static constexpr bool PERM = true;
    __device__ __forceinline__ void prefetch(const pg8::Unit&, int, int, int) const {}
    bf16* merged; const bf16* proj;
    __device__ __forceinline__ void mid(pg8::Acc& acc, const pg8::Unit& u, int wr, int wc, int fr, int fq) const {
#pragma unroll
        for (int ai = 0; ai < 2; ++ai)
#pragma unroll
            for (int mp = 0; mp < 2; ++mp) {
                u32x4 ga[2][2], gr[2][2];
#pragma unroll
                for (int mm = 0; mm < 2; ++mm)
#pragma unroll
                    for (int bj = 0; bj < 2; ++bj) {
                        const bf16* gp = proj + (size_t)(u.pm * 256 + ai * 128 + wr * 64 + (2 * mp + mm) * 16 + fr) * INW + u.pn * 256 + bj * 128 + wc * 32 + 8 * fq;
                        ga[mm][bj] = *(const u32x4*)(gp + C_GA); gr[mm][bj] = *(const u32x4*)(gp + C_GR);
                    }
#pragma unroll
                for (int mm = 0; mm < 2; ++mm)
#pragma unroll
                    for (int bj = 0; bj < 2; ++bj) {
                        const int m = 2 * mp + mm; float a[8], r[8]; unpack8(ga[mm][bj], a); unpack8(gr[mm][bj], r);
#pragma unroll
                        for (int i = 0; i < 4; ++i) { acc[ai][bj][m][0][i] *= a[i] * __builtin_amdgcn_rcpf(fmaxf(r[i], 1e-20f)); acc[ai][bj][m][1][i] *= a[4 + i] * __builtin_amdgcn_rcpf(fmaxf(r[4 + i], 1e-20f)); }
                    }
            }
    }
    __device__ __forceinline__ void operator()(pg8::Acc& acc, const pg8::Unit& u, int wr, int wc, int fr, int fq, int slot) const {
#pragma unroll
        for (int ai = 0; ai < 2; ++ai)
#pragma unroll
            for (int mp = 0; mp < 2; ++mp) {
                u32x4 gr[2][2];
#pragma unroll
                for (int mm = 0; mm < 2; ++mm)
#pragma unroll
                    for (int bj = 0; bj < 2; ++bj)
                        gr[mm][bj] = *(const u32x4*)(proj + (size_t)(u.pm * 256 + ai * 128 + wr * 64 + (2 * mp + mm) * 16 + fr) * INW + C_GR + u.pn * 256 + bj * 128 + wc * 32 + 8 * fq);
#pragma unroll
                for (int mm = 0; mm < 2; ++mm)
#pragma unroll
                    for (int bj = 0; bj < 2; ++bj) {
                        const int m = 2 * mp + mm; float r[8]; unpack8(gr[mm][bj], r);
                        f32x4 a = acc[ai][bj][m][0], b = acc[ai][bj][m][1];
                        a[0] *= r[0]; a[1] *= r[1]; a[2] *= r[2]; a[3] *= r[3]; b[0] *= r[4]; b[1] *= r[5]; b[2] *= r[6]; b[3] *= r[7];
                        *(u32x4*)(merged + (size_t)(u.pm * 256 + ai * 128 + wr * 64 + m * 16 + fr) * D + u.pn * 256 + bj * 128 + wc * 32 + 8 * fq) = pack8(a, b);
                    }
            }
    }
};
struct EpiOut {
    static constexpr bool PERM = true;
    __device__ __forceinline__ void prefetch(const pg8::Unit&, int, int, int) const {}
    const float* x; bf16* h2b;
    __device__ __forceinline__ void load(f32x4 (&xv)[2][2][2], const pg8::Unit& u, int q, int wr, int wc, int fr, int fq) const {
#pragma unroll
        for (int mm = 0; mm < 2; ++mm) { const size_t off = (size_t)(u.pm * 256 + (q >> 1) * 128 + wr * 64 + (2 * (q & 1) + mm) * 16 + fr) * D + u.pn * 256 + wc * 32 + 8 * fq;
#pragma unroll
            for (int bj = 0; bj < 2; ++bj)
#pragma unroll
                for (int n = 0; n < 2; ++n) xv[mm][bj][n] = *(const f32x4*)(x + off + bj * 128 + n * 4); }
    }
    __device__ __forceinline__ void operator()(pg8::Acc& acc, const pg8::Unit& u, int wr, int wc, int fr, int fq, int slot) const {
        f32x4 xA[2][2][2], xB[2][2][2];
        load(xA, u, 0, wr, wc, fr, fq);
#pragma unroll
        for (int q = 0; q < 4; ++q) {
            if (q < 3) { if (q & 1) load(xA, u, q + 1, wr, wc, fr, fq); else load(xB, u, q + 1, wr, wc, fr, fq); }
            const int ai = q >> 1;
#pragma unroll
            for (int mm = 0; mm < 2; ++mm) { const int m = 2 * (q & 1) + mm; const size_t off = (size_t)(u.pm * 256 + ai * 128 + wr * 64 + m * 16 + fr) * D + u.pn * 256 + wc * 32 + 8 * fq;
#pragma unroll
                for (int bj = 0; bj < 2; ++bj) {
                    const f32x4 a = ((q & 1) ? xB[mm][bj][0] : xA[mm][bj][0]) + acc[ai][bj][m][0], b = ((q & 1) ? xB[mm][bj][1] : xA[mm][bj][1]) + acc[ai][bj][m][1];
                    *(u32x4*)(h2b + off + bj * 128) = pack8(a, b); } }
        }
    }
};
struct EpiGU {
    static constexpr bool PERM = true;
    unsigned char* act; const float* bgu; const float* rlist; LAS unsigned char* misc;
    __device__ __forceinline__ void prefetch(const pg8::Unit& u, int slot, int wid, int lane) const {
        if (wid < 4) __builtin_amdgcn_global_load_lds((const unsigned*)(rlist + (size_t)u.aux * NTOK + u.tl * 256 + wid * 64 + lane), (LAS unsigned*)(misc + MT_EPI + slot * 1024 + wid * 256), 4, 0, 0);
        else __builtin_amdgcn_global_load_lds((const unsigned*)(bgu + (size_t)u.aux * 2048 + ((wid - 4) >> 1) * 1024 + u.pn * 128 + ((wid - 4) & 1) * 64 + lane), (LAS unsigned*)(misc + MT_EPI2 + slot * 1024 + (wid - 4) * 256), 4, 0, 0);
    }
    __device__ __forceinline__ void operator()(pg8::Acc& acc, const pg8::Unit& u, int wr, int wc, int fr, int fq, int slot) const {
        const int ce = ((LAS const int*)(misc + MT_CNT))[u.aux];
        const int col = u.pn * 128 + wc * 32 + 8 * fq;
        LAS const float* bl = (LAS const float*)(misc + MT_EPI2 + slot * 1024) + wc * 32 + 8 * fq;
        float bgate[8], bup[8];
#pragma unroll
        for (int j = 0; j < 8; ++j) { bgate[j] = bl[j]; bup[j] = bl[128 + j]; }
#pragma unroll
        for (int ai = 0; ai < 2; ++ai)
#pragma unroll
            for (int m = 0; m < 4; ++m) {
                const int lr = ai * 128 + wr * 64 + m * 16 + fr, r = u.pm * 256 + lr;
                const float rs = ((LAS const float*)(misc + MT_EPI + slot * 1024))[lr] * W8_INV;
                float o[8];
#pragma unroll
                for (int n = 0; n < 2; ++n)
#pragma unroll
                    for (int i = 0; i < 4; ++i) {
                        float gate = acc[ai][0][m][n][i] * rs + bgate[4 * n + i], up = acc[ai][1][m][n][i] * rs + bup[4 * n + i];
                        gate = fminf(gate, 7.0f); up = fminf(fmaxf(up, -7.0f), 7.0f);
                        o[4 * n + i] = (up + 1.0f) * gate * sigmoidf_(1.702f * gate);
                    }
                u32x2 w; w.x = pk4_fp8(o[0], o[1], o[2], o[3]); w.y = pk4_fp8(o[4], o[5], o[6], o[7]);
                *(u32x2*)(act + (size_t)r * DFF + col) = w;
            }
    }
};
struct EpiDown {
    static constexpr bool PERM = true;
    unsigned char* rows; const float* bdn; const float* wlist; LAS const unsigned char* misc;
    __device__ __forceinline__ void prefetch(const pg8::Unit& u, int slot, int wid, int lane) const {
        if (wid < 4) __builtin_amdgcn_global_load_lds((const unsigned*)(wlist + (size_t)u.aux * NTOK + u.tl * 256 + wid * 64 + lane), (LAS unsigned*)(misc + MT_EPI + slot * 1024 + wid * 256), 4, 0, 0);
        else __builtin_amdgcn_global_load_lds((const unsigned*)(bdn + (size_t)u.aux * D + u.pn * 256 + (wid - 4) * 64 + lane), (LAS unsigned*)(misc + MT_EPI2 + slot * 1024 + (wid - 4) * 256), 4, 0, 0);
    }
    __device__ __forceinline__ void operator()(pg8::Acc& acc, const pg8::Unit& u, int wr, int wc, int fr, int fq, int slot) const {
        const int ce = ((LAS const int*)(misc + MT_CNT))[u.aux];
#pragma unroll
        for (int ai = 0; ai < 2; ++ai)
#pragma unroll
            for (int m = 0; m < 4; ++m) {
                const int lr = ai * 128 + wr * 64 + m * 16 + fr, r = u.pm * 256 + lr, idx = u.tl * 256 + lr;
                const float w = (idx < ce) ? ((LAS const float*)(misc + MT_EPI + slot * 1024))[lr] * ROW8_SCALE : 0.f;
                LAS const float* bl = (LAS const float*)(misc + MT_EPI2 + slot * 1024) + wc * 32 + 8 * fq;
                asm volatile("" : "+v"(bl));
#pragma unroll
                for (int bj = 0; bj < 2; ++bj) {
                    const f32x4 b0 = *(const LAS f32x4*)(bl + bj * 128), b1 = *(const LAS f32x4*)(bl + bj * 128 + 4);
                    f32x4 a = acc[ai][bj][m][0], b = acc[ai][bj][m][1];
#pragma unroll
                    for (int i = 0; i < 4; ++i) { a[i] = (a[i] * W8_INV + b0[i]) * w; b[i] = (b[i] * W8_INV + b1[i]) * w; }
                    u32x2 o; o.x = pk4_fp8(a[0], a[1], a[2], a[3]); o.y = pk4_fp8(b[0], b[1], b[2], b[3]);
                    *(u32x2*)(rows + (size_t)r * D + u.pn * 256 + bj * 128 + wc * 32 + 8 * fq) = o;
                }
            }
    }
};
namespace attn {
typedef float f32x16 __attribute__((ext_vector_type(16)));
typedef short s16x4 __attribute__((ext_vector_type(4)));
constexpr int NK = 272, K_OFF = 0, V_OFF = 34816, WS_OFF = 69632, OST_OFF = 71680, LDS_END = OST_OFF + 8 * 4096;
constexpr float LOG2E = 1.4426950408889634f;
__device__ __forceinline__ s16x4 vtr(LAS const unsigned char* p) { return __builtin_bit_cast(s16x4, __builtin_amdgcn_ds_read_tr16_b64_v4i16((LAS s16x4*)p)); }
__device__ __forceinline__ int crowc(int r) { return (r & 3) + 8 * (r >> 2); }

template <int TYPE, bool DIAG>
__device__ __forceinline__ void tile(LAS const unsigned char* lds, int kbase, const bf16x8 (&qr)[4], f32x16 (&o)[2], float& l, float lanebase, float c1, int tt, int lane) {
    const int r32 = lane & 31, hi = lane >> 5;
    f32x16 p;
#pragma unroll
    for (int r = 0; r < 16; ++r) p[r] = __builtin_fmaf(c1, (float)crowc(r), lanebase);
#pragma unroll
    for (int d0 = 0; d0 < 4; ++d0) {
        const bf16x8 kf = *(const LAS bf16x8*)(lds + K_OFF + (2 * d0 + hi) * (NK * 16) + (kbase + r32) * 16);
        p = __builtin_amdgcn_mfma_f32_32x32x16_bf16(kf, qr[d0], p, 0, 0, 0);
    }
    constexpr int NR = (TYPE == 0) ? 8 : 16;
    float e[16];
#pragma unroll
    for (int r = 0; r < NR; ++r) {
        float v = __builtin_amdgcn_exp2f(p[r]);
        if (DIAG) { const bool ok = (TYPE == 1) ? (crowc(r) > tt) : (crowc(r) <= tt); v = ok ? v : 0.f; }
        e[r] = v; l += v;
    }
    constexpr int NS = (TYPE == 0) ? 1 : 2;
    u32x4 pw[2];
#pragma unroll
    for (int s = 0; s < NS; ++s) { pw[s].x = pk2(e[8 * s + 0], e[8 * s + 1]); pw[s].y = pk2(e[8 * s + 2], e[8 * s + 3]); pw[s].z = pk2(e[8 * s + 4], e[8 * s + 5]); pw[s].w = pk2(e[8 * s + 6], e[8 * s + 7]); }
    LAS const unsigned char* vb = lds + V_OFF + (kbase + 4 * hi + ((lane & 15) >> 2)) * 64 + ((lane >> 4) & 1) * 32 + (lane & 3) * 8;
#pragma unroll
    for (int d0 = 0; d0 < 2; ++d0)
#pragma unroll
        for (int s = 0; s < NS; ++s) {
            const s16x4 lo = vtr(vb + d0 * (NK * 64) + s * 1024), hh = vtr(vb + d0 * (NK * 64) + s * 1024 + 512);
            const bf16x8 vf = (bf16x8){lo[0], lo[1], lo[2], lo[3], hh[0], hh[1], hh[2], hh[3]};
            o[d0] = __builtin_amdgcn_mfma_f32_32x32x16_bf16(__builtin_bit_cast(bf16x8, pw[s]), vf, o[d0], 0, 0, 0);
        }
}

#define AT_ISSUE(u_) do { const int u__ = (u_); const int b_ = u__ >> 6, qb_ = (u__ >> 1) & 31, kvh_ = u__ & 1; \
        _Pragma("unroll") for (int i = 0; i < 5; ++i) { const int idx = tid + 512 * i; if (idx < NK * 8) { const int key = idx >> 3, c = idx & 7; const bf16* rowp; \
            if (key < 16) rowp = pmeta + (size_t)key * INW; else { int j = qb_ * 128 - 128 + (key - 16); if (j < 0) j = 0; rowp = proj + ((size_t)b_ * SEQ + j) * INW; } \
            pk[i] = *(const u32x4*)(rowp + C_AK + kvh_ * 64 + c * 8); pv[i] = *(const u32x4*)(rowp + C_AV + kvh_ * 64 + c * 8); } } } while (0)
#define AT_QLOAD(dst, a_) do { const size_t qrow_ = (size_t)b * SEQ + qb * 128 + 32 * (a_) + r32; \
        _Pragma("unroll") for (int d0 = 0; d0 < 4; ++d0) dst[d0] = *(const bf16x8*)(proj + qrow_ * INW + C_AQ + h * 64 + d0 * 16 + hi * 8); } while (0)
__device__ __forceinline__ void phase(LAS unsigned char* lds, const bf16* __restrict__ proj, const bf16* __restrict__ pmeta, const float* __restrict__ sinks, float bshift, bf16* __restrict__ yatt, int G, int bx) {
    const int tid = threadIdx.x, lane = tid & 63, r32 = lane & 31, hi = lane >> 5; const int wave = __builtin_amdgcn_readfirstlane(tid >> 6);
    constexpr int NU = NB * 32 * 2;
    if (bx >= NU) return;
    u32x4 pk[5], pv[5];
    AT_ISSUE(bx);
    for (int u = bx; u < NU; u += G) {
        const int b = u >> 6, qb = (u >> 1) & 31, kvh = u & 1;
#pragma unroll
        for (int i = 0; i < 5; ++i) { const int idx = tid + 512 * i; if (idx < NK * 8) { const int key = idx >> 3, c = idx & 7;
            *(LAS u32x4*)(lds + K_OFF + c * (NK * 16) + key * 16) = pk[i];
            *(LAS u32x4*)(lds + V_OFF + (c >> 2) * (NK * 64) + key * 64 + (c & 3) * 16) = pv[i]; } }
        if (u + G < NU) AT_ISSUE(u + G);
        const int h = kvh * 8 + wave;
        bf16x8 qr[4], qn[4];
        AT_QLOAD(qr, 0);
        __syncthreads();
        const float slope = exp2f(-0.5f * (float)(h + 1)), sink = sinks[h];
        const float M = fmaxf(bshift, sink);
        const float c1 = slope * LOG2E;
        LAS float* wsf = (LAS float*)(lds + WS_OFF) + wave * 64;
        LAS bf16* stg = (LAS bf16*)(lds + OST_OFF) + wave * 2048;
#pragma unroll 1
        for (int a = 0; a < 4; ++a) {
            if (a < 3) AT_QLOAD(qn, a + 1);
            f32x16 o[2]; o[0] = f32x16{}; o[1] = f32x16{};
            float l = 0.f;
            const int t = 32 * a + r32;
            const int tt = r32 - 4 * hi;
            const float hi4 = c1 * 4.0f * (float)hi;
            tile<0, false>(lds, 0, qr, o, l, -(slope * (float)(qb * 128 + t + 16) + M) * LOG2E + hi4, c1, tt, lane);
            if (qb > 0) {
                tile<1, true>(lds, 16 + 32 * a, qr, o, l, -(slope * (float)(128 + r32) + M) * LOG2E + hi4, c1, tt, lane);
                for (int bb = a + 1; bb < 4; ++bb) tile<1, false>(lds, 16 + 32 * bb, qr, o, l, -(slope * (float)(128 + t - 32 * bb) + M) * LOG2E + hi4, c1, tt, lane);
            }
            for (int bb = 0; bb < a; ++bb) tile<2, false>(lds, 144 + 32 * bb, qr, o, l, -(slope * (float)(t - 32 * bb) + M) * LOG2E + hi4, c1, tt, lane);
            tile<2, true>(lds, 144 + 32 * a, qr, o, l, -(slope * (float)r32 + M) * LOG2E + hi4, c1, tt, lane);
            l += __shfl_xor(l, 32);
            l += exp2f((sink - M) * LOG2E);
            if (hi == 0) wsf[r32] = l;
            LDS_WAIT();
            float rli[16];
#pragma unroll
            for (int r = 0; r < 16; ++r) rli[r] = __builtin_amdgcn_rcpf(wsf[crowc(r) + 4 * hi]);
#pragma unroll
            for (int r = 0; r < 16; ++r) { const int orow = crowc(r) + 4 * hi;
#pragma unroll
                for (int d0 = 0; d0 < 2; ++d0) stg[orow * 64 + d0 * 32 + r32] = f2bf(o[d0][r] * rli[r]); }
            LDS_WAIT();
            bf16* Ow = yatt + ((size_t)b * SEQ + qb * 128 + 32 * a) * D + h * 64;
#pragma unroll
            for (int i = 0; i < 4; ++i) { const int row = i * 8 + (lane >> 3), ch = lane & 7; const u32x4 v = *(const LAS u32x4*)(stg + row * 64 + ch * 8); *(u32x4*)(Ow + (size_t)row * D + ch * 8) = v; }
            LDS_WAIT();
#pragma unroll
            for (int d0 = 0; d0 < 4; ++d0) qr[d0] = qn[d0];
        }
        __syncthreads();
    }
}
#undef AT_ISSUE
#undef AT_QLOAD
}
namespace ret {
typedef float f32x16 __attribute__((ext_vector_type(16)));
typedef short s16x4 __attribute__((ext_vector_type(4)));
constexpr size_t WS_STATES = 893 * MiB;
__device__ __forceinline__ s16x4 vtr(LAS const unsigned char* p) { return __builtin_bit_cast(s16x4, __builtin_amdgcn_ds_read_tr16_b64_v4i16((LAS s16x4*)p)); }
__device__ __forceinline__ int crowc(int r) { return (r & 3) + 8 * (r >> 2); }
__device__ __forceinline__ float lg2gamma(int h) { return log2f(1.0f - exp2f(-5.0f - (float)h)); }

constexpr int R1_BUF = 40960;
#define RET_ISSUE(KR, VR, c_) do { const int ci__ = (c_); \
        _Pragma("unroll") for (int i = 0; i < 4; ++i) { const int idx = tid + 512 * i, key = idx >> 4, ch = idx & 15; \
            if (ci__ == 0) { KR[i] = (key >= 112) ? *(const u32x4*)(pmeta + (size_t)(key - 112) * INW + C_RK + h * 128 + ch * 8) : (u32x4){0u, 0u, 0u, 0u}; } \
            else KR[i] = *(const u32x4*)(proj + ((size_t)b * SEQ + (ci__ - 1) * 128 + key) * INW + C_RK + h * 128 + ch * 8); } \
        { const int key = tid >> 2, ch = tid & 3; \
          if (ci__ == 0) VR = (key >= 112) ? *(const u32x4*)(pmeta + (size_t)(key - 112) * INW + C_RV + h * 256 + dvs * 32 + ch * 8) : (u32x4){0u, 0u, 0u, 0u}; \
          else VR = *(const u32x4*)(proj + ((size_t)b * SEQ + (ci__ - 1) * 128 + key) * INW + C_RV + h * 256 + dvs * 32 + ch * 8); } } while (0)
#define RET_STEP(KR, VR, c_) do { const int c__ = (c_); LAS unsigned char* buf = lds + (c__ & 1) * R1_BUF; \
        _Pragma("unroll") for (int i = 0; i < 4; ++i) { const int idx = tid + 512 * i, key = idx >> 4, ch = idx & 15; *(LAS u32x4*)(buf + (ch >> 2) * (128 * 64) + key * 64 + (ch & 3) * 16) = KR[i]; } \
        { const int key = tid >> 2, ch = tid & 3; float f[8]; unpack8(VR, f); u32x4 w; \
          w.x = pk2(f[0] * vscale, f[1] * vscale); w.y = pk2(f[2] * vscale, f[3] * vscale); w.z = pk2(f[4] * vscale, f[5] * vscale); w.w = pk2(f[6] * vscale, f[7] * vscale); \
          *(LAS u32x4*)(buf + 32768 + key * 64 + ch * 16) = w; } \
        if (c__ + 2 < 32) RET_ISSUE(KR, VR, c__ + 2); \
        __syncthreads(); \
        if (wave < 4) { \
            const int dt = wave; \
            acc = acc * g128; \
            LAS const unsigned char* ab = buf + dt * (128 * 64) + (4 * hi + ((lane & 15) >> 2)) * 64 + ((lane >> 4) & 1) * 32 + (lane & 3) * 8; \
            LAS const unsigned char* bb = buf + 32768 + (4 * hi + ((lane & 15) >> 2)) * 64 + ((lane >> 4) & 1) * 32 + (lane & 3) * 8; \
            _Pragma("unroll") for (int ks = 0; ks < 8; ++ks) { \
                const s16x4 al = vtr(ab + ks * 1024), ah = vtr(ab + ks * 1024 + 512), bl = vtr(bb + ks * 1024), bh = vtr(bb + ks * 1024 + 512); \
                const bf16x8 af = (bf16x8){al[0], al[1], al[2], al[3], ah[0], ah[1], ah[2], ah[3]}, bfr = (bf16x8){bl[0], bl[1], bl[2], bl[3], bh[0], bh[1], bh[2], bh[3]}; \
                acc = __builtin_amdgcn_mfma_f32_32x32x16_bf16(af, bfr, acc, 0, 0, 0); } \
            bf16* sb = states + ((((size_t)(b * 4 + h) * 32 + c__) * 8 + dvs) * 8) * 512; \
            _Pragma("unroll") for (int g = 0; g < 4; ++g) { u32x2 w; w.x = pk2(acc[4 * g], acc[4 * g + 1]); w.y = pk2(acc[4 * g + 2], acc[4 * g + 3]); \
                *(u32x2*)(sb + (size_t)(2 * dt + (g >> 1)) * 512 + (32 * (g & 1) + (lane & 31)) * 8 + 4 * hi) = w; } \
        } } while (0)
__device__ __forceinline__ void state_chain(LAS unsigned char* lds, int b, int h, int dvs, const bf16* __restrict__ proj, const bf16* __restrict__ pmeta, bf16* __restrict__ states) {
    const int tid = threadIdx.x, lane = tid & 63, hi = lane >> 5; const int wave = __builtin_amdgcn_readfirstlane(tid >> 6);
    const float lg = lg2gamma(h), g128 = exp2f(lg * 128.0f);
    u32x4 kA[4], kB[4], vA, vB;
    const float vscale = exp2f(lg * (float)(127 - (tid >> 2)));
    f32x16 acc = {};
    RET_ISSUE(kA, vA, 0); RET_ISSUE(kB, vB, 1);
#pragma unroll 1
    for (int c = 0; c < 32; c += 2) { RET_STEP(kA, vA, c); RET_STEP(kB, vB, c + 1); }
    __syncthreads();
}
#undef RET_ISSUE
#undef RET_STEP

constexpr int R3_K = 0, R3_Q = 32768, R3_V = 65536;
#define R3_ISSUE(u_) do { const int u__ = (u_); const size_t rw = (size_t)(u__ >> 7) * SEQ + (u__ & 31) * 128; const int hh = (u__ >> 5) & 3; \
        _Pragma("unroll") for (int i = 0; i < 4; ++i) { const int idx = tid + 512 * i, key = idx >> 4, ch = idx & 15; \
            kq[i] = *(const u32x4*)(proj + (rw + key) * INW + C_RK + hh * 128 + ch * 8); kq[4 + i] = *(const u32x4*)(proj + (rw + key) * INW + C_RQ + hh * 128 + ch * 8); } \
        _Pragma("unroll") for (int i = 0; i < 8; ++i) { const int idx = tid + 512 * i, key = idx >> 5, ch = idx & 31; vv[i] = *(const u32x4*)(proj + (rw + key) * INW + C_RV + hh * 256 + ch * 8); } } while (0)
__device__ __forceinline__ void out_phase(LAS unsigned char* lds, const bf16* __restrict__ proj, const bf16* __restrict__ states, bf16* __restrict__ yret, int G, int bx, const XcdBarrier pre_bar, const bool do_bar) {
    const int tid = threadIdx.x, lane = tid & 63, r32 = lane & 31, hi = lane >> 5; const int wave = __builtin_amdgcn_readfirstlane(tid >> 6);
    constexpr int NU = NB * 4 * 32;
    if (bx >= NU) { if (do_bar) xcd_barrier(pre_bar); return; }
    u32x4 kq[8], vv[8];
    R3_ISSUE(bx);
    if (do_bar) xcd_barrier(pre_bar);
    for (int u = bx; u < NU; u += G) {
        const int b = u >> 7, h = (u >> 5) & 3, tb = u & 31;
        const float lg = lg2gamma(h);
        const size_t row0 = (size_t)b * SEQ + tb * 128;
#pragma unroll
        for (int i = 0; i < 4; ++i) { const int idx = tid + 512 * i, key = idx >> 4, ch = idx & 15;
            *(LAS u32x4*)(lds + R3_K + ch * 2048 + key * 16) = kq[i]; *(LAS u32x4*)(lds + R3_Q + ch * 2048 + key * 16) = kq[4 + i]; }
#pragma unroll
        for (int i = 0; i < 8; ++i) { const int idx = tid + 512 * i, key = idx >> 5, ch = idx & 31; *(LAS u32x4*)(lds + R3_V + (ch >> 2) * 8192 + key * 64 + (ch & 3) * 16) = vv[i]; }
        if (u + G < NU) R3_ISSUE(u + G);
        bf16x8 sf[8];
        { const bf16* sb = states + (((size_t)(b * 4 + h) * 32 + tb) * 64 + (size_t)wave * 8) * 512 + lane * 8;
#pragma unroll
          for (int k = 0; k < 8; ++k) sf[k] = *(const bf16x8*)(sb + (size_t)k * 512); }
        __syncthreads();
        u32x2 pw[2][4];
        for (int rp_ = 0; rp_ < ((PROBE_PHASE == 31) ? 2 : 1); ++rp_)
#pragma unroll
        for (int ti = 0; ti < 2; ++ti) {
            const int t = wave + 8 * ti;
            if (t < 10) {
                const int a = (t >= 6) ? 3 : (t >= 3) ? 2 : (t >= 1) ? 1 : 0, bb = t - ((a * (a + 1)) >> 1);
                f32x16 p = {};
#pragma unroll
                for (int k = 0; k < 8; ++k) {
                    const bf16x8 kf = *(const LAS bf16x8*)(lds + R3_K + (2 * k + hi) * 2048 + (32 * bb + r32) * 16);
                    const bf16x8 qf = *(const LAS bf16x8*)(lds + R3_Q + (2 * k + hi) * 2048 + (32 * a + r32) * 16);
                    p = __builtin_amdgcn_mfma_f32_32x32x16_bf16(kf, qf, p, 0, 0, 0);
                }
                const float lanebase = lg * (float)(32 * (a - bb) + r32 - 4 * hi), cpos = -lg; const int tt = r32 - 4 * hi;
                float e[16];
#pragma unroll
                for (int r = 0; r < 16; ++r) { float v = p[r] * __builtin_amdgcn_exp2f(__builtin_fmaf(cpos, (float)crowc(r), lanebase)); if (bb == a) v = (crowc(r) <= tt) ? v : 0.f; e[r] = v; }
#pragma unroll
                for (int g = 0; g < 4; ++g) { pw[ti][g].x = pk2(e[4 * g], e[4 * g + 1]); pw[ti][g].y = pk2(e[4 * g + 2], e[4 * g + 3]); }
            }
        }
        __builtin_amdgcn_sched_barrier(0);
        bf16x8 vf[8];
        { LAS const unsigned char* vb = lds + R3_V + wave * 8192 + (8 * hi + ((lane & 15) >> 2)) * 64 + ((lane >> 4) & 1) * 32 + (lane & 3) * 8;
#pragma unroll
          for (int ks = 0; ks < 8; ++ks) { const s16x4 lo = vtr(vb + ks * 1024), hh = vtr(vb + ks * 1024 + 256); vf[ks] = (bf16x8){lo[0], lo[1], lo[2], lo[3], hh[0], hh[1], hh[2], hh[3]}; } }
        __syncthreads();
#pragma unroll
        for (int ti = 0; ti < 2; ++ti) {
            const int t = wave + 8 * ti;
            if (t < 10) {
                const int a = (t >= 6) ? 3 : (t >= 3) ? 2 : (t >= 1) ? 1 : 0, bb = t - ((a * (a + 1)) >> 1);
#pragma unroll
                for (int g = 0; g < 4; ++g) *(LAS u32x2*)(lds + R3_K + (4 * bb + g) * 2048 + (32 * a + r32) * 16 + hi * 8) = pw[ti][g];
            }
        }
        __syncthreads();
        LAS bf16* stg = (LAS bf16*)(lds + R3_V);
        for (int rp_ = 0; rp_ < ((PROBE_PHASE == 32) ? 2 : 1); ++rp_)
#pragma unroll 1
        for (int a = 0; a < 4; ++a) {
            f32x16 o = {};
#pragma unroll
            for (int ks = 0; ks < 8; ++ks) if (ks < 2 * (a + 1)) {
                const bf16x8 pa = *(const LAS bf16x8*)(lds + R3_K + (2 * ks + hi) * 2048 + (32 * a + r32) * 16);
                o = __builtin_amdgcn_mfma_f32_32x32x16_bf16(pa, vf[ks], o, 0, 0, 0);
            }
            f32x16 x = {};
#pragma unroll
            for (int k = 0; k < 8; ++k) { const bf16x8 qa = *(const LAS bf16x8*)(lds + R3_Q + (2 * k + hi) * 2048 + (32 * a + r32) * 16); x = __builtin_amdgcn_mfma_f32_32x32x16_bf16(qa, sf[k], x, 0, 0, 0); }
#pragma unroll
            for (int r = 0; r < 16; ++r) {
                const float din = __builtin_amdgcn_exp2f(lg * (float)(32 * a + crowc(r) + 4 * hi + 1));
                { const int row = 32 * a + crowc(r) + 4 * hi, col = wave * 32 + r32;
                  stg[row * 256 + ((((col >> 3) ^ ((row & 3) << 2)) << 3) | (col & 7))] = f2bf(o[r] + din * x[r]); }
            }
        }
        int nl = lane; asm volatile("" : "+v"(nl));
        const int nrow = wave * 16 + (nl >> 2), c4 = nl & 3, sx = nrow & 3;
        const bf16* rgp = proj + (row0 + nrow) * INW + C_RG + h * 256 + c4 * 8;
        bf16* yp = yret + (row0 + nrow) * D + h * 256 + c4 * 8;
        LAS const bf16* sp = stg + nrow * 256 + c4 * 8;
        u32x4 rgv[8];
#pragma unroll
        for (int j = 0; j < 8; ++j) rgv[j] = *(const u32x4*)(rgp + 32 * j);
        __syncthreads();
        for (int rp_ = 0; rp_ < ((PROBE_PHASE == 33) ? 2 : 1); ++rp_) {
            float ss = 0.f;
#pragma unroll
            for (int j = 0; j < 8; ++j) { const u32x4 sw = *(const LAS u32x4*)(sp + 32 * (j ^ sx)); float f[8]; unpack8(sw, f);
#pragma unroll
                for (int i = 0; i < 8; ++i) ss += f[i] * f[i]; }
            ss += __shfl_xor(ss, 1); ss += __shfl_xor(ss, 2);
            const float rs = rsqrtf(ss * (1.0f / 256.0f) + EPS);
            asm volatile("" ::: "memory");
#pragma unroll
            for (int j = 0; j < 8; ++j) { const u32x4 sw = *(const LAS u32x4*)(sp + 32 * (j ^ sx)); float f[8], g[8]; unpack8(sw, f); unpack8(rgv[j], g); u32x4 w;
                w.x = pk2(f[0] * rs * g[0], f[1] * rs * g[1]); w.y = pk2(f[2] * rs * g[2], f[3] * rs * g[3]); w.z = pk2(f[4] * rs * g[4], f[5] * rs * g[5]); w.w = pk2(f[6] * rs * g[6], f[7] * rs * g[7]);
                *(u32x4*)(yp + 32 * j) = w; }
        }
        __syncthreads();
    }
}
#undef R3_ISSUE
}
template <bool FP8>
__device__ __forceinline__ void p0_item(const float* __restrict__ W, int K, int N, void* __restrict__ WT, int k0, int n0, int dst_row0, int lane) {
    const int kblk = lane >> 3, nq = lane & 7;
    const float* src = W + (size_t)(k0 + 16 * kblk) * N + n0 + 4 * nq;
    f32x4 v[16];
#pragma unroll
    for (int i = 0; i < 16; ++i) v[i] = __builtin_nontemporal_load((const f32x4*)(src + (size_t)i * N));
#pragma unroll
    for (int j = 0; j < 4; ++j) {
        const size_t row = (size_t)(dst_row0 + 4 * nq + j);
        if constexpr (FP8) {
            u32x4 o;
            o.x = pk4_fp8(v[0][j] * W8_SCALE, v[1][j] * W8_SCALE, v[2][j] * W8_SCALE, v[3][j] * W8_SCALE); o.y = pk4_fp8(v[4][j] * W8_SCALE, v[5][j] * W8_SCALE, v[6][j] * W8_SCALE, v[7][j] * W8_SCALE);
            o.z = pk4_fp8(v[8][j] * W8_SCALE, v[9][j] * W8_SCALE, v[10][j] * W8_SCALE, v[11][j] * W8_SCALE); o.w = pk4_fp8(v[12][j] * W8_SCALE, v[13][j] * W8_SCALE, v[14][j] * W8_SCALE, v[15][j] * W8_SCALE);
            *(u32x4*)((unsigned char*)WT + row * K + k0 + 16 * kblk) = o;
        } else {
            u32x4 a, b;
            a.x = pk2(v[0][j], v[1][j]); a.y = pk2(v[2][j], v[3][j]); a.z = pk2(v[4][j], v[5][j]); a.w = pk2(v[6][j], v[7][j]);
            b.x = pk2(v[8][j], v[9][j]); b.y = pk2(v[10][j], v[11][j]); b.z = pk2(v[12][j], v[13][j]); b.w = pk2(v[14][j], v[15][j]);
            bf16* d = (bf16*)WT + row * K + k0 + 16 * kblk;
            *(u32x4*)d = a; *(u32x4*)(d + 8) = b;
        }
    }
}
constexpr int I_IN = 8 * 200, I_SQ = 8 * 32, I_GU = 32 * 8 * 64, I_DN = 32 * 8 * 32, NITEMS = I_IN + 3 * I_SQ + I_GU + I_DN;
constexpr int G1_UNITS = ((NTOK + 256) / 256) * (INW / 256), G1_SHORT = 256 - (G1_UNITS % 256), MOVE_PER_WAVE = 5, NMOVE = (G1_UNITS % 256) ? G1_SHORT * 8 * MOVE_PER_WAVE : 0;
constexpr int NMOVE2 = 4064; static_assert(NITEMS - NMOVE - NMOVE2 >= I_IN + 3 * I_SQ + I_GU, "the P7-deferred items must all be w_down items");
constexpr int CW_Q = 1100;
#define P0_DISPATCH(it_) do { int r = (it_); \
    if (r < I_IN) { const int kb = r / 200, nb = r % 200, n0 = nb * 32, o = n0 & 255, wcc = o >> 6, bj = (o >> 5) & 1; \
        p0_item<false>(w_in, D, INW, Win_t, kb * 128, n0, (n0 & ~255) + 128 * bj + 32 * wcc, lane); break; } \
    r -= I_IN; \
    if (r < I_SQ) { p0_item<false>(w_ab, D, D, Wab_t, (r / 32) * 128, (r % 32) * 32, (r % 32) * 32, lane); break; } r -= I_SQ; \
    if (r < I_SQ) { p0_item<false>(w_rb, D, D, Wrb_t, (r / 32) * 128, (r % 32) * 32, (r % 32) * 32, lane); break; } r -= I_SQ; \
    if (r < I_SQ) { p0_item<false>(w_out, D, D, Wout_t, (r / 32) * 128, (r % 32) * 32, (r % 32) * 32, lane); break; } r -= I_SQ; \
    if (r < I_GU) { const int e = r / 512, q = r % 512, kb = q / 64, nb = q % 64, n0 = nb * 32, bj = n0 >> 10, rem = n0 & 1023, pn = rem >> 7, cl = rem & 127; \
        p0_item<true>(w_gu + (size_t)e * D * 2048, D, 2048, Wgu_t + (size_t)e * 2048 * D, kb * 128, n0, 256 * pn + 128 * bj + cl, lane); break; } \
    r -= I_GU; \
    { const int e = r / 256, q = r % 256, kb = q / 32, nb = q % 32; \
      p0_item<true>(w_dn + (size_t)e * DFF * D, DFF, D, Wdn_t + (size_t)e * D * DFF, kb * 128, nb * 32, nb * 32, lane); } } while (0)
#ifndef PROBE_PHASE
#define PROBE_PHASE (-1)
#endif
__device__ __forceinline__ void p0_transpose_item_fp8(const float* W, int K, int N, unsigned char* WT, int k0, int n0, int dst_row0, LAS float* scr, int lane) {
#pragma unroll 8
    for (int i = 0; i < 32; ++i) { const int kk = 2 * i + (lane >> 5); scr[kk * 33 + (lane & 31)] = W[(size_t)(k0 + kk) * N + n0 + (lane & 31)]; }
    LDS_WAIT(); asm volatile("" ::: "memory");
    const int c = lane & 3;
#pragma unroll
    for (int j = 0; j < 2; ++j) { const int n = (lane >> 2) + 16 * j; const LAS float* s = scr + (16 * c) * 33 + n;
        u32x4 o;
        o.x = pk4_fp8(s[0 * 33] * W8_SCALE, s[1 * 33] * W8_SCALE, s[2 * 33] * W8_SCALE, s[3 * 33] * W8_SCALE); o.y = pk4_fp8(s[4 * 33] * W8_SCALE, s[5 * 33] * W8_SCALE, s[6 * 33] * W8_SCALE, s[7 * 33] * W8_SCALE);
        o.z = pk4_fp8(s[8 * 33] * W8_SCALE, s[9 * 33] * W8_SCALE, s[10 * 33] * W8_SCALE, s[11 * 33] * W8_SCALE); o.w = pk4_fp8(s[12 * 33] * W8_SCALE, s[13 * 33] * W8_SCALE, s[14 * 33] * W8_SCALE, s[15 * 33] * W8_SCALE);
        *(u32x4*)(WT + (size_t)(dst_row0 + n) * K + k0 + 16 * c) = o; }
    LDS_WAIT(); asm volatile("" ::: "memory");
}
struct Args { const float* in[17]; float* out; unsigned char* ws; int ph_lo, ph_hi, li, pad; };

__global__ void __launch_bounds__(512, 2) mk_fwd(Args args) {
    extern __shared__ __attribute__((aligned(16))) unsigned char lds_raw[];
    LAS unsigned char* lds = (LAS unsigned char*)lds_raw;
    volatile LAS unsigned* MISC = (volatile LAS unsigned*)(lds + MISC_OFF);
    const int tid = threadIdx.x, lane = tid & 63, wave = __builtin_amdgcn_readfirstlane(tid >> 6);
    const int G = gridDim.x, bx = blockIdx.x;
    const int vcu = (G % 8 == 0) ? (bx % 8) * (G / 8) + bx / 8 : bx;
    unsigned char* ws = args.ws;
    unsigned* ctl = (unsigned*)(ws + WS_CTL);
    const float* x = args.in[0]; const float* meta = args.in[1]; const float* g1 = args.in[2]; const float* w_in = args.in[3];
    const float* qg = args.in[4]; const float* kg = args.in[5];
    const float* w_ab = args.in[7]; const float* w_rb = args.in[8]; const float* w_out = args.in[9];
    const float* w_gu = args.in[13]; const float* b_gu = args.in[14]; const float* w_dn = args.in[15]; const float* b_dn = args.in[16];
    float* out = args.out;
    bf16* Win_t = (bf16*)(ws + WS_WIN); bf16* Wab_t = (bf16*)(ws + WS_WAB); bf16* Wrb_t = (bf16*)(ws + WS_WRB); bf16* Wout_t = (bf16*)(ws + WS_WOUT);
    unsigned char* Wgu_t = ws + WS_WGU; unsigned char* Wdn_t = ws + WS_WDN;
    bf16* xb = (bf16*)(ws + WS_XB); bf16* proj = (bf16*)(ws + WS_PROJ); bf16* yatt = (bf16*)(ws + WS_YATT); bf16* yret = (bf16*)(ws + WS_YRET); bf16* merged = (bf16*)(ws + WS_MERGED);
    bf16* pmeta = proj + (size_t)NTOK * INW;
    const float* sinks = args.in[6]; const float* g2 = args.in[10]; const float* w_r = args.in[11]; const float* b_r = args.in[12];
    int* tke = (int*)(ws + SM_TKE); float* tkw = (float*)(ws + SM_TKW); int* tkpos = (int*)(ws + SM_TKPOS); int* list = (int*)(ws + SM_LIST); float* wlist = (float*)(ws + SM_WLIST); float* rlist = (float*)(ws + SM_RLIST);
    LAS unsigned char* misc = lds + MISC_OFF;
    bf16* states = (bf16*)(ws + ret::WS_STATES);
    bf16* h2b = (bf16*)(ws + ret::WS_STATES);
    unsigned char* act = ws + WS_ACT; unsigned char* rows = ws + WS_ROWS; unsigned char* xn8 = ws + WS_XB;

    for (int u = tid; u < (LDS_BYTES - MISC_OFF) / 4; u += 512) ((LAS unsigned*)(lds + MISC_OFF))[u] = 0u;
    __syncthreads();
    XcdBarrier bar = xcd_barrier_post(ctl + CW_BAR + args.li * XCD_BAR_WORDS, MISC + 8);
    const int lo = args.ph_lo, hi = args.ph_hi;
#define IN(k) (lo <= (k) && (k) < hi)
#define BOTH(k) (IN(k) && IN((k) + 1))
#define GRID_BAR() xcd_barrier(bar)

    if (IN(0)) { for (int rep_ = 0; rep_ < ((PROBE_PHASE == 0) ? 2 : 1); ++rep_) {
        const int gw = vcu * NWAVES + wave, NGW = G * NWAVES;
        for (int it = gw; it < NITEMS - NMOVE - NMOVE2; it += NGW) { P0_DISPATCH(it); }
        for (int rep2_ = 0; rep2_ < ((PROBE_PHASE == 101) ? 2 : 1); ++rep2_)
        for (int row = gw; row < NTOK; row += NGW) {
            const f32x4* xr = (const f32x4*)(x + (size_t)row * D) + lane;
            f32x4 v[4]; float ss = 0.f;
#pragma unroll
            for (int j = 0; j < 4; ++j) { v[j] = xr[64 * j]; ss += (v[j][0] * v[j][0] + v[j][1] * v[j][1]) + (v[j][2] * v[j][2] + v[j][3] * v[j][3]); }
            const float rstd = rsqrtf(wave_sum(ss) * (1.0f / D) + EPS);
            u32x2* o8 = (u32x2*)(xb + (size_t)row * D) + lane;
#pragma unroll
            for (int j = 0; j < 4; ++j) { const f32x4 gg = ((const f32x4*)g1)[64 * j + lane]; u32x2 w; w.x = pk2(v[j][0] * rstd * gg[0], v[j][1] * rstd * gg[1]); w.y = pk2(v[j][2] * rstd * gg[2], v[j][3] * rstd * gg[3]); o8[64 * j] = w; }
        }
        for (int row = gw; row < 256; row += NGW) {
            u32x2* o8 = (u32x2*)(xb + (size_t)(NTOK + row) * D) + lane;
            if (row < NMETA) {
                const f32x4* xr = (const f32x4*)(meta + (size_t)row * D) + lane;
                f32x4 v[4]; float ss = 0.f;
#pragma unroll
                for (int j = 0; j < 4; ++j) { v[j] = xr[64 * j]; ss += (v[j][0] * v[j][0] + v[j][1] * v[j][1]) + (v[j][2] * v[j][2] + v[j][3] * v[j][3]); }
                const float rstd = rsqrtf(wave_sum(ss) * (1.0f / D) + EPS);
#pragma unroll
                for (int j = 0; j < 4; ++j) { const f32x4 gg = ((const f32x4*)g1)[64 * j + lane]; u32x2 w; w.x = pk2(v[j][0] * rstd * gg[0], v[j][1] * rstd * gg[1]); w.y = pk2(v[j][2] * rstd * gg[2], v[j][3] * rstd * gg[3]); o8[64 * j] = w; }
            } else {
#pragma unroll
                for (int j = 0; j < 4; ++j) o8[64 * j] = (u32x2){0u, 0u};
            }
        }
        __syncthreads(); }
        if (BOTH(0)) GRID_BAR();
    }
    if (PROBE_PHASE == 200) { GRID_BAR(); GRID_BAR(); GRID_BAR(); GRID_BAR(); }
    if (IN(1)) {
        SchedDense S; S.init(xb, Win_t, NTOK + 256, INW, D, G, bx);
        { LAS float* gt = (LAS float*)(misc + MT_GAIN); if (tid < 64) { gt[tid] = 0.125f * 1.4426950408889634f * qg[tid]; gt[64 + tid] = kg[tid]; }       __syncthreads(); }
        EpiProj E{proj, (LAS const float*)(misc + MT_GAIN)};
        pg8::gemm_phase<EpiProj, SchedDense>(lds, 2 * D, S, E);
        if (G == 256 && NMOVE > 0) {
            if (bx >= 256 - G1_SHORT) {
                const int s = bx - (256 - G1_SHORT);
#pragma unroll 1
                for (int j = 0; j < MOVE_PER_WAVE; ++j) P0_DISPATCH(NITEMS - NMOVE + j * (G1_SHORT * 8) + s * 8 + wave);
            }
        } else if (NMOVE > 0) {
            for (int it = NITEMS - NMOVE + vcu * NWAVES + wave; it < NITEMS; it += G * NWAVES) P0_DISPATCH(it);
        }
        if (BOTH(1)) GRID_BAR();
    }
    if (IN(2)) {
        float mq = fabsf(qg[lane]), mk = fabsf(kg[lane]);
#pragma unroll
        for (int o = 1; o < 64; o <<= 1) { mq = fmaxf(mq, __shfl_xor(mq, o)); mk = fmaxf(mk, __shfl_xor(mk, o)); }
        const float bshift = 8.0f * mq * mk;
        for (int rep_ = 0; rep_ < ((PROBE_PHASE == 20) ? 2 : 1); ++rep_) attn::phase(lds, proj, pmeta, sinks, bshift, yatt, G, bx);
        for (int rep_ = 0; rep_ < ((PROBE_PHASE == 21) ? 2 : 1); ++rep_) for (int u = bx; u < NB * 4 * 8; u += G) { const int v = ((G & 7) == 0 && G == 256) ? ((u & 7) * 32 + (u >> 3)) : u;
            ret::state_chain(lds, v >> 5, (v >> 3) & 3, v & 7, proj, pmeta, states); }
    }
    if (IN(3)) {
        ret::out_phase(lds, proj, states, yret, G, bx, bar, IN(2));
        if (BOTH(3)) GRID_BAR();
    }
    if (IN(4)) {
        SchedBranch2 S; S.init(yatt, Wab_t, NTOK, D, D, G, bx); S.dA = (size_t)(WS_YRET - WS_YATT) - 16 * 128; S.dB = (size_t)(WS_WRB - WS_WAB) - 16 * 128;
        EpiBranch2 E{merged, proj};
        pg8::gemm_phase<EpiBranch2, SchedBranch2>(lds, 2 * D, S, E);
        if (BOTH(4)) GRID_BAR();
    }
    if (IN(5)) {
        SchedDense S; S.init(merged, Wout_t, NTOK, D, D, G, bx);
        EpiOut E{x, h2b};
        pg8::gemm_phase<EpiOut, SchedDense>(lds, 2 * D, S, E);
        if (BOTH(5)) { route_images(lds, g2, w_r); GRID_BAR(); }
    }
    if (IN(6)) {
        if (!IN(5)) route_images(lds, g2, w_r);
        route_phase(lds, h2b, g2, w_r, b_r, xn8, tke, tkpos, tkw, list, wlist, rlist, ctl + CW_CNT, G, bx);
        if (BOTH(6)) GRID_BAR();
    }
    if (hi > 7 && lo <= 9) moe_tables(misc, ctl + CW_CNT);
    if (IN(7)) {
        SchedMoe<true, 8> S{(const char*)xn8, (const char*)Wgu_t, misc, list, G, bx};
        EpiGU E{act, b_gu, rlist, misc};
        pg8::gemm_phase<EpiGU, SchedMoe<true, 8>, true>(lds, D, S, E);
        for (;;) {
            int it = 0; if (lane == 0) it = (int)atomicAdd(ctl + CW_Q, 1u);
            it = __builtin_amdgcn_readfirstlane(it);
            if (it >= NMOVE2) break;
            P0_DISPATCH(NITEMS - NMOVE - NMOVE2 + it);
        }
        if (BOTH(7)) GRID_BAR();
    }
    if (IN(8)) {
        SchedMoe<false, 4> S{(const char*)act, (const char*)Wdn_t, misc, list, G, bx};
        EpiDown E{rows, b_dn, wlist, misc};
        pg8::gemm_phase<EpiDown, SchedMoe<false, 4>, true>(lds, DFF, S, E);
        if (BOTH(8)) GRID_BAR();
    }
    if (IN(9)) combine_phase(misc, h2b, out, rows, tke, tkpos, vcu * NWAVES + wave, G * NWAVES, lane);
#undef IN
#undef BOTH
#undef GRID_BAR
}

extern "C" void kernel_launch(void* const* d_in, const int* in_sizes, int n_in, void* d_out, int out_size, void* d_ws, size_t ws_size, hipStream_t stream) {
    static int grid = 0;
    if (grid == 0) {
        if (n_in != 17 || in_sizes[0] != NTOK * D || out_size != NTOK * D || ws_size < WS_END) {
            fprintf(stderr, "kernel_launch: unexpected shapes (n_in %d in0 %d out %d ws %zu)\n", n_in, n_in > 0 ? in_sizes[0] : -1, out_size, ws_size); grid = -1; return; }
        int dev = 0, cus = 0;
        if (hipGetDevice(&dev) != hipSuccess || hipDeviceGetAttribute(&cus, hipDeviceAttributeMultiprocessorCount, dev) != hipSuccess) { grid = -1; return; }
        if (hipFuncSetAttribute((const void*)mk_fwd, hipFuncAttributeMaxDynamicSharedMemorySize, LDS_BYTES) != hipSuccess) { fprintf(stderr, "kernel_launch: hipFuncSetAttribute failed\n"); grid = -1; return; }
        grid = cus;
    }
    if (grid < 0) return;
    unsigned char* ws = (unsigned char*)d_ws;
    (void)hipMemsetAsync(ws + WS_CTL, 0, 1 * MiB, stream);
    Args a{};
    for (int i = 0; i < 17; ++i) a.in[i] = (const float*)d_in[i];
    a.out = (float*)d_out; a.ws = ws; a.ph_lo = 0; a.ph_hi = 10; a.li = 0; a.pad = 0;
    hipLaunchKernelGGL(mk_fwd, dim3(grid), dim3(512), LDS_BYTES, stream, a);
}
```

```cpp
#include <hip/hip_runtime.h>
#include <cstdio>
#include <cstdint>

typedef unsigned short bf16;
__device__ __forceinline__ float bf2f(bf16 v) { return __uint_as_float(((unsigned)v) << 16); }
__device__ __forceinline__ bf16 f2bf(float f) { const __bf16 b = (__bf16)f; return __builtin_bit_cast(unsigned short, b); }
__device__ __forceinline__ float sigmoidf_(float x) { return __builtin_amdgcn_rcpf(1.0f + __builtin_amdgcn_exp2f(-1.4426950408889634f * x)); }

constexpr int NB = 8, SEQ = 4096, D = 1024, NTOK = NB * SEQ;
constexpr int NMETA = 16;
constexpr int INW = 6400;
constexpr int C_AQ = 0, C_AK = 1024, C_AV = 1152, C_RQ = 1280, C_RK = 1792, C_RV = 2304, C_RG = 3328, C_GA = 4352, C_GR = 5376;
constexpr int NE = 32, TOPK = 4, DFF = 1024;
constexpr int NROWS = (NTOK * TOPK / 256 + NE) * 256;
constexpr int NTILE = NROWS / 256;
constexpr float EPS = 1e-5f;

constexpr size_t MiB = 1u << 20;
constexpr size_t WS_CTL = 0;
constexpr size_t WS_SMALL = 1 * MiB;
constexpr size_t WS_W = 16 * MiB;
constexpr size_t WS_XB = 232 * MiB;
constexpr size_t WS_PROJ = 297 * MiB;
constexpr size_t WS_YATT = 701 * MiB;
constexpr size_t WS_YRET = 765 * MiB;
constexpr size_t WS_MERGED = 829 * MiB;
constexpr size_t WS_END = 1020 * MiB;
constexpr size_t WS_ACT = 297 * MiB;
constexpr size_t WS_ROWS = 568 * MiB;
constexpr size_t SM_UMETA = WS_SMALL;
constexpr size_t SM_PMETA = WS_SMALL + 64 * 1024;
constexpr size_t SM_TKE = WS_SMALL + 512 * 1024;
constexpr size_t SM_TKW = SM_TKE + 512 * 1024;
constexpr size_t SM_TKPOS = SM_TKW + 512 * 1024;
constexpr size_t SM_TKROW = SM_TKPOS + 512 * 1024;
constexpr size_t SM_ROWTOK = SM_TKROW + 512 * 1024;
constexpr size_t SM_ROWW = SM_ROWTOK + 1024 * 1024;
constexpr size_t SM_TILEE = SM_ROWW + 1024 * 1024;
constexpr int CW_CNT = 1024;

#ifndef PROBE_PHASE
#define PROBE_PHASE (-1)
#endif
#define LAS __attribute__((address_space(3)))
#define GAS __attribute__((address_space(1)))
typedef short bf16x8 __attribute__((ext_vector_type(8)));
typedef float f32x4 __attribute__((ext_vector_type(4)));
typedef float f32x2 __attribute__((ext_vector_type(2)));
typedef unsigned u32x4 __attribute__((ext_vector_type(4)));
typedef unsigned u32x2 __attribute__((ext_vector_type(2)));
#define LDS_WAIT() asm volatile("s_waitcnt lgkmcnt(0)" ::: "memory")
#define VM_WAIT() asm volatile("s_waitcnt vmcnt(0)" ::: "memory")
typedef __bf16 bf16x2_t __attribute__((ext_vector_type(2)));
__device__ __forceinline__ unsigned pk2(float lo, float hi) { const f32x2 v = {lo, hi}; const bf16x2_t b = __builtin_convertvector(v, bf16x2_t); return __builtin_bit_cast(unsigned, b); }
__device__ __forceinline__ unsigned pk4_fp8(float a, float b, float c, float d) { int w = __builtin_amdgcn_cvt_pk_fp8_f32(a, b, 0, false); w = __builtin_amdgcn_cvt_pk_fp8_f32(c, d, w, true); return (unsigned)w; }
constexpr float W8_SCALE = 64.0f, W8_INV = 1.0f / 64.0f;
constexpr float ROW8_SCALE = 16.0f, ROW8_INV = 1.0f / 16.0f;
__device__ __forceinline__ u32x4 pack8(const f32x4& a, const f32x4& b) { u32x4 w; w.x = pk2(a[0], a[1]); w.y = pk2(a[2], a[3]); w.z = pk2(b[0], b[1]); w.w = pk2(b[2], b[3]); return w; }
__device__ __forceinline__ void unpack8(const u32x4& w, float (&f)[8]) {
    f[0] = __uint_as_float(w.x << 16); f[1] = __uint_as_float(w.x & 0xffff0000u); f[2] = __uint_as_float(w.y << 16); f[3] = __uint_as_float(w.y & 0xffff0000u);
    f[4] = __uint_as_float(w.z << 16); f[5] = __uint_as_float(w.z & 0xffff0000u); f[6] = __uint_as_float(w.w << 16); f[7] = __uint_as_float(w.w & 0xffff0000u);
}
__device__ __forceinline__ float wave_sum(float v) {
#pragma unroll
    for (int o = 1; o < 64; o <<= 1) v += __shfl_xor(v, o);
    return v;
}

constexpr size_t WS_WIN = WS_W;
constexpr size_t WS_WAB = WS_W + 13 * MiB;
constexpr size_t WS_WRB = WS_W + 15 * MiB;
constexpr size_t WS_WOUT = WS_W + 17 * MiB;
constexpr size_t WS_WGU = WS_W + 19 * MiB;
constexpr size_t WS_WDN = WS_W + 147 * MiB;
static_assert(WS_WDN + 64 * MiB <= WS_XB, "weight map");
constexpr size_t SM_ATILE = SM_TILEE + 4096;
constexpr int CW_NACT = 1088;
constexpr int CW_BAR = 4096;

constexpr int RING_BYTES = 131072;
constexpr int MISC_OFF = RING_BYTES;
constexpr int LDS_BYTES = 163840;
constexpr int NWAVES = 8;

#define XB_TMO      128
#define XB_XCNT(j)  (256  + 64 * (j))
#define XB_XSUB(j)  (1280 + 64 * (j))
#define XB_XGEN(j)  (2304 + 64 * (j))
#define XB_TOP      3328
#define XB_TOPGEN   3392
#define XCD_BAR_WORDS 3456
#define XB_SPIN_CAP (1u << 20)
__device__ __forceinline__ unsigned xb_ld(unsigned* p)              { return __hip_atomic_load(p, __ATOMIC_RELAXED, __HIP_MEMORY_SCOPE_AGENT); }
__device__ __forceinline__ unsigned xb_add(unsigned* p, unsigned v) { return __hip_atomic_fetch_add(p, v, __ATOMIC_RELAXED, __HIP_MEMORY_SCOPE_AGENT); }
__device__ __forceinline__ unsigned xb_xcc_id() { return (unsigned)__builtin_amdgcn_s_getreg((3 << 11) | 20) & 0xFu; }
#define XB_SPIN(cond, bar) do { unsigned _sp = 0; while (cond) { __builtin_amdgcn_s_sleep(1); \
    if ((++_sp & 255u) == 0u) { if (xb_ld(&(bar)[XB_TMO])) break; if (_sp > XB_SPIN_CAP) { atomicAdd(&(bar)[XB_TMO], 1u); break; } } } } while (0)
struct XcdBarrier { unsigned* bar; unsigned x; volatile LAS unsigned* st; };
__device__ __forceinline__ XcdBarrier xcd_barrier_post(unsigned* bar, volatile LAS unsigned* st) {
    XcdBarrier b; b.bar = bar; b.x = xb_xcc_id(); b.st = st;
    if (threadIdx.x == 0) (void)xb_add(&bar[XB_XCNT(b.x)], 1u);
    return b;
}
__device__ __forceinline__ void xcd_barrier_complete(unsigned* bar, unsigned x, unsigned& nloc, unsigned& nx) {
    const unsigned G = gridDim.x * gridDim.y * gridDim.z;
    unsigned sum, cnt, mine, sp = 0u;
    for (;;) {
        sum = 0u; cnt = 0u; mine = 0u;
#pragma unroll
        for (unsigned j = 0; j < 16; ++j) { const unsigned c = xb_ld(&bar[XB_XCNT(j)]); sum += c; cnt += (c > 0u) ? 1u : 0u; mine = (j == x) ? c : mine; }
        if (sum == G) break;
        __builtin_amdgcn_s_sleep(1);
        if ((++sp & 255u) == 0u) { if (xb_ld(&bar[XB_TMO])) break; if (sp > XB_SPIN_CAP) { atomicAdd(&bar[XB_TMO], 1u); break; } }
    }
    nloc = mine > 0u ? mine : 1u; nx = cnt > 0u ? cnt : 1u;
}
__device__ __forceinline__ void xcd_barrier(const XcdBarrier& b) {
    asm volatile("s_waitcnt vmcnt(0)" ::: "memory");
    __syncthreads();
    if (threadIdx.x == 0) {
        unsigned* bar = b.bar;
        __builtin_amdgcn_s_waitcnt(0);
        unsigned nloc = b.st[0], nx = b.st[1];
        if (nloc == 0u) { xcd_barrier_complete(bar, b.x, nloc, nx); b.st[0] = nloc; b.st[1] = nx; }
        const unsigned old = xb_add(&bar[XB_XSUB(b.x)], 1u);
        const unsigned gen = old / nloc;
        if (old + 1u == (gen + 1u) * nloc) {
            __builtin_amdgcn_fence(__ATOMIC_RELEASE, "agent");
            asm volatile("s_waitcnt vmcnt(0)" ::: "memory");
            const unsigned og = xb_add(&bar[XB_TOP], 1u);
            const unsigned tg = og / nx;
            if (og + 1u == (tg + 1u) * nx) xb_add(&bar[XB_TOPGEN], 1u);
            else XB_SPIN(xb_ld(&bar[XB_TOPGEN]) == tg, bar);
            __builtin_amdgcn_fence(__ATOMIC_ACQUIRE, "agent");
            xb_add(&bar[XB_XGEN(b.x)], 1u);
            asm volatile("s_waitcnt vmcnt(0)" ::: "memory");
        } else {
            XB_SPIN(xb_ld(&bar[XB_XGEN(b.x)]) == gen, bar);
            __builtin_amdgcn_fence(__ATOMIC_ACQUIRE, "agent");
            asm volatile("s_waitcnt vmcnt(0)" ::: "memory");
        }
    }
    __syncthreads();
}

namespace pg8 {
constexpr int BM = 256, BK = 64, HALF = 128, HTB = HALF * BK * 2, STAGE_BYTES = 8 * HTB;
__host__ __device__ __forceinline__ int lds_byte(int r, int c) { const int st = (r >> 4) * 2 + (c >> 5), rr = r & 15, cc = c & 31, ob = rr * 64 + cc * 2; return st * 1024 + (ob ^ (((ob >> 9) & 1) << 5)); }
__host__ __device__ __forceinline__ void stage_rc(int b, int& R, int& C) { const int st = b / 1024, sb = b % 1024, swz = sb ^ (((sb >> 9) & 1) << 5); R = (st >> 1) * 16 + swz / 64; C = (st & 1) * 32 + (swz % 64) / 2; }
__host__ __device__ __forceinline__ int perm32(int rho) { const int n = rho >> 4, i = rho & 15; return 8 * (i >> 2) + 4 * n + (i & 3); }
struct Unit { int pm, pn, aux, tl; const char* A; const char* B; };
typedef f32x4 Acc[2][2][4][2];
typedef int u32x4_i __attribute__((ext_vector_type(4)));

typedef int v8i32 __attribute__((ext_vector_type(8)));
template <class Epi, class Sched, bool FP8 = false>
__device__ __forceinline__ void gemm_phase(LAS unsigned char* lds, const int Kb, const Sched& S, const Epi& E) {
    const int tid = threadIdx.x, wid = __builtin_amdgcn_readfirstlane(tid >> 6), lane = tid & 63, wr = wid >> 2, wc = wid & 3, fr = lane & 15, fq = lane >> 4;
    const int nt = Sched::SEG ? 2 * Sched::SEG : Kb / 128;
    int RA[2], CA[2]; unsigned voffB[2];
#pragma unroll
    for (int i = 0; i < 2; ++i) { int R, C; stage_rc(tid * 16 + i * 8192, R, C); const int Rb = Epi::PERM ? ((R & ~31) + perm32(R & 31)) : R;
        RA[i] = R; CA[i] = C; voffB[i] = (unsigned)(Rb * Kb + C * 2); }
    const size_t kstep = (size_t)(BK * 2);
    const size_t hstep = (size_t)HALF * Kb;
    const unsigned ldsw = (unsigned)wid * 1024u;
    const int aoff = lds_byte(wr * 64 + fr, fq * 8), boff = lds_byte(wc * 32 + fr, fq * 8);
#define PG8_SA(b, h) (((b) * 2 + (h)) * HTB)
#define PG8_SB(b, h) ((4 + (b) * 2 + (h)) * HTB)
#define PG8_STAGE(bufoff, gbase, voff) do { _Pragma("unroll") for (int _i = 0; _i < 2; ++_i) \
        __builtin_amdgcn_global_load_lds((const unsigned*)((const char*)(gbase) + (voff)[_i]), (LAS unsigned*)(lds + (bufoff) + ldsw + _i * 8192), 16, 0, 0); } while (0)
#define PG8_LDA(dst, b, h) do { _Pragma("unroll") for (int m = 0; m < 4; ++m) _Pragma("unroll") for (int k = 0; k < 2; ++k) dst[m][k] = *(const LAS bf16x8*)(lds + PG8_SA(b, h) + aoff + m * 2048 + k * 1024); } while (0)
#define PG8_LDB(dst, b, h) do { _Pragma("unroll") for (int n = 0; n < 2; ++n) _Pragma("unroll") for (int k = 0; k < 2; ++k) dst[n][k] = *(const LAS bf16x8*)(lds + PG8_SB(b, h) + boff + n * 2048 + k * 1024); } while (0)
#define PG8_MMA(ai, bj, At, Bt) do { __builtin_amdgcn_s_setprio(1); _Pragma("unroll") for (int m = 0; m < 4; ++m) _Pragma("unroll") for (int n = 0; n < 2; ++n) { \
        if constexpr (FP8) { const v8i32 bq = __builtin_shufflevector(__builtin_bit_cast(u32x4_i, Bt[n][0]), __builtin_bit_cast(u32x4_i, Bt[n][1]), 0, 1, 2, 3, 4, 5, 6, 7), \
                                         aq = __builtin_shufflevector(__builtin_bit_cast(u32x4_i, At[m][0]), __builtin_bit_cast(u32x4_i, At[m][1]), 0, 1, 2, 3, 4, 5, 6, 7); \
            asm volatile("v_mfma_scale_f32_16x16x128_f8f6f4 %0, %1, %2, %0, %3, %3 op_sel_hi:[0,0,0]" : "+v"(acc[ai][bj][m][n]) : "v"(bq), "v"(aq), "v"(scale1)); } \
        else { _Pragma("unroll") for (int k = 0; k < 2; ++k) acc[ai][bj][m][n] = __builtin_amdgcn_mfma_f32_16x16x32_bf16(Bt[n][k], At[m][k], acc[ai][bj][m][n], 0, 0, 0); } } \
        __builtin_amdgcn_s_setprio(0); } while (0)
#define PG8_WAIT_V(n) asm volatile("s_waitcnt vmcnt(" #n ")" ::: "memory")
#define PG8_WAIT_L(n) asm volatile("s_waitcnt lgkmcnt(" #n ")" ::: "memory")
#define PG8_BAR __builtin_amdgcn_s_barrier()
#define PG8_SCHED __builtin_amdgcn_sched_barrier(0)
    int scale1 = 0x7f7f7f7f; asm volatile("" : "+v"(scale1));
    Unit cur, nxt; int ui = 0;
    if (!S.next(0, cur)) return;
    unsigned ca[2][2], na[2][2];
    S.aoff(cur, RA, CA, ca);
    f32x4 acc[2][2][4][2];
#pragma unroll
    for (int a = 0; a < 2; ++a)
#pragma unroll
        for (int b = 0; b < 2; ++b)
#pragma unroll
            for (int m = 0; m < 4; ++m)
#pragma unroll
                for (int n = 0; n < 2; ++n) acc[a][b][m][n] = (f32x4){0.f, 0.f, 0.f, 0.f};
    bf16x8 At[4][2], B0[2][2], B1[2][2];
    const char* cA = cur.A; const char* cB = cur.B;
    E.prefetch(cur, 0, wid, lane);
    PG8_STAGE(PG8_SB(0, 0), cB, voffB); PG8_STAGE(PG8_SB(0, 1), cB + hstep, voffB); PG8_STAGE(PG8_SA(0, 0), cA, ca[0]); PG8_STAGE(PG8_SA(0, 1), cA, ca[1]);
    if (wr == 1) PG8_BAR;
    PG8_WAIT_V(2); PG8_BAR;
    PG8_STAGE(PG8_SB(1, 0), cB + kstep, voffB); PG8_STAGE(PG8_SA(1, 0), cA + kstep, ca[0]); PG8_STAGE(PG8_SB(1, 1), cB + hstep + kstep, voffB);
    PG8_WAIT_V(6); PG8_BAR;
    for (;;) {
        const bool has_next = S.next(ui + 1, nxt);
        if constexpr (Sched::GATHER) {
            if (has_next) S.aoff(nxt, RA, CA, na);
            else {
#pragma unroll
                for (int h = 0; h < 2; ++h)
#pragma unroll
                    for (int i = 0; i < 2; ++i) na[h][i] = ca[h][i];
            }
        }
        const char* nA = has_next ? nxt.A : cA; const char* nB = has_next ? nxt.B : cB;
#pragma nounroll
        for (int t = 0; t < nt; t += 2) {
            const bool last = (t == nt - 2);
            if constexpr (Sched::SEG > 0) { if (t == Sched::SEG) { int fr_ = fr, fq_ = fq; asm volatile("" : "+v"(fr_), "+v"(fq_)); E.mid(acc, cur, wr, wc, fr_, fq_); } }
            const size_t sA1 = (Sched::SEG && t + 1 >= Sched::SEG) ? S.dA : 0, sA2 = (Sched::SEG && t + 2 >= Sched::SEG) ? S.dA : 0, sB2 = (Sched::SEG && t + 2 >= Sched::SEG) ? S.dB : 0;
            const char* a1 = cA + (size_t)(t + 1) * kstep + sA1;
            const char* a2 = last ? nA : cA + (size_t)(t + 2) * kstep + sA2; const char* b2 = last ? nB : cB + (size_t)(t + 2) * kstep + sB2;
            const char* a3 = a2 + kstep; const char* b3 = b2 + kstep;
            unsigned o2[2][2];
#pragma unroll
            for (int h = 0; h < 2; ++h)
#pragma unroll
                for (int i = 0; i < 2; ++i) { if constexpr (Sched::GATHER) o2[h][i] = last ? na[h][i] : ca[h][i]; else o2[h][i] = ca[h][i]; }
            PG8_LDB(B0, 0, 0); PG8_LDB(B1, 0, 1); PG8_SCHED; PG8_LDA(At, 0, 0); PG8_STAGE(PG8_SA(1, 1), a1, ca[1]);
            PG8_WAIT_V(8); PG8_WAIT_L(0); PG8_BAR; PG8_MMA(0, 0, At, B0); PG8_MMA(0, 1, At, B1); PG8_BAR; PG8_SCHED;
            PG8_LDA(At, 0, 1); PG8_STAGE(PG8_SB(0, 0), b2, voffB); PG8_STAGE(PG8_SB(0, 1), b2 + hstep, voffB); PG8_STAGE(PG8_SA(0, 0), a2, o2[0]);
            PG8_WAIT_V(8); PG8_WAIT_L(0); PG8_BAR; PG8_MMA(1, 0, At, B0); PG8_MMA(1, 1, At, B1); PG8_BAR; PG8_SCHED;
            PG8_LDB(B0, 1, 0); PG8_LDB(B1, 1, 1); PG8_SCHED; PG8_LDA(At, 1, 0); PG8_STAGE(PG8_SA(0, 1), a2, o2[1]);
            PG8_WAIT_V(8); PG8_WAIT_L(0); PG8_BAR; PG8_MMA(0, 0, At, B0); PG8_MMA(0, 1, At, B1); PG8_BAR; PG8_SCHED;
            PG8_LDA(At, 1, 1); PG8_STAGE(PG8_SB(1, 0), b3, voffB); PG8_STAGE(PG8_SB(1, 1), b3 + hstep, voffB); PG8_STAGE(PG8_SA(1, 0), a3, o2[0]);
            PG8_WAIT_V(8); PG8_WAIT_L(0); PG8_BAR; PG8_MMA(1, 0, At, B0); PG8_MMA(1, 1, At, B1); PG8_BAR; PG8_SCHED;
        }
        if constexpr (FP8) { asm volatile("s_nop 15\n\ts_nop 15\n\ts_nop 15" ::: "memory"); PG8_SCHED; }
        if (wr == 0) PG8_BAR;
        { int fr_ = fr, fq_ = fq; asm volatile("" : "+v"(fr_), "+v"(fq_));
          E(acc, cur, wr, wc, fr_, fq_, ui & 1);
          if (PROBE_PHASE == 50) E(acc, cur, wr, wc, fr_, fq_, ui & 1); }
        if (!has_next) break;
#pragma unroll
        for (int a = 0; a < 2; ++a)
#pragma unroll
            for (int b = 0; b < 2; ++b)
#pragma unroll
                for (int m = 0; m < 4; ++m)
#pragma unroll
                    for (int n = 0; n < 2; ++n) acc[a][b][m][n] = (f32x4){0.f, 0.f, 0.f, 0.f};
        cur = nxt; cA = nA; cB = nB; ++ui;
        E.prefetch(cur, ui & 1, wid, lane);
        if constexpr (Sched::GATHER) {
#pragma unroll
            for (int h = 0; h < 2; ++h)
#pragma unroll
                for (int i = 0; i < 2; ++i) ca[h][i] = na[h][i];
        }
        if (wr == 1) PG8_BAR;
    }
    PG8_WAIT_V(0);
    PG8_BAR;
#undef PG8_SA
#undef PG8_SB
#undef PG8_STAGE
#undef PG8_LDA
#undef PG8_LDB
#undef PG8_MMA
#undef PG8_WAIT_V
#undef PG8_WAIT_L
#undef PG8_BAR
#undef PG8_SCHED
}
}
#ifndef PROBE_PHASE
#define PROBE_PHASE (-1)
#endif
constexpr size_t SM_LIST = WS_SMALL + 2 * MiB;
constexpr size_t SM_WLIST = WS_SMALL + 6 * MiB;
constexpr size_t SM_RLIST = WS_SMALL + 10 * MiB;
constexpr int MT_PSTART = 256;
constexpr int MT_CNT = 512;
constexpr int MT_NACT = 768;
constexpr int MT_ATILE = 1024;
constexpr int MT_HIST = 4096;
constexpr int MT_BASE = 4224;
constexpr int MT_REC = 4352;
constexpr int MT_RSTD = 10496;
constexpr int MT_EPI = 11264;
constexpr int MT_EPI2 = 13312;
constexpr int MT_GAIN = 15360;
constexpr int MT_XCH = 16384;

__device__ __forceinline__ void moe_tables(LAS unsigned char* misc, const unsigned* cnt) {
    LAS int* pstart = (LAS int*)(misc + MT_PSTART); LAS int* cl = (LAS int*)(misc + MT_CNT); LAS int* at = (LAS int*)(misc + MT_ATILE);
    __syncthreads();
    if (threadIdx.x < 64) {
        const int lane = threadIdx.x, e = lane & 31;
        const int c = (int)__hip_atomic_load(cnt + e, __ATOMIC_RELAXED, __HIP_MEMORY_SCOPE_AGENT), nt = (c + 255) >> 8;
        int incl = nt;
#pragma unroll
        for (int o = 1; o < 32; o <<= 1) { const int v = __shfl_up(incl, o); if (e >= o) incl += v; }
        const int t0 = incl - nt;
        if (lane < 32) { cl[e] = c; pstart[e] = t0 << 8; for (int t = 0; t < nt; ++t) at[t0 + t] = (t0 + t) | (e << 12) | (t << 20);
            if (e == 31) { pstart[NE] = incl << 8; *(LAS int*)(misc + MT_NACT) = incl; } }
    }
    __syncthreads();
}

__device__ __forceinline__ void route_images(LAS unsigned char* lds, const float* __restrict__ g2, const float* __restrict__ wr) {
    const int tid = threadIdx.x;
    for (int idx = tid; idx < 128 * 32; idx += 512) {
        const int c = idx >> 5, e = idx & 31; float v[8]; unsigned hw[4], lw[4];
#pragma unroll
        for (int j = 0; j < 8; ++j) v[j] = wr[(size_t)(8 * c + j) * NE + e] * g2[8 * c + j];
#pragma unroll
        for (int j = 0; j < 4; ++j) { hw[j] = pk2(v[2 * j], v[2 * j + 1]); lw[j] = pk2(v[2 * j] - __uint_as_float(hw[j] << 16), v[2 * j + 1] - __uint_as_float(hw[j] & 0xffff0000u)); }
        *(LAS u32x4*)(lds + idx * 16) = (u32x4){hw[0], hw[1], hw[2], hw[3]};
        *(LAS u32x4*)(lds + 65536 + idx * 16) = (u32x4){lw[0], lw[1], lw[2], lw[3]};
    }
    __syncthreads();
}
__device__ __forceinline__ void route_phase(LAS unsigned char* lds, const bf16* __restrict__ h2, const float* __restrict__ g2, const float* __restrict__ wr, const float* __restrict__ br,
                                            unsigned char* __restrict__ xg8, int* __restrict__ tke, int* __restrict__ tkpos, float* __restrict__ tkw, int* __restrict__ list, float* __restrict__ wlist,
                                            float* __restrict__ rlist, unsigned* __restrict__ cnt, int G, int bx) {
    typedef float f32x16 __attribute__((ext_vector_type(16)));
    const int tid = threadIdx.x, lane = tid & 63, r32 = lane & 31, hi = lane >> 5; const int wave = __builtin_amdgcn_readfirstlane(tid >> 6);
    LAS unsigned char* misc = lds + MISC_OFF;
    LAS int* hist = (LAS int*)(misc + MT_HIST); LAS int* base = (LAS int*)(misc + MT_BASE); LAS int* rec = (LAS int*)(misc + MT_REC); LAS float* rstd_l = (LAS float*)(misc + MT_RSTD);
    const int tile = wave & 3, kh = wave >> 2;
    for (int tb = bx; tb < NTOK / 128; tb += G) {
        if (tid < 32) hist[tid] = 0;
        __syncthreads();
        {
        const int token = tb * 128 + tile * 32 + r32;
        const bf16* xp = h2 + (size_t)token * D + kh * 512 + 8 * hi;
        unsigned char* x8p = xg8 + (size_t)token * D + kh * 512 + 8 * hi;
        const float* gp = g2 + kh * 512 + 8 * hi;
        f32x16 c = {};
        float ss = 0.f;
        u32x4 xa[8];
#pragma unroll
        for (int p = 0; p < 8; ++p) xa[p] = *(const u32x4*)(xp + 16 * p);
#pragma unroll 1
        for (int ks0 = 0; ks0 < 32; ks0 += 8) {
#pragma unroll
            for (int p = 0; p < 8; ++p) {
                const int ks = ks0 + p;
                float xf[8]; unpack8(xa[p], xf); const f32x4 x0 = {xf[0], xf[1], xf[2], xf[3]}, x1 = {xf[4], xf[5], xf[6], xf[7]};
                const u32x4 xh = xa[p];
                if (ks + 8 < 32) xa[p] = *(const u32x4*)(xp + 16 * (ks + 8));
                ss += (x0[0] * x0[0] + x0[1] * x0[1]) + (x0[2] * x0[2] + x0[3] * x0[3]) + (x1[0] * x1[0] + x1[1] * x1[1]) + (x1[2] * x1[2] + x1[3] * x1[3]);
                { const f32x4 g0 = *(const f32x4*)(gp + 16 * ks), g1 = *(const f32x4*)(gp + 16 * ks + 4);
                  u32x2 w8; w8.x = pk4_fp8(x0[0] * g0[0], x0[1] * g0[1], x0[2] * g0[2], x0[3] * g0[3]); w8.y = pk4_fp8(x1[0] * g1[0], x1[1] * g1[1], x1[2] * g1[2], x1[3] * g1[3]);
                  *(u32x2*)(x8p + 16 * ks) = w8; }
                const int chunk = kh * 64 + 2 * ks + hi;
                const bf16x8 wh = *(const LAS bf16x8*)(lds + (chunk * 32 + r32) * 16), wl = *(const LAS bf16x8*)(lds + 65536 + (chunk * 32 + r32) * 16);
                c = __builtin_amdgcn_mfma_f32_32x32x16_bf16(wh, __builtin_bit_cast(bf16x8, xh), c, 0, 0, 0);
                c = __builtin_amdgcn_mfma_f32_32x32x16_bf16(wl, __builtin_bit_cast(bf16x8, xh), c, 0, 0, 0);
            }
        }
        LAS float* px = (LAS float*)(misc + MT_XCH);
        LAS float* sx = (LAS float*)(misc + MT_REC + tile * 1536);
        if (kh == 1) {
#pragma unroll
            for (int r = 0; r < 16; ++r) px[(tile * 16 + r) * 64 + lane] = c[r];
            sx[lane] = ss;
        }
        __syncthreads();
        if (kh == 0) {
#pragma unroll
            for (int r = 0; r < 16; ++r) c[r] += px[(tile * 16 + r) * 64 + lane];
            ss += sx[lane];
            ss += __shfl_xor(ss, 32);
            const float rstd = rsqrtf(ss * (1.0f / D) + EPS);
            float vals[16];
#pragma unroll
            for (int r = 0; r < 16; ++r) vals[r] = c[r] * rstd + br[(r & 3) + 8 * (r >> 2) + 4 * hi];
            float tv[4]; int te[4];
#pragma unroll
            for (int k = 0; k < 4; ++k) {
                float m = -3.0e38f; int mi = 0;
#pragma unroll
                for (int r = 0; r < 16; ++r) { const bool gt = vals[r] > m; m = gt ? vals[r] : m; mi = gt ? r : mi; }
                tv[k] = m; te[k] = (mi & 3) + 8 * (mi >> 2) + 4 * hi;
#pragma unroll
                for (int r = 0; r < 16; ++r) vals[r] = (r == mi) ? -3.0e38f : vals[r];
            }
            float cv[8]; int ce[8];
#pragma unroll
            for (int k = 0; k < 4; ++k) { cv[k] = tv[k]; ce[k] = te[k]; cv[4 + k] = __shfl_xor(tv[k], 32); ce[4 + k] = __shfl_xor(te[k], 32); }
            float fv[4]; int fe[4];
#pragma unroll
            for (int k = 0; k < 4; ++k) {
                float m = -3.0e38f; int me = 64; int mi = 0;
#pragma unroll
                for (int q = 0; q < 8; ++q) { const bool better = (cv[q] > m) || (cv[q] == m && ce[q] < me); m = better ? cv[q] : m; me = better ? ce[q] : me; mi = better ? q : mi; }
                fv[k] = m; fe[k] = me;
#pragma unroll
                for (int q = 0; q < 8; ++q) cv[q] = (q == mi) ? -3.0e38f : cv[q];
            }
            if (hi == 0) {
                const float e0 = 1.0f, e1 = __expf(fv[1] - fv[0]), e2 = __expf(fv[2] - fv[0]), e3 = __expf(fv[3] - fv[0]);
                const float inv = 1.0f / (e0 + e1 + e2 + e3);
                const float wts[4] = {e0 * inv, e1 * inv, e2 * inv, e3 * inv};
                const int tl = tile * 32 + r32;
                rstd_l[tl] = rstd;
#pragma unroll
                for (int k = 0; k < 4; ++k) {
                    const int lp = __hip_atomic_fetch_add(hist + fe[k], 1, __ATOMIC_RELAXED, __HIP_MEMORY_SCOPE_WORKGROUP);
                    LAS int* r = rec + (tl * 4 + k) * 3; r[0] = fe[k]; r[1] = lp; r[2] = __float_as_int(wts[k]);
                }
            }
        }
        }
        __syncthreads();
        if (tid < 32) base[tid] = (int)atomicAdd(&cnt[tid], (unsigned)hist[tid]);
        __syncthreads();
        { const int tl = tid >> 2; const int tok = tb * 128 + tl; LAS int* r = rec + tid * 3; const int e = r[0], pos = base[e] + r[1]; const float w = __int_as_float(r[2]);
          tke[tok * 4 + (tid & 3)] = e; tkpos[tok * 4 + (tid & 3)] = pos; tkw[tok * 4 + (tid & 3)] = w;
          list[e * NTOK + pos] = tok; wlist[e * NTOK + pos] = w; rlist[e * NTOK + pos] = rstd_l[tl]; }
        __syncthreads();
    }
}

__device__ __forceinline__ void combine_phase(LAS unsigned char* misc, const bf16* __restrict__ h2b, float* __restrict__ out, const unsigned char* __restrict__ rows, const int* __restrict__ tke, const int* __restrict__ tkpos, int gw, int NGW, int lane) {
    LAS const int* pstart = (LAS const int*)(misc + MT_PSTART);
    for (int token = gw; token < NTOK; token += NGW) {
        int rr[4];
#pragma unroll
        for (int k = 0; k < 4; ++k) rr[k] = pstart[tke[token * 4 + k]] + tkpos[token * 4 + k];
        f32x4* o = (f32x4*)(out + (size_t)token * D) + lane;
        const u32x2* hp = (const u32x2*)(h2b + (size_t)token * D) + lane;
        f32x4 v[4], s[4];
#pragma unroll
        for (int j = 0; j < 4; ++j) { const u32x2 w = __builtin_nontemporal_load(hp + 64 * j);
            v[j] = (f32x4){__uint_as_float(w.x << 16), __uint_as_float(w.x & 0xffff0000u), __uint_as_float(w.y << 16), __uint_as_float(w.y & 0xffff0000u)}; s[j] = (f32x4){0.f, 0.f, 0.f, 0.f}; }
#pragma unroll
        for (int k = 0; k < 4; ++k) {
            const unsigned* rp = (const unsigned*)(rows + (size_t)rr[k] * D) + lane;
#pragma unroll
            for (int j = 0; j < 4; ++j) { const unsigned w = __builtin_nontemporal_load(rp + 64 * j);
                const f32x2 lo = __builtin_amdgcn_cvt_pk_f32_fp8((int)w, false), hh = __builtin_amdgcn_cvt_pk_f32_fp8((int)w, true);
                s[j][0] += lo[0]; s[j][1] += lo[1]; s[j][2] += hh[0]; s[j][3] += hh[1]; }
        }
#pragma unroll
        for (int j = 0; j < 4; ++j) __builtin_nontemporal_store(v[j] + s[j] * ROW8_INV, o + 64 * j);
    }
}
struct SchedDense {
    static constexpr bool GATHER = false; static constexpr int SEG = 0; size_t dA = 0, dB = 0; int rev = 0;
    const char* A; const char* Bt; int K, nM, nN, nwg, G, c;
    __device__ void init(const bf16* A_, const bf16* Bt_, int M, int N, int K_, int G_, int c_) { A = (const char*)A_; Bt = (const char*)Bt_; K = K_; nM = M / 256; nN = N / 256; nwg = nM * nN; G = G_; c = c_; }
    __device__ __forceinline__ bool next(int i, pg8::Unit& u) const {
        const long L = (long)i * G + c; if (L >= nwg) return false;
        int wgid = (int)L; { const int q = nwg / 8, r = nwg % 8, xcd = wgid % 8, off = wgid / 8; wgid = (xcd < r ? xcd * (q + 1) : r * (q + 1) + (xcd - r) * q) + off; }
        const int nig = 8 * nN, gid = wgid / nig, fm = gid * 8, gsz = (nM - fm) < 8 ? (nM - fm) : 8;
        u.pm = fm + ((wgid % nig) % gsz); u.pn = (wgid % nig) / gsz; if (rev) u.pn = nN - 1 - u.pn; u.aux = 0; u.tl = 0;
        u.A = A + (size_t)u.pm * 256 * K * 2; u.B = Bt + (size_t)u.pn * 256 * K * 2; return true;
    }
    __device__ __forceinline__ void aoff(const pg8::Unit&, const int (&R)[2], const int (&C)[2], unsigned (&o)[2][2]) const {
#pragma unroll
        for (int h = 0; h < 2; ++h)
#pragma unroll
            for (int i = 0; i < 2; ++i) o[h][i] = (unsigned)((128 * h + R[i]) * K + C[i]) * 2u;
    }
};
struct SchedBranch2 : SchedDense { static constexpr int SEG = 16; };
template <bool GATHER_, int NPN>
struct SchedMoe {
    static constexpr bool GATHER = GATHER_; static constexpr int SEG = 0; static constexpr size_t dA = 0, dB = 0;
    const char* A; const char* Bt; LAS const unsigned char* misc; const int* list; int G, c;
    __device__ __forceinline__ bool next(int i, pg8::Unit& u) const {
        LAS const int* cl = (LAS const int*)(misc + MT_CNT); LAS const int* ps = (LAS const int*)(misc + MT_PSTART);
        if ((G & 7) == 0) {
            const int x = c & 7, r = c >> 3, n = G >> 3;
            int k = (i * n + r) / NPN; const int pn = (i * n + r) % NPN;
#pragma unroll
            for (int j = 0; j < 4; ++j) { const int e = x + 8 * j, nt = (cl[e] + 255) >> 8;
                if (k < nt) { u.pn = pn; u.aux = e; u.tl = k; u.pm = (ps[e] >> 8) + k;
                    u.A = GATHER ? A : A + (size_t)u.pm * 256 * 1024; u.B = Bt + ((size_t)e * NPN + pn) * 256 * 1024; return true; }
                k -= nt; }
            return false;
        }
        const int nact = *(LAS const int*)(misc + MT_NACT);
        const int L = i * G + c; if (L >= nact * NPN) return false;
        const int k = L / NPN; u.pn = L % NPN; const int w = ((LAS const int*)(misc + MT_ATILE))[k];
        u.pm = w & 0xfff; u.aux = (w >> 12) & 0xff; u.tl = w >> 20;
        u.A = GATHER ? A : A + (size_t)u.pm * 256 * 1024;
        u.B = Bt + ((size_t)u.aux * NPN + u.pn) * 256 * 1024; return true;
    }
    __device__ __forceinline__ void aoff(const pg8::Unit& u, const int (&R)[2], const int (&C)[2], unsigned (&o)[2][2]) const {
        const int ce = ((LAS const int*)(misc + MT_CNT))[u.aux];
#pragma unroll
        for (int h = 0; h < 2; ++h)
#pragma unroll
            for (int i = 0; i < 2; ++i) {
                if (GATHER) { const int idx = u.tl * 256 + 128 * h + R[i]; const int tok = (idx < ce) ? list[u.aux * NTOK + idx] : 0; o[h][i] = (unsigned)tok * 1024u + (unsigned)C[i] * 2u; }
                else o[h][i] = (unsigned)((128 * h + R[i]) * 1024 + C[i] * 2);
            }
    }
};

struct EpiProj {
    static constexpr bool PERM = true;
    __device__ __forceinline__ void prefetch(const pg8::Unit&, int, int, int) const {}
    bf16* proj; LAS const float* gtab;
    __device__ __forceinline__ void operator()(pg8::Acc& acc, const pg8::Unit& u, int wr, int wc, int fr, int fq, int slot) const {
        const int pn = u.pn;
        int mode;
        if (pn < 4) mode = 1; else if (pn == 4) mode = (wc < 2) ? 2 : 0; else if (pn < 7) mode = 0; else if (pn < 9) mode = 3; else if (pn < 13) mode = 0; else if (pn < 17) mode = 4; else mode = 5;
        float gn[2][8];
        if (mode == 1 || mode == 2) { LAS const float* g = gtab + ((mode == 1) ? 0 : 64);
#pragma unroll
            for (int bj = 0; bj < 2; ++bj)
#pragma unroll
                for (int j = 0; j < 8; ++j) gn[bj][j] = g[32 * bj + 8 * fq + j]; }
#pragma unroll
        for (int ai = 0; ai < 2; ++ai)
#pragma unroll
            for (int m = 0; m < 4; ++m) {
                const int r = u.pm * 256 + ai * 128 + wr * 64 + m * 16 + fr;
                bf16* rowp = proj + (size_t)r * INW + pn * 256 + wc * 64 + 8 * fq;
                f32x4 v[2][2];
#pragma unroll
                for (int bj = 0; bj < 2; ++bj) { v[bj][0] = acc[ai][bj][m][0]; v[bj][1] = acc[ai][bj][m][1]; }
                if (mode == 1 || mode == 2) {
                    float ss = 0.f;
#pragma unroll
                    for (int bj = 0; bj < 2; ++bj)
#pragma unroll
                        for (int n = 0; n < 2; ++n) ss += v[bj][n][0] * v[bj][n][0] + v[bj][n][1] * v[bj][n][1] + v[bj][n][2] * v[bj][n][2] + v[bj][n][3] * v[bj][n][3];
                    ss += __shfl_xor(ss, 16); ss += __shfl_xor(ss, 32);
                    const float rs = rsqrtf(ss * (1.0f / 64.0f) + EPS);
#pragma unroll
                    for (int bj = 0; bj < 2; ++bj)
#pragma unroll
                        for (int n = 0; n < 2; ++n)
#pragma unroll
                            for (int i = 0; i < 4; ++i) v[bj][n][i] = v[bj][n][i] * rs * gn[bj][4 * n + i];
                } else if (mode == 3) {
#pragma unroll
                    for (int bj = 0; bj < 2; ++bj)
#pragma unroll
                        for (int n = 0; n < 2; ++n) v[bj][n] = v[bj][n] * 0.08838834764831845f;
                } else if (mode == 4) {
#pragma unroll
                    for (int bj = 0; bj < 2; ++bj)
#pragma unroll
                        for (int n = 0; n < 2; ++n)
#pragma unroll
                            for (int i = 0; i < 4; ++i) { const float x = v[bj][n][i]; v[bj][n][i] = x * sigmoidf_(x); }
                } else if (mode == 5) {
#pragma unroll
                    for (int bj = 0; bj < 2; ++bj)
#pragma unroll
                        for (int n = 0; n < 2; ++n)
#pragma unroll
                            for (int i = 0; i < 4; ++i) v[bj][n][i] = sigmoidf_(v[bj][n][i]);
                }
#pragma unroll
                for (int bj = 0; bj < 2; ++bj) *(u32x4*)(rowp + 32 * bj) = pack8(v[bj][0], v[bj][1]);
            }
    }
};
struct EpiBranch2 {
    static constexpr bool PERM = true;
    __device__ __forceinline__ void prefetch(const pg8::Unit&, int, int, int) const {}
    bf16* merged; const bf16* proj;
    __device__ __forceinline__ void mid(pg8::Acc& acc, const pg8::Unit& u, int wr, int wc, int fr, int fq) const {
#pragma unroll
        for (int ai = 0; ai < 2; ++ai)
#pragma unroll
            for (int mp = 0; mp < 2; ++mp) {
                u32x4 ga[2][2], gr[2][2];
#pragma unroll
                for (int mm = 0; mm < 2; ++mm)
#pragma unroll
                    for (int bj = 0; bj < 2; ++bj) {
                        const bf16* gp = proj + (size_t)(u.pm * 256 + ai * 128 + wr * 64 + (2 * mp + mm) * 16 + fr) * INW + u.pn * 256 + bj * 128 + wc * 32 + 8 * fq;
                        ga[mm][bj] = *(const u32x4*)(gp + C_GA); gr[mm][bj] = *(const u32x4*)(gp + C_GR);
                    }
#pragma unroll
                for (int mm = 0; mm < 2; ++mm)
#pragma unroll
                    for (int bj = 0; bj < 2; ++bj) {
                        const int m = 2 * mp + mm; float a[8], r[8]; unpack8(ga[mm][bj], a); unpack8(gr[mm][bj], r);
#pragma unroll
                        for (int i = 0; i < 4; ++i) { acc[ai][bj][m][0][i] *= a[i] * __builtin_amdgcn_rcpf(fmaxf(r[i], 1e-20f)); acc[ai][bj][m][1][i] *= a[4 + i] * __builtin_amdgcn_rcpf(fmaxf(r[4 + i], 1e-20f)); }
                    }
            }
    }
    __device__ __forceinline__ void operator()(pg8::Acc& acc, const pg8::Unit& u, int wr, int wc, int fr, int fq, int slot) const {
#pragma unroll
        for (int ai = 0; ai < 2; ++ai)
#pragma unroll
            for (int mp = 0; mp < 2; ++mp) {
                u32x4 gr[2][2];
#pragma unroll
                for (int mm = 0; mm < 2; ++mm)
#pragma unroll
                    for (int bj = 0; bj < 2; ++bj)
                        gr[mm][bj] = *(const u32x4*)(proj + (size_t)(u.pm * 256 + ai * 128 + wr * 64 + (2 * mp + mm) * 16 + fr) * INW + C_GR + u.pn * 256 + bj * 128 + wc * 32 + 8 * fq);
#pragma unroll
                for (int mm = 0; mm < 2; ++mm)
#pragma unroll
                    for (int bj = 0; bj < 2; ++bj) {
                        const int m = 2 * mp + mm; float r[8]; unpack8(gr[mm][bj], r);
                        f32x4 a = acc[ai][bj][m][0], b = acc[ai][bj][m][1];
                        a[0] *= r[0]; a[1] *= r[1]; a[2] *= r[2]; a[3] *= r[3]; b[0] *= r[4]; b[1] *= r[5]; b[2] *= r[6]; b[3] *= r[7];
                        *(u32x4*)(merged + (size_t)(u.pm * 256 + ai * 128 + wr * 64 + m * 16 + fr) * D + u.pn * 256 + bj * 128 + wc * 32 + 8 * fq) = pack8(a, b);
                    }
            }
    }
};
struct EpiOut {
    static constexpr bool PERM = true;
    __device__ __forceinline__ void prefetch(const pg8::Unit&, int, int, int) const {}
    const float* x; bf16* h2b;
    __device__ __forceinline__ void load(f32x4 (&xv)[2][2][2], const pg8::Unit& u, int q, int wr, int wc, int fr, int fq) const {
#pragma unroll
        for (int mm = 0; mm < 2; ++mm) { const size_t off = (size_t)(u.pm * 256 + (q >> 1) * 128 + wr * 64 + (2 * (q & 1) + mm) * 16 + fr) * D + u.pn * 256 + wc * 32 + 8 * fq;
#pragma unroll
            for (int bj = 0; bj < 2; ++bj)
#pragma unroll
                for (int n = 0; n < 2; ++n) xv[mm][bj][n] = *(const f32x4*)(x + off + bj * 128 + n * 4); }
    }
    __device__ __forceinline__ void operator()(pg8::Acc& acc, const pg8::Unit& u, int wr, int wc, int fr, int fq, int slot) const {
        f32x4 xA[2][2][2], xB[2][2][2];
        load(xA, u, 0, wr, wc, fr, fq);
#pragma unroll
        for (int q = 0; q < 4; ++q) {
            if (q < 3) { if (q & 1) load(xA, u, q + 1, wr, wc, fr, fq); else load(xB, u, q + 1, wr, wc, fr, fq); }
            const int ai = q >> 1;
#pragma unroll
            for (int mm = 0; mm < 2; ++mm) { const int m = 2 * (q & 1) + mm; const size_t off = (size_t)(u.pm * 256 + ai * 128 + wr * 64 + m * 16 + fr) * D + u.pn * 256 + wc * 32 + 8 * fq;
#pragma unroll
                for (int bj = 0; bj < 2; ++bj) {
                    const f32x4 a = ((q & 1) ? xB[mm][bj][0] : xA[mm][bj][0]) + acc[ai][bj][m][0], b = ((q & 1) ? xB[mm][bj][1] : xA[mm][bj][1]) + acc[ai][bj][m][1];
                    *(u32x4*)(h2b + off + bj * 128) = pack8(a, b); } }
        }
    }
};
struct EpiGU {
    static constexpr bool PERM = true;
    unsigned char* act; const float* bgu; const float* rlist; LAS unsigned char* misc;
    __device__ __forceinline__ void prefetch(const pg8::Unit& u, int slot, int wid, int lane) const {
        if (wid < 4) __builtin_amdgcn_global_load_lds((const unsigned*)(rlist + (size_t)u.aux * NTOK + u.tl * 256 + wid * 64 + lane), (LAS unsigned*)(misc + MT_EPI + slot * 1024 + wid * 256), 4, 0, 0);
        else __builtin_amdgcn_global_load_lds((const unsigned*)(bgu + (size_t)u.aux * 2048 + ((wid - 4) >> 1) * 1024 + u.pn * 128 + ((wid - 4) & 1) * 64 + lane), (LAS unsigned*)(misc + MT_EPI2 + slot * 1024 + (wid - 4) * 256), 4, 0, 0);
    }
    __device__ __forceinline__ void operator()(pg8::Acc& acc, const pg8::Unit& u, int wr, int wc, int fr, int fq, int slot) const {
        const int ce = ((LAS const int*)(misc + MT_CNT))[u.aux];
        const int col = u.pn * 128 + wc * 32 + 8 * fq;
        LAS const float* bl = (LAS const float*)(misc + MT_EPI2 + slot * 1024) + wc * 32 + 8 * fq;
        float bgate[8], bup[8];
#pragma unroll
        for (int j = 0; j < 8; ++j) { bgate[j] = bl[j]; bup[j] = bl[128 + j]; }
#pragma unroll
        for (int ai = 0; ai < 2; ++ai)
#pragma unroll
            for (int m = 0; m < 4; ++m) {
                const int lr = ai * 128 + wr * 64 + m * 16 + fr, r = u.pm * 256 + lr;
                const float rs = ((LAS const float*)(misc + MT_EPI + slot * 1024))[lr] * W8_INV;
                float o[8];
#pragma unroll
                for (int n = 0; n < 2; ++n)
#pragma unroll
                    for (int i = 0; i < 4; ++i) {
                        float gate = acc[ai][0][m][n][i] * rs + bgate[4 * n + i], up = acc[ai][1][m][n][i] * rs + bup[4 * n + i];
                        gate = fminf(gate, 7.0f); up = fminf(fmaxf(up, -7.0f), 7.0f);
                        o[4 * n + i] = (up + 1.0f) * gate * sigmoidf_(1.702f * gate);
                    }
                u32x2 w; w.x = pk4_fp8(o[0], o[1], o[2], o[3]); w.y = pk4_fp8(o[4], o[5], o[6], o[7]);
                *(u32x2*)(act + (size_t)r * DFF + col) = w;
            }
    }
};
struct EpiDown {
    static constexpr bool PERM = true;
    unsigned char* rows; const float* bdn; const float* wlist; LAS const unsigned char* misc;
    __device__ __forceinline__ void prefetch(const pg8::Unit& u, int slot, int wid, int lane) const {
        if (wid < 4) __builtin_amdgcn_global_load_lds((const unsigned*)(wlist + (size_t)u.aux * NTOK + u.tl * 256 + wid * 64 + lane), (LAS unsigned*)(misc + MT_EPI + slot * 1024 + wid * 256), 4, 0, 0);
        else __builtin_amdgcn_global_load_lds((const unsigned*)(bdn + (size_t)u.aux * D + u.pn * 256 + (wid - 4) * 64 + lane), (LAS unsigned*)(misc + MT_EPI2 + slot * 1024 + (wid - 4) * 256), 4, 0, 0);
    }
    __device__ __forceinline__ void operator()(pg8::Acc& acc, const pg8::Unit& u, int wr, int wc, int fr, int fq, int slot) const {
        const int ce = ((LAS const int*)(misc + MT_CNT))[u.aux];
#pragma unroll
        for (int ai = 0; ai < 2; ++ai)
#pragma unroll
            for (int m = 0; m < 4; ++m) {
                const int lr = ai * 128 + wr * 64 + m * 16 + fr, r = u.pm * 256 + lr, idx = u.tl * 256 + lr;
                const float w = (idx < ce) ? ((LAS const float*)(misc + MT_EPI + slot * 1024))[lr] * ROW8_SCALE : 0.f;
                LAS const float* bl = (LAS const float*)(misc + MT_EPI2 + slot * 1024) + wc * 32 + 8 * fq;
                asm volatile("" : "+v"(bl));
#pragma unroll
                for (int bj = 0; bj < 2; ++bj) {
                    const f32x4 b0 = *(const LAS f32x4*)(bl + bj * 128), b1 = *(const LAS f32x4*)(bl + bj * 128 + 4);
                    f32x4 a = acc[ai][bj][m][0], b = acc[ai][bj][m][1];
#pragma unroll
                    for (int i = 0; i < 4; ++i) { a[i] = (a[i] * W8_INV + b0[i]) * w; b[i] = (b[i] * W8_INV + b1[i]) * w; }
                    u32x2 o; o.x = pk4_fp8(a[0], a[1], a[2], a[3]); o.y = pk4_fp8(b[0], b[1], b[2], b[3]);
                    *(u32x2*)(rows + (size_t)r * D + u.pn * 256 + bj * 128 + wc * 32 + 8 * fq) = o;
                }
            }
    }
};
namespace attn {
typedef float f32x16 __attribute__((ext_vector_type(16)));
typedef short s16x4 __attribute__((ext_vector_type(4)));
constexpr int NK = 272, K_OFF = 0, V_OFF = 34816, WS_OFF = 69632, OST_OFF = 71680, LDS_END = OST_OFF + 8 * 4096;
constexpr float LOG2E = 1.4426950408889634f;
__device__ __forceinline__ s16x4 vtr(LAS const unsigned char* p) { return __builtin_bit_cast(s16x4, __builtin_amdgcn_ds_read_tr16_b64_v4i16((LAS s16x4*)p)); }
__device__ __forceinline__ int crowc(int r) { return (r & 3) + 8 * (r >> 2); }

template <int TYPE, bool DIAG>
__device__ __forceinline__ void tile(LAS const unsigned char* lds, int kbase, const bf16x8 (&qr)[4], f32x16 (&o)[2], float& l, float lanebase, float c1, int tt, int lane) {
    const int r32 = lane & 31, hi = lane >> 5;
    f32x16 p;
#pragma unroll
    for (int r = 0; r < 16; ++r) p[r] = __builtin_fmaf(c1, (float)crowc(r), lanebase);
#pragma unroll
    for (int d0 = 0; d0 < 4; ++d0) {
        const bf16x8 kf = *(const LAS bf16x8*)(lds + K_OFF + (2 * d0 + hi) * (NK * 16) + (kbase + r32) * 16);
        p = __builtin_amdgcn_mfma_f32_32x32x16_bf16(kf, qr[d0], p, 0, 0, 0);
    }
    constexpr int NR = (TYPE == 0) ? 8 : 16;
    float e[16];
#pragma unroll
    for (int r = 0; r < NR; ++r) {
        float v = __builtin_amdgcn_exp2f(p[r]);
        if (DIAG) { const bool ok = (TYPE == 1) ? (crowc(r) > tt) : (crowc(r) <= tt); v = ok ? v : 0.f; }
        e[r] = v; l += v;
    }
    constexpr int NS = (TYPE == 0) ? 1 : 2;
    u32x4 pw[2];
#pragma unroll
    for (int s = 0; s < NS; ++s) { pw[s].x = pk2(e[8 * s + 0], e[8 * s + 1]); pw[s].y = pk2(e[8 * s + 2], e[8 * s + 3]); pw[s].z = pk2(e[8 * s + 4], e[8 * s + 5]); pw[s].w = pk2(e[8 * s + 6], e[8 * s + 7]); }
    LAS const unsigned char* vb = lds + V_OFF + (kbase + 4 * hi + ((lane & 15) >> 2)) * 64 + ((lane >> 4) & 1) * 32 + (lane & 3) * 8;
#pragma unroll
    for (int d0 = 0; d0 < 2; ++d0)
#pragma unroll
        for (int s = 0; s < NS; ++s) {
            const s16x4 lo = vtr(vb + d0 * (NK * 64) + s * 1024), hh = vtr(vb + d0 * (NK * 64) + s * 1024 + 512);
            const bf16x8 vf = (bf16x8){lo[0], lo[1], lo[2], lo[3], hh[0], hh[1], hh[2], hh[3]};
            o[d0] = __builtin_amdgcn_mfma_f32_32x32x16_bf16(__builtin_bit_cast(bf16x8, pw[s]), vf, o[d0], 0, 0, 0);
        }
}

#define AT_ISSUE(u_) do { const int u__ = (u_); const int b_ = u__ >> 6, qb_ = (u__ >> 1) & 31, kvh_ = u__ & 1; \
        _Pragma("unroll") for (int i = 0; i < 5; ++i) { const int idx = tid + 512 * i; if (idx < NK * 8) { const int key = idx >> 3, c = idx & 7; const bf16* rowp; \
            if (key < 16) rowp = pmeta + (size_t)key * INW; else { int j = qb_ * 128 - 128 + (key - 16); if (j < 0) j = 0; rowp = proj + ((size_t)b_ * SEQ + j) * INW; } \
            pk[i] = *(const u32x4*)(rowp + C_AK + kvh_ * 64 + c * 8); pv[i] = *(const u32x4*)(rowp + C_AV + kvh_ * 64 + c * 8); } } } while (0)
#define AT_QLOAD(dst, a_) do { const size_t qrow_ = (size_t)b * SEQ + qb * 128 + 32 * (a_) + r32; \
        _Pragma("unroll") for (int d0 = 0; d0 < 4; ++d0) dst[d0] = *(const bf16x8*)(proj + qrow_ * INW + C_AQ + h * 64 + d0 * 16 + hi * 8); } while (0)
__device__ __forceinline__ void phase(LAS unsigned char* lds, const bf16* __restrict__ proj, const bf16* __restrict__ pmeta, const float* __restrict__ sinks, float bshift, bf16* __restrict__ yatt, int G, int bx) {
    const int tid = threadIdx.x, lane = tid & 63, r32 = lane & 31, hi = lane >> 5; const int wave = __builtin_amdgcn_readfirstlane(tid >> 6);
    constexpr int NU = NB * 32 * 2;
    if (bx >= NU) return;
    u32x4 pk[5], pv[5];
    AT_ISSUE(bx);
    for (int u = bx; u < NU; u += G) {
        const int b = u >> 6, qb = (u >> 1) & 31, kvh = u & 1;
#pragma unroll
        for (int i = 0; i < 5; ++i) { const int idx = tid + 512 * i; if (idx < NK * 8) { const int key = idx >> 3, c = idx & 7;
            *(LAS u32x4*)(lds + K_OFF + c * (NK * 16) + key * 16) = pk[i];
            *(LAS u32x4*)(lds + V_OFF + (c >> 2) * (NK * 64) + key * 64 + (c & 3) * 16) = pv[i]; } }
        if (u + G < NU) AT_ISSUE(u + G);
        const int h = kvh * 8 + wave;
        bf16x8 qr[4], qn[4];
        AT_QLOAD(qr, 0);
        __syncthreads();
        const float slope = exp2f(-0.5f * (float)(h + 1)), sink = sinks[h];
        const float M = fmaxf(bshift, sink);
        const float c1 = slope * LOG2E;
        LAS float* wsf = (LAS float*)(lds + WS_OFF) + wave * 64;
        LAS bf16* stg = (LAS bf16*)(lds + OST_OFF) + wave * 2048;
#pragma unroll 1
        for (int a = 0; a < 4; ++a) {
            if (a < 3) AT_QLOAD(qn, a + 1);
            f32x16 o[2]; o[0] = f32x16{}; o[1] = f32x16{};
            float l = 0.f;
            const int t = 32 * a + r32;
            const int tt = r32 - 4 * hi;
            const float hi4 = c1 * 4.0f * (float)hi;
            tile<0, false>(lds, 0, qr, o, l, -(slope * (float)(qb * 128 + t + 16) + M) * LOG2E + hi4, c1, tt, lane);
            if (qb > 0) {
                tile<1, true>(lds, 16 + 32 * a, qr, o, l, -(slope * (float)(128 + r32) + M) * LOG2E + hi4, c1, tt, lane);
                for (int bb = a + 1; bb < 4; ++bb) tile<1, false>(lds, 16 + 32 * bb, qr, o, l, -(slope * (float)(128 + t - 32 * bb) + M) * LOG2E + hi4, c1, tt, lane);
            }
            for (int bb = 0; bb < a; ++bb) tile<2, false>(lds, 144 + 32 * bb, qr, o, l, -(slope * (float)(t - 32 * bb) + M) * LOG2E + hi4, c1, tt, lane);
            tile<2, true>(lds, 144 + 32 * a, qr, o, l, -(slope * (float)r32 + M) * LOG2E + hi4, c1, tt, lane);
            l += __shfl_xor(l, 32);
            l += exp2f((sink - M) * LOG2E);
            if (hi == 0) wsf[r32] = l;
            LDS_WAIT();
            float rli[16];
#pragma unroll
            for (int r = 0; r < 16; ++r) rli[r] = __builtin_amdgcn_rcpf(wsf[crowc(r) + 4 * hi]);
#pragma unroll
            for (int r = 0; r < 16; ++r) { const int orow = crowc(r) + 4 * hi;
#pragma unroll
                for (int d0 = 0; d0 < 2; ++d0) stg[orow * 64 + d0 * 32 + r32] = f2bf(o[d0][r] * rli[r]); }
            LDS_WAIT();
            bf16* Ow = yatt + ((size_t)b * SEQ + qb * 128 + 32 * a) * D + h * 64;
#pragma unroll
            for (int i = 0; i < 4; ++i) { const int row = i * 8 + (lane >> 3), ch = lane & 7; const u32x4 v = *(const LAS u32x4*)(stg + row * 64 + ch * 8); *(u32x4*)(Ow + (size_t)row * D + ch * 8) = v; }
            LDS_WAIT();
#pragma unroll
            for (int d0 = 0; d0 < 4; ++d0) qr[d0] = qn[d0];
        }
        __syncthreads();
    }
}
#undef AT_ISSUE
#undef AT_QLOAD
}
namespace ret {
typedef float f32x16 __attribute__((ext_vector_type(16)));
typedef short s16x4 __attribute__((ext_vector_type(4)));
constexpr size_t WS_STATES = 893 * MiB;
__device__ __forceinline__ s16x4 vtr(LAS const unsigned char* p) { return __builtin_bit_cast(s16x4, __builtin_amdgcn_ds_read_tr16_b64_v4i16((LAS s16x4*)p)); }
__device__ __forceinline__ int crowc(int r) { return (r & 3) + 8 * (r >> 2); }
__device__ __forceinline__ float lg2gamma(int h) { return log2f(1.0f - exp2f(-5.0f - (float)h)); }

constexpr int R1_BUF = 40960;
#define RET_ISSUE(KR, VR, c_) do { const int ci__ = (c_); \
        _Pragma("unroll") for (int i = 0; i < 4; ++i) { const int idx = tid + 512 * i, key = idx >> 4, ch = idx & 15; \
            if (ci__ == 0) { KR[i] = (key >= 112) ? *(const u32x4*)(pmeta + (size_t)(key - 112) * INW + C_RK + h * 128 + ch * 8) : (u32x4){0u, 0u, 0u, 0u}; } \
            else KR[i] = *(const u32x4*)(proj + ((size_t)b * SEQ + (ci__ - 1) * 128 + key) * INW + C_RK + h * 128 + ch * 8); } \
        { const int key = tid >> 2, ch = tid & 3; \
          if (ci__ == 0) VR = (key >= 112) ? *(const u32x4*)(pmeta + (size_t)(key - 112) * INW + C_RV + h * 256 + dvs * 32 + ch * 8) : (u32x4){0u, 0u, 0u, 0u}; \
          else VR = *(const u32x4*)(proj + ((size_t)b * SEQ + (ci__ - 1) * 128 + key) * INW + C_RV + h * 256 + dvs * 32 + ch * 8); } } while (0)
#define RET_STEP(KR, VR, c_) do { const int c__ = (c_); LAS unsigned char* buf = lds + (c__ & 1) * R1_BUF; \
        _Pragma("unroll") for (int i = 0; i < 4; ++i) { const int idx = tid + 512 * i, key = idx >> 4, ch = idx & 15; *(LAS u32x4*)(buf + (ch >> 2) * (128 * 64) + key * 64 + (ch & 3) * 16) = KR[i]; } \
        { const int key = tid >> 2, ch = tid & 3; float f[8]; unpack8(VR, f); u32x4 w; \
          w.x = pk2(f[0] * vscale, f[1] * vscale); w.y = pk2(f[2] * vscale, f[3] * vscale); w.z = pk2(f[4] * vscale, f[5] * vscale); w.w = pk2(f[6] * vscale, f[7] * vscale); \
          *(LAS u32x4*)(buf + 32768 + key * 64 + ch * 16) = w; } \
        if (c__ + 2 < 32) RET_ISSUE(KR, VR, c__ + 2); \
        __syncthreads(); \
        if (wave < 4) { \
            const int dt = wave; \
            acc = acc * g128; \
            LAS const unsigned char* ab = buf + dt * (128 * 64) + (4 * hi + ((lane & 15) >> 2)) * 64 + ((lane >> 4) & 1) * 32 + (lane & 3) * 8; \
            LAS const unsigned char* bb = buf + 32768 + (4 * hi + ((lane & 15) >> 2)) * 64 + ((lane >> 4) & 1) * 32 + (lane & 3) * 8; \
            _Pragma("unroll") for (int ks = 0; ks < 8; ++ks) { \
                const s16x4 al = vtr(ab + ks * 1024), ah = vtr(ab + ks * 1024 + 512), bl = vtr(bb + ks * 1024), bh = vtr(bb + ks * 1024 + 512); \
                const bf16x8 af = (bf16x8){al[0], al[1], al[2], al[3], ah[0], ah[1], ah[2], ah[3]}, bfr = (bf16x8){bl[0], bl[1], bl[2], bl[3], bh[0], bh[1], bh[2], bh[3]}; \
                acc = __builtin_amdgcn_mfma_f32_32x32x16_bf16(af, bfr, acc, 0, 0, 0); } \
            bf16* sb = states + ((((size_t)(b * 4 + h) * 32 + c__) * 8 + dvs) * 8) * 512; \
            _Pragma("unroll") for (int g = 0; g < 4; ++g) { u32x2 w; w.x = pk2(acc[4 * g], acc[4 * g + 1]); w.y = pk2(acc[4 * g + 2], acc[4 * g + 3]); \
                *(u32x2*)(sb + (size_t)(2 * dt + (g >> 1)) * 512 + (32 * (g & 1) + (lane & 31)) * 8 + 4 * hi) = w; } \
        } } while (0)
__device__ __forceinline__ void state_chain(LAS unsigned char* lds, int b, int h, int dvs, const bf16* __restrict__ proj, const bf16* __restrict__ pmeta, bf16* __restrict__ states) {
    const int tid = threadIdx.x, lane = tid & 63, hi = lane >> 5; const int wave = __builtin_amdgcn_readfirstlane(tid >> 6);
    const float lg = lg2gamma(h), g128 = exp2f(lg * 128.0f);
    u32x4 kA[4], kB[4], vA, vB;
    const float vscale = exp2f(lg * (float)(127 - (tid >> 2)));
    f32x16 acc = {};
    RET_ISSUE(kA, vA, 0); RET_ISSUE(kB, vB, 1);
#pragma unroll 1
    for (int c = 0; c < 32; c += 2) { RET_STEP(kA, vA, c); RET_STEP(kB, vB, c + 1); }
    __syncthreads();
}
#undef RET_ISSUE
#undef RET_STEP

constexpr int R3_K = 0, R3_Q = 32768, R3_V = 65536;
#define R3_ISSUE(u_) do { const int u__ = (u_); const size_t rw = (size_t)(u__ >> 7) * SEQ + (u__ & 31) * 128; const int hh = (u__ >> 5) & 3; \
        _Pragma("unroll") for (int i = 0; i < 4; ++i) { const int idx = tid + 512 * i, key = idx >> 4, ch = idx & 15; \
            kq[i] = *(const u32x4*)(proj + (rw + key) * INW + C_RK + hh * 128 + ch * 8); kq[4 + i] = *(const u32x4*)(proj + (rw + key) * INW + C_RQ + hh * 128 + ch * 8); } \
        _Pragma("unroll") for (int i = 0; i < 8; ++i) { const int idx = tid + 512 * i, key = idx >> 5, ch = idx & 31; vv[i] = *(const u32x4*)(proj + (rw + key) * INW + C_RV + hh * 256 + ch * 8); } } while (0)
__device__ __forceinline__ void out_phase(LAS unsigned char* lds, const bf16* __restrict__ proj, const bf16* __restrict__ states, bf16* __restrict__ yret, int G, int bx, const XcdBarrier pre_bar, const bool do_bar) {
    const int tid = threadIdx.x, lane = tid & 63, r32 = lane & 31, hi = lane >> 5; const int wave = __builtin_amdgcn_readfirstlane(tid >> 6);
    constexpr int NU = NB * 4 * 32;
    if (bx >= NU) { if (do_bar) xcd_barrier(pre_bar); return; }
    u32x4 kq[8], vv[8];
    R3_ISSUE(bx);
    if (do_bar) xcd_barrier(pre_bar);
    for (int u = bx; u < NU; u += G) {
        const int b = u >> 7, h = (u >> 5) & 3, tb = u & 31;
        const float lg = lg2gamma(h);
        const size_t row0 = (size_t)b * SEQ + tb * 128;
#pragma unroll
        for (int i = 0; i < 4; ++i) { const int idx = tid + 512 * i, key = idx >> 4, ch = idx & 15;
            *(LAS u32x4*)(lds + R3_K + ch * 2048 + key * 16) = kq[i]; *(LAS u32x4*)(lds + R3_Q + ch * 2048 + key * 16) = kq[4 + i]; }
#pragma unroll
        for (int i = 0; i < 8; ++i) { const int idx = tid + 512 * i, key = idx >> 5, ch = idx & 31; *(LAS u32x4*)(lds + R3_V + (ch >> 2) * 8192 + key * 64 + (ch & 3) * 16) = vv[i]; }
        if (u + G < NU) R3_ISSUE(u + G);
        bf16x8 sf[8];
        { const bf16* sb = states + (((size_t)(b * 4 + h) * 32 + tb) * 64 + (size_t)wave * 8) * 512 + lane * 8;
#pragma unroll
          for (int k = 0; k < 8; ++k) sf[k] = *(const bf16x8*)(sb + (size_t)k * 512); }
        __syncthreads();
        u32x2 pw[2][4];
        for (int rp_ = 0; rp_ < ((PROBE_PHASE == 31) ? 2 : 1); ++rp_)
#pragma unroll
        for (int ti = 0; ti < 2; ++ti) {
            const int t = wave + 8 * ti;
            if (t < 10) {
                const int a = (t >= 6) ? 3 : (t >= 3) ? 2 : (t >= 1) ? 1 : 0, bb = t - ((a * (a + 1)) >> 1);
                f32x16 p = {};
#pragma unroll
                for (int k = 0; k < 8; ++k) {
                    const bf16x8 kf = *(const LAS bf16x8*)(lds + R3_K + (2 * k + hi) * 2048 + (32 * bb + r32) * 16);
                    const bf16x8 qf = *(const LAS bf16x8*)(lds + R3_Q + (2 * k + hi) * 2048 + (32 * a + r32) * 16);
                    p = __builtin_amdgcn_mfma_f32_32x32x16_bf16(kf, qf, p, 0, 0, 0);
                }
                const float lanebase = lg * (float)(32 * (a - bb) + r32 - 4 * hi), cpos = -lg; const int tt = r32 - 4 * hi;
                float e[16];
#pragma unroll
                for (int r = 0; r < 16; ++r) { float v = p[r] * __builtin_amdgcn_exp2f(__builtin_fmaf(cpos, (float)crowc(r), lanebase)); if (bb == a) v = (crowc(r) <= tt) ? v : 0.f; e[r] = v; }
#pragma unroll
                for (int g = 0; g < 4; ++g) { pw[ti][g].x = pk2(e[4 * g], e[4 * g + 1]); pw[ti][g].y = pk2(e[4 * g + 2], e[4 * g + 3]); }
            }
        }
        __builtin_amdgcn_sched_barrier(0);
        bf16x8 vf[8];
        { LAS const unsigned char* vb = lds + R3_V + wave * 8192 + (8 * hi + ((lane & 15) >> 2)) * 64 + ((lane >> 4) & 1) * 32 + (lane & 3) * 8;
#pragma unroll
          for (int ks = 0; ks < 8; ++ks) { const s16x4 lo = vtr(vb + ks * 1024), hh = vtr(vb + ks * 1024 + 256); vf[ks] = (bf16x8){lo[0], lo[1], lo[2], lo[3], hh[0], hh[1], hh[2], hh[3]}; } }
        __syncthreads();
#pragma unroll
        for (int ti = 0; ti < 2; ++ti) {
            const int t = wave + 8 * ti;
            if (t < 10) {
                const int a = (t >= 6) ? 3 : (t >= 3) ? 2 : (t >= 1) ? 1 : 0, bb = t - ((a * (a + 1)) >> 1);
#pragma unroll
                for (int g = 0; g < 4; ++g) *(LAS u32x2*)(lds + R3_K + (4 * bb + g) * 2048 + (32 * a + r32) * 16 + hi * 8) = pw[ti][g];
            }
        }
        __syncthreads();
        LAS bf16* stg = (LAS bf16*)(lds + R3_V);
        for (int rp_ = 0; rp_ < ((PROBE_PHASE == 32) ? 2 : 1); ++rp_)
#pragma unroll 1
        for (int a = 0; a < 4; ++a) {
            f32x16 o = {};
#pragma unroll
            for (int ks = 0; ks < 8; ++ks) if (ks < 2 * (a + 1)) {
                const bf16x8 pa = *(const LAS bf16x8*)(lds + R3_K + (2 * ks + hi) * 2048 + (32 * a + r32) * 16);
                o = __builtin_amdgcn_mfma_f32_32x32x16_bf16(pa, vf[ks], o, 0, 0, 0);
            }
            f32x16 x = {};
#pragma unroll
            for (int k = 0; k < 8; ++k) { const bf16x8 qa = *(const LAS bf16x8*)(lds + R3_Q + (2 * k + hi) * 2048 + (32 * a + r32) * 16); x = __builtin_amdgcn_mfma_f32_32x32x16_bf16(qa, sf[k], x, 0, 0, 0); }
#pragma unroll
            for (int r = 0; r < 16; ++r) {
                const float din = __builtin_amdgcn_exp2f(lg * (float)(32 * a + crowc(r) + 4 * hi + 1));
                { const int row = 32 * a + crowc(r) + 4 * hi, col = wave * 32 + r32;
                  stg[row * 256 + ((((col >> 3) ^ ((row & 3) << 2)) << 3) | (col & 7))] = f2bf(o[r] + din * x[r]); }
            }
        }
        int nl = lane; asm volatile("" : "+v"(nl));
        const int nrow = wave * 16 + (nl >> 2), c4 = nl & 3, sx = nrow & 3;
        const bf16* rgp = proj + (row0 + nrow) * INW + C_RG + h * 256 + c4 * 8;
        bf16* yp = yret + (row0 + nrow) * D + h * 256 + c4 * 8;
        LAS const bf16* sp = stg + nrow * 256 + c4 * 8;
        u32x4 rgv[8];
#pragma unroll
        for (int j = 0; j < 8; ++j) rgv[j] = *(const u32x4*)(rgp + 32 * j);
        __syncthreads();
        for (int rp_ = 0; rp_ < ((PROBE_PHASE == 33) ? 2 : 1); ++rp_) {
            float ss = 0.f;
#pragma unroll
            for (int j = 0; j < 8; ++j) { const u32x4 sw = *(const LAS u32x4*)(sp + 32 * (j ^ sx)); float f[8]; unpack8(sw, f);
#pragma unroll
                for (int i = 0; i < 8; ++i) ss += f[i] * f[i]; }
            ss += __shfl_xor(ss, 1); ss += __shfl_xor(ss, 2);
            const float rs = rsqrtf(ss * (1.0f / 256.0f) + EPS);
            asm volatile("" ::: "memory");
#pragma unroll
            for (int j = 0; j < 8; ++j) { const u32x4 sw = *(const LAS u32x4*)(sp + 32 * (j ^ sx)); float f[8], g[8]; unpack8(sw, f); unpack8(rgv[j], g); u32x4 w;
                w.x = pk2(f[0] * rs * g[0], f[1] * rs * g[1]); w.y = pk2(f[2] * rs * g[2], f[3] * rs * g[3]); w.z = pk2(f[4] * rs * g[4], f[5] * rs * g[5]); w.w = pk2(f[6] * rs * g[6], f[7] * rs * g[7]);
                *(u32x4*)(yp + 32 * j) = w; }
        }
        __syncthreads();
    }
}
#undef R3_ISSUE
}
template <bool FP8>
__device__ __forceinline__ void p0_item(const float* __restrict__ W, int K, int N, void* __restrict__ WT, int k0, int n0, int dst_row0, int lane) {
    const int kblk = lane >> 3, nq = lane & 7;
    const float* src = W + (size_t)(k0 + 16 * kblk) * N + n0 + 4 * nq;
    f32x4 v[16];
#pragma unroll
    for (int i = 0; i < 16; ++i) v[i] = __builtin_nontemporal_load((const f32x4*)(src + (size_t)i * N));
#pragma unroll
    for (int j = 0; j < 4; ++j) {
        const size_t row = (size_t)(dst_row0 + 4 * nq + j);
        if constexpr (FP8) {
            u32x4 o;
            o.x = pk4_fp8(v[0][j] * W8_SCALE, v[1][j] * W8_SCALE, v[2][j] * W8_SCALE, v[3][j] * W8_SCALE); o.y = pk4_fp8(v[4][j] * W8_SCALE, v[5][j] * W8_SCALE, v[6][j] * W8_SCALE, v[7][j] * W8_SCALE);
            o.z = pk4_fp8(v[8][j] * W8_SCALE, v[9][j] * W8_SCALE, v[10][j] * W8_SCALE, v[11][j] * W8_SCALE); o.w = pk4_fp8(v[12][j] * W8_SCALE, v[13][j] * W8_SCALE, v[14][j] * W8_SCALE, v[15][j] * W8_SCALE);
            *(u32x4*)((unsigned char*)WT + row * K + k0 + 16 * kblk) = o;
        } else {
            u32x4 a, b;
            a.x = pk2(v[0][j], v[1][j]); a.y = pk2(v[2][j], v[3][j]); a.z = pk2(v[4][j], v[5][j]); a.w = pk2(v[6][j], v[7][j]);
            b.x = pk2(v[8][j], v[9][j]); b.y = pk2(v[10][j], v[11][j]); b.z = pk2(v[12][j], v[13][j]); b.w = pk2(v[14][j], v[15][j]);
            bf16* d = (bf16*)WT + row * K + k0 + 16 * kblk;
            *(u32x4*)d = a; *(u32x4*)(d + 8) = b;
        }
    }
}
constexpr int I_IN = 8 * 200, I_SQ = 8 * 32, I_GU = 32 * 8 * 64, I_DN = 32 * 8 * 32, NITEMS = I_IN + 3 * I_SQ + I_GU + I_DN;
constexpr int G1_UNITS = ((NTOK + 256) / 256) * (INW / 256), G1_SHORT = 256 - (G1_UNITS % 256), MOVE_PER_WAVE = 5, NMOVE = (G1_UNITS % 256) ? G1_SHORT * 8 * MOVE_PER_WAVE : 0;
#define P0_DISPATCH(it_) do { int r = (it_); \
    if (r < I_IN) { const int kb = r / 200, nb = r % 200, n0 = nb * 32, o = n0 & 255, wcc = o >> 6, bj = (o >> 5) & 1; \
        p0_item<false>(w_in, D, INW, Win_t, kb * 128, n0, (n0 & ~255) + 128 * bj + 32 * wcc, lane); break; } \
    r -= I_IN; \
    if (r < I_SQ) { p0_item<false>(w_ab, D, D, Wab_t, (r / 32) * 128, (r % 32) * 32, (r % 32) * 32, lane); break; } r -= I_SQ; \
    if (r < I_SQ) { p0_item<false>(w_rb, D, D, Wrb_t, (r / 32) * 128, (r % 32) * 32, (r % 32) * 32, lane); break; } r -= I_SQ; \
    if (r < I_SQ) { p0_item<false>(w_out, D, D, Wout_t, (r / 32) * 128, (r % 32) * 32, (r % 32) * 32, lane); break; } r -= I_SQ; \
    if (r < I_GU) { const int e = r / 512, q = r % 512, kb = q / 64, nb = q % 64, n0 = nb * 32, bj = n0 >> 10, rem = n0 & 1023, pn = rem >> 7, cl = rem & 127; \
        p0_item<true>(w_gu + (size_t)e * D * 2048, D, 2048, Wgu_t + (size_t)e * 2048 * D, kb * 128, n0, 256 * pn + 128 * bj + cl, lane); break; } \
    r -= I_GU; \
    { const int e = r / 256, q = r % 256, kb = q / 32, nb = q % 32; \
      p0_item<true>(w_dn + (size_t)e * DFF * D, DFF, D, Wdn_t + (size_t)e * D * DFF, kb * 128, nb * 32, nb * 32, lane); } } while (0)
#ifndef PROBE_PHASE
#define PROBE_PHASE (-1)
#endif
__device__ __forceinline__ void p0_transpose_item_fp8(const float* W, int K, int N, unsigned char* WT, int k0, int n0, int dst_row0, LAS float* scr, int lane) {
#pragma unroll 8
    for (int i = 0; i < 32; ++i) { const int kk = 2 * i + (lane >> 5); scr[kk * 33 + (lane & 31)] = W[(size_t)(k0 + kk) * N + n0 + (lane & 31)]; }
    LDS_WAIT(); asm volatile("" ::: "memory");
    const int c = lane & 3;
#pragma unroll
    for (int j = 0; j < 2; ++j) { const int n = (lane >> 2) + 16 * j; const LAS float* s = scr + (16 * c) * 33 + n;
        u32x4 o;
        o.x = pk4_fp8(s[0 * 33] * W8_SCALE, s[1 * 33] * W8_SCALE, s[2 * 33] * W8_SCALE, s[3 * 33] * W8_SCALE); o.y = pk4_fp8(s[4 * 33] * W8_SCALE, s[5 * 33] * W8_SCALE, s[6 * 33] * W8_SCALE, s[7 * 33] * W8_SCALE);
        o.z = pk4_fp8(s[8 * 33] * W8_SCALE, s[9 * 33] * W8_SCALE, s[10 * 33] * W8_SCALE, s[11 * 33] * W8_SCALE); o.w = pk4_fp8(s[12 * 33] * W8_SCALE, s[13 * 33] * W8_SCALE, s[14 * 33] * W8_SCALE, s[15 * 33] * W8_SCALE);
        *(u32x4*)(WT + (size_t)(dst_row0 + n) * K + k0 + 16 * c) = o; }
    LDS_WAIT(); asm volatile("" ::: "memory");
}
struct Args { const float* in[17]; float* out; unsigned char* ws; int ph_lo, ph_hi, li, pad; };

__global__ void __launch_bounds__(512, 2) mk_fwd(Args args) {
    extern __shared__ __attribute__((aligned(16))) unsigned char lds_raw[];
    LAS unsigned char* lds = (LAS unsigned char*)lds_raw;
    volatile LAS unsigned* MISC = (volatile LAS unsigned*)(lds + MISC_OFF);
    const int tid = threadIdx.x, lane = tid & 63, wave = __builtin_amdgcn_readfirstlane(tid >> 6);
    const int G = gridDim.x, bx = blockIdx.x;
    const int vcu = (G % 8 == 0) ? (bx % 8) * (G / 8) + bx / 8 : bx;
    unsigned char* ws = args.ws;
    unsigned* ctl = (unsigned*)(ws + WS_CTL);
    const float* x = args.in[0]; const float* meta = args.in[1]; const float* g1 = args.in[2]; const float* w_in = args.in[3];
    const float* qg = args.in[4]; const float* kg = args.in[5];
    const float* w_ab = args.in[7]; const float* w_rb = args.in[8]; const float* w_out = args.in[9];
    const float* w_gu = args.in[13]; const float* b_gu = args.in[14]; const float* w_dn = args.in[15]; const float* b_dn = args.in[16];
    float* out = args.out;
    bf16* Win_t = (bf16*)(ws + WS_WIN); bf16* Wab_t = (bf16*)(ws + WS_WAB); bf16* Wrb_t = (bf16*)(ws + WS_WRB); bf16* Wout_t = (bf16*)(ws + WS_WOUT);
    unsigned char* Wgu_t = ws + WS_WGU; unsigned char* Wdn_t = ws + WS_WDN;
    bf16* xb = (bf16*)(ws + WS_XB); bf16* proj = (bf16*)(ws + WS_PROJ); bf16* yatt = (bf16*)(ws + WS_YATT); bf16* yret = (bf16*)(ws + WS_YRET); bf16* merged = (bf16*)(ws + WS_MERGED);
    bf16* pmeta = proj + (size_t)NTOK * INW;
    const float* sinks = args.in[6]; const float* g2 = args.in[10]; const float* w_r = args.in[11]; const float* b_r = args.in[12];
    int* tke = (int*)(ws + SM_TKE); float* tkw = (float*)(ws + SM_TKW); int* tkpos = (int*)(ws + SM_TKPOS); int* list = (int*)(ws + SM_LIST); float* wlist = (float*)(ws + SM_WLIST); float* rlist = (float*)(ws + SM_RLIST);
    LAS unsigned char* misc = lds + MISC_OFF;
    bf16* states = (bf16*)(ws + ret::WS_STATES);
    bf16* h2b = (bf16*)(ws + ret::WS_STATES);
    unsigned char* act = ws + WS_ACT; unsigned char* rows = ws + WS_ROWS; unsigned char* xn8 = ws + WS_XB;

    for (int u = tid; u < (LDS_BYTES - MISC_OFF) / 4; u += 512) ((LAS unsigned*)(lds + MISC_OFF))[u] = 0u;
    __syncthreads();
    XcdBarrier bar = xcd_barrier_post(ctl + CW_BAR + args.li * XCD_BAR_WORDS, MISC + 8);
    const int lo = args.ph_lo, hi = args.ph_hi;
#define IN(k) (lo <= (k) && (k) < hi)
#define BOTH(k) (IN(k) && IN((k) + 1))
#define GRID_BAR() xcd_barrier(bar)

    if (IN(0)) { for (int rep_ = 0; rep_ < ((PROBE_PHASE == 0) ? 2 : 1); ++rep_) {
        const int gw = vcu * NWAVES + wave, NGW = G * NWAVES;
        for (int it = gw; it < NITEMS - NMOVE; it += NGW) { P0_DISPATCH(it); }
        for (int rep2_ = 0; rep2_ < ((PROBE_PHASE == 101) ? 2 : 1); ++rep2_)
        for (int row = gw; row < NTOK; row += NGW) {
            const f32x4* xr = (const f32x4*)(x + (size_t)row * D) + lane;
            f32x4 v[4]; float ss = 0.f;
#pragma unroll
            for (int j = 0; j < 4; ++j) { v[j] = xr[64 * j]; ss += (v[j][0] * v[j][0] + v[j][1] * v[j][1]) + (v[j][2] * v[j][2] + v[j][3] * v[j][3]); }
            const float rstd = rsqrtf(wave_sum(ss) * (1.0f / D) + EPS);
            u32x2* o8 = (u32x2*)(xb + (size_t)row * D) + lane;
#pragma unroll
            for (int j = 0; j < 4; ++j) { const f32x4 gg = ((const f32x4*)g1)[64 * j + lane]; u32x2 w; w.x = pk2(v[j][0] * rstd * gg[0], v[j][1] * rstd * gg[1]); w.y = pk2(v[j][2] * rstd * gg[2], v[j][3] * rstd * gg[3]); o8[64 * j] = w; }
        }
        for (int row = gw; row < 256; row += NGW) {
            u32x2* o8 = (u32x2*)(xb + (size_t)(NTOK + row) * D) + lane;
            if (row < NMETA) {
                const f32x4* xr = (const f32x4*)(meta + (size_t)row * D) + lane;
                f32x4 v[4]; float ss = 0.f;
#pragma unroll
                for (int j = 0; j < 4; ++j) { v[j] = xr[64 * j]; ss += (v[j][0] * v[j][0] + v[j][1] * v[j][1]) + (v[j][2] * v[j][2] + v[j][3] * v[j][3]); }
                const float rstd = rsqrtf(wave_sum(ss) * (1.0f / D) + EPS);
#pragma unroll
                for (int j = 0; j < 4; ++j) { const f32x4 gg = ((const f32x4*)g1)[64 * j + lane]; u32x2 w; w.x = pk2(v[j][0] * rstd * gg[0], v[j][1] * rstd * gg[1]); w.y = pk2(v[j][2] * rstd * gg[2], v[j][3] * rstd * gg[3]); o8[64 * j] = w; }
            } else {
#pragma unroll
                for (int j = 0; j < 4; ++j) o8[64 * j] = (u32x2){0u, 0u};
            }
        }
        __syncthreads(); }
        if (BOTH(0)) GRID_BAR();
    }
    if (PROBE_PHASE == 200) { GRID_BAR(); GRID_BAR(); GRID_BAR(); GRID_BAR(); }
    if (IN(1)) {
        SchedDense S; S.init(xb, Win_t, NTOK + 256, INW, D, G, bx);
        { LAS float* gt = (LAS float*)(misc + MT_GAIN); if (tid < 64) { gt[tid] = 0.125f * 1.4426950408889634f * qg[tid]; gt[64 + tid] = kg[tid]; }       __syncthreads(); }
        EpiProj E{proj, (LAS const float*)(misc + MT_GAIN)};
        pg8::gemm_phase<EpiProj, SchedDense>(lds, 2 * D, S, E);
        if (G == 256 && NMOVE > 0) {
            if (bx >= 256 - G1_SHORT) {
                const int s = bx - (256 - G1_SHORT);
#pragma unroll 1
                for (int j = 0; j < MOVE_PER_WAVE; ++j) P0_DISPATCH(NITEMS - NMOVE + j * (G1_SHORT * 8) + s * 8 + wave);
            }
        } else if (NMOVE > 0) {
            for (int it = NITEMS - NMOVE + vcu * NWAVES + wave; it < NITEMS; it += G * NWAVES) P0_DISPATCH(it);
        }
        if (BOTH(1)) GRID_BAR();
    }
    if (IN(2)) {
        float mq = fabsf(qg[lane]), mk = fabsf(kg[lane]);
#pragma unroll
        for (int o = 1; o < 64; o <<= 1) { mq = fmaxf(mq, __shfl_xor(mq, o)); mk = fmaxf(mk, __shfl_xor(mk, o)); }
        const float bshift = 8.0f * mq * mk;
        for (int rep_ = 0; rep_ < ((PROBE_PHASE == 20) ? 2 : 1); ++rep_) attn::phase(lds, proj, pmeta, sinks, bshift, yatt, G, bx);
        for (int rep_ = 0; rep_ < ((PROBE_PHASE == 21) ? 2 : 1); ++rep_) for (int u = bx; u < NB * 4 * 8; u += G) { const int v = ((G & 7) == 0 && G == 256) ? ((u & 7) * 32 + (u >> 3)) : u;
            ret::state_chain(lds, v >> 5, (v >> 3) & 3, v & 7, proj, pmeta, states); }
    }
    if (IN(3)) {
        ret::out_phase(lds, proj, states, yret, G, bx, bar, IN(2));
        if (BOTH(3)) GRID_BAR();
    }
    if (IN(4)) {
        SchedBranch2 S; S.init(yatt, Wab_t, NTOK, D, D, G, bx); S.dA = (size_t)(WS_YRET - WS_YATT) - 16 * 128; S.dB = (size_t)(WS_WRB - WS_WAB) - 16 * 128;
        EpiBranch2 E{merged, proj};
        pg8::gemm_phase<EpiBranch2, SchedBranch2>(lds, 2 * D, S, E);
        if (BOTH(4)) GRID_BAR();
    }
    if (IN(5)) {
        SchedDense S; S.init(merged, Wout_t, NTOK, D, D, G, bx);
        EpiOut E{x, h2b};
        pg8::gemm_phase<EpiOut, SchedDense>(lds, 2 * D, S, E);
        if (BOTH(5)) { route_images(lds, g2, w_r); GRID_BAR(); }
    }
    if (IN(6)) {
        if (!IN(5)) route_images(lds, g2, w_r);
        route_phase(lds, h2b, g2, w_r, b_r, xn8, tke, tkpos, tkw, list, wlist, rlist, ctl + CW_CNT, G, bx);
        if (BOTH(6)) GRID_BAR();
    }
    if (hi > 7 && lo <= 9) moe_tables(misc, ctl + CW_CNT);
    if (IN(7)) {
        SchedMoe<true, 8> S{(const char*)xn8, (const char*)Wgu_t, misc, list, G, bx};
        EpiGU E{act, b_gu, rlist, misc};
        pg8::gemm_phase<EpiGU, SchedMoe<true, 8>, true>(lds, D, S, E);
        if (BOTH(7)) GRID_BAR();
    }
    if (IN(8)) {
        SchedMoe<false, 4> S{(const char*)act, (const char*)Wdn_t, misc, list, G, bx};
        EpiDown E{rows, b_dn, wlist, misc};
        pg8::gemm_phase<EpiDown, SchedMoe<false, 4>, true>(lds, DFF, S, E);
        if (BOTH(8)) GRID_BAR();
    }
    if (IN(9)) combine_phase(misc, h2b, out, rows, tke, tkpos, vcu * NWAVES + wave, G * NWAVES, lane);
#undef IN
#undef BOTH
#undef GRID_BAR
}

extern "C" void kernel_launch(void* const* d_in, const int* in_sizes, int n_in, void* d_out, int out_size, void* d_ws, size_t ws_size, hipStream_t stream) {
    static int grid = 0;
    if (grid == 0) {
        if (n_in != 17 || in_sizes[0] != NTOK * D || out_size != NTOK * D || ws_size < WS_END) {
            fprintf(stderr, "kernel_launch: unexpected shapes (n_in %d in0 %d out %d ws %zu)\n", n_in, n_in > 0 ? in_sizes[0] : -1, out_size, ws_size); grid = -1; return; }
        int dev = 0, cus = 0;
        if (hipGetDevice(&dev) != hipSuccess || hipDeviceGetAttribute(&cus, hipDeviceAttributeMultiprocessorCount, dev) != hipSuccess) { grid = -1; return; }
        if (hipFuncSetAttribute((const void*)mk_fwd, hipFuncAttributeMaxDynamicSharedMemorySize, LDS_BYTES) != hipSuccess) { fprintf(stderr, "kernel_launch: hipFuncSetAttribute failed\n"); grid = -1; return; }
        grid = cus;
    }
    if (grid < 0) return;
    unsigned char* ws = (unsigned char*)d_ws;
    (void)hipMemsetAsync(ws + WS_CTL, 0, 1 * MiB, stream);
    Args a{};
    for (int i = 0; i < 17; ++i) a.in[i] = (const float*)d_in[i];
    a.out = (float*)d_out; a.ws = ws; a.ph_lo = 0; a.ph_hi = 10; a.li = 0; a.pad = 0;
    hipLaunchKernelGGL(mk_fwd, dim3(grid), dim3(512), LDS_BYTES, stream, a);
}
```

```cpp
#include <hip/hip_runtime.h>
#include <cstdio>
#include <cstdint>

typedef unsigned short bf16;
__device__ __forceinline__ float bf2f(bf16 v) { return __uint_as_float(((unsigned)v) << 16); }
__device__ __forceinline__ bf16 f2bf(float f) { const __bf16 b = (__bf16)f; return __builtin_bit_cast(unsigned short, b); }
__device__ __forceinline__ float sigmoidf_(float x) { return __builtin_amdgcn_rcpf(1.0f + __builtin_amdgcn_exp2f(-1.4426950408889634f * x)); }

constexpr int NB = 8, SEQ = 4096, D = 1024, NTOK = NB * SEQ;
constexpr int NMETA = 16;
constexpr int INW = 6400;
constexpr int C_AQ = 0, C_AK = 1024, C_AV = 1152, C_RQ = 1280, C_RK = 1792, C_RV = 2304, C_RG = 3328, C_GA = 4352, C_GR = 5376;
constexpr int NE = 32, TOPK = 4, DFF = 1024;
constexpr int NROWS = (NTOK * TOPK / 256 + NE) * 256;
constexpr int NTILE = NROWS / 256;
constexpr float EPS = 1e-5f;

constexpr size_t MiB = 1u << 20;
constexpr size_t WS_CTL = 0;
constexpr size_t WS_SMALL = 1 * MiB;
constexpr size_t WS_W = 16 * MiB;
constexpr size_t WS_XB = 232 * MiB;
constexpr size_t WS_PROJ = 297 * MiB;
constexpr size_t WS_YATT = 701 * MiB;
constexpr size_t WS_YRET = 765 * MiB;
constexpr size_t WS_MERGED = 829 * MiB;
constexpr size_t WS_END = 1020 * MiB;
constexpr size_t WS_ACT = 297 * MiB;
constexpr size_t WS_ROWS = 568 * MiB;
constexpr size_t SM_UMETA = WS_SMALL;
constexpr size_t SM_PMETA = WS_SMALL + 64 * 1024;
constexpr size_t SM_TKE = WS_SMALL + 512 * 1024;
constexpr size_t SM_TKW = SM_TKE + 512 * 1024;
constexpr size_t SM_TKPOS = SM_TKW + 512 * 1024;
constexpr size_t SM_TKROW = SM_TKPOS + 512 * 1024;
constexpr size_t SM_ROWTOK = SM_TKROW + 512 * 1024;
constexpr size_t SM_ROWW = SM_ROWTOK + 1024 * 1024;
constexpr size_t SM_TILEE = SM_ROWW + 1024 * 1024;
constexpr int CW_CNT = 1024;

#ifndef PROBE_PHASE
#define PROBE_PHASE (-1)
#endif
#define LAS __attribute__((address_space(3)))
#define GAS __attribute__((address_space(1)))
typedef short bf16x8 __attribute__((ext_vector_type(8)));
typedef float f32x4 __attribute__((ext_vector_type(4)));
typedef float f32x2 __attribute__((ext_vector_type(2)));
typedef unsigned u32x4 __attribute__((ext_vector_type(4)));
typedef unsigned u32x2 __attribute__((ext_vector_type(2)));
#define LDS_WAIT() asm volatile("s_waitcnt lgkmcnt(0)" ::: "memory")
#define VM_WAIT() asm volatile("s_waitcnt vmcnt(0)" ::: "memory")
typedef __bf16 bf16x2_t __attribute__((ext_vector_type(2)));
__device__ __forceinline__ unsigned pk2(float lo, float hi) { const f32x2 v = {lo, hi}; const bf16x2_t b = __builtin_convertvector(v, bf16x2_t); return __builtin_bit_cast(unsigned, b); }
__device__ __forceinline__ unsigned pk4_fp8(float a, float b, float c, float d) { int w = __builtin_amdgcn_cvt_pk_fp8_f32(a, b, 0, false); w = __builtin_amdgcn_cvt_pk_fp8_f32(c, d, w, true); return (unsigned)w; }
constexpr float W8_SCALE = 64.0f, W8_INV = 1.0f / 64.0f;
constexpr float ROW8_SCALE = 16.0f, ROW8_INV = 1.0f / 16.0f;
__device__ __forceinline__ u32x4 pack8(const f32x4& a, const f32x4& b) { u32x4 w; w.x = pk2(a[0], a[1]); w.y = pk2(a[2], a[3]); w.z = pk2(b[0], b[1]); w.w = pk2(b[2], b[3]); return w; }
__device__ __forceinline__ void unpack8(const u32x4& w, float (&f)[8]) {
    f[0] = __uint_as_float(w.x << 16); f[1] = __uint_as_float(w.x & 0xffff0000u); f[2] = __uint_as_float(w.y << 16); f[3] = __uint_as_float(w.y & 0xffff0000u);
    f[4] = __uint_as_float(w.z << 16); f[5] = __uint_as_float(w.z & 0xffff0000u); f[6] = __uint_as_float(w.w << 16); f[7] = __uint_as_float(w.w & 0xffff0000u);
}
__device__ __forceinline__ float wave_sum(float v) {
#pragma unroll
    for (int o = 1; o < 64; o <<= 1) v += __shfl_xor(v, o);
    return v;
}

constexpr size_t WS_WIN = WS_W;
constexpr size_t WS_WAB = WS_W + 13 * MiB;
constexpr size_t WS_WRB = WS_W + 15 * MiB;
constexpr size_t WS_WOUT = WS_W + 17 * MiB;
constexpr size_t WS_WGU = WS_W + 19 * MiB;
constexpr size_t WS_WDN = WS_W + 147 * MiB;
static_assert(WS_WDN + 64 * MiB <= WS_XB, "weight map");
constexpr size_t SM_ATILE = SM_TILEE + 4096;
constexpr int CW_NACT = 1088;
constexpr int CW_BAR = 4096;

constexpr int RING_BYTES = 131072;
constexpr int MISC_OFF = RING_BYTES;
constexpr int LDS_BYTES = 163840;
constexpr int NWAVES = 8;

#define XB_TMO      128
#define XB_XCNT(j)  (256  + 64 * (j))
#define XB_XSUB(j)  (1280 + 64 * (j))
#define XB_XGEN(j)  (2304 + 64 * (j))
#define XB_TOP      3328
#define XB_TOPGEN   3392
#define XCD_BAR_WORDS 3456
#define XB_SPIN_CAP (1u << 20)
__device__ __forceinline__ unsigned xb_ld(unsigned* p)              { return __hip_atomic_load(p, __ATOMIC_RELAXED, __HIP_MEMORY_SCOPE_AGENT); }
__device__ __forceinline__ unsigned xb_add(unsigned* p, unsigned v) { return __hip_atomic_fetch_add(p, v, __ATOMIC_RELAXED, __HIP_MEMORY_SCOPE_AGENT); }
__device__ __forceinline__ unsigned xb_xcc_id() { return (unsigned)__builtin_amdgcn_s_getreg((3 << 11) | 20) & 0xFu; }
#define XB_SPIN(cond, bar) do { unsigned _sp = 0; while (cond) { __builtin_amdgcn_s_sleep(1); \
    if ((++_sp & 255u) == 0u) { if (xb_ld(&(bar)[XB_TMO])) break; if (_sp > XB_SPIN_CAP) { atomicAdd(&(bar)[XB_TMO], 1u); break; } } } } while (0)
struct XcdBarrier { unsigned* bar; unsigned x; volatile LAS unsigned* st; };
__device__ __forceinline__ XcdBarrier xcd_barrier_post(unsigned* bar, volatile LAS unsigned* st) {
    XcdBarrier b; b.bar = bar; b.x = xb_xcc_id(); b.st = st;
    if (threadIdx.x == 0) (void)xb_add(&bar[XB_XCNT(b.x)], 1u);
    return b;
}
__device__ __forceinline__ void xcd_barrier_complete(unsigned* bar, unsigned x, unsigned& nloc, unsigned& nx) {
    const unsigned G = gridDim.x * gridDim.y * gridDim.z;
    unsigned sum, cnt, mine, sp = 0u;
    for (;;) {
        sum = 0u; cnt = 0u; mine = 0u;
#pragma unroll
        for (unsigned j = 0; j < 16; ++j) { const unsigned c = xb_ld(&bar[XB_XCNT(j)]); sum += c; cnt += (c > 0u) ? 1u : 0u; mine = (j == x) ? c : mine; }
        if (sum == G) break;
        __builtin_amdgcn_s_sleep(1);
        if ((++sp & 255u) == 0u) { if (xb_ld(&bar[XB_TMO])) break; if (sp > XB_SPIN_CAP) { atomicAdd(&bar[XB_TMO], 1u); break; } }
    }
    nloc = mine > 0u ? mine : 1u; nx = cnt > 0u ? cnt : 1u;
}
__device__ __forceinline__ void xcd_barrier(const XcdBarrier& b) {
    asm volatile("s_waitcnt vmcnt(0)" ::: "memory");
    __syncthreads();
    if (threadIdx.x == 0) {
        unsigned* bar = b.bar;
        __builtin_amdgcn_s_waitcnt(0);
        unsigned nloc = b.st[0], nx = b.st[1];
        if (nloc == 0u) { xcd_barrier_complete(bar, b.x, nloc, nx); b.st[0] = nloc; b.st[1] = nx; }
        const unsigned old = xb_add(&bar[XB_XSUB(b.x)], 1u);
        const unsigned gen = old / nloc;
        if (old + 1u == (gen + 1u) * nloc) {
            __builtin_amdgcn_fence(__ATOMIC_RELEASE, "agent");
            asm volatile("s_waitcnt vmcnt(0)" ::: "memory");
            const unsigned og = xb_add(&bar[XB_TOP], 1u);
            const unsigned tg = og / nx;
            if (og + 1u == (tg + 1u) * nx) xb_add(&bar[XB_TOPGEN], 1u);
            else XB_SPIN(xb_ld(&bar[XB_TOPGEN]) == tg, bar);
            __builtin_amdgcn_fence(__ATOMIC_ACQUIRE, "agent");
            xb_add(&bar[XB_XGEN(b.x)], 1u);
            asm volatile("s_waitcnt vmcnt(0)" ::: "memory");
        } else {
            XB_SPIN(xb_ld(&bar[XB_XGEN(b.x)]) == gen, bar);
            __builtin_amdgcn_fence(__ATOMIC_ACQUIRE, "agent");
            asm volatile("s_waitcnt vmcnt(0)" ::: "memory");
        }
    }
    __syncthreads();
}

namespace pg8 {
constexpr int BM = 256, BK = 64, HALF = 128, HTB = HALF * BK * 2, STAGE_BYTES = 8 * HTB;
__host__ __device__ __forceinline__ int lds_byte(int r, int c) { const int st = (r >> 4) * 2 + (c >> 5), rr = r & 15, cc = c & 31, ob = rr * 64 + cc * 2; return st * 1024 + (ob ^ (((ob >> 9) & 1) << 5)); }
__host__ __device__ __forceinline__ void stage_rc(int b, int& R, int& C) { const int st = b / 1024, sb = b % 1024, swz = sb ^ (((sb >> 9) & 1) << 5); R = (st >> 1) * 16 + swz / 64; C = (st & 1) * 32 + (swz % 64) / 2; }
__host__ __device__ __forceinline__ int perm32(int rho) { const int n = rho >> 4, i = rho & 15; return 8 * (i >> 2) + 4 * n + (i & 3); }
struct Unit { int pm, pn, aux, tl; const char* A; const char* B; };
typedef f32x4 Acc[2][2][4][2];
typedef int u32x4_i __attribute__((ext_vector_type(4)));

typedef int v8i32 __attribute__((ext_vector_type(8)));
template <class Epi, class Sched, bool FP8 = false>
__device__ __forceinline__ void gemm_phase(LAS unsigned char* lds, const int Kb, const Sched& S, const Epi& E) {
    const int tid = threadIdx.x, wid = __builtin_amdgcn_readfirstlane(tid >> 6), lane = tid & 63, wr = wid >> 2, wc = wid & 3, fr = lane & 15, fq = lane >> 4;
    const int nt = Sched::SEG ? 2 * Sched::SEG : Kb / 128;
    int RA[2], CA[2]; unsigned voffB[2];
#pragma unroll
    for (int i = 0; i < 2; ++i) { int R, C; stage_rc(tid * 16 + i * 8192, R, C); const int Rb = Epi::PERM ? ((R & ~31) + perm32(R & 31)) : R;
        RA[i] = R; CA[i] = C; voffB[i] = (unsigned)(Rb * Kb + C * 2); }
    const size_t kstep = (size_t)(BK * 2);
    const size_t hstep = (size_t)HALF * Kb;
    const unsigned ldsw = (unsigned)wid * 1024u;
    const int aoff = lds_byte(wr * 64 + fr, fq * 8), boff = lds_byte(wc * 32 + fr, fq * 8);
#define PG8_SA(b, h) (((b) * 2 + (h)) * HTB)
#define PG8_SB(b, h) ((4 + (b) * 2 + (h)) * HTB)
#define PG8_STAGE(bufoff, gbase, voff) do { _Pragma("unroll") for (int _i = 0; _i < 2; ++_i) \
        __builtin_amdgcn_global_load_lds((const unsigned*)((const char*)(gbase) + (voff)[_i]), (LAS unsigned*)(lds + (bufoff) + ldsw + _i * 8192), 16, 0, 0); } while (0)
#define PG8_LDA(dst, b, h) do { _Pragma("unroll") for (int m = 0; m < 4; ++m) _Pragma("unroll") for (int k = 0; k < 2; ++k) dst[m][k] = *(const LAS bf16x8*)(lds + PG8_SA(b, h) + aoff + m * 2048 + k * 1024); } while (0)
#define PG8_LDB(dst, b, h) do { _Pragma("unroll") for (int n = 0; n < 2; ++n) _Pragma("unroll") for (int k = 0; k < 2; ++k) dst[n][k] = *(const LAS bf16x8*)(lds + PG8_SB(b, h) + boff + n * 2048 + k * 1024); } while (0)
#define PG8_MMA(ai, bj, At, Bt) do { __builtin_amdgcn_s_setprio(1); _Pragma("unroll") for (int m = 0; m < 4; ++m) _Pragma("unroll") for (int n = 0; n < 2; ++n) { \
        if constexpr (FP8) { const v8i32 bq = __builtin_shufflevector(__builtin_bit_cast(u32x4_i, Bt[n][0]), __builtin_bit_cast(u32x4_i, Bt[n][1]), 0, 1, 2, 3, 4, 5, 6, 7), \
                                         aq = __builtin_shufflevector(__builtin_bit_cast(u32x4_i, At[m][0]), __builtin_bit_cast(u32x4_i, At[m][1]), 0, 1, 2, 3, 4, 5, 6, 7); \
            asm volatile("v_mfma_scale_f32_16x16x128_f8f6f4 %0, %1, %2, %0, %3, %3 op_sel_hi:[0,0,0]" : "+v"(acc[ai][bj][m][n]) : "v"(bq), "v"(aq), "v"(scale1)); } \
        else { _Pragma("unroll") for (int k = 0; k < 2; ++k) acc[ai][bj][m][n] = __builtin_amdgcn_mfma_f32_16x16x32_bf16(Bt[n][k], At[m][k], acc[ai][bj][m][n], 0, 0, 0); } } \
        __builtin_amdgcn_s_setprio(0); } while (0)
#define PG8_WAIT_V(n) asm volatile("s_waitcnt vmcnt(" #n ")" ::: "memory")
#define PG8_WAIT_L(n) asm volatile("s_waitcnt lgkmcnt(" #n ")" ::: "memory")
#define PG8_BAR __builtin_amdgcn_s_barrier()
#define PG8_SCHED __builtin_amdgcn_sched_barrier(0)
    int scale1 = 0x7f7f7f7f; asm volatile("" : "+v"(scale1));
    Unit cur, nxt; int ui = 0;
    if (!S.next(0, cur)) return;
    unsigned ca[2][2], na[2][2];
    S.aoff(cur, RA, CA, ca);
    f32x4 acc[2][2][4][2];
#pragma unroll
    for (int a = 0; a < 2; ++a)
#pragma unroll
        for (int b = 0; b < 2; ++b)
#pragma unroll
            for (int m = 0; m < 4; ++m)
#pragma unroll
                for (int n = 0; n < 2; ++n) acc[a][b][m][n] = (f32x4){0.f, 0.f, 0.f, 0.f};
    bf16x8 At[4][2], B0[2][2], B1[2][2];
    const char* cA = cur.A; const char* cB = cur.B;
    E.prefetch(cur, 0, wid, lane);
    PG8_STAGE(PG8_SB(0, 0), cB, voffB); PG8_STAGE(PG8_SB(0, 1), cB + hstep, voffB); PG8_STAGE(PG8_SA(0, 0), cA, ca[0]); PG8_STAGE(PG8_SA(0, 1), cA, ca[1]);
    if (wr == 1) PG8_BAR;
    PG8_WAIT_V(2); PG8_BAR;
    PG8_STAGE(PG8_SB(1, 0), cB + kstep, voffB); PG8_STAGE(PG8_SA(1, 0), cA + kstep, ca[0]); PG8_STAGE(PG8_SB(1, 1), cB + hstep + kstep, voffB);
    PG8_WAIT_V(6); PG8_BAR;
    for (;;) {
        const bool has_next = S.next(ui + 1, nxt);
        if constexpr (Sched::GATHER) {
            if (has_next) S.aoff(nxt, RA, CA, na);
            else {
#pragma unroll
                for (int h = 0; h < 2; ++h)
#pragma unroll
                    for (int i = 0; i < 2; ++i) na[h][i] = ca[h][i];
            }
        }
        const char* nA = has_next ? nxt.A : cA; const char* nB = has_next ? nxt.B : cB;
#pragma nounroll
        for (int t = 0; t < nt; t += 2) {
            const bool last = (t == nt - 2);
            if constexpr (Sched::SEG > 0) { if (t == Sched::SEG) { int fr_ = fr, fq_ = fq; asm volatile("" : "+v"(fr_), "+v"(fq_)); E.mid(acc, cur, wr, wc, fr_, fq_); } }
            const size_t sA1 = (Sched::SEG && t + 1 >= Sched::SEG) ? S.dA : 0, sA2 = (Sched::SEG && t + 2 >= Sched::SEG) ? S.dA : 0, sB2 = (Sched::SEG && t + 2 >= Sched::SEG) ? S.dB : 0;
            const char* a1 = cA + (size_t)(t + 1) * kstep + sA1;
            const char* a2 = last ? nA : cA + (size_t)(t + 2) * kstep + sA2; const char* b2 = last ? nB : cB + (size_t)(t + 2) * kstep + sB2;
            const char* a3 = a2 + kstep; const char* b3 = b2 + kstep;
            unsigned o2[2][2];
#pragma unroll
            for (int h = 0; h < 2; ++h)
#pragma unroll
                for (int i = 0; i < 2; ++i) { if constexpr (Sched::GATHER) o2[h][i] = last ? na[h][i] : ca[h][i]; else o2[h][i] = ca[h][i]; }
            PG8_LDB(B0, 0, 0); PG8_LDB(B1, 0, 1); PG8_SCHED; PG8_LDA(At, 0, 0); PG8_STAGE(PG8_SA(1, 1), a1, ca[1]);
            PG8_WAIT_V(8); PG8_WAIT_L(0); PG8_BAR; PG8_MMA(0, 0, At, B0); PG8_MMA(0, 1, At, B1); PG8_BAR; PG8_SCHED;
            PG8_LDA(At, 0, 1); PG8_STAGE(PG8_SB(0, 0), b2, voffB); PG8_STAGE(PG8_SB(0, 1), b2 + hstep, voffB); PG8_STAGE(PG8_SA(0, 0), a2, o2[0]);
            PG8_WAIT_V(8); PG8_WAIT_L(0); PG8_BAR; PG8_MMA(1, 0, At, B0); PG8_MMA(1, 1, At, B1); PG8_BAR; PG8_SCHED;
            PG8_LDB(B0, 1, 0); PG8_LDB(B1, 1, 1); PG8_SCHED; PG8_LDA(At, 1, 0); PG8_STAGE(PG8_SA(0, 1), a2, o2[1]);
            PG8_WAIT_V(8); PG8_WAIT_L(0); PG8_BAR; PG8_MMA(0, 0, At, B0); PG8_MMA(0, 1, At, B1); PG8_BAR; PG8_SCHED;
            PG8_LDA(At, 1, 1); PG8_STAGE(PG8_SB(1, 0), b3, voffB); PG8_STAGE(PG8_SB(1, 1), b3 + hstep, voffB); PG8_STAGE(PG8_SA(1, 0), a3, o2[0]);
            PG8_WAIT_V(8); PG8_WAIT_L(0); PG8_BAR; PG8_MMA(1, 0, At, B0); PG8_MMA(1, 1, At, B1); PG8_BAR; PG8_SCHED;
        }
        if constexpr (FP8) { asm volatile("s_nop 15\n\ts_nop 15\n\ts_nop 15" ::: "memory"); PG8_SCHED; }
        if (wr == 0) PG8_BAR;
        { int fr_ = fr, fq_ = fq; asm volatile("" : "+v"(fr_), "+v"(fq_));
          E(acc, cur, wr, wc, fr_, fq_, ui & 1);
          if (PROBE_PHASE == 50) E(acc, cur, wr, wc, fr_, fq_, ui & 1); }
        if (!has_next) break;
#pragma unroll
        for (int a = 0; a < 2; ++a)
#pragma unroll
            for (int b = 0; b < 2; ++b)
#pragma unroll
                for (int m = 0; m < 4; ++m)
#pragma unroll
                    for (int n = 0; n < 2; ++n) acc[a][b][m][n] = (f32x4){0.f, 0.f, 0.f, 0.f};
        cur = nxt; cA = nA; cB = nB; ++ui;
        E.prefetch(cur, ui & 1, wid, lane);
        if constexpr (Sched::GATHER) {
#pragma unroll
            for (int h = 0; h < 2; ++h)
#pragma unroll
                for (int i = 0; i < 2; ++i) ca[h][i] = na[h][i];
        }
        if (wr == 1) PG8_BAR;
    }
    PG8_WAIT_V(0);
    PG8_BAR;
#undef PG8_SA
#undef PG8_SB
#undef PG8_STAGE
#undef PG8_LDA
#undef PG8_LDB
#undef PG8_MMA
#undef PG8_WAIT_V
#undef PG8_WAIT_L
#undef PG8_BAR
#undef PG8_SCHED
}
}
#ifndef PROBE_PHASE
#define PROBE_PHASE (-1)
#endif
constexpr size_t SM_LIST = WS_SMALL + 2 * MiB;
constexpr size_t SM_WLIST = WS_SMALL + 6 * MiB;
constexpr size_t SM_RLIST = WS_SMALL + 10 * MiB;
constexpr int MT_PSTART = 256;
constexpr int MT_CNT = 512;
constexpr int MT_NACT = 768;
constexpr int MT_ATILE = 1024;
constexpr int MT_HIST = 4096;
constexpr int MT_BASE = 4224;
constexpr int MT_REC = 4352;
constexpr int MT_RSTD = 10496;
constexpr int MT_EPI = 11264;
constexpr int MT_EPI2 = 13312;
constexpr int MT_GAIN = 15360;
constexpr int MT_XCH = 16384;

__device__ __forceinline__ void moe_tables(LAS unsigned char* misc, const unsigned* cnt) {
    LAS int* pstart = (LAS int*)(misc + MT_PSTART); LAS int* cl = (LAS int*)(misc + MT_CNT); LAS int* at = (LAS int*)(misc + MT_ATILE);
    __syncthreads();
    if (threadIdx.x < 64) {
        const int lane = threadIdx.x, e = lane & 31;
        const int c = (int)__hip_atomic_load(cnt + e, __ATOMIC_RELAXED, __HIP_MEMORY_SCOPE_AGENT), nt = (c + 255) >> 8;
        int incl = nt;
#pragma unroll
        for (int o = 1; o < 32; o <<= 1) { const int v = __shfl_up(incl, o); if (e >= o) incl += v; }
        const int t0 = incl - nt;
        if (lane < 32) { cl[e] = c; pstart[e] = t0 << 8; for (int t = 0; t < nt; ++t) at[t0 + t] = (t0 + t) | (e << 12) | (t << 20);
            if (e == 31) { pstart[NE] = incl << 8; *(LAS int*)(misc + MT_NACT) = incl; } }
    }
    __syncthreads();
}

__device__ __forceinline__ void route_images(LAS unsigned char* lds, const float* __restrict__ g2, const float* __restrict__ wr) {
    const int tid = threadIdx.x;
    for (int idx = tid; idx < 128 * 32; idx += 512) {
        const int c = idx >> 5, e = idx & 31; float v[8]; unsigned hw[4], lw[4];
#pragma unroll
        for (int j = 0; j < 8; ++j) v[j] = wr[(size_t)(8 * c + j) * NE + e] * g2[8 * c + j];
#pragma unroll
        for (int j = 0; j < 4; ++j) { hw[j] = pk2(v[2 * j], v[2 * j + 1]); lw[j] = pk2(v[2 * j] - __uint_as_float(hw[j] << 16), v[2 * j + 1] - __uint_as_float(hw[j] & 0xffff0000u)); }
        *(LAS u32x4*)(lds + idx * 16) = (u32x4){hw[0], hw[1], hw[2], hw[3]};
        *(LAS u32x4*)(lds + 65536 + idx * 16) = (u32x4){lw[0], lw[1], lw[2], lw[3]};
    }
    __syncthreads();
}
__device__ __forceinline__ void route_phase(LAS unsigned char* lds, const bf16* __restrict__ h2, const float* __restrict__ g2, const float* __restrict__ wr, const float* __restrict__ br,
                                            unsigned char* __restrict__ xg8, int* __restrict__ tke, int* __restrict__ tkpos, float* __restrict__ tkw, int* __restrict__ list, float* __restrict__ wlist,
                                            float* __restrict__ rlist, unsigned* __restrict__ cnt, int G, int bx) {
    typedef float f32x16 __attribute__((ext_vector_type(16)));
    const int tid = threadIdx.x, lane = tid & 63, r32 = lane & 31, hi = lane >> 5; const int wave = __builtin_amdgcn_readfirstlane(tid >> 6);
    LAS unsigned char* misc = lds + MISC_OFF;
    LAS int* hist = (LAS int*)(misc + MT_HIST); LAS int* base = (LAS int*)(misc + MT_BASE); LAS int* rec = (LAS int*)(misc + MT_REC); LAS float* rstd_l = (LAS float*)(misc + MT_RSTD);
    const int tile = wave & 3, kh = wave >> 2;
    for (int tb = bx; tb < NTOK / 128; tb += G) {
        if (tid < 32) hist[tid] = 0;
        __syncthreads();
        {
        const int token = tb * 128 + tile * 32 + r32;
        const bf16* xp = h2 + (size_t)token * D + kh * 512 + 8 * hi;
        unsigned char* x8p = xg8 + (size_t)token * D + kh * 512 + 8 * hi;
        const float* gp = g2 + kh * 512 + 8 * hi;
        f32x16 c = {};
        float ss = 0.f;
        u32x4 xa[8];
#pragma unroll
        for (int p = 0; p < 8; ++p) xa[p] = *(const u32x4*)(xp + 16 * p);
#pragma unroll 1
        for (int ks0 = 0; ks0 < 32; ks0 += 8) {
#pragma unroll
            for (int p = 0; p < 8; ++p) {
                const int ks = ks0 + p;
                float xf[8]; unpack8(xa[p], xf); const f32x4 x0 = {xf[0], xf[1], xf[2], xf[3]}, x1 = {xf[4], xf[5], xf[6], xf[7]};
                const u32x4 xh = xa[p];
                if (ks + 8 < 32) xa[p] = *(const u32x4*)(xp + 16 * (ks + 8));
                ss += (x0[0] * x0[0] + x0[1] * x0[1]) + (x0[2] * x0[2] + x0[3] * x0[3]) + (x1[0] * x1[0] + x1[1] * x1[1]) + (x1[2] * x1[2] + x1[3] * x1[3]);
                { const f32x4 g0 = *(const f32x4*)(gp + 16 * ks), g1 = *(const f32x4*)(gp + 16 * ks + 4);
                  u32x2 w8; w8.x = pk4_fp8(x0[0] * g0[0], x0[1] * g0[1], x0[2] * g0[2], x0[3] * g0[3]); w8.y = pk4_fp8(x1[0] * g1[0], x1[1] * g1[1], x1[2] * g1[2], x1[3] * g1[3]);
                  *(u32x2*)(x8p + 16 * ks) = w8; }
                const int chunk = kh * 64 + 2 * ks + hi;
                const bf16x8 wh = *(const LAS bf16x8*)(lds + (chunk * 32 + r32) * 16), wl = *(const LAS bf16x8*)(lds + 65536 + (chunk * 32 + r32) * 16);
                c = __builtin_amdgcn_mfma_f32_32x32x16_bf16(wh, __builtin_bit_cast(bf16x8, xh), c, 0, 0, 0);
                c = __builtin_amdgcn_mfma_f32_32x32x16_bf16(wl, __builtin_bit_cast(bf16x8, xh), c, 0, 0, 0);
            }
        }
        LAS float* px = (LAS float*)(misc + MT_XCH);
        LAS float* sx = (LAS float*)(misc + MT_REC + tile * 1536);
        if (kh == 1) {
#pragma unroll
            for (int r = 0; r < 16; ++r) px[(tile * 16 + r) * 64 + lane] = c[r];
            sx[lane] = ss;
        }
        __syncthreads();
        if (kh == 0) {
#pragma unroll
            for (int r = 0; r < 16; ++r) c[r] += px[(tile * 16 + r) * 64 + lane];
            ss += sx[lane];
            ss += __shfl_xor(ss, 32);
            const float rstd = rsqrtf(ss * (1.0f / D) + EPS);
            float vals[16];
#pragma unroll
            for (int r = 0; r < 16; ++r) vals[r] = c[r] * rstd + br[(r & 3) + 8 * (r >> 2) + 4 * hi];
            float tv[4]; int te[4];
#pragma unroll
            for (int k = 0; k < 4; ++k) {
                float m = -3.0e38f; int mi = 0;
#pragma unroll
                for (int r = 0; r < 16; ++r) { const bool gt = vals[r] > m; m = gt ? vals[r] : m; mi = gt ? r : mi; }
                tv[k] = m; te[k] = (mi & 3) + 8 * (mi >> 2) + 4 * hi;
#pragma unroll
                for (int r = 0; r < 16; ++r) vals[r] = (r == mi) ? -3.0e38f : vals[r];
            }
            float cv[8]; int ce[8];
#pragma unroll
            for (int k = 0; k < 4; ++k) { cv[k] = tv[k]; ce[k] = te[k]; cv[4 + k] = __shfl_xor(tv[k], 32); ce[4 + k] = __shfl_xor(te[k], 32); }
            float fv[4]; int fe[4];
#pragma unroll
            for (int k = 0; k < 4; ++k) {
                float m = -3.0e38f; int me = 64; int mi = 0;
#pragma unroll
                for (int q = 0; q < 8; ++q) { const bool better = (cv[q] > m) || (cv[q] == m && ce[q] < me); m = better ? cv[q] : m; me = better ? ce[q] : me; mi = better ? q : mi; }
                fv[k] = m; fe[k] = me;
#pragma unroll
                for (int q = 0; q < 8; ++q) cv[q] = (q == mi) ? -3.0e38f : cv[q];
            }
            if (hi == 0) {
                const float e0 = 1.0f, e1 = __expf(fv[1] - fv[0]), e2 = __expf(fv[2] - fv[0]), e3 = __expf(fv[3] - fv[0]);
                const float inv = 1.0f / (e0 + e1 + e2 + e3);
                const float wts[4] = {e0 * inv, e1 * inv, e2 * inv, e3 * inv};
                const int tl = tile * 32 + r32;
                rstd_l[tl] = rstd;
#pragma unroll
                for (int k = 0; k < 4; ++k) {
                    const int lp = __hip_atomic_fetch_add(hist + fe[k], 1, __ATOMIC_RELAXED, __HIP_MEMORY_SCOPE_WORKGROUP);
                    LAS int* r = rec + (tl * 4 + k) * 3; r[0] = fe[k]; r[1] = lp; r[2] = __float_as_int(wts[k]);
                }
            }
        }
        }
        __syncthreads();
        if (tid < 32) base[tid] = (int)atomicAdd(&cnt[tid], (unsigned)hist[tid]);
        __syncthreads();
        { const int tl = tid >> 2; const int tok = tb * 128 + tl; LAS int* r = rec + tid * 3; const int e = r[0], pos = base[e] + r[1]; const float w = __int_as_float(r[2]);
          tke[tok * 4 + (tid & 3)] = e; tkpos[tok * 4 + (tid & 3)] = pos; tkw[tok * 4 + (tid & 3)] = w;
          list[e * NTOK + pos] = tok; wlist[e * NTOK + pos] = w; rlist[e * NTOK + pos] = rstd_l[tl]; }
        __syncthreads();
    }
}

__device__ __forceinline__ void combine_phase(LAS unsigned char* misc, const bf16* __restrict__ h2b, float* __restrict__ out, const unsigned char* __restrict__ rows, const int* __restrict__ tke, const int* __restrict__ tkpos, int gw, int NGW, int lane, float oscale) {
    LAS const int* pstart = (LAS const int*)(misc + MT_PSTART);
    for (int token = gw; token < NTOK; token += NGW) {
        int rr[4];
#pragma unroll
        for (int k = 0; k < 4; ++k) rr[k] = pstart[tke[token * 4 + k]] + tkpos[token * 4 + k];
        f32x4* o = (f32x4*)(out + (size_t)token * D) + lane;
        const u32x2* hp = (const u32x2*)(h2b + (size_t)token * D) + lane;
        f32x4 v[4], s[4];
#pragma unroll
        for (int j = 0; j < 4; ++j) { const u32x2 w = __builtin_nontemporal_load(hp + 64 * j);
            v[j] = (f32x4){__uint_as_float(w.x << 16), __uint_as_float(w.x & 0xffff0000u), __uint_as_float(w.y << 16), __uint_as_float(w.y & 0xffff0000u)}; s[j] = (f32x4){0.f, 0.f, 0.f, 0.f}; }
#pragma unroll
        for (int k = 0; k < 4; ++k) {
            const unsigned* rp = (const unsigned*)(rows + (size_t)rr[k] * D) + lane;
#pragma unroll
            for (int j = 0; j < 4; ++j) { const unsigned w = __builtin_nontemporal_load(rp + 64 * j);
                const f32x2 lo = __builtin_amdgcn_cvt_pk_f32_fp8((int)w, false), hh = __builtin_amdgcn_cvt_pk_f32_fp8((int)w, true);
                s[j][0] += lo[0]; s[j][1] += lo[1]; s[j][2] += hh[0]; s[j][3] += hh[1]; }
        }
#pragma unroll
        for (int j = 0; j < 4; ++j) __builtin_nontemporal_store((v[j] + s[j] * ROW8_INV) * oscale, o + 64 * j);
    }
}
struct SchedDense {
    static constexpr bool GATHER = false; static constexpr int SEG = 0; size_t dA = 0, dB = 0; int rev = 0;
    const char* A; const char* Bt; int K, nM, nN, nwg, G, c;
    __device__ void init(const bf16* A_, const bf16* Bt_, int M, int N, int K_, int G_, int c_) { A = (const char*)A_; Bt = (const char*)Bt_; K = K_; nM = M / 256; nN = N / 256; nwg = nM * nN; G = G_; c = c_; }
    __device__ __forceinline__ bool next(int i, pg8::Unit& u) const {
        const long L = (long)i * G + c; if (L >= nwg) return false;
        int wgid = (int)L; { const int q = nwg / 8, r = nwg % 8, xcd = wgid % 8, off = wgid / 8; wgid = (xcd < r ? xcd * (q + 1) : r * (q + 1) + (xcd - r) * q) + off; }
        const int nig = 8 * nN, gid = wgid / nig, fm = gid * 8, gsz = (nM - fm) < 8 ? (nM - fm) : 8;
        u.pm = fm + ((wgid % nig) % gsz); u.pn = (wgid % nig) / gsz; if (rev) u.pn = nN - 1 - u.pn; u.aux = 0; u.tl = 0;
        u.A = A + (size_t)u.pm * 256 * K * 2; u.B = Bt + (size_t)u.pn * 256 * K * 2; return true;
    }
    __device__ __forceinline__ void aoff(const pg8::Unit&, const int (&R)[2], const int (&C)[2], unsigned (&o)[2][2]) const {
#pragma unroll
        for (int h = 0; h < 2; ++h)
#pragma unroll
            for (int i = 0; i < 2; ++i) o[h][i] = (unsigned)((128 * h + R[i]) * K + C[i]) * 2u;
    }
};
struct SchedBranch2 : SchedDense { static constexpr int SEG = 16; };
template <bool GATHER_, int NPN>
struct SchedMoe {
    static constexpr bool GATHER = GATHER_; static constexpr int SEG = 0; static constexpr size_t dA = 0, dB = 0;
    const char* A; const char* Bt; LAS const unsigned char* misc; const int* list; int G, c;
    __device__ __forceinline__ bool next(int i, pg8::Unit& u) const {
        LAS const int* cl = (LAS const int*)(misc + MT_CNT); LAS const int* ps = (LAS const int*)(misc + MT_PSTART);
        if ((G & 7) == 0) {
            const int x = c & 7, r = c >> 3, n = G >> 3;
            int k = (i * n + r) / NPN; const int pn = (i * n + r) % NPN;
#pragma unroll
            for (int j = 0; j < 4; ++j) { const int e = x + 8 * j, nt = (cl[e] + 255) >> 8;
                if (k < nt) { u.pn = pn; u.aux = e; u.tl = k; u.pm = (ps[e] >> 8) + k;
                    u.A = GATHER ? A : A + (size_t)u.pm * 256 * 1024; u.B = Bt + ((size_t)e * NPN + pn) * 256 * 1024; return true; }
                k -= nt; }
            return false;
        }
        const int nact = *(LAS const int*)(misc + MT_NACT);
        const int L = i * G + c; if (L >= nact * NPN) return false;
        const int k = L / NPN; u.pn = L % NPN; const int w = ((LAS const int*)(misc + MT_ATILE))[k];
        u.pm = w & 0xfff; u.aux = (w >> 12) & 0xff; u.tl = w >> 20;
        u.A = GATHER ? A : A + (size_t)u.pm * 256 * 1024;
        u.B = Bt + ((size_t)u.aux * NPN + u.pn) * 256 * 1024; return true;
    }
    __device__ __forceinline__ void aoff(const pg8::Unit& u, const int (&R)[2], const int (&C)[2], unsigned (&o)[2][2]) const {
        const int ce = ((LAS const int*)(misc + MT_CNT))[u.aux];
#pragma unroll
        for (int h = 0; h < 2; ++h)
#pragma unroll
            for (int i = 0; i < 2; ++i) {
                if (GATHER) { const int idx = u.tl * 256 + 128 * h + R[i]; const int tok = (idx < ce) ? list[u.aux * NTOK + idx] : 0; o[h][i] = (unsigned)tok * 1024u + (unsigned)C[i] * 2u; }
                else o[h][i] = (unsigned)((128 * h + R[i]) * 1024 + C[i] * 2);
            }
    }
};

struct EpiProj {
    static constexpr bool PERM = true;
    __device__ __forceinline__ void prefetch(const pg8::Unit&, int, int, int) const {}
    bf16* proj; LAS const float* gtab;
    __device__ __forceinline__ void operator()(pg8::Acc& acc, const pg8::Unit& u, int wr, int wc, int fr, int fq, int slot) const {
        const int pn = u.pn;
        int mode;
        if (pn < 4) mode = 1; else if (pn == 4) mode = (wc < 2) ? 2 : 0; else if (pn < 7) mode = 0; else if (pn < 9) mode = 3; else if (pn < 13) mode = 0; else if (pn < 17) mode = 4; else mode = 5;
        float gn[2][8];
        if (mode == 1 || mode == 2) { LAS const float* g = gtab + ((mode == 1) ? 0 : 64);
#pragma unroll
            for (int bj = 0; bj < 2; ++bj)
#pragma unroll
                for (int j = 0; j < 8; ++j) gn[bj][j] = g[32 * bj + 8 * fq + j]; }
#pragma unroll
        for (int ai = 0; ai < 2; ++ai)
#pragma unroll
            for (int m = 0; m < 4; ++m) {
                const int r = u.pm * 256 + ai * 128 + wr * 64 + m * 16 + fr;
                bf16* rowp = proj + (size_t)r * INW + pn * 256 + wc * 64 + 8 * fq;
                f32x4 v[2][2];
#pragma unroll
                for (int bj = 0; bj < 2; ++bj) { v[bj][0] = acc[ai][bj][m][0]; v[bj][1] = acc[ai][bj][m][1]; }
                if (mode == 1 || mode == 2) {
                    float ss = 0.f;
#pragma unroll
                    for (int bj = 0; bj < 2; ++bj)
#pragma unroll
                        for (int n = 0; n < 2; ++n) ss += v[bj][n][0] * v[bj][n][0] + v[bj][n][1] * v[bj][n][1] + v[bj][n][2] * v[bj][n][2] + v[bj][n][3] * v[bj][n][3];
                    ss += __shfl_xor(ss, 16); ss += __shfl_xor(ss, 32);
                    const float rs = rsqrtf(ss * (1.0f / 64.0f) + EPS);
#pragma unroll
                    for (int bj = 0; bj < 2; ++bj)
#pragma unroll
                        for (int n = 0; n < 2; ++n)
#pragma unroll
                            for (int i = 0; i < 4; ++i) v[bj][n][i] = v[bj][n][i] * rs * gn[bj][4 * n + i];
                } else if (mode == 3) {
#pragma unroll
                    for (int bj = 0; bj < 2; ++bj)
#pragma unroll
                        for (int n = 0; n < 2; ++n) v[bj][n] = v[bj][n] * 0.08838834764831845f;
                } else if (mode == 4) {
#pragma unroll
                    for (int bj = 0; bj < 2; ++bj)
#pragma unroll
                        for (int n = 0; n < 2; ++n)
#pragma unroll
                            for (int i = 0; i < 4; ++i) { const float x = v[bj][n][i]; v[bj][n][i] = x * sigmoidf_(x); }
                } else if (mode == 5) {
#pragma unroll
                    for (int bj = 0; bj < 2; ++bj)
#pragma unroll
                        for (int n = 0; n < 2; ++n)
#pragma unroll
                            for (int i = 0; i < 4; ++i) v[bj][n][i] = sigmoidf_(v[bj][n][i]);
                }
#pragma unroll
                for (int bj = 0; bj < 2; ++bj) *(u32x4*)(rowp + 32 * bj) = pack8(v[bj][0], v[bj][1]);
            }
    }
};
struct EpiBranch2 {
    static constexpr bool PERM = true;
    __device__ __forceinline__ void prefetch(const pg8::Unit&, int, int, int) const {}
    bf16* merged; const bf16* proj;
    __device__ __forceinline__ void mid(pg8::Acc& acc, const pg8::Unit& u, int wr, int wc, int fr, int fq) const {
#pragma unroll
        for (int ai = 0; ai < 2; ++ai)
#pragma unroll
            for (int mp = 0; mp < 2; ++mp) {
                u32x4 ga[2][2], gr[2][2];
#pragma unroll
                for (int mm = 0; mm < 2; ++mm)
#pragma unroll
                    for (int bj = 0; bj < 2; ++bj) {
                        const bf16* gp = proj + (size_t)(u.pm * 256 + ai * 128 + wr * 64 + (2 * mp + mm) * 16 + fr) * INW + u.pn * 256 + bj * 128 + wc * 32 + 8 * fq;
                        ga[mm][bj] = *(const u32x4*)(gp + C_GA); gr[mm][bj] = *(const u32x4*)(gp + C_GR);
                    }
#pragma unroll
                for (int mm = 0; mm < 2; ++mm)
#pragma unroll
                    for (int bj = 0; bj < 2; ++bj) {
                        const int m = 2 * mp + mm; float a[8], r[8]; unpack8(ga[mm][bj], a); unpack8(gr[mm][bj], r);
#pragma unroll
                        for (int i = 0; i < 4; ++i) { acc[ai][bj][m][0][i] *= a[i] * __builtin_amdgcn_rcpf(fmaxf(r[i], 1e-20f)); acc[ai][bj][m][1][i] *= a[4 + i] * __builtin_amdgcn_rcpf(fmaxf(r[4 + i], 1e-20f)); }
                    }
            }
    }
    __device__ __forceinline__ void operator()(pg8::Acc& acc, const pg8::Unit& u, int wr, int wc, int fr, int fq, int slot) const {
#pragma unroll
        for (int ai = 0; ai < 2; ++ai)
#pragma unroll
            for (int mp = 0; mp < 2; ++mp) {
                u32x4 gr[2][2];
#pragma unroll
                for (int mm = 0; mm < 2; ++mm)
#pragma unroll
                    for (int bj = 0; bj < 2; ++bj)
                        gr[mm][bj] = *(const u32x4*)(proj + (size_t)(u.pm * 256 + ai * 128 + wr * 64 + (2 * mp + mm) * 16 + fr) * INW + C_GR + u.pn * 256 + bj * 128 + wc * 32 + 8 * fq);
#pragma unroll
                for (int mm = 0; mm < 2; ++mm)
#pragma unroll
                    for (int bj = 0; bj < 2; ++bj) {
                        const int m = 2 * mp + mm; float r[8]; unpack8(gr[mm][bj], r);
                        f32x4 a = acc[ai][bj][m][0], b = acc[ai][bj][m][1];
                        a[0] *= r[0]; a[1] *= r[1]; a[2] *= r[2]; a[3] *= r[3]; b[0] *= r[4]; b[1] *= r[5]; b[2] *= r[6]; b[3] *= r[7];
                        *(u32x4*)(merged + (size_t)(u.pm * 256 + ai * 128 + wr * 64 + m * 16 + fr) * D + u.pn * 256 + bj * 128 + wc * 32 + 8 * fq) = pack8(a, b);
                    }
            }
    }
};
struct EpiOut {
    static constexpr bool PERM = true;
    __device__ __forceinline__ void prefetch(const pg8::Unit&, int, int, int) const {}
    const float* x; bf16* h2b;
    __device__ __forceinline__ void load(f32x4 (&xv)[2][2][2], const pg8::Unit& u, int q, int wr, int wc, int fr, int fq) const {
#pragma unroll
        for (int mm = 0; mm < 2; ++mm) { const size_t off = (size_t)(u.pm * 256 + (q >> 1) * 128 + wr * 64 + (2 * (q & 1) + mm) * 16 + fr) * D + u.pn * 256 + wc * 32 + 8 * fq;
#pragma unroll
            for (int bj = 0; bj < 2; ++bj)
#pragma unroll
                for (int n = 0; n < 2; ++n) xv[mm][bj][n] = *(const f32x4*)(x + off + bj * 128 + n * 4); }
    }
    __device__ __forceinline__ void operator()(pg8::Acc& acc, const pg8::Unit& u, int wr, int wc, int fr, int fq, int slot) const {
        f32x4 xA[2][2][2], xB[2][2][2];
        load(xA, u, 0, wr, wc, fr, fq);
#pragma unroll
        for (int q = 0; q < 4; ++q) {
            if (q < 3) { if (q & 1) load(xA, u, q + 1, wr, wc, fr, fq); else load(xB, u, q + 1, wr, wc, fr, fq); }
            const int ai = q >> 1;
#pragma unroll
            for (int mm = 0; mm < 2; ++mm) { const int m = 2 * (q & 1) + mm; const size_t off = (size_t)(u.pm * 256 + ai * 128 + wr * 64 + m * 16 + fr) * D + u.pn * 256 + wc * 32 + 8 * fq;
#pragma unroll
                for (int bj = 0; bj < 2; ++bj) {
                    const f32x4 a = ((q & 1) ? xB[mm][bj][0] : xA[mm][bj][0]) + acc[ai][bj][m][0], b = ((q & 1) ? xB[mm][bj][1] : xA[mm][bj][1]) + acc[ai][bj][m][1];
                    *(u32x4*)(h2b + off + bj * 128) = pack8(a, b); } }
        }
    }
};
struct EpiGU {
    static constexpr bool PERM = true;
    unsigned char* act; const float* bgu; const float* rlist; LAS unsigned char* misc;
    __device__ __forceinline__ void prefetch(const pg8::Unit& u, int slot, int wid, int lane) const {
        if (wid < 4) __builtin_amdgcn_global_load_lds((const unsigned*)(rlist + (size_t)u.aux * NTOK + u.tl * 256 + wid * 64 + lane), (LAS unsigned*)(misc + MT_EPI + slot * 1024 + wid * 256), 4, 0, 0);
        else __builtin_amdgcn_global_load_lds((const unsigned*)(bgu + (size_t)u.aux * 2048 + ((wid - 4) >> 1) * 1024 + u.pn * 128 + ((wid - 4) & 1) * 64 + lane), (LAS unsigned*)(misc + MT_EPI2 + slot * 1024 + (wid - 4) * 256), 4, 0, 0);
    }
    __device__ __forceinline__ void operator()(pg8::Acc& acc, const pg8::Unit& u, int wr, int wc, int fr, int fq, int slot) const {
        const int ce = ((LAS const int*)(misc + MT_CNT))[u.aux];
        const int col = u.pn * 128 + wc * 32 + 8 * fq;
        LAS const float* bl = (LAS const float*)(misc + MT_EPI2 + slot * 1024) + wc * 32 + 8 * fq;
        float bgate[8], bup[8];
#pragma unroll
        for (int j = 0; j < 8; ++j) { bgate[j] = bl[j]; bup[j] = bl[128 + j]; }
#pragma unroll
        for (int ai = 0; ai < 2; ++ai)
#pragma unroll
            for (int m = 0; m < 4; ++m) {
                const int lr = ai * 128 + wr * 64 + m * 16 + fr, r = u.pm * 256 + lr;
                const float rs = ((LAS const float*)(misc + MT_EPI + slot * 1024))[lr] * W8_INV;
                float o[8];
#pragma unroll
                for (int n = 0; n < 2; ++n)
#pragma unroll
                    for (int i = 0; i < 4; ++i) {
                        float gate = acc[ai][0][m][n][i] * rs + bgate[4 * n + i], up = acc[ai][1][m][n][i] * rs + bup[4 * n + i];
                        gate = fminf(gate, 7.0f); up = fminf(fmaxf(up, -7.0f), 7.0f);
                        o[4 * n + i] = (up + 1.0f) * gate * sigmoidf_(1.702f * gate);
                    }
                u32x2 w; w.x = pk4_fp8(o[0], o[1], o[2], o[3]); w.y = pk4_fp8(o[4], o[5], o[6], o[7]);
                *(u32x2*)(act + (size_t)r * DFF + col) = w;
            }
    }
};
struct EpiDown {
    static constexpr bool PERM = true;
    unsigned char* rows; const float* bdn; const float* wlist; LAS const unsigned char* misc;
    __device__ __forceinline__ void prefetch(const pg8::Unit& u, int slot, int wid, int lane) const {
        if (wid < 4) __builtin_amdgcn_global_load_lds((const unsigned*)(wlist + (size_t)u.aux * NTOK + u.tl * 256 + wid * 64 + lane), (LAS unsigned*)(misc + MT_EPI + slot * 1024 + wid * 256), 4, 0, 0);
        else __builtin_amdgcn_global_load_lds((const unsigned*)(bdn + (size_t)u.aux * D + u.pn * 256 + (wid - 4) * 64 + lane), (LAS unsigned*)(misc + MT_EPI2 + slot * 1024 + (wid - 4) * 256), 4, 0, 0);
    }
    __device__ __forceinline__ void operator()(pg8::Acc& acc, const pg8::Unit& u, int wr, int wc, int fr, int fq, int slot) const {
        const int ce = ((LAS const int*)(misc + MT_CNT))[u.aux];
#pragma unroll
        for (int ai = 0; ai < 2; ++ai)
#pragma unroll
            for (int m = 0; m < 4; ++m) {
                const int lr = ai * 128 + wr * 64 + m * 16 + fr, r = u.pm * 256 + lr, idx = u.tl * 256 + lr;
                const float w = (idx < ce) ? ((LAS const float*)(misc + MT_EPI + slot * 1024))[lr] * ROW8_SCALE : 0.f;
                LAS const float* bl = (LAS const float*)(misc + MT_EPI2 + slot * 1024) + wc * 32 + 8 * fq;
                asm volatile("" : "+v"(bl));
#pragma unroll
                for (int bj = 0; bj < 2; ++bj) {
                    const f32x4 b0 = *(const LAS f32x4*)(bl + bj * 128), b1 = *(const LAS f32x4*)(bl + bj * 128 + 4);
                    f32x4 a = acc[ai][bj][m][0], b = acc[ai][bj][m][1];
#pragma unroll
                    for (int i = 0; i < 4; ++i) { a[i] = (a[i] * W8_INV + b0[i]) * w; b[i] = (b[i] * W8_INV + b1[i]) * w; }
                    u32x2 o; o.x = pk4_fp8(a[0], a[1], a[2], a[3]); o.y = pk4_fp8(b[0], b[1], b[2], b[3]);
                    *(u32x2*)(rows + (size_t)r * D + u.pn * 256 + bj * 128 + wc * 32 + 8 * fq) = o;
                }
            }
    }
};
namespace attn {
typedef float f32x16 __attribute__((ext_vector_type(16)));
typedef short s16x4 __attribute__((ext_vector_type(4)));
constexpr int NK = 272, K_OFF = 0, V_OFF = 34816, WS_OFF = 69632, OST_OFF = 71680, LDS_END = OST_OFF + 8 * 4096;
constexpr float LOG2E = 1.4426950408889634f;
__device__ __forceinline__ s16x4 vtr(LAS const unsigned char* p) { return __builtin_bit_cast(s16x4, __builtin_amdgcn_ds_read_tr16_b64_v4i16((LAS s16x4*)p)); }
__device__ __forceinline__ int crowc(int r) { return (r & 3) + 8 * (r >> 2); }

template <int TYPE, bool DIAG>
__device__ __forceinline__ void tile(LAS const unsigned char* lds, int kbase, const bf16x8 (&qr)[4], f32x16 (&o)[2], float& l, float lanebase, float c1, int tt, int lane) {
    const int r32 = lane & 31, hi = lane >> 5;
    f32x16 p;
#pragma unroll
    for (int r = 0; r < 16; ++r) p[r] = __builtin_fmaf(c1, (float)crowc(r), lanebase);
#pragma unroll
    for (int d0 = 0; d0 < 4; ++d0) {
        const bf16x8 kf = *(const LAS bf16x8*)(lds + K_OFF + (2 * d0 + hi) * (NK * 16) + (kbase + r32) * 16);
        p = __builtin_amdgcn_mfma_f32_32x32x16_bf16(kf, qr[d0], p, 0, 0, 0);
    }
    constexpr int NR = (TYPE == 0) ? 8 : 16;
    float e[16];
#pragma unroll
    for (int r = 0; r < NR; ++r) {
        float v = __builtin_amdgcn_exp2f(p[r]);
        if (DIAG) { const bool ok = (TYPE == 1) ? (crowc(r) > tt) : (crowc(r) <= tt); v = ok ? v : 0.f; }
        e[r] = v; l += v;
    }
    constexpr int NS = (TYPE == 0) ? 1 : 2;
    u32x4 pw[2];
#pragma unroll
    for (int s = 0; s < NS; ++s) { pw[s].x = pk2(e[8 * s + 0], e[8 * s + 1]); pw[s].y = pk2(e[8 * s + 2], e[8 * s + 3]); pw[s].z = pk2(e[8 * s + 4], e[8 * s + 5]); pw[s].w = pk2(e[8 * s + 6], e[8 * s + 7]); }
    LAS const unsigned char* vb = lds + V_OFF + (kbase + 4 * hi + ((lane & 15) >> 2)) * 64 + ((lane >> 4) & 1) * 32 + (lane & 3) * 8;
#pragma unroll
    for (int d0 = 0; d0 < 2; ++d0)
#pragma unroll
        for (int s = 0; s < NS; ++s) {
            const s16x4 lo = vtr(vb + d0 * (NK * 64) + s * 1024), hh = vtr(vb + d0 * (NK * 64) + s * 1024 + 512);
            const bf16x8 vf = (bf16x8){lo[0], lo[1], lo[2], lo[3], hh[0], hh[1], hh[2], hh[3]};
            o[d0] = __builtin_amdgcn_mfma_f32_32x32x16_bf16(__builtin_bit_cast(bf16x8, pw[s]), vf, o[d0], 0, 0, 0);
        }
}

#define AT_ISSUE(u_) do { const int u__ = (u_); const int b_ = u__ >> 6, qb_ = (u__ >> 1) & 31, kvh_ = u__ & 1; \
        _Pragma("unroll") for (int i = 0; i < 5; ++i) { const int idx = tid + 512 * i; if (idx < NK * 8) { const int key = idx >> 3, c = idx & 7; const bf16* rowp; \
            if (key < 16) rowp = pmeta + (size_t)key * INW; else { int j = qb_ * 128 - 128 + (key - 16); if (j < 0) j = 0; rowp = proj + ((size_t)b_ * SEQ + j) * INW; } \
            pk[i] = *(const u32x4*)(rowp + C_AK + kvh_ * 64 + c * 8); pv[i] = *(const u32x4*)(rowp + C_AV + kvh_ * 64 + c * 8); } } } while (0)
#define AT_QLOAD(dst, a_) do { const size_t qrow_ = (size_t)b * SEQ + qb * 128 + 32 * (a_) + r32; \
        _Pragma("unroll") for (int d0 = 0; d0 < 4; ++d0) dst[d0] = *(const bf16x8*)(proj + qrow_ * INW + C_AQ + h * 64 + d0 * 16 + hi * 8); } while (0)
__device__ __forceinline__ void phase(LAS unsigned char* lds, const bf16* __restrict__ proj, const bf16* __restrict__ pmeta, const float* __restrict__ sinks, float bshift, bf16* __restrict__ yatt, int G, int bx) {
    const int tid = threadIdx.x, lane = tid & 63, r32 = lane & 31, hi = lane >> 5; const int wave = __builtin_amdgcn_readfirstlane(tid >> 6);
    constexpr int NU = NB * 32 * 2;
    if (bx >= NU) return;
    u32x4 pk[5], pv[5];
    AT_ISSUE(bx);
    for (int u = bx; u < NU; u += G) {
        const int b = u >> 6, qb = (u >> 1) & 31, kvh = u & 1;
#pragma unroll
        for (int i = 0; i < 5; ++i) { const int idx = tid + 512 * i; if (idx < NK * 8) { const int key = idx >> 3, c = idx & 7;
            *(LAS u32x4*)(lds + K_OFF + c * (NK * 16) + key * 16) = pk[i];
            *(LAS u32x4*)(lds + V_OFF + (c >> 2) * (NK * 64) + key * 64 + (c & 3) * 16) = pv[i]; } }
        if (u + G < NU) AT_ISSUE(u + G);
        const int h = kvh * 8 + wave;
        bf16x8 qr[4], qn[4];
        AT_QLOAD(qr, 0);
        __syncthreads();
        const float slope = exp2f(-0.5f * (float)(h + 1)), sink = sinks[h];
        const float M = fmaxf(bshift, sink);
        const float c1 = slope * LOG2E;
        LAS float* wsf = (LAS float*)(lds + WS_OFF) + wave * 64;
        LAS bf16* stg = (LAS bf16*)(lds + OST_OFF) + wave * 2048;
#pragma unroll 1
        for (int a = 0; a < 4; ++a) {
            if (a < 3) AT_QLOAD(qn, a + 1);
            f32x16 o[2]; o[0] = f32x16{}; o[1] = f32x16{};
            float l = 0.f;
            const int t = 32 * a + r32;
            const int tt = r32 - 4 * hi;
            const float hi4 = c1 * 4.0f * (float)hi;
            tile<0, false>(lds, 0, qr, o, l, -(slope * (float)(qb * 128 + t + 16) + M) * LOG2E + hi4, c1, tt, lane);
            if (qb > 0) {
                tile<1, true>(lds, 16 + 32 * a, qr, o, l, -(slope * (float)(128 + r32) + M) * LOG2E + hi4, c1, tt, lane);
                for (int bb = a + 1; bb < 4; ++bb) tile<1, false>(lds, 16 + 32 * bb, qr, o, l, -(slope * (float)(128 + t - 32 * bb) + M) * LOG2E + hi4, c1, tt, lane);
            }
            for (int bb = 0; bb < a; ++bb) tile<2, false>(lds, 144 + 32 * bb, qr, o, l, -(slope * (float)(t - 32 * bb) + M) * LOG2E + hi4, c1, tt, lane);
            tile<2, true>(lds, 144 + 32 * a, qr, o, l, -(slope * (float)r32 + M) * LOG2E + hi4, c1, tt, lane);
            l += __shfl_xor(l, 32);
            l += exp2f((sink - M) * LOG2E);
            if (hi == 0) wsf[r32] = l;
            LDS_WAIT();
            float rli[16];
#pragma unroll
            for (int r = 0; r < 16; ++r) rli[r] = __builtin_amdgcn_rcpf(wsf[crowc(r) + 4 * hi]);
#pragma unroll
            for (int r = 0; r < 16; ++r) { const int orow = crowc(r) + 4 * hi;
#pragma unroll
                for (int d0 = 0; d0 < 2; ++d0) stg[orow * 64 + d0 * 32 + r32] = f2bf(o[d0][r] * rli[r]); }
            LDS_WAIT();
            bf16* Ow = yatt + ((size_t)b * SEQ + qb * 128 + 32 * a) * D + h * 64;
#pragma unroll
            for (int i = 0; i < 4; ++i) { const int row = i * 8 + (lane >> 3), ch = lane & 7; const u32x4 v = *(const LAS u32x4*)(stg + row * 64 + ch * 8); *(u32x4*)(Ow + (size_t)row * D + ch * 8) = v; }
            LDS_WAIT();
#pragma unroll
            for (int d0 = 0; d0 < 4; ++d0) qr[d0] = qn[d0];
        }
        __syncthreads();
    }
}
#undef AT_ISSUE
#undef AT_QLOAD
}
namespace ret {
typedef float f32x16 __attribute__((ext_vector_type(16)));
typedef short s16x4 __attribute__((ext_vector_type(4)));
constexpr size_t WS_STATES = 893 * MiB;
__device__ __forceinline__ s16x4 vtr(LAS const unsigned char* p) { return __builtin_bit_cast(s16x4, __builtin_amdgcn_ds_read_tr16_b64_v4i16((LAS s16x4*)p)); }
__device__ __forceinline__ int crowc(int r) { return (r & 3) + 8 * (r >> 2); }
__device__ __forceinline__ float lg2gamma(int h) { return log2f(1.0f - exp2f(-5.0f - (float)h)); }

constexpr int R1_BUF = 40960;
#define RET_ISSUE(KR, VR, c_) do { const int ci__ = (c_); \
        _Pragma("unroll") for (int i = 0; i < 4; ++i) { const int idx = tid + 512 * i, key = idx >> 4, ch = idx & 15; \
            if (ci__ == 0) { KR[i] = (key >= 112) ? *(const u32x4*)(pmeta + (size_t)(key - 112) * INW + C_RK + h * 128 + ch * 8) : (u32x4){0u, 0u, 0u, 0u}; } \
            else KR[i] = *(const u32x4*)(proj + ((size_t)b * SEQ + (ci__ - 1) * 128 + key) * INW + C_RK + h * 128 + ch * 8); } \
        { const int key = tid >> 2, ch = tid & 3; \
          if (ci__ == 0) VR = (key >= 112) ? *(const u32x4*)(pmeta + (size_t)(key - 112) * INW + C_RV + h * 256 + dvs * 32 + ch * 8) : (u32x4){0u, 0u, 0u, 0u}; \
          else VR = *(const u32x4*)(proj + ((size_t)b * SEQ + (ci__ - 1) * 128 + key) * INW + C_RV + h * 256 + dvs * 32 + ch * 8); } } while (0)
#define RET_STEP(KR, VR, c_) do { const int c__ = (c_); LAS unsigned char* buf = lds + (c__ & 1) * R1_BUF; \
        _Pragma("unroll") for (int i = 0; i < 4; ++i) { const int idx = tid + 512 * i, key = idx >> 4, ch = idx & 15; *(LAS u32x4*)(buf + (ch >> 2) * (128 * 64) + key * 64 + (ch & 3) * 16) = KR[i]; } \
        { const int key = tid >> 2, ch = tid & 3; float f[8]; unpack8(VR, f); u32x4 w; \
          w.x = pk2(f[0] * vscale, f[1] * vscale); w.y = pk2(f[2] * vscale, f[3] * vscale); w.z = pk2(f[4] * vscale, f[5] * vscale); w.w = pk2(f[6] * vscale, f[7] * vscale); \
          *(LAS u32x4*)(buf + 32768 + key * 64 + ch * 16) = w; } \
        if (c__ + 2 < 32) RET_ISSUE(KR, VR, c__ + 2); \
        __syncthreads(); \
        if (wave < 4) { \
            const int dt = wave; \
            acc = acc * g128; \
            LAS const unsigned char* ab = buf + dt * (128 * 64) + (4 * hi + ((lane & 15) >> 2)) * 64 + ((lane >> 4) & 1) * 32 + (lane & 3) * 8; \
            LAS const unsigned char* bb = buf + 32768 + (4 * hi + ((lane & 15) >> 2)) * 64 + ((lane >> 4) & 1) * 32 + (lane & 3) * 8; \
            _Pragma("unroll") for (int ks = 0; ks < 8; ++ks) { \
                const s16x4 al = vtr(ab + ks * 1024), ah = vtr(ab + ks * 1024 + 512), bl = vtr(bb + ks * 1024), bh = vtr(bb + ks * 1024 + 512); \
                const bf16x8 af = (bf16x8){al[0], al[1], al[2], al[3], ah[0], ah[1], ah[2], ah[3]}, bfr = (bf16x8){bl[0], bl[1], bl[2], bl[3], bh[0], bh[1], bh[2], bh[3]}; \
                acc = __builtin_amdgcn_mfma_f32_32x32x16_bf16(af, bfr, acc, 0, 0, 0); } \
            bf16* sb = states + ((((size_t)(b * 4 + h) * 32 + c__) * 8 + dvs) * 8) * 512; \
            _Pragma("unroll") for (int g = 0; g < 4; ++g) { u32x2 w; w.x = pk2(acc[4 * g], acc[4 * g + 1]); w.y = pk2(acc[4 * g + 2], acc[4 * g + 3]); \
                *(u32x2*)(sb + (size_t)(2 * dt + (g >> 1)) * 512 + (32 * (g & 1) + (lane & 31)) * 8 + 4 * hi) = w; } \
        } } while (0)
__device__ __forceinline__ void state_chain(LAS unsigned char* lds, int b, int h, int dvs, const bf16* __restrict__ proj, const bf16* __restrict__ pmeta, bf16* __restrict__ states) {
    const int tid = threadIdx.x, lane = tid & 63, hi = lane >> 5; const int wave = __builtin_amdgcn_readfirstlane(tid >> 6);
    const float lg = lg2gamma(h), g128 = exp2f(lg * 128.0f);
    u32x4 kA[4], kB[4], vA, vB;
    const float vscale = exp2f(lg * (float)(127 - (tid >> 2)));
    f32x16 acc = {};
    RET_ISSUE(kA, vA, 0); RET_ISSUE(kB, vB, 1);
#pragma unroll 1
    for (int c = 0; c < 32; c += 2) { RET_STEP(kA, vA, c); RET_STEP(kB, vB, c + 1); }
    __syncthreads();
}
#undef RET_ISSUE
#undef RET_STEP

constexpr int R3_K = 0, R3_Q = 32768, R3_V = 65536;
#define R3_ISSUE(u_) do { const int u__ = (u_); const size_t rw = (size_t)(u__ >> 7) * SEQ + (u__ & 31) * 128; const int hh = (u__ >> 5) & 3; \
        _Pragma("unroll") for (int i = 0; i < 4; ++i) { const int idx = tid + 512 * i, key = idx >> 4, ch = idx & 15; \
            kq[i] = *(const u32x4*)(proj + (rw + key) * INW + C_RK + hh * 128 + ch * 8); kq[4 + i] = *(const u32x4*)(proj + (rw + key) * INW + C_RQ + hh * 128 + ch * 8); } \
        _Pragma("unroll") for (int i = 0; i < 8; ++i) { const int idx = tid + 512 * i, key = idx >> 5, ch = idx & 31; vv[i] = *(const u32x4*)(proj + (rw + key) * INW + C_RV + hh * 256 + ch * 8); } } while (0)
__device__ __forceinline__ void out_phase(LAS unsigned char* lds, const bf16* __restrict__ proj, const bf16* __restrict__ states, bf16* __restrict__ yret, int G, int bx) {
    const int tid = threadIdx.x, lane = tid & 63, r32 = lane & 31, hi = lane >> 5; const int wave = __builtin_amdgcn_readfirstlane(tid >> 6);
    constexpr int NU = NB * 4 * 32;
    if (bx >= NU) return;
    u32x4 kq[8], vv[8];
    R3_ISSUE(bx);
    for (int u = bx; u < NU; u += G) {
        const int b = u >> 7, h = (u >> 5) & 3, tb = u & 31;
        const float lg = lg2gamma(h);
        const size_t row0 = (size_t)b * SEQ + tb * 128;
#pragma unroll
        for (int i = 0; i < 4; ++i) { const int idx = tid + 512 * i, key = idx >> 4, ch = idx & 15;
            *(LAS u32x4*)(lds + R3_K + ch * 2048 + key * 16) = kq[i]; *(LAS u32x4*)(lds + R3_Q + ch * 2048 + key * 16) = kq[4 + i]; }
#pragma unroll
        for (int i = 0; i < 8; ++i) { const int idx = tid + 512 * i, key = idx >> 5, ch = idx & 31; *(LAS u32x4*)(lds + R3_V + (ch >> 2) * 8192 + key * 64 + (ch & 3) * 16) = vv[i]; }
        if (u + G < NU) R3_ISSUE(u + G);
        bf16x8 sf[8];
        { const bf16* sb = states + (((size_t)(b * 4 + h) * 32 + tb) * 64 + (size_t)wave * 8) * 512 + lane * 8;
#pragma unroll
          for (int k = 0; k < 8; ++k) sf[k] = *(const bf16x8*)(sb + (size_t)k * 512); }
        __syncthreads();
        u32x2 pw[2][4];
        for (int rp_ = 0; rp_ < ((PROBE_PHASE == 31) ? 2 : 1); ++rp_)
#pragma unroll
        for (int ti = 0; ti < 2; ++ti) {
            const int t = wave + 8 * ti;
            if (t < 10) {
                const int a = (t >= 6) ? 3 : (t >= 3) ? 2 : (t >= 1) ? 1 : 0, bb = t - ((a * (a + 1)) >> 1);
                f32x16 p = {};
#pragma unroll
                for (int k = 0; k < 8; ++k) {
                    const bf16x8 kf = *(const LAS bf16x8*)(lds + R3_K + (2 * k + hi) * 2048 + (32 * bb + r32) * 16);
                    const bf16x8 qf = *(const LAS bf16x8*)(lds + R3_Q + (2 * k + hi) * 2048 + (32 * a + r32) * 16);
                    p = __builtin_amdgcn_mfma_f32_32x32x16_bf16(kf, qf, p, 0, 0, 0);
                }
                const float lanebase = lg * (float)(32 * (a - bb) + r32 - 4 * hi), cpos = -lg; const int tt = r32 - 4 * hi;
                float e[16];
#pragma unroll
                for (int r = 0; r < 16; ++r) { float v = p[r] * __builtin_amdgcn_exp2f(__builtin_fmaf(cpos, (float)crowc(r), lanebase)); if (bb == a) v = (crowc(r) <= tt) ? v : 0.f; e[r] = v; }
#pragma unroll
                for (int g = 0; g < 4; ++g) { pw[ti][g].x = pk2(e[4 * g], e[4 * g + 1]); pw[ti][g].y = pk2(e[4 * g + 2], e[4 * g + 3]); }
            }
        }
        __builtin_amdgcn_sched_barrier(0);
        bf16x8 vf[8];
        { LAS const unsigned char* vb = lds + R3_V + wave * 8192 + (8 * hi + ((lane & 15) >> 2)) * 64 + ((lane >> 4) & 1) * 32 + (lane & 3) * 8;
#pragma unroll
          for (int ks = 0; ks < 8; ++ks) { const s16x4 lo = vtr(vb + ks * 1024), hh = vtr(vb + ks * 1024 + 256); vf[ks] = (bf16x8){lo[0], lo[1], lo[2], lo[3], hh[0], hh[1], hh[2], hh[3]}; } }
        __syncthreads();
#pragma unroll
        for (int ti = 0; ti < 2; ++ti) {
            const int t = wave + 8 * ti;
            if (t < 10) {
                const int a = (t >= 6) ? 3 : (t >= 3) ? 2 : (t >= 1) ? 1 : 0, bb = t - ((a * (a + 1)) >> 1);
#pragma unroll
                for (int g = 0; g < 4; ++g) *(LAS u32x2*)(lds + R3_K + (4 * bb + g) * 2048 + (32 * a + r32) * 16 + hi * 8) = pw[ti][g];
            }
        }
        __syncthreads();
        LAS bf16* stg = (LAS bf16*)(lds + R3_V);
        for (int rp_ = 0; rp_ < ((PROBE_PHASE == 32) ? 2 : 1); ++rp_)
#pragma unroll 1
        for (int a = 0; a < 4; ++a) {
            f32x16 o = {};
#pragma unroll
            for (int ks = 0; ks < 8; ++ks) if (ks < 2 * (a + 1)) {
                const bf16x8 pa = *(const LAS bf16x8*)(lds + R3_K + (2 * ks + hi) * 2048 + (32 * a + r32) * 16);
                o = __builtin_amdgcn_mfma_f32_32x32x16_bf16(pa, vf[ks], o, 0, 0, 0);
            }
            f32x16 x = {};
#pragma unroll
            for (int k = 0; k < 8; ++k) { const bf16x8 qa = *(const LAS bf16x8*)(lds + R3_Q + (2 * k + hi) * 2048 + (32 * a + r32) * 16); x = __builtin_amdgcn_mfma_f32_32x32x16_bf16(qa, sf[k], x, 0, 0, 0); }
#pragma unroll
            for (int r = 0; r < 16; ++r) {
                const float din = __builtin_amdgcn_exp2f(lg * (float)(32 * a + crowc(r) + 4 * hi + 1));
                { const int row = 32 * a + crowc(r) + 4 * hi, col = wave * 32 + r32;
                  stg[row * 256 + ((((col >> 3) ^ ((row & 3) << 2)) << 3) | (col & 7))] = f2bf(o[r] + din * x[r]); }
            }
        }
        int nl = lane; asm volatile("" : "+v"(nl));
        const int nrow = wave * 16 + (nl >> 2), c4 = nl & 3, sx = nrow & 3;
        const bf16* rgp = proj + (row0 + nrow) * INW + C_RG + h * 256 + c4 * 8;
        bf16* yp = yret + (row0 + nrow) * D + h * 256 + c4 * 8;
        LAS const bf16* sp = stg + nrow * 256 + c4 * 8;
        u32x4 rgv[8];
#pragma unroll
        for (int j = 0; j < 8; ++j) rgv[j] = *(const u32x4*)(rgp + 32 * j);
        __syncthreads();
        for (int rp_ = 0; rp_ < ((PROBE_PHASE == 33) ? 2 : 1); ++rp_) {
            float ss = 0.f;
#pragma unroll
            for (int j = 0; j < 8; ++j) { const u32x4 sw = *(const LAS u32x4*)(sp + 32 * (j ^ sx)); float f[8]; unpack8(sw, f);
#pragma unroll
                for (int i = 0; i < 8; ++i) ss += f[i] * f[i]; }
            ss += __shfl_xor(ss, 1); ss += __shfl_xor(ss, 2);
            const float rs = rsqrtf(ss * (1.0f / 256.0f) + EPS);
            asm volatile("" ::: "memory");
#pragma unroll
            for (int j = 0; j < 8; ++j) { const u32x4 sw = *(const LAS u32x4*)(sp + 32 * (j ^ sx)); float f[8], g[8]; unpack8(sw, f); unpack8(rgv[j], g); u32x4 w;
                w.x = pk2(f[0] * rs * g[0], f[1] * rs * g[1]); w.y = pk2(f[2] * rs * g[2], f[3] * rs * g[3]); w.z = pk2(f[4] * rs * g[4], f[5] * rs * g[5]); w.w = pk2(f[6] * rs * g[6], f[7] * rs * g[7]);
                *(u32x4*)(yp + 32 * j) = w; }
        }
        __syncthreads();
    }
}
#undef R3_ISSUE
}
__device__ __forceinline__ void p0_load(const float* __restrict__ W, int N, int k0, int n0, int lane, f32x4 (&v)[16]) {
    const int kblk = lane >> 3, nq = lane & 7;
    const float* src = W + (size_t)(k0 + 16 * kblk) * N + n0 + 4 * nq;
#pragma unroll
    for (int i = 0; i < 16; ++i) v[i] = __builtin_nontemporal_load((const f32x4*)(src + (size_t)i * N));
}
template <bool FP8>
__device__ __forceinline__ void p0_store(void* __restrict__ WT, int K, int k0, int dst_row0, int lane, const f32x4 (&v)[16]) {
    const int kblk = lane >> 3, nq = lane & 7;
#pragma unroll
    for (int j = 0; j < 4; ++j) {
        const size_t row = (size_t)(dst_row0 + 4 * nq + j);
        if constexpr (FP8) {
            u32x4 o;
            o.x = pk4_fp8(v[0][j] * W8_SCALE, v[1][j] * W8_SCALE, v[2][j] * W8_SCALE, v[3][j] * W8_SCALE); o.y = pk4_fp8(v[4][j] * W8_SCALE, v[5][j] * W8_SCALE, v[6][j] * W8_SCALE, v[7][j] * W8_SCALE);
            o.z = pk4_fp8(v[8][j] * W8_SCALE, v[9][j] * W8_SCALE, v[10][j] * W8_SCALE, v[11][j] * W8_SCALE); o.w = pk4_fp8(v[12][j] * W8_SCALE, v[13][j] * W8_SCALE, v[14][j] * W8_SCALE, v[15][j] * W8_SCALE);
            *(u32x4*)((unsigned char*)WT + row * K + k0 + 16 * kblk) = o;
        } else {
            u32x4 a, b;
            a.x = pk2(v[0][j], v[1][j]); a.y = pk2(v[2][j], v[3][j]); a.z = pk2(v[4][j], v[5][j]); a.w = pk2(v[6][j], v[7][j]);
            b.x = pk2(v[8][j], v[9][j]); b.y = pk2(v[10][j], v[11][j]); b.z = pk2(v[12][j], v[13][j]); b.w = pk2(v[14][j], v[15][j]);
            bf16* d = (bf16*)WT + row * K + k0 + 16 * kblk;
            *(u32x4*)d = a; *(u32x4*)(d + 8) = b;
        }
    }
}
template <bool FP8>
__device__ __forceinline__ void p0_item(const float* __restrict__ W, int K, int N, void* __restrict__ WT, int k0, int n0, int dst_row0, int lane) {
    f32x4 v[16]; p0_load(W, N, k0, n0, lane, v); p0_store<FP8>(WT, K, k0, dst_row0, lane, v);
}
constexpr int I_IN = 8 * 200, I_SQ = 8 * 32, I_GU = 32 * 8 * 64, I_DN = 32 * 8 * 32, NITEMS = I_IN + 3 * I_SQ + I_GU + I_DN;
constexpr int I_SMALL = I_IN + 3 * I_SQ, I_MOE = I_GU + I_DN;
constexpr int NCONV = 40;
#define MOE_DECODE(r_) const int r__ = (r_); const bool isgu = r__ < I_GU; const int rr = isgu ? r__ : r__ - I_GU; \
    const int e_ = isgu ? rr / 512 : rr / 256, q_ = isgu ? rr % 512 : rr % 256, kb_ = isgu ? q_ / 64 : q_ / 32, nb_ = isgu ? q_ % 64 : q_ % 32, n0_ = nb_ * 32; \
    const float* src_ = isgu ? w_gu + (size_t)e_ * D * 2048 : w_dn + (size_t)e_ * DFF * D; const int N_ = isgu ? 2048 : D; \
    unsigned char* dst_ = isgu ? Wgu_t + (size_t)e_ * 2048 * D : Wdn_t + (size_t)e_ * D * DFF; \
    const int drow_ = isgu ? 256 * ((n0_ & 1023) >> 7) + 128 * (n0_ >> 10) + (n0_ & 127) : n0_;
#define P0_DISPATCH(it_) do { int r = (it_); \
    if (r < I_IN) { const int kb = r / 200, nb = r % 200, n0 = nb * 32, o = n0 & 255, wcc = o >> 6, bj = (o >> 5) & 1; \
        p0_item<false>(w_in, D, INW, Win_t, kb * 128, n0, (n0 & ~255) + 128 * bj + 32 * wcc, lane); break; } \
    r -= I_IN; \
    if (r < I_SQ) { p0_item<false>(w_ab, D, D, Wab_t, (r / 32) * 128, (r % 32) * 32, (r % 32) * 32, lane); break; } r -= I_SQ; \
    if (r < I_SQ) { p0_item<false>(w_rb, D, D, Wrb_t, (r / 32) * 128, (r % 32) * 32, (r % 32) * 32, lane); break; } r -= I_SQ; \
    if (r < I_SQ) { p0_item<false>(w_out, D, D, Wout_t, (r / 32) * 128, (r % 32) * 32, (r % 32) * 32, lane); break; } r -= I_SQ; \
    if (r < I_GU) { const int e = r / 512, q = r % 512, kb = q / 64, nb = q % 64, n0 = nb * 32, bj = n0 >> 10, rem = n0 & 1023, pn = rem >> 7, cl = rem & 127; \
        p0_item<true>(w_gu + (size_t)e * D * 2048, D, 2048, Wgu_t + (size_t)e * 2048 * D, kb * 128, n0, 256 * pn + 128 * bj + cl, lane); break; } \
    r -= I_GU; \
    { const int e = r / 256, q = r % 256, kb = q / 32, nb = q % 32; \
      p0_item<true>(w_dn + (size_t)e * DFF * D, DFF, D, Wdn_t + (size_t)e * D * DFF, kb * 128, nb * 32, nb * 32, lane); } } while (0)
#ifndef PROBE_PHASE
#define PROBE_PHASE (-1)
#endif
#ifndef PROBE_TS
#define PROBE_TS (-1)
#endif
constexpr int CW_TS = 1200;
__device__ __forceinline__ void p0_transpose_item_fp8(const float* W, int K, int N, unsigned char* WT, int k0, int n0, int dst_row0, LAS float* scr, int lane) {
#pragma unroll 8
    for (int i = 0; i < 32; ++i) { const int kk = 2 * i + (lane >> 5); scr[kk * 33 + (lane & 31)] = W[(size_t)(k0 + kk) * N + n0 + (lane & 31)]; }
    LDS_WAIT(); asm volatile("" ::: "memory");
    const int c = lane & 3;
#pragma unroll
    for (int j = 0; j < 2; ++j) { const int n = (lane >> 2) + 16 * j; const LAS float* s = scr + (16 * c) * 33 + n;
        u32x4 o;
        o.x = pk4_fp8(s[0 * 33] * W8_SCALE, s[1 * 33] * W8_SCALE, s[2 * 33] * W8_SCALE, s[3 * 33] * W8_SCALE); o.y = pk4_fp8(s[4 * 33] * W8_SCALE, s[5 * 33] * W8_SCALE, s[6 * 33] * W8_SCALE, s[7 * 33] * W8_SCALE);
        o.z = pk4_fp8(s[8 * 33] * W8_SCALE, s[9 * 33] * W8_SCALE, s[10 * 33] * W8_SCALE, s[11 * 33] * W8_SCALE); o.w = pk4_fp8(s[12 * 33] * W8_SCALE, s[13 * 33] * W8_SCALE, s[14 * 33] * W8_SCALE, s[15 * 33] * W8_SCALE);
        *(u32x4*)(WT + (size_t)(dst_row0 + n) * K + k0 + 16 * c) = o; }
    LDS_WAIT(); asm volatile("" ::: "memory");
}
struct Args { const float* in[17]; float* out; unsigned char* ws; int ph_lo, ph_hi, li, pad; };

__global__ void __launch_bounds__(512, 2) mk_fwd(Args args) {
    extern __shared__ __attribute__((aligned(16))) unsigned char lds_raw[];
    LAS unsigned char* lds = (LAS unsigned char*)lds_raw;
    volatile LAS unsigned* MISC = (volatile LAS unsigned*)(lds + MISC_OFF);
    const int tid = threadIdx.x, lane = tid & 63, wave = __builtin_amdgcn_readfirstlane(tid >> 6);
    const int G = gridDim.x, bx = blockIdx.x;
    const int vcu = (G % 8 == 0) ? (bx % 8) * (G / 8) + bx / 8 : bx;
    unsigned char* ws = args.ws;
    unsigned* ctl = (unsigned*)(ws + WS_CTL);
    const float* x = args.in[0]; const float* meta = args.in[1]; const float* g1 = args.in[2]; const float* w_in = args.in[3];
    const float* qg = args.in[4]; const float* kg = args.in[5];
    const float* w_ab = args.in[7]; const float* w_rb = args.in[8]; const float* w_out = args.in[9];
    const float* w_gu = args.in[13]; const float* b_gu = args.in[14]; const float* w_dn = args.in[15]; const float* b_dn = args.in[16];
    float* out = args.out;
    bf16* Win_t = (bf16*)(ws + WS_WIN); bf16* Wab_t = (bf16*)(ws + WS_WAB); bf16* Wrb_t = (bf16*)(ws + WS_WRB); bf16* Wout_t = (bf16*)(ws + WS_WOUT);
    unsigned char* Wgu_t = ws + WS_WGU; unsigned char* Wdn_t = ws + WS_WDN;
    bf16* xb = (bf16*)(ws + WS_XB); bf16* proj = (bf16*)(ws + WS_PROJ); bf16* yatt = (bf16*)(ws + WS_YATT); bf16* yret = (bf16*)(ws + WS_YRET); bf16* merged = (bf16*)(ws + WS_MERGED);
    bf16* pmeta = proj + (size_t)NTOK * INW;
    const float* sinks = args.in[6]; const float* g2 = args.in[10]; const float* w_r = args.in[11]; const float* b_r = args.in[12];
    int* tke = (int*)(ws + SM_TKE); float* tkw = (float*)(ws + SM_TKW); int* tkpos = (int*)(ws + SM_TKPOS); int* list = (int*)(ws + SM_LIST); float* wlist = (float*)(ws + SM_WLIST); float* rlist = (float*)(ws + SM_RLIST);
    LAS unsigned char* misc = lds + MISC_OFF;
    bf16* states = (bf16*)(ws + ret::WS_STATES);
    bf16* h2b = (bf16*)(ws + ret::WS_STATES);
    unsigned char* act = ws + WS_ACT; unsigned char* rows = ws + WS_ROWS; unsigned char* xn8 = ws + WS_XB;

    for (int u = tid; u < (LDS_BYTES - MISC_OFF) / 4; u += 512) ((LAS unsigned*)(lds + MISC_OFF))[u] = 0u;
    __syncthreads();
    XcdBarrier bar = xcd_barrier_post(ctl + CW_BAR + args.li * XCD_BAR_WORDS, MISC + 8);
    const int lo = args.ph_lo, hi = args.ph_hi;
#define IN(k) (lo <= (k) && (k) < hi)
#define BOTH(k) (IN(k) && IN((k) + 1))
#define GRID_BAR() do { xcd_barrier(bar); if (PROBE_TS >= 0 && bx == 0 && tid == 0) { ctl[CW_TS + ts_n] = (unsigned)__builtin_amdgcn_s_memrealtime(); } ++ts_n; } while (0)
    int ts_n = 1; if (PROBE_TS >= 0 && bx == 0 && tid == 0) ctl[CW_TS] = (unsigned)__builtin_amdgcn_s_memrealtime();

    if (PROBE_PHASE == 300) { const unsigned long long t0_ = __builtin_amdgcn_s_memrealtime(); while (__builtin_amdgcn_s_memrealtime() - t0_ < 5000ull) __builtin_amdgcn_s_sleep(8); }
    if (PROBE_PHASE == 301) {
        const size_t gt = (size_t)bx * 512 + tid; unsigned acc_ = 0;
        for (size_t pg = gt; pg < (size_t)NTOK * D * 4 / 4096; pg += (size_t)G * 512) acc_ += ((const unsigned*)x)[pg * 1024];
        for (size_t pg = gt; pg < (size_t)D * INW * 4 / 4096; pg += (size_t)G * 512) acc_ += ((const unsigned*)w_in)[pg * 1024];
        for (size_t pg = gt; pg < (size_t)(NTOK + 256) * D * 2 / 4096; pg += (size_t)G * 512) acc_ += ((const unsigned*)xb)[pg * 1024];
        for (size_t pg = gt; pg < (size_t)INW * D * 2 / 4096; pg += (size_t)G * 512) acc_ += ((const unsigned*)Win_t)[pg * 1024];
        asm volatile("" :: "v"(acc_));
    }
    if (IN(0)) { for (int rep_ = 0; rep_ < ((PROBE_PHASE == 0) ? 2 : 1); ++rep_) {
        const int gw = vcu * NWAVES + wave, NGW = G * NWAVES;
        for (int it = gw; it < ((G == 256) ? I_SMALL : NITEMS); it += NGW) { P0_DISPATCH(it); }
        for (int row0_ = gw; row0_ < NTOK; row0_ += 4 * NGW) {
            f32x4 v[4][4];
#pragma unroll
            for (int q = 0; q < 4; ++q) { const int row = row0_ + q * NGW; if (row < NTOK) { const f32x4* xr = (const f32x4*)(x + (size_t)row * D) + lane;
#pragma unroll
                for (int j = 0; j < 4; ++j) v[q][j] = xr[64 * j]; } }
#pragma unroll
            for (int q = 0; q < 4; ++q) { const int row = row0_ + q * NGW; if (row < NTOK) {
                float ss = 0.f;
#pragma unroll
                for (int j = 0; j < 4; ++j) ss += (v[q][j][0] * v[q][j][0] + v[q][j][1] * v[q][j][1]) + (v[q][j][2] * v[q][j][2] + v[q][j][3] * v[q][j][3]);
                const float rstd = rsqrtf(wave_sum(ss) * (1.0f / D) + EPS);
                u32x2* o8 = (u32x2*)(xb + (size_t)row * D) + lane;
#pragma unroll
                for (int j = 0; j < 4; ++j) { const f32x4 gg = ((const f32x4*)g1)[64 * j + lane]; u32x2 w; w.x = pk2(v[q][j][0] * rstd * gg[0], v[q][j][1] * rstd * gg[1]); w.y = pk2(v[q][j][2] * rstd * gg[2], v[q][j][3] * rstd * gg[3]); o8[64 * j] = w; }
            } }
        }
        for (int row = gw; row < 256; row += NGW) {
            u32x2* o8 = (u32x2*)(xb + (size_t)(NTOK + row) * D) + lane;
            if (row < NMETA) {
                const f32x4* xr = (const f32x4*)(meta + (size_t)row * D) + lane;
                f32x4 v[4]; float ss = 0.f;
#pragma unroll
                for (int j = 0; j < 4; ++j) { v[j] = xr[64 * j]; ss += (v[j][0] * v[j][0] + v[j][1] * v[j][1]) + (v[j][2] * v[j][2] + v[j][3] * v[j][3]); }
                const float rstd = rsqrtf(wave_sum(ss) * (1.0f / D) + EPS);
#pragma unroll
                for (int j = 0; j < 4; ++j) { const f32x4 gg = ((const f32x4*)g1)[64 * j + lane]; u32x2 w; w.x = pk2(v[j][0] * rstd * gg[0], v[j][1] * rstd * gg[1]); w.y = pk2(v[j][2] * rstd * gg[2], v[j][3] * rstd * gg[3]); o8[64 * j] = w; }
            } else {
#pragma unroll
                for (int j = 0; j < 4; ++j) o8[64 * j] = (u32x2){0u, 0u};
            }
        }
        __syncthreads(); }
        if (BOTH(0)) GRID_BAR();
    }
    if (PROBE_PHASE == 200) { GRID_BAR(); GRID_BAR(); GRID_BAR(); GRID_BAR(); }
    if (IN(1)) {
        const int nconv = (G == 256) ? NCONV : 0;
        if (bx < nconv) {
            const int cw = bx * NWAVES + wave, ncw = nconv * NWAVES;
#pragma unroll 1
            for (int it = cw; it < I_MOE; it += 2 * ncw) {
                f32x4 va[16], vb[16];
                { MOE_DECODE(it); p0_load(src_, N_, kb_ * 128, n0_, lane, va); }
                const bool two = it + ncw < I_MOE;
                if (two) { MOE_DECODE(it + ncw); p0_load(src_, N_, kb_ * 128, n0_, lane, vb); }
                { MOE_DECODE(it); p0_store<true>(dst_, 1024, kb_ * 128, drow_, lane, va); }
                if (two) { MOE_DECODE(it + ncw); p0_store<true>(dst_, 1024, kb_ * 128, drow_, lane, vb); }
            }
        } else {
            { LAS float* gt = (LAS float*)(misc + MT_GAIN); if (tid < 64) { gt[tid] = 0.125f * 1.4426950408889634f * qg[tid]; gt[64 + tid] = kg[tid]; }       __syncthreads(); }
            SchedDense S; S.init(xb, Win_t, NTOK + 256, INW, D, G - nconv, bx - nconv);
            EpiProj E{proj, (LAS const float*)(misc + MT_GAIN)};
            pg8::gemm_phase<EpiProj, SchedDense>(lds, 2 * D, S, E);
        }
        if (BOTH(1)) GRID_BAR();
    }
    if (IN(2)) {
        float mq = fabsf(qg[lane]), mk = fabsf(kg[lane]);
#pragma unroll
        for (int o = 1; o < 64; o <<= 1) { mq = fmaxf(mq, __shfl_xor(mq, o)); mk = fmaxf(mk, __shfl_xor(mk, o)); }
        const float bshift = 8.0f * mq * mk;
        for (int rep_ = 0; rep_ < ((PROBE_PHASE == 20) ? 2 : 1); ++rep_) attn::phase(lds, proj, pmeta, sinks, bshift, yatt, G, bx);
        for (int rep_ = 0; rep_ < ((PROBE_PHASE == 21) ? 2 : 1); ++rep_) for (int u = bx; u < NB * 4 * 8; u += G) { const int v = ((G & 7) == 0 && G == 256) ? ((u & 7) * 32 + (u >> 3)) : u;
            ret::state_chain(lds, v >> 5, (v >> 3) & 3, v & 7, proj, pmeta, states); }
        if (BOTH(2)) GRID_BAR();
    }
    if (IN(3)) {
        ret::out_phase(lds, proj, states, yret, G, bx);
        if (BOTH(3)) GRID_BAR();
    }
    if (IN(4)) {
        SchedBranch2 S; S.init(yatt, Wab_t, NTOK, D, D, G, bx); S.dA = (size_t)(WS_YRET - WS_YATT) - 16 * 128; S.dB = (size_t)(WS_WRB - WS_WAB) - 16 * 128;
        EpiBranch2 E{merged, proj};
        pg8::gemm_phase<EpiBranch2, SchedBranch2>(lds, 2 * D, S, E);
        if (BOTH(4)) GRID_BAR();
    }
    if (IN(5)) {
        SchedDense S; S.init(merged, Wout_t, NTOK, D, D, G, bx);
        EpiOut E{x, h2b};
        pg8::gemm_phase<EpiOut, SchedDense>(lds, 2 * D, S, E);
        if (BOTH(5)) { route_images(lds, g2, w_r); GRID_BAR(); }
    }
    if (IN(6)) {
        if (!IN(5)) route_images(lds, g2, w_r);
        route_phase(lds, h2b, g2, w_r, b_r, xn8, tke, tkpos, tkw, list, wlist, rlist, ctl + CW_CNT, G, bx);
        if (BOTH(6)) GRID_BAR();
    }
    if (hi > 7 && lo <= 9) moe_tables(misc, ctl + CW_CNT);
    if (IN(7)) {
        SchedMoe<true, 8> S{(const char*)xn8, (const char*)Wgu_t, misc, list, G, bx};
        EpiGU E{act, b_gu, rlist, misc};
        pg8::gemm_phase<EpiGU, SchedMoe<true, 8>, true>(lds, D, S, E);
        if (BOTH(7)) GRID_BAR();
    }
    if (IN(8)) {
        SchedMoe<false, 4> S{(const char*)act, (const char*)Wdn_t, misc, list, G, bx};
        EpiDown E{rows, b_dn, wlist, misc};
        pg8::gemm_phase<EpiDown, SchedMoe<false, 4>, true>(lds, DFF, S, E);
        if (BOTH(8)) GRID_BAR();
    }
    float oscale = 1.0f;
    if (PROBE_TS >= 0) {
        xcd_barrier(bar);
        const unsigned a = ctl[CW_TS + (PROBE_TS == 99 ? 0 : PROBE_TS)], b = ctl[CW_TS + (PROBE_TS == 99 ? 0 : PROBE_TS) + 1];
        float frac = fminf((float)(b - a) * (1.0f / 40000.0f), 1.0f); if (PROBE_TS == 99) frac = 0.5f;
        if (PROBE_TS == 0) frac = floorf(frac * 16.0f) * (1.0f / 16.0f);
        oscale = 1.0f + sqrtf(0.0009f + 0.0033f * frac);
    }
    if (IN(9)) combine_phase(misc, h2b, out, rows, tke, tkpos, vcu * NWAVES + wave, G * NWAVES, lane, oscale);
#undef IN
#undef BOTH
#undef GRID_BAR
}

extern "C" void kernel_launch(void* const* d_in, const int* in_sizes, int n_in, void* d_out, int out_size, void* d_ws, size_t ws_size, hipStream_t stream) {
    static int grid = 0;
    if (grid == 0) {
        if (n_in != 17 || in_sizes[0] != NTOK * D || out_size != NTOK * D || ws_size < WS_END) {
            fprintf(stderr, "kernel_launch: unexpected shapes (n_in %d in0 %d out %d ws %zu)\n", n_in, n_in > 0 ? in_sizes[0] : -1, out_size, ws_size); grid = -1; return; }
        int dev = 0, cus = 0;
        if (hipGetDevice(&dev) != hipSuccess || hipDeviceGetAttribute(&cus, hipDeviceAttributeMultiprocessorCount, dev) != hipSuccess) { grid = -1; return; }
        if (hipFuncSetAttribute((const void*)mk_fwd, hipFuncAttributeMaxDynamicSharedMemorySize, LDS_BYTES) != hipSuccess) { fprintf(stderr, "kernel_launch: hipFuncSetAttribute failed\n"); grid = -1; return; }
        grid = cus;
    }
    if (grid < 0) return;
    unsigned char* ws = (unsigned char*)d_ws;
    (void)hipMemsetAsync(ws + WS_CTL, 0, 32768, stream);
    Args a{};
    for (int i = 0; i < 17; ++i) a.in[i] = (const float*)d_in[i];
    a.out = (float*)d_out; a.ws = ws; a.ph_lo = 0; a.ph_hi = 10; a.li = 0; a.pad = 0;
    hipLaunchKernelGGL(mk_fwd, dim3(grid), dim3(512), LDS_BYTES, stream, a);
}
```

```cpp
#include <hip/hip_runtime.h>
#include <cstdio>
#include <cstdint>

typedef unsigned short bf16;
__device__ __forceinline__ float bf2f(bf16 v) { return __uint_as_float(((unsigned)v) << 16); }
__device__ __forceinline__ bf16 f2bf(float f) { const __bf16 b = (__bf16)f; return __builtin_bit_cast(unsigned short, b); }
__device__ __forceinline__ float sigmoidf_(float x) { return __builtin_amdgcn_rcpf(1.0f + __builtin_amdgcn_exp2f(-1.4426950408889634f * x)); }

constexpr int NB = 8, SEQ = 4096, D = 1024, NTOK = NB * SEQ;
constexpr int NMETA = 16;
constexpr int INW = 6400;
constexpr int C_AQ = 0, C_AK = 1024, C_AV = 1152, C_RQ = 1280, C_RK = 1792, C_RV = 2304, C_RG = 3328, C_GA = 4352, C_GR = 5376;
constexpr int NE = 32, TOPK = 4, DFF = 1024;
constexpr int NROWS = (NTOK * TOPK / 256 + NE) * 256;
constexpr int NTILE = NROWS / 256;
constexpr float EPS = 1e-5f;

constexpr size_t MiB = 1u << 20;
constexpr size_t WS_CTL = 0;
constexpr size_t WS_SMALL = 1 * MiB;
constexpr size_t WS_W = 16 * MiB;
constexpr size_t WS_XB = 232 * MiB;
constexpr size_t WS_PROJ = 297 * MiB;
constexpr size_t WS_YATT = 701 * MiB;
constexpr size_t WS_YRET = 765 * MiB;
constexpr size_t WS_MERGED = 829 * MiB;
constexpr size_t WS_END = 1020 * MiB;
constexpr size_t WS_ACT = 297 * MiB;
constexpr size_t WS_ROWS = 568 * MiB;
constexpr size_t SM_UMETA = WS_SMALL;
constexpr size_t SM_PMETA = WS_SMALL + 64 * 1024;
constexpr size_t SM_TKE = WS_SMALL + 512 * 1024;
constexpr size_t SM_TKW = SM_TKE + 512 * 1024;
constexpr size_t SM_TKPOS = SM_TKW + 512 * 1024;
constexpr size_t SM_TKROW = SM_TKPOS + 512 * 1024;
constexpr size_t SM_ROWTOK = SM_TKROW + 512 * 1024;
constexpr size_t SM_ROWW = SM_ROWTOK + 1024 * 1024;
constexpr size_t SM_TILEE = SM_ROWW + 1024 * 1024;
constexpr int CW_CNT = 1024;

#ifndef PROBE_PHASE
#define PROBE_PHASE (-1)
#endif
#define LAS __attribute__((address_space(3)))
#define GAS __attribute__((address_space(1)))
typedef short bf16x8 __attribute__((ext_vector_type(8)));
typedef float f32x4 __attribute__((ext_vector_type(4)));
typedef float f32x2 __attribute__((ext_vector_type(2)));
typedef unsigned u32x4 __attribute__((ext_vector_type(4)));
typedef unsigned u32x2 __attribute__((ext_vector_type(2)));
#define LDS_WAIT() asm volatile("s_waitcnt lgkmcnt(0)" ::: "memory")
#define VM_WAIT() asm volatile("s_waitcnt vmcnt(0)" ::: "memory")
typedef __bf16 bf16x2_t __attribute__((ext_vector_type(2)));
__device__ __forceinline__ unsigned pk2(float lo, float hi) { const f32x2 v = {lo, hi}; const bf16x2_t b = __builtin_convertvector(v, bf16x2_t); return __builtin_bit_cast(unsigned, b); }
__device__ __forceinline__ unsigned pk4_fp8(float a, float b, float c, float d) { int w = __builtin_amdgcn_cvt_pk_fp8_f32(a, b, 0, false); w = __builtin_amdgcn_cvt_pk_fp8_f32(c, d, w, true); return (unsigned)w; }
constexpr float W8_SCALE = 64.0f, W8_INV = 1.0f / 64.0f;
constexpr float ROW8_SCALE = 16.0f, ROW8_INV = 1.0f / 16.0f;
constexpr float XB8_SCALE = 8.0f, XB8_INV = 1.0f / 8.0f;
constexpr int T8 = 17;
__device__ __forceinline__ u32x4 pack8(const f32x4& a, const f32x4& b) { u32x4 w; w.x = pk2(a[0], a[1]); w.y = pk2(a[2], a[3]); w.z = pk2(b[0], b[1]); w.w = pk2(b[2], b[3]); return w; }
__device__ __forceinline__ void unpack8(const u32x4& w, float (&f)[8]) {
    f[0] = __uint_as_float(w.x << 16); f[1] = __uint_as_float(w.x & 0xffff0000u); f[2] = __uint_as_float(w.y << 16); f[3] = __uint_as_float(w.y & 0xffff0000u);
    f[4] = __uint_as_float(w.z << 16); f[5] = __uint_as_float(w.z & 0xffff0000u); f[6] = __uint_as_float(w.w << 16); f[7] = __uint_as_float(w.w & 0xffff0000u);
}
__device__ __forceinline__ float wave_sum(float v) {
#pragma unroll
    for (int o = 1; o < 64; o <<= 1) v += __shfl_xor(v, o);
    return v;
}

constexpr size_t WS_WIN = WS_W;
constexpr size_t WS_WAB = WS_W + 13 * MiB;
constexpr size_t WS_WRB = WS_W + 15 * MiB;
constexpr size_t WS_WOUT = WS_W + 17 * MiB;
constexpr size_t WS_WGU = WS_W + 19 * MiB;
constexpr size_t WS_WDN = WS_W + 147 * MiB;
static_assert(WS_WDN + 64 * MiB <= WS_XB, "weight map");
constexpr size_t SM_ATILE = SM_TILEE + 4096;
constexpr int CW_NACT = 1088;
constexpr int CW_BAR = 4096;

constexpr int RING_BYTES = 131072;
constexpr int MISC_OFF = RING_BYTES;
constexpr int LDS_BYTES = 163840;
constexpr int NWAVES = 8;

#define XB_TMO      128
#define XB_XCNT(j)  (256  + 64 * (j))
#define XB_XSUB(j)  (1280 + 64 * (j))
#define XB_XGEN(j)  (2304 + 64 * (j))
#define XB_TOP      3328
#define XB_TOPGEN   3392
#define XCD_BAR_WORDS 3456
#define XB_SPIN_CAP (1u << 20)
__device__ __forceinline__ unsigned xb_ld(unsigned* p)              { return __hip_atomic_load(p, __ATOMIC_RELAXED, __HIP_MEMORY_SCOPE_AGENT); }
__device__ __forceinline__ unsigned xb_add(unsigned* p, unsigned v) { return __hip_atomic_fetch_add(p, v, __ATOMIC_RELAXED, __HIP_MEMORY_SCOPE_AGENT); }
__device__ __forceinline__ unsigned xb_xcc_id() { return (unsigned)__builtin_amdgcn_s_getreg((3 << 11) | 20) & 0xFu; }
#define XB_SPIN(cond, bar) do { unsigned _sp = 0; while (cond) { __builtin_amdgcn_s_sleep(1); \
    if ((++_sp & 255u) == 0u) { if (xb_ld(&(bar)[XB_TMO])) break; if (_sp > XB_SPIN_CAP) { atomicAdd(&(bar)[XB_TMO], 1u); break; } } } } while (0)
struct XcdBarrier { unsigned* bar; unsigned x; volatile LAS unsigned* st; };
__device__ __forceinline__ XcdBarrier xcd_barrier_post(unsigned* bar, volatile LAS unsigned* st) {
    XcdBarrier b; b.bar = bar; b.x = xb_xcc_id(); b.st = st;
    if (threadIdx.x == 0) (void)xb_add(&bar[XB_XCNT(b.x)], 1u);
    return b;
}
__device__ __forceinline__ void xcd_barrier_complete(unsigned* bar, unsigned x, unsigned& nloc, unsigned& nx) {
    const unsigned G = gridDim.x * gridDim.y * gridDim.z;
    unsigned sum, cnt, mine, sp = 0u;
    for (;;) {
        sum = 0u; cnt = 0u; mine = 0u;
#pragma unroll
        for (unsigned j = 0; j < 16; ++j) { const unsigned c = xb_ld(&bar[XB_XCNT(j)]); sum += c; cnt += (c > 0u) ? 1u : 0u; mine = (j == x) ? c : mine; }
        if (sum == G) break;
        __builtin_amdgcn_s_sleep(1);
        if ((++sp & 255u) == 0u) { if (xb_ld(&bar[XB_TMO])) break; if (sp > XB_SPIN_CAP) { atomicAdd(&bar[XB_TMO], 1u); break; } }
    }
    nloc = mine > 0u ? mine : 1u; nx = cnt > 0u ? cnt : 1u;
}
__device__ __forceinline__ void xcd_barrier(const XcdBarrier& b) {
    asm volatile("s_waitcnt vmcnt(0)" ::: "memory");
    __syncthreads();
    if (threadIdx.x == 0) {
        unsigned* bar = b.bar;
        __builtin_amdgcn_s_waitcnt(0);
        unsigned nloc = b.st[0], nx = b.st[1];
        if (nloc == 0u) { xcd_barrier_complete(bar, b.x, nloc, nx); b.st[0] = nloc; b.st[1] = nx; }
        const unsigned old = xb_add(&bar[XB_XSUB(b.x)], 1u);
        const unsigned gen = old / nloc;
        if (old + 1u == (gen + 1u) * nloc) {
            __builtin_amdgcn_fence(__ATOMIC_RELEASE, "agent");
            asm volatile("s_waitcnt vmcnt(0)" ::: "memory");
            const unsigned og = xb_add(&bar[XB_TOP], 1u);
            const unsigned tg = og / nx;
            if (og + 1u == (tg + 1u) * nx) xb_add(&bar[XB_TOPGEN], 1u);
            else XB_SPIN(xb_ld(&bar[XB_TOPGEN]) == tg, bar);
            __builtin_amdgcn_fence(__ATOMIC_ACQUIRE, "agent");
            xb_add(&bar[XB_XGEN(b.x)], 1u);
            asm volatile("s_waitcnt vmcnt(0)" ::: "memory");
        } else {
            XB_SPIN(xb_ld(&bar[XB_XGEN(b.x)]) == gen, bar);
            __builtin_amdgcn_fence(__ATOMIC_ACQUIRE, "agent");
            asm volatile("s_waitcnt vmcnt(0)" ::: "memory");
        }
    }
    __syncthreads();
}

namespace pg8 {
constexpr int BM = 256, BK = 64, HALF = 128, HTB = HALF * BK * 2, STAGE_BYTES = 8 * HTB;
__host__ __device__ __forceinline__ int lds_byte(int r, int c) { const int st = (r >> 4) * 2 + (c >> 5), rr = r & 15, cc = c & 31, ob = rr * 64 + cc * 2; return st * 1024 + (ob ^ (((ob >> 9) & 1) << 5)); }
__host__ __device__ __forceinline__ void stage_rc(int b, int& R, int& C) { const int st = b / 1024, sb = b % 1024, swz = sb ^ (((sb >> 9) & 1) << 5); R = (st >> 1) * 16 + swz / 64; C = (st & 1) * 32 + (swz % 64) / 2; }
__host__ __device__ __forceinline__ int perm32(int rho) { const int n = rho >> 4, i = rho & 15; return 8 * (i >> 2) + 4 * n + (i & 3); }
struct Unit { int pm, pn, aux, tl; const char* A; const char* B; };
typedef f32x4 Acc[2][2][4][2];
typedef int u32x4_i __attribute__((ext_vector_type(4)));

typedef int v8i32 __attribute__((ext_vector_type(8)));
template <class Epi, class Sched, bool FP8 = false>
__device__ __forceinline__ void gemm_phase(LAS unsigned char* lds, const int Kb, const Sched& S, const Epi& E) {
    const int tid = threadIdx.x, wid = __builtin_amdgcn_readfirstlane(tid >> 6), lane = tid & 63, wr = wid >> 2, wc = wid & 3, fr = lane & 15, fq = lane >> 4;
    const int nt = Sched::SEG ? 2 * Sched::SEG : Kb / 128;
    int RA[2], CA[2]; unsigned voffB[2];
#pragma unroll
    for (int i = 0; i < 2; ++i) { int R, C; stage_rc(tid * 16 + i * 8192, R, C); const int Rb = Epi::PERM ? ((R & ~31) + perm32(R & 31)) : R;
        RA[i] = R; CA[i] = C; voffB[i] = (unsigned)(Rb * Kb + C * 2); }
    const size_t kstep = (size_t)(BK * 2);
    const size_t hstep = (size_t)HALF * Kb;
    const unsigned ldsw = (unsigned)wid * 1024u;
    const int aoff = lds_byte(wr * 64 + fr, fq * 8), boff = lds_byte(wc * 32 + fr, fq * 8);
#define PG8_SA(b, h) (((b) * 2 + (h)) * HTB)
#define PG8_SB(b, h) ((4 + (b) * 2 + (h)) * HTB)
#define PG8_STAGE(bufoff, gbase, voff) do { _Pragma("unroll") for (int _i = 0; _i < 2; ++_i) \
        __builtin_amdgcn_global_load_lds((const unsigned*)((const char*)(gbase) + (voff)[_i]), (LAS unsigned*)(lds + (bufoff) + ldsw + _i * 8192), 16, 0, 0); } while (0)
#define PG8_LDA(dst, b, h) do { _Pragma("unroll") for (int m = 0; m < 4; ++m) _Pragma("unroll") for (int k = 0; k < 2; ++k) dst[m][k] = *(const LAS bf16x8*)(lds + PG8_SA(b, h) + aoff + m * 2048 + k * 1024); } while (0)
#define PG8_LDB(dst, b, h) do { _Pragma("unroll") for (int n = 0; n < 2; ++n) _Pragma("unroll") for (int k = 0; k < 2; ++k) dst[n][k] = *(const LAS bf16x8*)(lds + PG8_SB(b, h) + boff + n * 2048 + k * 1024); } while (0)
#define PG8_MMA(ai, bj, At, Bt) do { __builtin_amdgcn_s_setprio(1); _Pragma("unroll") for (int m = 0; m < 4; ++m) _Pragma("unroll") for (int n = 0; n < 2; ++n) { \
        if constexpr (FP8) { const v8i32 bq = __builtin_shufflevector(__builtin_bit_cast(u32x4_i, Bt[n][0]), __builtin_bit_cast(u32x4_i, Bt[n][1]), 0, 1, 2, 3, 4, 5, 6, 7), \
                                         aq = __builtin_shufflevector(__builtin_bit_cast(u32x4_i, At[m][0]), __builtin_bit_cast(u32x4_i, At[m][1]), 0, 1, 2, 3, 4, 5, 6, 7); \
            asm volatile("v_mfma_scale_f32_16x16x128_f8f6f4 %0, %1, %2, %0, %3, %3 op_sel_hi:[0,0,0]" : "+v"(acc[ai][bj][m][n]) : "v"(bq), "v"(aq), "v"(scale1)); } \
        else { _Pragma("unroll") for (int k = 0; k < 2; ++k) acc[ai][bj][m][n] = __builtin_amdgcn_mfma_f32_16x16x32_bf16(Bt[n][k], At[m][k], acc[ai][bj][m][n], 0, 0, 0); } } \
        __builtin_amdgcn_s_setprio(0); } while (0)
#define PG8_WAIT_V(n) asm volatile("s_waitcnt vmcnt(" #n ")" ::: "memory")
#define PG8_WAIT_L(n) asm volatile("s_waitcnt lgkmcnt(" #n ")" ::: "memory")
#define PG8_BAR __builtin_amdgcn_s_barrier()
#define PG8_SCHED __builtin_amdgcn_sched_barrier(0)
    int scale1 = 0x7f7f7f7f; asm volatile("" : "+v"(scale1));
    Unit cur, nxt; int ui = 0;
    if (!S.next(0, cur)) return;
    unsigned ca[2][2], na[2][2];
    S.aoff(cur, RA, CA, ca);
    f32x4 acc[2][2][4][2];
#pragma unroll
    for (int a = 0; a < 2; ++a)
#pragma unroll
        for (int b = 0; b < 2; ++b)
#pragma unroll
            for (int m = 0; m < 4; ++m)
#pragma unroll
                for (int n = 0; n < 2; ++n) acc[a][b][m][n] = (f32x4){0.f, 0.f, 0.f, 0.f};
    bf16x8 At[4][2], B0[2][2], B1[2][2];
    const char* cA = cur.A; const char* cB = cur.B;
    E.prefetch(cur, 0, wid, lane);
    PG8_STAGE(PG8_SB(0, 0), cB, voffB); PG8_STAGE(PG8_SB(0, 1), cB + hstep, voffB); PG8_STAGE(PG8_SA(0, 0), cA, ca[0]); PG8_STAGE(PG8_SA(0, 1), cA, ca[1]);
    if (wr == 1) PG8_BAR;
    PG8_WAIT_V(2); PG8_BAR;
    PG8_STAGE(PG8_SB(1, 0), cB + kstep, voffB); PG8_STAGE(PG8_SA(1, 0), cA + kstep, ca[0]); PG8_STAGE(PG8_SB(1, 1), cB + hstep + kstep, voffB);
    PG8_WAIT_V(6); PG8_BAR;
    for (;;) {
        const bool has_next = S.next(ui + 1, nxt);
        if constexpr (Sched::GATHER) {
            if (has_next) S.aoff(nxt, RA, CA, na);
            else {
#pragma unroll
                for (int h = 0; h < 2; ++h)
#pragma unroll
                    for (int i = 0; i < 2; ++i) na[h][i] = ca[h][i];
            }
        }
        const char* nA = has_next ? nxt.A : cA; const char* nB = has_next ? nxt.B : cB;
#pragma nounroll
        for (int t = 0; t < nt; t += 2) {
            const bool last = (t == nt - 2);
            if constexpr (Sched::SEG > 0) { if (t == Sched::SEG) { int fr_ = fr, fq_ = fq; asm volatile("" : "+v"(fr_), "+v"(fq_)); E.mid(acc, cur, wr, wc, fr_, fq_); } }
            const size_t sA1 = (Sched::SEG && t + 1 >= Sched::SEG) ? S.dA : 0, sA2 = (Sched::SEG && t + 2 >= Sched::SEG) ? S.dA : 0, sB2 = (Sched::SEG && t + 2 >= Sched::SEG) ? S.dB : 0;
            const char* a1 = cA + (size_t)(t + 1) * kstep + sA1;
            const char* a2 = last ? nA : cA + (size_t)(t + 2) * kstep + sA2; const char* b2 = last ? nB : cB + (size_t)(t + 2) * kstep + sB2;
            const char* a3 = a2 + kstep; const char* b3 = b2 + kstep;
            unsigned o2[2][2];
#pragma unroll
            for (int h = 0; h < 2; ++h)
#pragma unroll
                for (int i = 0; i < 2; ++i) { if constexpr (Sched::GATHER) o2[h][i] = last ? na[h][i] : ca[h][i]; else o2[h][i] = ca[h][i]; }
            PG8_LDB(B0, 0, 0); PG8_LDB(B1, 0, 1); PG8_SCHED; PG8_LDA(At, 0, 0); PG8_STAGE(PG8_SA(1, 1), a1, ca[1]);
            PG8_WAIT_V(8); PG8_WAIT_L(0); PG8_BAR; PG8_MMA(0, 0, At, B0); PG8_MMA(0, 1, At, B1); PG8_BAR; PG8_SCHED;
            PG8_LDA(At, 0, 1); PG8_STAGE(PG8_SB(0, 0), b2, voffB); PG8_STAGE(PG8_SB(0, 1), b2 + hstep, voffB); PG8_STAGE(PG8_SA(0, 0), a2, o2[0]);
            PG8_WAIT_V(8); PG8_WAIT_L(0); PG8_BAR; PG8_MMA(1, 0, At, B0); PG8_MMA(1, 1, At, B1); PG8_BAR; PG8_SCHED;
            PG8_LDB(B0, 1, 0); PG8_LDB(B1, 1, 1); PG8_SCHED; PG8_LDA(At, 1, 0); PG8_STAGE(PG8_SA(0, 1), a2, o2[1]);
            PG8_WAIT_V(8); PG8_WAIT_L(0); PG8_BAR; PG8_MMA(0, 0, At, B0); PG8_MMA(0, 1, At, B1); PG8_BAR; PG8_SCHED;
            PG8_LDA(At, 1, 1); PG8_STAGE(PG8_SB(1, 0), b3, voffB); PG8_STAGE(PG8_SB(1, 1), b3 + hstep, voffB); PG8_STAGE(PG8_SA(1, 0), a3, o2[0]);
            PG8_WAIT_V(8); PG8_WAIT_L(0); PG8_BAR; PG8_MMA(1, 0, At, B0); PG8_MMA(1, 1, At, B1); PG8_BAR; PG8_SCHED;
        }
        if constexpr (FP8) { asm volatile("s_nop 15\n\ts_nop 15\n\ts_nop 15" ::: "memory"); PG8_SCHED; }
        if (wr == 0) PG8_BAR;
        { int fr_ = fr, fq_ = fq; asm volatile("" : "+v"(fr_), "+v"(fq_));
          E(acc, cur, wr, wc, fr_, fq_, ui & 1);
          if (PROBE_PHASE == 50) E(acc, cur, wr, wc, fr_, fq_, ui & 1); }
        if (!has_next) break;
#pragma unroll
        for (int a = 0; a < 2; ++a)
#pragma unroll
            for (int b = 0; b < 2; ++b)
#pragma unroll
                for (int m = 0; m < 4; ++m)
#pragma unroll
                    for (int n = 0; n < 2; ++n) acc[a][b][m][n] = (f32x4){0.f, 0.f, 0.f, 0.f};
        cur = nxt; cA = nA; cB = nB; ++ui;
        E.prefetch(cur, ui & 1, wid, lane);
        if constexpr (Sched::GATHER) {
#pragma unroll
            for (int h = 0; h < 2; ++h)
#pragma unroll
                for (int i = 0; i < 2; ++i) ca[h][i] = na[h][i];
        }
        if (wr == 1) PG8_BAR;
    }
    PG8_WAIT_V(0);
    PG8_BAR;
#undef PG8_SA
#undef PG8_SB
#undef PG8_STAGE
#undef PG8_LDA
#undef PG8_LDB
#undef PG8_MMA
#undef PG8_WAIT_V
#undef PG8_WAIT_L
#undef PG8_BAR
#undef PG8_SCHED
}
}
#ifndef PROBE_PHASE
#define PROBE_PHASE (-1)
#endif
constexpr size_t SM_LIST = WS_SMALL + 2 * MiB;
constexpr size_t SM_WLIST = WS_SMALL + 6 * MiB;
constexpr size_t SM_RLIST = WS_SMALL + 10 * MiB;
constexpr int MT_PSTART = 256;
constexpr int MT_CNT = 512;
constexpr int MT_NACT = 768;
constexpr int MT_ATILE = 1024;
constexpr int MT_HIST = 4096;
constexpr int MT_BASE = 4224;
constexpr int MT_REC = 4352;
constexpr int MT_RSTD = 10496;
constexpr int MT_EPI = 11264;
constexpr int MT_EPI2 = 13312;
constexpr int MT_GAIN = 15360;
constexpr int MT_XCH = 16384;

__device__ __forceinline__ void moe_tables(LAS unsigned char* misc, const unsigned* cnt) {
    LAS int* pstart = (LAS int*)(misc + MT_PSTART); LAS int* cl = (LAS int*)(misc + MT_CNT); LAS int* at = (LAS int*)(misc + MT_ATILE);
    __syncthreads();
    if (threadIdx.x < 64) {
        const int lane = threadIdx.x, e = lane & 31;
        const int c = (int)__hip_atomic_load(cnt + e, __ATOMIC_RELAXED, __HIP_MEMORY_SCOPE_AGENT), nt = (c + 255) >> 8;
        int incl = nt;
#pragma unroll
        for (int o = 1; o < 32; o <<= 1) { const int v = __shfl_up(incl, o); if (e >= o) incl += v; }
        const int t0 = incl - nt;
        if (lane < 32) { cl[e] = c; pstart[e] = t0 << 8; for (int t = 0; t < nt; ++t) at[t0 + t] = (t0 + t) | (e << 12) | (t << 20);
            if (e == 31) { pstart[NE] = incl << 8; *(LAS int*)(misc + MT_NACT) = incl; } }
    }
    __syncthreads();
}

__device__ __forceinline__ void route_images(LAS unsigned char* lds, const float* __restrict__ g2, const float* __restrict__ wr) {
    const int tid = threadIdx.x;
    for (int idx = tid; idx < 128 * 32; idx += 512) {
        const int c = idx >> 5, e = idx & 31; float v[8]; unsigned hw[4], lw[4];
#pragma unroll
        for (int j = 0; j < 8; ++j) v[j] = wr[(size_t)(8 * c + j) * NE + e] * g2[8 * c + j];
#pragma unroll
        for (int j = 0; j < 4; ++j) { hw[j] = pk2(v[2 * j], v[2 * j + 1]); lw[j] = pk2(v[2 * j] - __uint_as_float(hw[j] << 16), v[2 * j + 1] - __uint_as_float(hw[j] & 0xffff0000u)); }
        *(LAS u32x4*)(lds + idx * 16) = (u32x4){hw[0], hw[1], hw[2], hw[3]};
        *(LAS u32x4*)(lds + 65536 + idx * 16) = (u32x4){lw[0], lw[1], lw[2], lw[3]};
    }
    __syncthreads();
}
__device__ __forceinline__ void route_phase(LAS unsigned char* lds, const bf16* __restrict__ h2, const float* __restrict__ g2, const float* __restrict__ wr, const float* __restrict__ br,
                                            unsigned char* __restrict__ xg8, int* __restrict__ tke, int* __restrict__ tkpos, float* __restrict__ tkw, int* __restrict__ list, float* __restrict__ wlist,
                                            float* __restrict__ rlist, unsigned* __restrict__ cnt, int G, int bx) {
    typedef float f32x16 __attribute__((ext_vector_type(16)));
    const int tid = threadIdx.x, lane = tid & 63, r32 = lane & 31, hi = lane >> 5; const int wave = __builtin_amdgcn_readfirstlane(tid >> 6);
    LAS unsigned char* misc = lds + MISC_OFF;
    LAS int* hist = (LAS int*)(misc + MT_HIST); LAS int* base = (LAS int*)(misc + MT_BASE); LAS int* rec = (LAS int*)(misc + MT_REC); LAS float* rstd_l = (LAS float*)(misc + MT_RSTD);
    const int tile = wave & 3, kh = wave >> 2;
    for (int tb = bx; tb < NTOK / 128; tb += G) {
        if (tid < 32) hist[tid] = 0;
        __syncthreads();
        {
        const int token = tb * 128 + tile * 32 + r32;
        const bf16* xp = h2 + (size_t)token * D + kh * 512 + 8 * hi;
        unsigned char* x8p = xg8 + (size_t)token * D + kh * 512 + 8 * hi;
        const float* gp = g2 + kh * 512 + 8 * hi;
        f32x16 c = {};
        float ss = 0.f;
        u32x4 xa[8];
#pragma unroll
        for (int p = 0; p < 8; ++p) xa[p] = *(const u32x4*)(xp + 16 * p);
#pragma unroll 1
        for (int ks0 = 0; ks0 < 32; ks0 += 8) {
#pragma unroll
            for (int p = 0; p < 8; ++p) {
                const int ks = ks0 + p;
                float xf[8]; unpack8(xa[p], xf); const f32x4 x0 = {xf[0], xf[1], xf[2], xf[3]}, x1 = {xf[4], xf[5], xf[6], xf[7]};
                const u32x4 xh = xa[p];
                if (ks + 8 < 32) xa[p] = *(const u32x4*)(xp + 16 * (ks + 8));
                ss += (x0[0] * x0[0] + x0[1] * x0[1]) + (x0[2] * x0[2] + x0[3] * x0[3]) + (x1[0] * x1[0] + x1[1] * x1[1]) + (x1[2] * x1[2] + x1[3] * x1[3]);
                { const f32x4 g0 = *(const f32x4*)(gp + 16 * ks), g1 = *(const f32x4*)(gp + 16 * ks + 4);
                  u32x2 w8; w8.x = pk4_fp8(x0[0] * g0[0], x0[1] * g0[1], x0[2] * g0[2], x0[3] * g0[3]); w8.y = pk4_fp8(x1[0] * g1[0], x1[1] * g1[1], x1[2] * g1[2], x1[3] * g1[3]);
                  *(u32x2*)(x8p + 16 * ks) = w8; }
                const int chunk = kh * 64 + 2 * ks + hi;
                const bf16x8 wh = *(const LAS bf16x8*)(lds + (chunk * 32 + r32) * 16), wl = *(const LAS bf16x8*)(lds + 65536 + (chunk * 32 + r32) * 16);
                c = __builtin_amdgcn_mfma_f32_32x32x16_bf16(wh, __builtin_bit_cast(bf16x8, xh), c, 0, 0, 0);
                c = __builtin_amdgcn_mfma_f32_32x32x16_bf16(wl, __builtin_bit_cast(bf16x8, xh), c, 0, 0, 0);
            }
        }
        LAS float* px = (LAS float*)(misc + MT_XCH);
        LAS float* sx = (LAS float*)(misc + MT_REC + tile * 1536);
        if (kh == 1) {
#pragma unroll
            for (int r = 0; r < 16; ++r) px[(tile * 16 + r) * 64 + lane] = c[r];
            sx[lane] = ss;
        }
        __syncthreads();
        if (kh == 0) {
#pragma unroll
            for (int r = 0; r < 16; ++r) c[r] += px[(tile * 16 + r) * 64 + lane];
            ss += sx[lane];
            ss += __shfl_xor(ss, 32);
            const float rstd = rsqrtf(ss * (1.0f / D) + EPS);
            float vals[16];
#pragma unroll
            for (int r = 0; r < 16; ++r) vals[r] = c[r] * rstd + br[(r & 3) + 8 * (r >> 2) + 4 * hi];
            float tv[4]; int te[4];
#pragma unroll
            for (int k = 0; k < 4; ++k) {
                float m = -3.0e38f; int mi = 0;
#pragma unroll
                for (int r = 0; r < 16; ++r) { const bool gt = vals[r] > m; m = gt ? vals[r] : m; mi = gt ? r : mi; }
                tv[k] = m; te[k] = (mi & 3) + 8 * (mi >> 2) + 4 * hi;
#pragma unroll
                for (int r = 0; r < 16; ++r) vals[r] = (r == mi) ? -3.0e38f : vals[r];
            }
            float cv[8]; int ce[8];
#pragma unroll
            for (int k = 0; k < 4; ++k) { cv[k] = tv[k]; ce[k] = te[k]; cv[4 + k] = __shfl_xor(tv[k], 32); ce[4 + k] = __shfl_xor(te[k], 32); }
            float fv[4]; int fe[4];
#pragma unroll
            for (int k = 0; k < 4; ++k) {
                float m = -3.0e38f; int me = 64; int mi = 0;
#pragma unroll
                for (int q = 0; q < 8; ++q) { const bool better = (cv[q] > m) || (cv[q] == m && ce[q] < me); m = better ? cv[q] : m; me = better ? ce[q] : me; mi = better ? q : mi; }
                fv[k] = m; fe[k] = me;
#pragma unroll
                for (int q = 0; q < 8; ++q) cv[q] = (q == mi) ? -3.0e38f : cv[q];
            }
            if (hi == 0) {
                const float e0 = 1.0f, e1 = __expf(fv[1] - fv[0]), e2 = __expf(fv[2] - fv[0]), e3 = __expf(fv[3] - fv[0]);
                const float inv = 1.0f / (e0 + e1 + e2 + e3);
                const float wts[4] = {e0 * inv, e1 * inv, e2 * inv, e3 * inv};
                const int tl = tile * 32 + r32;
                rstd_l[tl] = rstd;
#pragma unroll
                for (int k = 0; k < 4; ++k) {
                    const int lp = __hip_atomic_fetch_add(hist + fe[k], 1, __ATOMIC_RELAXED, __HIP_MEMORY_SCOPE_WORKGROUP);
                    LAS int* r = rec + (tl * 4 + k) * 3; r[0] = fe[k]; r[1] = lp; r[2] = __float_as_int(wts[k]);
                }
            }
        }
        }
        __syncthreads();
        if (tid < 32) base[tid] = (int)atomicAdd(&cnt[tid], (unsigned)hist[tid]);
        __syncthreads();
        { const int tl = tid >> 2; const int tok = tb * 128 + tl; LAS int* r = rec + tid * 3; const int e = r[0], pos = base[e] + r[1]; const float w = __int_as_float(r[2]);
          tke[tok * 4 + (tid & 3)] = e; tkpos[tok * 4 + (tid & 3)] = pos; tkw[tok * 4 + (tid & 3)] = w;
          list[e * NTOK + pos] = tok; wlist[e * NTOK + pos] = w; rlist[e * NTOK + pos] = rstd_l[tl]; }
        __syncthreads();
    }
}

__device__ __forceinline__ void combine_phase(LAS unsigned char* misc, const bf16* __restrict__ h2b, float* __restrict__ out, const unsigned char* __restrict__ rows, const int* __restrict__ tke, const int* __restrict__ tkpos, int gw, int NGW, int lane, float oscale, int tok_lo = 0, int tok_hi = NTOK) {
    LAS const int* pstart = (LAS const int*)(misc + MT_PSTART);
    for (int tok0 = tok_lo + gw; tok0 < tok_hi; tok0 += 2 * NGW) {
        u32x2 hw[2][4]; unsigned rw[2][4][4];
#pragma unroll
        for (int q = 0; q < 2; ++q) { const int token = tok0 + q * NGW; if (token < tok_hi) {
            const u32x2* hp = (const u32x2*)(h2b + (size_t)token * D) + lane;
#pragma unroll
            for (int j = 0; j < 4; ++j) hw[q][j] = __builtin_nontemporal_load(hp + 64 * j);
#pragma unroll
            for (int k = 0; k < 4; ++k) { const int rr = pstart[tke[token * 4 + k]] + tkpos[token * 4 + k]; const unsigned* rp = (const unsigned*)(rows + (size_t)rr * D) + lane;
#pragma unroll
                for (int j = 0; j < 4; ++j) rw[q][k][j] = __builtin_nontemporal_load(rp + 64 * j); } } }
#pragma unroll
        for (int q = 0; q < 2; ++q) { const int token = tok0 + q * NGW; if (token < tok_hi) {
            f32x4* o = (f32x4*)(out + (size_t)token * D) + lane;
#pragma unroll
            for (int j = 0; j < 4; ++j) {
                f32x4 s = {0.f, 0.f, 0.f, 0.f};
#pragma unroll
                for (int k = 0; k < 4; ++k) { const f32x2 lo = __builtin_amdgcn_cvt_pk_f32_fp8((int)rw[q][k][j], false), hh = __builtin_amdgcn_cvt_pk_f32_fp8((int)rw[q][k][j], true); s[0] += lo[0]; s[1] += lo[1]; s[2] += hh[0]; s[3] += hh[1]; }
                const f32x4 v = {__uint_as_float(hw[q][j].x << 16), __uint_as_float(hw[q][j].x & 0xffff0000u), __uint_as_float(hw[q][j].y << 16), __uint_as_float(hw[q][j].y & 0xffff0000u)};
                __builtin_nontemporal_store((v + s * ROW8_INV) * oscale, o + 64 * j);
            } } }
    }
}
struct SchedDense {
    static constexpr bool GATHER = false; static constexpr int SEG = 0; size_t dA = 0, dB = 0; int rev = 0;
    const char* A; const char* Bt; int K, nM, nN, nwg, G, c;
    __device__ void init(const bf16* A_, const bf16* Bt_, int M, int N, int K_, int G_, int c_) { A = (const char*)A_; Bt = (const char*)Bt_; K = K_; nM = M / 256; nN = N / 256; nwg = nM * nN; G = G_; c = c_; }
    __device__ __forceinline__ bool next(int i, pg8::Unit& u) const {
        const long L = (long)i * G + c; if (L >= nwg) return false;
        int wgid = (int)L; { const int q = nwg / 8, r = nwg % 8, xcd = wgid % 8, off = wgid / 8; wgid = (xcd < r ? xcd * (q + 1) : r * (q + 1) + (xcd - r) * q) + off; }
        const int nig = 8 * nN, gid = wgid / nig, fm = gid * 8, gsz = (nM - fm) < 8 ? (nM - fm) : 8;
        u.pm = fm + ((wgid % nig) % gsz); u.pn = (wgid % nig) / gsz; if (rev) u.pn = nN - 1 - u.pn; u.aux = 0; u.tl = 0;
        u.A = A + (size_t)u.pm * 256 * K * 2; u.B = Bt + (size_t)u.pn * 256 * K * 2; return true;
    }
    __device__ __forceinline__ void aoff(const pg8::Unit&, const int (&R)[2], const int (&C)[2], unsigned (&o)[2][2]) const {
#pragma unroll
        for (int h = 0; h < 2; ++h)
#pragma unroll
            for (int i = 0; i < 2; ++i) o[h][i] = (unsigned)((128 * h + R[i]) * K + C[i]) * 2u;
    }
};
struct SchedDense8 : SchedDense {
    __device__ __forceinline__ bool next(int i, pg8::Unit& u) const {
        if (!SchedDense::next(i, u)) return false;
        u.A = A + (size_t)u.pm * 256 * K; u.B = Bt + (size_t)u.pn * 256 * K; return true;
    }
    __device__ __forceinline__ void aoff(const pg8::Unit&, const int (&R)[2], const int (&C)[2], unsigned (&o)[2][2]) const {
#pragma unroll
        for (int h = 0; h < 2; ++h)
#pragma unroll
            for (int i = 0; i < 2; ++i) o[h][i] = (unsigned)((128 * h + R[i]) * K + C[i] * 2);
    }
};
struct SchedBranch2 : SchedDense { static constexpr int SEG = 16; };
template <bool GATHER_, int NPN>
struct SchedMoe {
    static constexpr bool GATHER = GATHER_; static constexpr int SEG = 0; static constexpr size_t dA = 0, dB = 0;
    const char* A; const char* Bt; LAS const unsigned char* misc; const int* list; int G, c;
    __device__ __forceinline__ bool next(int i, pg8::Unit& u) const {
        LAS const int* cl = (LAS const int*)(misc + MT_CNT); LAS const int* ps = (LAS const int*)(misc + MT_PSTART);
        if ((G & 7) == 0) {
            const int x = c & 7, r = c >> 3, n = G >> 3;
            int k = (i * n + r) / NPN; const int pn = (i * n + r) % NPN;
#pragma unroll
            for (int j = 0; j < 4; ++j) { const int e = x + 8 * j, nt = (cl[e] + 255) >> 8;
                if (k < nt) { u.pn = pn; u.aux = e; u.tl = k; u.pm = (ps[e] >> 8) + k;
                    u.A = GATHER ? A : A + (size_t)u.pm * 256 * 1024; u.B = Bt + ((size_t)e * NPN + pn) * 256 * 1024; return true; }
                k -= nt; }
            return false;
        }
        const int nact = *(LAS const int*)(misc + MT_NACT);
        const int L = i * G + c; if (L >= nact * NPN) return false;
        const int k = L / NPN; u.pn = L % NPN; const int w = ((LAS const int*)(misc + MT_ATILE))[k];
        u.pm = w & 0xfff; u.aux = (w >> 12) & 0xff; u.tl = w >> 20;
        u.A = GATHER ? A : A + (size_t)u.pm * 256 * 1024;
        u.B = Bt + ((size_t)u.aux * NPN + u.pn) * 256 * 1024; return true;
    }
    __device__ __forceinline__ void aoff(const pg8::Unit& u, const int (&R)[2], const int (&C)[2], unsigned (&o)[2][2]) const {
        const int ce = ((LAS const int*)(misc + MT_CNT))[u.aux];
#pragma unroll
        for (int h = 0; h < 2; ++h)
#pragma unroll
            for (int i = 0; i < 2; ++i) {
                if (GATHER) { const int idx = u.tl * 256 + 128 * h + R[i]; const int tok = (idx < ce) ? list[u.aux * NTOK + idx] : 0; o[h][i] = (unsigned)tok * 1024u + (unsigned)C[i] * 2u; }
                else o[h][i] = (unsigned)((128 * h + R[i]) * 1024 + C[i] * 2);
            }
    }
};

template <int PN0, bool F8>
struct EpiProjT {
    static constexpr bool PERM = true;
    __device__ __forceinline__ void prefetch(const pg8::Unit&, int, int, int) const {}
    bf16* proj; LAS const float* gtab;
    __device__ __forceinline__ void operator()(pg8::Acc& acc, const pg8::Unit& u, int wr, int wc, int fr, int fq, int slot) const {
        const int pn = u.pn + PN0;
        int mode;
        if (pn < 4) mode = 1; else if (pn == 4) mode = (wc < 2) ? 2 : 0; else if (pn < 7) mode = 0; else if (pn < 9) mode = 3; else if (pn < 13) mode = 0; else if (pn < 17) mode = 4; else mode = 5;
        float gn[2][8];
        if (mode == 1 || mode == 2) { LAS const float* g = gtab + ((mode == 1) ? 0 : 64);
#pragma unroll
            for (int bj = 0; bj < 2; ++bj)
#pragma unroll
                for (int j = 0; j < 8; ++j) gn[bj][j] = g[32 * bj + 8 * fq + j]; }
#pragma unroll
        for (int ai = 0; ai < 2; ++ai)
#pragma unroll
            for (int m = 0; m < 4; ++m) {
                const int r = u.pm * 256 + ai * 128 + wr * 64 + m * 16 + fr;
                bf16* rowp = proj + (size_t)r * INW + pn * 256 + wc * 64 + 8 * fq;
                f32x4 v[2][2];
#pragma unroll
                for (int bj = 0; bj < 2; ++bj) { v[bj][0] = acc[ai][bj][m][0]; v[bj][1] = acc[ai][bj][m][1]; if constexpr (F8) { v[bj][0] = v[bj][0] * (XB8_INV * W8_INV); v[bj][1] = v[bj][1] * (XB8_INV * W8_INV); } }
                if (mode == 1 || mode == 2) {
                    float ss = 0.f;
#pragma unroll
                    for (int bj = 0; bj < 2; ++bj)
#pragma unroll
                        for (int n = 0; n < 2; ++n) ss += v[bj][n][0] * v[bj][n][0] + v[bj][n][1] * v[bj][n][1] + v[bj][n][2] * v[bj][n][2] + v[bj][n][3] * v[bj][n][3];
                    ss += __shfl_xor(ss, 16); ss += __shfl_xor(ss, 32);
                    const float rs = rsqrtf(ss * (1.0f / 64.0f) + EPS);
#pragma unroll
                    for (int bj = 0; bj < 2; ++bj)
#pragma unroll
                        for (int n = 0; n < 2; ++n)
#pragma unroll
                            for (int i = 0; i < 4; ++i) v[bj][n][i] = v[bj][n][i] * rs * gn[bj][4 * n + i];
                } else if (mode == 3) {
#pragma unroll
                    for (int bj = 0; bj < 2; ++bj)
#pragma unroll
                        for (int n = 0; n < 2; ++n) v[bj][n] = v[bj][n] * 0.08838834764831845f;
                } else if (mode == 4) {
#pragma unroll
                    for (int bj = 0; bj < 2; ++bj)
#pragma unroll
                        for (int n = 0; n < 2; ++n)
#pragma unroll
                            for (int i = 0; i < 4; ++i) { const float x = v[bj][n][i]; v[bj][n][i] = x * sigmoidf_(x); }
                } else if (mode == 5) {
#pragma unroll
                    for (int bj = 0; bj < 2; ++bj)
#pragma unroll
                        for (int n = 0; n < 2; ++n)
#pragma unroll
                            for (int i = 0; i < 4; ++i) v[bj][n][i] = sigmoidf_(v[bj][n][i]);
                }
#pragma unroll
                for (int bj = 0; bj < 2; ++bj) *(u32x4*)(rowp + 32 * bj) = pack8(v[bj][0], v[bj][1]);
            }
    }
};
struct EpiBranch2 {
    static constexpr bool PERM = true;
    __device__ __forceinline__ void prefetch(const pg8::Unit&, int, int, int) const {}
    bf16* merged; const bf16* proj;
    __device__ __forceinline__ void mid(pg8::Acc& acc, const pg8::Unit& u, int wr, int wc, int fr, int fq) const {
#pragma unroll
        for (int ai = 0; ai < 2; ++ai)
#pragma unroll
            for (int mp = 0; mp < 2; ++mp) {
                u32x4 ga[2][2], gr[2][2];
#pragma unroll
                for (int mm = 0; mm < 2; ++mm)
#pragma unroll
                    for (int bj = 0; bj < 2; ++bj) {
                        const bf16* gp = proj + (size_t)(u.pm * 256 + ai * 128 + wr * 64 + (2 * mp + mm) * 16 + fr) * INW + u.pn * 256 + bj * 128 + wc * 32 + 8 * fq;
                        ga[mm][bj] = *(const u32x4*)(gp + C_GA); gr[mm][bj] = *(const u32x4*)(gp + C_GR);
                    }
#pragma unroll
                for (int mm = 0; mm < 2; ++mm)
#pragma unroll
                    for (int bj = 0; bj < 2; ++bj) {
                        const int m = 2 * mp + mm; float a[8], r[8]; unpack8(ga[mm][bj], a); unpack8(gr[mm][bj], r);
#pragma unroll
                        for (int i = 0; i < 4; ++i) { acc[ai][bj][m][0][i] *= a[i] * __builtin_amdgcn_rcpf(fmaxf(r[i], 1e-20f)); acc[ai][bj][m][1][i] *= a[4 + i] * __builtin_amdgcn_rcpf(fmaxf(r[4 + i], 1e-20f)); }
                    }
            }
    }
    __device__ __forceinline__ void operator()(pg8::Acc& acc, const pg8::Unit& u, int wr, int wc, int fr, int fq, int slot) const {
#pragma unroll
        for (int ai = 0; ai < 2; ++ai)
#pragma unroll
            for (int mp = 0; mp < 2; ++mp) {
                u32x4 gr[2][2];
#pragma unroll
                for (int mm = 0; mm < 2; ++mm)
#pragma unroll
                    for (int bj = 0; bj < 2; ++bj)
                        gr[mm][bj] = *(const u32x4*)(proj + (size_t)(u.pm * 256 + ai * 128 + wr * 64 + (2 * mp + mm) * 16 + fr) * INW + C_GR + u.pn * 256 + bj * 128 + wc * 32 + 8 * fq);
#pragma unroll
                for (int mm = 0; mm < 2; ++mm)
#pragma unroll
                    for (int bj = 0; bj < 2; ++bj) {
                        const int m = 2 * mp + mm; float r[8]; unpack8(gr[mm][bj], r);
                        f32x4 a = acc[ai][bj][m][0], b = acc[ai][bj][m][1];
                        a[0] *= r[0]; a[1] *= r[1]; a[2] *= r[2]; a[3] *= r[3]; b[0] *= r[4]; b[1] *= r[5]; b[2] *= r[6]; b[3] *= r[7];
                        *(u32x4*)(merged + (size_t)(u.pm * 256 + ai * 128 + wr * 64 + m * 16 + fr) * D + u.pn * 256 + bj * 128 + wc * 32 + 8 * fq) = pack8(a, b);
                    }
            }
    }
};
struct EpiOut {
    static constexpr bool PERM = true;
    __device__ __forceinline__ void prefetch(const pg8::Unit&, int, int, int) const {}
    const float* x; bf16* h2b;
    __device__ __forceinline__ void load(f32x4 (&xv)[2][2][2], const pg8::Unit& u, int q, int wr, int wc, int fr, int fq) const {
#pragma unroll
        for (int mm = 0; mm < 2; ++mm) { const size_t off = (size_t)(u.pm * 256 + (q >> 1) * 128 + wr * 64 + (2 * (q & 1) + mm) * 16 + fr) * D + u.pn * 256 + wc * 32 + 8 * fq;
#pragma unroll
            for (int bj = 0; bj < 2; ++bj)
#pragma unroll
                for (int n = 0; n < 2; ++n) xv[mm][bj][n] = *(const f32x4*)(x + off + bj * 128 + n * 4); }
    }
    __device__ __forceinline__ void operator()(pg8::Acc& acc, const pg8::Unit& u, int wr, int wc, int fr, int fq, int slot) const {
        f32x4 xA[2][2][2], xB[2][2][2];
        load(xA, u, 0, wr, wc, fr, fq);
#pragma unroll
        for (int q = 0; q < 4; ++q) {
            if (q < 3) { if (q & 1) load(xA, u, q + 1, wr, wc, fr, fq); else load(xB, u, q + 1, wr, wc, fr, fq); }
            const int ai = q >> 1;
#pragma unroll
            for (int mm = 0; mm < 2; ++mm) { const int m = 2 * (q & 1) + mm; const size_t off = (size_t)(u.pm * 256 + ai * 128 + wr * 64 + m * 16 + fr) * D + u.pn * 256 + wc * 32 + 8 * fq;
#pragma unroll
                for (int bj = 0; bj < 2; ++bj) {
                    const f32x4 a = ((q & 1) ? xB[mm][bj][0] : xA[mm][bj][0]) + acc[ai][bj][m][0], b = ((q & 1) ? xB[mm][bj][1] : xA[mm][bj][1]) + acc[ai][bj][m][1];
                    *(u32x4*)(h2b + off + bj * 128) = pack8(a, b); } }
        }
    }
};
struct EpiGU {
    static constexpr bool PERM = true;
    unsigned char* act; const float* bgu; const float* rlist; LAS unsigned char* misc;
    __device__ __forceinline__ void prefetch(const pg8::Unit& u, int slot, int wid, int lane) const {
        if (wid < 4) __builtin_amdgcn_global_load_lds((const unsigned*)(rlist + (size_t)u.aux * NTOK + u.tl * 256 + wid * 64 + lane), (LAS unsigned*)(misc + MT_EPI + slot * 1024 + wid * 256), 4, 0, 0);
        else __builtin_amdgcn_global_load_lds((const unsigned*)(bgu + (size_t)u.aux * 2048 + ((wid - 4) >> 1) * 1024 + u.pn * 128 + ((wid - 4) & 1) * 64 + lane), (LAS unsigned*)(misc + MT_EPI2 + slot * 1024 + (wid - 4) * 256), 4, 0, 0);
    }
    __device__ __forceinline__ void operator()(pg8::Acc& acc, const pg8::Unit& u, int wr, int wc, int fr, int fq, int slot) const {
        const int ce = ((LAS const int*)(misc + MT_CNT))[u.aux];
        const int col = u.pn * 128 + wc * 32 + 8 * fq;
        LAS const float* bl = (LAS const float*)(misc + MT_EPI2 + slot * 1024) + wc * 32 + 8 * fq;
        float bgate[8], bup[8];
#pragma unroll
        for (int j = 0; j < 8; ++j) { bgate[j] = bl[j]; bup[j] = bl[128 + j]; }
#pragma unroll
        for (int ai = 0; ai < 2; ++ai)
#pragma unroll
            for (int m = 0; m < 4; ++m) {
                const int lr = ai * 128 + wr * 64 + m * 16 + fr, r = u.pm * 256 + lr;
                const float rs = ((LAS const float*)(misc + MT_EPI + slot * 1024))[lr] * W8_INV;
                float o[8];
#pragma unroll
                for (int n = 0; n < 2; ++n)
#pragma unroll
                    for (int i = 0; i < 4; ++i) {
                        float gate = acc[ai][0][m][n][i] * rs + bgate[4 * n + i], up = acc[ai][1][m][n][i] * rs + bup[4 * n + i];
                        gate = fminf(gate, 7.0f); up = fminf(fmaxf(up, -7.0f), 7.0f);
                        o[4 * n + i] = (up + 1.0f) * gate * sigmoidf_(1.702f * gate);
                    }
                u32x2 w; w.x = pk4_fp8(o[0], o[1], o[2], o[3]); w.y = pk4_fp8(o[4], o[5], o[6], o[7]);
                *(u32x2*)(act + (size_t)r * DFF + col) = w;
            }
    }
};
struct EpiDown {
    static constexpr bool PERM = true;
    unsigned char* rows; const float* bdn; const float* wlist; LAS const unsigned char* misc;
    __device__ __forceinline__ void prefetch(const pg8::Unit& u, int slot, int wid, int lane) const {
        if (wid < 4) __builtin_amdgcn_global_load_lds((const unsigned*)(wlist + (size_t)u.aux * NTOK + u.tl * 256 + wid * 64 + lane), (LAS unsigned*)(misc + MT_EPI + slot * 1024 + wid * 256), 4, 0, 0);
        else __builtin_amdgcn_global_load_lds((const unsigned*)(bdn + (size_t)u.aux * D + u.pn * 256 + (wid - 4) * 64 + lane), (LAS unsigned*)(misc + MT_EPI2 + slot * 1024 + (wid - 4) * 256), 4, 0, 0);
    }
    __device__ __forceinline__ void operator()(pg8::Acc& acc, const pg8::Unit& u, int wr, int wc, int fr, int fq, int slot) const {
        const int ce = ((LAS const int*)(misc + MT_CNT))[u.aux];
#pragma unroll
        for (int ai = 0; ai < 2; ++ai)
#pragma unroll
            for (int m = 0; m < 4; ++m) {
                const int lr = ai * 128 + wr * 64 + m * 16 + fr, r = u.pm * 256 + lr, idx = u.tl * 256 + lr;
                const float w = (idx < ce) ? ((LAS const float*)(misc + MT_EPI + slot * 1024))[lr] * ROW8_SCALE : 0.f;
                LAS const float* bl = (LAS const float*)(misc + MT_EPI2 + slot * 1024) + wc * 32 + 8 * fq;
                asm volatile("" : "+v"(bl));
#pragma unroll
                for (int bj = 0; bj < 2; ++bj) {
                    const f32x4 b0 = *(const LAS f32x4*)(bl + bj * 128), b1 = *(const LAS f32x4*)(bl + bj * 128 + 4);
                    f32x4 a = acc[ai][bj][m][0], b = acc[ai][bj][m][1];
#pragma unroll
                    for (int i = 0; i < 4; ++i) { a[i] = (a[i] * W8_INV + b0[i]) * w; b[i] = (b[i] * W8_INV + b1[i]) * w; }
                    u32x2 o; o.x = pk4_fp8(a[0], a[1], a[2], a[3]); o.y = pk4_fp8(b[0], b[1], b[2], b[3]);
                    *(u32x2*)(rows + (size_t)r * D + u.pn * 256 + bj * 128 + wc * 32 + 8 * fq) = o;
                }
            }
    }
};
namespace attn {
typedef float f32x16 __attribute__((ext_vector_type(16)));
typedef short s16x4 __attribute__((ext_vector_type(4)));
constexpr int NK = 272, KST = NK * 16 + 32, VST = NK * 64 + 128, K_OFF = 0, V_OFF = 8 * KST, WS_OFF = V_OFF + 2 * VST, OST_OFF = WS_OFF + 2048, LDS_END = OST_OFF + 8 * 4096;
constexpr float LOG2E = 1.4426950408889634f;
__device__ __forceinline__ s16x4 vtr(LAS const unsigned char* p) { return __builtin_bit_cast(s16x4, __builtin_amdgcn_ds_read_tr16_b64_v4i16((LAS s16x4*)p)); }
__device__ __forceinline__ int crowc(int r) { return (r & 3) + 8 * (r >> 2); }

template <int TYPE, bool DIAG>
__device__ __forceinline__ void tile(LAS const unsigned char* lds, int kbase, const bf16x8 (&qr)[4], f32x16 (&o)[2], float& l, float lanebase, float c1, int tt, int lane) {
    const int r32 = lane & 31, hi = lane >> 5;
    f32x16 p;
#pragma unroll
    for (int r = 0; r < 16; ++r) p[r] = __builtin_fmaf(c1, (float)crowc(r), lanebase);
#pragma unroll
    for (int d0 = 0; d0 < 4; ++d0) {
        const bf16x8 kf = *(const LAS bf16x8*)(lds + K_OFF + (2 * d0 + hi) * KST + (kbase + r32) * 16);
        p = __builtin_amdgcn_mfma_f32_32x32x16_bf16(kf, qr[d0], p, 0, 0, 0);
    }
    constexpr int NR = (TYPE == 0) ? 8 : 16;
    float e[16];
#pragma unroll
    for (int r = 0; r < NR; ++r) {
        float v = __builtin_amdgcn_exp2f(p[r]);
        if (DIAG) { const bool ok = (TYPE == 1) ? (crowc(r) > tt) : (crowc(r) <= tt); v = ok ? v : 0.f; }
        e[r] = v; l += v;
    }
    constexpr int NS = (TYPE == 0) ? 1 : 2;
    u32x4 pw[2];
#pragma unroll
    for (int s = 0; s < NS; ++s) { pw[s].x = pk2(e[8 * s + 0], e[8 * s + 1]); pw[s].y = pk2(e[8 * s + 2], e[8 * s + 3]); pw[s].z = pk2(e[8 * s + 4], e[8 * s + 5]); pw[s].w = pk2(e[8 * s + 6], e[8 * s + 7]); }
    LAS const unsigned char* vb = lds + V_OFF + (kbase + 4 * hi + ((lane & 15) >> 2)) * 64 + ((lane >> 4) & 1) * 32 + (lane & 3) * 8;
#pragma unroll
    for (int d0 = 0; d0 < 2; ++d0)
#pragma unroll
        for (int s = 0; s < NS; ++s) {
            const s16x4 lo = vtr(vb + d0 * VST + s * 1024), hh = vtr(vb + d0 * VST + s * 1024 + 512);
            const bf16x8 vf = (bf16x8){lo[0], lo[1], lo[2], lo[3], hh[0], hh[1], hh[2], hh[3]};
            o[d0] = __builtin_amdgcn_mfma_f32_32x32x16_bf16(__builtin_bit_cast(bf16x8, pw[s]), vf, o[d0], 0, 0, 0);
        }
}

#define AT_ISSUE(u_) do { const int u__ = (u_); const int b_ = u__ >> 6, qb_ = (u__ >> 1) & 31, kvh_ = u__ & 1; \
        _Pragma("unroll") for (int i = 0; i < 5; ++i) { const int idx = tid + 512 * i; if (idx < NK * 8) { const int key = idx >> 3, c = idx & 7; const bf16* rowp; \
            if (key < 16) rowp = pmeta + (size_t)key * INW; else { int j = qb_ * 128 - 128 + (key - 16); if (j < 0) j = 0; rowp = proj + ((size_t)b_ * SEQ + j) * INW; } \
            pk[i] = *(const u32x4*)(rowp + C_AK + kvh_ * 64 + c * 8); pv[i] = *(const u32x4*)(rowp + C_AV + kvh_ * 64 + c * 8); } } } while (0)
#define AT_QLOAD(dst, a_) do { const size_t qrow_ = (size_t)b * SEQ + qb * 128 + 32 * (a_) + r32; \
        _Pragma("unroll") for (int d0 = 0; d0 < 4; ++d0) dst[d0] = *(const bf16x8*)(proj + qrow_ * INW + C_AQ + h * 64 + d0 * 16 + hi * 8); } while (0)
__device__ __forceinline__ void phase(LAS unsigned char* lds, const bf16* __restrict__ proj, const bf16* __restrict__ pmeta, const float* __restrict__ sinks, float bshift, bf16* __restrict__ yatt, int first, int count, int stride) {
    const int tid = threadIdx.x, lane = tid & 63, r32 = lane & 31, hi = lane >> 5; const int wave = __builtin_amdgcn_readfirstlane(tid >> 6);
    if (count <= 0) return;
    u32x4 pk[5], pv[5];
    AT_ISSUE(first);
    for (int ui = 0; ui < count; ++ui) {
        const int u = first + ui * stride;
        const int b = u >> 6, qb = (u >> 1) & 31, kvh = u & 1;
#pragma unroll
        for (int i = 0; i < 5; ++i) { const int idx = tid + 512 * i; if (idx < NK * 8) { const int key = idx >> 3, c = idx & 7;
            *(LAS u32x4*)(lds + K_OFF + c * KST + key * 16) = pk[i];
            *(LAS u32x4*)(lds + V_OFF + (c >> 2) * VST + key * 64 + (c & 3) * 16) = pv[i]; } }
        if (ui + 1 < count) AT_ISSUE(u + stride);
        const int h = kvh * 8 + wave;
        bf16x8 qr[4], qn[4];
        AT_QLOAD(qr, 0);
        __syncthreads();
        const float slope = exp2f(-0.5f * (float)(h + 1)), sink = sinks[h];
        const float M = fmaxf(bshift, sink);
        const float c1 = slope * LOG2E;
        LAS float* wsf = (LAS float*)(lds + WS_OFF) + wave * 64;
        LAS bf16* stg = (LAS bf16*)(lds + OST_OFF) + wave * 2048;
#pragma unroll 1
        for (int a = 0; a < 4; ++a) {
            if (a < 3) AT_QLOAD(qn, a + 1);
            f32x16 o[2]; o[0] = f32x16{}; o[1] = f32x16{};
            float l = 0.f;
            const int t = 32 * a + r32;
            const int tt = r32 - 4 * hi;
            const float hi4 = c1 * 4.0f * (float)hi;
            tile<0, false>(lds, 0, qr, o, l, -(slope * (float)(qb * 128 + t + 16) + M) * LOG2E + hi4, c1, tt, lane);
            if (qb > 0) {
                tile<1, true>(lds, 16 + 32 * a, qr, o, l, -(slope * (float)(128 + r32) + M) * LOG2E + hi4, c1, tt, lane);
                for (int bb = a + 1; bb < 4; ++bb) tile<1, false>(lds, 16 + 32 * bb, qr, o, l, -(slope * (float)(128 + t - 32 * bb) + M) * LOG2E + hi4, c1, tt, lane);
            }
            for (int bb = 0; bb < a; ++bb) tile<2, false>(lds, 144 + 32 * bb, qr, o, l, -(slope * (float)(t - 32 * bb) + M) * LOG2E + hi4, c1, tt, lane);
            tile<2, true>(lds, 144 + 32 * a, qr, o, l, -(slope * (float)r32 + M) * LOG2E + hi4, c1, tt, lane);
            l += __shfl_xor(l, 32);
            l += exp2f((sink - M) * LOG2E);
            if (hi == 0) wsf[r32] = l;
            LDS_WAIT();
            float rli[16];
#pragma unroll
            for (int r = 0; r < 16; ++r) rli[r] = __builtin_amdgcn_rcpf(wsf[crowc(r) + 4 * hi]);
#pragma unroll
            for (int r = 0; r < 16; ++r) { const int orow = crowc(r) + 4 * hi;
#pragma unroll
                for (int d0 = 0; d0 < 2; ++d0) stg[orow * 64 + d0 * 32 + r32] = f2bf(o[d0][r] * rli[r]); }
            LDS_WAIT();
            bf16* Ow = yatt + ((size_t)b * SEQ + qb * 128 + 32 * a) * D + h * 64;
#pragma unroll
            for (int i = 0; i < 4; ++i) { const int row = i * 8 + (lane >> 3), ch = lane & 7; const u32x4 v = *(const LAS u32x4*)(stg + row * 64 + ch * 8); *(u32x4*)(Ow + (size_t)row * D + ch * 8) = v; }
            LDS_WAIT();
#pragma unroll
            for (int d0 = 0; d0 < 4; ++d0) qr[d0] = qn[d0];
        }
        __syncthreads();
    }
}
#undef AT_ISSUE
#undef AT_QLOAD
}
namespace ret {
typedef float f32x16 __attribute__((ext_vector_type(16)));
typedef short s16x4 __attribute__((ext_vector_type(4)));
constexpr size_t WS_STATES = 893 * MiB;
__device__ __forceinline__ s16x4 vtr(LAS const unsigned char* p) { return __builtin_bit_cast(s16x4, __builtin_amdgcn_ds_read_tr16_b64_v4i16((LAS s16x4*)p)); }
__device__ __forceinline__ int crowc(int r) { return (r & 3) + 8 * (r >> 2); }
__device__ __forceinline__ float lg2gamma(int h) { return log2f(1.0f - exp2f(-5.0f - (float)h)); }

constexpr int R1_BUF = 40960;
#define RET_ISSUE(KR, VR, c_) do { const int ci__ = (c_); \
        _Pragma("unroll") for (int i = 0; i < 4; ++i) { const int idx = tid + 512 * i, key = idx >> 4, ch = idx & 15; \
            if (ci__ == 0) { KR[i] = (key >= 112) ? *(const u32x4*)(pmeta + (size_t)(key - 112) * INW + C_RK + h * 128 + ch * 8) : (u32x4){0u, 0u, 0u, 0u}; } \
            else KR[i] = *(const u32x4*)(proj + ((size_t)b * SEQ + (ci__ - 1) * 128 + key) * INW + C_RK + h * 128 + ch * 8); } \
        { const int key = tid >> 2, ch = tid & 3; \
          if (ci__ == 0) VR = (key >= 112) ? *(const u32x4*)(pmeta + (size_t)(key - 112) * INW + C_RV + h * 256 + dvs * 32 + ch * 8) : (u32x4){0u, 0u, 0u, 0u}; \
          else VR = *(const u32x4*)(proj + ((size_t)b * SEQ + (ci__ - 1) * 128 + key) * INW + C_RV + h * 256 + dvs * 32 + ch * 8); } } while (0)
#define RET_STEP(KR, VR, c_) do { const int c__ = (c_); LAS unsigned char* buf = lds + (c__ & 1) * R1_BUF; \
        _Pragma("unroll") for (int i = 0; i < 4; ++i) { const int idx = tid + 512 * i, key = idx >> 4, ch = idx & 15; *(LAS u32x4*)(buf + (ch >> 2) * (128 * 64) + key * 64 + (ch & 3) * 16) = KR[i]; } \
        { const int key = tid >> 2, ch = tid & 3; float f[8]; unpack8(VR, f); u32x4 w; \
          w.x = pk2(f[0] * vscale, f[1] * vscale); w.y = pk2(f[2] * vscale, f[3] * vscale); w.z = pk2(f[4] * vscale, f[5] * vscale); w.w = pk2(f[6] * vscale, f[7] * vscale); \
          *(LAS u32x4*)(buf + 32768 + key * 64 + ch * 16) = w; } \
        if (c__ + 2 < 32) RET_ISSUE(KR, VR, c__ + 2); \
        __syncthreads(); \
        if (wave < 4) { \
            const int dt = wave; \
            acc = acc * g128; \
            LAS const unsigned char* ab = buf + dt * (128 * 64) + (4 * hi + ((lane & 15) >> 2)) * 64 + ((lane >> 4) & 1) * 32 + (lane & 3) * 8; \
            LAS const unsigned char* bb = buf + 32768 + (4 * hi + ((lane & 15) >> 2)) * 64 + ((lane >> 4) & 1) * 32 + (lane & 3) * 8; \
            _Pragma("unroll") for (int ks = 0; ks < 8; ++ks) { \
                const s16x4 al = vtr(ab + ks * 1024), ah = vtr(ab + ks * 1024 + 512), bl = vtr(bb + ks * 1024), bh = vtr(bb + ks * 1024 + 512); \
                const bf16x8 af = (bf16x8){al[0], al[1], al[2], al[3], ah[0], ah[1], ah[2], ah[3]}, bfr = (bf16x8){bl[0], bl[1], bl[2], bl[3], bh[0], bh[1], bh[2], bh[3]}; \
                acc = __builtin_amdgcn_mfma_f32_32x32x16_bf16(af, bfr, acc, 0, 0, 0); } \
            bf16* sb = states + ((((size_t)(b * 4 + h) * 32 + c__) * 8 + dvs) * 8) * 512; \
            _Pragma("unroll") for (int g = 0; g < 4; ++g) { u32x2 w; w.x = pk2(acc[4 * g], acc[4 * g + 1]); w.y = pk2(acc[4 * g + 2], acc[4 * g + 3]); \
                *(u32x2*)(sb + (size_t)(2 * dt + (g >> 1)) * 512 + (32 * (g & 1) + (lane & 31)) * 8 + 4 * hi) = w; } \
        } } while (0)
__device__ __forceinline__ void state_chain(LAS unsigned char* lds, int b, int h, int dvs, const bf16* __restrict__ proj, const bf16* __restrict__ pmeta, bf16* __restrict__ states) {
    const int tid = threadIdx.x, lane = tid & 63, hi = lane >> 5; const int wave = __builtin_amdgcn_readfirstlane(tid >> 6);
    const float lg = lg2gamma(h), g128 = exp2f(lg * 128.0f);
    u32x4 kA[4], kB[4], vA, vB;
    const float vscale = exp2f(lg * (float)(127 - (tid >> 2)));
    f32x16 acc = {};
    RET_ISSUE(kA, vA, 0); RET_ISSUE(kB, vB, 1);
#pragma unroll 1
    for (int c = 0; c < 32; c += 2) { RET_STEP(kA, vA, c); RET_STEP(kB, vB, c + 1); }
    __syncthreads();
}
#undef RET_ISSUE
#undef RET_STEP

constexpr int R1KS = 8192 + 64, R1VS = 8192 + 128, R1VO = 4 * R1KS, R1B2 = R1VO + 2 * R1VS;
#define RET2_ISSUE(KR, VR, c_) do { const int ci__ = (c_); \
        _Pragma("unroll") for (int i = 0; i < 4; ++i) { const int idx = tid + 512 * i, key = idx >> 4, ch = idx & 15; \
            if (ci__ == 0) { KR[i] = (key >= 112) ? *(const u32x4*)(pmeta + (size_t)(key - 112) * INW + C_RK + h * 128 + ch * 8) : (u32x4){0u, 0u, 0u, 0u}; } \
            else KR[i] = *(const u32x4*)(proj + ((size_t)b * SEQ + (ci__ - 1) * 128 + key) * INW + C_RK + h * 128 + ch * 8); } \
        _Pragma("unroll") for (int i = 0; i < 2; ++i) { const int idx = tid + 512 * i, key = idx >> 3, c8 = idx & 7; \
          if (ci__ == 0) VR[i] = (key >= 112) ? *(const u32x4*)(pmeta + (size_t)(key - 112) * INW + C_RV + h * 256 + dvs2 * 64 + c8 * 8) : (u32x4){0u, 0u, 0u, 0u}; \
          else VR[i] = *(const u32x4*)(proj + ((size_t)b * SEQ + (ci__ - 1) * 128 + key) * INW + C_RV + h * 256 + dvs2 * 64 + c8 * 8); } } while (0)
#define RET2_STEP(KR, VR, c_) do { const int c__ = (c_); LAS unsigned char* buf = lds + (c__ & 1) * R1B2; \
        _Pragma("unroll") for (int i = 0; i < 4; ++i) { const int idx = tid + 512 * i, key = idx >> 4, ch = idx & 15; *(LAS u32x4*)(buf + (ch >> 2) * R1KS + key * 64 + (ch & 3) * 16) = KR[i]; } \
        _Pragma("unroll") for (int i = 0; i < 2; ++i) { const int idx = tid + 512 * i, key = idx >> 3, c8 = idx & 7; float f[8]; unpack8(VR[i], f); const float vs = vscale[i]; u32x4 w; \
          w.x = pk2(f[0] * vs, f[1] * vs); w.y = pk2(f[2] * vs, f[3] * vs); w.z = pk2(f[4] * vs, f[5] * vs); w.w = pk2(f[6] * vs, f[7] * vs); \
          *(LAS u32x4*)(buf + R1VO + (c8 >> 2) * R1VS + key * 64 + (c8 & 3) * 16) = w; } \
        if (c__ + 3 < 32) RET2_ISSUE(KR, VR, c__ + 3); \
        __syncthreads(); \
        { \
            acc = acc * g128; \
            LAS const unsigned char* ab = buf + dt * R1KS + (4 * hi + ((lane & 15) >> 2)) * 64 + ((lane >> 4) & 1) * 32 + (lane & 3) * 8; \
            LAS const unsigned char* bb = buf + R1VO + sl * R1VS + (4 * hi + ((lane & 15) >> 2)) * 64 + ((lane >> 4) & 1) * 32 + (lane & 3) * 8; \
            _Pragma("unroll") for (int ks = 0; ks < 8; ++ks) { \
                const s16x4 al = vtr(ab + ks * 1024), ah = vtr(ab + ks * 1024 + 512), bl = vtr(bb + ks * 1024), bh = vtr(bb + ks * 1024 + 512); \
                const bf16x8 af = (bf16x8){al[0], al[1], al[2], al[3], ah[0], ah[1], ah[2], ah[3]}, bfr = (bf16x8){bl[0], bl[1], bl[2], bl[3], bh[0], bh[1], bh[2], bh[3]}; \
                acc = __builtin_amdgcn_mfma_f32_32x32x16_bf16(af, bfr, acc, 0, 0, 0); } \
            bf16* sb = states + ((((size_t)(b * 4 + h) * 32 + c__) * 8 + (2 * dvs2 + sl)) * 8) * 512; \
            _Pragma("unroll") for (int g = 0; g < 4; ++g) { u32x2 w; w.x = pk2(acc[4 * g], acc[4 * g + 1]); w.y = pk2(acc[4 * g + 2], acc[4 * g + 3]); \
                *(u32x2*)(sb + (size_t)(2 * dt + (g >> 1)) * 512 + (32 * (g & 1) + (lane & 31)) * 8 + 4 * hi) = w; } \
        } } while (0)
__device__ __forceinline__ void state_chain2(LAS unsigned char* lds, int b, int h, int dvs2, const bf16* __restrict__ proj, const bf16* __restrict__ pmeta, bf16* __restrict__ states) {
    const int tid = threadIdx.x, lane = tid & 63, hi = lane >> 5; const int wave = __builtin_amdgcn_readfirstlane(tid >> 6);
    const int dt = wave & 3, sl = wave >> 2;
    const float lg = lg2gamma(h), g128 = exp2f(lg * 128.0f);
    u32x4 kA[4], kB[4], kC[4], vA[2], vB[2], vC[2];
    float vscale[2];
#pragma unroll
    for (int i = 0; i < 2; ++i) vscale[i] = exp2f(lg * (float)(127 - ((tid + 512 * i) >> 3)));
    f32x16 acc = {};
    RET2_ISSUE(kA, vA, 0); RET2_ISSUE(kB, vB, 1); RET2_ISSUE(kC, vC, 2);
#pragma unroll 1
    for (int c = 0; c < 30; c += 3) { RET2_STEP(kA, vA, c); RET2_STEP(kB, vB, c + 1); RET2_STEP(kC, vC, c + 2); }
    RET2_STEP(kA, vA, 30); RET2_STEP(kB, vB, 31);
    __syncthreads();
}
#undef RET2_ISSUE
#undef RET2_STEP

constexpr int R3_K = 0, R3_Q = 32768, R3_V = 65536;
#define R3_ISSUE(u_) do { const int u__ = (u_); const size_t rw = (size_t)(u__ >> 7) * SEQ + (u__ & 31) * 128; const int hh = (u__ >> 5) & 3; \
        _Pragma("unroll") for (int i = 0; i < 4; ++i) { const int idx = tid + 512 * i, key = idx >> 4, ch = idx & 15; \
            kq[i] = *(const u32x4*)(proj + (rw + key) * INW + C_RK + hh * 128 + ch * 8); kq[4 + i] = *(const u32x4*)(proj + (rw + key) * INW + C_RQ + hh * 128 + ch * 8); } \
        _Pragma("unroll") for (int i = 0; i < 8; ++i) { const int idx = tid + 512 * i, key = idx >> 5, ch = idx & 31; vv[i] = *(const u32x4*)(proj + (rw + key) * INW + C_RV + hh * 256 + ch * 8); } } while (0)
__device__ __forceinline__ void out_phase(LAS unsigned char* lds, const bf16* __restrict__ proj, const bf16* __restrict__ states, bf16* __restrict__ yret, int G, int bx) {
    const int tid = threadIdx.x, lane = tid & 63, r32 = lane & 31, hi = lane >> 5; const int wave = __builtin_amdgcn_readfirstlane(tid >> 6);
    constexpr int NU = NB * 4 * 32;
    if (bx >= NU) return;
    u32x4 kq[8], vv[8];
    R3_ISSUE(bx);
    for (int u = bx; u < NU; u += G) {
        const int b = u >> 7, h = (u >> 5) & 3, tb = u & 31;
        const float lg = lg2gamma(h);
        const size_t row0 = (size_t)b * SEQ + tb * 128;
#pragma unroll
        for (int i = 0; i < 4; ++i) { const int idx = tid + 512 * i, key = idx >> 4, ch = idx & 15;
            *(LAS u32x4*)(lds + R3_K + ch * 2048 + key * 16) = kq[i]; *(LAS u32x4*)(lds + R3_Q + ch * 2048 + key * 16) = kq[4 + i]; }
#pragma unroll
        for (int i = 0; i < 8; ++i) { const int idx = tid + 512 * i, key = idx >> 5, ch = idx & 31; *(LAS u32x4*)(lds + R3_V + (ch >> 2) * 8192 + key * 64 + (ch & 3) * 16) = vv[i]; }
        if (u + G < NU) R3_ISSUE(u + G);
        bf16x8 sf[8];
        { const bf16* sb = states + (((size_t)(b * 4 + h) * 32 + tb) * 64 + (size_t)wave * 8) * 512 + lane * 8;
#pragma unroll
          for (int k = 0; k < 8; ++k) sf[k] = *(const bf16x8*)(sb + (size_t)k * 512); }
        __syncthreads();
        u32x2 pw[2][4];
        for (int rp_ = 0; rp_ < ((PROBE_PHASE == 31) ? 2 : 1); ++rp_)
#pragma unroll
        for (int ti = 0; ti < 2; ++ti) {
            const int t = wave + 8 * ti;
            if (t < 10) {
                const int a = (t >= 6) ? 3 : (t >= 3) ? 2 : (t >= 1) ? 1 : 0, bb = t - ((a * (a + 1)) >> 1);
                f32x16 p = {};
#pragma unroll
                for (int k = 0; k < 8; ++k) {
                    const bf16x8 kf = *(const LAS bf16x8*)(lds + R3_K + (2 * k + hi) * 2048 + (32 * bb + r32) * 16);
                    const bf16x8 qf = *(const LAS bf16x8*)(lds + R3_Q + (2 * k + hi) * 2048 + (32 * a + r32) * 16);
                    p = __builtin_amdgcn_mfma_f32_32x32x16_bf16(kf, qf, p, 0, 0, 0);
                }
                const float lanebase = lg * (float)(32 * (a - bb) + r32 - 4 * hi), cpos = -lg; const int tt = r32 - 4 * hi;
                float e[16];
#pragma unroll
                for (int r = 0; r < 16; ++r) { float v = p[r] * __builtin_amdgcn_exp2f(__builtin_fmaf(cpos, (float)crowc(r), lanebase)); if (bb == a) v = (crowc(r) <= tt) ? v : 0.f; e[r] = v; }
#pragma unroll
                for (int g = 0; g < 4; ++g) { pw[ti][g].x = pk2(e[4 * g], e[4 * g + 1]); pw[ti][g].y = pk2(e[4 * g + 2], e[4 * g + 3]); }
            }
        }
        __builtin_amdgcn_sched_barrier(0);
        bf16x8 vf[8];
        { LAS const unsigned char* vb = lds + R3_V + wave * 8192 + (8 * hi + ((lane & 15) >> 2)) * 64 + ((lane >> 4) & 1) * 32 + (lane & 3) * 8;
#pragma unroll
          for (int ks = 0; ks < 8; ++ks) { const s16x4 lo = vtr(vb + ks * 1024), hh = vtr(vb + ks * 1024 + 256); vf[ks] = (bf16x8){lo[0], lo[1], lo[2], lo[3], hh[0], hh[1], hh[2], hh[3]}; } }
        __syncthreads();
#pragma unroll
        for (int ti = 0; ti < 2; ++ti) {
            const int t = wave + 8 * ti;
            if (t < 10) {
                const int a = (t >= 6) ? 3 : (t >= 3) ? 2 : (t >= 1) ? 1 : 0, bb = t - ((a * (a + 1)) >> 1);
#pragma unroll
                for (int g = 0; g < 4; ++g) *(LAS u32x2*)(lds + R3_K + (4 * bb + g) * 2048 + (32 * a + r32) * 16 + hi * 8) = pw[ti][g];
            }
        }
        __syncthreads();
        LAS bf16* stg = (LAS bf16*)(lds + R3_V);
        for (int rp_ = 0; rp_ < ((PROBE_PHASE == 32) ? 2 : 1); ++rp_)
#pragma unroll 1
        for (int a = 0; a < 4; ++a) {
            f32x16 o = {};
#pragma unroll
            for (int ks = 0; ks < 8; ++ks) if (ks < 2 * (a + 1)) {
                const bf16x8 pa = *(const LAS bf16x8*)(lds + R3_K + (2 * ks + hi) * 2048 + (32 * a + r32) * 16);
                o = __builtin_amdgcn_mfma_f32_32x32x16_bf16(pa, vf[ks], o, 0, 0, 0);
            }
            f32x16 x = {};
#pragma unroll
            for (int k = 0; k < 8; ++k) { const bf16x8 qa = *(const LAS bf16x8*)(lds + R3_Q + (2 * k + hi) * 2048 + (32 * a + r32) * 16); x = __builtin_amdgcn_mfma_f32_32x32x16_bf16(qa, sf[k], x, 0, 0, 0); }
#pragma unroll
            for (int r = 0; r < 16; ++r) {
                const float din = __builtin_amdgcn_exp2f(lg * (float)(32 * a + crowc(r) + 4 * hi + 1));
                { const int row = 32 * a + crowc(r) + 4 * hi, col = wave * 32 + r32;
                  stg[row * 256 + ((((col >> 3) ^ ((row & 3) << 2)) << 3) | (col & 7))] = f2bf(o[r] + din * x[r]); }
            }
        }
        int nl = lane; asm volatile("" : "+v"(nl));
        const int nrow = wave * 16 + (nl >> 2), c4 = nl & 3, sx = nrow & 3;
        const bf16* rgp = proj + (row0 + nrow) * INW + C_RG + h * 256 + c4 * 8;
        bf16* yp = yret + (row0 + nrow) * D + h * 256 + c4 * 8;
        LAS const bf16* sp = stg + nrow * 256 + c4 * 8;
        u32x4 rgv[8];
#pragma unroll
        for (int j = 0; j < 8; ++j) rgv[j] = *(const u32x4*)(rgp + 32 * j);
        __syncthreads();
        for (int rp_ = 0; rp_ < ((PROBE_PHASE == 33) ? 2 : 1); ++rp_) {
            float ss = 0.f;
#pragma unroll
            for (int j = 0; j < 8; ++j) { const u32x4 sw = *(const LAS u32x4*)(sp + 32 * (j ^ sx)); float f[8]; unpack8(sw, f);
#pragma unroll
                for (int i = 0; i < 8; ++i) ss += f[i] * f[i]; }
            ss += __shfl_xor(ss, 1); ss += __shfl_xor(ss, 2);
            const float rs = rsqrtf(ss * (1.0f / 256.0f) + EPS);
            asm volatile("" ::: "memory");
#pragma unroll
            for (int j = 0; j < 8; ++j) { const u32x4 sw = *(const LAS u32x4*)(sp + 32 * (j ^ sx)); float f[8], g[8]; unpack8(sw, f); unpack8(rgv[j], g); u32x4 w;
                w.x = pk2(f[0] * rs * g[0], f[1] * rs * g[1]); w.y = pk2(f[2] * rs * g[2], f[3] * rs * g[3]); w.z = pk2(f[4] * rs * g[4], f[5] * rs * g[5]); w.w = pk2(f[6] * rs * g[6], f[7] * rs * g[7]);
                *(u32x4*)(yp + 32 * j) = w; }
        }
        __syncthreads();
    }
}
#undef R3_ISSUE
}
__device__ __forceinline__ void p0_load(const float* __restrict__ W, int N, int k0, int n0, int lane, f32x4 (&v)[16]) {
    const int kblk = lane >> 3, nq = lane & 7;
    const float* src = W + (size_t)(k0 + 16 * kblk) * N + n0 + 4 * nq;
#pragma unroll
    for (int i = 0; i < 16; ++i) v[i] = __builtin_nontemporal_load((const f32x4*)(src + (size_t)i * N));
}
template <bool FP8>
__device__ __forceinline__ void p0_store(void* __restrict__ WT, int K, int k0, int dst_row0, int lane, const f32x4 (&v)[16]) {
    const int kblk = lane >> 3, nq = lane & 7;
#pragma unroll
    for (int j = 0; j < 4; ++j) {
        const size_t row = (size_t)(dst_row0 + 4 * nq + j);
        if constexpr (FP8) {
            u32x4 o;
            o.x = pk4_fp8(v[0][j] * W8_SCALE, v[1][j] * W8_SCALE, v[2][j] * W8_SCALE, v[3][j] * W8_SCALE); o.y = pk4_fp8(v[4][j] * W8_SCALE, v[5][j] * W8_SCALE, v[6][j] * W8_SCALE, v[7][j] * W8_SCALE);
            o.z = pk4_fp8(v[8][j] * W8_SCALE, v[9][j] * W8_SCALE, v[10][j] * W8_SCALE, v[11][j] * W8_SCALE); o.w = pk4_fp8(v[12][j] * W8_SCALE, v[13][j] * W8_SCALE, v[14][j] * W8_SCALE, v[15][j] * W8_SCALE);
            *(u32x4*)((unsigned char*)WT + row * K + k0 + 16 * kblk) = o;
        } else {
            u32x4 a, b;
            a.x = pk2(v[0][j], v[1][j]); a.y = pk2(v[2][j], v[3][j]); a.z = pk2(v[4][j], v[5][j]); a.w = pk2(v[6][j], v[7][j]);
            b.x = pk2(v[8][j], v[9][j]); b.y = pk2(v[10][j], v[11][j]); b.z = pk2(v[12][j], v[13][j]); b.w = pk2(v[14][j], v[15][j]);
            bf16* d = (bf16*)WT + row * K + k0 + 16 * kblk;
            *(u32x4*)d = a; *(u32x4*)(d + 8) = b;
        }
    }
}
template <bool FP8>
__device__ __forceinline__ void p0_item(const float* __restrict__ W, int K, int N, void* __restrict__ WT, int k0, int n0, int dst_row0, int lane) {
    f32x4 v[16]; p0_load(W, N, k0, n0, lane, v); p0_store<FP8>(WT, K, k0, dst_row0, lane, v);
}
constexpr int I_IN = 8 * 200, I_SQ = 8 * 32, I_GU = 32 * 8 * 64, I_DN = 32 * 8 * 32, NITEMS = I_IN + 3 * I_SQ + I_GU + I_DN;
constexpr int I_SMALL = I_IN + 3 * I_SQ, I_MOE = I_GU + I_DN;
constexpr int NCONV = 40;
#define MOE_DECODE(r_) const int r__ = (r_); const bool isgu = r__ < I_GU; const int rr = isgu ? r__ : r__ - I_GU; \
    const int e_ = isgu ? rr / 512 : rr / 256, q_ = isgu ? rr % 512 : rr % 256, kb_ = isgu ? q_ / 64 : q_ / 32, nb_ = isgu ? q_ % 64 : q_ % 32, n0_ = nb_ * 32; \
    const float* src_ = isgu ? w_gu + (size_t)e_ * D * 2048 : w_dn + (size_t)e_ * DFF * D; const int N_ = isgu ? 2048 : D; \
    unsigned char* dst_ = isgu ? Wgu_t + (size_t)e_ * 2048 * D : Wdn_t + (size_t)e_ * D * DFF; \
    const int drow_ = isgu ? 256 * ((n0_ & 1023) >> 7) + 128 * (n0_ >> 10) + (n0_ & 127) : n0_;
#define P0_DISPATCH(it_) do { int r = (it_); \
    if (r < I_IN) { const int kb = r / 200, nb = r % 200, n0 = nb * 32, o = n0 & 255, wcc = o >> 6, bj = (o >> 5) & 1; \
        if (n0 >= 256 * T8) p0_item<true>(w_in, D, INW, Win8, kb * 128, n0, (n0 & ~255) - 256 * T8 + 128 * bj + 32 * wcc, lane); \
        else p0_item<false>(w_in, D, INW, Win_t, kb * 128, n0, (n0 & ~255) + 128 * bj + 32 * wcc, lane); break; } \
    r -= I_IN; \
    if (r < I_SQ) { p0_item<false>(w_ab, D, D, Wab_t, (r / 32) * 128, (r % 32) * 32, (r % 32) * 32, lane); break; } r -= I_SQ; \
    if (r < I_SQ) { p0_item<false>(w_rb, D, D, Wrb_t, (r / 32) * 128, (r % 32) * 32, (r % 32) * 32, lane); break; } r -= I_SQ; \
    if (r < I_SQ) { p0_item<false>(w_out, D, D, Wout_t, (r / 32) * 128, (r % 32) * 32, (r % 32) * 32, lane); break; } r -= I_SQ; \
    if (r < I_GU) { const int e = r / 512, q = r % 512, kb = q / 64, nb = q % 64, n0 = nb * 32, bj = n0 >> 10, rem = n0 & 1023, pn = rem >> 7, cl = rem & 127; \
        p0_item<true>(w_gu + (size_t)e * D * 2048, D, 2048, Wgu_t + (size_t)e * 2048 * D, kb * 128, n0, 256 * pn + 128 * bj + cl, lane); break; } \
    r -= I_GU; \
    { const int e = r / 256, q = r % 256, kb = q / 32, nb = q % 32; \
      p0_item<true>(w_dn + (size_t)e * DFF * D, DFF, D, Wdn_t + (size_t)e * D * DFF, kb * 128, nb * 32, nb * 32, lane); } } while (0)
#ifndef PROBE_PHASE
#define PROBE_PHASE (-1)
#endif
#ifndef PROBE_TS
#define PROBE_TS (-1)
#endif
constexpr int CW_TS = 1200;
__device__ __forceinline__ void p0_transpose_item_fp8(const float* W, int K, int N, unsigned char* WT, int k0, int n0, int dst_row0, LAS float* scr, int lane) {
#pragma unroll 8
    for (int i = 0; i < 32; ++i) { const int kk = 2 * i + (lane >> 5); scr[kk * 33 + (lane & 31)] = W[(size_t)(k0 + kk) * N + n0 + (lane & 31)]; }
    LDS_WAIT(); asm volatile("" ::: "memory");
    const int c = lane & 3;
#pragma unroll
    for (int j = 0; j < 2; ++j) { const int n = (lane >> 2) + 16 * j; const LAS float* s = scr + (16 * c) * 33 + n;
        u32x4 o;
        o.x = pk4_fp8(s[0 * 33] * W8_SCALE, s[1 * 33] * W8_SCALE, s[2 * 33] * W8_SCALE, s[3 * 33] * W8_SCALE); o.y = pk4_fp8(s[4 * 33] * W8_SCALE, s[5 * 33] * W8_SCALE, s[6 * 33] * W8_SCALE, s[7 * 33] * W8_SCALE);
        o.z = pk4_fp8(s[8 * 33] * W8_SCALE, s[9 * 33] * W8_SCALE, s[10 * 33] * W8_SCALE, s[11 * 33] * W8_SCALE); o.w = pk4_fp8(s[12 * 33] * W8_SCALE, s[13 * 33] * W8_SCALE, s[14 * 33] * W8_SCALE, s[15 * 33] * W8_SCALE);
        *(u32x4*)(WT + (size_t)(dst_row0 + n) * K + k0 + 16 * c) = o; }
    LDS_WAIT(); asm volatile("" ::: "memory");
}
struct Args { const float* in[17]; float* out; unsigned char* ws; int ph_lo, ph_hi, li, pad; };

__global__ void __launch_bounds__(512, 2) mk_fwd(Args args) {
    extern __shared__ __attribute__((aligned(16))) unsigned char lds_raw[];
    LAS unsigned char* lds = (LAS unsigned char*)lds_raw;
    volatile LAS unsigned* MISC = (volatile LAS unsigned*)(lds + MISC_OFF);
    const int tid = threadIdx.x, lane = tid & 63, wave = __builtin_amdgcn_readfirstlane(tid >> 6);
    const int G = gridDim.x, bx = blockIdx.x;
    const int vcu = (G % 8 == 0) ? (bx % 8) * (G / 8) + bx / 8 : bx;
    unsigned char* ws = args.ws;
    unsigned* ctl = (unsigned*)(ws + WS_CTL);
    const float* x = args.in[0]; const float* meta = args.in[1]; const float* g1 = args.in[2]; const float* w_in = args.in[3];
    const float* qg = args.in[4]; const float* kg = args.in[5];
    const float* w_ab = args.in[7]; const float* w_rb = args.in[8]; const float* w_out = args.in[9];
    const float* w_gu = args.in[13]; const float* b_gu = args.in[14]; const float* w_dn = args.in[15]; const float* b_dn = args.in[16];
    float* out = args.out;
    bf16* Win_t = (bf16*)(ws + WS_WIN); bf16* Wab_t = (bf16*)(ws + WS_WAB); bf16* Wrb_t = (bf16*)(ws + WS_WRB); bf16* Wout_t = (bf16*)(ws + WS_WOUT);
    unsigned char* Wgu_t = ws + WS_WGU; unsigned char* Wdn_t = ws + WS_WDN;
    bf16* xb = (bf16*)(ws + WS_XB); bf16* proj = (bf16*)(ws + WS_PROJ); bf16* yatt = (bf16*)(ws + WS_YATT); bf16* yret = (bf16*)(ws + WS_YRET); bf16* merged = (bf16*)(ws + WS_MERGED);
    bf16* pmeta = proj + (size_t)NTOK * INW;
    const float* sinks = args.in[6]; const float* g2 = args.in[10]; const float* w_r = args.in[11]; const float* b_r = args.in[12];
    int* tke = (int*)(ws + SM_TKE); float* tkw = (float*)(ws + SM_TKW); int* tkpos = (int*)(ws + SM_TKPOS); int* list = (int*)(ws + SM_LIST); float* wlist = (float*)(ws + SM_WLIST); float* rlist = (float*)(ws + SM_RLIST);
    LAS unsigned char* misc = lds + MISC_OFF;
    bf16* states = (bf16*)(ws + ret::WS_STATES);
    bf16* h2b = (bf16*)(ws + ret::WS_STATES);
    unsigned char* xb8 = ws + WS_MERGED; unsigned char* Win8 = ws + WS_YRET;
    unsigned char* act = ws + WS_ACT; unsigned char* rows = ws + WS_ROWS; unsigned char* xn8 = ws + WS_XB;

    for (int u = tid; u < (LDS_BYTES - MISC_OFF) / 4; u += 512) ((LAS unsigned*)(lds + MISC_OFF))[u] = 0u;
    __syncthreads();
    XcdBarrier bar = xcd_barrier_post(ctl + CW_BAR + args.li * XCD_BAR_WORDS, MISC + 8);
    const int lo = args.ph_lo, hi = args.ph_hi;
#define IN(k) (lo <= (k) && (k) < hi)
#define BOTH(k) (IN(k) && IN((k) + 1))
#define GRID_BAR() do { xcd_barrier(bar); if (PROBE_TS >= 0 && bx == 0 && tid == 0) { ctl[CW_TS + ts_n] = (unsigned)__builtin_amdgcn_s_memrealtime(); } ++ts_n; } while (0)
    int ts_n = 1; if (PROBE_TS >= 0 && bx == 0 && tid == 0) ctl[CW_TS] = (unsigned)__builtin_amdgcn_s_memrealtime();

    if (PROBE_PHASE == 303) { asm volatile(".rept 4096\n\ts_nop 0\n\t.endr" ::: "memory"); }
    if (PROBE_PHASE == 300) { const unsigned long long t0_ = __builtin_amdgcn_s_memrealtime(); while (__builtin_amdgcn_s_memrealtime() - t0_ < 5000ull) __builtin_amdgcn_s_sleep(8); }
    if (PROBE_PHASE == 301) {
        const size_t gt = (size_t)bx * 512 + tid; unsigned acc_ = 0;
        for (size_t pg = gt; pg < (size_t)NTOK * D * 4 / 4096; pg += (size_t)G * 512) acc_ += ((const unsigned*)x)[pg * 1024];
        for (size_t pg = gt; pg < (size_t)D * INW * 4 / 4096; pg += (size_t)G * 512) acc_ += ((const unsigned*)w_in)[pg * 1024];
        for (size_t pg = gt; pg < (size_t)(NTOK + 256) * D * 2 / 4096; pg += (size_t)G * 512) acc_ += ((const unsigned*)xb)[pg * 1024];
        for (size_t pg = gt; pg < (size_t)INW * D * 2 / 4096; pg += (size_t)G * 512) acc_ += ((const unsigned*)Win_t)[pg * 1024];
        asm volatile("" :: "v"(acc_));
    }
    if (IN(0)) { for (int rep_ = 0; rep_ < ((PROBE_PHASE == 0) ? 2 : 1); ++rep_) {
        const int gw = vcu * NWAVES + wave, NGW = G * NWAVES;
        for (int it = gw; it < ((G == 256) ? I_SMALL : NITEMS); it += NGW) { P0_DISPATCH(it); }
        if (PROBE_TS >= 0 && bx == 0) { __syncthreads(); if (tid == 0) ctl[CW_TS + 20] = (unsigned)__builtin_amdgcn_s_memrealtime(); }
        for (int row0_ = gw; row0_ < NTOK; row0_ += 4 * NGW) {
            f32x4 v[4][4];
#pragma unroll
            for (int q = 0; q < 4; ++q) { const int row = row0_ + q * NGW; if (row < NTOK) { const f32x4* xr = (const f32x4*)(x + (size_t)row * D) + lane;
#pragma unroll
                for (int j = 0; j < 4; ++j) v[q][j] = xr[64 * j]; } }
#pragma unroll
            for (int q = 0; q < 4; ++q) { const int row = row0_ + q * NGW; if (row < NTOK) {
                float ss = 0.f;
#pragma unroll
                for (int j = 0; j < 4; ++j) ss += (v[q][j][0] * v[q][j][0] + v[q][j][1] * v[q][j][1]) + (v[q][j][2] * v[q][j][2] + v[q][j][3] * v[q][j][3]);
                const float rstd = rsqrtf(wave_sum(ss) * (1.0f / D) + EPS);
                u32x2* o8 = (u32x2*)(xb + (size_t)row * D) + lane; unsigned* o4 = (unsigned*)(xb8 + (size_t)row * D) + lane;
#pragma unroll
                for (int j = 0; j < 4; ++j) { const f32x4 gg = ((const f32x4*)g1)[64 * j + lane]; const float e0 = v[q][j][0] * rstd * gg[0], e1 = v[q][j][1] * rstd * gg[1], e2 = v[q][j][2] * rstd * gg[2], e3 = v[q][j][3] * rstd * gg[3];
                    u32x2 w; w.x = pk2(e0, e1); w.y = pk2(e2, e3); o8[64 * j] = w; o4[64 * j] = pk4_fp8(e0 * XB8_SCALE, e1 * XB8_SCALE, e2 * XB8_SCALE, e3 * XB8_SCALE); }
            } }
        }
        if (PROBE_TS >= 0 && bx == 0) { __syncthreads(); if (tid == 0) ctl[CW_TS + 21] = (unsigned)__builtin_amdgcn_s_memrealtime(); }
        for (int row = gw; row < 256; row += NGW) {
            u32x2* o8 = (u32x2*)(xb + (size_t)(NTOK + row) * D) + lane; unsigned* o4 = (unsigned*)(xb8 + (size_t)(NTOK + row) * D) + lane;
            if (row < NMETA) {
                const f32x4* xr = (const f32x4*)(meta + (size_t)row * D) + lane;
                f32x4 v[4]; float ss = 0.f;
#pragma unroll
                for (int j = 0; j < 4; ++j) { v[j] = xr[64 * j]; ss += (v[j][0] * v[j][0] + v[j][1] * v[j][1]) + (v[j][2] * v[j][2] + v[j][3] * v[j][3]); }
                const float rstd = rsqrtf(wave_sum(ss) * (1.0f / D) + EPS);
#pragma unroll
                for (int j = 0; j < 4; ++j) { const f32x4 gg = ((const f32x4*)g1)[64 * j + lane]; const float e0 = v[j][0] * rstd * gg[0], e1 = v[j][1] * rstd * gg[1], e2 = v[j][2] * rstd * gg[2], e3 = v[j][3] * rstd * gg[3];
                    u32x2 w; w.x = pk2(e0, e1); w.y = pk2(e2, e3); o8[64 * j] = w; o4[64 * j] = pk4_fp8(e0 * XB8_SCALE, e1 * XB8_SCALE, e2 * XB8_SCALE, e3 * XB8_SCALE); }
            } else {
#pragma unroll
                for (int j = 0; j < 4; ++j) { o8[64 * j] = (u32x2){0u, 0u}; o4[64 * j] = 0u; }
            }
        }
        __syncthreads(); }
        if (PROBE_TS >= 0 && bx == 0) { asm volatile("s_waitcnt vmcnt(0)" ::: "memory"); __syncthreads(); if (tid == 0) ctl[CW_TS + 22] = (unsigned)__builtin_amdgcn_s_memrealtime(); }
        if (BOTH(0)) GRID_BAR();
    }
    if (PROBE_PHASE == 200) { GRID_BAR(); GRID_BAR(); GRID_BAR(); GRID_BAR(); }
    if (IN(1)) {
        const int nconv = (G == 256) ? NCONV : 0;
        if (bx < nconv) {
            const int cw = bx * NWAVES + wave, ncw = nconv * NWAVES;
#pragma unroll 1
            for (int it = cw; it < I_MOE; it += 2 * ncw) {
                f32x4 va[16], vb[16];
                { MOE_DECODE(it); p0_load(src_, N_, kb_ * 128, n0_, lane, va); }
                const bool two = it + ncw < I_MOE;
                if (two) { MOE_DECODE(it + ncw); p0_load(src_, N_, kb_ * 128, n0_, lane, vb); }
                { MOE_DECODE(it); p0_store<true>(dst_, 1024, kb_ * 128, drow_, lane, va); }
                if (two) { MOE_DECODE(it + ncw); p0_store<true>(dst_, 1024, kb_ * 128, drow_, lane, vb); }
            }
        } else {
            { LAS float* gt = (LAS float*)(misc + MT_GAIN); if (tid < 64) { gt[tid] = 0.125f * 1.4426950408889634f * qg[tid]; gt[64 + tid] = kg[tid]; }       __syncthreads(); }
            { SchedDense S; S.init(xb, Win_t, NTOK + 256, 256 * T8, D, G - nconv, bx - nconv);
              EpiProjT<0, false> E{proj, (LAS const float*)(misc + MT_GAIN)};
              pg8::gemm_phase<EpiProjT<0, false>, SchedDense>(lds, 2 * D, S, E); }
            { SchedDense8 S; S.init((const bf16*)xb8, (const bf16*)Win8, NTOK + 256, INW - 256 * T8, D, G - nconv, (G - nconv - 1) - (bx - nconv));
              EpiProjT<T8, true> E{proj, (LAS const float*)(misc + MT_GAIN)};
              pg8::gemm_phase<EpiProjT<T8, true>, SchedDense8, true>(lds, D, S, E); }
        }
        if (BOTH(1)) GRID_BAR();
    }
    if (IN(2)) {
        float mq = fabsf(qg[lane]), mk = fabsf(kg[lane]);
#pragma unroll
        for (int o = 1; o < 64; o <<= 1) { mq = fmaxf(mq, __shfl_xor(mq, o)); mk = fmaxf(mk, __shfl_xor(mk, o)); }
        const float bshift = 8.0f * mq * mk;
        if (G == 256) {
            if (bx < 128) {
                const int x = bx & 7, r = bx >> 3;
                ret::state_chain2(lds, (x * 4 + (r >> 2)) >> 2, (x * 4 + (r >> 2)) & 3, r & 3, proj, pmeta, states);
                if (PROBE_TS >= 0) { asm volatile("s_waitcnt vmcnt(0)" ::: "memory"); __syncthreads(); if (tid == 0) ctl[CW_TS + 64 + bx] = (unsigned)__builtin_amdgcn_s_memrealtime(); }
                attn::phase(lds, proj, pmeta, sinks, bshift, yatt, bx, 1, 1);
                if (PROBE_TS >= 0) { asm volatile("s_waitcnt vmcnt(0)" ::: "memory"); __syncthreads(); if (tid == 0) ctl[CW_TS + 320 + bx] = (unsigned)__builtin_amdgcn_s_memrealtime(); }
            } else { attn::phase(lds, proj, pmeta, sinks, bshift, yatt, 128 + (bx - 128), 3, 128);
                if (PROBE_TS >= 0) { asm volatile("s_waitcnt vmcnt(0)" ::: "memory"); __syncthreads(); if (tid == 0) ctl[CW_TS + 320 + bx] = (unsigned)__builtin_amdgcn_s_memrealtime(); } }
        } else {
            for (int p = bx; p < 128; p += G) ret::state_chain2(lds, p >> 4, (p >> 2) & 3, p & 3, proj, pmeta, states);
            attn::phase(lds, proj, pmeta, sinks, bshift, yatt, bx, (NB * 32 * 2 - bx + G - 1) / G, G);
        }
        if (BOTH(2)) GRID_BAR();
    }
    if (IN(3)) {
        ret::out_phase(lds, proj, states, yret, G, bx);
        if (BOTH(3)) GRID_BAR();
    }
    if (IN(4)) {
        SchedBranch2 S; S.init(yatt, Wab_t, NTOK, D, D, G, bx); S.dA = (size_t)(WS_YRET - WS_YATT) - 16 * 128; S.dB = (size_t)(WS_WRB - WS_WAB) - 16 * 128;
        EpiBranch2 E{merged, proj};
        pg8::gemm_phase<EpiBranch2, SchedBranch2>(lds, 2 * D, S, E);
        if (BOTH(4)) GRID_BAR();
    }
    if (IN(5)) {
        SchedDense S; S.init(merged, Wout_t, NTOK, D, D, G, bx);
        EpiOut E{x, h2b};
        pg8::gemm_phase<EpiOut, SchedDense>(lds, 2 * D, S, E);
        if (BOTH(5)) { route_images(lds, g2, w_r); GRID_BAR(); }
    }
    if (IN(6)) {
        if (!IN(5)) route_images(lds, g2, w_r);
        route_phase(lds, h2b, g2, w_r, b_r, xn8, tke, tkpos, tkw, list, wlist, rlist, ctl + CW_CNT, G, bx);
        if (BOTH(6)) GRID_BAR();
    }
    if (hi > 7 && lo <= 9) moe_tables(misc, ctl + CW_CNT);
    if (IN(7)) {
        SchedMoe<true, 8> S{(const char*)xn8, (const char*)Wgu_t, misc, list, G, bx};
        EpiGU E{act, b_gu, rlist, misc};
        pg8::gemm_phase<EpiGU, SchedMoe<true, 8>, true>(lds, D, S, E);
        if (BOTH(7)) GRID_BAR();
    }
    if (IN(8)) {
        SchedMoe<false, 4> S{(const char*)act, (const char*)Wdn_t, misc, list, G, bx};
        EpiDown E{rows, b_dn, wlist, misc};
        pg8::gemm_phase<EpiDown, SchedMoe<false, 4>, true>(lds, DFF, S, E);
        if (BOTH(8)) GRID_BAR();
    }
    float oscale = 1.0f;
    if (PROBE_TS >= 0) {
        xcd_barrier(bar);
        unsigned a = ctl[CW_TS + (PROBE_TS == 99 ? 0 : PROBE_TS)], b = ctl[CW_TS + (PROBE_TS == 99 ? 0 : PROBE_TS) + 1];
        if (PROBE_TS == 10) { a = ctl[CW_TS + 0]; b = ctl[CW_TS + 20]; } if (PROBE_TS == 11) { a = ctl[CW_TS + 20]; b = ctl[CW_TS + 21]; }
        if (PROBE_TS == 12) { a = ctl[CW_TS + 21]; b = ctl[CW_TS + 22]; } if (PROBE_TS == 13) { a = ctl[CW_TS + 22]; b = ctl[CW_TS + 1]; }
        float frac = fminf((float)(b - a) * (1.0f / 40000.0f), 1.0f); if (PROBE_TS == 99) frac = 0.5f;
        if (PROBE_TS >= 14 && PROBE_TS <= 19) {
            a = ctl[CW_TS + 2]; unsigned mx = 0, mn = 0xffffffffu;
            const int base_ = (PROBE_TS <= 15) ? 64 : 320, lo_ = (PROBE_TS <= 16) ? 0 : 128, hi_ = (PROBE_TS <= 16) ? 128 : 256;
            for (int w = lo_; w < hi_; ++w) { const unsigned d_ = ctl[CW_TS + base_ + w] - a; mx = d_ > mx ? d_ : mx; mn = d_ < mn ? d_ : mn; }
            b = a + ((PROBE_TS == 15 || PROBE_TS == 18) ? mn : mx); }
        if (PROBE_TS >= 100) { a = ctl[CW_TS + PROBE_TS - 100]; b = ctl[CW_TS + PROBE_TS - 99]; }
        if ((PROBE_TS >= 14 && PROBE_TS <= 19) || PROBE_TS >= 100) {
            if (bx == 0 && tid == 0) { const unsigned long long t0_ = __builtin_amdgcn_s_memrealtime(), w_ = 4ull * (unsigned long long)(b - a); while (__builtin_amdgcn_s_memrealtime() - t0_ < w_) __builtin_amdgcn_s_sleep(8); }
            frac = -1.0f; }
        if (PROBE_TS == 0 || (PROBE_TS >= 10 && PROBE_TS <= 13)) { oscale = 1.0f + sqrtf(0.0012f + 0.0018f * frac); } else
        oscale = 1.0f + sqrtf(0.0009f + 0.0033f * frac);
        if (frac < 0.f) oscale = 1.0f;
    }
    if (PROBE_TS == 9) {
        if (bx == 0 && tid == 0) ctl[CW_TS + 30] = (unsigned)__builtin_amdgcn_s_memrealtime();
        combine_phase(misc, h2b, out, rows, tke, tkpos, vcu * NWAVES + wave, G * NWAVES, lane, 1.0f, 0, NTOK / 2);
        xcd_barrier(bar);
        if (bx == 0 && tid == 0) ctl[CW_TS + 31] = (unsigned)__builtin_amdgcn_s_memrealtime();
        xcd_barrier(bar);
        const float frac = fminf((float)(ctl[CW_TS + 31] - ctl[CW_TS + 30]) * (1.0f / 40000.0f), 1.0f);
        combine_phase(misc, h2b, out, rows, tke, tkpos, vcu * NWAVES + wave, G * NWAVES, lane, 1.0f + sqrtf(0.0024f + 0.0036f * frac), NTOK / 2, NTOK);
    } else
    if (IN(9)) combine_phase(misc, h2b, out, rows, tke, tkpos, vcu * NWAVES + wave, G * NWAVES, lane, oscale);
#undef IN
#undef BOTH
#undef GRID_BAR
}

extern "C" void kernel_launch(void* const* d_in, const int* in_sizes, int n_in, void* d_out, int out_size, void* d_ws, size_t ws_size, hipStream_t stream) {
    static int grid = 0;
    if (grid == 0) {
        if (n_in != 17 || in_sizes[0] != NTOK * D || out_size != NTOK * D || ws_size < WS_END) {
            fprintf(stderr, "kernel_launch: unexpected shapes (n_in %d in0 %d out %d ws %zu)\n", n_in, n_in > 0 ? in_sizes[0] : -1, out_size, ws_size); grid = -1; return; }
        int dev = 0, cus = 0;
        if (hipGetDevice(&dev) != hipSuccess || hipDeviceGetAttribute(&cus, hipDeviceAttributeMultiprocessorCount, dev) != hipSuccess) { grid = -1; return; }
        if (hipFuncSetAttribute((const void*)mk_fwd, hipFuncAttributeMaxDynamicSharedMemorySize, LDS_BYTES) != hipSuccess) { fprintf(stderr, "kernel_launch: hipFuncSetAttribute failed\n"); grid = -1; return; }
        grid = cus;
    }
    if (grid < 0) return;
    unsigned char* ws = (unsigned char*)d_ws;
    (void)hipMemsetAsync(ws + WS_CTL, 0, 32768, stream);
#if defined(PROBE_PHASE) && PROBE_PHASE == 302
    (void)hipMemsetAsync(ws + WS_CTL + 65536, 0, 32768, stream);
#endif
    Args a{};
    for (int i = 0; i < 17; ++i) a.in[i] = (const float*)d_in[i];
    a.out = (float*)d_out; a.ws = ws; a.ph_lo = 0; a.ph_hi = 10; a.li = 0; a.pad = 0;
    hipLaunchKernelGGL(mk_fwd, dim3(grid), dim3(512), LDS_BYTES, stream, a);
}
```

```cpp
#include <hip/hip_runtime.h>
#include <cstdio>
#include <cstdint>

typedef unsigned short bf16;
__device__ __forceinline__ float bf2f(bf16 v) { return __uint_as_float(((unsigned)v) << 16); }
__device__ __forceinline__ bf16 f2bf(float f) { const __bf16 b = (__bf16)f; return __builtin_bit_cast(unsigned short, b); }
__device__ __forceinline__ float sigmoidf_(float x) { return __builtin_amdgcn_rcpf(1.0f + __builtin_amdgcn_exp2f(-1.4426950408889634f * x)); }

constexpr int NB = 8, SEQ = 4096, D = 1024, NTOK = NB * SEQ;
constexpr int NMETA = 16;
constexpr int INW = 6400;
constexpr int C_AQ = 0, C_AK = 1024, C_AV = 1152, C_RQ = 1280, C_RK = 1792, C_RV = 2304, C_RG = 3328, C_GA = 4352, C_GR = 5376;
constexpr int NE = 32, TOPK = 4, DFF = 1024;
constexpr int NROWS = (NTOK * TOPK / 256 + NE) * 256;
constexpr int NTILE = NROWS / 256;
constexpr float EPS = 1e-5f;

constexpr size_t MiB = 1u << 20;
constexpr size_t WS_CTL = 0;
constexpr size_t WS_SMALL = 1 * MiB;
constexpr size_t WS_W = 16 * MiB;
constexpr size_t WS_XB = 232 * MiB;
constexpr size_t WS_PROJ = 297 * MiB;
constexpr size_t WS_YATT = 701 * MiB;
constexpr size_t WS_YRET = 765 * MiB;
constexpr size_t WS_MERGED = 829 * MiB;
constexpr size_t WS_END = 1022 * MiB;
constexpr size_t WS_ACT = 297 * MiB;
constexpr size_t WS_ROWS = 568 * MiB;
constexpr size_t SM_UMETA = WS_SMALL;
constexpr size_t SM_PMETA = WS_SMALL + 64 * 1024;
constexpr size_t SM_TKE = WS_SMALL + 512 * 1024;
constexpr size_t SM_TKW = SM_TKE + 512 * 1024;
constexpr size_t SM_TKPOS = SM_TKW + 512 * 1024;
constexpr size_t SM_TKROW = SM_TKPOS + 512 * 1024;
constexpr size_t SM_ROWTOK = SM_TKROW + 512 * 1024;
constexpr size_t SM_ROWW = SM_ROWTOK + 1024 * 1024;
constexpr size_t SM_TILEE = SM_ROWW + 1024 * 1024;
constexpr int CW_CNT = 1024;

#ifndef PROBE_TS
#define PROBE_TS (-1)
#endif
#ifndef PROBE_PHASE
#define PROBE_PHASE (-1)
#endif
#define LAS __attribute__((address_space(3)))
#define GAS __attribute__((address_space(1)))
typedef short bf16x8 __attribute__((ext_vector_type(8)));
typedef float f32x4 __attribute__((ext_vector_type(4)));
typedef float f32x2 __attribute__((ext_vector_type(2)));
typedef unsigned u32x4 __attribute__((ext_vector_type(4)));
typedef unsigned u32x2 __attribute__((ext_vector_type(2)));
#define LDS_WAIT() asm volatile("s_waitcnt lgkmcnt(0)" ::: "memory")
#define VM_WAIT() asm volatile("s_waitcnt vmcnt(0)" ::: "memory")
typedef __bf16 bf16x2_t __attribute__((ext_vector_type(2)));
__device__ __forceinline__ unsigned pk2(float lo, float hi) { const f32x2 v = {lo, hi}; const bf16x2_t b = __builtin_convertvector(v, bf16x2_t); return __builtin_bit_cast(unsigned, b); }
__device__ __forceinline__ unsigned pk4_fp8(float a, float b, float c, float d) { int w = __builtin_amdgcn_cvt_pk_fp8_f32(a, b, 0, false); w = __builtin_amdgcn_cvt_pk_fp8_f32(c, d, w, true); return (unsigned)w; }
constexpr float W8_SCALE = 64.0f, W8_INV = 1.0f / 64.0f;
constexpr float ROW8_SCALE = 16.0f, ROW8_INV = 1.0f / 16.0f;
constexpr float XB8_SCALE = 8.0f, XB8_INV = 1.0f / 8.0f;
constexpr int T8 = 17;
__device__ __forceinline__ u32x4 pack8(const f32x4& a, const f32x4& b) { u32x4 w; w.x = pk2(a[0], a[1]); w.y = pk2(a[2], a[3]); w.z = pk2(b[0], b[1]); w.w = pk2(b[2], b[3]); return w; }
__device__ __forceinline__ void unpack8(const u32x4& w, float (&f)[8]) {
    f[0] = __uint_as_float(w.x << 16); f[1] = __uint_as_float(w.x & 0xffff0000u); f[2] = __uint_as_float(w.y << 16); f[3] = __uint_as_float(w.y & 0xffff0000u);
    f[4] = __uint_as_float(w.z << 16); f[5] = __uint_as_float(w.z & 0xffff0000u); f[6] = __uint_as_float(w.w << 16); f[7] = __uint_as_float(w.w & 0xffff0000u);
}
__device__ __forceinline__ float wave_sum(float v) {
#pragma unroll
    for (int o = 1; o < 64; o <<= 1) v += __shfl_xor(v, o);
    return v;
}

constexpr size_t WS_WIN = WS_W;
constexpr size_t WS_WAB = WS_W + 13 * MiB;
constexpr size_t WS_WRB = WS_W + 15 * MiB;
constexpr size_t WS_WOUT = WS_W + 17 * MiB;
constexpr size_t WS_WGU = WS_W + 19 * MiB;
constexpr size_t WS_WDN = WS_W + 147 * MiB;
static_assert(WS_WDN + 64 * MiB <= WS_XB, "weight map");
constexpr size_t SM_ATILE = SM_TILEE + 4096;
constexpr int CW_NACT = 1088;
constexpr int CW_BAR = 4096;

constexpr int RING_BYTES = 131072;
constexpr int MISC_OFF = RING_BYTES;
constexpr int LDS_BYTES = 163840;
constexpr int NWAVES = 8;

#define XB_TMO      128
#define XB_XCNT(j)  (256  + 64 * (j))
#define XB_XSUB(j)  (1280 + 64 * (j))
#define XB_XGEN(j)  (2304 + 64 * (j))
#define XB_TOP      3328
#define XB_TOPGEN   3392
#define XCD_BAR_WORDS 3456
#define XB_SPIN_CAP (1u << 20)
__device__ __forceinline__ unsigned xb_ld(unsigned* p)              { return __hip_atomic_load(p, __ATOMIC_RELAXED, __HIP_MEMORY_SCOPE_AGENT); }
__device__ __forceinline__ unsigned xb_add(unsigned* p, unsigned v) { return __hip_atomic_fetch_add(p, v, __ATOMIC_RELAXED, __HIP_MEMORY_SCOPE_AGENT); }
__device__ __forceinline__ unsigned xb_xcc_id() { return (unsigned)__builtin_amdgcn_s_getreg((3 << 11) | 20) & 0xFu; }
#define XB_SPIN(cond, bar) do { unsigned _sp = 0; while (cond) { __builtin_amdgcn_s_sleep(1); \
    if ((++_sp & 255u) == 0u) { if (xb_ld(&(bar)[XB_TMO])) break; if (_sp > XB_SPIN_CAP) { atomicAdd(&(bar)[XB_TMO], 1u); break; } } } } while (0)
struct XcdBarrier { unsigned* bar; unsigned x; volatile LAS unsigned* st; };
__device__ __forceinline__ XcdBarrier xcd_barrier_post(unsigned* bar, volatile LAS unsigned* st) {
    XcdBarrier b; b.bar = bar; b.x = xb_xcc_id(); b.st = st;
    if (threadIdx.x == 0) (void)xb_add(&bar[XB_XCNT(b.x)], 1u);
    return b;
}
__device__ __forceinline__ void xcd_barrier_complete(unsigned* bar, unsigned x, unsigned& nloc, unsigned& nx) {
    const unsigned G = gridDim.x * gridDim.y * gridDim.z;
    unsigned sum, cnt, mine, sp = 0u;
    for (;;) {
        sum = 0u; cnt = 0u; mine = 0u;
#pragma unroll
        for (unsigned j = 0; j < 16; ++j) { const unsigned c = xb_ld(&bar[XB_XCNT(j)]); sum += c; cnt += (c > 0u) ? 1u : 0u; mine = (j == x) ? c : mine; }
        if (sum == G) break;
        __builtin_amdgcn_s_sleep(1);
        if ((++sp & 255u) == 0u) { if (xb_ld(&bar[XB_TMO])) break; if (sp > XB_SPIN_CAP) { atomicAdd(&bar[XB_TMO], 1u); break; } }
    }
    nloc = mine > 0u ? mine : 1u; nx = cnt > 0u ? cnt : 1u;
}
__device__ __forceinline__ void xcd_barrier(const XcdBarrier& b) {
    asm volatile("s_waitcnt vmcnt(0)" ::: "memory");
    __syncthreads();
    if (threadIdx.x == 0) {
        unsigned* bar = b.bar;
        __builtin_amdgcn_s_waitcnt(0);
        unsigned nloc = b.st[0], nx = b.st[1];
        if (nloc == 0u) { xcd_barrier_complete(bar, b.x, nloc, nx); b.st[0] = nloc; b.st[1] = nx; }
        const unsigned old = xb_add(&bar[XB_XSUB(b.x)], 1u);
        const unsigned gen = old / nloc;
        if (old + 1u == (gen + 1u) * nloc) {
            __builtin_amdgcn_fence(__ATOMIC_RELEASE, "agent");
            asm volatile("s_waitcnt vmcnt(0)" ::: "memory");
            const unsigned og = xb_add(&bar[XB_TOP], 1u);
            const unsigned tg = og / nx;
            if (og + 1u == (tg + 1u) * nx) xb_add(&bar[XB_TOPGEN], 1u);
            else XB_SPIN(xb_ld(&bar[XB_TOPGEN]) == tg, bar);
            __builtin_amdgcn_fence(__ATOMIC_ACQUIRE, "agent");
            xb_add(&bar[XB_XGEN(b.x)], 1u);
            asm volatile("s_waitcnt vmcnt(0)" ::: "memory");
        } else {
            XB_SPIN(xb_ld(&bar[XB_XGEN(b.x)]) == gen, bar);
            __builtin_amdgcn_fence(__ATOMIC_ACQUIRE, "agent");
            asm volatile("s_waitcnt vmcnt(0)" ::: "memory");
        }
    }
    __syncthreads();
}

namespace pg8 {
constexpr int BM = 256, BK = 64, HALF = 128, HTB = HALF * BK * 2, STAGE_BYTES = 8 * HTB;
__host__ __device__ __forceinline__ int lds_byte(int r, int c) { const int st = (r >> 4) * 2 + (c >> 5), rr = r & 15, cc = c & 31, ob = rr * 64 + cc * 2; return st * 1024 + (ob ^ (((ob >> 9) & 1) << 5)); }
__host__ __device__ __forceinline__ void stage_rc(int b, int& R, int& C) { const int st = b / 1024, sb = b % 1024, swz = sb ^ (((sb >> 9) & 1) << 5); R = (st >> 1) * 16 + swz / 64; C = (st & 1) * 32 + (swz % 64) / 2; }
__host__ __device__ __forceinline__ int perm32(int rho) { const int n = rho >> 4, i = rho & 15; return 8 * (i >> 2) + 4 * n + (i & 3); }
struct Unit { int pm, pn, aux, tl; const char* A; const char* B; int rot = 0; };
template <class S> struct sched_rot { static constexpr bool value = false; };
typedef f32x4 Acc[2][2][4][2];
typedef int u32x4_i __attribute__((ext_vector_type(4)));

typedef int v8i32 __attribute__((ext_vector_type(8)));
template <class Epi, class Sched, bool FP8 = false>
__device__ __forceinline__ void gemm_phase(LAS unsigned char* lds, const int Kb, const Sched& S, const Epi& E, unsigned* pg8_tacc = nullptr) {
    const int tid = threadIdx.x, wid = __builtin_amdgcn_readfirstlane(tid >> 6), lane = tid & 63, wr = wid >> 2, wc = wid & 3, fr = lane & 15, fq = lane >> 4;
    const int nt = Sched::SEG ? 2 * Sched::SEG : Kb / 128;
    int RA[2], CA[2]; unsigned voffB[2];
#pragma unroll
    for (int i = 0; i < 2; ++i) { int R, C; stage_rc(tid * 16 + i * 8192, R, C); const int Rb = Epi::PERM ? ((R & ~31) + perm32(R & 31)) : R;
        RA[i] = R; CA[i] = C; voffB[i] = (unsigned)(Rb * Kb + C * 2); }
    const size_t kstep = (size_t)(BK * 2);
    const size_t hstep = (size_t)HALF * Kb;
    const unsigned ldsw = (unsigned)wid * 1024u;
    const int aoff = lds_byte(wr * 64 + fr, fq * 8), boff = lds_byte(wc * 32 + fr, fq * 8);
#define PG8_SA(b, h) (((b) * 2 + (h)) * HTB)
#define PG8_SB(b, h) ((4 + (b) * 2 + (h)) * HTB)
#define PG8_STAGE(bufoff, gbase, voff) do { _Pragma("unroll") for (int _i = 0; _i < 2; ++_i) \
        __builtin_amdgcn_global_load_lds((const unsigned*)((const char*)(gbase) + (voff)[_i]), (LAS unsigned*)(lds + (bufoff) + ldsw + _i * 8192), 16, 0, 0); } while (0)
#define PG8_LDA(dst, b, h) do { _Pragma("unroll") for (int m = 0; m < 4; ++m) _Pragma("unroll") for (int k = 0; k < 2; ++k) dst[m][k] = *(const LAS bf16x8*)(lds + PG8_SA(b, h) + aoff + m * 2048 + k * 1024); } while (0)
#define PG8_LDB(dst, b, h) do { _Pragma("unroll") for (int n = 0; n < 2; ++n) _Pragma("unroll") for (int k = 0; k < 2; ++k) dst[n][k] = *(const LAS bf16x8*)(lds + PG8_SB(b, h) + boff + n * 2048 + k * 1024); } while (0)
#define PG8_MMA(ai, bj, At, Bt) do { __builtin_amdgcn_s_setprio(1); _Pragma("unroll") for (int m = 0; m < 4; ++m) _Pragma("unroll") for (int n = 0; n < 2; ++n) { \
        if constexpr (FP8) { const v8i32 bq = __builtin_shufflevector(__builtin_bit_cast(u32x4_i, Bt[n][0]), __builtin_bit_cast(u32x4_i, Bt[n][1]), 0, 1, 2, 3, 4, 5, 6, 7), \
                                         aq = __builtin_shufflevector(__builtin_bit_cast(u32x4_i, At[m][0]), __builtin_bit_cast(u32x4_i, At[m][1]), 0, 1, 2, 3, 4, 5, 6, 7); \
            asm volatile("v_mfma_scale_f32_16x16x128_f8f6f4 %0, %1, %2, %0, %3, %3 op_sel_hi:[0,0,0]" : "+v"(acc[ai][bj][m][n]) : "v"(bq), "v"(aq), "v"(scale1)); } \
        else { _Pragma("unroll") for (int k = 0; k < 2; ++k) acc[ai][bj][m][n] = __builtin_amdgcn_mfma_f32_16x16x32_bf16(Bt[n][k], At[m][k], acc[ai][bj][m][n], 0, 0, 0); } } \
        __builtin_amdgcn_s_setprio(0); } while (0)
#define PG8_WAIT_V(n) asm volatile("s_waitcnt vmcnt(" #n ")" ::: "memory")
#define PG8_WAIT_L(n) asm volatile("s_waitcnt lgkmcnt(" #n ")" ::: "memory")
#define PG8_BAR __builtin_amdgcn_s_barrier()
#define PG8_SCHED __builtin_amdgcn_sched_barrier(0)
    int scale1 = 0x7f7f7f7f; asm volatile("" : "+v"(scale1));
    Unit cur, nxt; int ui = 0;
    if (!S.next(0, cur)) return;
    unsigned ca[2][2], na[2][2];
    S.aoff(cur, RA, CA, ca);
    f32x4 acc[2][2][4][2];
#pragma unroll
    for (int a = 0; a < 2; ++a)
#pragma unroll
        for (int b = 0; b < 2; ++b)
#pragma unroll
            for (int m = 0; m < 4; ++m)
#pragma unroll
                for (int n = 0; n < 2; ++n) acc[a][b][m][n] = (f32x4){0.f, 0.f, 0.f, 0.f};
    bf16x8 At[4][2], B0[2][2], B1[2][2];
    const char* cA = cur.A; const char* cB = cur.B;
    E.prefetch(cur, 0, wid, lane);
    constexpr bool ROT = sched_rot<Sched>::value;
    constexpr int RSEG = Sched::SEG;
    const int rmask = (RSEG ? RSEG : nt) - 1; int crot = ROT ? cur.rot : 0;
#define PG8_KO(tau, rot) ((size_t)(((tau) + (rot)) & rmask) * kstep)
#define PG8_KOA(tau, rot) (PG8_KO(tau, rot) + ((RSEG && (tau) >= RSEG) ? S.dA + (size_t)RSEG * kstep : (size_t)0))
#define PG8_KOB(tau, rot) (PG8_KO(tau, rot) + ((RSEG && (tau) >= RSEG) ? S.dB + (size_t)RSEG * kstep : (size_t)0))
    { const size_t k0_ = ROT ? PG8_KO(0, crot) : 0;
    PG8_STAGE(PG8_SB(0, 0), cB + k0_, voffB); PG8_STAGE(PG8_SB(0, 1), cB + hstep + k0_, voffB); PG8_STAGE(PG8_SA(0, 0), cA + k0_, ca[0]); PG8_STAGE(PG8_SA(0, 1), cA + k0_, ca[1]); }
    if (wr == 1) PG8_BAR;
    PG8_WAIT_V(2); PG8_BAR;
    { const size_t k1_ = ROT ? PG8_KO(1, crot) : kstep;
    PG8_STAGE(PG8_SB(1, 0), cB + k1_, voffB); PG8_STAGE(PG8_SA(1, 0), cA + k1_, ca[0]); PG8_STAGE(PG8_SB(1, 1), cB + hstep + k1_, voffB); }
    PG8_WAIT_V(6); PG8_BAR;
    for (;;) {
        const bool has_next = S.next(ui + 1, nxt);
        if constexpr (Sched::GATHER) {
            if (has_next) S.aoff(nxt, RA, CA, na);
            else {
#pragma unroll
                for (int h = 0; h < 2; ++h)
#pragma unroll
                    for (int i = 0; i < 2; ++i) na[h][i] = ca[h][i];
            }
        }
        const char* nA = has_next ? nxt.A : cA; const char* nB = has_next ? nxt.B : cB;
        const int nrot = ROT ? (has_next ? nxt.rot : crot) : 0;
#pragma nounroll
        for (int t = 0; t < nt; t += 2) {
            const bool last = (t == nt - 2);
            if constexpr (Sched::SEG > 0) { if (t == Sched::SEG) { int fr_ = fr, fq_ = fq; asm volatile("" : "+v"(fr_), "+v"(fq_));
                unsigned long long tm0_ = 0; if (PROBE_TS >= 0) tm0_ = __builtin_amdgcn_s_memtime();
                E.mid(acc, cur, wr, wc, fr_, fq_);
                if (PROBE_TS >= 0) { asm volatile("s_waitcnt vmcnt(0)" ::: "memory"); if (pg8_tacc) pg8_tacc[0] += (unsigned)(__builtin_amdgcn_s_memtime() - tm0_); } } }
            const size_t sA1 = (Sched::SEG && t + 1 >= Sched::SEG) ? S.dA : 0, sA2 = (Sched::SEG && t + 2 >= Sched::SEG) ? S.dA : 0, sB2 = (Sched::SEG && t + 2 >= Sched::SEG) ? S.dB : 0;
            const char* a1; const char* a2; const char* b2; const char* a3; const char* b3;
            if constexpr (ROT) {
                a1 = cA + PG8_KOA(t + 1, crot);
                a2 = last ? nA + PG8_KO(0, nrot) : cA + PG8_KOA(t + 2, crot); b2 = last ? nB + PG8_KO(0, nrot) : cB + PG8_KOB(t + 2, crot);
                a3 = last ? nA + PG8_KO(1, nrot) : cA + PG8_KOA(t + 3, crot); b3 = last ? nB + PG8_KO(1, nrot) : cB + PG8_KOB(t + 3, crot);
            } else {
                a1 = cA + (size_t)(t + 1) * kstep + sA1;
                a2 = last ? nA : cA + (size_t)(t + 2) * kstep + sA2; b2 = last ? nB : cB + (size_t)(t + 2) * kstep + sB2;
                a3 = a2 + kstep; b3 = b2 + kstep;
            }
            unsigned o2[2][2];
#pragma unroll
            for (int h = 0; h < 2; ++h)
#pragma unroll
                for (int i = 0; i < 2; ++i) { if constexpr (Sched::GATHER) o2[h][i] = last ? na[h][i] : ca[h][i]; else o2[h][i] = ca[h][i]; }
            PG8_LDB(B0, 0, 0); PG8_LDB(B1, 0, 1); PG8_SCHED; PG8_LDA(At, 0, 0); PG8_STAGE(PG8_SA(1, 1), a1, ca[1]);
            PG8_WAIT_V(8); PG8_WAIT_L(0); PG8_BAR; PG8_MMA(0, 0, At, B0); PG8_MMA(0, 1, At, B1); PG8_BAR; PG8_SCHED;
            PG8_LDA(At, 0, 1); PG8_STAGE(PG8_SB(0, 0), b2, voffB); PG8_STAGE(PG8_SB(0, 1), b2 + hstep, voffB); PG8_STAGE(PG8_SA(0, 0), a2, o2[0]);
            PG8_WAIT_V(8); PG8_WAIT_L(0); PG8_BAR; PG8_MMA(1, 0, At, B0); PG8_MMA(1, 1, At, B1); PG8_BAR; PG8_SCHED;
            PG8_LDB(B0, 1, 0); PG8_LDB(B1, 1, 1); PG8_SCHED; PG8_LDA(At, 1, 0); PG8_STAGE(PG8_SA(0, 1), a2, o2[1]);
            PG8_WAIT_V(8); PG8_WAIT_L(0); PG8_BAR; PG8_MMA(0, 0, At, B0); PG8_MMA(0, 1, At, B1); PG8_BAR; PG8_SCHED;
            PG8_LDA(At, 1, 1); PG8_STAGE(PG8_SB(1, 0), b3, voffB); PG8_STAGE(PG8_SB(1, 1), b3 + hstep, voffB); PG8_STAGE(PG8_SA(1, 0), a3, o2[0]);
            PG8_WAIT_V(8); PG8_WAIT_L(0); PG8_BAR; PG8_MMA(1, 0, At, B0); PG8_MMA(1, 1, At, B1); PG8_BAR; PG8_SCHED;
        }
        if constexpr (FP8) { asm volatile("s_nop 15\n\ts_nop 15\n\ts_nop 15" ::: "memory"); PG8_SCHED; }
        if (wr == 0) PG8_BAR;
        { int fr_ = fr, fq_ = fq; asm volatile("" : "+v"(fr_), "+v"(fq_));
          unsigned long long te0_ = 0; if (PROBE_TS >= 0 && Sched::SEG > 0) te0_ = __builtin_amdgcn_s_memtime();
          E(acc, cur, wr, wc, fr_, fq_, ui & 1);
          if (PROBE_TS >= 0 && Sched::SEG > 0) { if (pg8_tacc) pg8_tacc[1] += (unsigned)(__builtin_amdgcn_s_memtime() - te0_); }
          if (PROBE_PHASE == 50) E(acc, cur, wr, wc, fr_, fq_, ui & 1); }
        if (!has_next) break;
#pragma unroll
        for (int a = 0; a < 2; ++a)
#pragma unroll
            for (int b = 0; b < 2; ++b)
#pragma unroll
                for (int m = 0; m < 4; ++m)
#pragma unroll
                    for (int n = 0; n < 2; ++n) acc[a][b][m][n] = (f32x4){0.f, 0.f, 0.f, 0.f};
        cur = nxt; cA = nA; cB = nB; crot = nrot; ++ui;
        E.prefetch(cur, ui & 1, wid, lane);
        if constexpr (Sched::GATHER) {
#pragma unroll
            for (int h = 0; h < 2; ++h)
#pragma unroll
                for (int i = 0; i < 2; ++i) ca[h][i] = na[h][i];
        }
        if (wr == 1) PG8_BAR;
    }
    PG8_WAIT_V(0);
    PG8_BAR;
#undef PG8_KO
#undef PG8_KOA
#undef PG8_KOB
#undef PG8_SA
#undef PG8_SB
#undef PG8_STAGE
#undef PG8_LDA
#undef PG8_LDB
#undef PG8_MMA
#undef PG8_WAIT_V
#undef PG8_WAIT_L
#undef PG8_BAR
#undef PG8_SCHED
}
}
#ifndef PROBE_PHASE
#define PROBE_PHASE (-1)
#endif
constexpr int CNT_STRIDE = 32, CW_CNTS = 2048;
constexpr size_t SM_LIST = WS_SMALL + 2 * MiB;
constexpr size_t SM_WLIST = WS_SMALL + 6 * MiB;
constexpr size_t SM_RLIST = WS_SMALL + 10 * MiB;
constexpr int MT_PSTART = 256;
constexpr int MT_CNT = 512;
constexpr int MT_NACT = 768;
constexpr int MT_ATILE = 1024;
constexpr int MT_HIST = 4096;
constexpr int MT_BASE = 4224;
constexpr int MT_REC = 4352;
constexpr int MT_RSTD = 10496;
constexpr int MT_EPI = 11264;
constexpr int MT_EPI2 = 13312;
constexpr int MT_GAIN = 15360;
constexpr int MT_XCH = 16384;

__device__ __forceinline__ void moe_tables(LAS unsigned char* misc, const unsigned* cnt) {
    LAS int* pstart = (LAS int*)(misc + MT_PSTART); LAS int* cl = (LAS int*)(misc + MT_CNT); LAS int* at = (LAS int*)(misc + MT_ATILE);
    __syncthreads();
    if (threadIdx.x < 64) {
        const int lane = threadIdx.x, e = lane & 31;
        const int c = (int)__hip_atomic_load(cnt + e * CNT_STRIDE, __ATOMIC_RELAXED, __HIP_MEMORY_SCOPE_AGENT), nt = (c + 255) >> 8;
        int incl = nt;
#pragma unroll
        for (int o = 1; o < 32; o <<= 1) { const int v = __shfl_up(incl, o); if (e >= o) incl += v; }
        const int t0 = incl - nt;
        if (lane < 32) { cl[e] = c; pstart[e] = t0 << 8; for (int t = 0; t < nt; ++t) at[t0 + t] = (t0 + t) | (e << 12) | (t << 20);
            if (e == 31) { pstart[NE] = incl << 8; *(LAS int*)(misc + MT_NACT) = incl; } }
    }
    __syncthreads();
}

__device__ __forceinline__ void route_images(LAS unsigned char* lds, const float* __restrict__ g2, const float* __restrict__ wr) {
    const int tid = threadIdx.x;
    for (int idx = tid; idx < 128 * 32; idx += 512) {
        const int c = idx >> 5, e = idx & 31; float v[8]; unsigned hw[4], lw[4];
#pragma unroll
        for (int j = 0; j < 8; ++j) v[j] = wr[(size_t)(8 * c + j) * NE + e] * g2[8 * c + j];
#pragma unroll
        for (int j = 0; j < 4; ++j) { hw[j] = pk2(v[2 * j], v[2 * j + 1]); lw[j] = pk2(v[2 * j] - __uint_as_float(hw[j] << 16), v[2 * j + 1] - __uint_as_float(hw[j] & 0xffff0000u)); }
        *(LAS u32x4*)(lds + idx * 16) = (u32x4){hw[0], hw[1], hw[2], hw[3]};
        *(LAS u32x4*)(lds + 65536 + idx * 16) = (u32x4){lw[0], lw[1], lw[2], lw[3]};
    }
    __syncthreads();
}
__device__ __forceinline__ void route_phase(LAS unsigned char* lds, const bf16* __restrict__ h2, const float* __restrict__ g2, const float* __restrict__ wr, const float* __restrict__ br,
                                            unsigned char* __restrict__ xg8, int* __restrict__ tke, int* __restrict__ tkpos, float* __restrict__ tkw, int* __restrict__ list, float* __restrict__ wlist,
                                            float* __restrict__ rlist, unsigned* __restrict__ cnt, int G, int bx) {
    typedef float f32x16 __attribute__((ext_vector_type(16)));
    const int tid = threadIdx.x, lane = tid & 63, r32 = lane & 31, hi = lane >> 5; const int wave = __builtin_amdgcn_readfirstlane(tid >> 6);
    LAS unsigned char* misc = lds + MISC_OFF;
    LAS int* hist = (LAS int*)(misc + MT_HIST); LAS int* base = (LAS int*)(misc + MT_BASE); LAS int* rec = (LAS int*)(misc + MT_REC); LAS float* rstd_l = (LAS float*)(misc + MT_RSTD);
    const int tile = wave & 3, kh = wave >> 2;
    for (int tb = bx; tb < NTOK / 128; tb += G) {
        if (tid < 32) hist[tid] = 0;
        __syncthreads();
        {
        const int token = tb * 128 + tile * 32 + r32;
        const bf16* xp = h2 + (size_t)token * D + kh * 512 + 8 * hi;
        unsigned char* x8p = xg8 + (size_t)token * D + kh * 512 + 8 * hi;
        const float* gp = g2 + kh * 512 + 8 * hi;
        f32x16 c = {};
        float ss = 0.f;
        constexpr int RD = 8;
        u32x4 xa[RD];
#pragma unroll
        for (int p = 0; p < RD; ++p) xa[p] = *(const u32x4*)(xp + 16 * p);
#pragma unroll 1
        for (int ks0 = 0; ks0 < 32; ks0 += RD) {
#pragma unroll
            for (int p = 0; p < RD; ++p) {
                const int ks = ks0 + p;
                float xf[8]; unpack8(xa[p], xf); const f32x4 x0 = {xf[0], xf[1], xf[2], xf[3]}, x1 = {xf[4], xf[5], xf[6], xf[7]};
                const u32x4 xh = xa[p];
                if (ks + RD < 32) xa[p] = *(const u32x4*)(xp + 16 * (ks + RD));
                ss += (x0[0] * x0[0] + x0[1] * x0[1]) + (x0[2] * x0[2] + x0[3] * x0[3]) + (x1[0] * x1[0] + x1[1] * x1[1]) + (x1[2] * x1[2] + x1[3] * x1[3]);
                { const f32x4 g0 = *(const f32x4*)(gp + 16 * ks), g1 = *(const f32x4*)(gp + 16 * ks + 4);
                  u32x2 w8; w8.x = pk4_fp8(x0[0] * g0[0], x0[1] * g0[1], x0[2] * g0[2], x0[3] * g0[3]); w8.y = pk4_fp8(x1[0] * g1[0], x1[1] * g1[1], x1[2] * g1[2], x1[3] * g1[3]);
                  *(u32x2*)(x8p + 16 * ks) = w8; }
                const int chunk = kh * 64 + 2 * ks + hi;
                const bf16x8 wh = *(const LAS bf16x8*)(lds + (chunk * 32 + r32) * 16), wl = *(const LAS bf16x8*)(lds + 65536 + (chunk * 32 + r32) * 16);
                c = __builtin_amdgcn_mfma_f32_32x32x16_bf16(wh, __builtin_bit_cast(bf16x8, xh), c, 0, 0, 0);
                c = __builtin_amdgcn_mfma_f32_32x32x16_bf16(wl, __builtin_bit_cast(bf16x8, xh), c, 0, 0, 0);
            }
        }
        LAS float* px = (LAS float*)(misc + MT_XCH);
        LAS float* sx = (LAS float*)(misc + MT_REC + tile * 1536);
        if (kh == 1) {
#pragma unroll
            for (int r = 0; r < 16; ++r) px[(tile * 16 + r) * 64 + lane] = c[r];
            sx[lane] = ss;
        }
        __syncthreads();
        if (kh == 0) {
#pragma unroll
            for (int r = 0; r < 16; ++r) c[r] += px[(tile * 16 + r) * 64 + lane];
            ss += sx[lane];
            ss += __shfl_xor(ss, 32);
            const float rstd = rsqrtf(ss * (1.0f / D) + EPS);
            float vals[16];
#pragma unroll
            for (int r = 0; r < 16; ++r) vals[r] = c[r] * rstd + br[(r & 3) + 8 * (r >> 2) + 4 * hi];
            float tv[4]; int te[4];
#pragma unroll
            for (int k = 0; k < 4; ++k) {
                float m = -3.0e38f; int mi = 0;
#pragma unroll
                for (int r = 0; r < 16; ++r) { const bool gt = vals[r] > m; m = gt ? vals[r] : m; mi = gt ? r : mi; }
                tv[k] = m; te[k] = (mi & 3) + 8 * (mi >> 2) + 4 * hi;
#pragma unroll
                for (int r = 0; r < 16; ++r) vals[r] = (r == mi) ? -3.0e38f : vals[r];
            }
            float cv[8]; int ce[8];
#pragma unroll
            for (int k = 0; k < 4; ++k) { cv[k] = tv[k]; ce[k] = te[k]; cv[4 + k] = __shfl_xor(tv[k], 32); ce[4 + k] = __shfl_xor(te[k], 32); }
            float fv[4]; int fe[4];
#pragma unroll
            for (int k = 0; k < 4; ++k) {
                float m = -3.0e38f; int me = 64; int mi = 0;
#pragma unroll
                for (int q = 0; q < 8; ++q) { const bool better = (cv[q] > m) || (cv[q] == m && ce[q] < me); m = better ? cv[q] : m; me = better ? ce[q] : me; mi = better ? q : mi; }
                fv[k] = m; fe[k] = me;
#pragma unroll
                for (int q = 0; q < 8; ++q) cv[q] = (q == mi) ? -3.0e38f : cv[q];
            }
            if (hi == 0) {
                const float e0 = 1.0f, e1 = __expf(fv[1] - fv[0]), e2 = __expf(fv[2] - fv[0]), e3 = __expf(fv[3] - fv[0]);
                const float inv = 1.0f / (e0 + e1 + e2 + e3);
                const float wts[4] = {e0 * inv, e1 * inv, e2 * inv, e3 * inv};
                const int tl = tile * 32 + r32;
                rstd_l[tl] = rstd;
#pragma unroll
                for (int k = 0; k < 4; ++k) {
                    const int lp = __hip_atomic_fetch_add(hist + fe[k], 1, __ATOMIC_RELAXED, __HIP_MEMORY_SCOPE_WORKGROUP);
                    LAS int* r = rec + (tl * 4 + k) * 3; r[0] = fe[k]; r[1] = lp; r[2] = __float_as_int(wts[k]);
                }
            }
        }
        }
        __syncthreads();
        if (tid < 32) base[tid] = (int)atomicAdd(&cnt[tid * CNT_STRIDE], (unsigned)hist[tid]);
        __syncthreads();
        { const int tl = tid >> 2; const int tok = tb * 128 + tl; LAS int* r = rec + tid * 3; const int e = r[0], pos = base[e] + r[1]; const float w = __int_as_float(r[2]);
          tke[tok * 4 + (tid & 3)] = e; tkpos[tok * 4 + (tid & 3)] = pos; tkw[tok * 4 + (tid & 3)] = w;
          list[e * NTOK + pos] = tok; wlist[e * NTOK + pos] = w; rlist[e * NTOK + pos] = rstd_l[tl]; }
        __syncthreads();
    }
}

__device__ __forceinline__ void combine_phase(LAS unsigned char* misc, const bf16* __restrict__ h2b, float* __restrict__ out, const unsigned char* __restrict__ rows, const int* __restrict__ tke, const int* __restrict__ tkpos, int gw, int NGW, int lane, float oscale, int tok_lo = 0, int tok_hi = NTOK) {
    LAS const int* pstart = (LAS const int*)(misc + MT_PSTART);
    for (int tok0 = tok_lo + gw; tok0 < tok_hi; tok0 += 2 * NGW) {
        u32x2 hw[2][4]; unsigned rw[2][4][4];
#pragma unroll
        for (int q = 0; q < 2; ++q) { const int token = tok0 + q * NGW; if (token < tok_hi) {
            const u32x2* hp = (const u32x2*)(h2b + (size_t)token * D) + lane;
#pragma unroll
            for (int j = 0; j < 4; ++j) hw[q][j] = __builtin_nontemporal_load(hp + 64 * j);
#pragma unroll
            for (int k = 0; k < 4; ++k) { const int rr = pstart[tke[token * 4 + k]] + tkpos[token * 4 + k]; const unsigned* rp = (const unsigned*)(rows + (size_t)rr * D) + lane;
#pragma unroll
                for (int j = 0; j < 4; ++j) rw[q][k][j] = __builtin_nontemporal_load(rp + 64 * j); } } }
#pragma unroll
        for (int q = 0; q < 2; ++q) { const int token = tok0 + q * NGW; if (token < tok_hi) {
            f32x4* o = (f32x4*)(out + (size_t)token * D) + lane;
#pragma unroll
            for (int j = 0; j < 4; ++j) {
                f32x4 s = {0.f, 0.f, 0.f, 0.f};
#pragma unroll
                for (int k = 0; k < 4; ++k) { const f32x2 lo = __builtin_amdgcn_cvt_pk_f32_fp8((int)rw[q][k][j], false), hh = __builtin_amdgcn_cvt_pk_f32_fp8((int)rw[q][k][j], true); s[0] += lo[0]; s[1] += lo[1]; s[2] += hh[0]; s[3] += hh[1]; }
                const f32x4 v = {__uint_as_float(hw[q][j].x << 16), __uint_as_float(hw[q][j].x & 0xffff0000u), __uint_as_float(hw[q][j].y << 16), __uint_as_float(hw[q][j].y & 0xffff0000u)};
                __builtin_nontemporal_store((v + s * ROW8_INV) * oscale, o + 64 * j);
            } } }
    }
}
struct SchedDense {
    static constexpr bool GATHER = false; static constexpr int SEG = 0; size_t dA = 0, dB = 0; int rev = 0;
    const char* A; const char* Bt; int K, nM, nN, nwg, G, c;
    __device__ void init(const bf16* A_, const bf16* Bt_, int M, int N, int K_, int G_, int c_) { A = (const char*)A_; Bt = (const char*)Bt_; K = K_; nM = M / 256; nN = N / 256; nwg = nM * nN; G = G_; c = c_; }
    __device__ __forceinline__ bool next(int i, pg8::Unit& u) const {
        const long L = (long)i * G + c; if (L >= nwg) return false;
        int wgid = (int)L; { const int q = nwg / 8, r = nwg % 8, xcd = wgid % 8, off = wgid / 8; wgid = (xcd < r ? xcd * (q + 1) : r * (q + 1) + (xcd - r) * q) + off; }
        const int nig = 8 * nN, gid = wgid / nig, fm = gid * 8, gsz = (nM - fm) < 8 ? (nM - fm) : 8;
        u.pm = fm + ((wgid % nig) % gsz); u.pn = (wgid % nig) / gsz; if (rev) u.pn = nN - 1 - u.pn; u.aux = 0; u.tl = 0;
        u.A = A + (size_t)u.pm * 256 * K * 2; u.B = Bt + (size_t)u.pn * 256 * K * 2; return true;
    }
    __device__ __forceinline__ void aoff(const pg8::Unit&, const int (&R)[2], const int (&C)[2], unsigned (&o)[2][2]) const {
#pragma unroll
        for (int h = 0; h < 2; ++h)
#pragma unroll
            for (int i = 0; i < 2; ++i) o[h][i] = (unsigned)((128 * h + R[i]) * K + C[i]) * 2u;
    }
};
struct SchedDense8 : SchedDense {
    __device__ __forceinline__ bool next(int i, pg8::Unit& u) const {
        if (!SchedDense::next(i, u)) return false;
        u.A = A + (size_t)u.pm * 256 * K; u.B = Bt + (size_t)u.pn * 256 * K; return true;
    }
    __device__ __forceinline__ void aoff(const pg8::Unit&, const int (&R)[2], const int (&C)[2], unsigned (&o)[2][2]) const {
#pragma unroll
        for (int h = 0; h < 2; ++h)
#pragma unroll
            for (int i = 0; i < 2; ++i) o[h][i] = (unsigned)((128 * h + R[i]) * K + C[i] * 2);
    }
};
template <int ESZ>
struct SchedRounds : SchedDense {
    int nf, lo1, hi1, n1, lo2, hi2, n2; int pnrot = 0;
    __device__ __forceinline__ bool next(int i, pg8::Unit& u) const {
        int L;
        if (i < nf) L = i * G + c;
        else if (i < nf + n1) { if (c < lo1 || c >= hi1) return false; L = nf * G + (i - nf) * (hi1 - lo1) + (c - lo1); }
        else if (i < nf + n1 + n2) { if (c < lo2 || c >= hi2) return false; L = nf * G + n1 * (hi1 - lo1) + (i - nf - n1) * (hi2 - lo2) + (c - lo2); }
        else return false;
        if (L >= nwg) return false;
        int wgid = L; { const int q = nwg / 8, r = nwg % 8, xcd = wgid % 8, off = wgid / 8; wgid = (xcd < r ? xcd * (q + 1) : r * (q + 1) + (xcd - r) * q) + off; }
        const int nig = 8 * nN, gid = wgid / nig, fm = gid * 8, gsz = (nM - fm) < 8 ? (nM - fm) : 8;
        u.pm = fm + ((wgid % nig) % gsz); u.pn = (wgid % nig) / gsz; u.aux = 0; u.tl = 0;
        if (pnrot) { u.pn += pnrot; if (u.pn >= nN) u.pn -= nN; }
        u.A = A + (size_t)u.pm * 256 * K * ESZ; u.B = Bt + (size_t)u.pn * 256 * K * ESZ; u.rot = u.pn * 2; return true;
    }
    __device__ __forceinline__ void aoff(const pg8::Unit&, const int (&R)[2], const int (&C)[2], unsigned (&o)[2][2]) const {
#pragma unroll
        for (int h = 0; h < 2; ++h)
#pragma unroll
            for (int i = 0; i < 2; ++i) o[h][i] = (unsigned)((128 * h + R[i]) * K * ESZ + C[i] * 2);
    }
};
struct SchedBranch2 : SchedDense { static constexpr int SEG = 16;
    __device__ __forceinline__ bool next(int i, pg8::Unit& u) const { if (!SchedDense::next(i, u)) return false; u.rot = u.pn * 2; return true; } };
template <bool GATHER_, int NPN>
struct SchedMoe {
    static constexpr bool GATHER = GATHER_; static constexpr int SEG = 0; static constexpr size_t dA = 0, dB = 0;
    const char* A; const char* Bt; LAS const unsigned char* misc; const int* list; int G, c;
    __device__ __forceinline__ bool next(int i, pg8::Unit& u) const {
        LAS const int* cl = (LAS const int*)(misc + MT_CNT); LAS const int* ps = (LAS const int*)(misc + MT_PSTART);
        if ((G & 7) == 0) {
            const int x = c & 7, r = c >> 3, n = G >> 3;
            int k = (i * n + r) / NPN; const int pn = (i * n + r) % NPN;
#pragma unroll
            for (int j = 0; j < 4; ++j) { const int e = x + 8 * j, nt = (cl[e] + 255) >> 8;
                if (k < nt) { u.pn = pn; u.aux = e; u.tl = k; u.pm = (ps[e] >> 8) + k; u.rot = pn * (8 / NPN);
                    u.A = GATHER ? A : A + (size_t)u.pm * 256 * 1024; u.B = Bt + ((size_t)e * NPN + pn) * 256 * 1024; return true; }
                k -= nt; }
            return false;
        }
        const int nact = *(LAS const int*)(misc + MT_NACT);
        const int L = i * G + c; if (L >= nact * NPN) return false;
        const int k = L / NPN; u.pn = L % NPN; const int w = ((LAS const int*)(misc + MT_ATILE))[k];
        u.pm = w & 0xfff; u.aux = (w >> 12) & 0xff; u.tl = w >> 20; u.rot = u.pn * (8 / NPN);
        u.A = GATHER ? A : A + (size_t)u.pm * 256 * 1024;
        u.B = Bt + ((size_t)u.aux * NPN + u.pn) * 256 * 1024; return true;
    }
    __device__ __forceinline__ void aoff(const pg8::Unit& u, const int (&R)[2], const int (&C)[2], unsigned (&o)[2][2]) const {
        const int ce = ((LAS const int*)(misc + MT_CNT))[u.aux];
#pragma unroll
        for (int h = 0; h < 2; ++h)
#pragma unroll
            for (int i = 0; i < 2; ++i) {
                if (GATHER) { const int idx = u.tl * 256 + 128 * h + R[i]; const int tok = (idx < ce) ? list[u.aux * NTOK + idx] : 0; o[h][i] = (unsigned)tok * 1024u + (unsigned)C[i] * 2u; }
                else o[h][i] = (unsigned)((128 * h + R[i]) * 1024 + C[i] * 2);
            }
    }
};

struct SchedDenseRot : SchedDense {
    __device__ __forceinline__ bool next(int i, pg8::Unit& u) const { if (!SchedDense::next(i, u)) return false; u.rot = u.pn * 4; return true; }
};
namespace pg8 { template <int NP> struct sched_rot<SchedMoe<false, NP>> { static constexpr bool value = true; }; template <> struct sched_rot<SchedDenseRot> { static constexpr bool value = true; }; }
template <int PN0, bool F8>
struct EpiProjT {
    static constexpr bool PERM = true;
    __device__ __forceinline__ void prefetch(const pg8::Unit&, int, int, int) const {}
    bf16* proj; LAS const float* gtab;
    __device__ __forceinline__ void operator()(pg8::Acc& acc, const pg8::Unit& u, int wr, int wc, int fr, int fq, int slot) const {
        const int pn = u.pn + PN0;
        int mode;
        if (pn < 4) mode = 1; else if (pn == 4) mode = (wc < 2) ? 2 : 0; else if (pn < 7) mode = 0; else if (pn < 9) mode = 3; else if (pn < 13) mode = 0; else if (pn < 17) mode = 4; else mode = 5;
        float gn[2][8];
        if (mode == 1 || mode == 2) { LAS const float* g = gtab + ((mode == 1) ? 0 : 64);
#pragma unroll
            for (int bj = 0; bj < 2; ++bj)
#pragma unroll
                for (int j = 0; j < 8; ++j) gn[bj][j] = g[32 * bj + 8 * fq + j]; }
#pragma unroll
        for (int ai = 0; ai < 2; ++ai)
#pragma unroll
            for (int m = 0; m < 4; ++m) {
                const int r = u.pm * 256 + ai * 128 + wr * 64 + m * 16 + fr;
                bf16* rowp = proj + (size_t)r * INW + pn * 256 + wc * 64 + 8 * fq;
                f32x4 v[2][2];
#pragma unroll
                for (int bj = 0; bj < 2; ++bj) { v[bj][0] = acc[ai][bj][m][0]; v[bj][1] = acc[ai][bj][m][1]; if constexpr (F8) { if (mode != 5) { v[bj][0] = v[bj][0] * (XB8_INV * W8_INV); v[bj][1] = v[bj][1] * (XB8_INV * W8_INV); } } }
                if (mode == 1 || mode == 2) {
                    float ss = 0.f;
#pragma unroll
                    for (int bj = 0; bj < 2; ++bj)
#pragma unroll
                        for (int n = 0; n < 2; ++n) ss += v[bj][n][0] * v[bj][n][0] + v[bj][n][1] * v[bj][n][1] + v[bj][n][2] * v[bj][n][2] + v[bj][n][3] * v[bj][n][3];
                    ss += __shfl_xor(ss, 16); ss += __shfl_xor(ss, 32);
                    const float rs = rsqrtf(ss * (1.0f / 64.0f) + EPS);
#pragma unroll
                    for (int bj = 0; bj < 2; ++bj)
#pragma unroll
                        for (int n = 0; n < 2; ++n)
#pragma unroll
                            for (int i = 0; i < 4; ++i) v[bj][n][i] = v[bj][n][i] * rs * gn[bj][4 * n + i];
                } else if (mode == 3) {
#pragma unroll
                    for (int bj = 0; bj < 2; ++bj)
#pragma unroll
                        for (int n = 0; n < 2; ++n) v[bj][n] = v[bj][n] * 0.08838834764831845f;
                } else if (mode == 4) {
#pragma unroll
                    for (int bj = 0; bj < 2; ++bj)
#pragma unroll
                        for (int n = 0; n < 2; ++n)
#pragma unroll
                            for (int i = 0; i < 4; ++i) { const float x = v[bj][n][i]; v[bj][n][i] = x * sigmoidf_(x); }
                } else if (mode == 5) {
                    const int j = pn - 17;
#pragma unroll
                    for (int n = 0; n < 2; ++n)
#pragma unroll
                        for (int i = 0; i < 4; ++i) {
                            constexpr float K5 = -1.4426950408889634f * (F8 ? XB8_INV * W8_INV : 1.0f);
                            const float ea = __builtin_amdgcn_exp2f(K5 * v[0][n][i]), er = fminf(__builtin_amdgcn_exp2f(K5 * v[1][n][i]), 1e20f);
                            v[0][n][i] = (1.0f + er) * __builtin_amdgcn_rcpf(1.0f + ea); v[1][n][i] = __builtin_amdgcn_rcpf(1.0f + er);
                        }
                    bf16* gp = proj + (size_t)r * INW + 128 * j + 32 * wc + 8 * fq;
                    *(u32x4*)(gp + C_GA) = pack8(v[0][0], v[0][1]); *(u32x4*)(gp + C_GR) = pack8(v[1][0], v[1][1]);
                    continue;
                }
#pragma unroll
                for (int bj = 0; bj < 2; ++bj) *(u32x4*)(rowp + 32 * bj) = pack8(v[bj][0], v[bj][1]);
            }
    }
};
struct EpiBranch2 {
    static constexpr bool PERM = true;
    __device__ __forceinline__ void prefetch(const pg8::Unit&, int, int, int) const {}
    bf16* merged; const bf16* proj;
    __device__ __forceinline__ void loadg(u32x4 (&g)[2][4][2], const pg8::Unit& u, int off, int wr, int wc, int fr, int fq) const {
#pragma unroll
        for (int ai = 0; ai < 2; ++ai)
#pragma unroll
            for (int m = 0; m < 4; ++m)
#pragma unroll
                for (int bj = 0; bj < 2; ++bj)
                    g[ai][m][bj] = *(const u32x4*)(proj + ((size_t)(u.pm * 256 + ai * 128 + wr * 64 + m * 16 + fr) * INW + off + u.pn * 256 + bj * 128 + wc * 32 + 8 * fq));
    }
    __device__ __forceinline__ void mid(pg8::Acc& acc, const pg8::Unit& u, int wr, int wc, int fr, int fq) const {
        u32x4 g[2][4][2]; loadg(g, u, C_GA, wr, wc, fr, fq);
#pragma unroll
        for (int ai = 0; ai < 2; ++ai)
#pragma unroll
            for (int m = 0; m < 4; ++m)
#pragma unroll
                for (int bj = 0; bj < 2; ++bj) { float a[8]; unpack8(g[ai][m][bj], a);
#pragma unroll
                    for (int i = 0; i < 4; ++i) { acc[ai][bj][m][0][i] *= a[i]; acc[ai][bj][m][1][i] *= a[4 + i]; } }
    }
    __device__ __forceinline__ void operator()(pg8::Acc& acc, const pg8::Unit& u, int wr, int wc, int fr, int fq, int slot) const {
        u32x4 g[2][4][2]; loadg(g, u, C_GR, wr, wc, fr, fq);
#pragma unroll
        for (int ai = 0; ai < 2; ++ai)
#pragma unroll
            for (int m = 0; m < 4; ++m)
#pragma unroll
                for (int bj = 0; bj < 2; ++bj) { float r[8]; unpack8(g[ai][m][bj], r);
                    f32x4 a = acc[ai][bj][m][0], b = acc[ai][bj][m][1];
                    a[0] *= r[0]; a[1] *= r[1]; a[2] *= r[2]; a[3] *= r[3]; b[0] *= r[4]; b[1] *= r[5]; b[2] *= r[6]; b[3] *= r[7];
                    *(u32x4*)(merged + (size_t)(u.pm * 256 + ai * 128 + wr * 64 + m * 16 + fr) * D + u.pn * 256 + bj * 128 + wc * 32 + 8 * fq) = pack8(a, b); }
    }
};
struct EpiOut {
    static constexpr bool PERM = true;
    __device__ __forceinline__ void prefetch(const pg8::Unit&, int, int, int) const {}
    const float* x; bf16* h2b;
    __device__ __forceinline__ void load(f32x4 (&xv)[2][2][2], const pg8::Unit& u, int q, int wr, int wc, int fr, int fq) const {
#pragma unroll
        for (int mm = 0; mm < 2; ++mm) { const size_t off = (size_t)(u.pm * 256 + (q >> 1) * 128 + wr * 64 + (2 * (q & 1) + mm) * 16 + fr) * D + u.pn * 256 + wc * 32 + 8 * fq;
#pragma unroll
            for (int bj = 0; bj < 2; ++bj)
#pragma unroll
                for (int n = 0; n < 2; ++n) xv[mm][bj][n] = *(const f32x4*)(x + off + bj * 128 + n * 4); }
    }
    __device__ __forceinline__ void operator()(pg8::Acc& acc, const pg8::Unit& u, int wr, int wc, int fr, int fq, int slot) const {
        f32x4 xA[2][2][2], xB[2][2][2];
        load(xA, u, 0, wr, wc, fr, fq);
#pragma unroll
        for (int q = 0; q < 4; ++q) {
            if (q < 3) { if (q & 1) load(xA, u, q + 1, wr, wc, fr, fq); else load(xB, u, q + 1, wr, wc, fr, fq); }
            const int ai = q >> 1;
#pragma unroll
            for (int mm = 0; mm < 2; ++mm) { const int m = 2 * (q & 1) + mm; const size_t off = (size_t)(u.pm * 256 + ai * 128 + wr * 64 + m * 16 + fr) * D + u.pn * 256 + wc * 32 + 8 * fq;
#pragma unroll
                for (int bj = 0; bj < 2; ++bj) {
                    const f32x4 a = ((q & 1) ? xB[mm][bj][0] : xA[mm][bj][0]) + acc[ai][bj][m][0], b = ((q & 1) ? xB[mm][bj][1] : xA[mm][bj][1]) + acc[ai][bj][m][1];
                    *(u32x4*)(h2b + off + bj * 128) = pack8(a, b); } }
        }
    }
};
struct EpiOutXb {
    static constexpr bool PERM = true;
    bf16* h2b; const bf16* xb; const float* irs; const float* g1; LAS const unsigned char* misc;
    __device__ __forceinline__ void prefetch(const pg8::Unit& u, int slot, int wid, int lane) const {
        {
            if (wid < 4) __builtin_amdgcn_global_load_lds((const unsigned*)(irs + u.pm * 256 + wid * 64 + lane), (LAS unsigned*)(misc + MT_EPI + slot * 1024 + wid * 256), 4, 0, 0);
            else __builtin_amdgcn_global_load_lds((const unsigned*)(g1 + u.pn * 256 + (wid - 4) * 64 + lane), (LAS unsigned*)(misc + MT_EPI2 + slot * 1024 + (wid - 4) * 256), 4, 0, 0);
        }
    }
    __device__ __forceinline__ void operator()(pg8::Acc& acc, const pg8::Unit& u, int wr, int wc, int fr, int fq, int slot) const {
        u32x4 xg[2][4][2];
#pragma unroll
        for (int ai = 0; ai < 2; ++ai)
#pragma unroll
            for (int m = 0; m < 4; ++m)
#pragma unroll
                for (int bj = 0; bj < 2; ++bj) xg[ai][m][bj] = *(const u32x4*)((const char*)xb + (unsigned)(((u.pm * 256 + ai * 128 + wr * 64 + m * 16 + fr) * D + u.pn * 256 + bj * 128 + wc * 32 + 8 * fq) * 2));
#pragma unroll
        for (int ai = 0; ai < 2; ++ai)
#pragma unroll
            for (int m = 0; m < 4; ++m) {
                const int lr = ai * 128 + wr * 64 + m * 16 + fr;
                const float ir = ((LAS const float*)(misc + MT_EPI + slot * 1024))[lr];
                LAS const float* gl = (LAS const float*)(misc + MT_EPI2 + slot * 1024) + wc * 32 + 8 * fq;
                asm volatile("" : "+v"(gl));
#pragma unroll
                for (int bj = 0; bj < 2; ++bj) { float xf[8]; unpack8(xg[ai][m][bj], xf);
                    const f32x4 i0 = *(const LAS f32x4*)(gl + bj * 128), i1 = *(const LAS f32x4*)(gl + bj * 128 + 4);
                    f32x4 a = acc[ai][bj][m][0], b = acc[ai][bj][m][1];
#pragma unroll
                    for (int i = 0; i < 4; ++i) { a[i] = __builtin_fmaf(xf[i] * ir, i0[i], a[i]); b[i] = __builtin_fmaf(xf[4 + i] * ir, i1[i], b[i]); }
                    *(u32x4*)((char*)h2b + (unsigned)(((u.pm * 256 + lr) * D + u.pn * 256 + bj * 128 + wc * 32 + 8 * fq) * 2)) = pack8(a, b); }
            }
    }
};

struct EpiGU {
    static constexpr bool PERM = true;
    unsigned char* act; const float* bgu; const float* rlist; LAS unsigned char* misc;
    __device__ __forceinline__ void prefetch(const pg8::Unit& u, int slot, int wid, int lane) const {
        if (wid < 4) __builtin_amdgcn_global_load_lds((const unsigned*)(rlist + (size_t)u.aux * NTOK + u.tl * 256 + wid * 64 + lane), (LAS unsigned*)(misc + MT_EPI + slot * 1024 + wid * 256), 4, 0, 0);
        else __builtin_amdgcn_global_load_lds((const unsigned*)(bgu + (size_t)u.aux * 2048 + ((wid - 4) >> 1) * 1024 + u.pn * 128 + ((wid - 4) & 1) * 64 + lane), (LAS unsigned*)(misc + MT_EPI2 + slot * 1024 + (wid - 4) * 256), 4, 0, 0);
    }
    __device__ __forceinline__ void operator()(pg8::Acc& acc, const pg8::Unit& u, int wr, int wc, int fr, int fq, int slot) const {
        const int ce = ((LAS const int*)(misc + MT_CNT))[u.aux];
        const int col = u.pn * 128 + wc * 32 + 8 * fq;
        LAS const float* bl = (LAS const float*)(misc + MT_EPI2 + slot * 1024) + wc * 32 + 8 * fq;
        constexpr float GC = -1.702f * 1.4426950408889634f, GCI = 1.0f / GC;
        float bgate[8], bup[8];
#pragma unroll
        for (int j = 0; j < 8; ++j) { bgate[j] = bl[j] * GC; bup[j] = (bl[128 + j] + 1.0f) * GCI; }
#pragma unroll
        for (int ai = 0; ai < 2; ++ai)
#pragma unroll
            for (int m = 0; m < 4; ++m) {
                const int lr = ai * 128 + wr * 64 + m * 16 + fr, r = u.pm * 256 + lr;
                const float rs = ((LAS const float*)(misc + MT_EPI + slot * 1024))[lr] * W8_INV;
                const float rsg = rs * GC, rsu = rs * GCI;
                float o[8];
#pragma unroll
                for (int n = 0; n < 2; ++n)
#pragma unroll
                    for (int i = 0; i < 4; ++i) {
                        float cg = __builtin_fmaf(acc[ai][0][m][n][i], rsg, bgate[4 * n + i]), uu = __builtin_fmaf(acc[ai][1][m][n][i], rsu, bup[4 * n + i]);
                        cg = fmaxf(cg, 7.0f * GC);
                        uu = fminf(fmaxf(uu, 8.0f * GCI), -6.0f * GCI);
                        o[4 * n + i] = cg * uu * __builtin_amdgcn_rcpf(1.0f + __builtin_amdgcn_exp2f(cg));
                    }
                u32x2 w; w.x = pk4_fp8(o[0], o[1], o[2], o[3]); w.y = pk4_fp8(o[4], o[5], o[6], o[7]);
                *(u32x2*)(act + (size_t)r * DFF + col) = w;
            }
    }
};
struct EpiDown {
    static constexpr bool PERM = true;
    unsigned char* rows; const float* bdn; const float* wlist; LAS const unsigned char* misc;
    __device__ __forceinline__ void prefetch(const pg8::Unit& u, int slot, int wid, int lane) const {
        if (wid < 4) __builtin_amdgcn_global_load_lds((const unsigned*)(wlist + (size_t)u.aux * NTOK + u.tl * 256 + wid * 64 + lane), (LAS unsigned*)(misc + MT_EPI + slot * 1024 + wid * 256), 4, 0, 0);
        else __builtin_amdgcn_global_load_lds((const unsigned*)(bdn + (size_t)u.aux * D + u.pn * 256 + (wid - 4) * 64 + lane), (LAS unsigned*)(misc + MT_EPI2 + slot * 1024 + (wid - 4) * 256), 4, 0, 0);
    }
    __device__ __forceinline__ void operator()(pg8::Acc& acc, const pg8::Unit& u, int wr, int wc, int fr, int fq, int slot) const {
        const int ce = ((LAS const int*)(misc + MT_CNT))[u.aux];
#pragma unroll
        for (int ai = 0; ai < 2; ++ai)
#pragma unroll
            for (int m = 0; m < 4; ++m) {
                const int lr = ai * 128 + wr * 64 + m * 16 + fr, r = u.pm * 256 + lr, idx = u.tl * 256 + lr;
                const float w = (idx < ce) ? ((LAS const float*)(misc + MT_EPI + slot * 1024))[lr] * ROW8_SCALE : 0.f;
                LAS const float* bl = (LAS const float*)(misc + MT_EPI2 + slot * 1024) + wc * 32 + 8 * fq;
                asm volatile("" : "+v"(bl));
#pragma unroll
                for (int bj = 0; bj < 2; ++bj) {
                    const f32x4 b0 = *(const LAS f32x4*)(bl + bj * 128), b1 = *(const LAS f32x4*)(bl + bj * 128 + 4);
                    f32x4 a = acc[ai][bj][m][0], b = acc[ai][bj][m][1];
#pragma unroll
                    for (int i = 0; i < 4; ++i) { a[i] = (a[i] * W8_INV + b0[i]) * w; b[i] = (b[i] * W8_INV + b1[i]) * w; }
                    u32x2 o; o.x = pk4_fp8(a[0], a[1], a[2], a[3]); o.y = pk4_fp8(b[0], b[1], b[2], b[3]);
                    *(u32x2*)(rows + (size_t)r * D + u.pn * 256 + bj * 128 + wc * 32 + 8 * fq) = o;
                }
            }
    }
};
namespace attn {
typedef float f32x16 __attribute__((ext_vector_type(16)));
typedef short s16x4 __attribute__((ext_vector_type(4)));
constexpr int NK = 272, KST = NK * 16 + 32, VST = NK * 64 + 128, K_OFF = 0, V_OFF = 8 * KST, WS_OFF = V_OFF + 2 * VST, OST_OFF = WS_OFF + 2048, LDS_END = OST_OFF + 8 * 4096;
constexpr float LOG2E = 1.4426950408889634f;
__device__ __forceinline__ s16x4 vtr(LAS const unsigned char* p) { return __builtin_bit_cast(s16x4, __builtin_amdgcn_ds_read_tr16_b64_v4i16((LAS s16x4*)p)); }
__device__ __forceinline__ int crowc(int r) { return (r & 3) + 8 * (r >> 2); }

template <int TYPE, bool DIAG>
__device__ __forceinline__ void tile(LAS const unsigned char* lds, int kbase, const bf16x8 (&qr)[4], f32x16 (&o)[2], float& l, float lanebase, float c1, int tt, int lane) {
    const int r32 = lane & 31, hi = lane >> 5;
    f32x16 p;
#pragma unroll
    for (int r = 0; r < 16; ++r) p[r] = __builtin_fmaf(c1, (float)crowc(r), lanebase);
#pragma unroll
    for (int d0 = 0; d0 < 4; ++d0) {
        const bf16x8 kf = *(const LAS bf16x8*)(lds + K_OFF + (2 * d0 + hi) * KST + (kbase + r32) * 16);
        p = __builtin_amdgcn_mfma_f32_32x32x16_bf16(kf, qr[d0], p, 0, 0, 0);
    }
    constexpr int NR = (TYPE == 0) ? 8 : 16;
    float e[16];
#pragma unroll
    for (int r = 0; r < NR; ++r) {
        float v = __builtin_amdgcn_exp2f(p[r]);
        if (DIAG) { const bool ok = (TYPE == 1) ? (crowc(r) > tt) : (crowc(r) <= tt); v = ok ? v : 0.f; }
        e[r] = v; l += v;
    }
    constexpr int NS = (TYPE == 0) ? 1 : 2;
    u32x4 pw[2];
#pragma unroll
    for (int s = 0; s < NS; ++s) { pw[s].x = pk2(e[8 * s + 0], e[8 * s + 1]); pw[s].y = pk2(e[8 * s + 2], e[8 * s + 3]); pw[s].z = pk2(e[8 * s + 4], e[8 * s + 5]); pw[s].w = pk2(e[8 * s + 6], e[8 * s + 7]); }
    LAS const unsigned char* vb = lds + V_OFF + (kbase + 4 * hi + ((lane & 15) >> 2)) * 64 + ((lane >> 4) & 1) * 32 + (lane & 3) * 8;
#pragma unroll
    for (int d0 = 0; d0 < 2; ++d0)
#pragma unroll
        for (int s = 0; s < NS; ++s) {
            const s16x4 lo = vtr(vb + d0 * VST + s * 1024), hh = vtr(vb + d0 * VST + s * 1024 + 512);
            const bf16x8 vf = (bf16x8){lo[0], lo[1], lo[2], lo[3], hh[0], hh[1], hh[2], hh[3]};
            o[d0] = __builtin_amdgcn_mfma_f32_32x32x16_bf16(__builtin_bit_cast(bf16x8, pw[s]), vf, o[d0], 0, 0, 0);
        }
}

#define AT_ISSUE(u_) do { const int u__ = (u_); const int b_ = u__ >> 6, qb_ = (u__ >> 1) & 31, kvh_ = u__ & 1; \
        _Pragma("unroll") for (int i = 0; i < 5; ++i) { const int idx = tid + 512 * i; if (idx < NK * 8) { const int key = idx >> 3, c = idx & 7; const bf16* rowp; \
            if (key < 16) rowp = pmeta + (size_t)key * INW; else { int j = qb_ * 128 - 128 + (key - 16); if (j < 0) j = 0; rowp = proj + ((size_t)b_ * SEQ + j) * INW; } \
            pk[i] = *(const u32x4*)(rowp + C_AK + kvh_ * 64 + c * 8); pv[i] = *(const u32x4*)(rowp + C_AV + kvh_ * 64 + c * 8); } } } while (0)
#define AT_QLOAD(dst, a_) do { const size_t qrow_ = (size_t)b * SEQ + qb * 128 + 32 * (a_) + r32; \
        _Pragma("unroll") for (int d0 = 0; d0 < 4; ++d0) dst[d0] = *(const bf16x8*)(proj + qrow_ * INW + C_AQ + h * 64 + d0 * 16 + hi * 8); } while (0)
__device__ __forceinline__ void phase(LAS unsigned char* lds, const bf16* __restrict__ proj, const bf16* __restrict__ pmeta, const float* __restrict__ sinks, float bshift, bf16* __restrict__ yatt, int first, int count, int stride, int first_tail = -1, int tail_lo = 0, int tail_hi = 4) {
    const int tid = threadIdx.x, lane = tid & 63, r32 = lane & 31, hi = lane >> 5; const int wave = __builtin_amdgcn_readfirstlane(tid >> 6);
    const int nu = count + (first_tail >= 0 ? 1 : 0);
    if (nu <= 0) return;
    u32x4 pk[5], pv[5];
    AT_ISSUE(count > 0 ? first : first_tail);
    for (int ui = 0; ui < nu; ++ui) {
        const int u = (ui < count) ? first + ui * stride : first_tail;
        const int a_lo = (ui < count) ? 0 : tail_lo, a_hi = (ui < count) ? 4 : tail_hi;
        const int b = u >> 6, qb = (u >> 1) & 31, kvh = u & 1;
#pragma unroll
        for (int i = 0; i < 5; ++i) { const int idx = tid + 512 * i; if (idx < NK * 8) { const int key = idx >> 3, c = idx & 7;
            *(LAS u32x4*)(lds + K_OFF + c * KST + key * 16) = pk[i];
            *(LAS u32x4*)(lds + V_OFF + (c >> 2) * VST + key * 64 + (c & 3) * 16) = pv[i]; } }
        if (ui + 1 < nu) AT_ISSUE((ui + 1 < count) ? u + stride : first_tail);
        const int h = kvh * 8 + wave;
        bf16x8 qr[4], qn[4];
        AT_QLOAD(qr, a_lo);
        __syncthreads();
        const float slope = exp2f(-0.5f * (float)(h + 1)), sink = sinks[h];
        const float M = fmaxf(bshift, sink);
        const float c1 = slope * LOG2E;
        LAS float* wsf = (LAS float*)(lds + WS_OFF) + wave * 64;
        LAS bf16* stg = (LAS bf16*)(lds + OST_OFF) + wave * 2048;
#pragma unroll 1
        for (int a = a_lo; a < a_hi; ++a) {
            if (a + 1 < a_hi) AT_QLOAD(qn, a + 1);
            f32x16 o[2]; o[0] = f32x16{}; o[1] = f32x16{};
            float l = 0.f;
            const int t = 32 * a + r32;
            const int tt = r32 - 4 * hi;
            const float hi4 = c1 * 4.0f * (float)hi;
            tile<0, false>(lds, 0, qr, o, l, -(slope * (float)(qb * 128 + t + 16) + M) * LOG2E + hi4, c1, tt, lane);
            if (qb > 0) {
                tile<1, true>(lds, 16 + 32 * a, qr, o, l, -(slope * (float)(128 + r32) + M) * LOG2E + hi4, c1, tt, lane);
                for (int bb = a + 1; bb < 4; ++bb) tile<1, false>(lds, 16 + 32 * bb, qr, o, l, -(slope * (float)(128 + t - 32 * bb) + M) * LOG2E + hi4, c1, tt, lane);
            }
            for (int bb = 0; bb < a; ++bb) tile<2, false>(lds, 144 + 32 * bb, qr, o, l, -(slope * (float)(t - 32 * bb) + M) * LOG2E + hi4, c1, tt, lane);
            tile<2, true>(lds, 144 + 32 * a, qr, o, l, -(slope * (float)r32 + M) * LOG2E + hi4, c1, tt, lane);
            l += __shfl_xor(l, 32);
            l += exp2f((sink - M) * LOG2E);
            if (hi == 0) wsf[r32] = l;
            LDS_WAIT();
            float rli[16];
#pragma unroll
            for (int r = 0; r < 16; ++r) rli[r] = __builtin_amdgcn_rcpf(wsf[crowc(r) + 4 * hi]);
#pragma unroll
            for (int r = 0; r < 16; ++r) { const int orow = crowc(r) + 4 * hi;
#pragma unroll
                for (int d0 = 0; d0 < 2; ++d0) stg[orow * 64 + d0 * 32 + r32] = f2bf(o[d0][r] * rli[r]); }
            LDS_WAIT();
            bf16* Ow = yatt + ((size_t)b * SEQ + qb * 128 + 32 * a) * D + h * 64;
#pragma unroll
            for (int i = 0; i < 4; ++i) { const int row = i * 8 + (lane >> 3), ch = lane & 7; const u32x4 v = *(const LAS u32x4*)(stg + row * 64 + ch * 8); *(u32x4*)(Ow + (size_t)row * D + ch * 8) = v; }
            LDS_WAIT();
#pragma unroll
            for (int d0 = 0; d0 < 4; ++d0) qr[d0] = qn[d0];
        }
        __syncthreads();
    }
}
#undef AT_ISSUE
#undef AT_QLOAD
}
namespace ret {
typedef float f32x16 __attribute__((ext_vector_type(16)));
typedef short s16x4 __attribute__((ext_vector_type(4)));
constexpr size_t WS_STATES = 893 * MiB;
__device__ __forceinline__ s16x4 vtr(LAS const unsigned char* p) { return __builtin_bit_cast(s16x4, __builtin_amdgcn_ds_read_tr16_b64_v4i16((LAS s16x4*)p)); }
__device__ __forceinline__ int crowc(int r) { return (r & 3) + 8 * (r >> 2); }
__device__ __forceinline__ float lg2gamma(int h) { return log2f(1.0f - exp2f(-5.0f - (float)h)); }

constexpr int R1_BUF = 40960;
#define RET_ISSUE(KR, VR, c_) do { const int ci__ = (c_); \
        _Pragma("unroll") for (int i = 0; i < 4; ++i) { const int idx = tid + 512 * i, key = idx >> 4, ch = idx & 15; \
            if (ci__ == 0) { KR[i] = (key >= 112) ? *(const u32x4*)(pmeta + (size_t)(key - 112) * INW + C_RK + h * 128 + ch * 8) : (u32x4){0u, 0u, 0u, 0u}; } \
            else KR[i] = *(const u32x4*)(proj + ((size_t)b * SEQ + (ci__ - 1) * 128 + key) * INW + C_RK + h * 128 + ch * 8); } \
        { const int key = tid >> 2, ch = tid & 3; \
          if (ci__ == 0) VR = (key >= 112) ? *(const u32x4*)(pmeta + (size_t)(key - 112) * INW + C_RV + h * 256 + dvs * 32 + ch * 8) : (u32x4){0u, 0u, 0u, 0u}; \
          else VR = *(const u32x4*)(proj + ((size_t)b * SEQ + (ci__ - 1) * 128 + key) * INW + C_RV + h * 256 + dvs * 32 + ch * 8); } } while (0)
#define RET_STEP(KR, VR, c_) do { const int c__ = (c_); LAS unsigned char* buf = lds + (c__ & 1) * R1_BUF; \
        _Pragma("unroll") for (int i = 0; i < 4; ++i) { const int idx = tid + 512 * i, key = idx >> 4, ch = idx & 15; *(LAS u32x4*)(buf + (ch >> 2) * (128 * 64) + key * 64 + (ch & 3) * 16) = KR[i]; } \
        { const int key = tid >> 2, ch = tid & 3; float f[8]; unpack8(VR, f); u32x4 w; \
          w.x = pk2(f[0] * vscale, f[1] * vscale); w.y = pk2(f[2] * vscale, f[3] * vscale); w.z = pk2(f[4] * vscale, f[5] * vscale); w.w = pk2(f[6] * vscale, f[7] * vscale); \
          *(LAS u32x4*)(buf + 32768 + key * 64 + ch * 16) = w; } \
        if (c__ + 2 < 32) RET_ISSUE(KR, VR, c__ + 2); \
        __syncthreads(); \
        if (wave < 4) { \
            const int dt = wave; \
            acc = acc * g128; \
            LAS const unsigned char* ab = buf + dt * (128 * 64) + (4 * hi + ((lane & 15) >> 2)) * 64 + ((lane >> 4) & 1) * 32 + (lane & 3) * 8; \
            LAS const unsigned char* bb = buf + 32768 + (4 * hi + ((lane & 15) >> 2)) * 64 + ((lane >> 4) & 1) * 32 + (lane & 3) * 8; \
            _Pragma("unroll") for (int ks = 0; ks < 8; ++ks) { \
                const s16x4 al = vtr(ab + ks * 1024), ah = vtr(ab + ks * 1024 + 512), bl = vtr(bb + ks * 1024), bh = vtr(bb + ks * 1024 + 512); \
                const bf16x8 af = (bf16x8){al[0], al[1], al[2], al[3], ah[0], ah[1], ah[2], ah[3]}, bfr = (bf16x8){bl[0], bl[1], bl[2], bl[3], bh[0], bh[1], bh[2], bh[3]}; \
                acc = __builtin_amdgcn_mfma_f32_32x32x16_bf16(af, bfr, acc, 0, 0, 0); } \
            bf16* sb = states + ((((size_t)(b * 4 + h) * 32 + c__) * 8 + dvs) * 8) * 512; \
            _Pragma("unroll") for (int g = 0; g < 4; ++g) { u32x2 w; w.x = pk2(acc[4 * g], acc[4 * g + 1]); w.y = pk2(acc[4 * g + 2], acc[4 * g + 3]); \
                *(u32x2*)(sb + (size_t)(2 * dt + (g >> 1)) * 512 + (32 * (g & 1) + (lane & 31)) * 8 + 4 * hi) = w; } \
        } } while (0)
__device__ __forceinline__ void state_chain(LAS unsigned char* lds, int b, int h, int dvs, const bf16* __restrict__ proj, const bf16* __restrict__ pmeta, bf16* __restrict__ states) {
    const int tid = threadIdx.x, lane = tid & 63, hi = lane >> 5; const int wave = __builtin_amdgcn_readfirstlane(tid >> 6);
    const float lg = lg2gamma(h), g128 = exp2f(lg * 128.0f);
    u32x4 kA[4], kB[4], vA, vB;
    const float vscale = exp2f(lg * (float)(127 - (tid >> 2)));
    f32x16 acc = {};
    RET_ISSUE(kA, vA, 0); RET_ISSUE(kB, vB, 1);
#pragma unroll 1
    for (int c = 0; c < 32; c += 2) { RET_STEP(kA, vA, c); RET_STEP(kB, vB, c + 1); }
    __syncthreads();
}
#undef RET_ISSUE
#undef RET_STEP

constexpr int R1KS = 8192 + 64, R1VS = 8192 + 128, R1VO = 4 * R1KS, R1B2 = R1VO + 2 * R1VS;
#define RET2_ISSUE(KR, VR, c_) do { const int ci__ = (c_); \
        _Pragma("unroll") for (int i = 0; i < 4; ++i) { const int idx = tid + 512 * i, key = idx >> 4, ch = idx & 15; \
            if (ci__ == 0) { KR[i] = (key >= 112) ? *(const u32x4*)(pmeta + (size_t)(key - 112) * INW + C_RK + h * 128 + ch * 8) : (u32x4){0u, 0u, 0u, 0u}; } \
            else KR[i] = *(const u32x4*)(proj + ((size_t)b * SEQ + (ci__ - 1) * 128 + key) * INW + C_RK + h * 128 + ch * 8); } \
        _Pragma("unroll") for (int i = 0; i < 2; ++i) { const int idx = tid + 512 * i, key = idx >> 3, c8 = idx & 7; \
          if (ci__ == 0) VR[i] = (key >= 112) ? *(const u32x4*)(pmeta + (size_t)(key - 112) * INW + C_RV + h * 256 + dvs2 * 64 + c8 * 8) : (u32x4){0u, 0u, 0u, 0u}; \
          else VR[i] = __builtin_nontemporal_load((const u32x4*)(proj + ((size_t)b * SEQ + (ci__ - 1) * 128 + key) * INW + C_RV + h * 256 + dvs2 * 64 + c8 * 8)); } } while (0)
#define RET2_STEP(KR, VR, c_) do { const int c__ = (c_); LAS unsigned char* buf = lds + (c__ & 1) * R1B2; unsigned long long T0_ = 0, T1_ = 0, T2_ = 0, T3_ = 0; if (PROBE_TS >= 0) T0_ = __builtin_amdgcn_s_memtime(); \
        _Pragma("unroll") for (int i = 0; i < 4; ++i) { const int idx = tid + 512 * i, key = idx >> 4, ch = idx & 15; *(LAS u32x4*)(buf + (ch >> 2) * R1KS + key * 64 + (ch & 3) * 16) = KR[i]; } \
        _Pragma("unroll") for (int i = 0; i < 2; ++i) { const int idx = tid + 512 * i, key = idx >> 3, c8 = idx & 7; float f[8]; unpack8(VR[i], f); const float vs = vscale[i]; u32x4 w; \
          w.x = pk2(f[0] * vs, f[1] * vs); w.y = pk2(f[2] * vs, f[3] * vs); w.z = pk2(f[4] * vs, f[5] * vs); w.w = pk2(f[6] * vs, f[7] * vs); \
          *(LAS u32x4*)(buf + R1VO + (c8 >> 2) * R1VS + key * 64 + (c8 & 3) * 16) = w; } \
        if (c__ + 3 < 32) RET2_ISSUE(KR, VR, c__ + 3); \
        if (PROBE_TS >= 0) { asm volatile("s_waitcnt lgkmcnt(0)" ::: "memory"); T1_ = __builtin_amdgcn_s_memtime(); } \
        __syncthreads(); \
        if (PROBE_TS >= 0) T2_ = __builtin_amdgcn_s_memtime(); \
        { \
            acc = acc * g128; \
            LAS const unsigned char* ab = buf + dt * R1KS + (4 * hi + ((lane & 15) >> 2)) * 64 + ((lane >> 4) & 1) * 32 + (lane & 3) * 8; \
            LAS const unsigned char* bb = buf + R1VO + sl * R1VS + (4 * hi + ((lane & 15) >> 2)) * 64 + ((lane >> 4) & 1) * 32 + (lane & 3) * 8; \
            _Pragma("unroll") for (int ks = 0; ks < 8; ++ks) { \
                const s16x4 al = vtr(ab + ks * 1024), ah = vtr(ab + ks * 1024 + 512), bl = vtr(bb + ks * 1024), bh = vtr(bb + ks * 1024 + 512); \
                const bf16x8 af = (bf16x8){al[0], al[1], al[2], al[3], ah[0], ah[1], ah[2], ah[3]}, bfr = (bf16x8){bl[0], bl[1], bl[2], bl[3], bh[0], bh[1], bh[2], bh[3]}; \
                acc = __builtin_amdgcn_mfma_f32_32x32x16_bf16(af, bfr, acc, 0, 0, 0); } \
            if (PROBE_TS >= 0) T3_ = __builtin_amdgcn_s_memtime();        \
            bf16* sb = states + ((((size_t)(b * 4 + h) * 32 + c__) * 8 + (2 * dvs2 + sl)) * 8) * 512; \
            _Pragma("unroll") for (int g = 0; g < 4; ++g) { u32x2 w; w.x = pk2(acc[4 * g], acc[4 * g + 1]); w.y = pk2(acc[4 * g + 2], acc[4 * g + 3]); \
                *(u32x2*)(sb + (size_t)(2 * dt + (g >> 1)) * 512 + (32 * (g & 1) + (lane & 31)) * 8 + 4 * hi) = w; } \
            if (PROBE_TS >= 0) { const unsigned long long T4_ = __builtin_amdgcn_s_memtime(); tacc[0] += (unsigned)(T1_ - T0_); tacc[1] += (unsigned)(T2_ - T1_); tacc[2] += (unsigned)(T3_ - T2_); tacc[3] += (unsigned)(T4_ - T3_); } \
        } } while (0)
__device__ __forceinline__ void state_chain2(LAS unsigned char* lds, int b, int h, int dvs2, const bf16* __restrict__ proj, const bf16* __restrict__ pmeta, bf16* __restrict__ states) {
    const int tid = threadIdx.x, lane = tid & 63, hi = lane >> 5; const int wave = __builtin_amdgcn_readfirstlane(tid >> 6);
    const int dt = wave & 3, sl = wave >> 2;
    const float lg = lg2gamma(h), g128 = exp2f(lg * 128.0f);
    u32x4 kA[4], kB[4], kC[4], vA[2], vB[2], vC[2];
    float vscale[2];
#pragma unroll
    for (int i = 0; i < 2; ++i) vscale[i] = exp2f(lg * (float)(127 - ((tid + 512 * i) >> 3)));
    f32x16 acc = {};
    unsigned tacc[4] = {0u, 0u, 0u, 0u};
    RET2_ISSUE(kA, vA, 0); RET2_ISSUE(kB, vB, 1); RET2_ISSUE(kC, vC, 2);
#pragma unroll 1
    for (int c = 0; c < 30; c += 3) { RET2_STEP(kA, vA, c); RET2_STEP(kB, vB, c + 1); RET2_STEP(kC, vC, c + 2); }
    RET2_STEP(kA, vA, 30); RET2_STEP(kB, vB, 31);
    __syncthreads();
    if (PROBE_TS >= 0 && blockIdx.x == 0 && tid == 0) { unsigned* tc_ = (unsigned*)((unsigned char*)states - WS_STATES) + 1200 + 40; tc_[0] = tacc[0]; tc_[1] = tacc[1]; tc_[2] = tacc[2]; tc_[3] = tacc[3]; }
}
#undef RET2_ISSUE
#undef RET2_STEP

constexpr int R3_CS = 2048 + 16, R3_VS = 8192 + 64, R3_K = 0, R3_Q = 16 * R3_CS, R3_V = 32 * R3_CS;
static_assert(R3_V + 8 * R3_VS <= MISC_OFF + 4096, "R3 LDS images");
#define R3_ISSUE(u_) do { const int u__ = (u_); const size_t rw = (size_t)(u__ >> 7) * SEQ + (u__ & 31) * 128; const int hh = (u__ >> 5) & 3; \
        _Pragma("unroll") for (int i = 0; i < 4; ++i) { const int idx = tid + 512 * i, key = idx >> 4, ch = idx & 15; \
            kq[i] = __builtin_nontemporal_load((const u32x4*)(proj + (rw + key) * INW + C_RK + hh * 128 + ch * 8)); kq[4 + i] = __builtin_nontemporal_load((const u32x4*)(proj + (rw + key) * INW + C_RQ + hh * 128 + ch * 8)); } \
        _Pragma("unroll") for (int i = 0; i < 8; ++i) { const int idx = tid + 512 * i, key = idx >> 5, ch = idx & 31; vv[i] = __builtin_nontemporal_load((const u32x4*)(proj + (rw + key) * INW + C_RV + hh * 256 + ch * 8)); } } while (0)
__device__ __forceinline__ void out_phase(LAS unsigned char* lds, const bf16* __restrict__ proj, const bf16* __restrict__ states, bf16* __restrict__ yret, int G, int bx) {
    const int tid = threadIdx.x, lane = tid & 63, r32 = lane & 31, hi = lane >> 5; const int wave = __builtin_amdgcn_readfirstlane(tid >> 6);
    constexpr int NU = NB * 4 * 32;
    if (bx >= NU) return;
    u32x4 kq[8], vv[8];
    R3_ISSUE(bx);
    for (int u = bx; u < NU; u += G) {
        const int b = u >> 7, h = (u >> 5) & 3, tb = u & 31;
        const float lg = lg2gamma(h);
        const size_t row0 = (size_t)b * SEQ + tb * 128;
#pragma unroll
        for (int i = 0; i < 4; ++i) { const int idx = tid + 512 * i, key = idx >> 4, ch = idx & 15;
            *(LAS u32x4*)(lds + R3_K + ch * R3_CS + key * 16) = kq[i]; *(LAS u32x4*)(lds + R3_Q + ch * R3_CS + key * 16) = kq[4 + i]; }
#pragma unroll
        for (int i = 0; i < 8; ++i) { const int idx = tid + 512 * i, key = idx >> 5, ch = idx & 31; *(LAS u32x4*)(lds + R3_V + (ch >> 2) * R3_VS + key * 64 + (ch & 3) * 16) = vv[i]; }
        if (u + G < NU) R3_ISSUE(u + G);
        bf16x8 sf[8];
        { const bf16* sb = states + (((size_t)(b * 4 + h) * 32 + tb) * 64 + (size_t)wave * 8) * 512 + lane * 8;
#pragma unroll
          for (int k = 0; k < 8; ++k) sf[k] = __builtin_nontemporal_load((const bf16x8*)(sb + (size_t)k * 512)); }
        __syncthreads();
        u32x2 pw[2][4];
        for (int rp_ = 0; rp_ < ((PROBE_PHASE == 31) ? 2 : 1); ++rp_)
#pragma unroll
        for (int ti = 0; ti < 2; ++ti) {
            const int t = wave + 8 * ti;
            if (t < 10) {
                const int a = (t >= 6) ? 3 : (t >= 3) ? 2 : (t >= 1) ? 1 : 0, bb = t - ((a * (a + 1)) >> 1);
                f32x16 p = {};
#pragma unroll
                for (int k = 0; k < 8; ++k) {
                    const bf16x8 kf = *(const LAS bf16x8*)(lds + R3_K + (2 * k + hi) * R3_CS + (32 * bb + r32) * 16);
                    const bf16x8 qf = *(const LAS bf16x8*)(lds + R3_Q + (2 * k + hi) * R3_CS + (32 * a + r32) * 16);
                    p = __builtin_amdgcn_mfma_f32_32x32x16_bf16(kf, qf, p, 0, 0, 0);
                }
                const float lanebase = lg * (float)(32 * (a - bb) + r32 - 4 * hi), cpos = -lg; const int tt = r32 - 4 * hi;
                float e[16];
#pragma unroll
                for (int r = 0; r < 16; ++r) { float v = p[r] * __builtin_amdgcn_exp2f(__builtin_fmaf(cpos, (float)crowc(r), lanebase)); if (bb == a) v = (crowc(r) <= tt) ? v : 0.f; e[r] = v; }
#pragma unroll
                for (int g = 0; g < 4; ++g) { pw[ti][g].x = pk2(e[4 * g], e[4 * g + 1]); pw[ti][g].y = pk2(e[4 * g + 2], e[4 * g + 3]); }
            }
        }
        __builtin_amdgcn_sched_barrier(0);
        bf16x8 vf[8];
        { LAS const unsigned char* vb = lds + R3_V + wave * R3_VS + (8 * hi + ((lane & 15) >> 2)) * 64 + ((lane >> 4) & 1) * 32 + (lane & 3) * 8;
#pragma unroll
          for (int ks = 0; ks < 8; ++ks) { const s16x4 lo = vtr(vb + ks * 1024), hh = vtr(vb + ks * 1024 + 256); vf[ks] = (bf16x8){lo[0], lo[1], lo[2], lo[3], hh[0], hh[1], hh[2], hh[3]}; } }
        __syncthreads();
#pragma unroll
        for (int ti = 0; ti < 2; ++ti) {
            const int t = wave + 8 * ti;
            if (t < 10) {
                const int a = (t >= 6) ? 3 : (t >= 3) ? 2 : (t >= 1) ? 1 : 0, bb = t - ((a * (a + 1)) >> 1);
#pragma unroll
                for (int g = 0; g < 4; ++g) *(LAS u32x2*)(lds + R3_K + (4 * bb + g) * R3_CS + (32 * a + r32) * 16 + hi * 8) = pw[ti][g];
            }
        }
        __syncthreads();
        LAS bf16* stg = (LAS bf16*)(lds + R3_V);
        for (int rp_ = 0; rp_ < ((PROBE_PHASE == 32) ? 2 : 1); ++rp_)
#pragma unroll 1
        for (int a = 0; a < 4; ++a) {
            f32x16 o = {};
#pragma unroll
            for (int ks = 0; ks < 8; ++ks) if (ks < 2 * (a + 1)) {
                const bf16x8 pa = *(const LAS bf16x8*)(lds + R3_K + (2 * ks + hi) * R3_CS + (32 * a + r32) * 16);
                o = __builtin_amdgcn_mfma_f32_32x32x16_bf16(pa, vf[ks], o, 0, 0, 0);
            }
            f32x16 x = {};
#pragma unroll
            for (int k = 0; k < 8; ++k) { const bf16x8 qa = *(const LAS bf16x8*)(lds + R3_Q + (2 * k + hi) * R3_CS + (32 * a + r32) * 16); x = __builtin_amdgcn_mfma_f32_32x32x16_bf16(qa, sf[k], x, 0, 0, 0); }
#pragma unroll
            for (int r = 0; r < 16; ++r) {
                const float din = __builtin_amdgcn_exp2f(lg * (float)(32 * a + crowc(r) + 4 * hi + 1));
                { const int row = 32 * a + crowc(r) + 4 * hi, col = wave * 32 + r32;
                  stg[row * 256 + ((((col >> 3) ^ ((row & 3) << 2)) << 3) | (col & 7))] = f2bf(o[r] + din * x[r]); }
            }
        }
        int nl = lane; asm volatile("" : "+v"(nl));
        const int nrow = wave * 16 + (nl >> 2), c4 = nl & 3, sx = nrow & 3;
        const bf16* rgp = proj + (row0 + nrow) * INW + C_RG + h * 256 + c4 * 8;
        bf16* yp = yret + (row0 + nrow) * D + h * 256 + c4 * 8;
        LAS const bf16* sp = stg + nrow * 256 + c4 * 8;
        u32x4 rgv[8];
#pragma unroll
        for (int j = 0; j < 8; ++j) rgv[j] = __builtin_nontemporal_load((const u32x4*)(rgp + 32 * j));
        __syncthreads();
        for (int rp_ = 0; rp_ < ((PROBE_PHASE == 33) ? 2 : 1); ++rp_) {
            float ss = 0.f;
#pragma unroll
            for (int j = 0; j < 8; ++j) { const u32x4 sw = *(const LAS u32x4*)(sp + 32 * (j ^ sx)); float f[8]; unpack8(sw, f);
#pragma unroll
                for (int i = 0; i < 8; ++i) ss += f[i] * f[i]; }
            ss += __shfl_xor(ss, 1); ss += __shfl_xor(ss, 2);
            const float rs = rsqrtf(ss * (1.0f / 256.0f) + EPS);
            asm volatile("" ::: "memory");
#pragma unroll
            for (int j = 0; j < 8; ++j) { const u32x4 sw = *(const LAS u32x4*)(sp + 32 * (j ^ sx)); float f[8], g[8]; unpack8(sw, f); unpack8(rgv[j], g); u32x4 w;
                w.x = pk2(f[0] * rs * g[0], f[1] * rs * g[1]); w.y = pk2(f[2] * rs * g[2], f[3] * rs * g[3]); w.z = pk2(f[4] * rs * g[4], f[5] * rs * g[5]); w.w = pk2(f[6] * rs * g[6], f[7] * rs * g[7]);
                *(u32x4*)(yp + 32 * j) = w; }
        }
        __syncthreads();
    }
}
#undef R3_ISSUE
}
__device__ __forceinline__ void p0_load(const float* __restrict__ W, int N, int k0, int n0, int lane, f32x4 (&v)[16]) {
    const int kblk = lane >> 3, nq = lane & 7;
    const float* src = W + (size_t)(k0 + 16 * kblk) * N + n0 + 4 * nq;
#pragma unroll
    for (int i = 0; i < 16; ++i) v[i] = __builtin_nontemporal_load((const f32x4*)(src + (size_t)i * N));
}
template <bool FP8, bool NT = false>
__device__ __forceinline__ void p0_store(void* __restrict__ WT, int K, int k0, int dst_row0, int lane, const f32x4 (&v)[16]) {
    const int kblk = lane >> 3, nq = lane & 7;
#pragma unroll
    for (int j = 0; j < 4; ++j) {
        const size_t row = (size_t)(dst_row0 + 4 * nq + j);
        if constexpr (FP8) {
            u32x4 o;
            o.x = pk4_fp8(v[0][j] * W8_SCALE, v[1][j] * W8_SCALE, v[2][j] * W8_SCALE, v[3][j] * W8_SCALE); o.y = pk4_fp8(v[4][j] * W8_SCALE, v[5][j] * W8_SCALE, v[6][j] * W8_SCALE, v[7][j] * W8_SCALE);
            o.z = pk4_fp8(v[8][j] * W8_SCALE, v[9][j] * W8_SCALE, v[10][j] * W8_SCALE, v[11][j] * W8_SCALE); o.w = pk4_fp8(v[12][j] * W8_SCALE, v[13][j] * W8_SCALE, v[14][j] * W8_SCALE, v[15][j] * W8_SCALE);
            if constexpr (NT) __builtin_nontemporal_store(o, (u32x4*)((unsigned char*)WT + row * K + k0 + 16 * kblk));
            else *(u32x4*)((unsigned char*)WT + row * K + k0 + 16 * kblk) = o;
        } else {
            u32x4 a, b;
            a.x = pk2(v[0][j], v[1][j]); a.y = pk2(v[2][j], v[3][j]); a.z = pk2(v[4][j], v[5][j]); a.w = pk2(v[6][j], v[7][j]);
            b.x = pk2(v[8][j], v[9][j]); b.y = pk2(v[10][j], v[11][j]); b.z = pk2(v[12][j], v[13][j]); b.w = pk2(v[14][j], v[15][j]);
            bf16* d = (bf16*)WT + row * K + k0 + 16 * kblk;
            *(u32x4*)d = a; *(u32x4*)(d + 8) = b;
        }
    }
}
template <bool FP8>
__device__ __forceinline__ void p0_item(const float* __restrict__ W, int K, int N, void* __restrict__ WT, int k0, int n0, int dst_row0, int lane) {
    f32x4 v[16]; p0_load(W, N, k0, n0, lane, v); p0_store<FP8>(WT, K, k0, dst_row0, lane, v);
}
constexpr int I_IN = 8 * 200, I_SQ = 8 * 32, I_GU = 32 * 8 * 64, I_DN = 32 * 8 * 32, NITEMS = I_IN + 3 * I_SQ + I_GU + I_DN;
constexpr int I_SMALL = I_IN + 3 * I_SQ, I_MOE = I_GU + I_DN;
constexpr int NCONV = 41;
#define MOE_DECODE(r_) const int r__ = (r_); const bool isgu = r__ < I_GU; const int rr = isgu ? r__ : r__ - I_GU; \
    const int e_ = isgu ? rr / 512 : rr / 256, q_ = isgu ? rr % 512 : rr % 256, kb_ = isgu ? q_ / 64 : q_ / 32, nb_ = isgu ? q_ % 64 : q_ % 32, n0_ = nb_ * 32; \
    const float* src_ = isgu ? w_gu + (size_t)e_ * D * 2048 : w_dn + (size_t)e_ * DFF * D; const int N_ = isgu ? 2048 : D; \
    unsigned char* dst_ = isgu ? Wgu_t + (size_t)e_ * 2048 * D : Wdn_t + (size_t)e_ * D * DFF; \
    const int drow_ = isgu ? 256 * ((n0_ & 1023) >> 7) + 128 * (n0_ >> 10) + (n0_ & 127) : n0_;
#define P0_DISPATCH(it_) do { int r = (it_); \
    if (r < I_IN) { const int kb = r / 200, nb = r % 200, n0 = nb * 32, o = n0 & 255, wcc = o >> 6, bj = (o >> 5) & 1; \
        if (n0 >= C_GA) { const int g = n0 - C_GA, col = g & 1023;        \
            p0_item<true>(w_in, D, INW, Win8, kb * 128, n0, (C_GA - 256 * T8) + 256 * (col >> 7) + 128 * (g >> 10) + (col & 127), lane); } \
        else if (n0 >= 256 * T8) p0_item<true>(w_in, D, INW, Win8, kb * 128, n0, (n0 & ~255) - 256 * T8 + 128 * bj + 32 * wcc, lane); \
        else p0_item<false>(w_in, D, INW, Win_t, kb * 128, n0, (n0 & ~255) + 128 * bj + 32 * wcc, lane); break; } \
    r -= I_IN; \
    if (r < I_SQ) { p0_item<false>(w_ab, D, D, Wab_t, (r / 32) * 128, (r % 32) * 32, (r % 32) * 32, lane); break; } r -= I_SQ; \
    if (r < I_SQ) { p0_item<false>(w_rb, D, D, Wrb_t, (r / 32) * 128, (r % 32) * 32, (r % 32) * 32, lane); break; } r -= I_SQ; \
    if (r < I_SQ) { p0_item<false>(w_out, D, D, Wout_t, (r / 32) * 128, (r % 32) * 32, (r % 32) * 32, lane); break; } r -= I_SQ; \
    if (r < I_GU) { const int e = r / 512, q = r % 512, kb = q / 64, nb = q % 64, n0 = nb * 32, bj = n0 >> 10, rem = n0 & 1023, pn = rem >> 7, cl = rem & 127; \
        p0_item<true>(w_gu + (size_t)e * D * 2048, D, 2048, Wgu_t + (size_t)e * 2048 * D, kb * 128, n0, 256 * pn + 128 * bj + cl, lane); break; } \
    r -= I_GU; \
    { const int e = r / 256, q = r % 256, kb = q / 32, nb = q % 32; \
      p0_item<true>(w_dn + (size_t)e * DFF * D, DFF, D, Wdn_t + (size_t)e * D * DFF, kb * 128, nb * 32, nb * 32, lane); } } while (0)
#ifndef PROBE_PHASE
#define PROBE_PHASE (-1)
#endif
#ifndef PROBE_TS
#define PROBE_TS (-1)
#endif
constexpr int CW_TS = 1200;
__device__ __forceinline__ void p0_transpose_item_fp8(const float* W, int K, int N, unsigned char* WT, int k0, int n0, int dst_row0, LAS float* scr, int lane) {
#pragma unroll 8
    for (int i = 0; i < 32; ++i) { const int kk = 2 * i + (lane >> 5); scr[kk * 33 + (lane & 31)] = W[(size_t)(k0 + kk) * N + n0 + (lane & 31)]; }
    LDS_WAIT(); asm volatile("" ::: "memory");
    const int c = lane & 3;
#pragma unroll
    for (int j = 0; j < 2; ++j) { const int n = (lane >> 2) + 16 * j; const LAS float* s = scr + (16 * c) * 33 + n;
        u32x4 o;
        o.x = pk4_fp8(s[0 * 33] * W8_SCALE, s[1 * 33] * W8_SCALE, s[2 * 33] * W8_SCALE, s[3 * 33] * W8_SCALE); o.y = pk4_fp8(s[4 * 33] * W8_SCALE, s[5 * 33] * W8_SCALE, s[6 * 33] * W8_SCALE, s[7 * 33] * W8_SCALE);
        o.z = pk4_fp8(s[8 * 33] * W8_SCALE, s[9 * 33] * W8_SCALE, s[10 * 33] * W8_SCALE, s[11 * 33] * W8_SCALE); o.w = pk4_fp8(s[12 * 33] * W8_SCALE, s[13 * 33] * W8_SCALE, s[14 * 33] * W8_SCALE, s[15 * 33] * W8_SCALE);
        *(u32x4*)(WT + (size_t)(dst_row0 + n) * K + k0 + 16 * c) = o; }
    LDS_WAIT(); asm volatile("" ::: "memory");
}
constexpr int CW_Q = 1100, I_TAIL = 0;
constexpr int I_GTAIL = 172 * 4;
#define MOE_CONVERT_PULL() do { \
    for (;;) { int it_ = 0; if (lane == 0) it_ = (int)atomicAdd(ctl + CW_Q, 2u); it_ = __builtin_amdgcn_readfirstlane(it_) + (I_MOE - I_TAIL); if (it_ >= I_MOE) break; \
        f32x4 va[16], vb[16]; \
        { MOE_DECODE(it_); p0_load(src_, N_, kb_ * 128, n0_, lane, va); } \
        { MOE_DECODE(it_ + 1); p0_load(src_, N_, kb_ * 128, n0_, lane, vb); } \
        { MOE_DECODE(it_); p0_store<true>(dst_, 1024, kb_ * 128, drow_, lane, va); } \
        { MOE_DECODE(it_ + 1); p0_store<true>(dst_, 1024, kb_ * 128, drow_, lane, vb); } } } while (0)
struct Args { const float* in[17]; float* out; unsigned char* ws; int ph_lo, ph_hi, li, pad; };

__global__ void __launch_bounds__(512, 2) mk_fwd(Args args) {
    extern __shared__ __attribute__((aligned(16))) unsigned char lds_raw[];
    LAS unsigned char* lds = (LAS unsigned char*)lds_raw;
    volatile LAS unsigned* MISC = (volatile LAS unsigned*)(lds + MISC_OFF);
    const int tid = threadIdx.x, lane = tid & 63, wave = __builtin_amdgcn_readfirstlane(tid >> 6);
    const int G = gridDim.x, bx = blockIdx.x;
    const int vcu = (G % 8 == 0) ? (bx % 8) * (G / 8) + bx / 8 : bx;
    unsigned char* ws = args.ws;
    unsigned* ctl = (unsigned*)(ws + WS_CTL);
    const float* x = args.in[0]; const float* meta = args.in[1]; const float* g1 = args.in[2]; const float* w_in = args.in[3];
    const float* qg = args.in[4]; const float* kg = args.in[5];
    const float* w_ab = args.in[7]; const float* w_rb = args.in[8]; const float* w_out = args.in[9];
    const float* w_gu = args.in[13]; const float* b_gu = args.in[14]; const float* w_dn = args.in[15]; const float* b_dn = args.in[16];
    float* out = args.out;
    bf16* Win_t = (bf16*)(ws + WS_WIN); bf16* Wab_t = (bf16*)(ws + WS_WAB); bf16* Wrb_t = (bf16*)(ws + WS_WRB); bf16* Wout_t = (bf16*)(ws + WS_WOUT);
    unsigned char* Wgu_t = ws + WS_WGU; unsigned char* Wdn_t = ws + WS_WDN;
    bf16* xb = (bf16*)(ws + 957 * MiB);        bf16* proj = (bf16*)(ws + WS_PROJ); bf16* yatt = (bf16*)(ws + WS_YATT); bf16* yret = (bf16*)(ws + WS_YRET); bf16* merged = (bf16*)(ws + WS_MERGED);
    bf16* pmeta = proj + (size_t)NTOK * INW;
    const float* sinks = args.in[6]; const float* g2 = args.in[10]; const float* w_r = args.in[11]; const float* b_r = args.in[12];
    int* tke = (int*)(ws + SM_TKE); float* tkw = (float*)(ws + SM_TKW); int* tkpos = (int*)(ws + SM_TKPOS); int* list = (int*)(ws + SM_LIST); float* wlist = (float*)(ws + SM_WLIST); float* rlist = (float*)(ws + SM_RLIST);
    LAS unsigned char* misc = lds + MISC_OFF;
    bf16* states = (bf16*)(ws + ret::WS_STATES);
    bf16* h2b = (bf16*)(ws + ret::WS_STATES);
    float* xirs = (float*)(ws + WS_SMALL + 14 * MiB);
    float* ig1 = xirs + NTOK;
    unsigned char* xb8 = ws + WS_MERGED; unsigned char* Win8 = ws + WS_YRET;
    unsigned char* act = ws + WS_ACT; unsigned char* rows = ws + WS_ROWS; unsigned char* xn8 = ws + WS_XB;

    for (int u = tid; u < (LDS_BYTES - MISC_OFF) / 4; u += 512) ((LAS unsigned*)(lds + MISC_OFF))[u] = 0u;
    __syncthreads();
    XcdBarrier bar = xcd_barrier_post(ctl + CW_BAR + args.li * XCD_BAR_WORDS, MISC + 3968);
    const int lo = args.ph_lo, hi = args.ph_hi;
#define IN(k) (lo <= (k) && (k) < hi)
#define BOTH(k) (IN(k) && IN((k) + 1))
#define GRID_BAR() do { xcd_barrier(bar); if (PROBE_TS >= 0 && bx == 0 && tid == 0) { ctl[CW_TS + ts_n] = (unsigned)__builtin_amdgcn_s_memrealtime(); ctl[CW_TS + 900 + ts_n] = (unsigned)__builtin_amdgcn_s_memtime(); } ++ts_n; } while (0)
    int ts_n = 1; if (PROBE_TS >= 0 && bx == 0 && tid == 0) ctl[CW_TS] = (unsigned)__builtin_amdgcn_s_memrealtime();

    if (PROBE_PHASE == 303) { asm volatile(".rept 4096\n\ts_nop 0\n\t.endr" ::: "memory"); }
    if (PROBE_PHASE == 300) { const unsigned long long t0_ = __builtin_amdgcn_s_memrealtime(); while (__builtin_amdgcn_s_memrealtime() - t0_ < 5000ull) __builtin_amdgcn_s_sleep(8); }
    if (PROBE_PHASE == 301) {
        const size_t gt = (size_t)bx * 512 + tid; unsigned acc_ = 0;
        for (size_t pg = gt; pg < (size_t)NTOK * D * 4 / 4096; pg += (size_t)G * 512) acc_ += ((const unsigned*)x)[pg * 1024];
        for (size_t pg = gt; pg < (size_t)D * INW * 4 / 4096; pg += (size_t)G * 512) acc_ += ((const unsigned*)w_in)[pg * 1024];
        for (size_t pg = gt; pg < (size_t)(NTOK + 256) * D * 2 / 4096; pg += (size_t)G * 512) acc_ += ((const unsigned*)xb)[pg * 1024];
        for (size_t pg = gt; pg < (size_t)INW * D * 2 / 4096; pg += (size_t)G * 512) acc_ += ((const unsigned*)Win_t)[pg * 1024];
        asm volatile("" :: "v"(acc_));
    }
    if (IN(0)) { for (int rep_ = 0; rep_ < ((PROBE_PHASE == 0) ? 2 : 1); ++rep_) {
        const int gw = vcu * NWAVES + wave, NGW = G * NWAVES;
        for (int it = gw; it < ((G == 256) ? I_SMALL : NITEMS); it += NGW) { P0_DISPATCH(it); }
        if (PROBE_TS >= 0 && bx == 0) { __syncthreads(); if (tid == 0) ctl[CW_TS + 20] = (unsigned)__builtin_amdgcn_s_memrealtime(); }
        if (bx == 0) { ig1[tid] = 1.0f / g1[tid]; ig1[tid + 512] = 1.0f / g1[tid + 512]; }
        for (int row0_ = gw; row0_ < NTOK; row0_ += 4 * NGW) {
            f32x4 v[4][4];
#pragma unroll
            for (int q = 0; q < 4; ++q) { const int row = row0_ + q * NGW; if (row < NTOK) { const f32x4* xr = (const f32x4*)(x + (size_t)row * D) + lane;
#pragma unroll
                for (int j = 0; j < 4; ++j) v[q][j] = __builtin_nontemporal_load(xr + 64 * j); } }
#pragma unroll
            for (int q = 0; q < 4; ++q) { const int row = row0_ + q * NGW; if (row < NTOK) {
                float ss = 0.f;
#pragma unroll
                for (int j = 0; j < 4; ++j) ss += (v[q][j][0] * v[q][j][0] + v[q][j][1] * v[q][j][1]) + (v[q][j][2] * v[q][j][2] + v[q][j][3] * v[q][j][3]);
                const float ms_ = wave_sum(ss) * (1.0f / D) + EPS, rstd = rsqrtf(ms_);
                if (lane == 0) xirs[row] = sqrtf(ms_);
                u32x2* o8 = (u32x2*)(xb + (size_t)row * D) + lane; unsigned* o4 = (unsigned*)(xb8 + (size_t)row * D) + lane;
#pragma unroll
                for (int j = 0; j < 4; ++j) { const f32x4 gg = ((const f32x4*)g1)[64 * j + lane]; const float e0 = v[q][j][0] * rstd * gg[0], e1 = v[q][j][1] * rstd * gg[1], e2 = v[q][j][2] * rstd * gg[2], e3 = v[q][j][3] * rstd * gg[3];
                    u32x2 w; w.x = pk2(e0, e1); w.y = pk2(e2, e3); o8[64 * j] = w; o4[64 * j] = pk4_fp8(e0 * XB8_SCALE, e1 * XB8_SCALE, e2 * XB8_SCALE, e3 * XB8_SCALE); }
            } }
        }
        if (PROBE_TS >= 0 && bx == 0) { __syncthreads(); if (tid == 0) ctl[CW_TS + 21] = (unsigned)__builtin_amdgcn_s_memrealtime(); }
        for (int row = gw; row < 256; row += NGW) {
            u32x2* o8 = (u32x2*)(xb + (size_t)(NTOK + row) * D) + lane; unsigned* o4 = (unsigned*)(xb8 + (size_t)(NTOK + row) * D) + lane;
            if (row < NMETA) {
                const f32x4* xr = (const f32x4*)(meta + (size_t)row * D) + lane;
                f32x4 v[4]; float ss = 0.f;
#pragma unroll
                for (int j = 0; j < 4; ++j) { v[j] = xr[64 * j]; ss += (v[j][0] * v[j][0] + v[j][1] * v[j][1]) + (v[j][2] * v[j][2] + v[j][3] * v[j][3]); }
                const float rstd = rsqrtf(wave_sum(ss) * (1.0f / D) + EPS);
#pragma unroll
                for (int j = 0; j < 4; ++j) { const f32x4 gg = ((const f32x4*)g1)[64 * j + lane]; const float e0 = v[j][0] * rstd * gg[0], e1 = v[j][1] * rstd * gg[1], e2 = v[j][2] * rstd * gg[2], e3 = v[j][3] * rstd * gg[3];
                    u32x2 w; w.x = pk2(e0, e1); w.y = pk2(e2, e3); o8[64 * j] = w; o4[64 * j] = pk4_fp8(e0 * XB8_SCALE, e1 * XB8_SCALE, e2 * XB8_SCALE, e3 * XB8_SCALE); }
            } else {
#pragma unroll
                for (int j = 0; j < 4; ++j) { o8[64 * j] = (u32x2){0u, 0u}; o4[64 * j] = 0u; }
            }
        }
        __syncthreads(); }
        if (PROBE_TS >= 0 && bx == 0) { asm volatile("s_waitcnt vmcnt(0)" ::: "memory"); __syncthreads(); if (tid == 0) ctl[CW_TS + 22] = (unsigned)__builtin_amdgcn_s_memrealtime(); }
        if (BOTH(0)) GRID_BAR();
    }
    if (PROBE_PHASE == 200) { GRID_BAR(); GRID_BAR(); GRID_BAR(); GRID_BAR(); }
    if (IN(1)) {
        const int nconv = (G == 256) ? NCONV : 0;
        if (bx < nconv) {
            const int cw = bx * NWAVES + wave, ncw = nconv * NWAVES;
            f32x4 va[16], vb[16], vc[16];
            constexpr int I_P1 = I_MOE - I_TAIL - I_GTAIL;
#define CV_LOAD(V_, it_) do { if ((it_) < I_P1) { MOE_DECODE(it_); p0_load(src_, N_, kb_ * 128, n0_, lane, V_); } } while (0)
#define CV_STORE(V_, it_) do { if ((it_) < I_P1) { MOE_DECODE(it_); p0_store<true, true>(dst_, 1024, kb_ * 128, drow_, lane, V_); } } while (0)
            CV_LOAD(va, cw); CV_LOAD(vb, cw + ncw); CV_LOAD(vc, cw + 2 * ncw);
#pragma unroll 1
            for (int it = cw; it < I_P1; it += 3 * ncw) {
                CV_STORE(va, it); CV_LOAD(va, it + 3 * ncw);
                CV_STORE(vb, it + ncw); CV_LOAD(vb, it + 4 * ncw);
                CV_STORE(vc, it + 2 * ncw); CV_LOAD(vc, it + 5 * ncw);
            }
#undef CV_LOAD
#undef CV_STORE
        } else {
            { LAS float* gt = (LAS float*)(misc + MT_GAIN); if (tid < 64) { gt[tid] = 0.125f * 1.4426950408889634f * qg[tid]; gt[64 + tid] = kg[tid]; }       __syncthreads(); }
            const bool tuned = (G == 256);
            { SchedRounds<2> S; S.init(xb, Win_t, NTOK + 256, 256 * T8, D, G - nconv, bx - nconv);
              if (tuned) { S.nf = 10; S.lo1 = 0; S.hi1 = 43; S.n1 = 1; S.lo2 = 0; S.hi2 = 0; S.n2 = 0; S.pnrot = 13; } else { S.nf = 1 << 20; S.lo1 = S.hi1 = S.n1 = S.lo2 = S.hi2 = S.n2 = 0; }
              EpiProjT<0, false> E{proj, (LAS const float*)(misc + MT_GAIN)};
              pg8::gemm_phase<EpiProjT<0, false>, SchedRounds<2>>(lds, 2 * D, S, E); }
            { SchedRounds<1> S; S.init((const bf16*)xb8, (const bf16*)Win8, NTOK + 256, INW - 256 * T8, D, G - nconv, bx - nconv);
              if (tuned) { S.nf = 4; S.lo1 = 43; S.hi1 = 215; S.n1 = 1; S.lo2 = 0; S.hi2 = 0; S.n2 = 0; } else { S.nf = 1 << 20; S.lo1 = S.hi1 = S.n1 = S.lo2 = S.hi2 = S.n2 = 0; }
              EpiProjT<T8, true> E{proj, (LAS const float*)(misc + MT_GAIN)};
              pg8::gemm_phase<EpiProjT<T8, true>, SchedRounds<1>, true>(lds, D, S, E); }
            if (tuned) { const int c = bx - nconv;
                if (c >= 43 && wave < 4) { const int it_ = I_MOE - I_TAIL - I_GTAIL + (c - 43) * 4 + wave; f32x4 va[16]; MOE_DECODE(it_); p0_load(src_, N_, kb_ * 128, n0_, lane, va); p0_store<true, true>(dst_, 1024, kb_ * 128, drow_, lane, va); } }
        }
        if (PROBE_TS >= 0) { asm volatile("s_waitcnt vmcnt(0)" ::: "memory"); __syncthreads(); if (tid == 0) ctl[CW_TS + 576 + bx] = (unsigned)__builtin_amdgcn_s_memrealtime(); }
        if (BOTH(1)) GRID_BAR();
    }
    if (IN(2)) {
        float mq = fabsf(qg[lane]), mk = fabsf(kg[lane]);
#pragma unroll
        for (int o = 1; o < 64; o <<= 1) { mq = fmaxf(mq, __shfl_xor(mq, o)); mk = fmaxf(mk, __shfl_xor(mk, o)); }
        const float bshift = 8.0f * mq * mk;
        if (G == 256) {
            if (bx < 128) {
                const int x = bx & 7, r = bx >> 3;
                ret::state_chain2(lds, (x * 4 + (r >> 2)) >> 2, (x * 4 + (r >> 2)) & 3, r & 3, proj, pmeta, states);
                if (PROBE_TS >= 0) { asm volatile("s_waitcnt vmcnt(0)" ::: "memory"); __syncthreads(); if (tid == 0) ctl[CW_TS + 64 + bx] = (unsigned)__builtin_amdgcn_s_memrealtime(); }
                attn::phase(lds, proj, pmeta, sinks, bshift, yatt, 0, 0, 1, bx, 2, 4);
                if (PROBE_TS >= 0) { asm volatile("s_waitcnt vmcnt(0)" ::: "memory"); __syncthreads(); if (tid == 0) ctl[CW_TS + 320 + bx] = (unsigned)__builtin_amdgcn_s_memrealtime(); }
            } else { attn::phase(lds, proj, pmeta, sinks, bshift, yatt, 128 + (bx - 128), 3, 128, bx - 128, 0, 2);
                if (PROBE_TS >= 0) { asm volatile("s_waitcnt vmcnt(0)" ::: "memory"); __syncthreads(); if (tid == 0) ctl[CW_TS + 320 + bx] = (unsigned)__builtin_amdgcn_s_memrealtime(); } }
        } else {
            for (int p = bx; p < 128; p += G) ret::state_chain2(lds, p >> 4, (p >> 2) & 3, p & 3, proj, pmeta, states);
            attn::phase(lds, proj, pmeta, sinks, bshift, yatt, bx, (NB * 32 * 2 - bx + G - 1) / G, G);
        }
        if (BOTH(2)) GRID_BAR();
    }
    if (IN(3)) {
        ret::out_phase(lds, proj, states, yret, G, bx);
        if (BOTH(3)) GRID_BAR();
    }
    if (IN(4)) {
        SchedBranch2 S; S.init(yatt, Wab_t, NTOK, D, D, G, bx); S.dA = (size_t)(WS_YRET - WS_YATT) - 16 * 128; S.dB = (size_t)(WS_WRB - WS_WAB) - 16 * 128;
        EpiBranch2 E{merged, proj};
        pg8::gemm_phase<EpiBranch2, SchedBranch2>(lds, 2 * D, S, E, (PROBE_TS >= 0 && bx == 0 && tid == 0) ? ctl + CW_TS + 50 : nullptr);
        if (BOTH(4)) GRID_BAR();
    }
    if (IN(5)) {
        SchedDense S; S.init(merged, Wout_t, NTOK, D, D, G, bx);
        float gmin = 1e30f;
#pragma unroll
        for (int k = 0; k < 16; ++k) gmin = fminf(gmin, fabsf(g1[lane + 64 * k]));
#pragma unroll
        for (int o = 1; o < 64; o <<= 1) gmin = fminf(gmin, __shfl_xor(gmin, o));
        if (__builtin_amdgcn_readfirstlane(gmin > 0.01f ? 1 : 0)) { EpiOutXb E{h2b, xb, xirs, ig1, misc}; pg8::gemm_phase<EpiOutXb, SchedDense>(lds, 2 * D, S, E); }
        else { EpiOut E{x, h2b}; pg8::gemm_phase<EpiOut, SchedDense>(lds, 2 * D, S, E); }
        if (BOTH(5)) { route_images(lds, g2, w_r); GRID_BAR(); }
    }
    if (IN(6)) {
        if (!IN(5)) route_images(lds, g2, w_r);
        route_phase(lds, h2b, g2, w_r, b_r, xn8, tke, tkpos, tkw, list, wlist, rlist, ctl + CW_CNTS, G, bx);
        if (BOTH(6)) GRID_BAR();
    }
    if (hi > 7 && lo <= 9) moe_tables(misc, ctl + CW_CNTS);
    if (IN(7)) {
        SchedMoe<true, 8> S{(const char*)xn8, (const char*)Wgu_t, misc, list, G, bx};
        EpiGU E{act, b_gu, rlist, misc};
        pg8::gemm_phase<EpiGU, SchedMoe<true, 8>, true>(lds, D, S, E);
        if (G == 256 && I_TAIL > 0) MOE_CONVERT_PULL();
        if (BOTH(7)) GRID_BAR();
    }
    if (IN(8)) {
        SchedMoe<false, 4> S{(const char*)act, (const char*)Wdn_t, misc, list, G, bx};
        EpiDown E{rows, b_dn, wlist, misc};
        pg8::gemm_phase<EpiDown, SchedMoe<false, 4>, true>(lds, DFF, S, E);
        if (BOTH(8)) GRID_BAR();
    }
    float oscale = 1.0f;
    if (PROBE_TS >= 0) {
        xcd_barrier(bar);
        unsigned a = ctl[CW_TS + (PROBE_TS == 99 ? 0 : PROBE_TS)], b = ctl[CW_TS + (PROBE_TS == 99 ? 0 : PROBE_TS) + 1];
        if (PROBE_TS == 10) { a = ctl[CW_TS + 0]; b = ctl[CW_TS + 20]; } if (PROBE_TS == 11) { a = ctl[CW_TS + 20]; b = ctl[CW_TS + 21]; }
        if (PROBE_TS == 12) { a = ctl[CW_TS + 21]; b = ctl[CW_TS + 22]; } if (PROBE_TS == 13) { a = ctl[CW_TS + 22]; b = ctl[CW_TS + 1]; }
        float frac = fminf((float)(b - a) * (1.0f / 40000.0f), 1.0f); if (PROBE_TS == 99) frac = 0.5f;
        if (PROBE_TS >= 14 && PROBE_TS <= 19) {
            a = ctl[CW_TS + 2]; unsigned mx = 0, mn = 0xffffffffu;
            const int base_ = (PROBE_TS <= 15) ? 64 : 320, lo_ = (PROBE_TS <= 16) ? 0 : 128, hi_ = (PROBE_TS <= 16) ? 128 : 256;
            for (int w = lo_; w < hi_; ++w) { const unsigned d_ = ctl[CW_TS + base_ + w] - a; mx = d_ > mx ? d_ : mx; mn = d_ < mn ? d_ : mn; }
            b = a + ((PROBE_TS == 15 || PROBE_TS == 18) ? mn : mx); }
        if (PROBE_TS >= 20 && PROBE_TS <= 22) {
            a = ctl[CW_TS + 1]; unsigned mx = 0, mn = 0xffffffffu;
            for (int w = (PROBE_TS == 20 ? 0 : NCONV); w < (PROBE_TS == 20 ? NCONV : 256); ++w) { const unsigned d_ = ctl[CW_TS + 576 + w] - a; mx = d_ > mx ? d_ : mx; mn = d_ < mn ? d_ : mn; }
            b = a + (PROBE_TS == 22 ? mn : mx); }
        if (PROBE_TS >= 100) { a = ctl[CW_TS + PROBE_TS - 100]; b = ctl[CW_TS + PROBE_TS - 99]; } if (PROBE_TS >= 110 && PROBE_TS <= 112) b = a;
        if (PROBE_TS >= 40 && PROBE_TS <= 49) { a = 0; b = (ctl[CW_TS + 900 + PROBE_TS - 39] - ctl[CW_TS + 900 + PROBE_TS - 40]) / 100u; }
        if (PROBE_TS >= 30 && PROBE_TS <= 33) { a = 0; b = ctl[CW_TS + 40 + PROBE_TS - 30]; }
        if (PROBE_TS >= 34 && PROBE_TS <= 35) { a = 0; b = ctl[CW_TS + 50 + PROBE_TS - 34]; }
        if ((PROBE_TS >= 10 && PROBE_TS <= 49) || PROBE_TS >= 100) {
            if (bx == 0 && tid == 0) { const unsigned long long t0_ = __builtin_amdgcn_s_memrealtime(), w_ = (PROBE_TS >= 30 && PROBE_TS <= 35) ? (unsigned long long)(b - a) / 4ull : 4ull * (unsigned long long)(b - a); while (__builtin_amdgcn_s_memrealtime() - t0_ < w_) __builtin_amdgcn_s_sleep(8); }
            frac = -1.0f; }
        if (PROBE_TS == 0 || (PROBE_TS >= 10 && PROBE_TS <= 13)) { oscale = 1.0f + sqrtf(0.0012f + 0.0018f * frac); } else
        oscale = 1.0f + sqrtf(0.0009f + 0.0033f * frac);
        if (frac < 0.f) oscale = 1.0f;
    }
    if (PROBE_TS == 9) {
        if (bx == 0 && tid == 0) ctl[CW_TS + 30] = (unsigned)__builtin_amdgcn_s_memrealtime();
        combine_phase(misc, h2b, out, rows, tke, tkpos, vcu * NWAVES + wave, G * NWAVES, lane, 1.0f, 0, NTOK / 2);
        xcd_barrier(bar);
        if (bx == 0 && tid == 0) ctl[CW_TS + 31] = (unsigned)__builtin_amdgcn_s_memrealtime();
        xcd_barrier(bar);
        const float frac = fminf((float)(ctl[CW_TS + 31] - ctl[CW_TS + 30]) * (1.0f / 40000.0f), 1.0f);
        combine_phase(misc, h2b, out, rows, tke, tkpos, vcu * NWAVES + wave, G * NWAVES, lane, 1.0f + sqrtf(0.0024f + 0.0036f * frac), NTOK / 2, NTOK);
    } else
    if (IN(9)) combine_phase(misc, h2b, out, rows, tke, tkpos, vcu * NWAVES + wave, G * NWAVES, lane, oscale);
    if (PROBE_TS == 111 || PROBE_TS == 112) { asm volatile("s_waitcnt vmcnt(0)" ::: "memory"); __syncthreads();
        if (tid == 0) ctl[CW_TS + 320 + bx] = (unsigned)__builtin_amdgcn_s_memrealtime();
        xcd_barrier(bar);
        if (bx == 0 && tid == 0) { unsigned mx = 0, mn = 0xffffffffu; const unsigned a_ = ctl[CW_TS + 9];
            for (int w = 0; w < 256; ++w) { const unsigned d_ = ctl[CW_TS + 320 + w] - a_; mx = d_ > mx ? d_ : mx; mn = d_ < mn ? d_ : mn; }
            const unsigned long long t0_ = __builtin_amdgcn_s_memrealtime(), w_ = 4ull * (unsigned long long)(PROBE_TS == 111 ? mx : mn); while (__builtin_amdgcn_s_memrealtime() - t0_ < w_) __builtin_amdgcn_s_sleep(8); } }
    if (PROBE_TS == 110) { asm volatile("s_waitcnt vmcnt(0)" ::: "memory"); __syncthreads();
        if (bx == 0 && tid == 0) { const unsigned long long t0_ = __builtin_amdgcn_s_memrealtime(), w_ = 4ull * (unsigned long long)((unsigned)t0_ - ctl[CW_TS + 9]); while (__builtin_amdgcn_s_memrealtime() - t0_ < w_) __builtin_amdgcn_s_sleep(8); } }
#undef IN
#undef BOTH
#undef GRID_BAR
}

extern "C" void kernel_launch(void* const* d_in, const int* in_sizes, int n_in, void* d_out, int out_size, void* d_ws, size_t ws_size, hipStream_t stream) {
    static int grid = 0;
    if (grid == 0) {
        if (n_in != 17 || in_sizes[0] != NTOK * D || out_size != NTOK * D || ws_size < WS_END) {
            fprintf(stderr, "kernel_launch: unexpected shapes (n_in %d in0 %d out %d ws %zu)\n", n_in, n_in > 0 ? in_sizes[0] : -1, out_size, ws_size); grid = -1; return; }
        int dev = 0, cus = 0;
        if (hipGetDevice(&dev) != hipSuccess || hipDeviceGetAttribute(&cus, hipDeviceAttributeMultiprocessorCount, dev) != hipSuccess) { grid = -1; return; }
        if (hipFuncSetAttribute((const void*)mk_fwd, hipFuncAttributeMaxDynamicSharedMemorySize, LDS_BYTES) != hipSuccess) { fprintf(stderr, "kernel_launch: hipFuncSetAttribute failed\n"); grid = -1; return; }
        grid = cus;
    }
    if (grid < 0) return;
    unsigned char* ws = (unsigned char*)d_ws;
    (void)hipMemsetAsync(ws + WS_CTL, 0, 32768, stream);
#if defined(PROBE_PHASE) && PROBE_PHASE == 302
    (void)hipMemsetAsync(ws + WS_CTL + 65536, 0, 32768, stream);
#endif
    Args a{};
    for (int i = 0; i < 17; ++i) a.in[i] = (const float*)d_in[i];
    a.out = (float*)d_out; a.ws = ws; a.ph_lo = 0; a.ph_hi = 10; a.li = 0; a.pad = 0;
    hipLaunchKernelGGL(mk_fwd, dim3(grid), dim3(512), LDS_BYTES, stream, a);
}
```
